# Optimizing an MI355X kernel written in HIP

```python
import jax, jax.numpy as jnp
from jax import lax
import numpy as np

D_MODEL = 1024
BATCH = 16
SEQ = 4096
DEPTH = 1

MLA_HEADS = 8
MLA_NOPE_DIM = 64
MLA_ROPE_DIM = 32
MLA_V_DIM = 64
MLA_Q_RANK = 256
MLA_KV_RANK = 128
MLA_WIDTH = MLA_HEADS * MLA_V_DIM
MOBA_HEADS = 8
MOBA_HEAD_DIM = 64
MOBA_WIDTH = MOBA_HEADS * MOBA_HEAD_DIM
MOBA_BLOCK = 256
MOBA_TOPK = 3
MOBA_Q_CHUNK = 16
ATTN_Q_BLOCK = 128
ROPE_THETA = 10000.0
EPS = 1e-6
N_BRANCHES = 2
IN_SIZES = (MLA_Q_RANK, MLA_KV_RANK, MLA_ROPE_DIM, MLA_WIDTH,
            MOBA_WIDTH, MOBA_WIDTH, MOBA_WIDTH, MOBA_WIDTH, N_BRANCHES * D_MODEL)
D_IN = MLA_Q_RANK + MLA_KV_RANK + MLA_ROPE_DIM + MLA_WIDTH + 4 * MOBA_WIDTH + N_BRANCHES * D_MODEL

kernel_name = "hybrid_mla_moba_gated_parallel"


def rms_norm(t, g):
    tf = t.astype(jnp.float32)
    tf = tf * lax.rsqrt(jnp.mean(tf * tf, axis=-1, keepdims=True) + EPS)
    return (tf * g.astype(jnp.float32)).astype(t.dtype)


def apply_rope(t, positions):
    half = t.shape[-1] // 2
    inv_freq = ROPE_THETA ** (-jnp.arange(half, dtype=jnp.float32) / half)
    ang = positions.astype(jnp.float32)[:, :, None, None] * inv_freq
    cos, sin = jnp.cos(ang), jnp.sin(ang)
    tf = t.astype(jnp.float32)
    t1, t2 = tf[..., :half], tf[..., half:]
    return jnp.concatenate([t1 * cos - t2 * sin, t2 * cos + t1 * sin], axis=-1).astype(t.dtype)


def split_cols(t, sizes):
    outs, start = [], 0
    for n in sizes:
        outs.append(t[..., start:start + n])
        start += n
    return outs


def causal_dense_attention(q, k, v, scale):
    B, S, H, _ = q.shape
    kpos = jnp.arange(S)

    def one_block(i):
        start = i * ATTN_Q_BLOCK
        qb = lax.dynamic_slice_in_dim(q, start, ATTN_Q_BLOCK, axis=1)
        s = jnp.einsum('bqhd,bkhd->bhqk', qb, k).astype(jnp.float32) * scale
        qpos = start + jnp.arange(ATTN_Q_BLOCK)
        s = jnp.where(kpos[None, :] <= qpos[:, None], s, -jnp.inf)
        p = jax.nn.softmax(s, axis=-1).astype(v.dtype)
        return jnp.einsum('bhqk,bkhd->bqhd', p, v)

    out = lax.map(one_block, jnp.arange(S // ATTN_Q_BLOCK))
    return out.transpose(1, 0, 2, 3, 4).reshape(B, S, H, v.shape[-1])


def moba_attention(q, k, v):
    B, S, H, dh = q.shape
    nb = -(-S // MOBA_BLOCK)
    n_top = min(MOBA_TOPK, nb)
    pad = nb * MOBA_BLOCK - S
    kp = jnp.pad(k, ((0, 0), (0, pad), (0, 0), (0, 0)))
    vp = jnp.pad(v, ((0, 0), (0, pad), (0, 0), (0, 0)))
    kb = kp.reshape(B, nb, MOBA_BLOCK, H, dh).transpose(0, 3, 1, 2, 4)
    vb = vp.reshape(B, nb, MOBA_BLOCK, H, dh).transpose(0, 3, 1, 2, 4)
    kmean = jnp.mean(kb.astype(jnp.float32), axis=3)
    scale = dh ** -0.5
    bi = jnp.arange(B)[:, None, None, None]
    hi = jnp.arange(H)[None, :, None, None]
    in_blk = jnp.arange(MOBA_BLOCK)
    blk_ids = jnp.arange(nb)
    n_sel = n_top * MOBA_BLOCK

    def one_chunk(i):
        start = i * MOBA_Q_CHUNK
        qc = lax.dynamic_slice_in_dim(q, start, MOBA_Q_CHUNK, axis=1)
        qpos = start + jnp.arange(MOBA_Q_CHUNK)
        own = start // MOBA_BLOCK
        gate = jnp.einsum('bqhd,bhnd->bhqn', qc.astype(jnp.float32), kmean)
        gate = jnp.where(blk_ids < own, gate, -jnp.inf)
        _, idx = lax.top_k(gate, n_top)
        valid = jnp.arange(n_top) < own
        k_sel = kb[bi, hi, idx]
        v_sel = vb[bi, hi, idx]
        s_sel = jnp.einsum('bqhd,bhqnkd->bhqnk', qc, k_sel).astype(jnp.float32) * scale
        s_sel = jnp.where(valid[:, None], s_sel, -jnp.inf)
        k_own = lax.dynamic_index_in_dim(kb, own, axis=2, keepdims=False)
        v_own = lax.dynamic_index_in_dim(vb, own, axis=2, keepdims=False)
        s_own = jnp.einsum('bqhd,bhkd->bhqk', qc, k_own).astype(jnp.float32) * scale
        kpos_own = own * MOBA_BLOCK + in_blk
        s_own = jnp.where(kpos_own[None, :] <= qpos[:, None], s_own, -jnp.inf)
        s = jnp.concatenate([s_sel.reshape(B, H, MOBA_Q_CHUNK, n_sel), s_own], axis=-1)
        p = jax.nn.softmax(s, axis=-1).astype(v.dtype)
        p_sel = p[..., :n_sel].reshape(B, H, MOBA_Q_CHUNK, n_top, MOBA_BLOCK)
        p_own = p[..., n_sel:]
        return (jnp.einsum('bhqnk,bhqnkd->bqhd', p_sel, v_sel)
                + jnp.einsum('bhqk,bhkd->bqhd', p_own, v_own))

    out = lax.map(one_chunk, jnp.arange(S // MOBA_Q_CHUNK))
    return out.transpose(1, 0, 2, 3, 4).reshape(B, S, H, dh)


def setup_inputs(seed: int = 0) -> dict:
    key = jax.random.key(seed)
    ks = jax.random.split(key, 20)

    def w(k, shape, fan_in, mult=1.0):
        return jax.random.normal(k, shape, jnp.float32) * (mult * fan_in ** -0.5)

    def gain(k, n):
        return 1.0 + 0.05 * jax.random.normal(k, (DEPTH, n), jnp.float32)

    x = jax.random.normal(ks[0], (BATCH, SEQ, D_MODEL), jnp.float32)
    c = jax.random.normal(ks[1], (BATCH, D_MODEL), jnp.float32)
    offset = jax.random.randint(ks[2], (BATCH, 1), 0, 1024, dtype=jnp.int32)
    positions = (offset + jnp.arange(SEQ, dtype=jnp.int32)[None, :]).astype(jnp.int32)
    return {
        "x": x,
        "c": c,
        "positions": positions,
        "w_ada": w(ks[3], (DEPTH, D_MODEL, 3 * D_MODEL), D_MODEL, 0.5),
        "b_ada": 0.01 * jax.random.normal(ks[4], (DEPTH, 3 * D_MODEL), jnp.float32),
        "g_pre": gain(ks[5], D_MODEL),
        "g_post": gain(ks[6], D_MODEL),
        "w_in": w(ks[7], (DEPTH, D_MODEL, D_IN), D_MODEL),
        "g_q_lat": gain(ks[8], MLA_Q_RANK),
        "w_uq": w(ks[9], (DEPTH, MLA_Q_RANK, MLA_HEADS * (MLA_NOPE_DIM + MLA_ROPE_DIM)), MLA_Q_RANK),
        "g_kv_lat": gain(ks[10], MLA_KV_RANK),
        "w_ukv": w(ks[11], (DEPTH, MLA_KV_RANK, MLA_HEADS * (MLA_NOPE_DIM + MLA_V_DIM)), MLA_KV_RANK),
        "w_o_mla": w(ks[12], (DEPTH, MLA_WIDTH, D_MODEL), MLA_WIDTH),
        "w_o_moba": w(ks[13], (DEPTH, MOBA_WIDTH, D_MODEL), MOBA_WIDTH),
        "b_merge": 0.01 * jax.random.normal(ks[14], (DEPTH, N_BRANCHES * D_MODEL), jnp.float32),
        "w_out": w(ks[15], (DEPTH, D_MODEL, D_MODEL), D_MODEL),
    }


def reference(x, c, positions, w_ada, b_ada, g_pre, g_post, w_in, g_q_lat, w_uq,
              g_kv_lat, w_ukv, w_o_mla, w_o_moba, b_merge, w_out):
    B, S, D = x.shape
    for l in range(DEPTH):
        mod = jax.nn.silu(c) @ w_ada[l] + b_ada[l]
        shift, scale, gate = jnp.split(mod, 3, axis=-1)
        h = rms_norm(x, g_pre[l]) * (1 + scale[:, None, :]) + shift[:, None, :]

        proj = h @ w_in[l]
        (q_lat, kv_lat, k_rope, z_mla, q_mb, k_mb, v_mb, z_mb,
         merge_logits) = split_cols(proj, IN_SIZES)

        q = (rms_norm(q_lat, g_q_lat[l]) @ w_uq[l]).reshape(B, S, MLA_HEADS, MLA_NOPE_DIM + MLA_ROPE_DIM)
        q_nope, q_pe = q[..., :MLA_NOPE_DIM], q[..., MLA_NOPE_DIM:]
        kv = (rms_norm(kv_lat, g_kv_lat[l]) @ w_ukv[l]).reshape(B, S, MLA_HEADS, MLA_NOPE_DIM + MLA_V_DIM)
        k_nope, v_mla = kv[..., :MLA_NOPE_DIM], kv[..., MLA_NOPE_DIM:]
        q_pe = apply_rope(q_pe, positions)
        k_pe = apply_rope(k_rope[:, :, None, :], positions)
        q_full = jnp.concatenate([q_nope, q_pe], axis=-1)
        k_full = jnp.concatenate([k_nope, jnp.broadcast_to(k_pe, (B, S, MLA_HEADS, MLA_ROPE_DIM))], axis=-1)
        o_mla = causal_dense_attention(q_full, k_full, v_mla,
                                       (MLA_NOPE_DIM + MLA_ROPE_DIM) ** -0.5).reshape(B, S, MLA_WIDTH)
        y_mla = (o_mla * jax.nn.silu(z_mla)) @ w_o_mla[l]

        qm = apply_rope(q_mb.reshape(B, S, MOBA_HEADS, MOBA_HEAD_DIM), positions)
        km = apply_rope(k_mb.reshape(B, S, MOBA_HEADS, MOBA_HEAD_DIM), positions)
        vm = v_mb.reshape(B, S, MOBA_HEADS, MOBA_HEAD_DIM)
        o_mb = moba_attention(qm, km, vm).reshape(B, S, MOBA_WIDTH)
        y_mb = (o_mb * jax.nn.silu(z_mb)) @ w_o_moba[l]

        gates = jax.nn.sigmoid(merge_logits + b_merge[l])
        g_a, g_b = jnp.split(gates, 2, axis=-1)
        y = (g_a * y_mla + g_b * y_mb) @ w_out[l]

        x = x + gate[:, None, :] * rms_norm(y, g_post[l])
    return x
```

```cpp
#include <hip/hip_runtime.h>
#include <cstdio>
#include <cstdint>

typedef _Float16 h16;
typedef _Float16 h16x4 __attribute__((ext_vector_type(4)));

constexpr int NB = 16, SEQ = 4096, DM = 1024, M_ = NB * SEQ, NH = 8;
constexpr int D_IN = 5024;
constexpr int C_QLAT = 0, C_KVLAT = 256, C_KROPE = 384, C_ZMLA = 416, C_QMB = 928, C_KMB = 1440, C_VMB = 1952, C_ZMB = 2464, C_GA = 2976, C_GB = 4000;
constexpr float EPS = 1e-6f;
constexpr float LOG2E = 1.4426950408889634f;
constexpr float SC_MLA = 0.10206207261596577f * LOG2E;
constexpr float SC_MB = 0.125f * LOG2E;

constexpr size_t MiB = 1u << 20;
constexpr size_t WS_CTL = 0, WS_KMEAN = 512 * 1024, WS_SSQ = 1 * MiB, ZERO_BYTES = 2 * MiB;
constexpr size_t WS_MOD = 2 * MiB, WS_TAB = 4 * MiB, WS_WT = 20 * MiB;
constexpr size_t WS_H = 36 * MiB, WS_KN = 36 * MiB, WS_VM = 100 * MiB, WS_T = 36 * MiB;
constexpr size_t WS_QLAT = 164 * MiB, WS_KVL = 196 * MiB, WS_KPE = 228 * MiB, WS_ZMLA = 232 * MiB;
constexpr size_t WS_QMB = 296 * MiB, WS_KMB = 360 * MiB, WS_VMB = 424 * MiB, WS_ZMB = 488 * MiB, WS_YM = 296 * MiB;
constexpr size_t WS_GA = 552 * MiB, WS_GB = 680 * MiB, WS_Y = 552 * MiB, WS_QMLA = 808 * MiB, WS_END = 904 * MiB;

struct Params {
    const float *x, *c; const int* pos; const float *w_ada, *b_ada, *g_pre, *g_post, *w_in, *g_q, *w_uq, *g_kv, *w_ukv, *w_o_mla, *w_o_moba, *b_merge, *w_out;
    float* out; unsigned char* ws;
};

__device__ __forceinline__ float wave_sum(float v) {
#pragma unroll
    for (int o = 1; o < 64; o <<= 1) v += __shfl_xor(v, o);
    return v;
}
__device__ __forceinline__ float silu_f(float v) { return v / (1.f + __expf(-v)); }
__device__ __forceinline__ float sigmoid_f(float v) { return 1.f / (1.f + __expf(-v)); }

__device__ void ph_prep(const Params& p, int gtid, int gsize) {
    float* mod = (float*)(p.ws + WS_MOD);
    for (int i = gtid; i < NB * 3072; i += gsize) {
        const int b = i / 3072, j = i % 3072; float s = p.b_ada[j];
        for (int k = 0; k < DM; ++k) { const float cv = p.c[b * DM + k]; s += (cv / (1.f + expf(-cv))) * p.w_ada[(size_t)k * 3072 + j]; }
        mod[i] = s;
    }
    float2* tab = (float2*)(p.ws + WS_TAB);
    for (int i = gtid; i < M_ * 32; i += gsize) {
        const int m = i >> 5, f = i & 31;
        const double inv = exp2(-(double)f * (13.287712379549449 / 32.0));
        const double a = (double)p.pos[m] * inv;
        const double k = rint(a * 0.15915494309189535);
        const double r = (a - k * 6.283185307179586) - k * 2.4492935982947064e-16;
        tab[i] = make_float2((float)cos(r), (float)sin(r));
    }
}

__device__ void ph_hnorm(const Params& p, int gwave, int nwaves, int lane) {
    const float* mod = (const float*)(p.ws + WS_MOD); h16* H = (h16*)(p.ws + WS_H);
    for (int m = gwave; m < M_; m += nwaves) {
        const int b = m >> 12; const float4* xr = (const float4*)(p.x + (size_t)m * DM);
        float4 v[4]; float ss = 0.f;
#pragma unroll
        for (int j = 0; j < 4; ++j) { v[j] = xr[lane + 64 * j]; ss += (v[j].x * v[j].x + v[j].y * v[j].y) + (v[j].z * v[j].z + v[j].w * v[j].w); }
        ss = wave_sum(ss); const float rstd = 1.f / sqrtf(ss * (1.f / DM) + EPS);
#pragma unroll
        for (int j = 0; j < 4; ++j) {
            const int col = 4 * (lane + 64 * j);
            const float4 g = *(const float4*)(p.g_pre + col), sc = *(const float4*)(mod + b * 3072 + 1024 + col), sh = *(const float4*)(mod + b * 3072 + col);
            h16x4 o; o[0] = (h16)(v[j].x * rstd * g.x * (1.f + sc.x) + sh.x); o[1] = (h16)(v[j].y * rstd * g.y * (1.f + sc.y) + sh.y);
            o[2] = (h16)(v[j].z * rstd * g.z * (1.f + sc.z) + sh.z); o[3] = (h16)(v[j].w * rstd * g.w * (1.f + sc.w) + sh.w);
            *(h16x4*)(H + (size_t)m * DM + col) = o;
        }
    }
}

template <typename AT, class Epi>
__device__ void gemm_naive(const AT* A, int lda, const float* W, int ldw, const float* kscale, int K, int Nv, const Epi& e, float* lds, int vb, int nvb) {
    float (*As)[132] = (float (*)[132])lds; float (*Bs)[132] = (float (*)[132])(lds + 16 * 132);
    const int tid = threadIdx.x, tx = tid & 31, ty = tid >> 5;
    const int ntn = (Nv + 127) / 128, ntiles = (M_ / 128) * ntn;
    for (int tile = vb; tile < ntiles; tile += nvb) {
        const int m0 = (tile / ntn) * 128, n0 = (tile % ntn) * 128;
        float acc[8][4];
#pragma unroll
        for (int i = 0; i < 8; ++i)
#pragma unroll
            for (int j = 0; j < 4; ++j) acc[i][j] = 0.f;
        for (int k0 = 0; k0 < K; k0 += 16) {
#pragma unroll
            for (int i = 0; i < 4; ++i) { const int idx = tid + i * 512, mm = idx >> 4, kk = idx & 15; float a = (float)A[(size_t)(m0 + mm) * lda + k0 + kk]; if (kscale) a *= kscale[k0 + kk]; As[kk][mm] = a; }
#pragma unroll
            for (int i = 0; i < 4; ++i) { const int idx = tid + i * 512, kk = idx >> 7, nn = idx & 127, j = n0 + nn; Bs[kk][nn] = (j < Nv) ? W[(size_t)(k0 + kk) * ldw + e.col(j)] : 0.f; }
            __syncthreads();
#pragma unroll
            for (int kk = 0; kk < 16; ++kk) {
                float a[8], b[4];
#pragma unroll
                for (int i = 0; i < 8; ++i) a[i] = As[kk][ty * 8 + i];
#pragma unroll
                for (int j = 0; j < 4; ++j) b[j] = Bs[kk][tx * 4 + j];
#pragma unroll
                for (int i = 0; i < 8; ++i)
#pragma unroll
                    for (int j = 0; j < 4; ++j) acc[i][j] = fmaf(a[i], b[j], acc[i][j]);
            }
            __syncthreads();
        }
        const int j0 = n0 + tx * 4;
        if (j0 < Nv) {
#pragma unroll
            for (int i = 0; i < 8; ++i) e.store(m0 + ty * 8 + i, j0, acc[i]);
        }
    }
}

struct EpiIn {
    unsigned char* ws; const float* b_merge;
    __device__ int col(int j) const {
        if (j >= C_KROPE && j < C_ZMLA) { const int w = j - C_KROPE; return C_KROPE + (w >> 1) + 16 * (w & 1); }
        if (j >= C_QMB && j < C_VMB) { const int w = (j - C_QMB) & 63, base = j - w; return base + (w >> 1) + 32 * (w & 1); }
        return j;
    }
    __device__ void store(int m, int j0, const float (&v)[4]) const {
        const float2* tab = (const float2*)(ws + WS_TAB) + (size_t)m * 32;
        if (j0 < C_KVLAT) {
            h16x4 o; o[0] = (h16)v[0]; o[1] = (h16)v[1]; o[2] = (h16)v[2]; o[3] = (h16)v[3];
            *(h16x4*)((h16*)(ws + WS_QLAT) + (size_t)m * 256 + j0) = o;
            atomicAdd((float*)(ws + WS_SSQ) + m, (v[0] * v[0] + v[1] * v[1]) + (v[2] * v[2] + v[3] * v[3]));
        } else if (j0 < C_KROPE) {
            h16x4 o; o[0] = (h16)v[0]; o[1] = (h16)v[1]; o[2] = (h16)v[2]; o[3] = (h16)v[3];
            *(h16x4*)((h16*)(ws + WS_KVL) + (size_t)m * 256 + (j0 - C_KVLAT)) = o;
            atomicAdd((float*)(ws + WS_SSQ) + M_ + m, (v[0] * v[0] + v[1] * v[1]) + (v[2] * v[2] + v[3] * v[3]));
        } else if (j0 < C_ZMLA) {
            const int i = (j0 - C_KROPE) >> 1; h16* kpe = (h16*)(ws + WS_KPE) + (size_t)m * 32; h16* kvl = (h16*)(ws + WS_KVL) + (size_t)m * 256;
#pragma unroll
            for (int q = 0; q < 2; ++q) { const float2 cs = tab[2 * (i + q)]; const float t1 = v[2 * q], t2 = v[2 * q + 1];
                kpe[i + q] = (h16)(t1 * cs.x - t2 * cs.y); kpe[i + q + 16] = (h16)(t2 * cs.x + t1 * cs.y);
                kvl[128 + i + q] = (h16)t1; kvl[128 + 16 + i + q] = (h16)t2; }
            const int z0 = 160 + (j0 - C_KROPE) * 3;
#pragma unroll
            for (int q = 0; q < 12; ++q) kvl[z0 + q] = (h16)0.f;
        } else if (j0 < C_QMB) {
            h16x4 o; o[0] = (h16)silu_f(v[0]); o[1] = (h16)silu_f(v[1]); o[2] = (h16)silu_f(v[2]); o[3] = (h16)silu_f(v[3]);
            *(h16x4*)((h16*)(ws + WS_ZMLA) + (size_t)m * 512 + (j0 - C_ZMLA)) = o;
        } else if (j0 < C_VMB) {
            const bool isq = j0 < C_KMB; const int w0 = j0 - (isq ? C_QMB : C_KMB), hh = w0 >> 6, i = (w0 & 63) >> 1;
            h16* dst = (h16*)(ws + (isq ? WS_QMB : WS_KMB)) + (size_t)m * 512 + hh * 64; const float sc = isq ? SC_MB : 1.f;
#pragma unroll
            for (int q = 0; q < 2; ++q) { const float2 cs = tab[i + q]; const float t1 = v[2 * q], t2 = v[2 * q + 1];
                dst[i + q] = (h16)((t1 * cs.x - t2 * cs.y) * sc); dst[i + q + 32] = (h16)((t2 * cs.x + t1 * cs.y) * sc); }
        } else if (j0 < C_ZMB) {
            h16x4 o; o[0] = (h16)v[0]; o[1] = (h16)v[1]; o[2] = (h16)v[2]; o[3] = (h16)v[3];
            *(h16x4*)((h16*)(ws + WS_VMB) + (size_t)m * 512 + (j0 - C_VMB)) = o;
        } else if (j0 < C_GA) {
            h16x4 o; o[0] = (h16)silu_f(v[0]); o[1] = (h16)silu_f(v[1]); o[2] = (h16)silu_f(v[2]); o[3] = (h16)silu_f(v[3]);
            *(h16x4*)((h16*)(ws + WS_ZMB) + (size_t)m * 512 + (j0 - C_ZMB)) = o;
        } else {
            const bool isa = j0 < C_GB; const int n = j0 - (isa ? C_GA : C_GB); const float* bm = b_merge + (isa ? 0 : 1024) + n;
            h16x4 o; o[0] = (h16)sigmoid_f(v[0] + bm[0]); o[1] = (h16)sigmoid_f(v[1] + bm[1]); o[2] = (h16)sigmoid_f(v[2] + bm[2]); o[3] = (h16)sigmoid_f(v[3] + bm[3]);
            *(h16x4*)((h16*)(ws + (isa ? WS_GA : WS_GB)) + (size_t)m * 1024 + n) = o;
        }
    }
};
struct EpiUq {
    unsigned char* ws;
    __device__ int col(int j) const { const int w = j % 96; if (w < 64) return j; const int u = w - 64; return j - w + 64 + (u >> 1) + 16 * (u & 1); }
    __device__ void store(int m, int j0, const float (&v)[4]) const {
        const float rstd = 1.f / sqrtf(((const float*)(ws + WS_SSQ))[m] * (1.f / 256.f) + EPS);
        const int hh = j0 / 96, w = j0 % 96; h16* dst = (h16*)(ws + WS_QMLA) + (size_t)m * 768 + hh * 96;
        if (w < 64) { h16x4 o; o[0] = (h16)(v[0] * rstd * SC_MLA); o[1] = (h16)(v[1] * rstd * SC_MLA); o[2] = (h16)(v[2] * rstd * SC_MLA); o[3] = (h16)(v[3] * rstd * SC_MLA); *(h16x4*)(dst + w) = o; }
        else { const float2* tab = (const float2*)(ws + WS_TAB) + (size_t)m * 32; const int i = (w - 64) >> 1;
#pragma unroll
            for (int q = 0; q < 2; ++q) { const float2 cs = tab[2 * (i + q)]; const float t1 = v[2 * q] * rstd * SC_MLA, t2 = v[2 * q + 1] * rstd * SC_MLA;
                dst[64 + i + q] = (h16)(t1 * cs.x - t2 * cs.y); dst[80 + i + q] = (h16)(t2 * cs.x + t1 * cs.y); } }
    }
};
struct EpiUkv {
    unsigned char* ws;
    __device__ int col(int j) const { return j; }
    __device__ void store(int m, int j0, const float (&v)[4]) const {
        const float rstd = 1.f / sqrtf(((const float*)(ws + WS_SSQ))[M_ + m] * (1.f / 128.f) + EPS);
        const int hh = j0 >> 7, w = j0 & 127; h16* dst = (h16*)(ws + (w < 64 ? WS_KN : WS_VM)) + (size_t)m * 512 + hh * 64 + (w & 63);
        h16x4 o; o[0] = (h16)(v[0] * rstd); o[1] = (h16)(v[1] * rstd); o[2] = (h16)(v[2] * rstd); o[3] = (h16)(v[3] * rstd); *(h16x4*)dst = o;
    }
};
struct EpiYa {
    unsigned char* ws;
    __device__ int col(int j) const { return j; }
    __device__ void store(int m, int j0, const float (&v)[4]) const {
        const h16x4 g = *(const h16x4*)((const h16*)(ws + WS_GA) + (size_t)m * 1024 + j0);
        h16x4 o; o[0] = (h16)(v[0] * (float)g[0]); o[1] = (h16)(v[1] * (float)g[1]); o[2] = (h16)(v[2] * (float)g[2]); o[3] = (h16)(v[3] * (float)g[3]);
        *(h16x4*)((h16*)(ws + WS_T) + (size_t)m * 1024 + j0) = o;
    }
};
struct EpiYb {
    unsigned char* ws;
    __device__ int col(int j) const { return j; }
    __device__ void store(int m, int j0, const float (&v)[4]) const {
        const h16x4 g = *(const h16x4*)((const h16*)(ws + WS_GB) + (size_t)m * 1024 + j0), t = *(const h16x4*)((const h16*)(ws + WS_T) + (size_t)m * 1024 + j0);
        h16x4 o; o[0] = (h16)((float)t[0] + v[0] * (float)g[0]); o[1] = (h16)((float)t[1] + v[1] * (float)g[1]); o[2] = (h16)((float)t[2] + v[2] * (float)g[2]); o[3] = (h16)((float)t[3] + v[3] * (float)g[3]);
        *(h16x4*)((h16*)(ws + WS_YM) + (size_t)m * 1024 + j0) = o;
    }
};
struct EpiY {
    unsigned char* ws;
    __device__ int col(int j) const { return j; }
    __device__ void store(int m, int j0, const float (&v)[4]) const { *(float4*)((float*)(ws + WS_Y) + (size_t)m * 1024 + j0) = make_float4(v[0], v[1], v[2], v[3]); }
};

__device__ void ph_kmean(const Params& p, int gtid, int gsize) {
    const h16* KMB = (const h16*)(p.ws + WS_KMB); float* km = (float*)(p.ws + WS_KMEAN);
    for (int i = gtid; i < NB * 16 * 512; i += gsize) {
        const int c = i & 511, n = (i >> 9) & 15, b = i >> 13; float s = 0.f;
        for (int r = 0; r < 256; ++r) s += (float)KMB[((size_t)b * SEQ + n * 256 + r) * 512 + c];
        km[i] = s * (1.f / 256.f);
    }
}

__device__ void ph_attn_mla_naive(const Params& p, int vb, int nvb) {
    const h16* Q = (const h16*)(p.ws + WS_QMLA); const h16* KN = (const h16*)(p.ws + WS_KN); const h16* KPE = (const h16*)(p.ws + WS_KPE); const h16* VM = (const h16*)(p.ws + WS_VM);
    h16* Z = (h16*)(p.ws + WS_ZMLA);
    for (int item = vb; item < NB * NH * 8; item += nvb) {
        const int ch = item & 7, h = (item >> 3) & 7, b = item >> 6;
        const int t = ch * 512 + threadIdx.x; const size_t m = (size_t)b * SEQ + t;
        float q[96], o[64];
#pragma unroll
        for (int d = 0; d < 96; ++d) q[d] = (float)Q[m * 768 + h * 96 + d];
#pragma unroll
        for (int d = 0; d < 64; ++d) o[d] = 0.f;
        float mx = -1e30f, l = 0.f;
        const int tmax = ch * 512 + (threadIdx.x | 63);
        for (int j = 0; j <= tmax; ++j) {
            const size_t mj = (size_t)b * SEQ + j; const h16* kn = KN + mj * 512 + h * 64; const h16* kp = KPE + mj * 32; const h16* vv = VM + mj * 512 + h * 64;
            float s = 0.f;
#pragma unroll
            for (int d = 0; d < 64; ++d) s = fmaf(q[d], (float)kn[d], s);
#pragma unroll
            for (int d = 0; d < 32; ++d) s = fmaf(q[64 + d], (float)kp[d], s);
            if (j <= t) {
                const float mn = fmaxf(mx, s), a = exp2f(mx - mn), pj = exp2f(s - mn); l = l * a + pj; mx = mn;
#pragma unroll
                for (int d = 0; d < 64; ++d) o[d] = fmaf(o[d], a, pj * (float)vv[d]);
            }
        }
        const float rl = 1.f / l;
#pragma unroll
        for (int d = 0; d < 64; ++d) { h16* zp = Z + m * 512 + h * 64 + d; *zp = (h16)(o[d] * rl * (float)*zp); }
    }
}

__device__ void ph_attn_moba_naive(const Params& p, int vb, int nvb) {
    const h16* Q = (const h16*)(p.ws + WS_QMB); const h16* KB = (const h16*)(p.ws + WS_KMB); const h16* VB = (const h16*)(p.ws + WS_VMB); const float* km = (const float*)(p.ws + WS_KMEAN);
    h16* Z = (h16*)(p.ws + WS_ZMB);
    for (int item = vb; item < NB * NH * 8; item += nvb) {
        const int ch = item & 7, h = (item >> 3) & 7, b = item >> 6;
        const int t = ch * 512 + threadIdx.x; const size_t m = (size_t)b * SEQ + t; const int own = t >> 8;
        float q[64], o[64];
#pragma unroll
        for (int d = 0; d < 64; ++d) { q[d] = (float)Q[m * 512 + h * 64 + d]; o[d] = 0.f; }
        unsigned sel = 0u;
        {
            float g0 = -INFINITY, g1 = -INFINITY, g2 = -INFINITY; int i0 = -1, i1 = -1, i2 = -1;
            for (int n = 0; n < own; ++n) {
                const float* kmp = km + ((size_t)(b * 16 + n)) * 512 + h * 64; float g = 0.f;
#pragma unroll
                for (int d = 0; d < 64; ++d) g = fmaf(q[d], kmp[d], g);
                if (g > g0) { g2 = g1; i2 = i1; g1 = g0; i1 = i0; g0 = g; i0 = n; }
                else if (g > g1) { g2 = g1; i2 = i1; g1 = g; i1 = n; }
                else if (g > g2) { g2 = g; i2 = n; }
            }
            if (i0 >= 0) sel |= 1u << i0; if (i1 >= 0) sel |= 1u << i1; if (i2 >= 0) sel |= 1u << i2;
        }
        float mx = -1e30f, l = 0.f;
        const int own_w = own;
        for (int n = 0; n <= own_w; ++n) {
            const bool isown = (n == own_w); const bool mine = isown || ((sel >> n) & 1u);
            if (!__any(mine)) continue;
            const int jend = isown ? ((t | 63) & 255) : 255;
            for (int jj = 0; jj <= jend; ++jj) {
                const int j = n * 256 + jj; const size_t mj = (size_t)b * SEQ + j; const h16* kk = KB + mj * 512 + h * 64; const h16* vv = VB + mj * 512 + h * 64;
                float s = 0.f;
#pragma unroll
                for (int d = 0; d < 64; ++d) s = fmaf(q[d], (float)kk[d], s);
                if (mine && j <= t) {
                    const float mn = fmaxf(mx, s), a = exp2f(mx - mn), pj = exp2f(s - mn); l = l * a + pj; mx = mn;
#pragma unroll
                    for (int d = 0; d < 64; ++d) o[d] = fmaf(o[d], a, pj * (float)vv[d]);
                }
            }
        }
        const float rl = 1.f / l;
#pragma unroll
        for (int d = 0; d < 64; ++d) { h16* zp = Z + m * 512 + h * 64 + d; *zp = (h16)(o[d] * rl * (float)*zp); }
    }
}

__device__ void ph_final(const Params& p, int gwave, int nwaves, int lane) {
    const float* mod = (const float*)(p.ws + WS_MOD); const float* Y = (const float*)(p.ws + WS_Y);
    for (int m = gwave; m < M_; m += nwaves) {
        const int b = m >> 12; const float4* yr = (const float4*)(Y + (size_t)m * DM); const float4* xr = (const float4*)(p.x + (size_t)m * DM); float4* orow = (float4*)(p.out + (size_t)m * DM);
        float4 v[4]; float ss = 0.f;
#pragma unroll
        for (int j = 0; j < 4; ++j) { v[j] = yr[lane + 64 * j]; ss += (v[j].x * v[j].x + v[j].y * v[j].y) + (v[j].z * v[j].z + v[j].w * v[j].w); }
        ss = wave_sum(ss); const float rstd = 1.f / sqrtf(ss * (1.f / DM) + EPS);
#pragma unroll
        for (int j = 0; j < 4; ++j) {
            const int col = 4 * (lane + 64 * j);
            const float4 g = *(const float4*)(p.g_post + col), gt = *(const float4*)(mod + b * 3072 + 2048 + col), xv = xr[lane + 64 * j];
            orow[lane + 64 * j] = make_float4(xv.x + gt.x * v[j].x * rstd * g.x, xv.y + gt.y * v[j].y * rstd * g.y, xv.z + gt.z * v[j].z * rstd * g.z, xv.w + gt.w * v[j].w * rstd * g.w);
        }
    }
}

template <int PH> __global__ void __launch_bounds__(512, 2) k_ph(Params p) {
    extern __shared__ __attribute__((aligned(16))) unsigned char lds[];
    const int vb = blockIdx.x, nvb = gridDim.x, tid = threadIdx.x, lane = tid & 63, wave = tid >> 6;
    const int gtid = vb * 512 + tid, gsize = nvb * 512, gwave = vb * 8 + wave, nwaves = nvb * 8;
    if (PH == 0) ph_prep(p, gtid, gsize);
    if (PH == 1) ph_hnorm(p, gwave, nwaves, lane);
    if (PH == 2) { EpiIn e{p.ws, p.b_merge}; gemm_naive<h16, EpiIn>((const h16*)(p.ws + WS_H), DM, p.w_in, D_IN, nullptr, DM, D_IN, e, (float*)lds, vb, nvb); }
    if (PH == 3) { EpiUq e{p.ws}; gemm_naive<h16, EpiUq>((const h16*)(p.ws + WS_QLAT), 256, p.w_uq, 768, p.g_q, 256, 768, e, (float*)lds, vb, nvb); }
    if (PH == 4) { EpiUkv e{p.ws}; gemm_naive<h16, EpiUkv>((const h16*)(p.ws + WS_KVL), 256, p.w_ukv, 1024, p.g_kv, 128, 1024, e, (float*)lds, vb, nvb); }
    if (PH == 5) ph_kmean(p, gtid, gsize);
    if (PH == 6) ph_attn_mla_naive(p, vb, nvb);
    if (PH == 7) ph_attn_moba_naive(p, vb, nvb);
    if (PH == 8) { EpiYa e{p.ws}; gemm_naive<h16, EpiYa>((const h16*)(p.ws + WS_ZMLA), 512, p.w_o_mla, 1024, nullptr, 512, 1024, e, (float*)lds, vb, nvb); }
    if (PH == 9) { EpiYb e{p.ws}; gemm_naive<h16, EpiYb>((const h16*)(p.ws + WS_ZMB), 512, p.w_o_moba, 1024, nullptr, 512, 1024, e, (float*)lds, vb, nvb); }
    if (PH == 10) { EpiY e{p.ws}; gemm_naive<h16, EpiY>((const h16*)(p.ws + WS_YM), 1024, p.w_out, 1024, nullptr, 1024, 1024, e, (float*)lds, vb, nvb); }
    if (PH == 11) ph_final(p, gwave, nwaves, lane);
}

extern "C" void kernel_launch(void* const* d_in, const int* in_sizes, int n_in, void* d_out, int out_size, void* d_ws, size_t ws_size, hipStream_t stream) {
    if (n_in != 16 || out_size != M_ * DM || ws_size < WS_END) { fprintf(stderr, "kernel_launch: unexpected shapes (n_in %d, out %d, ws %zu)\n", n_in, out_size, ws_size); return; }
    Params p{};
    p.x = (const float*)d_in[0]; p.c = (const float*)d_in[1]; p.pos = (const int*)d_in[2]; p.w_ada = (const float*)d_in[3]; p.b_ada = (const float*)d_in[4];
    p.g_pre = (const float*)d_in[5]; p.g_post = (const float*)d_in[6]; p.w_in = (const float*)d_in[7]; p.g_q = (const float*)d_in[8]; p.w_uq = (const float*)d_in[9];
    p.g_kv = (const float*)d_in[10]; p.w_ukv = (const float*)d_in[11]; p.w_o_mla = (const float*)d_in[12]; p.w_o_moba = (const float*)d_in[13]; p.b_merge = (const float*)d_in[14]; p.w_out = (const float*)d_in[15];
    p.out = (float*)d_out; p.ws = (unsigned char*)d_ws;
    hipMemsetAsync(d_ws, 0, ZERO_BYTES, stream);
    const int G = 1024, L = 32768;
    hipLaunchKernelGGL(k_ph<0>, dim3(G), dim3(512), L, stream, p);
    hipLaunchKernelGGL(k_ph<1>, dim3(G), dim3(512), L, stream, p);
    hipLaunchKernelGGL(k_ph<2>, dim3(G), dim3(512), L, stream, p);
    hipLaunchKernelGGL(k_ph<3>, dim3(G), dim3(512), L, stream, p);
    hipLaunchKernelGGL(k_ph<4>, dim3(G), dim3(512), L, stream, p);
    hipLaunchKernelGGL(k_ph<5>, dim3(G), dim3(512), L, stream, p);
    hipLaunchKernelGGL(k_ph<6>, dim3(G), dim3(512), L, stream, p);
    hipLaunchKernelGGL(k_ph<7>, dim3(G), dim3(512), L, stream, p);
    hipLaunchKernelGGL(k_ph<8>, dim3(G), dim3(512), L, stream, p);
    hipLaunchKernelGGL(k_ph<9>, dim3(G), dim3(512), L, stream, p);
    hipLaunchKernelGGL(k_ph<10>, dim3(G), dim3(512), L, stream, p);
    hipLaunchKernelGGL(k_ph<11>, dim3(G), dim3(512), L, stream, p);
}
```

```cpp
#include <hip/hip_runtime.h>
#include <cstdio>
#include <cstdint>

typedef _Float16 h16;
typedef _Float16 h16x4 __attribute__((ext_vector_type(4)));

constexpr int NB = 16, SEQ = 4096, DM = 1024, M_ = NB * SEQ, NH = 8;
constexpr int D_IN = 5024;
constexpr int C_QLAT = 0, C_KVLAT = 256, C_KROPE = 384, C_ZMLA = 416, C_QMB = 928, C_KMB = 1440, C_VMB = 1952, C_ZMB = 2464, C_GA = 2976, C_GB = 4000;
constexpr float EPS = 1e-6f;
constexpr float LOG2E = 1.4426950408889634f;
constexpr float SC_MLA = 0.10206207261596577f * LOG2E;
constexpr float SC_MB = 0.125f * LOG2E;

constexpr size_t MiB = 1u << 20;
constexpr size_t WS_CTL = 0, WS_KMEAN = 512 * 1024, WS_SSQ = 1 * MiB, ZERO_BYTES = 2 * MiB;
constexpr size_t WS_MOD = 2 * MiB, WS_TAB = 4 * MiB, WS_WT = 20 * MiB;
constexpr size_t WS_H = 36 * MiB, WS_KN = 36 * MiB, WS_VM = 100 * MiB, WS_T = 36 * MiB;
constexpr size_t WS_QLAT = 164 * MiB, WS_KVL = 196 * MiB, WS_KPE = 228 * MiB, WS_ZMLA = 232 * MiB;
constexpr size_t WS_QMB = 296 * MiB, WS_KMB = 360 * MiB, WS_VMB = 424 * MiB, WS_ZMB = 488 * MiB, WS_YM = 296 * MiB;
constexpr size_t WS_GA = 552 * MiB, WS_GB = 680 * MiB, WS_Y = 552 * MiB, WS_QMLA = 808 * MiB, WS_END = 904 * MiB;

struct Params {
    const float *x, *c; const int* pos; const float *w_ada, *b_ada, *g_pre, *g_post, *w_in, *g_q, *w_uq, *g_kv, *w_ukv, *w_o_mla, *w_o_moba, *b_merge, *w_out;
    float* out; unsigned char* ws;
};

__device__ __forceinline__ float wave_sum(float v) {
#pragma unroll
    for (int o = 1; o < 64; o <<= 1) v += __shfl_xor(v, o);
    return v;
}
__device__ __forceinline__ float silu_f(float v) { return v / (1.f + __expf(-v)); }
__device__ __forceinline__ float sigmoid_f(float v) { return 1.f / (1.f + __expf(-v)); }

__device__ void ph_prep(const Params& p, int gtid, int gsize) {
    float* mod = (float*)(p.ws + WS_MOD);
    for (int i = gtid; i < NB * 3072; i += gsize) {
        const int b = i / 3072, j = i % 3072; float s = p.b_ada[j];
        for (int k = 0; k < DM; ++k) { const float cv = p.c[b * DM + k]; s += (cv / (1.f + expf(-cv))) * p.w_ada[(size_t)k * 3072 + j]; }
        mod[i] = s;
    }
    float2* tab = (float2*)(p.ws + WS_TAB);
    for (int i = gtid; i < M_ * 32; i += gsize) {
        const int m = i >> 5, f = i & 31;
        const double inv = exp2(-(double)f * (13.287712379549449 / 32.0));
        const double a = (double)p.pos[m] * inv;
        const double k = rint(a * 0.15915494309189535);
        const double r = (a - k * 6.283185307179586) - k * 2.4492935982947064e-16;
        tab[i] = make_float2((float)cos(r), (float)sin(r));
    }
}

__device__ void ph_hnorm(const Params& p, int gwave, int nwaves, int lane) {
    const float* mod = (const float*)(p.ws + WS_MOD); h16* H = (h16*)(p.ws + WS_H);
    for (int m = gwave; m < M_; m += nwaves) {
        const int b = m >> 12; const float4* xr = (const float4*)(p.x + (size_t)m * DM);
        float4 v[4]; float ss = 0.f;
#pragma unroll
        for (int j = 0; j < 4; ++j) { v[j] = xr[lane + 64 * j]; ss += (v[j].x * v[j].x + v[j].y * v[j].y) + (v[j].z * v[j].z + v[j].w * v[j].w); }
        ss = wave_sum(ss); const float rstd = 1.f / sqrtf(ss * (1.f / DM) + EPS);
#pragma unroll
        for (int j = 0; j < 4; ++j) {
            const int col = 4 * (lane + 64 * j);
            const float4 g = *(const float4*)(p.g_pre + col), sc = *(const float4*)(mod + b * 3072 + 1024 + col), sh = *(const float4*)(mod + b * 3072 + col);
            h16x4 o; o[0] = (h16)(v[j].x * rstd * g.x * (1.f + sc.x) + sh.x); o[1] = (h16)(v[j].y * rstd * g.y * (1.f + sc.y) + sh.y);
            o[2] = (h16)(v[j].z * rstd * g.z * (1.f + sc.z) + sh.z); o[3] = (h16)(v[j].w * rstd * g.w * (1.f + sc.w) + sh.w);
            *(h16x4*)(H + (size_t)m * DM + col) = o;
        }
    }
}

template <typename AT, class Epi>
__device__ void gemm_naive(const AT* A, int lda, const float* W, int ldw, const float* kscale, int K, int Nv, const Epi& e, float* lds, int vb, int nvb) {
    float (*As)[132] = (float (*)[132])lds; float (*Bs)[132] = (float (*)[132])(lds + 16 * 132);
    const int tid = threadIdx.x, tx = tid & 31, ty = tid >> 5;
    const int ntn = (Nv + 127) / 128, ntiles = (M_ / 128) * ntn;
    for (int tile = vb; tile < ntiles; tile += nvb) {
        const int m0 = (tile / ntn) * 128, n0 = (tile % ntn) * 128;
        float acc[8][4];
#pragma unroll
        for (int i = 0; i < 8; ++i)
#pragma unroll
            for (int j = 0; j < 4; ++j) acc[i][j] = 0.f;
        for (int k0 = 0; k0 < K; k0 += 16) {
#pragma unroll
            for (int i = 0; i < 4; ++i) { const int idx = tid + i * 512, mm = idx >> 4, kk = idx & 15; float a = (float)A[(size_t)(m0 + mm) * lda + k0 + kk]; if (kscale) a *= kscale[k0 + kk]; As[kk][mm] = a; }
#pragma unroll
            for (int i = 0; i < 4; ++i) { const int idx = tid + i * 512, kk = idx >> 7, nn = idx & 127, j = n0 + nn; Bs[kk][nn] = (j < Nv) ? W[(size_t)(k0 + kk) * ldw + e.col(j)] : 0.f; }
            __syncthreads();
#pragma unroll
            for (int kk = 0; kk < 16; ++kk) {
                float a[8], b[4];
#pragma unroll
                for (int i = 0; i < 8; ++i) a[i] = As[kk][ty * 8 + i];
#pragma unroll
                for (int j = 0; j < 4; ++j) b[j] = Bs[kk][tx * 4 + j];
#pragma unroll
                for (int i = 0; i < 8; ++i)
#pragma unroll
                    for (int j = 0; j < 4; ++j) acc[i][j] = fmaf(a[i], b[j], acc[i][j]);
            }
            __syncthreads();
        }
        const int j0 = n0 + tx * 4;
        if (j0 < Nv) {
#pragma unroll
            for (int i = 0; i < 8; ++i) e.store(m0 + ty * 8 + i, j0, acc[i]);
        }
    }
}

struct EpiIn {
    unsigned char* ws; const float* b_merge;
    __device__ int col(int j) const {
        if (j >= C_KROPE && j < C_ZMLA) { const int w = j - C_KROPE; return C_KROPE + (w >> 1) + 16 * (w & 1); }
        if (j >= C_QMB && j < C_VMB) { const int w = (j - C_QMB) & 63, base = j - w; return base + (w >> 1) + 32 * (w & 1); }
        return j;
    }
    __device__ void store(int m, int j0, const float (&v)[4]) const {
        const float2* tab = (const float2*)(ws + WS_TAB) + (size_t)m * 32;
        if (j0 < C_KVLAT) {
            h16x4 o; o[0] = (h16)v[0]; o[1] = (h16)v[1]; o[2] = (h16)v[2]; o[3] = (h16)v[3];
            *(h16x4*)((h16*)(ws + WS_QLAT) + (size_t)m * 256 + j0) = o;
            atomicAdd((float*)(ws + WS_SSQ) + m, (v[0] * v[0] + v[1] * v[1]) + (v[2] * v[2] + v[3] * v[3]));
        } else if (j0 < C_KROPE) {
            h16x4 o; o[0] = (h16)v[0]; o[1] = (h16)v[1]; o[2] = (h16)v[2]; o[3] = (h16)v[3];
            *(h16x4*)((h16*)(ws + WS_KVL) + (size_t)m * 256 + (j0 - C_KVLAT)) = o;
            atomicAdd((float*)(ws + WS_SSQ) + M_ + m, (v[0] * v[0] + v[1] * v[1]) + (v[2] * v[2] + v[3] * v[3]));
        } else if (j0 < C_ZMLA) {
            const int i = (j0 - C_KROPE) >> 1; h16* kpe = (h16*)(ws + WS_KPE) + (size_t)m * 32; h16* kvl = (h16*)(ws + WS_KVL) + (size_t)m * 256;
#pragma unroll
            for (int q = 0; q < 2; ++q) { const float2 cs = tab[2 * (i + q)]; const float t1 = v[2 * q], t2 = v[2 * q + 1];
                kpe[i + q] = (h16)(t1 * cs.x - t2 * cs.y); kpe[i + q + 16] = (h16)(t2 * cs.x + t1 * cs.y);
                kvl[128 + i + q] = (h16)t1; kvl[128 + 16 + i + q] = (h16)t2; }
            const int z0 = 160 + (j0 - C_KROPE) * 3;
#pragma unroll
            for (int q = 0; q < 12; ++q) kvl[z0 + q] = (h16)0.f;
        } else if (j0 < C_QMB) {
            h16x4 o; o[0] = (h16)silu_f(v[0]); o[1] = (h16)silu_f(v[1]); o[2] = (h16)silu_f(v[2]); o[3] = (h16)silu_f(v[3]);
            *(h16x4*)((h16*)(ws + WS_ZMLA) + (size_t)m * 512 + (j0 - C_ZMLA)) = o;
        } else if (j0 < C_VMB) {
            const bool isq = j0 < C_KMB; const int w0 = j0 - (isq ? C_QMB : C_KMB), hh = w0 >> 6, i = (w0 & 63) >> 1;
            h16* dst = (h16*)(ws + (isq ? WS_QMB : WS_KMB)) + (size_t)m * 512 + hh * 64; const float sc = isq ? SC_MB : 1.f;
#pragma unroll
            for (int q = 0; q < 2; ++q) { const float2 cs = tab[i + q]; const float t1 = v[2 * q], t2 = v[2 * q + 1];
                dst[i + q] = (h16)((t1 * cs.x - t2 * cs.y) * sc); dst[i + q + 32] = (h16)((t2 * cs.x + t1 * cs.y) * sc); }
        } else if (j0 < C_ZMB) {
            h16x4 o; o[0] = (h16)v[0]; o[1] = (h16)v[1]; o[2] = (h16)v[2]; o[3] = (h16)v[3];
            *(h16x4*)((h16*)(ws + WS_VMB) + (size_t)m * 512 + (j0 - C_VMB)) = o;
        } else if (j0 < C_GA) {
            h16x4 o; o[0] = (h16)silu_f(v[0]); o[1] = (h16)silu_f(v[1]); o[2] = (h16)silu_f(v[2]); o[3] = (h16)silu_f(v[3]);
            *(h16x4*)((h16*)(ws + WS_ZMB) + (size_t)m * 512 + (j0 - C_ZMB)) = o;
        } else {
            const bool isa = j0 < C_GB; const int n = j0 - (isa ? C_GA : C_GB); const float* bm = b_merge + (isa ? 0 : 1024) + n;
            h16x4 o; o[0] = (h16)sigmoid_f(v[0] + bm[0]); o[1] = (h16)sigmoid_f(v[1] + bm[1]); o[2] = (h16)sigmoid_f(v[2] + bm[2]); o[3] = (h16)sigmoid_f(v[3] + bm[3]);
            *(h16x4*)((h16*)(ws + (isa ? WS_GA : WS_GB)) + (size_t)m * 1024 + n) = o;
        }
    }
};
struct EpiUq {
    unsigned char* ws;
    __device__ int col(int j) const { const int w = j % 96; if (w < 64) return j; const int u = w - 64; return j - w + 64 + (u >> 1) + 16 * (u & 1); }
    __device__ void store(int m, int j0, const float (&v)[4]) const {
        const float rstd = 1.f / sqrtf(((const float*)(ws + WS_SSQ))[m] * (1.f / 256.f) + EPS);
        const int hh = j0 / 96, w = j0 % 96; h16* dst = (h16*)(ws + WS_QMLA) + (size_t)m * 768 + hh * 96;
        if (w < 64) { h16x4 o; o[0] = (h16)(v[0] * rstd * SC_MLA); o[1] = (h16)(v[1] * rstd * SC_MLA); o[2] = (h16)(v[2] * rstd * SC_MLA); o[3] = (h16)(v[3] * rstd * SC_MLA); *(h16x4*)(dst + w) = o; }
        else { const float2* tab = (const float2*)(ws + WS_TAB) + (size_t)m * 32; const int i = (w - 64) >> 1;
#pragma unroll
            for (int q = 0; q < 2; ++q) { const float2 cs = tab[2 * (i + q)]; const float t1 = v[2 * q] * rstd * SC_MLA, t2 = v[2 * q + 1] * rstd * SC_MLA;
                dst[64 + i + q] = (h16)(t1 * cs.x - t2 * cs.y); dst[80 + i + q] = (h16)(t2 * cs.x + t1 * cs.y); } }
    }
};
struct EpiUkv {
    unsigned char* ws;
    __device__ int col(int j) const { return j; }
    __device__ void store(int m, int j0, const float (&v)[4]) const {
        const float rstd = 1.f / sqrtf(((const float*)(ws + WS_SSQ))[M_ + m] * (1.f / 128.f) + EPS);
        const int hh = j0 >> 7, w = j0 & 127; h16* dst = (h16*)(ws + (w < 64 ? WS_KN : WS_VM)) + (size_t)m * 512 + hh * 64 + (w & 63);
        h16x4 o; o[0] = (h16)(v[0] * rstd); o[1] = (h16)(v[1] * rstd); o[2] = (h16)(v[2] * rstd); o[3] = (h16)(v[3] * rstd); *(h16x4*)dst = o;
    }
};
struct EpiYa {
    unsigned char* ws;
    __device__ int col(int j) const { return j; }
    __device__ void store(int m, int j0, const float (&v)[4]) const {
        const h16x4 g = *(const h16x4*)((const h16*)(ws + WS_GA) + (size_t)m * 1024 + j0);
        h16x4 o; o[0] = (h16)(v[0] * (float)g[0]); o[1] = (h16)(v[1] * (float)g[1]); o[2] = (h16)(v[2] * (float)g[2]); o[3] = (h16)(v[3] * (float)g[3]);
        *(h16x4*)((h16*)(ws + WS_T) + (size_t)m * 1024 + j0) = o;
    }
};
struct EpiYb {
    unsigned char* ws;
    __device__ int col(int j) const { return j; }
    __device__ void store(int m, int j0, const float (&v)[4]) const {
        const h16x4 g = *(const h16x4*)((const h16*)(ws + WS_GB) + (size_t)m * 1024 + j0), t = *(const h16x4*)((const h16*)(ws + WS_T) + (size_t)m * 1024 + j0);
        h16x4 o; o[0] = (h16)((float)t[0] + v[0] * (float)g[0]); o[1] = (h16)((float)t[1] + v[1] * (float)g[1]); o[2] = (h16)((float)t[2] + v[2] * (float)g[2]); o[3] = (h16)((float)t[3] + v[3] * (float)g[3]);
        *(h16x4*)((h16*)(ws + WS_YM) + (size_t)m * 1024 + j0) = o;
    }
};
struct EpiY {
    unsigned char* ws;
    __device__ int col(int j) const { return j; }
    __device__ void store(int m, int j0, const float (&v)[4]) const { *(float4*)((float*)(ws + WS_Y) + (size_t)m * 1024 + j0) = make_float4(v[0], v[1], v[2], v[3]); }
};

__device__ void ph_kmean(const Params& p, int gtid, int gsize) {
    const h16* KMB = (const h16*)(p.ws + WS_KMB); float* km = (float*)(p.ws + WS_KMEAN);
    for (int i = gtid; i < NB * 16 * 512; i += gsize) {
        const int c = i & 511, n = (i >> 9) & 15, b = i >> 13; float s = 0.f;
        for (int r = 0; r < 256; ++r) s += (float)KMB[((size_t)b * SEQ + n * 256 + r) * 512 + c];
        km[i] = s * (1.f / 256.f);
    }
}

__device__ void ph_attn_mla_naive(const Params& p, int vb, int nvb) {
    const h16* Q = (const h16*)(p.ws + WS_QMLA); const h16* KN = (const h16*)(p.ws + WS_KN); const h16* KPE = (const h16*)(p.ws + WS_KPE); const h16* VM = (const h16*)(p.ws + WS_VM);
    h16* Z = (h16*)(p.ws + WS_ZMLA);
    for (int item = vb; item < NB * NH * 8; item += nvb) {
        const int ch = item & 7, h = (item >> 3) & 7, b = item >> 6;
        const int t = ch * 512 + threadIdx.x; const size_t m = (size_t)b * SEQ + t;
        float q[96], o[64];
#pragma unroll
        for (int d = 0; d < 96; ++d) q[d] = (float)Q[m * 768 + h * 96 + d];
#pragma unroll
        for (int d = 0; d < 64; ++d) o[d] = 0.f;
        float mx = -1e30f, l = 0.f;
        const int tmax = ch * 512 + (threadIdx.x | 63);
        for (int j = 0; j <= tmax; ++j) {
            const size_t mj = (size_t)b * SEQ + j; const h16* kn = KN + mj * 512 + h * 64; const h16* kp = KPE + mj * 32; const h16* vv = VM + mj * 512 + h * 64;
            float s = 0.f;
#pragma unroll
            for (int d = 0; d < 64; ++d) s = fmaf(q[d], (float)kn[d], s);
#pragma unroll
            for (int d = 0; d < 32; ++d) s = fmaf(q[64 + d], (float)kp[d], s);
            if (j <= t) {
                const float mn = fmaxf(mx, s), a = exp2f(mx - mn), pj = exp2f(s - mn); l = l * a + pj; mx = mn;
#pragma unroll
                for (int d = 0; d < 64; ++d) o[d] = fmaf(o[d], a, pj * (float)vv[d]);
            }
        }
        const float rl = 1.f / l;
#pragma unroll
        for (int d = 0; d < 64; ++d) { h16* zp = Z + m * 512 + h * 64 + d; *zp = (h16)(o[d] * rl * (float)*zp); }
    }
}

__device__ void ph_attn_moba_naive(const Params& p, int vb, int nvb) {
    const h16* Q = (const h16*)(p.ws + WS_QMB); const h16* KB = (const h16*)(p.ws + WS_KMB); const h16* VB = (const h16*)(p.ws + WS_VMB); const float* km = (const float*)(p.ws + WS_KMEAN);
    h16* Z = (h16*)(p.ws + WS_ZMB);
    for (int item = vb; item < NB * NH * 8; item += nvb) {
        const int ch = item & 7, h = (item >> 3) & 7, b = item >> 6;
        const int t = ch * 512 + threadIdx.x; const size_t m = (size_t)b * SEQ + t; const int own = t >> 8;
        float q[64], o[64];
#pragma unroll
        for (int d = 0; d < 64; ++d) { q[d] = (float)Q[m * 512 + h * 64 + d]; o[d] = 0.f; }
        unsigned sel = 0u;
        {
            float g0 = -INFINITY, g1 = -INFINITY, g2 = -INFINITY; int i0 = -1, i1 = -1, i2 = -1;
            for (int n = 0; n < own; ++n) {
                const float* kmp = km + ((size_t)(b * 16 + n)) * 512 + h * 64; float g = 0.f;
#pragma unroll
                for (int d = 0; d < 64; ++d) g = fmaf(q[d], kmp[d], g);
                if (g > g0) { g2 = g1; i2 = i1; g1 = g0; i1 = i0; g0 = g; i0 = n; }
                else if (g > g1) { g2 = g1; i2 = i1; g1 = g; i1 = n; }
                else if (g > g2) { g2 = g; i2 = n; }
            }
            if (i0 >= 0) sel |= 1u << i0; if (i1 >= 0) sel |= 1u << i1; if (i2 >= 0) sel |= 1u << i2;
        }
        float mx = -1e30f, l = 0.f;
        const int own_w = own;
        for (int n = 0; n <= own_w; ++n) {
            const bool isown = (n == own_w); const bool mine = isown || ((sel >> n) & 1u);
            if (!__any(mine)) continue;
            const int jend = isown ? ((t | 63) & 255) : 255;
            for (int jj = 0; jj <= jend; ++jj) {
                const int j = n * 256 + jj; const size_t mj = (size_t)b * SEQ + j; const h16* kk = KB + mj * 512 + h * 64; const h16* vv = VB + mj * 512 + h * 64;
                float s = 0.f;
#pragma unroll
                for (int d = 0; d < 64; ++d) s = fmaf(q[d], (float)kk[d], s);
                if (mine && j <= t) {
                    const float mn = fmaxf(mx, s), a = exp2f(mx - mn), pj = exp2f(s - mn); l = l * a + pj; mx = mn;
#pragma unroll
                    for (int d = 0; d < 64; ++d) o[d] = fmaf(o[d], a, pj * (float)vv[d]);
                }
            }
        }
        const float rl = 1.f / l;
#pragma unroll
        for (int d = 0; d < 64; ++d) { h16* zp = Z + m * 512 + h * 64 + d; *zp = (h16)(o[d] * rl * (float)*zp); }
    }
}

__device__ void ph_final(const Params& p, int gwave, int nwaves, int lane) {
    const float* mod = (const float*)(p.ws + WS_MOD); const float* Y = (const float*)(p.ws + WS_Y);
    for (int m = gwave; m < M_; m += nwaves) {
        const int b = m >> 12; const float4* yr = (const float4*)(Y + (size_t)m * DM); const float4* xr = (const float4*)(p.x + (size_t)m * DM); float4* orow = (float4*)(p.out + (size_t)m * DM);
        float4 v[4]; float ss = 0.f;
#pragma unroll
        for (int j = 0; j < 4; ++j) { v[j] = yr[lane + 64 * j]; ss += (v[j].x * v[j].x + v[j].y * v[j].y) + (v[j].z * v[j].z + v[j].w * v[j].w); }
        ss = wave_sum(ss); const float rstd = 1.f / sqrtf(ss * (1.f / DM) + EPS);
#pragma unroll
        for (int j = 0; j < 4; ++j) {
            const int col = 4 * (lane + 64 * j);
            const float4 g = *(const float4*)(p.g_post + col), gt = *(const float4*)(mod + b * 3072 + 2048 + col), xv = xr[lane + 64 * j];
            orow[lane + 64 * j] = make_float4(xv.x + gt.x * v[j].x * rstd * g.x, xv.y + gt.y * v[j].y * rstd * g.y, xv.z + gt.z * v[j].z * rstd * g.z, xv.w + gt.w * v[j].w * rstd * g.w);
        }
    }
}


#define XB_TMO      128
#define XB_XCNT(j)  (256  + 64 * (j))
#define XB_XSUB(j)  (1280 + 64 * (j))
#define XB_XGEN(j)  (2304 + 64 * (j))
#define XB_TOP      3328
#define XB_TOPGEN   3392
#define XCD_BAR_WORDS 3456
#define XB_SPIN_CAP (1u << 27)
#define LAS __attribute__((address_space(3)))
__device__ __forceinline__ unsigned xb_ld(unsigned* p)              { return __hip_atomic_load(p, __ATOMIC_RELAXED, __HIP_MEMORY_SCOPE_AGENT); }
__device__ __forceinline__ unsigned xb_add(unsigned* p, unsigned v) { return __hip_atomic_fetch_add(p, v, __ATOMIC_RELAXED, __HIP_MEMORY_SCOPE_AGENT); }
__device__ __forceinline__ unsigned xb_xcc_id() { return (unsigned)__builtin_amdgcn_s_getreg((3 << 11) | 20) & 0xFu; }
#define XB_SPIN(cond, bar) do { unsigned _sp = 0; while (cond) { __builtin_amdgcn_s_sleep(1); \
    if ((++_sp & 255u) == 0u) { if (xb_ld(&(bar)[XB_TMO])) break; if (_sp > XB_SPIN_CAP) { atomicAdd(&(bar)[XB_TMO], 1u); break; } } } } while (0)
struct XcdBarrier { unsigned* bar; unsigned x; volatile LAS unsigned* st; };
__device__ __forceinline__ XcdBarrier xcd_barrier_post(unsigned* bar, volatile LAS unsigned* st) {
    XcdBarrier b; b.bar = bar; b.x = xb_xcc_id(); b.st = st;
    if (threadIdx.x == 0) (void)xb_add(&bar[XB_XCNT(b.x)], 1u);
    return b;
}
__device__ __forceinline__ void xcd_barrier_complete(unsigned* bar, unsigned x, unsigned& nloc, unsigned& nx) {
    const unsigned G = gridDim.x * gridDim.y * gridDim.z;
    unsigned sum, cnt, mine, sp = 0u;
    for (;;) {
        sum = 0u; cnt = 0u; mine = 0u;
#pragma unroll
        for (unsigned j = 0; j < 16; ++j) { const unsigned c = xb_ld(&bar[XB_XCNT(j)]); sum += c; cnt += (c > 0u) ? 1u : 0u; mine = (j == x) ? c : mine; }
        if (sum == G) break;
        __builtin_amdgcn_s_sleep(1);
        if ((++sp & 255u) == 0u) { if (xb_ld(&bar[XB_TMO])) break; if (sp > XB_SPIN_CAP) { atomicAdd(&bar[XB_TMO], 1u); break; } }
    }
    nloc = mine > 0u ? mine : 1u; nx = cnt > 0u ? cnt : 1u;
}
__device__ __forceinline__ void xcd_barrier(const XcdBarrier& b) {
    asm volatile("s_waitcnt vmcnt(0)" ::: "memory");
    __syncthreads();
    if (threadIdx.x == 0) {
        unsigned* bar = b.bar;
        __builtin_amdgcn_s_waitcnt(0);
        unsigned nloc = b.st[0], nx = b.st[1];
        if (nloc == 0u) { xcd_barrier_complete(bar, b.x, nloc, nx); b.st[0] = nloc; b.st[1] = nx; }
        const unsigned old = xb_add(&bar[XB_XSUB(b.x)], 1u);
        const unsigned gen = old / nloc;
        if (old + 1u == (gen + 1u) * nloc) {
            __builtin_amdgcn_fence(__ATOMIC_RELEASE, "agent");
            asm volatile("s_waitcnt vmcnt(0)" ::: "memory");
            const unsigned og = xb_add(&bar[XB_TOP], 1u);
            const unsigned tg = og / nx;
            if (og + 1u == (tg + 1u) * nx) xb_add(&bar[XB_TOPGEN], 1u);
            else XB_SPIN(xb_ld(&bar[XB_TOPGEN]) == tg, bar);
            __builtin_amdgcn_fence(__ATOMIC_ACQUIRE, "agent");
            xb_add(&bar[XB_XGEN(b.x)], 1u);
            asm volatile("s_waitcnt vmcnt(0)" ::: "memory");
        } else {
            XB_SPIN(xb_ld(&bar[XB_XGEN(b.x)]) == gen, bar);
            __builtin_amdgcn_fence(__ATOMIC_ACQUIRE, "agent");
            asm volatile("s_waitcnt vmcnt(0)" ::: "memory");
        }
    }
    __syncthreads();
}

constexpr int RING_BYTES = 131072, MISC_OFF = RING_BYTES + 320, LDS_BYTES = 147456;
constexpr int CW_BAR = 4096;

__global__ void __launch_bounds__(512, 2) mega(Params p) {
    extern __shared__ __attribute__((aligned(16))) unsigned char lds[];
    const int vb = blockIdx.x, nvb = gridDim.x, tid = threadIdx.x, lane = tid & 63, wave = tid >> 6;
    const int gtid = vb * 512 + tid, gsize = nvb * 512, gwave = vb * 8 + wave, nwaves = nvb * 8;
    volatile LAS unsigned* misc = (volatile LAS unsigned*)((LAS unsigned char*)lds + MISC_OFF);
    if (tid < 32) misc[tid] = 0u;
    __syncthreads();
    XcdBarrier bar = xcd_barrier_post((unsigned*)(p.ws + WS_CTL) + CW_BAR, misc + 8);
    ph_prep(p, gtid, gsize);
    xcd_barrier(bar);
    ph_hnorm(p, gwave, nwaves, lane);
    xcd_barrier(bar);
    { EpiIn e{p.ws, p.b_merge}; gemm_naive<h16, EpiIn>((const h16*)(p.ws + WS_H), DM, p.w_in, D_IN, nullptr, DM, D_IN, e, (float*)lds, vb, nvb); }
    xcd_barrier(bar);
    { EpiUq e{p.ws}; gemm_naive<h16, EpiUq>((const h16*)(p.ws + WS_QLAT), 256, p.w_uq, 768, p.g_q, 256, 768, e, (float*)lds, vb, nvb); }
    { EpiUkv e{p.ws}; gemm_naive<h16, EpiUkv>((const h16*)(p.ws + WS_KVL), 256, p.w_ukv, 1024, p.g_kv, 128, 1024, e, (float*)lds, vb, nvb); }
    ph_kmean(p, gtid, gsize);
    xcd_barrier(bar);
    ph_attn_mla_naive(p, vb, nvb);
    ph_attn_moba_naive(p, vb, nvb);
    xcd_barrier(bar);
    { EpiYa e{p.ws}; gemm_naive<h16, EpiYa>((const h16*)(p.ws + WS_ZMLA), 512, p.w_o_mla, 1024, nullptr, 512, 1024, e, (float*)lds, vb, nvb); }
    { EpiYb e{p.ws}; gemm_naive<h16, EpiYb>((const h16*)(p.ws + WS_ZMB), 512, p.w_o_moba, 1024, nullptr, 512, 1024, e, (float*)lds, vb, nvb); }
    xcd_barrier(bar);
    { EpiY e{p.ws}; gemm_naive<h16, EpiY>((const h16*)(p.ws + WS_YM), 1024, p.w_out, 1024, nullptr, 1024, 1024, e, (float*)lds, vb, nvb); }
    xcd_barrier(bar);
    ph_final(p, gwave, nwaves, lane);
}

template <int PH> __global__ void __launch_bounds__(512, 2) k_ph(Params p) {
    extern __shared__ __attribute__((aligned(16))) unsigned char lds[];
    const int vb = blockIdx.x, nvb = gridDim.x, tid = threadIdx.x, lane = tid & 63, wave = tid >> 6;
    const int gtid = vb * 512 + tid, gsize = nvb * 512, gwave = vb * 8 + wave, nwaves = nvb * 8;
    if (PH == 0) ph_prep(p, gtid, gsize);
    if (PH == 1) ph_hnorm(p, gwave, nwaves, lane);
    if (PH == 2) { EpiIn e{p.ws, p.b_merge}; gemm_naive<h16, EpiIn>((const h16*)(p.ws + WS_H), DM, p.w_in, D_IN, nullptr, DM, D_IN, e, (float*)lds, vb, nvb); }
    if (PH == 3) { EpiUq e{p.ws}; gemm_naive<h16, EpiUq>((const h16*)(p.ws + WS_QLAT), 256, p.w_uq, 768, p.g_q, 256, 768, e, (float*)lds, vb, nvb); }
    if (PH == 4) { EpiUkv e{p.ws}; gemm_naive<h16, EpiUkv>((const h16*)(p.ws + WS_KVL), 256, p.w_ukv, 1024, p.g_kv, 128, 1024, e, (float*)lds, vb, nvb); }
    if (PH == 5) ph_kmean(p, gtid, gsize);
    if (PH == 6) ph_attn_mla_naive(p, vb, nvb);
    if (PH == 7) ph_attn_moba_naive(p, vb, nvb);
    if (PH == 8) { EpiYa e{p.ws}; gemm_naive<h16, EpiYa>((const h16*)(p.ws + WS_ZMLA), 512, p.w_o_mla, 1024, nullptr, 512, 1024, e, (float*)lds, vb, nvb); }
    if (PH == 9) { EpiYb e{p.ws}; gemm_naive<h16, EpiYb>((const h16*)(p.ws + WS_ZMB), 512, p.w_o_moba, 1024, nullptr, 512, 1024, e, (float*)lds, vb, nvb); }
    if (PH == 10) { EpiY e{p.ws}; gemm_naive<h16, EpiY>((const h16*)(p.ws + WS_YM), 1024, p.w_out, 1024, nullptr, 1024, 1024, e, (float*)lds, vb, nvb); }
    if (PH == 11) ph_final(p, gwave, nwaves, lane);
}

extern "C" void kernel_launch(void* const* d_in, const int* in_sizes, int n_in, void* d_out, int out_size, void* d_ws, size_t ws_size, hipStream_t stream) {
    if (n_in != 16 || out_size != M_ * DM || ws_size < WS_END) { fprintf(stderr, "kernel_launch: unexpected shapes (n_in %d, out %d, ws %zu)\n", n_in, out_size, ws_size); return; }
    Params p{};
    p.x = (const float*)d_in[0]; p.c = (const float*)d_in[1]; p.pos = (const int*)d_in[2]; p.w_ada = (const float*)d_in[3]; p.b_ada = (const float*)d_in[4];
    p.g_pre = (const float*)d_in[5]; p.g_post = (const float*)d_in[6]; p.w_in = (const float*)d_in[7]; p.g_q = (const float*)d_in[8]; p.w_uq = (const float*)d_in[9];
    p.g_kv = (const float*)d_in[10]; p.w_ukv = (const float*)d_in[11]; p.w_o_mla = (const float*)d_in[12]; p.w_o_moba = (const float*)d_in[13]; p.b_merge = (const float*)d_in[14]; p.w_out = (const float*)d_in[15];
    p.out = (float*)d_out; p.ws = (unsigned char*)d_ws;
    static int grid = 0;
    if (grid == 0) {
        int dev = 0, cus = 0, per_cu = 0;
        if (hipGetDevice(&dev) != hipSuccess || hipDeviceGetAttribute(&cus, hipDeviceAttributeMultiprocessorCount, dev) != hipSuccess) { fprintf(stderr, "kernel_launch: device query failed\n"); grid = -1; return; }
        if (hipFuncSetAttribute((const void*)mega, hipFuncAttributeMaxDynamicSharedMemorySize, LDS_BYTES) != hipSuccess) { fprintf(stderr, "kernel_launch: hipFuncSetAttribute failed\n"); grid = -1; return; }
        if (hipOccupancyMaxActiveBlocksPerMultiprocessor(&per_cu, (const void*)mega, 512, LDS_BYTES) != hipSuccess || per_cu < 1) { fprintf(stderr, "kernel_launch: occupancy query says %d\n", per_cu); }
        (void)hipGetLastError();
        grid = cus;
    }
    if (grid < 0) return;
    (void)hipMemsetAsync(d_ws, 0, ZERO_BYTES, stream);
#if defined(MULTI_LAUNCH)
    const int G = 1024, L = 32768;
    hipLaunchKernelGGL(k_ph<0>, dim3(G), dim3(512), L, stream, p);
    hipLaunchKernelGGL(k_ph<1>, dim3(G), dim3(512), L, stream, p);
    hipLaunchKernelGGL(k_ph<2>, dim3(G), dim3(512), L, stream, p);
    hipLaunchKernelGGL(k_ph<3>, dim3(G), dim3(512), L, stream, p);
    hipLaunchKernelGGL(k_ph<4>, dim3(G), dim3(512), L, stream, p);
    hipLaunchKernelGGL(k_ph<5>, dim3(G), dim3(512), L, stream, p);
    hipLaunchKernelGGL(k_ph<6>, dim3(G), dim3(512), L, stream, p);
    hipLaunchKernelGGL(k_ph<7>, dim3(G), dim3(512), L, stream, p);
    hipLaunchKernelGGL(k_ph<8>, dim3(G), dim3(512), L, stream, p);
    hipLaunchKernelGGL(k_ph<9>, dim3(G), dim3(512), L, stream, p);
    hipLaunchKernelGGL(k_ph<10>, dim3(G), dim3(512), L, stream, p);
    hipLaunchKernelGGL(k_ph<11>, dim3(G), dim3(512), L, stream, p);
#else
    hipLaunchKernelGGL(mega, dim3(grid), dim3(512), LDS_BYTES, stream, p);
#endif
}
```

```cpp
#include <hip/hip_runtime.h>
#include <cstdio>
#include <cstdint>

typedef _Float16 h16;
typedef _Float16 h16x4 __attribute__((ext_vector_type(4)));

constexpr int NB = 16, SEQ = 4096, DM = 1024, M_ = NB * SEQ, NH = 8;
constexpr int D_IN = 5024;
constexpr int C_QLAT = 0, C_KVLAT = 256, C_KROPE = 384, C_ZMLA = 416, C_QMB = 928, C_KMB = 1440, C_VMB = 1952, C_ZMB = 2464, C_GA = 2976, C_GB = 4000;
constexpr float EPS = 1e-6f;
constexpr float LOG2E = 1.4426950408889634f;
constexpr float SC_MLA = 0.10206207261596577f * LOG2E;
constexpr float SC_MB = 0.125f * LOG2E;

constexpr size_t MiB = 1u << 20;
constexpr size_t WS_CTL = 0, WS_KMEAN = 512 * 1024, WS_SSQ = 1 * MiB, ZERO_BYTES = 2 * MiB;
constexpr size_t WS_MOD = 2 * MiB, WS_TAB = 4 * MiB, WS_WT = 20 * MiB;
constexpr size_t WS_H = 36 * MiB, WS_KN = 36 * MiB, WS_VM = 100 * MiB, WS_T = 36 * MiB;
constexpr size_t WS_QLAT = 164 * MiB, WS_KVL = 196 * MiB, WS_KPE = 228 * MiB, WS_ZMLA = 232 * MiB;
constexpr size_t WS_QMB = 296 * MiB, WS_KMB = 360 * MiB, WS_VMB = 424 * MiB, WS_ZMB = 488 * MiB, WS_YM = 296 * MiB;
constexpr size_t WS_GA = 552 * MiB, WS_GB = 680 * MiB, WS_Y = 552 * MiB, WS_QMLA = 808 * MiB, WS_END = 904 * MiB;

struct Params {
    const float *x, *c; const int* pos; const float *w_ada, *b_ada, *g_pre, *g_post, *w_in, *g_q, *w_uq, *g_kv, *w_ukv, *w_o_mla, *w_o_moba, *b_merge, *w_out;
    float* out; unsigned char* ws;
};

__device__ __forceinline__ float wave_sum(float v) {
#pragma unroll
    for (int o = 1; o < 64; o <<= 1) v += __shfl_xor(v, o);
    return v;
}
__device__ __forceinline__ float silu_f(float v) { return v / (1.f + __expf(-v)); }
__device__ __forceinline__ float sigmoid_f(float v) { return 1.f / (1.f + __expf(-v)); }

__device__ void ph_prep(const Params& p, int gtid, int gsize) {
    float* mod = (float*)(p.ws + WS_MOD);
    for (int i = gtid; i < NB * 3072; i += gsize) {
        const int b = i / 3072, j = i % 3072; float s = p.b_ada[j];
        for (int k = 0; k < DM; ++k) { const float cv = p.c[b * DM + k]; s += (cv / (1.f + expf(-cv))) * p.w_ada[(size_t)k * 3072 + j]; }
        mod[i] = s;
    }
    float2* tab = (float2*)(p.ws + WS_TAB);
    for (int i = gtid; i < M_ * 32; i += gsize) {
        const int m = i >> 5, f = i & 31;
        const double inv = exp2(-(double)f * (13.287712379549449 / 32.0));
        const double a = (double)p.pos[m] * inv;
        const double k = rint(a * 0.15915494309189535);
        const double r = (a - k * 6.283185307179586) - k * 2.4492935982947064e-16;
        tab[i] = make_float2((float)cos(r), (float)sin(r));
    }
}

__device__ void ph_hnorm(const Params& p, int gwave, int nwaves, int lane) {
    const float* mod = (const float*)(p.ws + WS_MOD); h16* H = (h16*)(p.ws + WS_H);
    for (int m = gwave; m < M_; m += nwaves) {
        const int b = m >> 12; const float4* xr = (const float4*)(p.x + (size_t)m * DM);
        float4 v[4]; float ss = 0.f;
#pragma unroll
        for (int j = 0; j < 4; ++j) { v[j] = xr[lane + 64 * j]; ss += (v[j].x * v[j].x + v[j].y * v[j].y) + (v[j].z * v[j].z + v[j].w * v[j].w); }
        ss = wave_sum(ss); const float rstd = 1.f / sqrtf(ss * (1.f / DM) + EPS);
#pragma unroll
        for (int j = 0; j < 4; ++j) {
            const int col = 4 * (lane + 64 * j);
            const float4 g = *(const float4*)(p.g_pre + col), sc = *(const float4*)(mod + b * 3072 + 1024 + col), sh = *(const float4*)(mod + b * 3072 + col);
            h16x4 o; o[0] = (h16)(v[j].x * rstd * g.x * (1.f + sc.x) + sh.x); o[1] = (h16)(v[j].y * rstd * g.y * (1.f + sc.y) + sh.y);
            o[2] = (h16)(v[j].z * rstd * g.z * (1.f + sc.z) + sh.z); o[3] = (h16)(v[j].w * rstd * g.w * (1.f + sc.w) + sh.w);
            *(h16x4*)(H + (size_t)m * DM + col) = o;
        }
    }
}

template <typename AT, class Epi>
__device__ void gemm_naive(const AT* A, int lda, const float* W, int ldw, const float* kscale, int K, int Nv, const Epi& e, float* lds, int vb, int nvb) {
    float (*As)[132] = (float (*)[132])lds; float (*Bs)[132] = (float (*)[132])(lds + 16 * 132);
    const int tid = threadIdx.x, tx = tid & 31, ty = tid >> 5;
    const int ntn = (Nv + 127) / 128, ntiles = (M_ / 128) * ntn;
    for (int tile = vb; tile < ntiles; tile += nvb) {
        const int m0 = (tile / ntn) * 128, n0 = (tile % ntn) * 128;
        float acc[8][4];
#pragma unroll
        for (int i = 0; i < 8; ++i)
#pragma unroll
            for (int j = 0; j < 4; ++j) acc[i][j] = 0.f;
        for (int k0 = 0; k0 < K; k0 += 16) {
#pragma unroll
            for (int i = 0; i < 4; ++i) { const int idx = tid + i * 512, mm = idx >> 4, kk = idx & 15; float a = (float)A[(size_t)(m0 + mm) * lda + k0 + kk]; if (kscale) a *= kscale[k0 + kk]; As[kk][mm] = a; }
#pragma unroll
            for (int i = 0; i < 4; ++i) { const int idx = tid + i * 512, kk = idx >> 7, nn = idx & 127, j = n0 + nn; Bs[kk][nn] = (j < Nv) ? W[(size_t)(k0 + kk) * ldw + e.col(j)] : 0.f; }
            __syncthreads();
#pragma unroll
            for (int kk = 0; kk < 16; ++kk) {
                float a[8], b[4];
#pragma unroll
                for (int i = 0; i < 8; ++i) a[i] = As[kk][ty * 8 + i];
#pragma unroll
                for (int j = 0; j < 4; ++j) b[j] = Bs[kk][tx * 4 + j];
#pragma unroll
                for (int i = 0; i < 8; ++i)
#pragma unroll
                    for (int j = 0; j < 4; ++j) acc[i][j] = fmaf(a[i], b[j], acc[i][j]);
            }
            __syncthreads();
        }
        const int j0 = n0 + tx * 4;
        if (j0 < Nv) {
#pragma unroll
            for (int i = 0; i < 8; ++i) e.store(m0 + ty * 8 + i, j0, acc[i]);
        }
    }
}

struct EpiIn {
    unsigned char* ws; const float* b_merge;
    __device__ int col(int j) const {
        if (j >= C_KROPE && j < C_ZMLA) { const int w = j - C_KROPE; return C_KROPE + (w >> 1) + 16 * (w & 1); }
        if (j >= C_QMB && j < C_VMB) { const int w = (j - C_QMB) & 63, base = j - w; return base + (w >> 1) + 32 * (w & 1); }
        return j;
    }
    __device__ void store(int m, int j0, const float (&v)[4]) const {
        const float2* tab = (const float2*)(ws + WS_TAB) + (size_t)m * 32;
        if (j0 < C_KVLAT) {
            h16x4 o; o[0] = (h16)v[0]; o[1] = (h16)v[1]; o[2] = (h16)v[2]; o[3] = (h16)v[3];
            *(h16x4*)((h16*)(ws + WS_QLAT) + (size_t)m * 256 + j0) = o;
            atomicAdd((float*)(ws + WS_SSQ) + m, (v[0] * v[0] + v[1] * v[1]) + (v[2] * v[2] + v[3] * v[3]));
        } else if (j0 < C_KROPE) {
            h16x4 o; o[0] = (h16)v[0]; o[1] = (h16)v[1]; o[2] = (h16)v[2]; o[3] = (h16)v[3];
            *(h16x4*)((h16*)(ws + WS_KVL) + (size_t)m * 256 + (j0 - C_KVLAT)) = o;
            atomicAdd((float*)(ws + WS_SSQ) + M_ + m, (v[0] * v[0] + v[1] * v[1]) + (v[2] * v[2] + v[3] * v[3]));
        } else if (j0 < C_ZMLA) {
            const int i = (j0 - C_KROPE) >> 1; h16* kpe = (h16*)(ws + WS_KPE) + (size_t)m * 32; h16* kvl = (h16*)(ws + WS_KVL) + (size_t)m * 256;
#pragma unroll
            for (int q = 0; q < 2; ++q) { const float2 cs = tab[2 * (i + q)]; const float t1 = v[2 * q], t2 = v[2 * q + 1];
                kpe[i + q] = (h16)(t1 * cs.x - t2 * cs.y); kpe[i + q + 16] = (h16)(t2 * cs.x + t1 * cs.y);
                kvl[128 + i + q] = (h16)t1; kvl[128 + 16 + i + q] = (h16)t2; }
            const int z0 = 160 + (j0 - C_KROPE) * 3;
#pragma unroll
            for (int q = 0; q < 12; ++q) kvl[z0 + q] = (h16)0.f;
        } else if (j0 < C_QMB) {
            h16x4 o; o[0] = (h16)silu_f(v[0]); o[1] = (h16)silu_f(v[1]); o[2] = (h16)silu_f(v[2]); o[3] = (h16)silu_f(v[3]);
            *(h16x4*)((h16*)(ws + WS_ZMLA) + (size_t)m * 512 + (j0 - C_ZMLA)) = o;
        } else if (j0 < C_VMB) {
            const bool isq = j0 < C_KMB; const int w0 = j0 - (isq ? C_QMB : C_KMB), hh = w0 >> 6, i = (w0 & 63) >> 1;
            h16* dst = (h16*)(ws + (isq ? WS_QMB : WS_KMB)) + (size_t)m * 512 + hh * 64; const float sc = isq ? SC_MB : 1.f;
#pragma unroll
            for (int q = 0; q < 2; ++q) { const float2 cs = tab[i + q]; const float t1 = v[2 * q], t2 = v[2 * q + 1];
                dst[i + q] = (h16)((t1 * cs.x - t2 * cs.y) * sc); dst[i + q + 32] = (h16)((t2 * cs.x + t1 * cs.y) * sc); }
        } else if (j0 < C_ZMB) {
            h16x4 o; o[0] = (h16)v[0]; o[1] = (h16)v[1]; o[2] = (h16)v[2]; o[3] = (h16)v[3];
            *(h16x4*)((h16*)(ws + WS_VMB) + (size_t)m * 512 + (j0 - C_VMB)) = o;
        } else if (j0 < C_GA) {
            h16x4 o; o[0] = (h16)silu_f(v[0]); o[1] = (h16)silu_f(v[1]); o[2] = (h16)silu_f(v[2]); o[3] = (h16)silu_f(v[3]);
            *(h16x4*)((h16*)(ws + WS_ZMB) + (size_t)m * 512 + (j0 - C_ZMB)) = o;
        } else {
            const bool isa = j0 < C_GB; const int n = j0 - (isa ? C_GA : C_GB); const float* bm = b_merge + (isa ? 0 : 1024) + n;
            h16x4 o; o[0] = (h16)sigmoid_f(v[0] + bm[0]); o[1] = (h16)sigmoid_f(v[1] + bm[1]); o[2] = (h16)sigmoid_f(v[2] + bm[2]); o[3] = (h16)sigmoid_f(v[3] + bm[3]);
            *(h16x4*)((h16*)(ws + (isa ? WS_GA : WS_GB)) + (size_t)m * 1024 + n) = o;
        }
    }
};
struct EpiUq {
    unsigned char* ws;
    __device__ int col(int j) const { const int w = j % 96; if (w < 64) return j; const int u = w - 64; return j - w + 64 + (u >> 1) + 16 * (u & 1); }
    __device__ void store(int m, int j0, const float (&v)[4]) const {
        const float rstd = 1.f / sqrtf(((const float*)(ws + WS_SSQ))[m] * (1.f / 256.f) + EPS);
        const int hh = j0 / 96, w = j0 % 96; h16* dst = (h16*)(ws + WS_QMLA) + (size_t)m * 768 + hh * 96;
        if (w < 64) { h16x4 o; o[0] = (h16)(v[0] * rstd * SC_MLA); o[1] = (h16)(v[1] * rstd * SC_MLA); o[2] = (h16)(v[2] * rstd * SC_MLA); o[3] = (h16)(v[3] * rstd * SC_MLA); *(h16x4*)(dst + w) = o; }
        else { const float2* tab = (const float2*)(ws + WS_TAB) + (size_t)m * 32; const int i = (w - 64) >> 1;
#pragma unroll
            for (int q = 0; q < 2; ++q) { const float2 cs = tab[2 * (i + q)]; const float t1 = v[2 * q] * rstd * SC_MLA, t2 = v[2 * q + 1] * rstd * SC_MLA;
                dst[64 + i + q] = (h16)(t1 * cs.x - t2 * cs.y); dst[80 + i + q] = (h16)(t2 * cs.x + t1 * cs.y); } }
    }
};
struct EpiUkv {
    unsigned char* ws;
    __device__ int col(int j) const { return j; }
    __device__ void store(int m, int j0, const float (&v)[4]) const {
        const float rstd = 1.f / sqrtf(((const float*)(ws + WS_SSQ))[M_ + m] * (1.f / 128.f) + EPS);
        const int hh = j0 >> 7, w = j0 & 127; h16* dst = (h16*)(ws + (w < 64 ? WS_KN : WS_VM)) + (size_t)m * 512 + hh * 64 + (w & 63);
        h16x4 o; o[0] = (h16)(v[0] * rstd); o[1] = (h16)(v[1] * rstd); o[2] = (h16)(v[2] * rstd); o[3] = (h16)(v[3] * rstd); *(h16x4*)dst = o;
    }
};
struct EpiYa {
    unsigned char* ws;
    __device__ int col(int j) const { return j; }
    __device__ void store(int m, int j0, const float (&v)[4]) const {
        const h16x4 g = *(const h16x4*)((const h16*)(ws + WS_GA) + (size_t)m * 1024 + j0);
        h16x4 o; o[0] = (h16)(v[0] * (float)g[0]); o[1] = (h16)(v[1] * (float)g[1]); o[2] = (h16)(v[2] * (float)g[2]); o[3] = (h16)(v[3] * (float)g[3]);
        *(h16x4*)((h16*)(ws + WS_T) + (size_t)m * 1024 + j0) = o;
    }
};
struct EpiYb {
    unsigned char* ws;
    __device__ int col(int j) const { return j; }
    __device__ void store(int m, int j0, const float (&v)[4]) const {
        const h16x4 g = *(const h16x4*)((const h16*)(ws + WS_GB) + (size_t)m * 1024 + j0), t = *(const h16x4*)((const h16*)(ws + WS_T) + (size_t)m * 1024 + j0);
        h16x4 o; o[0] = (h16)((float)t[0] + v[0] * (float)g[0]); o[1] = (h16)((float)t[1] + v[1] * (float)g[1]); o[2] = (h16)((float)t[2] + v[2] * (float)g[2]); o[3] = (h16)((float)t[3] + v[3] * (float)g[3]);
        *(h16x4*)((h16*)(ws + WS_YM) + (size_t)m * 1024 + j0) = o;
    }
};
struct EpiY {
    unsigned char* ws;
    __device__ int col(int j) const { return j; }
    __device__ void store(int m, int j0, const float (&v)[4]) const { *(float4*)((float*)(ws + WS_Y) + (size_t)m * 1024 + j0) = make_float4(v[0], v[1], v[2], v[3]); }
};

__device__ void ph_kmean(const Params& p, int gtid, int gsize) {
    const h16* KMB = (const h16*)(p.ws + WS_KMB); float* km = (float*)(p.ws + WS_KMEAN);
    for (int i = gtid; i < NB * 16 * 512; i += gsize) {
        const int c = i & 511, n = (i >> 9) & 15, b = i >> 13; float s = 0.f;
        for (int r = 0; r < 256; ++r) s += (float)KMB[((size_t)b * SEQ + n * 256 + r) * 512 + c];
        km[i] = s * (1.f / 256.f);
    }
}

__device__ void ph_attn_mla_naive(const Params& p, int vb, int nvb) {
    const h16* Q = (const h16*)(p.ws + WS_QMLA); const h16* KN = (const h16*)(p.ws + WS_KN); const h16* KPE = (const h16*)(p.ws + WS_KPE); const h16* VM = (const h16*)(p.ws + WS_VM);
    h16* Z = (h16*)(p.ws + WS_ZMLA);
    for (int item = vb; item < NB * NH * 8; item += nvb) {
        const int ch = item & 7, h = (item >> 3) & 7, b = item >> 6;
        const int t = ch * 512 + threadIdx.x; const size_t m = (size_t)b * SEQ + t;
        float q[96], o[64];
#pragma unroll
        for (int d = 0; d < 96; ++d) q[d] = (float)Q[m * 768 + h * 96 + d];
#pragma unroll
        for (int d = 0; d < 64; ++d) o[d] = 0.f;
        float mx = -1e30f, l = 0.f;
        const int tmax = ch * 512 + (threadIdx.x | 63);
        for (int j = 0; j <= tmax; ++j) {
            const size_t mj = (size_t)b * SEQ + j; const h16* kn = KN + mj * 512 + h * 64; const h16* kp = KPE + mj * 32; const h16* vv = VM + mj * 512 + h * 64;
            float s = 0.f;
#pragma unroll
            for (int d = 0; d < 64; ++d) s = fmaf(q[d], (float)kn[d], s);
#pragma unroll
            for (int d = 0; d < 32; ++d) s = fmaf(q[64 + d], (float)kp[d], s);
            if (j <= t) {
                const float mn = fmaxf(mx, s), a = exp2f(mx - mn), pj = exp2f(s - mn); l = l * a + pj; mx = mn;
#pragma unroll
                for (int d = 0; d < 64; ++d) o[d] = fmaf(o[d], a, pj * (float)vv[d]);
            }
        }
        const float rl = 1.f / l;
#pragma unroll
        for (int d = 0; d < 64; ++d) { h16* zp = Z + m * 512 + h * 64 + d; *zp = (h16)(o[d] * rl * (float)*zp); }
    }
}

__device__ void ph_attn_moba_naive(const Params& p, int vb, int nvb) {
    const h16* Q = (const h16*)(p.ws + WS_QMB); const h16* KB = (const h16*)(p.ws + WS_KMB); const h16* VB = (const h16*)(p.ws + WS_VMB); const float* km = (const float*)(p.ws + WS_KMEAN);
    h16* Z = (h16*)(p.ws + WS_ZMB);
    for (int item = vb; item < NB * NH * 8; item += nvb) {
        const int ch = item & 7, h = (item >> 3) & 7, b = item >> 6;
        const int t = ch * 512 + threadIdx.x; const size_t m = (size_t)b * SEQ + t; const int own = t >> 8;
        float q[64], o[64];
#pragma unroll
        for (int d = 0; d < 64; ++d) { q[d] = (float)Q[m * 512 + h * 64 + d]; o[d] = 0.f; }
        unsigned sel = 0u;
        {
            float g0 = -INFINITY, g1 = -INFINITY, g2 = -INFINITY; int i0 = -1, i1 = -1, i2 = -1;
            for (int n = 0; n < own; ++n) {
                const float* kmp = km + ((size_t)(b * 16 + n)) * 512 + h * 64; float g = 0.f;
#pragma unroll
                for (int d = 0; d < 64; ++d) g = fmaf(q[d], kmp[d], g);
                if (g > g0) { g2 = g1; i2 = i1; g1 = g0; i1 = i0; g0 = g; i0 = n; }
                else if (g > g1) { g2 = g1; i2 = i1; g1 = g; i1 = n; }
                else if (g > g2) { g2 = g; i2 = n; }
            }
            if (i0 >= 0) sel |= 1u << i0; if (i1 >= 0) sel |= 1u << i1; if (i2 >= 0) sel |= 1u << i2;
        }
        float mx = -1e30f, l = 0.f;
        const int own_w = own;
        for (int n = 0; n <= own_w; ++n) {
            const bool isown = (n == own_w); const bool mine = isown || ((sel >> n) & 1u);
            if (!__any(mine)) continue;
            const int jend = isown ? ((t | 63) & 255) : 255;
            for (int jj = 0; jj <= jend; ++jj) {
                const int j = n * 256 + jj; const size_t mj = (size_t)b * SEQ + j; const h16* kk = KB + mj * 512 + h * 64; const h16* vv = VB + mj * 512 + h * 64;
                float s = 0.f;
#pragma unroll
                for (int d = 0; d < 64; ++d) s = fmaf(q[d], (float)kk[d], s);
                if (mine && j <= t) {
                    const float mn = fmaxf(mx, s), a = exp2f(mx - mn), pj = exp2f(s - mn); l = l * a + pj; mx = mn;
#pragma unroll
                    for (int d = 0; d < 64; ++d) o[d] = fmaf(o[d], a, pj * (float)vv[d]);
                }
            }
        }
        const float rl = 1.f / l;
#pragma unroll
        for (int d = 0; d < 64; ++d) { h16* zp = Z + m * 512 + h * 64 + d; *zp = (h16)(o[d] * rl * (float)*zp); }
    }
}

__device__ void ph_final(const Params& p, int gwave, int nwaves, int lane) {
    const float* mod = (const float*)(p.ws + WS_MOD); const float* Y = (const float*)(p.ws + WS_Y);
    for (int m = gwave; m < M_; m += nwaves) {
        const int b = m >> 12; const float4* yr = (const float4*)(Y + (size_t)m * DM); const float4* xr = (const float4*)(p.x + (size_t)m * DM); float4* orow = (float4*)(p.out + (size_t)m * DM);
        float4 v[4]; float ss = 0.f;
#pragma unroll
        for (int j = 0; j < 4; ++j) { v[j] = yr[lane + 64 * j]; ss += (v[j].x * v[j].x + v[j].y * v[j].y) + (v[j].z * v[j].z + v[j].w * v[j].w); }
        ss = wave_sum(ss); const float rstd = 1.f / sqrtf(ss * (1.f / DM) + EPS);
#pragma unroll
        for (int j = 0; j < 4; ++j) {
            const int col = 4 * (lane + 64 * j);
            const float4 g = *(const float4*)(p.g_post + col), gt = *(const float4*)(mod + b * 3072 + 2048 + col), xv = xr[lane + 64 * j];
            orow[lane + 64 * j] = make_float4(xv.x + gt.x * v[j].x * rstd * g.x, xv.y + gt.y * v[j].y * rstd * g.y, xv.z + gt.z * v[j].z * rstd * g.z, xv.w + gt.w * v[j].w * rstd * g.w);
        }
    }
}


#define XB_TMO      128
#define XB_XCNT(j)  (256  + 64 * (j))
#define XB_XSUB(j)  (1280 + 64 * (j))
#define XB_XGEN(j)  (2304 + 64 * (j))
#define XB_TOP      3328
#define XB_TOPGEN   3392
#define XCD_BAR_WORDS 3456
#define XB_SPIN_CAP (1u << 27)
#define LAS __attribute__((address_space(3)))
__device__ __forceinline__ unsigned xb_ld(unsigned* p)              { return __hip_atomic_load(p, __ATOMIC_RELAXED, __HIP_MEMORY_SCOPE_AGENT); }
__device__ __forceinline__ unsigned xb_add(unsigned* p, unsigned v) { return __hip_atomic_fetch_add(p, v, __ATOMIC_RELAXED, __HIP_MEMORY_SCOPE_AGENT); }
__device__ __forceinline__ unsigned xb_xcc_id() { return (unsigned)__builtin_amdgcn_s_getreg((3 << 11) | 20) & 0xFu; }
#define XB_SPIN(cond, bar) do { unsigned _sp = 0; while (cond) { __builtin_amdgcn_s_sleep(1); \
    if ((++_sp & 255u) == 0u) { if (xb_ld(&(bar)[XB_TMO])) break; if (_sp > XB_SPIN_CAP) { atomicAdd(&(bar)[XB_TMO], 1u); break; } } } } while (0)
struct XcdBarrier { unsigned* bar; unsigned x; volatile LAS unsigned* st; };
__device__ __forceinline__ XcdBarrier xcd_barrier_post(unsigned* bar, volatile LAS unsigned* st) {
    XcdBarrier b; b.bar = bar; b.x = xb_xcc_id(); b.st = st;
    if (threadIdx.x == 0) (void)xb_add(&bar[XB_XCNT(b.x)], 1u);
    return b;
}
__device__ __forceinline__ void xcd_barrier_complete(unsigned* bar, unsigned x, unsigned& nloc, unsigned& nx) {
    const unsigned G = gridDim.x * gridDim.y * gridDim.z;
    unsigned sum, cnt, mine, sp = 0u;
    for (;;) {
        sum = 0u; cnt = 0u; mine = 0u;
#pragma unroll
        for (unsigned j = 0; j < 16; ++j) { const unsigned c = xb_ld(&bar[XB_XCNT(j)]); sum += c; cnt += (c > 0u) ? 1u : 0u; mine = (j == x) ? c : mine; }
        if (sum == G) break;
        __builtin_amdgcn_s_sleep(1);
        if ((++sp & 255u) == 0u) { if (xb_ld(&bar[XB_TMO])) break; if (sp > XB_SPIN_CAP) { atomicAdd(&bar[XB_TMO], 1u); break; } }
    }
    nloc = mine > 0u ? mine : 1u; nx = cnt > 0u ? cnt : 1u;
}
__device__ __forceinline__ void xcd_barrier(const XcdBarrier& b) {
    asm volatile("s_waitcnt vmcnt(0)" ::: "memory");
    __syncthreads();
    if (threadIdx.x == 0) {
        unsigned* bar = b.bar;
        __builtin_amdgcn_s_waitcnt(0);
        unsigned nloc = b.st[0], nx = b.st[1];
        if (nloc == 0u) { xcd_barrier_complete(bar, b.x, nloc, nx); b.st[0] = nloc; b.st[1] = nx; }
        const unsigned old = xb_add(&bar[XB_XSUB(b.x)], 1u);
        const unsigned gen = old / nloc;
        if (old + 1u == (gen + 1u) * nloc) {
            __builtin_amdgcn_fence(__ATOMIC_RELEASE, "agent");
            asm volatile("s_waitcnt vmcnt(0)" ::: "memory");
            const unsigned og = xb_add(&bar[XB_TOP], 1u);
            const unsigned tg = og / nx;
            if (og + 1u == (tg + 1u) * nx) xb_add(&bar[XB_TOPGEN], 1u);
            else XB_SPIN(xb_ld(&bar[XB_TOPGEN]) == tg, bar);
            __builtin_amdgcn_fence(__ATOMIC_ACQUIRE, "agent");
            xb_add(&bar[XB_XGEN(b.x)], 1u);
            asm volatile("s_waitcnt vmcnt(0)" ::: "memory");
        } else {
            XB_SPIN(xb_ld(&bar[XB_XGEN(b.x)]) == gen, bar);
            __builtin_amdgcn_fence(__ATOMIC_ACQUIRE, "agent");
            asm volatile("s_waitcnt vmcnt(0)" ::: "memory");
        }
    }
    __syncthreads();
}

namespace pg8 {
#define PG8_LAS __attribute__((address_space(3)))
typedef unsigned short bf16_t;
typedef _Float16 bf16x8 __attribute__((ext_vector_type(8)));
typedef float f32x4 __attribute__((ext_vector_type(4)));
typedef unsigned u32x4 __attribute__((ext_vector_type(4)));
constexpr int BM = 256, BK = 64, HALF = 128, HTB = HALF * BK * 2  , STAGE_BYTES = 8 * HTB, NXCD = 8, WGM = 8;

__host__ __device__ __forceinline__ int lds_byte(int r, int c) { const int st = (r >> 4) * 2 + (c >> 5), rr = r & 15, cc = c & 31, ob = rr * 64 + cc * 2; return st * 1024 + (ob ^ (((ob >> 9) & 1) << 5)); }
__host__ __device__ __forceinline__ void stage_rc(int b, int& R, int& C) { const int st = b / 1024, sb = b % 1024, swz = sb ^ (((sb >> 9) & 1) << 5); R = (st >> 1) * 16 + swz / 64; C = (st & 1) * 32 + (swz % 64) / 2; }
__host__ __device__ __forceinline__ int perm32(int rho) { const int n = rho >> 4, i = rho & 15; return 8 * (i >> 2) + 4 * n + (i & 3); }

struct Unit { int pm, pn; };
struct Gemm { const bf16_t* A; const bf16_t* Bt; int M, N, K; };

struct StaticOrder {
    int nM, nN, nwg, G, c;
    __host__ __device__ void init(int M, int N, int G_, int c_) { nM = M / BM; nN = N / BM; nwg = nM * nN; G = G_; c = c_; }
    __host__ __device__ bool next(int i, Unit& u) const {
        const long L = (long)i * G + c; if (L >= nwg) return false;
        int wgid = (int)L; { const int q = nwg / NXCD, r = nwg % NXCD, xcd = wgid % NXCD, off = wgid / NXCD; wgid = (xcd < r ? xcd * (q + 1) : r * (q + 1) + (xcd - r) * q) + off; }
        const int nig = WGM * nN, gid = wgid / nig, fm = gid * WGM, gsz = (nM - fm) < WGM ? (nM - fm) : WGM;
        u.pm = fm + ((wgid % nig) % gsz); u.pn = (wgid % nig) / gsz; return true;
    }
    __device__ __forceinline__ void a_ready(const Unit&) const {}
    __device__ __forceinline__ void done(const Unit&) const {}
};

template <class Epi, class Sched, bool ALIGN_EPI = false, bool SP2 = false>
__device__ __forceinline__ void gemm_phase(PG8_LAS unsigned char* lds, const Gemm g, const Sched& S, const Epi& E) {
    int tid_ = threadIdx.x; asm volatile("" : "+v"(tid_));
    const int tid = tid_, wid = __builtin_amdgcn_readfirstlane(tid >> 6), lane = tid & 63, wr = wid >> 2, wc = wid & 3, fr = lane & 15, fq = lane >> 4;
    const int K = g.K, nt = K / BK;
    unsigned voffA[2], voffB[2];
#pragma unroll
    for (int i = 0; i < 2; ++i) { int R, C; stage_rc(tid * 16 + i * 8192, R, C); const int Rb = Epi::PERM ? ((R & ~31) + perm32(R & 31)) : R;
        voffA[i] = (unsigned)(R * K + C) * 2u; voffB[i] = (unsigned)(Rb * K + C) * 2u; }
    const size_t kstep = (size_t)(BK * 2);
    const size_t hstep = (size_t)HALF * K * 2;
    const size_t tstep = 2 * hstep;
    const unsigned ldsw = (unsigned)wid * 1024u;
    const int aoff = lds_byte(wr * 64 + fr, fq * 8), boff = lds_byte(wc * 32 + fr, fq * 8);
#define PG8_SA(b, h) (((b) * 2 + (h)) * HTB)
#define PG8_SB(b, h) ((4 + (b) * 2 + (h)) * HTB)
#define PG8_STAGE(bufoff, gbase, voff) do { _Pragma("unroll") for (int _i = 0; _i < 2; ++_i) \
        __builtin_amdgcn_global_load_lds((const unsigned*)((const char*)(gbase) + (voff)[_i]), (PG8_LAS unsigned*)(lds + (bufoff) + ldsw + _i * 8192), 16, 0, 0); } while (0)
#define PG8_LDA(dst, b, h) do { _Pragma("unroll") for (int m = 0; m < 4; ++m) _Pragma("unroll") for (int k = 0; k < 2; ++k) dst[m][k] = *(const PG8_LAS bf16x8*)(lds + PG8_SA(b, h) + aoff + m * 2048 + k * 1024); } while (0)
#define PG8_LDB(dst, b, h) do { _Pragma("unroll") for (int n = 0; n < 2; ++n) _Pragma("unroll") for (int k = 0; k < 2; ++k) dst[n][k] = *(const PG8_LAS bf16x8*)(lds + PG8_SB(b, h) + boff + n * 2048 + k * 1024); } while (0)
#define PG8_MMA(ai, bj, At, Bt) do { __builtin_amdgcn_s_setprio(1); _Pragma("unroll") for (int m = 0; m < 4; ++m) _Pragma("unroll") for (int n = 0; n < 2; ++n) _Pragma("unroll") for (int k = 0; k < 2; ++k) \
        acc[ai][bj][m][n] = __builtin_amdgcn_mfma_f32_16x16x32_f16(Bt[n][k], At[m][k], acc[ai][bj][m][n], 0, 0, 0); __builtin_amdgcn_s_setprio(0); } while (0)
#define PG8_WAIT_V(n) asm volatile("s_waitcnt vmcnt(" #n ")" ::: "memory")
#define PG8_WAIT_L(n) asm volatile("s_waitcnt lgkmcnt(" #n ")" ::: "memory")
#define PG8_BAR __builtin_amdgcn_s_barrier()
#define PG8_SCHED __builtin_amdgcn_sched_barrier(0)
    Unit cur, nxt; int ui = 0;
    if (!S.next(0, cur)) return;
    f32x4 acc[2][2][4][2];
#pragma unroll
    for (int a = 0; a < 2; ++a)
#pragma unroll
        for (int b = 0; b < 2; ++b)
#pragma unroll
            for (int m = 0; m < 4; ++m)
#pragma unroll
                for (int n = 0; n < 2; ++n) acc[a][b][m][n] = (f32x4){0.f, 0.f, 0.f, 0.f};
    bf16x8 At[4][2], B0[2][2], B1[2][2];
    const char* cA = (const char*)g.A + (size_t)cur.pm * tstep; const char* cB = (const char*)g.Bt + (size_t)cur.pn * tstep;
    S.a_ready(cur);
    if constexpr (SP2) {
        PG8_STAGE(PG8_SB(0, 0), cB, voffB); PG8_STAGE(PG8_SB(0, 1), cB + hstep, voffB); PG8_STAGE(PG8_SA(0, 0), cA, voffA); PG8_STAGE(PG8_SA(0, 1), cA + hstep, voffA);
        if (wr == 1) PG8_BAR;
        PG8_WAIT_V(2); PG8_BAR;
        PG8_STAGE(PG8_SB(1, 0), cB + kstep, voffB); PG8_STAGE(PG8_SA(1, 0), cA + kstep, voffA); PG8_STAGE(PG8_SB(1, 1), cB + hstep + kstep, voffB);
        PG8_WAIT_V(6); PG8_BAR;
    } else {
        PG8_STAGE(PG8_SB(0, 0), cB, voffB); PG8_STAGE(PG8_SA(0, 0), cA, voffA); PG8_STAGE(PG8_SB(0, 1), cB + hstep, voffB); PG8_STAGE(PG8_SA(0, 1), cA + hstep, voffA);
        if (wr == 1) PG8_BAR;
        PG8_WAIT_V(4); PG8_BAR;
        PG8_STAGE(PG8_SB(1, 0), cB + kstep, voffB); PG8_STAGE(PG8_SA(1, 0), cA + kstep, voffA); PG8_STAGE(PG8_SB(1, 1), cB + hstep + kstep, voffB);
        PG8_WAIT_V(6); PG8_BAR;
    }
    for (;;) {
        const bool has_next = S.next(ui + 1, nxt);
        const char* nA = has_next ? (const char*)g.A + (size_t)nxt.pm * tstep : cA; const char* nB = has_next ? (const char*)g.Bt + (size_t)nxt.pn * tstep : cB;
        for (int t = 0; t < nt; t += 2) {
            const bool last = (t == nt - 2);
            const char* a1 = cA + (size_t)(t + 1) * kstep;
            const char* a2 = last ? nA : cA + (size_t)(t + 2) * kstep; const char* b2 = last ? nB : cB + (size_t)(t + 2) * kstep;
            const char* a3 = a2 + kstep; const char* b3 = b2 + kstep;
            if (last && has_next) S.a_ready(nxt);
            if constexpr (SP2) {
            PG8_LDB(B0, 0, 0); PG8_LDB(B1, 0, 1); PG8_SCHED; PG8_LDA(At, 0, 0); PG8_STAGE(PG8_SA(1, 1), a1 + hstep, voffA);
            PG8_WAIT_V(8); PG8_WAIT_L(0); PG8_BAR; PG8_MMA(0, 0, At, B0); PG8_MMA(0, 1, At, B1); PG8_BAR; PG8_SCHED;
            PG8_LDA(At, 0, 1); PG8_STAGE(PG8_SB(0, 0), b2, voffB); PG8_STAGE(PG8_SB(0, 1), b2 + hstep, voffB); PG8_STAGE(PG8_SA(0, 0), a2, voffA);
            PG8_WAIT_V(8); PG8_WAIT_L(0); PG8_BAR; PG8_MMA(1, 0, At, B0); PG8_MMA(1, 1, At, B1); PG8_BAR; PG8_SCHED;
            PG8_LDB(B0, 1, 0); PG8_LDB(B1, 1, 1); PG8_SCHED; PG8_LDA(At, 1, 0); PG8_STAGE(PG8_SA(0, 1), a2 + hstep, voffA);
            PG8_WAIT_V(8); PG8_WAIT_L(0); PG8_BAR; PG8_MMA(0, 0, At, B0); PG8_MMA(0, 1, At, B1); PG8_BAR; PG8_SCHED;
            PG8_LDA(At, 1, 1); PG8_STAGE(PG8_SB(1, 0), b3, voffB); PG8_STAGE(PG8_SB(1, 1), b3 + hstep, voffB); PG8_STAGE(PG8_SA(1, 0), a3, voffA);
            PG8_WAIT_V(8); PG8_WAIT_L(0); PG8_BAR; PG8_MMA(1, 0, At, B0); PG8_MMA(1, 1, At, B1); PG8_BAR; PG8_SCHED;
            } else {
            PG8_LDB(B0, 0, 0); PG8_SCHED; PG8_LDA(At, 0, 0); PG8_STAGE(PG8_SA(1, 1), a1 + hstep, voffA);
            PG8_WAIT_L(8); PG8_BAR; PG8_WAIT_L(0); PG8_MMA(0, 0, At, B0); PG8_BAR; PG8_SCHED;
            PG8_LDB(B1, 0, 1); PG8_STAGE(PG8_SB(0, 0), b2, voffB);
            PG8_BAR; PG8_WAIT_L(0); PG8_MMA(0, 1, At, B1); PG8_BAR;
            PG8_LDA(At, 0, 1); PG8_STAGE(PG8_SA(0, 0), a2, voffA);
            PG8_BAR; PG8_WAIT_L(0); PG8_MMA(1, 0, At, B0); PG8_BAR; PG8_SCHED;
            PG8_STAGE(PG8_SB(0, 1), b2 + hstep, voffB);
            PG8_WAIT_V(6); PG8_BAR; PG8_MMA(1, 1, At, B1); PG8_BAR;
            PG8_LDB(B0, 1, 0); PG8_SCHED; PG8_LDA(At, 1, 0); PG8_STAGE(PG8_SA(0, 1), a2 + hstep, voffA);
            PG8_WAIT_L(8); PG8_BAR; PG8_WAIT_L(0); PG8_MMA(0, 0, At, B0); PG8_BAR; PG8_SCHED;
            PG8_LDB(B1, 1, 1); PG8_STAGE(PG8_SB(1, 0), b3, voffB);
            PG8_BAR; PG8_WAIT_L(0); PG8_MMA(0, 1, At, B1); PG8_BAR;
            PG8_LDA(At, 1, 1); PG8_STAGE(PG8_SA(1, 0), a3, voffA);
            PG8_BAR; PG8_WAIT_L(0); PG8_MMA(1, 0, At, B0); PG8_BAR; PG8_SCHED;
            PG8_STAGE(PG8_SB(1, 1), b3 + hstep, voffB);
            PG8_WAIT_V(6); PG8_BAR; PG8_MMA(1, 1, At, B1); PG8_BAR;
            }
        }
        if constexpr (ALIGN_EPI) { if (wr == 0) PG8_BAR; }
        if constexpr (!Epi::AFTER_DRAIN) { E(acc, cur, wr, wc, fr, fq); S.done(cur); }
        if (!has_next) break;
#pragma unroll
        for (int a = 0; a < 2; ++a)
#pragma unroll
            for (int b = 0; b < 2; ++b)
#pragma unroll
                for (int m = 0; m < 4; ++m)
#pragma unroll
                    for (int n = 0; n < 2; ++n) acc[a][b][m][n] = (f32x4){0.f, 0.f, 0.f, 0.f};
        cur = nxt; cA = nA; cB = nB; ++ui;
        if constexpr (ALIGN_EPI) { if (wr == 1) PG8_BAR; }
    }
    PG8_WAIT_V(0);
    if constexpr (!ALIGN_EPI) { if (wr == 0) PG8_BAR; }
    PG8_BAR;
    if constexpr (Epi::AFTER_DRAIN) { E.fused(acc, cur, wr, wc, fr, fq, lds, wid, lane); S.done(cur); }
#undef PG8_SA
#undef PG8_SB
#undef PG8_STAGE
#undef PG8_LDA
#undef PG8_LDB
#undef PG8_MMA
#undef PG8_WAIT_V
#undef PG8_WAIT_L
#undef PG8_BAR
#undef PG8_SCHED
}
typedef _Float16 h8v __attribute__((ext_vector_type(8)));
typedef _Float16 h2v __attribute__((ext_vector_type(2)));
__device__ __forceinline__ unsigned pk_h2(float lo, float hi) { h2v v; v[0] = (_Float16)lo; v[1] = (_Float16)hi; return __builtin_bit_cast(unsigned, v); }
__device__ __forceinline__ u32x4 pack8(const f32x4& a, const f32x4& b) { u32x4 w; w.x = pk_h2(a[0], a[1]); w.y = pk_h2(a[2], a[3]); w.z = pk_h2(b[0], b[1]); w.w = pk_h2(b[2], b[3]); return w; }
__device__ __forceinline__ float silu1(float v) { return v / (1.f + __expf(-v)); }
__device__ __forceinline__ float sigm1(float v) { return 1.f / (1.f + __expf(-v)); }
__device__ __forceinline__ f32x4 silu4(const f32x4& v) { return (f32x4){silu1(v[0]), silu1(v[1]), silu1(v[2]), silu1(v[3])}; }
__device__ __forceinline__ f32x4 sigm4(const f32x4& v) { return (f32x4){sigm1(v[0]), sigm1(v[1]), sigm1(v[2]), sigm1(v[3])}; }

#define PG8_OPAQUE(fr_, fq_) int frx = (fr_), fqx = (fq_); asm volatile("" : "+v"(frx), "+v"(fqx))
__device__ __forceinline__ void st16(unsigned char* base, unsigned off, const u32x4& v) { *(u32x4*)(base + off) = v; }
__device__ __forceinline__ f32x4 ld16f(const unsigned char* base, unsigned off) { return *(const f32x4*)(base + off); }
__device__ __forceinline__ float ld4f(const unsigned char* base, unsigned off) { return *(const float*)(base + off); }
__device__ __forceinline__ h8v ld16h(const unsigned char* base, unsigned off) { return *(const h8v*)(base + off); }
__device__ __forceinline__ float sumsq8(const f32x4& a, const f32x4& b) { return (a[0] * a[0] + a[1] * a[1]) + (a[2] * a[2] + a[3] * a[3]) + (b[0] * b[0] + b[1] * b[1]) + (b[2] * b[2] + b[3] * b[3]); }
__device__ __forceinline__ void rope4(const f32x4& t1, const f32x4& t2, const f32x4& csA, const f32x4& csB, f32x4& o1, f32x4& o2) {
    o1[0] = t1[0] * csA[0] - t2[0] * csA[1]; o2[0] = t2[0] * csA[0] + t1[0] * csA[1];
    o1[1] = t1[1] * csA[2] - t2[1] * csA[3]; o2[1] = t2[1] * csA[2] + t1[1] * csA[3];
    o1[2] = t1[2] * csB[0] - t2[2] * csB[1]; o2[2] = t2[2] * csB[0] + t1[2] * csB[1];
    o1[3] = t1[3] * csB[2] - t2[3] * csB[3]; o2[3] = t2[3] * csB[2] + t1[3] * csB[3];
}

struct EpiInF {
    static constexpr bool PERM = true, AFTER_DRAIN = false;
    unsigned char* ws; const float* b_merge;
    template <bool ISQ> __device__ __forceinline__ void rope_tile(const f32x4 (&acc)[2][2][4][2], const Unit& u, int wr, int wc, int frx, int fqx) const {
        const int pn = u.pn; const unsigned row0 = (unsigned)(u.pm * 256 + wr * 64) + (unsigned)frx; const float sc = ISQ ? SC_MB : 1.f;
        unsigned char* dst = ws + (ISQ ? WS_QMB : WS_KMB); const unsigned char* tab = ws + WS_TAB;
        const unsigned o0 = row0 * 1024u + (((pn & 1) ? 256u : 0u) + 64u * wc + 8u * fqx) * 2u, t0 = row0 * 256u + 64u * fqx;
        f32x4 c1[2] = {{0.f, 0.f, 0.f, 0.f}, {0.f, 0.f, 0.f, 0.f}}, c2[2] = {{0.f, 0.f, 0.f, 0.f}, {0.f, 0.f, 0.f, 0.f}};
#pragma unroll
        for (int ai = 0; ai < 2; ++ai)
#pragma unroll
            for (int m = 0; m < 4; ++m) { const unsigned ro = o0 + (unsigned)(ai * 128 + m * 16) * 1024u, to = t0 + (unsigned)(ai * 128 + m * 16) * 256u;
                f32x4 o1[2], o2[2];
#pragma unroll
                for (int n = 0; n < 2; ++n) { rope4(acc[ai][0][m][n], acc[ai][1][m][n], ld16f(tab, to + 32u * n), ld16f(tab, to + 32u * n + 16u), o1[n], o2[n]);
                    if (!ISQ) { c1[n] += o1[n]; c2[n] += o2[n]; } }
                st16(dst, ro, pack8(o1[0] * sc, o1[1] * sc)); st16(dst, ro + 64u, pack8(o2[0] * sc, o2[1] * sc));
                if (!ISQ) asm volatile("" : "+v"(c1[0]), "+v"(c1[1]), "+v"(c2[0]), "+v"(c2[1]));
                asm volatile("" ::: "memory"); }
        if (!ISQ) {
            float* km = (float*)(ws + WS_KMEAN) + (size_t)u.pm * 512 + ((pn & 1) ? 256 : 0) + 64 * wc + 8 * fqx;
#pragma unroll
            for (int n = 0; n < 2; ++n)
#pragma unroll
                for (int j = 0; j < 4; ++j) { float a = c1[n][j], b = c2[n][j];
#pragma unroll
                    for (int o = 1; o < 16; o <<= 1) { a += __shfl_xor(a, o); b += __shfl_xor(b, o); }
                    if (frx == 0) { atomicAdd(km + 4 * n + j, a * (1.f / 256.f)); atomicAdd(km + 32 + 4 * n + j, b * (1.f / 256.f)); } }
        }
    }
    __device__ __forceinline__ void operator()(const f32x4 (&acc)[2][2][4][2], const Unit& u, int wr, int wc, int fr, int fq) const {
        PG8_OPAQUE(fr, fq);
        const int pn = u.pn; const unsigned row0 = (unsigned)(u.pm * 256 + wr * 64) + (unsigned)frx, cl = 32u * wc + 8u * fqx;
        if (pn == 0) {
            unsigned char* dst = ws + WS_QLAT; float* ssq = (float*)(ws + WS_SSQ); const unsigned o0 = row0 * 512u + cl * 2u;
#pragma unroll
            for (int ai = 0; ai < 2; ++ai)
#pragma unroll
                for (int m = 0; m < 4; ++m) { const unsigned ro = o0 + (unsigned)(ai * 128 + m * 16) * 512u; float s = 0.f;
#pragma unroll
                    for (int bj = 0; bj < 2; ++bj) { s += sumsq8(acc[ai][bj][m][0], acc[ai][bj][m][1]); st16(dst, ro + bj * 256u, pack8(acc[ai][bj][m][0], acc[ai][bj][m][1])); }
                    s += __shfl_xor(s, 16); s += __shfl_xor(s, 32);
                    if (fqx == 0) atomicAdd(ssq + (row0 + ai * 128 + m * 16), s); }
        } else if (pn == 1) {
            unsigned char* kvl = ws + WS_KVL; unsigned char* kpe = ws + WS_KPE; float* ssq = (float*)(ws + WS_SSQ) + M_; const unsigned char* tab = ws + WS_TAB;
#pragma unroll
            for (int ai = 0; ai < 2; ++ai)
#pragma unroll
                for (int m = 0; m < 4; ++m) { const unsigned row = row0 + ai * 128 + m * 16;
                    if (wc < 2) { float s = 0.f;
#pragma unroll
                        for (int bj = 0; bj < 2; ++bj) { s += sumsq8(acc[ai][bj][m][0], acc[ai][bj][m][1]); st16(kvl, row * 512u + (bj * 64u + cl) * 2u, pack8(acc[ai][bj][m][0], acc[ai][bj][m][1])); }
                        s += __shfl_xor(s, 16); s += __shfl_xor(s, 32);
                        if (fqx == 0) atomicAdd(ssq + row, s);
                    } else {
                        if (wc == 2 && fqx < 2) {
                            f32x4 o1[2], o2[2];
#pragma unroll
                            for (int n = 0; n < 2; ++n) { const unsigned to = row * 256u + (unsigned)(2 * (8 * fqx + 4 * n)) * 8u;
                                const f32x4 c0 = ld16f(tab, to), c1 = ld16f(tab, to + 16u), c2 = ld16f(tab, to + 32u), c3 = ld16f(tab, to + 48u);
                                rope4(acc[ai][0][m][n], acc[ai][1][m][n], (f32x4){c0[0], c0[1], c1[0], c1[1]}, (f32x4){c2[0], c2[1], c3[0], c3[1]}, o1[n], o2[n]); }
                            st16(kpe, row * 64u + 16u * fqx, pack8(o1[0], o1[1])); st16(kpe, row * 64u + 32u + 16u * fqx, pack8(o2[0], o2[1]));
                        }
                        const u32x4 z = {0u, 0u, 0u, 0u};
                        st16(kvl, row * 512u + (128u + (cl - 64u)) * 2u, z); st16(kvl, row * 512u + (192u + (cl - 64u)) * 2u, z);
                    }
                    asm volatile("" ::: "memory"); }
        } else if (pn < 4 || (pn >= 8 && pn < 12)) {
            const bool act = (pn < 4) || (pn >= 10);
            unsigned char* dst = ws + (pn < 4 ? WS_ZMLA : (pn < 10 ? WS_VMB : WS_ZMB)); const unsigned o0 = row0 * 1024u + (((pn & 1) ? 256u : 0u) + cl) * 2u;
#pragma unroll
            for (int ai = 0; ai < 2; ++ai)
#pragma unroll
                for (int m = 0; m < 4; ++m) { const unsigned ro = o0 + (unsigned)(ai * 128 + m * 16) * 1024u;
#pragma unroll
                    for (int bj = 0; bj < 2; ++bj) { f32x4 a = acc[ai][bj][m][0], b = acc[ai][bj][m][1]; if (act) { a = silu4(a); b = silu4(b); }
                        st16(dst, ro + bj * 256u, pack8(a, b)); } }
        } else if (pn < 6) { rope_tile<true>(acc, u, wr, wc, frx, fqx);
        } else if (pn < 8) { rope_tile<false>(acc, u, wr, wc, frx, fqx);
        } else {
            const bool isa = pn < 16; unsigned char* dst = ws + (isa ? WS_GA : WS_GB); const unsigned cg = 256u * ((pn - 12) & 3) + cl;
            const unsigned char* bm = (const unsigned char*)(b_merge + (isa ? 0 : 1024)); const unsigned o0 = row0 * 2048u + cg * 2u;
            f32x4 bv[2][2];
#pragma unroll
            for (int bj = 0; bj < 2; ++bj)
#pragma unroll
                for (int n = 0; n < 2; ++n) bv[bj][n] = ld16f(bm, (cg + bj * 128u + 4u * n) * 4u);
#pragma unroll
            for (int ai = 0; ai < 2; ++ai)
#pragma unroll
                for (int m = 0; m < 4; ++m) { const unsigned ro = o0 + (unsigned)(ai * 128 + m * 16) * 2048u;
#pragma unroll
                    for (int bj = 0; bj < 2; ++bj) st16(dst, ro + bj * 256u, pack8(sigm4(acc[ai][bj][m][0] + bv[bj][0]), sigm4(acc[ai][bj][m][1] + bv[bj][1]))); }
        }
    }
};
struct EpiUqF {
    static constexpr bool PERM = true, AFTER_DRAIN = false;
    unsigned char* ws;
    __device__ __forceinline__ void operator()(const f32x4 (&acc)[2][2][4][2], const Unit& u, int wr, int wc, int fr, int fq) const {
        PG8_OPAQUE(fr, fq);
        const int pn = u.pn; const unsigned row0 = (unsigned)(u.pm * 256 + wr * 64) + (unsigned)frx; unsigned char* Q = ws + WS_QMLA; const unsigned char* ssq = ws + WS_SSQ; const unsigned char* tab = ws + WS_TAB;
#pragma unroll
        for (int ai = 0; ai < 2; ++ai)
#pragma unroll
            for (int m = 0; m < 4; ++m) { const unsigned row = row0 + ai * 128 + m * 16; const float rs = SC_MLA / sqrtf(ld4f(ssq, row * 4u) * (1.f / 256.f) + EPS);
                if (pn < 2) {
#pragma unroll
                    for (int bj = 0; bj < 2; ++bj) { const unsigned head = 4u * pn + 2u * bj + (wc >> 1), d = 32u * (wc & 1) + 8u * fqx;
                        st16(Q, row * 1536u + (96u * head + d) * 2u, pack8(acc[ai][bj][m][0] * rs, acc[ai][bj][m][1] * rs)); }
                } else { const unsigned head = 2u * wc + ((unsigned)fqx >> 1), i0 = 8u * (fqx & 1); f32x4 o1[2], o2[2];
#pragma unroll
                    for (int n = 0; n < 2; ++n) { const unsigned to = row * 256u + (2u * (i0 + 4u * n)) * 8u;
                        const f32x4 c0 = ld16f(tab, to), c1 = ld16f(tab, to + 16u), c2 = ld16f(tab, to + 32u), c3 = ld16f(tab, to + 48u);
                        rope4(acc[ai][0][m][n] * rs, acc[ai][1][m][n] * rs, (f32x4){c0[0], c0[1], c1[0], c1[1]}, (f32x4){c2[0], c2[1], c3[0], c3[1]}, o1[n], o2[n]); }
                    st16(Q, row * 1536u + (96u * head + 64u + i0) * 2u, pack8(o1[0], o1[1])); st16(Q, row * 1536u + (96u * head + 80u + i0) * 2u, pack8(o2[0], o2[1])); }
                asm volatile("" ::: "memory"); }
    }
};
struct EpiUkvF {
    static constexpr bool PERM = true, AFTER_DRAIN = false;
    unsigned char* ws;
    __device__ __forceinline__ void operator()(const f32x4 (&acc)[2][2][4][2], const Unit& u, int wr, int wc, int fr, int fq) const {
        PG8_OPAQUE(fr, fq);
        const int pn = u.pn; const unsigned row0 = (unsigned)(u.pm * 256 + wr * 64) + (unsigned)frx; unsigned char* dst = ws + (pn < 2 ? WS_KN : WS_VM); const unsigned char* ssq = ws + WS_SSQ + (size_t)M_ * 4;
#pragma unroll
        for (int ai = 0; ai < 2; ++ai)
#pragma unroll
            for (int m = 0; m < 4; ++m) { const unsigned row = row0 + ai * 128 + m * 16; const float rs = 1.f / sqrtf(ld4f(ssq, row * 4u) * (1.f / 128.f) + EPS);
#pragma unroll
                for (int bj = 0; bj < 2; ++bj) { const unsigned head = 4u * (pn & 1) + 2u * bj + (wc >> 1), d = 32u * (wc & 1) + 8u * fqx;
                    st16(dst, row * 1024u + (64u * head + d) * 2u, pack8(acc[ai][bj][m][0] * rs, acc[ai][bj][m][1] * rs)); } }
    }
};
template <int MODE> struct EpiYabF {
    static constexpr bool PERM = true, AFTER_DRAIN = false;
    unsigned char* ws;
    __device__ __forceinline__ void operator()(const f32x4 (&acc)[2][2][4][2], const Unit& u, int wr, int wc, int fr, int fq) const {
        PG8_OPAQUE(fr, fq);
        const unsigned row0 = (unsigned)(u.pm * 256 + wr * 64) + (unsigned)frx, c0 = u.pn * 256u + 32u * wc + 8u * fqx, o0 = row0 * 2048u + c0 * 2u;
        const unsigned char* G = ws + (MODE == 0 ? WS_GA : WS_GB); unsigned char* T = ws + WS_T; unsigned char* YM = ws + WS_YM;
#pragma unroll
        for (int ai = 0; ai < 2; ++ai)
#pragma unroll
            for (int m = 0; m < 4; ++m) {
#pragma unroll
                for (int bj = 0; bj < 2; ++bj) { const unsigned off = o0 + (unsigned)(ai * 128 + m * 16) * 2048u + bj * 256u; const h8v g = ld16h(G, off);
                    f32x4 a = acc[ai][bj][m][0], b = acc[ai][bj][m][1];
                    a = a * (f32x4){(float)g[0], (float)g[1], (float)g[2], (float)g[3]}; b = b * (f32x4){(float)g[4], (float)g[5], (float)g[6], (float)g[7]};
                    if (MODE == 1) { const h8v t = ld16h(T, off); a += (f32x4){(float)t[0], (float)t[1], (float)t[2], (float)t[3]}; b += (f32x4){(float)t[4], (float)t[5], (float)t[6], (float)t[7]}; }
                    st16(MODE == 0 ? T : YM, off, pack8(a, b)); }
                asm volatile("" ::: "memory"); }
    }
};
struct EpiYF {
    static constexpr bool PERM = false, AFTER_DRAIN = false;
    unsigned char* ws;
    __device__ __forceinline__ void operator()(const f32x4 (&acc)[2][2][4][2], const Unit& u, int wr, int wc, int fr, int fq) const {
        PG8_OPAQUE(fr, fq);
        const unsigned row0 = (unsigned)(u.pm * 256 + wr * 64) + (unsigned)frx, col0 = u.pn * 256u + wc * 32u + 4u * fqx, o0 = row0 * 4096u + col0 * 4u; unsigned char* Y = ws + WS_Y;
#pragma unroll
        for (int ai = 0; ai < 2; ++ai)
#pragma unroll
            for (int m = 0; m < 4; ++m) {
#pragma unroll
                for (int bj = 0; bj < 2; ++bj)
#pragma unroll
                    for (int n = 0; n < 2; ++n) *(f32x4*)(Y + (o0 + (unsigned)(ai * 128 + m * 16) * 4096u + bj * 512u + n * 64u)) = acc[ai][bj][m][n]; }
    }
};
}

struct MapIn { __device__ int operator()(int n) const { const int t = n >> 8, tc = n & 255, bj = tc >> 7, uu = tc & 127;
    if (t == 0) return n;
    if (t == 1) return uu < 64 ? C_KVLAT + 64 * bj + uu : (uu < 80 ? C_KROPE + 16 * bj + (uu - 64) : -1);
    if (t < 4) return C_ZMLA + (n - 512);
    if (t < 8) return (t < 6 ? C_QMB : C_KMB) + 256 * (t & 1) + 64 * (uu >> 5) + 32 * bj + (uu & 31);
    if (t < 10) return C_VMB + (n - 2048);
    if (t < 12) return C_ZMB + (n - 2560);
    if (t < 16) return C_GA + (n - 3072);
    return C_GB + (n - 4096); } };
struct MapUq { __device__ int operator()(int n) const { const int t = n >> 8, tc = n & 255, bj = tc >> 7, uu = tc & 127;
    if (t < 2) return 96 * (4 * t + (tc >> 6)) + (tc & 63);
    return 96 * (uu >> 4) + 64 + 16 * bj + (uu & 15); } };
struct MapUkv { __device__ int operator()(int n) const { const int t = n >> 8, tc = n & 255; return 128 * (4 * (t & 1) + (tc >> 6)) + (t < 2 ? 0 : 64) + (tc & 63); } };
struct MapId { __device__ int operator()(int n) const { return n; } };
template <class Map> __device__ __forceinline__ void wt_items(const float* W, int ldw, int Kreal, int K, int N, unsigned short* WT, const float* kscale, Map map, LAS float* scr, int gw, int ngw, int lane) {
    const int nblk = N / 32, nitems = (K / 64) * nblk;
    for (int it = gw; it < nitems; it += ngw) {
        const int kb = it / nblk, nb = it % nblk, k0 = 64 * kb, n0 = 32 * nb; const int src = map(n0 + (lane & 31));
#pragma unroll 8
        for (int i = 0; i < 32; ++i) { const int kk = 2 * i + (lane >> 5), k = k0 + kk; float v = 0.f; if (src >= 0 && k < Kreal) { v = W[(size_t)k * ldw + src]; if (kscale) v *= kscale[k]; } scr[kk * 33 + (lane & 31)] = v; }
        asm volatile("s_waitcnt lgkmcnt(0)" ::: "memory");
        const int c = lane & 7;
#pragma unroll
        for (int j = 0; j < 4; ++j) { const int n = (lane >> 3) + 8 * j; const LAS float* s = scr + (8 * c) * 33 + n;
            pg8::u32x4 o; o.x = pg8::pk_h2(s[0 * 33], s[1 * 33]); o.y = pg8::pk_h2(s[2 * 33], s[3 * 33]); o.z = pg8::pk_h2(s[4 * 33], s[5 * 33]); o.w = pg8::pk_h2(s[6 * 33], s[7 * 33]);
            *(pg8::u32x4*)(WT + (size_t)(n0 + n) * K + k0 + 8 * c) = o; }
        asm volatile("s_waitcnt lgkmcnt(0)" ::: "memory");
    }
}
constexpr size_t WT_IN = WS_WT, WT_UQ = WS_WT + 10 * MiB, WT_UKV = WT_UQ + 512 * 1024, WT_OA = WS_WT + 11 * MiB, WT_OB = WS_WT + 12 * MiB, WT_OUT = WS_WT + 13 * MiB;
__device__ __forceinline__ void ph_weights(const Params& p, LAS unsigned char* lds, int gw, int ngw, int wave, int lane) {
    LAS float* scr = (LAS float*)(lds + wave * 16384);
    wt_items(p.w_in, D_IN, 1024, 1024, 5120, (unsigned short*)(p.ws + WT_IN), nullptr, MapIn(), scr, gw, ngw, lane);
    wt_items(p.w_uq, 768, 256, 256, 768, (unsigned short*)(p.ws + WT_UQ), p.g_q, MapUq(), scr, gw, ngw, lane);
    wt_items(p.w_ukv, 1024, 128, 256, 1024, (unsigned short*)(p.ws + WT_UKV), p.g_kv, MapUkv(), scr, gw, ngw, lane);
    wt_items(p.w_o_mla, 1024, 512, 512, 1024, (unsigned short*)(p.ws + WT_OA), nullptr, MapId(), scr, gw, ngw, lane);
    wt_items(p.w_o_moba, 1024, 512, 512, 1024, (unsigned short*)(p.ws + WT_OB), nullptr, MapId(), scr, gw, ngw, lane);
    wt_items(p.w_out, 1024, 1024, 1024, 1024, (unsigned short*)(p.ws + WT_OUT), nullptr, MapId(), scr, gw, ngw, lane);
}

namespace att {
typedef _Float16 h8 __attribute__((ext_vector_type(8)));
typedef short s4 __attribute__((ext_vector_type(4)));
typedef short s8 __attribute__((ext_vector_type(8)));
typedef float f16v __attribute__((ext_vector_type(16)));
typedef unsigned u4 __attribute__((ext_vector_type(4)));
typedef short v4i16_t __attribute__((ext_vector_type(4)));
constexpr int KBUF = 16384, VBUF = 8192;
constexpr int L_K = 0, L_V = 2 * KBUF, L_WS = L_V + 2 * VBUF, L_OST = L_WS + 8 * 256, L_TB = L_OST + 8 * 4096, L_UN = L_TB + 256, L_END = L_UN + 64;
constexpr float THR = 8.f;
__device__ __forceinline__ int crow(int r, int hi) { return (r & 3) + 8 * (r >> 2) + 4 * hi; }
template <int DK> __device__ __forceinline__ int kaddr(int row, int ch) { return DK == 64 ? row * 128 + ((ch ^ ((row >> 1) & 7)) << 4) : row * 256 + ((ch ^ (row & 7)) << 4); }
__device__ __forceinline__ s4 vtr(const LAS unsigned char* p) { return __builtin_bit_cast(s4, __builtin_amdgcn_ds_read_tr16_b64_v4i16((LAS v4i16_t*)p)); }
__device__ __forceinline__ float swapmax(float m) { auto rr = __builtin_amdgcn_permlane32_swap(__float_as_uint(m), __float_as_uint(m), false, false); return fmaxf(__uint_as_float(rr[0]), __uint_as_float(rr[1])); }
__device__ __forceinline__ float swapsum(float m) { auto rr = __builtin_amdgcn_permlane32_swap(__float_as_uint(m), __float_as_uint(m), false, false); return __uint_as_float(rr[0]) + __uint_as_float(rr[1]); }
__device__ __forceinline__ unsigned pkh(float lo, float hi) { typedef _Float16 h2 __attribute__((ext_vector_type(2))); h2 v; v[0] = (_Float16)lo; v[1] = (_Float16)hi; return __builtin_bit_cast(unsigned, v); }

template <int DK, bool MOBA>
__device__ __forceinline__ void attn_unit(unsigned char* ws, int b, int h, int qb, LAS unsigned char* lds) {
    constexpr int ND = DK / 16, QP = MOBA ? 512 : 768, QH = MOBA ? 64 : 96;
    const int tid = threadIdx.x, lane = tid & 63, r32 = lane & 31, hi = lane >> 5; const int wid = __builtin_amdgcn_readfirstlane(tid >> 6);
    const _Float16* Qg = (const _Float16*)(ws + (MOBA ? WS_QMB : WS_QMLA)); const _Float16* Kg = (const _Float16*)(ws + (MOBA ? WS_KMB : WS_KN));
    const _Float16* Vg = (const _Float16*)(ws + (MOBA ? WS_VMB : WS_VM)); const _Float16* Pg = (const _Float16*)(ws + WS_KPE); _Float16* Zg = (_Float16*)(ws + (MOBA ? WS_ZMB : WS_ZMLA));
    const size_t rowbase = (size_t)b * SEQ; const int q0 = qb * 256, qw0 = q0 + wid * 32, qrow = qw0 + r32;
    LAS float* wsf = (LAS float*)(lds + L_WS) + wid * 64; LAS int* tb = (LAS int*)(lds + L_TB); LAS unsigned* un = (LAS unsigned*)(lds + L_UN);
    h8 qr[ND];
#pragma unroll
    for (int d0 = 0; d0 < ND; ++d0) qr[d0] = *(const h8*)(Qg + (rowbase + qrow) * QP + h * QH + d0 * 16 + hi * 8);
    unsigned sel = 0u, blocks = (2u << qb) - 1u;
    if (MOBA) {
        const float* km = (const float*)(ws + WS_KMEAN) + (size_t)b * 16 * 512 + h * 64 + hi * 8;
        float g0 = -INFINITY, g1 = -INFINITY, g2 = -INFINITY; int i0 = -1, i1 = -1, i2 = -1;
        for (int m = 0; m < qb; ++m) {
            float part = 0.f;
#pragma unroll
            for (int d0 = 0; d0 < 4; ++d0) { const float4 a = *(const float4*)(km + m * 512 + d0 * 16), c = *(const float4*)(km + m * 512 + d0 * 16 + 4);
                part += (float)qr[d0][0] * a.x + (float)qr[d0][1] * a.y + (float)qr[d0][2] * a.z + (float)qr[d0][3] * a.w + (float)qr[d0][4] * c.x + (float)qr[d0][5] * c.y + (float)qr[d0][6] * c.z + (float)qr[d0][7] * c.w; }
            const float g = swapsum(part);
            if (g > g0) { g2 = g1; i2 = i1; g1 = g0; i1 = i0; g0 = g; i0 = m; }
            else if (g > g1) { g2 = g1; i2 = i1; g1 = g; i1 = m; }
            else if (g > g2) { g2 = g; i2 = m; }
        }
        if (i0 >= 0) sel |= 1u << i0; if (i1 >= 0) sel |= 1u << i1; if (i2 >= 0) sel |= 1u << i2;
        unsigned uw = sel;
#pragma unroll
        for (int o = 1; o < 64; o <<= 1) uw |= (unsigned)__shfl_xor((int)uw, o);
        if (lane == 0) un[wid] = uw;
        __syncthreads();
        unsigned ua = 0u;
#pragma unroll
        for (int w = 0; w < 8; ++w) ua |= un[w];
        blocks = (unsigned)__builtin_amdgcn_readfirstlane((int)(ua | (1u << qb)));
    }
    const int NT = 4 * __builtin_popcount(blocks);
    if (tid < 64 && tid < NT) { unsigned bm = blocks; for (int k = 0; k < (tid >> 2); ++k) bm &= bm - 1u; tb[tid] = (__builtin_ctz(bm) << 8) + ((tid & 3) << 6); }
    __syncthreads();
    const int srow = tid >> 3, sch = tid & 7, prow = (tid >> 2) & 63, pch = tid & 3;
    const _Float16* kgp = Kg + (rowbase + srow) * 512 + h * 64 + sch * 8; const _Float16* vgp = Vg + (rowbase + srow) * 512 + h * 64 + sch * 8; const _Float16* pgp = Pg + (rowbase + prow) * 32 + pch * 8;
    const int kwo = kaddr<DK>(srow, sch), pwo = kaddr<DK>(prow, 8 + pch), vwo = (sch >> 2) * 4096 + srow * 64 + (sch & 3) * 16;
    h8 kreg, vreg, preg;
#define ATT_LOAD(kb) do { kreg = *(const h8*)(kgp + (size_t)(kb) * 512); vreg = *(const h8*)(vgp + (size_t)(kb) * 512); if (DK == 96 && tid < 256) preg = *(const h8*)(pgp + (size_t)(kb) * 32); } while (0)
#define ATT_WRITE(buf) do { *(LAS h8*)(lds + L_K + (buf) * KBUF + kwo) = kreg; *(LAS h8*)(lds + L_V + (buf) * VBUF + vwo) = vreg; if (DK == 96 && tid < 256) *(LAS h8*)(lds + L_K + (buf) * KBUF + pwo) = preg; } while (0)
    const int vro = ((lane >> 4) & 1) * 32 + (lane & 3) * 8 + (4 * hi + ((lane & 15) >> 2)) * 64;
    float m_reg = -1e30f, l_reg = 0.f; f16v o[2]; o[0] = f16v{}; o[1] = f16v{};
    ATT_LOAD(tb[0]); ATT_WRITE(0);
    if (NT > 1) ATT_LOAD(tb[1]);
    __syncthreads();
    for (int t = 0; t < NT; ++t) {
        const int cur = t & 1, kb = tb[t];
        if (t + 1 < NT) ATT_WRITE(cur ^ 1);
        if (t + 2 < NT) ATT_LOAD(tb[t + 2]);
        const bool ownblk = kb >= q0; const bool rowsel = MOBA ? (ownblk || ((sel >> (kb >> 8)) & 1u)) : true;
        const bool live = (kb <= qw0 + 31) && __any(rowsel);
        if (live) {
            const LAS unsigned char* kl = lds + L_K + cur * KBUF; f16v p0 = f16v{}, p1 = f16v{};
#pragma unroll
            for (int d0 = 0; d0 < ND; ++d0) { const h8 k0 = *(const LAS h8*)(kl + kaddr<DK>(r32, 2 * d0 + hi)), k1 = *(const LAS h8*)(kl + kaddr<DK>(32 + r32, 2 * d0 + hi));
                p0 = __builtin_amdgcn_mfma_f32_32x32x16_f16(k0, qr[d0], p0, 0, 0, 0); p1 = __builtin_amdgcn_mfma_f32_32x32x16_f16(k1, qr[d0], p1, 0, 0, 0); }
            if (kb + 63 > qw0) {
#pragma unroll
                for (int r = 0; r < 16; ++r) { const int kv = kb + crow(r, hi); if (kv > qrow) p0[r] = -INFINITY; if (kv + 32 > qrow) p1[r] = -INFINITY; }
            }
            float pmax = fmaxf(p0[0], p1[0]);
#pragma unroll
            for (int r = 1; r < 16; ++r) pmax = fmaxf(pmax, fmaxf(p0[r], p1[r]));
            pmax = swapmax(pmax);
            if (MOBA && !rowsel) pmax = -INFINITY;
            float alpha = 1.f, mn = m_reg;
            if (!__all(pmax - m_reg <= THR)) { mn = fmaxf(m_reg, pmax); alpha = __builtin_amdgcn_exp2f(m_reg - mn); m_reg = mn;
                if (hi == 0) wsf[r32] = alpha; asm volatile("s_waitcnt lgkmcnt(0)" ::: "memory");
#pragma unroll
                for (int r = 0; r < 16; ++r) { const float a = wsf[crow(r, hi)]; o[0][r] *= a; o[1][r] *= a; } }
            const float mne = (MOBA && !rowsel) ? INFINITY : mn;
            float ps = 0.f;
#pragma unroll
            for (int r = 0; r < 16; ++r) { p0[r] = __builtin_amdgcn_exp2f(p0[r] - mne); p1[r] = __builtin_amdgcn_exp2f(p1[r] - mne); ps += p0[r] + p1[r]; }
            l_reg = l_reg * alpha + swapsum(ps);
            u4 pw[4];
#pragma unroll
            for (int k = 0; k < 2; ++k) { pw[k] = (u4){pkh(p0[8 * k], p0[8 * k + 1]), pkh(p0[8 * k + 2], p0[8 * k + 3]), pkh(p0[8 * k + 4], p0[8 * k + 5]), pkh(p0[8 * k + 6], p0[8 * k + 7])};
                pw[2 + k] = (u4){pkh(p1[8 * k], p1[8 * k + 1]), pkh(p1[8 * k + 2], p1[8 * k + 3]), pkh(p1[8 * k + 4], p1[8 * k + 5]), pkh(p1[8 * k + 6], p1[8 * k + 7])}; }
            const LAS unsigned char* vl = lds + L_V + cur * VBUF + vro;
#pragma unroll
            for (int d0 = 0; d0 < 2; ++d0)
#pragma unroll
                for (int k = 0; k < 4; ++k) { const s4 lo = vtr(vl + d0 * 4096 + k * 1024), hh = vtr(vl + d0 * 4096 + k * 1024 + 512);
                    const s8 vv = (s8){lo[0], lo[1], lo[2], lo[3], hh[0], hh[1], hh[2], hh[3]};
                    o[d0] = __builtin_amdgcn_mfma_f32_32x32x16_f16(__builtin_bit_cast(h8, pw[k]), __builtin_bit_cast(h8, vv), o[d0], 0, 0, 0); }
        }
        __syncthreads();
    }
    if (hi == 0) wsf[32 + r32] = l_reg; asm volatile("s_waitcnt lgkmcnt(0)" ::: "memory");
    LAS _Float16* stg = (LAS _Float16*)(lds + L_OST) + wid * 2048;
#pragma unroll
    for (int r = 0; r < 16; ++r) { const int orow = crow(r, hi); const float rl = 1.f / wsf[32 + orow];
        stg[orow * 64 + r32] = (_Float16)(o[0][r] * rl); stg[orow * 64 + 32 + r32] = (_Float16)(o[1][r] * rl); }
    asm volatile("s_waitcnt lgkmcnt(0)" ::: "memory");
#pragma unroll
    for (int i = 0; i < 4; ++i) { const int row = i * 8 + (lane >> 3), ch = lane & 7; const h8 v = *(const LAS h8*)(stg + row * 64 + ch * 8);
        _Float16* zp = Zg + (rowbase + qw0 + row) * 512 + h * 64 + ch * 8; const h8 z = *(const h8*)zp; h8 ov;
#pragma unroll
        for (int j = 0; j < 8; ++j) ov[j] = (_Float16)((float)v[j] * (float)z[j]);
        *(h8*)zp = ov; }
    __syncthreads();
#undef ATT_LOAD
#undef ATT_WRITE
}

__device__ __forceinline__ void attn_phase(unsigned char* ws, LAS unsigned char* lds, int vb, int nvb) {
    const int vcu = (nvb % 8 == 0) ? (vb % 8) * (nvb / 8) + vb / 8 : vb; const int per = (1024 + nvb - 1) / nvb;
    for (int it = vcu * per; it < (vcu + 1) * per && it < 1024; ++it) {
        const int bh = it >> 3, pr = it & 7, b = bh >> 3, h = bh & 7;
        for (int uu = 0; uu < 2; ++uu) attn_unit<96, false>(ws, b, h, uu ? 15 - pr : pr, lds);
        for (int uu = 0; uu < 2; ++uu) attn_unit<64, true>(ws, b, h, uu ? 15 - pr : pr, lds);
    }
}
}

constexpr int RING_BYTES = 131072, MISC_OFF = RING_BYTES + 320, LDS_BYTES = 147456;
constexpr int CW_BAR = 4096;

__global__ void __launch_bounds__(512, 2) mega(Params p) {
    extern __shared__ __attribute__((aligned(16))) unsigned char lds[];
    const int vb = blockIdx.x, nvb = gridDim.x, tid = threadIdx.x, lane = tid & 63, wave = tid >> 6;
    const int gtid = vb * 512 + tid, gsize = nvb * 512, gwave = vb * 8 + wave, nwaves = nvb * 8;
    volatile LAS unsigned* misc = (volatile LAS unsigned*)((LAS unsigned char*)lds + MISC_OFF);
    if (tid < 32) misc[tid] = 0u;
    __syncthreads();
    XcdBarrier bar = xcd_barrier_post((unsigned*)(p.ws + WS_CTL) + CW_BAR, misc + 8);
    LAS unsigned char* ldsl = (LAS unsigned char*)lds;
    { int t_ = threadIdx.x; asm volatile("" : "+v"(t_)); ph_prep(p, vb * 512 + t_, gsize); ph_weights(p, ldsl, vb * 8 + (t_ >> 6), nwaves, t_ >> 6, t_ & 63); }
    xcd_barrier(bar);
    { int t_ = threadIdx.x; asm volatile("" : "+v"(t_)); ph_hnorm(p, vb * 8 + (t_ >> 6), nwaves, t_ & 63); }
    xcd_barrier(bar);
    {
        pg8::Gemm g{(const pg8::bf16_t*)(p.ws + WS_H), (const pg8::bf16_t*)(p.ws + WT_IN), M_, 5120, 1024}; pg8::StaticOrder S; S.init(M_, 5120, nvb, vb);
        pg8::EpiInF E{p.ws, p.b_merge}; pg8::gemm_phase<pg8::EpiInF, pg8::StaticOrder, true, true>(ldsl, g, S, E);
    }
    xcd_barrier(bar);
    {
        pg8::Gemm g{(const pg8::bf16_t*)(p.ws + WS_QLAT), (const pg8::bf16_t*)(p.ws + WT_UQ), M_, 768, 256}; pg8::StaticOrder S; S.init(M_, 768, nvb, vb);
        pg8::EpiUqF E{p.ws}; pg8::gemm_phase<pg8::EpiUqF, pg8::StaticOrder, true, true>(ldsl, g, S, E);
    }
    {
        pg8::Gemm g{(const pg8::bf16_t*)(p.ws + WS_KVL), (const pg8::bf16_t*)(p.ws + WT_UKV), M_, 1024, 256}; pg8::StaticOrder S; S.init(M_, 1024, nvb, vb);
        pg8::EpiUkvF E{p.ws}; pg8::gemm_phase<pg8::EpiUkvF, pg8::StaticOrder, true, true>(ldsl, g, S, E);
    }
    xcd_barrier(bar);
    att::attn_phase(p.ws, ldsl, vb, nvb);
    xcd_barrier(bar);
    {
        pg8::Gemm g{(const pg8::bf16_t*)(p.ws + WS_ZMLA), (const pg8::bf16_t*)(p.ws + WT_OA), M_, 1024, 512}; pg8::StaticOrder S; S.init(M_, 1024, nvb, vb);
        pg8::EpiYabF<0> E{p.ws}; pg8::gemm_phase<pg8::EpiYabF<0>, pg8::StaticOrder, true, true>(ldsl, g, S, E);
    }
    {
        pg8::Gemm g{(const pg8::bf16_t*)(p.ws + WS_ZMB), (const pg8::bf16_t*)(p.ws + WT_OB), M_, 1024, 512}; pg8::StaticOrder S; S.init(M_, 1024, nvb, vb);
        pg8::EpiYabF<1> E{p.ws}; pg8::gemm_phase<pg8::EpiYabF<1>, pg8::StaticOrder, true, true>(ldsl, g, S, E);
    }
    xcd_barrier(bar);
    {
        pg8::Gemm g{(const pg8::bf16_t*)(p.ws + WS_YM), (const pg8::bf16_t*)(p.ws + WT_OUT), M_, 1024, 1024}; pg8::StaticOrder S; S.init(M_, 1024, nvb, vb);
        pg8::EpiYF E{p.ws}; pg8::gemm_phase<pg8::EpiYF, pg8::StaticOrder, true, true>(ldsl, g, S, E);
    }
    xcd_barrier(bar);
    { int t_ = threadIdx.x; asm volatile("" : "+v"(t_)); ph_final(p, vb * 8 + (t_ >> 6), nwaves, t_ & 63); }
}

template <int PH> __global__ void __launch_bounds__(512, 2) k_ph(Params p) {
    extern __shared__ __attribute__((aligned(16))) unsigned char lds[];
    const int vb = blockIdx.x, nvb = gridDim.x, tid = threadIdx.x, lane = tid & 63, wave = tid >> 6;
    const int gtid = vb * 512 + tid, gsize = nvb * 512, gwave = vb * 8 + wave, nwaves = nvb * 8;
    if (PH == 0) ph_prep(p, gtid, gsize);
    if (PH == 1) ph_hnorm(p, gwave, nwaves, lane);
    if (PH == 2) { EpiIn e{p.ws, p.b_merge}; gemm_naive<h16, EpiIn>((const h16*)(p.ws + WS_H), DM, p.w_in, D_IN, nullptr, DM, D_IN, e, (float*)lds, vb, nvb); }
    if (PH == 3) { EpiUq e{p.ws}; gemm_naive<h16, EpiUq>((const h16*)(p.ws + WS_QLAT), 256, p.w_uq, 768, p.g_q, 256, 768, e, (float*)lds, vb, nvb); }
    if (PH == 4) { EpiUkv e{p.ws}; gemm_naive<h16, EpiUkv>((const h16*)(p.ws + WS_KVL), 256, p.w_ukv, 1024, p.g_kv, 128, 1024, e, (float*)lds, vb, nvb); }
    if (PH == 5) ph_kmean(p, gtid, gsize);
    if (PH == 6) ph_attn_mla_naive(p, vb, nvb);
    if (PH == 7) ph_attn_moba_naive(p, vb, nvb);
    if (PH == 8) { EpiYa e{p.ws}; gemm_naive<h16, EpiYa>((const h16*)(p.ws + WS_ZMLA), 512, p.w_o_mla, 1024, nullptr, 512, 1024, e, (float*)lds, vb, nvb); }
    if (PH == 9) { EpiYb e{p.ws}; gemm_naive<h16, EpiYb>((const h16*)(p.ws + WS_ZMB), 512, p.w_o_moba, 1024, nullptr, 512, 1024, e, (float*)lds, vb, nvb); }
    if (PH == 10) { EpiY e{p.ws}; gemm_naive<h16, EpiY>((const h16*)(p.ws + WS_YM), 1024, p.w_out, 1024, nullptr, 1024, 1024, e, (float*)lds, vb, nvb); }
    if (PH == 11) ph_final(p, gwave, nwaves, lane);
}

extern "C" void kernel_launch(void* const* d_in, const int* in_sizes, int n_in, void* d_out, int out_size, void* d_ws, size_t ws_size, hipStream_t stream) {
    if (n_in != 16 || out_size != M_ * DM || ws_size < WS_END) { fprintf(stderr, "kernel_launch: unexpected shapes (n_in %d, out %d, ws %zu)\n", n_in, out_size, ws_size); return; }
    Params p{};
    p.x = (const float*)d_in[0]; p.c = (const float*)d_in[1]; p.pos = (const int*)d_in[2]; p.w_ada = (const float*)d_in[3]; p.b_ada = (const float*)d_in[4];
    p.g_pre = (const float*)d_in[5]; p.g_post = (const float*)d_in[6]; p.w_in = (const float*)d_in[7]; p.g_q = (const float*)d_in[8]; p.w_uq = (const float*)d_in[9];
    p.g_kv = (const float*)d_in[10]; p.w_ukv = (const float*)d_in[11]; p.w_o_mla = (const float*)d_in[12]; p.w_o_moba = (const float*)d_in[13]; p.b_merge = (const float*)d_in[14]; p.w_out = (const float*)d_in[15];
    p.out = (float*)d_out; p.ws = (unsigned char*)d_ws;
    static int grid = 0;
    if (grid == 0) {
        int dev = 0, cus = 0, per_cu = 0;
        if (hipGetDevice(&dev) != hipSuccess || hipDeviceGetAttribute(&cus, hipDeviceAttributeMultiprocessorCount, dev) != hipSuccess) { fprintf(stderr, "kernel_launch: device query failed\n"); grid = -1; return; }
        if (hipFuncSetAttribute((const void*)mega, hipFuncAttributeMaxDynamicSharedMemorySize, LDS_BYTES) != hipSuccess) { fprintf(stderr, "kernel_launch: hipFuncSetAttribute failed\n"); grid = -1; return; }
        if (hipOccupancyMaxActiveBlocksPerMultiprocessor(&per_cu, (const void*)mega, 512, LDS_BYTES) != hipSuccess || per_cu < 1) { fprintf(stderr, "kernel_launch: occupancy query says %d\n", per_cu); }
        (void)hipGetLastError();
        grid = cus;
    }
    if (grid < 0) return;
    (void)hipMemsetAsync(d_ws, 0, ZERO_BYTES, stream);
#if defined(MULTI_LAUNCH)
    const int G = 1024, L = 32768;
    hipLaunchKernelGGL(k_ph<0>, dim3(G), dim3(512), L, stream, p);
    hipLaunchKernelGGL(k_ph<1>, dim3(G), dim3(512), L, stream, p);
    hipLaunchKernelGGL(k_ph<2>, dim3(G), dim3(512), L, stream, p);
    hipLaunchKernelGGL(k_ph<3>, dim3(G), dim3(512), L, stream, p);
    hipLaunchKernelGGL(k_ph<4>, dim3(G), dim3(512), L, stream, p);
    hipLaunchKernelGGL(k_ph<5>, dim3(G), dim3(512), L, stream, p);
    hipLaunchKernelGGL(k_ph<6>, dim3(G), dim3(512), L, stream, p);
    hipLaunchKernelGGL(k_ph<7>, dim3(G), dim3(512), L, stream, p);
    hipLaunchKernelGGL(k_ph<8>, dim3(G), dim3(512), L, stream, p);
    hipLaunchKernelGGL(k_ph<9>, dim3(G), dim3(512), L, stream, p);
    hipLaunchKernelGGL(k_ph<10>, dim3(G), dim3(512), L, stream, p);
    hipLaunchKernelGGL(k_ph<11>, dim3(G), dim3(512), L, stream, p);
#else
    hipLaunchKernelGGL(mega, dim3(grid), dim3(512), LDS_BYTES, stream, p);
#endif
}
```

```cpp
#include <hip/hip_runtime.h>
#include <cstdio>
#ifndef PROBE
#define PROBE 0
#endif
#include <cstdint>

typedef _Float16 h16;
typedef _Float16 h16x4 __attribute__((ext_vector_type(4)));
typedef _Float16 h2n __attribute__((ext_vector_type(2)));

constexpr int NB = 16, SEQ = 4096, DM = 1024, M_ = NB * SEQ, NH = 8;
constexpr int D_IN = 5024;
constexpr int C_QLAT = 0, C_KVLAT = 256, C_KROPE = 384, C_ZMLA = 416, C_QMB = 928, C_KMB = 1440, C_VMB = 1952, C_ZMB = 2464, C_GA = 2976, C_GB = 4000;
constexpr float EPS = 1e-6f;
constexpr float LOG2E = 1.4426950408889634f;
constexpr float SC_MLA = 0.10206207261596577f * LOG2E;
constexpr float SC_MB = 0.125f * LOG2E;

constexpr size_t MiB = 1u << 20;
constexpr size_t WS_CTL = 0, WS_KMEAN = 512 * 1024, WS_SSQ = 1 * MiB, ZERO_BYTES = 2 * MiB;
constexpr size_t WS_MOD = 2 * MiB, WS_TAB = 4 * MiB, WS_WT = 20 * MiB;
constexpr size_t WS_H = 36 * MiB, WS_KN = 36 * MiB, WS_VM = 100 * MiB, WS_T = 36 * MiB;
constexpr size_t WS_QLAT = 164 * MiB, WS_KVL = 196 * MiB, WS_KPE = 228 * MiB, WS_ZMLA = 232 * MiB;
constexpr size_t WS_QMB = 296 * MiB, WS_KMB = 360 * MiB, WS_VMB = 424 * MiB, WS_ZMB = 488 * MiB, WS_YM = 296 * MiB;
constexpr size_t WS_GA = 552 * MiB, WS_GB = 680 * MiB, WS_Y = 552 * MiB, WS_QMLA = 808 * MiB, WS_END = 904 * MiB;

struct Params {
    const float *x, *c; const int* pos; const float *w_ada, *b_ada, *g_pre, *g_post, *w_in, *g_q, *w_uq, *g_kv, *w_ukv, *w_o_mla, *w_o_moba, *b_merge, *w_out;
    float* out; unsigned char* ws;
};

__device__ __forceinline__ float wave_sum(float v) {
#pragma unroll
    for (int o = 1; o < 64; o <<= 1) v += __shfl_xor(v, o);
    return v;
}
__device__ __forceinline__ float silu_f(float v) { return v / (1.f + __expf(-v)); }
__device__ __forceinline__ float sigmoid_f(float v) { return 1.f / (1.f + __expf(-v)); }

__device__ void ph_prep(const Params& p, int gtid, int gsize) {
    float* mod = (float*)(p.ws + WS_MOD);
    for (int i = gtid; i < NB * 3072; i += gsize) {
        const int b = i / 3072, j = i % 3072; float s = p.b_ada[j];
        for (int k = 0; k < DM; ++k) { const float cv = p.c[b * DM + k]; s += (cv / (1.f + expf(-cv))) * p.w_ada[(size_t)k * 3072 + j]; }
        mod[i] = s;
    }
    unsigned* tab = (unsigned*)(p.ws + WS_TAB);
    for (int i = gtid; i < M_ * 32; i += gsize) {
        const int m = i >> 5, f = i & 31;
        const double inv = exp2(-(double)f * (13.287712379549449 / 32.0));
        const double a = (double)p.pos[m] * inv;
        const double k = rint(a * 0.15915494309189535);
        const double r = (a - k * 6.283185307179586) - k * 2.4492935982947064e-16;
        { typedef _Float16 h2t __attribute__((ext_vector_type(2))); h2t cs; cs[0] = (_Float16)(float)cos(r); cs[1] = (_Float16)(float)sin(r); tab[i] = __builtin_bit_cast(unsigned, cs); }
    }
}

__device__ void ph_hnorm(const Params& p, int gwave, int nwaves, int lane) {
    const float* mod = (const float*)(p.ws + WS_MOD); h16* H = (h16*)(p.ws + WS_H);
    for (int m = gwave; m < M_; m += nwaves) {
        const int b = m >> 12; const float4* xr = (const float4*)(p.x + (size_t)m * DM);
        float4 v[4]; float ss = 0.f;
#pragma unroll
        for (int j = 0; j < 4; ++j) { v[j] = xr[lane + 64 * j]; ss += (v[j].x * v[j].x + v[j].y * v[j].y) + (v[j].z * v[j].z + v[j].w * v[j].w); }
        ss = wave_sum(ss); const float rstd = 1.f / sqrtf(ss * (1.f / DM) + EPS);
#pragma unroll
        for (int j = 0; j < 4; ++j) {
            const int col = 4 * (lane + 64 * j);
            const float4 g = *(const float4*)(p.g_pre + col), sc = *(const float4*)(mod + b * 3072 + 1024 + col), sh = *(const float4*)(mod + b * 3072 + col);
            h16x4 o; o[0] = (h16)(v[j].x * rstd * g.x * (1.f + sc.x) + sh.x); o[1] = (h16)(v[j].y * rstd * g.y * (1.f + sc.y) + sh.y);
            o[2] = (h16)(v[j].z * rstd * g.z * (1.f + sc.z) + sh.z); o[3] = (h16)(v[j].w * rstd * g.w * (1.f + sc.w) + sh.w);
            *(h16x4*)(H + (size_t)m * DM + col) = o;
        }
    }
}

template <typename AT, class Epi>
__device__ void gemm_naive(const AT* A, int lda, const float* W, int ldw, const float* kscale, int K, int Nv, const Epi& e, float* lds, int vb, int nvb) {
    float (*As)[132] = (float (*)[132])lds; float (*Bs)[132] = (float (*)[132])(lds + 16 * 132);
    const int tid = threadIdx.x, tx = tid & 31, ty = tid >> 5;
    const int ntn = (Nv + 127) / 128, ntiles = (M_ / 128) * ntn;
    for (int tile = vb; tile < ntiles; tile += nvb) {
        const int m0 = (tile / ntn) * 128, n0 = (tile % ntn) * 128;
        float acc[8][4];
#pragma unroll
        for (int i = 0; i < 8; ++i)
#pragma unroll
            for (int j = 0; j < 4; ++j) acc[i][j] = 0.f;
        for (int k0 = 0; k0 < K; k0 += 16) {
#pragma unroll
            for (int i = 0; i < 4; ++i) { const int idx = tid + i * 512, mm = idx >> 4, kk = idx & 15; float a = (float)A[(size_t)(m0 + mm) * lda + k0 + kk]; if (kscale) a *= kscale[k0 + kk]; As[kk][mm] = a; }
#pragma unroll
            for (int i = 0; i < 4; ++i) { const int idx = tid + i * 512, kk = idx >> 7, nn = idx & 127, j = n0 + nn; Bs[kk][nn] = (j < Nv) ? W[(size_t)(k0 + kk) * ldw + e.col(j)] : 0.f; }
            __syncthreads();
#pragma unroll
            for (int kk = 0; kk < 16; ++kk) {
                float a[8], b[4];
#pragma unroll
                for (int i = 0; i < 8; ++i) a[i] = As[kk][ty * 8 + i];
#pragma unroll
                for (int j = 0; j < 4; ++j) b[j] = Bs[kk][tx * 4 + j];
#pragma unroll
                for (int i = 0; i < 8; ++i)
#pragma unroll
                    for (int j = 0; j < 4; ++j) acc[i][j] = fmaf(a[i], b[j], acc[i][j]);
            }
            __syncthreads();
        }
        const int j0 = n0 + tx * 4;
        if (j0 < Nv) {
#pragma unroll
            for (int i = 0; i < 8; ++i) e.store(m0 + ty * 8 + i, j0, acc[i]);
        }
    }
}

struct EpiIn {
    unsigned char* ws; const float* b_merge;
    __device__ int col(int j) const {
        if (j >= C_KROPE && j < C_ZMLA) { const int w = j - C_KROPE; return C_KROPE + (w >> 1) + 16 * (w & 1); }
        if (j >= C_QMB && j < C_VMB) { const int w = (j - C_QMB) & 63, base = j - w; return base + (w >> 1) + 32 * (w & 1); }
        return j;
    }
    __device__ void store(int m, int j0, const float (&v)[4]) const {
        const h2n* tab = (const h2n*)(ws + WS_TAB) + (size_t)m * 32;
        if (j0 < C_KVLAT) {
            h16x4 o; o[0] = (h16)v[0]; o[1] = (h16)v[1]; o[2] = (h16)v[2]; o[3] = (h16)v[3];
            *(h16x4*)((h16*)(ws + WS_QLAT) + (size_t)m * 256 + j0) = o;
            atomicAdd((float*)(ws + WS_SSQ) + m, (v[0] * v[0] + v[1] * v[1]) + (v[2] * v[2] + v[3] * v[3]));
        } else if (j0 < C_KROPE) {
            h16x4 o; o[0] = (h16)v[0]; o[1] = (h16)v[1]; o[2] = (h16)v[2]; o[3] = (h16)v[3];
            *(h16x4*)((h16*)(ws + WS_KVL) + (size_t)m * 256 + (j0 - C_KVLAT)) = o;
            atomicAdd((float*)(ws + WS_SSQ) + M_ + m, (v[0] * v[0] + v[1] * v[1]) + (v[2] * v[2] + v[3] * v[3]));
        } else if (j0 < C_ZMLA) {
            const int i = (j0 - C_KROPE) >> 1; h16* kpe = (h16*)(ws + WS_KPE) + (size_t)m * 32; h16* kvl = (h16*)(ws + WS_KVL) + (size_t)m * 256;
#pragma unroll
            for (int q = 0; q < 2; ++q) { const h2n cs_ = tab[2 * (i + q)]; const float2 cs = make_float2((float)cs_[0], (float)cs_[1]); const float t1 = v[2 * q], t2 = v[2 * q + 1];
                kpe[i + q] = (h16)(t1 * cs.x - t2 * cs.y); kpe[i + q + 16] = (h16)(t2 * cs.x + t1 * cs.y);
                kvl[128 + i + q] = (h16)t1; kvl[128 + 16 + i + q] = (h16)t2; }
            const int z0 = 160 + (j0 - C_KROPE) * 3;
#pragma unroll
            for (int q = 0; q < 12; ++q) kvl[z0 + q] = (h16)0.f;
        } else if (j0 < C_QMB) {
            h16x4 o; o[0] = (h16)silu_f(v[0]); o[1] = (h16)silu_f(v[1]); o[2] = (h16)silu_f(v[2]); o[3] = (h16)silu_f(v[3]);
            *(h16x4*)((h16*)(ws + WS_ZMLA) + (size_t)m * 512 + (j0 - C_ZMLA)) = o;
        } else if (j0 < C_VMB) {
            const bool isq = j0 < C_KMB; const int w0 = j0 - (isq ? C_QMB : C_KMB), hh = w0 >> 6, i = (w0 & 63) >> 1;
            h16* dst = (h16*)(ws + (isq ? WS_QMB : WS_KMB)) + (size_t)m * 512 + hh * 64; const float sc = isq ? SC_MB : 1.f;
#pragma unroll
            for (int q = 0; q < 2; ++q) { const h2n cs_ = tab[i + q]; const float2 cs = make_float2((float)cs_[0], (float)cs_[1]); const float t1 = v[2 * q], t2 = v[2 * q + 1];
                dst[i + q] = (h16)((t1 * cs.x - t2 * cs.y) * sc); dst[i + q + 32] = (h16)((t2 * cs.x + t1 * cs.y) * sc); }
        } else if (j0 < C_ZMB) {
            h16x4 o; o[0] = (h16)v[0]; o[1] = (h16)v[1]; o[2] = (h16)v[2]; o[3] = (h16)v[3];
            *(h16x4*)((h16*)(ws + WS_VMB) + (size_t)m * 512 + (j0 - C_VMB)) = o;
        } else if (j0 < C_GA) {
            h16x4 o; o[0] = (h16)silu_f(v[0]); o[1] = (h16)silu_f(v[1]); o[2] = (h16)silu_f(v[2]); o[3] = (h16)silu_f(v[3]);
            *(h16x4*)((h16*)(ws + WS_ZMB) + (size_t)m * 512 + (j0 - C_ZMB)) = o;
        } else {
            const bool isa = j0 < C_GB; const int n = j0 - (isa ? C_GA : C_GB); const float* bm = b_merge + (isa ? 0 : 1024) + n;
            h16x4 o; o[0] = (h16)sigmoid_f(v[0] + bm[0]); o[1] = (h16)sigmoid_f(v[1] + bm[1]); o[2] = (h16)sigmoid_f(v[2] + bm[2]); o[3] = (h16)sigmoid_f(v[3] + bm[3]);
            *(h16x4*)((h16*)(ws + (isa ? WS_GA : WS_GB)) + (size_t)m * 1024 + n) = o;
        }
    }
};
struct EpiUq {
    unsigned char* ws;
    __device__ int col(int j) const { const int w = j % 96; if (w < 64) return j; const int u = w - 64; return j - w + 64 + (u >> 1) + 16 * (u & 1); }
    __device__ void store(int m, int j0, const float (&v)[4]) const {
        const float rstd = 1.f / sqrtf(((const float*)(ws + WS_SSQ))[m] * (1.f / 256.f) + EPS);
        const int hh = j0 / 96, w = j0 % 96; h16* dst = (h16*)(ws + WS_QMLA) + (size_t)m * 768 + hh * 96;
        if (w < 64) { h16x4 o; o[0] = (h16)(v[0] * rstd * SC_MLA); o[1] = (h16)(v[1] * rstd * SC_MLA); o[2] = (h16)(v[2] * rstd * SC_MLA); o[3] = (h16)(v[3] * rstd * SC_MLA); *(h16x4*)(dst + w) = o; }
        else { const h2n* tab = (const h2n*)(ws + WS_TAB) + (size_t)m * 32; const int i = (w - 64) >> 1;
#pragma unroll
            for (int q = 0; q < 2; ++q) { const h2n cs_ = tab[2 * (i + q)]; const float2 cs = make_float2((float)cs_[0], (float)cs_[1]); const float t1 = v[2 * q] * rstd * SC_MLA, t2 = v[2 * q + 1] * rstd * SC_MLA;
                dst[64 + i + q] = (h16)(t1 * cs.x - t2 * cs.y); dst[80 + i + q] = (h16)(t2 * cs.x + t1 * cs.y); } }
    }
};
struct EpiUkv {
    unsigned char* ws;
    __device__ int col(int j) const { return j; }
    __device__ void store(int m, int j0, const float (&v)[4]) const {
        const float rstd = 1.f / sqrtf(((const float*)(ws + WS_SSQ))[M_ + m] * (1.f / 128.f) + EPS);
        const int hh = j0 >> 7, w = j0 & 127; h16* dst = (h16*)(ws + (w < 64 ? WS_KN : WS_VM)) + (size_t)m * 512 + hh * 64 + (w & 63);
        h16x4 o; o[0] = (h16)(v[0] * rstd); o[1] = (h16)(v[1] * rstd); o[2] = (h16)(v[2] * rstd); o[3] = (h16)(v[3] * rstd); *(h16x4*)dst = o;
    }
};
struct EpiYa {
    unsigned char* ws;
    __device__ int col(int j) const { return j; }
    __device__ void store(int m, int j0, const float (&v)[4]) const {
        const h16x4 g = *(const h16x4*)((const h16*)(ws + WS_GA) + (size_t)m * 1024 + j0);
        h16x4 o; o[0] = (h16)(v[0] * (float)g[0]); o[1] = (h16)(v[1] * (float)g[1]); o[2] = (h16)(v[2] * (float)g[2]); o[3] = (h16)(v[3] * (float)g[3]);
        *(h16x4*)((h16*)(ws + WS_T) + (size_t)m * 1024 + j0) = o;
    }
};
struct EpiYb {
    unsigned char* ws;
    __device__ int col(int j) const { return j; }
    __device__ void store(int m, int j0, const float (&v)[4]) const {
        const h16x4 g = *(const h16x4*)((const h16*)(ws + WS_GB) + (size_t)m * 1024 + j0), t = *(const h16x4*)((const h16*)(ws + WS_T) + (size_t)m * 1024 + j0);
        h16x4 o; o[0] = (h16)((float)t[0] + v[0] * (float)g[0]); o[1] = (h16)((float)t[1] + v[1] * (float)g[1]); o[2] = (h16)((float)t[2] + v[2] * (float)g[2]); o[3] = (h16)((float)t[3] + v[3] * (float)g[3]);
        *(h16x4*)((h16*)(ws + WS_YM) + (size_t)m * 1024 + j0) = o;
    }
};
struct EpiY {
    unsigned char* ws;
    __device__ int col(int j) const { return j; }
    __device__ void store(int m, int j0, const float (&v)[4]) const { *(float4*)((float*)(ws + WS_Y) + (size_t)m * 1024 + j0) = make_float4(v[0], v[1], v[2], v[3]); }
};

__device__ void ph_kmean(const Params& p, int gtid, int gsize) {
    const h16* KMB = (const h16*)(p.ws + WS_KMB); float* km = (float*)(p.ws + WS_KMEAN);
    for (int i = gtid; i < NB * 16 * 512; i += gsize) {
        const int c = i & 511, n = (i >> 9) & 15, b = i >> 13; float s = 0.f;
        for (int r = 0; r < 256; ++r) s += (float)KMB[((size_t)b * SEQ + n * 256 + r) * 512 + c];
        km[i] = s * (1.f / 256.f);
    }
}

__device__ void ph_attn_mla_naive(const Params& p, int vb, int nvb) {
    const h16* Q = (const h16*)(p.ws + WS_QMLA); const h16* KN = (const h16*)(p.ws + WS_KN); const h16* KPE = (const h16*)(p.ws + WS_KPE); const h16* VM = (const h16*)(p.ws + WS_VM);
    h16* Z = (h16*)(p.ws + WS_ZMLA);
    for (int item = vb; item < NB * NH * 8; item += nvb) {
        const int ch = item & 7, h = (item >> 3) & 7, b = item >> 6;
        const int t = ch * 512 + threadIdx.x; const size_t m = (size_t)b * SEQ + t;
        float q[96], o[64];
#pragma unroll
        for (int d = 0; d < 96; ++d) q[d] = (float)Q[m * 768 + h * 96 + d];
#pragma unroll
        for (int d = 0; d < 64; ++d) o[d] = 0.f;
        float mx = -1e30f, l = 0.f;
        const int tmax = ch * 512 + (threadIdx.x | 63);
        for (int j = 0; j <= tmax; ++j) {
            const size_t mj = (size_t)b * SEQ + j; const h16* kn = KN + mj * 512 + h * 64; const h16* kp = KPE + mj * 32; const h16* vv = VM + mj * 512 + h * 64;
            float s = 0.f;
#pragma unroll
            for (int d = 0; d < 64; ++d) s = fmaf(q[d], (float)kn[d], s);
#pragma unroll
            for (int d = 0; d < 32; ++d) s = fmaf(q[64 + d], (float)kp[d], s);
            if (j <= t) {
                const float mn = fmaxf(mx, s), a = exp2f(mx - mn), pj = exp2f(s - mn); l = l * a + pj; mx = mn;
#pragma unroll
                for (int d = 0; d < 64; ++d) o[d] = fmaf(o[d], a, pj * (float)vv[d]);
            }
        }
        const float rl = 1.f / l;
#pragma unroll
        for (int d = 0; d < 64; ++d) { h16* zp = Z + m * 512 + h * 64 + d; *zp = (h16)(o[d] * rl * (float)*zp); }
    }
}

__device__ void ph_attn_moba_naive(const Params& p, int vb, int nvb) {
    const h16* Q = (const h16*)(p.ws + WS_QMB); const h16* KB = (const h16*)(p.ws + WS_KMB); const h16* VB = (const h16*)(p.ws + WS_VMB); const float* km = (const float*)(p.ws + WS_KMEAN);
    h16* Z = (h16*)(p.ws + WS_ZMB);
    for (int item = vb; item < NB * NH * 8; item += nvb) {
        const int ch = item & 7, h = (item >> 3) & 7, b = item >> 6;
        const int t = ch * 512 + threadIdx.x; const size_t m = (size_t)b * SEQ + t; const int own = t >> 8;
        float q[64], o[64];
#pragma unroll
        for (int d = 0; d < 64; ++d) { q[d] = (float)Q[m * 512 + h * 64 + d]; o[d] = 0.f; }
        unsigned sel = 0u;
        {
            float g0 = -INFINITY, g1 = -INFINITY, g2 = -INFINITY; int i0 = -1, i1 = -1, i2 = -1;
            for (int n = 0; n < own; ++n) {
                const float* kmp = km + ((size_t)(b * 16 + n)) * 512 + h * 64; float g = 0.f;
#pragma unroll
                for (int d = 0; d < 64; ++d) g = fmaf(q[d], kmp[d], g);
                if (g > g0) { g2 = g1; i2 = i1; g1 = g0; i1 = i0; g0 = g; i0 = n; }
                else if (g > g1) { g2 = g1; i2 = i1; g1 = g; i1 = n; }
                else if (g > g2) { g2 = g; i2 = n; }
            }
            if (i0 >= 0) sel |= 1u << i0; if (i1 >= 0) sel |= 1u << i1; if (i2 >= 0) sel |= 1u << i2;
        }
        float mx = -1e30f, l = 0.f;
        const int own_w = own;
        for (int n = 0; n <= own_w; ++n) {
            const bool isown = (n == own_w); const bool mine = isown || ((sel >> n) & 1u);
            if (!__any(mine)) continue;
            const int jend = isown ? ((t | 63) & 255) : 255;
            for (int jj = 0; jj <= jend; ++jj) {
                const int j = n * 256 + jj; const size_t mj = (size_t)b * SEQ + j; const h16* kk = KB + mj * 512 + h * 64; const h16* vv = VB + mj * 512 + h * 64;
                float s = 0.f;
#pragma unroll
                for (int d = 0; d < 64; ++d) s = fmaf(q[d], (float)kk[d], s);
                if (mine && j <= t) {
                    const float mn = fmaxf(mx, s), a = exp2f(mx - mn), pj = exp2f(s - mn); l = l * a + pj; mx = mn;
#pragma unroll
                    for (int d = 0; d < 64; ++d) o[d] = fmaf(o[d], a, pj * (float)vv[d]);
                }
            }
        }
        const float rl = 1.f / l;
#pragma unroll
        for (int d = 0; d < 64; ++d) { h16* zp = Z + m * 512 + h * 64 + d; *zp = (h16)(o[d] * rl * (float)*zp); }
    }
}

__device__ void ph_final(const Params& p, int gwave, int nwaves, int lane) {
    const float* mod = (const float*)(p.ws + WS_MOD); const float* Y = (const float*)(p.ws + WS_Y);
    for (int m = gwave; m < M_; m += nwaves) {
        const int b = m >> 12; const float4* yr = (const float4*)(Y + (size_t)m * DM); const float4* xr = (const float4*)(p.x + (size_t)m * DM); float4* orow = (float4*)(p.out + (size_t)m * DM);
        float4 v[4]; float ss = 0.f;
#pragma unroll
        for (int j = 0; j < 4; ++j) { v[j] = yr[lane + 64 * j]; ss += (v[j].x * v[j].x + v[j].y * v[j].y) + (v[j].z * v[j].z + v[j].w * v[j].w); }
        ss = wave_sum(ss); const float rstd = 1.f / sqrtf(ss * (1.f / DM) + EPS);
#pragma unroll
        for (int j = 0; j < 4; ++j) {
            const int col = 4 * (lane + 64 * j);
            const float4 g = *(const float4*)(p.g_post + col), gt = *(const float4*)(mod + b * 3072 + 2048 + col), xv = xr[lane + 64 * j];
            orow[lane + 64 * j] = make_float4(xv.x + gt.x * v[j].x * rstd * g.x, xv.y + gt.y * v[j].y * rstd * g.y, xv.z + gt.z * v[j].z * rstd * g.z, xv.w + gt.w * v[j].w * rstd * g.w);
        }
    }
}


#define XB_TMO      128
#define XB_XCNT(j)  (256  + 64 * (j))
#define XB_XSUB(j)  (1280 + 64 * (j))
#define XB_XGEN(j)  (2304 + 64 * (j))
#define XB_TOP      3328
#define XB_TOPGEN   3392
#define XCD_BAR_WORDS 3456
#define XB_SPIN_CAP (1u << 27)
#define LAS __attribute__((address_space(3)))
__device__ __forceinline__ unsigned xb_ld(unsigned* p)              { return __hip_atomic_load(p, __ATOMIC_RELAXED, __HIP_MEMORY_SCOPE_AGENT); }
__device__ __forceinline__ unsigned xb_add(unsigned* p, unsigned v) { return __hip_atomic_fetch_add(p, v, __ATOMIC_RELAXED, __HIP_MEMORY_SCOPE_AGENT); }
__device__ __forceinline__ unsigned xb_xcc_id() { return (unsigned)__builtin_amdgcn_s_getreg((3 << 11) | 20) & 0xFu; }
#define XB_SPIN(cond, bar) do { unsigned _sp = 0; while (cond) { __builtin_amdgcn_s_sleep(1); \
    if ((++_sp & 255u) == 0u) { if (xb_ld(&(bar)[XB_TMO])) break; if (_sp > XB_SPIN_CAP) { atomicAdd(&(bar)[XB_TMO], 1u); break; } } } } while (0)
struct XcdBarrier { unsigned* bar; unsigned x; volatile LAS unsigned* st; };
__device__ __forceinline__ XcdBarrier xcd_barrier_post(unsigned* bar, volatile LAS unsigned* st) {
    XcdBarrier b; b.bar = bar; b.x = xb_xcc_id(); b.st = st;
    if (threadIdx.x == 0) (void)xb_add(&bar[XB_XCNT(b.x)], 1u);
    return b;
}
__device__ __forceinline__ void xcd_barrier_complete(unsigned* bar, unsigned x, unsigned& nloc, unsigned& nx) {
    const unsigned G = gridDim.x * gridDim.y * gridDim.z;
    unsigned sum, cnt, mine, sp = 0u;
    for (;;) {
        sum = 0u; cnt = 0u; mine = 0u;
#pragma unroll
        for (unsigned j = 0; j < 16; ++j) { const unsigned c = xb_ld(&bar[XB_XCNT(j)]); sum += c; cnt += (c > 0u) ? 1u : 0u; mine = (j == x) ? c : mine; }
        if (sum == G) break;
        __builtin_amdgcn_s_sleep(1);
        if ((++sp & 255u) == 0u) { if (xb_ld(&bar[XB_TMO])) break; if (sp > XB_SPIN_CAP) { atomicAdd(&bar[XB_TMO], 1u); break; } }
    }
    nloc = mine > 0u ? mine : 1u; nx = cnt > 0u ? cnt : 1u;
}
__device__ __forceinline__ void xcd_barrier(const XcdBarrier& b) {
    asm volatile("s_waitcnt vmcnt(0)" ::: "memory");
    __syncthreads();
    if (threadIdx.x == 0) {
        unsigned* bar = b.bar;
        __builtin_amdgcn_s_waitcnt(0);
        unsigned nloc = b.st[0], nx = b.st[1];
        if (nloc == 0u) { xcd_barrier_complete(bar, b.x, nloc, nx); b.st[0] = nloc; b.st[1] = nx; }
        const unsigned old = xb_add(&bar[XB_XSUB(b.x)], 1u);
        const unsigned gen = old / nloc;
        if (old + 1u == (gen + 1u) * nloc) {
            __builtin_amdgcn_fence(__ATOMIC_RELEASE, "agent");
            asm volatile("s_waitcnt vmcnt(0)" ::: "memory");
            const unsigned og = xb_add(&bar[XB_TOP], 1u);
            const unsigned tg = og / nx;
            if (og + 1u == (tg + 1u) * nx) xb_add(&bar[XB_TOPGEN], 1u);
            else XB_SPIN(xb_ld(&bar[XB_TOPGEN]) == tg, bar);
            __builtin_amdgcn_fence(__ATOMIC_ACQUIRE, "agent");
            xb_add(&bar[XB_XGEN(b.x)], 1u);
            asm volatile("s_waitcnt vmcnt(0)" ::: "memory");
        } else {
            XB_SPIN(xb_ld(&bar[XB_XGEN(b.x)]) == gen, bar);
            __builtin_amdgcn_fence(__ATOMIC_ACQUIRE, "agent");
            asm volatile("s_waitcnt vmcnt(0)" ::: "memory");
        }
    }
    __syncthreads();
}

namespace pg8 {
#define PG8_LAS __attribute__((address_space(3)))
typedef unsigned short bf16_t;
typedef _Float16 bf16x8 __attribute__((ext_vector_type(8)));
typedef float f32x4 __attribute__((ext_vector_type(4)));
typedef unsigned u32x4 __attribute__((ext_vector_type(4)));
constexpr int BM = 256, BK = 64, HALF = 128, HTB = HALF * BK * 2  , STAGE_BYTES = 8 * HTB, NXCD = 8, WGM = 8;

__host__ __device__ __forceinline__ int lds_byte(int r, int c) { const int st = (r >> 4) * 2 + (c >> 5), rr = r & 15, cc = c & 31, ob = rr * 64 + cc * 2; return st * 1024 + (ob ^ (((ob >> 9) & 1) << 5)); }
__host__ __device__ __forceinline__ void stage_rc(int b, int& R, int& C) { const int st = b / 1024, sb = b % 1024, swz = sb ^ (((sb >> 9) & 1) << 5); R = (st >> 1) * 16 + swz / 64; C = (st & 1) * 32 + (swz % 64) / 2; }
__host__ __device__ __forceinline__ int perm32(int rho) { const int n = rho >> 4, i = rho & 15; return 8 * (i >> 2) + 4 * n + (i & 3); }

struct Unit { int pm, pn; };
struct Gemm { const bf16_t* A; const bf16_t* Bt; int M, N, K; };

struct StaticOrder {
    int nM, nN, nwg, G, c;
    __host__ __device__ void init(int M, int N, int G_, int c_) { nM = M / BM; nN = N / BM; nwg = nM * nN; G = G_; c = c_; }
    __host__ __device__ bool next(int i, Unit& u) const {
        const long L = (long)i * G + c; if (L >= nwg) return false;
        int wgid = (int)L; { const int q = nwg / NXCD, r = nwg % NXCD, xcd = wgid % NXCD, off = wgid / NXCD; wgid = (xcd < r ? xcd * (q + 1) : r * (q + 1) + (xcd - r) * q) + off; }
        const int nig = WGM * nN, gid = wgid / nig, fm = gid * WGM, gsz = (nM - fm) < WGM ? (nM - fm) : WGM;
        u.pm = fm + ((wgid % nig) % gsz); u.pn = (wgid % nig) / gsz; return true;
    }
    __device__ __forceinline__ void a_ready(const Unit&) const {}
    __device__ __forceinline__ void done(const Unit&) const {}
};

template <class Epi, class Sched, bool ALIGN_EPI = false, bool SP2 = false>
__device__ __forceinline__ void gemm_phase(PG8_LAS unsigned char* lds, const Gemm g, const Sched& S, const Epi& E) {
    int tid_ = threadIdx.x; asm volatile("" : "+v"(tid_));
    const int tid = tid_, wid = __builtin_amdgcn_readfirstlane(tid >> 6), lane = tid & 63, wr = wid >> 2, wc = wid & 3, fr = lane & 15, fq = lane >> 4;
    const int K = g.K, nt = K / BK;
    unsigned voffA[2], voffB[2];
#pragma unroll
    for (int i = 0; i < 2; ++i) { int R, C; stage_rc(tid * 16 + i * 8192, R, C); const int Rb = Epi::PERM ? ((R & ~31) + perm32(R & 31)) : R;
        voffA[i] = (unsigned)(R * K + C) * 2u; voffB[i] = (unsigned)(Rb * K + C) * 2u; }
    const size_t kstep = (size_t)(BK * 2);
    const size_t hstep = (size_t)HALF * K * 2;
    const size_t tstep = 2 * hstep;
    const unsigned ldsw = (unsigned)wid * 1024u;
    const int aoff = lds_byte(wr * 64 + fr, fq * 8), boff = lds_byte(wc * 32 + fr, fq * 8);
#define PG8_SA(b, h) (((b) * 2 + (h)) * HTB)
#define PG8_SB(b, h) ((4 + (b) * 2 + (h)) * HTB)
#define PG8_STAGE(bufoff, gbase, voff) do { _Pragma("unroll") for (int _i = 0; _i < 2; ++_i) \
        __builtin_amdgcn_global_load_lds((const unsigned*)((const char*)(gbase) + (voff)[_i]), (PG8_LAS unsigned*)(lds + (bufoff) + ldsw + _i * 8192), 16, 0, 0); } while (0)
#define PG8_LDA(dst, b, h) do { _Pragma("unroll") for (int m = 0; m < 4; ++m) _Pragma("unroll") for (int k = 0; k < 2; ++k) dst[m][k] = *(const PG8_LAS bf16x8*)(lds + PG8_SA(b, h) + aoff + m * 2048 + k * 1024); } while (0)
#define PG8_LDB(dst, b, h) do { _Pragma("unroll") for (int n = 0; n < 2; ++n) _Pragma("unroll") for (int k = 0; k < 2; ++k) dst[n][k] = *(const PG8_LAS bf16x8*)(lds + PG8_SB(b, h) + boff + n * 2048 + k * 1024); } while (0)
#define PG8_MMA(ai, bj, At, Bt) do { __builtin_amdgcn_s_setprio(1); _Pragma("unroll") for (int m = 0; m < 4; ++m) _Pragma("unroll") for (int n = 0; n < 2; ++n) _Pragma("unroll") for (int k = 0; k < 2; ++k) \
        acc[ai][bj][m][n] = __builtin_amdgcn_mfma_f32_16x16x32_f16(Bt[n][k], At[m][k], acc[ai][bj][m][n], 0, 0, 0); __builtin_amdgcn_s_setprio(0); } while (0)
#define PG8_WAIT_V(n) asm volatile("s_waitcnt vmcnt(" #n ")" ::: "memory")
#define PG8_WAIT_L(n) asm volatile("s_waitcnt lgkmcnt(" #n ")" ::: "memory")
#define PG8_BAR __builtin_amdgcn_s_barrier()
#define PG8_SCHED __builtin_amdgcn_sched_barrier(0)
    Unit cur, nxt; int ui = 0;
    if (!S.next(0, cur)) return;
    f32x4 acc[2][2][4][2];
#pragma unroll
    for (int a = 0; a < 2; ++a)
#pragma unroll
        for (int b = 0; b < 2; ++b)
#pragma unroll
            for (int m = 0; m < 4; ++m)
#pragma unroll
                for (int n = 0; n < 2; ++n) acc[a][b][m][n] = (f32x4){0.f, 0.f, 0.f, 0.f};
    bf16x8 At[4][2], B0[2][2], B1[2][2];
    const char* cA = (const char*)g.A + (size_t)cur.pm * tstep; const char* cB = (const char*)g.Bt + (size_t)cur.pn * tstep;
    S.a_ready(cur);
    if constexpr (SP2) {
        PG8_STAGE(PG8_SB(0, 0), cB, voffB); PG8_STAGE(PG8_SB(0, 1), cB + hstep, voffB); PG8_STAGE(PG8_SA(0, 0), cA, voffA); PG8_STAGE(PG8_SA(0, 1), cA + hstep, voffA);
        if (wr == 1) PG8_BAR;
        PG8_WAIT_V(2); PG8_BAR;
        PG8_STAGE(PG8_SB(1, 0), cB + kstep, voffB); PG8_STAGE(PG8_SA(1, 0), cA + kstep, voffA); PG8_STAGE(PG8_SB(1, 1), cB + hstep + kstep, voffB);
        PG8_WAIT_V(6); PG8_BAR;
    } else {
        PG8_STAGE(PG8_SB(0, 0), cB, voffB); PG8_STAGE(PG8_SA(0, 0), cA, voffA); PG8_STAGE(PG8_SB(0, 1), cB + hstep, voffB); PG8_STAGE(PG8_SA(0, 1), cA + hstep, voffA);
        if (wr == 1) PG8_BAR;
        PG8_WAIT_V(4); PG8_BAR;
        PG8_STAGE(PG8_SB(1, 0), cB + kstep, voffB); PG8_STAGE(PG8_SA(1, 0), cA + kstep, voffA); PG8_STAGE(PG8_SB(1, 1), cB + hstep + kstep, voffB);
        PG8_WAIT_V(6); PG8_BAR;
    }
    for (;;) {
        const bool has_next = S.next(ui + 1, nxt);
        const char* nA = has_next ? (const char*)g.A + (size_t)nxt.pm * tstep : cA; const char* nB = has_next ? (const char*)g.Bt + (size_t)nxt.pn * tstep : cB;
#pragma nounroll
        for (int t = 0; t < nt; t += 2) {
            const bool last = (t == nt - 2);
            const char* a1 = cA + (size_t)(t + 1) * kstep;
            const char* a2 = last ? nA : cA + (size_t)(t + 2) * kstep; const char* b2 = last ? nB : cB + (size_t)(t + 2) * kstep;
            const char* a3 = a2 + kstep; const char* b3 = b2 + kstep;
            if (last && has_next) S.a_ready(nxt);
            if constexpr (SP2) {
            PG8_LDB(B0, 0, 0); PG8_LDB(B1, 0, 1); PG8_SCHED; PG8_LDA(At, 0, 0); PG8_STAGE(PG8_SA(1, 1), a1 + hstep, voffA);
            PG8_WAIT_V(8); PG8_WAIT_L(0); PG8_BAR; PG8_MMA(0, 0, At, B0); PG8_MMA(0, 1, At, B1); PG8_BAR; PG8_SCHED;
            PG8_LDA(At, 0, 1); PG8_STAGE(PG8_SB(0, 0), b2, voffB); PG8_STAGE(PG8_SB(0, 1), b2 + hstep, voffB); PG8_STAGE(PG8_SA(0, 0), a2, voffA);
            PG8_WAIT_V(8); PG8_WAIT_L(0); PG8_BAR; PG8_MMA(1, 0, At, B0); PG8_MMA(1, 1, At, B1); PG8_BAR; PG8_SCHED;
            PG8_LDB(B0, 1, 0); PG8_LDB(B1, 1, 1); PG8_SCHED; PG8_LDA(At, 1, 0); PG8_STAGE(PG8_SA(0, 1), a2 + hstep, voffA);
            PG8_WAIT_V(8); PG8_WAIT_L(0); PG8_BAR; PG8_MMA(0, 0, At, B0); PG8_MMA(0, 1, At, B1); PG8_BAR; PG8_SCHED;
            PG8_LDA(At, 1, 1); PG8_STAGE(PG8_SB(1, 0), b3, voffB); PG8_STAGE(PG8_SB(1, 1), b3 + hstep, voffB); PG8_STAGE(PG8_SA(1, 0), a3, voffA);
            PG8_WAIT_V(8); PG8_WAIT_L(0); PG8_BAR; PG8_MMA(1, 0, At, B0); PG8_MMA(1, 1, At, B1); PG8_BAR; PG8_SCHED;
            } else {
            PG8_LDB(B0, 0, 0); PG8_SCHED; PG8_LDA(At, 0, 0); PG8_STAGE(PG8_SA(1, 1), a1 + hstep, voffA);
            PG8_WAIT_L(8); PG8_BAR; PG8_WAIT_L(0); PG8_MMA(0, 0, At, B0); PG8_BAR; PG8_SCHED;
            PG8_LDB(B1, 0, 1); PG8_STAGE(PG8_SB(0, 0), b2, voffB);
            PG8_BAR; PG8_WAIT_L(0); PG8_MMA(0, 1, At, B1); PG8_BAR;
            PG8_LDA(At, 0, 1); PG8_STAGE(PG8_SA(0, 0), a2, voffA);
            PG8_BAR; PG8_WAIT_L(0); PG8_MMA(1, 0, At, B0); PG8_BAR; PG8_SCHED;
            PG8_STAGE(PG8_SB(0, 1), b2 + hstep, voffB);
            PG8_WAIT_V(6); PG8_BAR; PG8_MMA(1, 1, At, B1); PG8_BAR;
            PG8_LDB(B0, 1, 0); PG8_SCHED; PG8_LDA(At, 1, 0); PG8_STAGE(PG8_SA(0, 1), a2 + hstep, voffA);
            PG8_WAIT_L(8); PG8_BAR; PG8_WAIT_L(0); PG8_MMA(0, 0, At, B0); PG8_BAR; PG8_SCHED;
            PG8_LDB(B1, 1, 1); PG8_STAGE(PG8_SB(1, 0), b3, voffB);
            PG8_BAR; PG8_WAIT_L(0); PG8_MMA(0, 1, At, B1); PG8_BAR;
            PG8_LDA(At, 1, 1); PG8_STAGE(PG8_SA(1, 0), a3, voffA);
            PG8_BAR; PG8_WAIT_L(0); PG8_MMA(1, 0, At, B0); PG8_BAR; PG8_SCHED;
            PG8_STAGE(PG8_SB(1, 1), b3 + hstep, voffB);
            PG8_WAIT_V(6); PG8_BAR; PG8_MMA(1, 1, At, B1); PG8_BAR;
            }
        }
        if constexpr (ALIGN_EPI) { if (wr == 0) PG8_BAR; }
        if constexpr (!Epi::AFTER_DRAIN) { E(acc, cur, wr, wc, fr, fq); S.done(cur); }
        if (!has_next) break;
#pragma unroll
        for (int a = 0; a < 2; ++a)
#pragma unroll
            for (int b = 0; b < 2; ++b)
#pragma unroll
                for (int m = 0; m < 4; ++m)
#pragma unroll
                    for (int n = 0; n < 2; ++n) acc[a][b][m][n] = (f32x4){0.f, 0.f, 0.f, 0.f};
        cur = nxt; cA = nA; cB = nB; ++ui;
        if constexpr (ALIGN_EPI) { if (wr == 1) PG8_BAR; }
    }
    PG8_WAIT_V(0);
    if constexpr (!ALIGN_EPI) { if (wr == 0) PG8_BAR; }
    PG8_BAR;
    if constexpr (Epi::AFTER_DRAIN) { E.fused(acc, cur, wr, wc, fr, fq, lds, wid, lane); S.done(cur); }
#undef PG8_SA
#undef PG8_SB
#undef PG8_STAGE
#undef PG8_LDA
#undef PG8_LDB
#undef PG8_MMA
#undef PG8_WAIT_V
#undef PG8_WAIT_L
#undef PG8_BAR
#undef PG8_SCHED
}
typedef _Float16 h8v __attribute__((ext_vector_type(8)));
typedef _Float16 h2v __attribute__((ext_vector_type(2)));
__device__ __forceinline__ unsigned pk_h2(float lo, float hi) { h2v v; v[0] = (_Float16)lo; v[1] = (_Float16)hi; return __builtin_bit_cast(unsigned, v); }
__device__ __forceinline__ u32x4 pack8(const f32x4& a, const f32x4& b) { u32x4 w; w.x = pk_h2(a[0], a[1]); w.y = pk_h2(a[2], a[3]); w.z = pk_h2(b[0], b[1]); w.w = pk_h2(b[2], b[3]); return w; }
__device__ __forceinline__ float sigm1(float v) { return __builtin_amdgcn_rcpf(1.f + __builtin_amdgcn_exp2f(v * -1.4426950408889634f)); }
__device__ __forceinline__ float silu1(float v) { return v * sigm1(v); }
__device__ __forceinline__ f32x4 silu4(const f32x4& v) { return (f32x4){silu1(v[0]), silu1(v[1]), silu1(v[2]), silu1(v[3])}; }
__device__ __forceinline__ f32x4 sigm4(const f32x4& v) { return (f32x4){sigm1(v[0]), sigm1(v[1]), sigm1(v[2]), sigm1(v[3])}; }

#define PG8_OPAQUE(fr_, fq_) int lane_x; asm volatile("v_mbcnt_lo_u32_b32 %0, -1, 0\n\tv_mbcnt_hi_u32_b32 %0, -1, %0" : "=v"(lane_x)); const int frx = lane_x & 15, fqx = lane_x >> 4
__device__ __forceinline__ void st16(unsigned char* base, unsigned off, const u32x4& v) { *(u32x4*)(base + off) = v; }
__device__ __forceinline__ f32x4 ld16f(const unsigned char* base, unsigned off) { return *(const f32x4*)(base + off); }
__device__ __forceinline__ float ld4f(const unsigned char* base, unsigned off) { return *(const float*)(base + off); }
__device__ __forceinline__ h8v ld16h(const unsigned char* base, unsigned off) { return *(const h8v*)(base + off); }
__device__ __forceinline__ float sumsq8(const f32x4& a, const f32x4& b) { return (a[0] * a[0] + a[1] * a[1]) + (a[2] * a[2] + a[3] * a[3]) + (b[0] * b[0] + b[1] * b[1]) + (b[2] * b[2] + b[3] * b[3]); }
__device__ __forceinline__ void rope4(const f32x4& t1, const f32x4& t2, const u32x4& cs, f32x4& o1, f32x4& o2) {
#pragma unroll
    for (int j = 0; j < 4; ++j) { const unsigned wj = cs[j]; h2v w; __builtin_memcpy(&w, &wj, 4);
        const float c = (float)w[0], s = (float)w[1]; o1[j] = t1[j] * c - t2[j] * s; o2[j] = t2[j] * c + t1[j] * s; }
}
__device__ __forceinline__ u32x4 ld16u(const unsigned char* base, unsigned off) { return *(const u32x4*)(base + off); }

struct EpiInF {
    static constexpr bool PERM = true, AFTER_DRAIN = false;
    unsigned char* ws; const float* b_merge; int noatomic;
    template <bool ISQ> __device__ __forceinline__ void rope_tile(const f32x4 (&acc)[2][2][4][2], const Unit& u, int wr, int wc, int frx, int fqx) const {
        const int pn = u.pn; const unsigned row0 = (unsigned)(u.pm * 256 + wr * 64) + (unsigned)frx; const float sc = ISQ ? SC_MB : 1.f;
        unsigned char* dst = ws + (ISQ ? WS_QMB : WS_KMB); const unsigned char* tab = ws + WS_TAB;
        const unsigned o0 = row0 * 1024u + (((pn & 1) ? 256u : 0u) + 64u * wc + 8u * fqx) * 2u, t0 = row0 * 128u + 32u * fqx;
        f32x4 c1[2] = {{0.f, 0.f, 0.f, 0.f}, {0.f, 0.f, 0.f, 0.f}}, c2[2] = {{0.f, 0.f, 0.f, 0.f}, {0.f, 0.f, 0.f, 0.f}};
        u32x4 cs[2][4][2];
#pragma unroll
        for (int ai = 0; ai < 2; ++ai)
#pragma unroll
            for (int m = 0; m < 4; ++m) { const unsigned to = t0 + (unsigned)(ai * 128 + m * 16) * 128u; cs[ai][m][0] = ld16u(tab, to); cs[ai][m][1] = ld16u(tab, to + 16u); }
#pragma unroll
        for (int ai = 0; ai < 2; ++ai)
#pragma unroll
            for (int m = 0; m < 4; ++m) { const unsigned ro = o0 + (unsigned)(ai * 128 + m * 16) * 1024u;
                f32x4 o1[2], o2[2];
#pragma unroll
                for (int n = 0; n < 2; ++n) { rope4(acc[ai][0][m][n], acc[ai][1][m][n], cs[ai][m][n], o1[n], o2[n]);
                    if (!ISQ) { c1[n] += o1[n]; c2[n] += o2[n]; } }
                st16(dst, ro, pack8(o1[0] * sc, o1[1] * sc)); st16(dst, ro + 64u, pack8(o2[0] * sc, o2[1] * sc));
                if (!ISQ) asm volatile("" : "+v"(c1[0]), "+v"(c1[1]), "+v"(c2[0]), "+v"(c2[1])); }
        if (!ISQ) {
            float* km = (float*)(ws + WS_KMEAN) + (size_t)u.pm * 512 + ((pn & 1) ? 256 : 0) + 64 * wc + 8 * fqx;
#pragma unroll
            for (int n = 0; n < 2; ++n)
#pragma unroll
                for (int j = 0; j < 4; ++j) { float a = c1[n][j], b = c2[n][j];
#pragma unroll
                    for (int o = 1; o < 16; o <<= 1) { a += __shfl_xor(a, o); b += __shfl_xor(b, o); }
                    if (frx == 0 && !noatomic) { atomicAdd(km + 4 * n + j, a * (1.f / 256.f)); atomicAdd(km + 32 + 4 * n + j, b * (1.f / 256.f)); } }
        }
    }
    __device__ __forceinline__ void operator()(const f32x4 (&acc)[2][2][4][2], const Unit& u, int wr, int wc, int fr, int fq) const {
        PG8_OPAQUE(fr, fq);
        const int pn = u.pn; const unsigned row0 = (unsigned)(u.pm * 256 + wr * 64) + (unsigned)frx, cl = 32u * wc + 8u * fqx;
        if (pn == 0) {
            unsigned char* dst = ws + WS_QLAT; float* ssq = (float*)(ws + WS_SSQ); const unsigned o0 = row0 * 512u + cl * 2u;
#pragma unroll
            for (int ai = 0; ai < 2; ++ai)
#pragma unroll
                for (int m = 0; m < 4; ++m) { const unsigned ro = o0 + (unsigned)(ai * 128 + m * 16) * 512u; float s = 0.f;
#pragma unroll
                    for (int bj = 0; bj < 2; ++bj) { s += sumsq8(acc[ai][bj][m][0], acc[ai][bj][m][1]); st16(dst, ro + bj * 256u, pack8(acc[ai][bj][m][0], acc[ai][bj][m][1])); }
                    s += __shfl_xor(s, 16); s += __shfl_xor(s, 32);
                    if (fqx == 0 && !noatomic) atomicAdd(ssq + (row0 + ai * 128 + m * 16), s); }
        } else if (pn == 1) {
            unsigned char* kvl = ws + WS_KVL; unsigned char* kpe = ws + WS_KPE; float* ssq = (float*)(ws + WS_SSQ) + M_; const unsigned char* tab = ws + WS_TAB;
#pragma unroll
            for (int ai = 0; ai < 2; ++ai)
#pragma unroll
                for (int m = 0; m < 4; ++m) { const unsigned row = row0 + ai * 128 + m * 16;
                    if (wc < 2) { float s = 0.f;
#pragma unroll
                        for (int bj = 0; bj < 2; ++bj) { s += sumsq8(acc[ai][bj][m][0], acc[ai][bj][m][1]); st16(kvl, row * 512u + (bj * 64u + cl) * 2u, pack8(acc[ai][bj][m][0], acc[ai][bj][m][1])); }
                        s += __shfl_xor(s, 16); s += __shfl_xor(s, 32);
                        if (fqx == 0 && !noatomic) atomicAdd(ssq + row, s);
                    } else {
                        if (wc == 2 && fqx < 2) {
                            f32x4 o1[2], o2[2];
#pragma unroll
                            for (int n = 0; n < 2; ++n) { const unsigned to = row * 128u + (unsigned)(16 * fqx + 8 * n) * 4u; const u32x4 wa = ld16u(tab, to), wb = ld16u(tab, to + 16u);
                                rope4(acc[ai][0][m][n], acc[ai][1][m][n], (u32x4){wa[0], wa[2], wb[0], wb[2]}, o1[n], o2[n]); }
                            st16(kpe, row * 64u + 16u * fqx, pack8(o1[0], o1[1])); st16(kpe, row * 64u + 32u + 16u * fqx, pack8(o2[0], o2[1]));
                        }
                        const u32x4 z = {0u, 0u, 0u, 0u};
                        st16(kvl, row * 512u + (128u + (cl - 64u)) * 2u, z); st16(kvl, row * 512u + (192u + (cl - 64u)) * 2u, z);
                    }
                    asm volatile("" ::: "memory"); }
        } else if (pn < 4 || (pn >= 8 && pn < 12)) {
            const bool act = (pn < 4) || (pn >= 10);
            unsigned char* dst = ws + (pn < 4 ? WS_ZMLA : (pn < 10 ? WS_VMB : WS_ZMB)); const unsigned o0 = row0 * 1024u + (((pn & 1) ? 256u : 0u) + cl) * 2u;
#pragma unroll
            for (int ai = 0; ai < 2; ++ai)
#pragma unroll
                for (int m = 0; m < 4; ++m) { const unsigned ro = o0 + (unsigned)(ai * 128 + m * 16) * 1024u;
#pragma unroll
                    for (int bj = 0; bj < 2; ++bj) { f32x4 a = acc[ai][bj][m][0], b = acc[ai][bj][m][1]; if (act) { a = silu4(a); b = silu4(b); }
                        st16(dst, ro + bj * 256u, pack8(a, b)); } }
        } else if (pn < 6) { rope_tile<true>(acc, u, wr, wc, frx, fqx);
        } else if (pn < 8) { rope_tile<false>(acc, u, wr, wc, frx, fqx);
        } else {
            const bool isa = pn < 16; unsigned char* dst = ws + (isa ? WS_GA : WS_GB); const unsigned cg = 256u * ((pn - 12) & 3) + cl;
            const unsigned char* bm = (const unsigned char*)(b_merge + (isa ? 0 : 1024)); const unsigned o0 = row0 * 2048u + cg * 2u;
            f32x4 bv[2][2];
#pragma unroll
            for (int bj = 0; bj < 2; ++bj)
#pragma unroll
                for (int n = 0; n < 2; ++n) bv[bj][n] = ld16f(bm, (cg + bj * 128u + 4u * n) * 4u);
#pragma unroll
            for (int ai = 0; ai < 2; ++ai)
#pragma unroll
                for (int m = 0; m < 4; ++m) { const unsigned ro = o0 + (unsigned)(ai * 128 + m * 16) * 2048u;
#pragma unroll
                    for (int bj = 0; bj < 2; ++bj) st16(dst, ro + bj * 256u, pack8(sigm4(acc[ai][bj][m][0] + bv[bj][0]), sigm4(acc[ai][bj][m][1] + bv[bj][1]))); }
        }
    }
};
struct EpiUqF {
    static constexpr bool PERM = true, AFTER_DRAIN = false;
    unsigned char* ws;
    __device__ __forceinline__ void operator()(const f32x4 (&acc)[2][2][4][2], const Unit& u, int wr, int wc, int fr, int fq) const {
        PG8_OPAQUE(fr, fq);
        const int pn = u.pn; const unsigned row0 = (unsigned)(u.pm * 256 + wr * 64) + (unsigned)frx; unsigned char* Q = ws + WS_QMLA; const unsigned char* ssq = ws + WS_SSQ; const unsigned char* tab = ws + WS_TAB;
        float rsv[2][4];
#pragma unroll
        for (int ai = 0; ai < 2; ++ai)
#pragma unroll
            for (int m = 0; m < 4; ++m) rsv[ai][m] = ld4f(ssq, (row0 + ai * 128 + m * 16) * 4u);
#pragma unroll
        for (int ai = 0; ai < 2; ++ai)
#pragma unroll
            for (int m = 0; m < 4; ++m) { const unsigned row = row0 + ai * 128 + m * 16; const float rs = SC_MLA * __builtin_amdgcn_rsqf(rsv[ai][m] * (1.f / 256.f) + EPS);
                if (pn < 2) {
#pragma unroll
                    for (int bj = 0; bj < 2; ++bj) { const unsigned head = 4u * pn + 2u * bj + (wc >> 1), d = 32u * (wc & 1) + 8u * fqx;
                        st16(Q, row * 1536u + (96u * head + d) * 2u, pack8(acc[ai][bj][m][0] * rs, acc[ai][bj][m][1] * rs)); }
                } else { const unsigned head = 2u * wc + ((unsigned)fqx >> 1), i0 = 8u * (fqx & 1); f32x4 o1[2], o2[2];
#pragma unroll
                    for (int n = 0; n < 2; ++n) { const unsigned to = row * 128u + (2u * (i0 + 4u * n)) * 4u; const u32x4 wa = ld16u(tab, to), wb = ld16u(tab, to + 16u);
                        rope4(acc[ai][0][m][n] * rs, acc[ai][1][m][n] * rs, (u32x4){wa[0], wa[2], wb[0], wb[2]}, o1[n], o2[n]); }
                    st16(Q, row * 1536u + (96u * head + 64u + i0) * 2u, pack8(o1[0], o1[1])); st16(Q, row * 1536u + (96u * head + 80u + i0) * 2u, pack8(o2[0], o2[1])); } }
    }
};
struct EpiUkvF {
    static constexpr bool PERM = true, AFTER_DRAIN = false;
    unsigned char* ws;
    __device__ __forceinline__ void operator()(const f32x4 (&acc)[2][2][4][2], const Unit& u, int wr, int wc, int fr, int fq) const {
        PG8_OPAQUE(fr, fq);
        const int pn = u.pn; const unsigned row0 = (unsigned)(u.pm * 256 + wr * 64) + (unsigned)frx; unsigned char* dst = ws + (pn < 2 ? WS_KN : WS_VM); const unsigned char* ssq = ws + WS_SSQ + (size_t)M_ * 4;
        float rsv[2][4];
#pragma unroll
        for (int ai = 0; ai < 2; ++ai)
#pragma unroll
            for (int m = 0; m < 4; ++m) rsv[ai][m] = ld4f(ssq, (row0 + ai * 128 + m * 16) * 4u);
#pragma unroll
        for (int ai = 0; ai < 2; ++ai)
#pragma unroll
            for (int m = 0; m < 4; ++m) { const unsigned row = row0 + ai * 128 + m * 16; const float rs = __builtin_amdgcn_rsqf(rsv[ai][m] * (1.f / 128.f) + EPS);
#pragma unroll
                for (int bj = 0; bj < 2; ++bj) { const unsigned head = 4u * (pn & 1) + 2u * bj + (wc >> 1), d = 32u * (wc & 1) + 8u * fqx;
                    st16(dst, row * 1024u + (64u * head + d) * 2u, pack8(acc[ai][bj][m][0] * rs, acc[ai][bj][m][1] * rs)); } }
    }
};
template <int MODE> struct EpiYabF {
    static constexpr bool PERM = true, AFTER_DRAIN = false;
    unsigned char* ws;
    __device__ __forceinline__ void operator()(const f32x4 (&acc)[2][2][4][2], const Unit& u, int wr, int wc, int fr, int fq) const {
        PG8_OPAQUE(fr, fq);
        const unsigned row0 = (unsigned)(u.pm * 256 + wr * 64) + (unsigned)frx, c0 = u.pn * 256u + 32u * wc + 8u * fqx, o0 = row0 * 2048u + c0 * 2u;
        const unsigned char* G = ws + (MODE == 0 ? WS_GA : WS_GB); unsigned char* T = ws + WS_T; unsigned char* YM = ws + WS_YM;
#pragma unroll
        for (int ai = 0; ai < 2; ++ai) {
            h8v gv[4][2], tv[4][2];
#pragma unroll
            for (int m = 0; m < 4; ++m)
#pragma unroll
                for (int bj = 0; bj < 2; ++bj) { const unsigned off = o0 + (unsigned)(ai * 128 + m * 16) * 2048u + bj * 256u; gv[m][bj] = ld16h(G, off); if (MODE == 1) tv[m][bj] = ld16h(T, off); }
#pragma unroll
            for (int m = 0; m < 4; ++m)
#pragma unroll
                for (int bj = 0; bj < 2; ++bj) { const unsigned off = o0 + (unsigned)(ai * 128 + m * 16) * 2048u + bj * 256u; const h8v g = gv[m][bj];
                    f32x4 a = acc[ai][bj][m][0], b = acc[ai][bj][m][1];
                    a = a * (f32x4){(float)g[0], (float)g[1], (float)g[2], (float)g[3]}; b = b * (f32x4){(float)g[4], (float)g[5], (float)g[6], (float)g[7]};
                    if (MODE == 1) { const h8v t = tv[m][bj]; a += (f32x4){(float)t[0], (float)t[1], (float)t[2], (float)t[3]}; b += (f32x4){(float)t[4], (float)t[5], (float)t[6], (float)t[7]}; }
                    st16(MODE == 0 ? T : YM, off, pack8(a, b)); }
            asm volatile("" ::: "memory"); }
    }
};
struct EpiYF {
    static constexpr bool PERM = false, AFTER_DRAIN = false;
    unsigned char* ws;
    __device__ __forceinline__ void operator()(const f32x4 (&acc)[2][2][4][2], const Unit& u, int wr, int wc, int fr, int fq) const {
        PG8_OPAQUE(fr, fq);
        const unsigned row0 = (unsigned)(u.pm * 256 + wr * 64) + (unsigned)frx, col0 = u.pn * 256u + wc * 32u + 4u * fqx, o0 = row0 * 4096u + col0 * 4u; unsigned char* Y = ws + WS_Y;
#pragma unroll
        for (int ai = 0; ai < 2; ++ai)
#pragma unroll
            for (int m = 0; m < 4; ++m) {
#pragma unroll
                for (int bj = 0; bj < 2; ++bj)
#pragma unroll
                    for (int n = 0; n < 2; ++n) *(f32x4*)(Y + (o0 + (unsigned)(ai * 128 + m * 16) * 4096u + bj * 512u + n * 64u)) = acc[ai][bj][m][n]; }
    }
};
}

struct MapIn { __device__ int operator()(int n) const { const int t = n >> 8, tc = n & 255, bj = tc >> 7, uu = tc & 127;
    if (t == 0) return n;
    if (t == 1) return uu < 64 ? C_KVLAT + 64 * bj + uu : (uu < 80 ? C_KROPE + 16 * bj + (uu - 64) : -1);
    if (t < 4) return C_ZMLA + (n - 512);
    if (t < 8) return (t < 6 ? C_QMB : C_KMB) + 256 * (t & 1) + 64 * (uu >> 5) + 32 * bj + (uu & 31);
    if (t < 10) return C_VMB + (n - 2048);
    if (t < 12) return C_ZMB + (n - 2560);
    if (t < 16) return C_GA + (n - 3072);
    return C_GB + (n - 4096); } };
struct MapUq { __device__ int operator()(int n) const { const int t = n >> 8, tc = n & 255, bj = tc >> 7, uu = tc & 127;
    if (t < 2) return 96 * (4 * t + (tc >> 6)) + (tc & 63);
    return 96 * (uu >> 4) + 64 + 16 * bj + (uu & 15); } };
struct MapUkv { __device__ int operator()(int n) const { const int t = n >> 8, tc = n & 255; return 128 * (4 * (t & 1) + (tc >> 6)) + (t < 2 ? 0 : 64) + (tc & 63); } };
struct MapId { __device__ int operator()(int n) const { return n; } };
template <class Map> __device__ __forceinline__ void wt_items(const float* W, int ldw, int Kreal, int K, int N, unsigned short* WT, const float* kscale, Map map, LAS float* scr, int gw, int ngw, int lane) {
    const int nblk = N / 32, nitems = (K / 64) * nblk;
    for (int it = gw; it < nitems; it += ngw) {
        const int kb = it / nblk, nb = it % nblk, k0 = 64 * kb, n0 = 32 * nb; const int src = map(n0 + (lane & 31));
#pragma unroll 8
        for (int i = 0; i < 32; ++i) { const int kk = 2 * i + (lane >> 5), k = k0 + kk; float v = 0.f; if (src >= 0 && k < Kreal) { v = W[(size_t)k * ldw + src]; if (kscale) v *= kscale[k]; } scr[kk * 33 + (lane & 31)] = v; }
        asm volatile("s_waitcnt lgkmcnt(0)" ::: "memory");
        const int c = lane & 7;
#pragma unroll
        for (int j = 0; j < 4; ++j) { const int n = (lane >> 3) + 8 * j; const LAS float* s = scr + (8 * c) * 33 + n;
            pg8::u32x4 o; o.x = pg8::pk_h2(s[0 * 33], s[1 * 33]); o.y = pg8::pk_h2(s[2 * 33], s[3 * 33]); o.z = pg8::pk_h2(s[4 * 33], s[5 * 33]); o.w = pg8::pk_h2(s[6 * 33], s[7 * 33]);
            *(pg8::u32x4*)(WT + (size_t)(n0 + n) * K + k0 + 8 * c) = o; }
        asm volatile("s_waitcnt lgkmcnt(0)" ::: "memory");
    }
}
constexpr size_t WT_IN = WS_WT, WT_UQ = WS_WT + 10 * MiB, WT_UKV = WT_UQ + 512 * 1024, WT_OA = WS_WT + 11 * MiB, WT_OB = WS_WT + 12 * MiB, WT_OUT = WS_WT + 13 * MiB;
__device__ __forceinline__ void ph_weights(const Params& p, LAS unsigned char* lds, int gw, int ngw, int wave, int lane) {
    LAS float* scr = (LAS float*)(lds + wave * 16384);
    wt_items(p.w_in, D_IN, 1024, 1024, 5120, (unsigned short*)(p.ws + WT_IN), nullptr, MapIn(), scr, gw, ngw, lane);
    wt_items(p.w_uq, 768, 256, 256, 768, (unsigned short*)(p.ws + WT_UQ), p.g_q, MapUq(), scr, gw, ngw, lane);
    wt_items(p.w_ukv, 1024, 128, 256, 1024, (unsigned short*)(p.ws + WT_UKV), p.g_kv, MapUkv(), scr, gw, ngw, lane);
    wt_items(p.w_o_mla, 1024, 512, 512, 1024, (unsigned short*)(p.ws + WT_OA), nullptr, MapId(), scr, gw, ngw, lane);
    wt_items(p.w_o_moba, 1024, 512, 512, 1024, (unsigned short*)(p.ws + WT_OB), nullptr, MapId(), scr, gw, ngw, lane);
    wt_items(p.w_out, 1024, 1024, 1024, 1024, (unsigned short*)(p.ws + WT_OUT), nullptr, MapId(), scr, gw, ngw, lane);
}

namespace att {
typedef _Float16 h8 __attribute__((ext_vector_type(8)));
typedef short s4 __attribute__((ext_vector_type(4)));
typedef short s8 __attribute__((ext_vector_type(8)));
typedef float f16v __attribute__((ext_vector_type(16)));
typedef unsigned u4 __attribute__((ext_vector_type(4)));
typedef short v4i16_t __attribute__((ext_vector_type(4)));
constexpr int KBUF = 16384, VBUF = 8192;
constexpr int NBUF = 3;
constexpr int L_K = 0, L_V = NBUF * KBUF, L_WS = L_V + NBUF * VBUF, L_OST = L_WS + 8 * 256, L_TB = L_OST + 8 * 4096, L_UN = L_TB + 256, L_END = L_UN + 64;
constexpr float THR = 8.f;
#ifndef PROBE_ABL
#define PROBE_ABL 0
#endif
#ifndef ATT_STAGGER
#define ATT_STAGGER 0
#endif
constexpr bool STAGGER = ATT_STAGGER;
__device__ __forceinline__ int crow(int r, int hi) { return (r & 3) + 8 * (r >> 2) + 4 * hi; }
template <int DK> __device__ __forceinline__ int kaddr(int row, int ch) { return DK == 64 ? row * 128 + ((ch ^ ((row >> 1) & 7)) << 4) : row * 256 + ((ch ^ (row & 15)) << 4); }
__device__ __forceinline__ s4 vtr(const LAS unsigned char* p) { return __builtin_bit_cast(s4, __builtin_amdgcn_ds_read_tr16_b64_v4i16((LAS v4i16_t*)p)); }
__device__ __forceinline__ float swapmax(float m) { auto rr = __builtin_amdgcn_permlane32_swap(__float_as_uint(m), __float_as_uint(m), false, false); return fmaxf(__uint_as_float(rr[0]), __uint_as_float(rr[1])); }
__device__ __forceinline__ float swapsum(float m) { auto rr = __builtin_amdgcn_permlane32_swap(__float_as_uint(m), __float_as_uint(m), false, false); return __uint_as_float(rr[0]) + __uint_as_float(rr[1]); }
__device__ __forceinline__ void glds16(const void* g, unsigned lds_base) { unsigned sv;
    asm volatile("s_mov_b32 %0, m0\n\ts_mov_b32 m0, %2\n\ts_nop 0\n\tglobal_load_lds_dwordx4 %1, off\n\ts_mov_b32 m0, %0" : "=&s"(sv) : "v"(g), "s"(lds_base) : "memory"); }
__device__ __forceinline__ float max3f(float a, float b, float c) { float r; asm("v_max3_f32 %0, %1, %2, %3" : "=v"(r) : "v"(a), "v"(b), "v"(c)); return r; }
__device__ __forceinline__ unsigned pkh(float lo, float hi) { typedef _Float16 h2 __attribute__((ext_vector_type(2))); h2 v; v[0] = (_Float16)lo; v[1] = (_Float16)hi; return __builtin_bit_cast(unsigned, v); }

template <int DK, bool MOBA, int ABL = 0>
__device__ __forceinline__ void attn_unit(unsigned char* ws, int b, int h, int qb, LAS unsigned char* lds, bool dry = false) {
    constexpr int ND = DK / 16, QP = MOBA ? 512 : 768, QH = MOBA ? 64 : 96;
    int tid_ = threadIdx.x; asm volatile("" : "+v"(tid_));
    const int tid = tid_, lane = tid & 63, r32 = lane & 31, hi = lane >> 5; const int wid = __builtin_amdgcn_readfirstlane(tid >> 6);
    const _Float16* Qg = (const _Float16*)(ws + (MOBA ? WS_QMB : WS_QMLA)); const _Float16* Kg = (const _Float16*)(ws + (MOBA ? WS_KMB : WS_KN));
    const _Float16* Vg = (const _Float16*)(ws + (MOBA ? WS_VMB : WS_VM)); const _Float16* Pg = (const _Float16*)(ws + WS_KPE); _Float16* Zg = (_Float16*)(ws + (MOBA ? WS_ZMB : WS_ZMLA));
    const size_t rowbase = (size_t)b * SEQ; const int q0 = qb * 256, qw0 = q0 + wid * 32, qrow = qw0 + r32;
    LAS float* wsf = (LAS float*)(lds + L_WS) + wid * 64; LAS int* tb = (LAS int*)(lds + L_TB); LAS unsigned* un = (LAS unsigned*)(lds + L_UN);
    h8 qr[ND];
#pragma unroll
    for (int d0 = 0; d0 < ND; ++d0) qr[d0] = *(const h8*)(Qg + (rowbase + qrow) * QP + h * QH + d0 * 16 + hi * 8);
#pragma unroll
    for (int d0 = 0; d0 < ND; ++d0) asm volatile("" : "+v"(qr[d0]));
    unsigned sel = 0u, blocks = (2u << qb) - 1u;
    if (MOBA) {
        const float* km = (const float*)(ws + WS_KMEAN) + (size_t)b * 16 * 512 + h * 64 + hi * 8;
        float g0 = -INFINITY, g1 = -INFINITY, g2 = -INFINITY; int i0 = -1, i1 = -1, i2 = -1;
        for (int m = 0; m < qb; ++m) {
            float part = 0.f;
#pragma unroll
            for (int d0 = 0; d0 < 4; ++d0) { const float4 a = *(const float4*)(km + m * 512 + d0 * 16), c = *(const float4*)(km + m * 512 + d0 * 16 + 4);
                part += (float)qr[d0][0] * a.x + (float)qr[d0][1] * a.y + (float)qr[d0][2] * a.z + (float)qr[d0][3] * a.w + (float)qr[d0][4] * c.x + (float)qr[d0][5] * c.y + (float)qr[d0][6] * c.z + (float)qr[d0][7] * c.w; }
            const float g = swapsum(part);
            if (g > g0) { g2 = g1; i2 = i1; g1 = g0; i1 = i0; g0 = g; i0 = m; }
            else if (g > g1) { g2 = g1; i2 = i1; g1 = g; i1 = m; }
            else if (g > g2) { g2 = g; i2 = m; }
        }
        if (i0 >= 0) sel |= 1u << i0; if (i1 >= 0) sel |= 1u << i1; if (i2 >= 0) sel |= 1u << i2;
        unsigned uw = sel;
#pragma unroll
        for (int o = 1; o < 64; o <<= 1) uw |= (unsigned)__shfl_xor((int)uw, o);
        if (lane == 0) un[wid] = uw;
        __syncthreads();
        unsigned ua = 0u;
#pragma unroll
        for (int w = 0; w < 8; ++w) ua |= un[w];
        blocks = (unsigned)__builtin_amdgcn_readfirstlane((int)(ua | (1u << qb)));
    }
    const int NT = 4 * __builtin_popcount(blocks);
    if (tid < 64 && tid < NT) { unsigned bm = blocks; for (int k = 0; k < (tid >> 2); ++k) bm &= bm - 1u; tb[tid] = (__builtin_ctz(bm) << 8) + ((tid & 3) << 6); }
    __syncthreads();
    const unsigned char* kbu = (const unsigned char*)(Kg + rowbase * 512 + h * 64); const unsigned char* vbu = (const unsigned char*)(Vg + rowbase * 512 + h * 64); const unsigned char* pbu = (const unsigned char*)(Pg + rowbase * 32);
    unsigned ksrc0, ksrc1 = 0u; bool kact0 = true, kact1 = true, kpe0 = false, kpe1 = false;
    if (DK == 96) { const int r0 = 4 * wid + (lane >> 4), r1 = r0 + 32, c0 = (lane & 15) ^ (r0 & 15), c1 = (lane & 15) ^ (r1 & 15);
        kact0 = c0 < 12; kpe0 = c0 >= 8; ksrc0 = kpe0 ? (unsigned)(r0 * 32 + (c0 - 8) * 8) * 2u : (unsigned)(r0 * 512 + c0 * 8) * 2u;
        kact1 = c1 < 12; kpe1 = c1 >= 8; ksrc1 = kpe1 ? (unsigned)(r1 * 32 + (c1 - 8) * 8) * 2u : (unsigned)(r1 * 512 + c1 * 8) * 2u;
    } else { const int r0 = 8 * wid + (lane >> 3), c0 = (lane & 7) ^ ((r0 >> 1) & 7); ksrc0 = (unsigned)(r0 * 512 + c0 * 8) * 2u; }
    const unsigned vsrc = (unsigned)((16 * (wid & 3) + (lane >> 2)) * 512 + (wid >> 2) * 32 + (lane & 3) * 8) * 2u;
    constexpr int NDMA = (DK == 96) ? 3 : 2;
#define ATT_GLDS(src, dst) glds16((const void*)(src), (unsigned)__builtin_amdgcn_readfirstlane((int)(unsigned)(size_t)(dst)))
#define ATT_DMA(kb, buf) do { const unsigned kb_ = (unsigned)(kb); LAS unsigned char* kd_ = lds + L_K + (buf) * KBUF; \
        if (DK == 96) { if (kact0) ATT_GLDS(kpe0 ? pbu + (ksrc0 + kb_ * 64u) : kbu + (ksrc0 + kb_ * 1024u), kd_ + wid * 1024); \
                        if (kact1) ATT_GLDS(kpe1 ? pbu + (ksrc1 + kb_ * 64u) : kbu + (ksrc1 + kb_ * 1024u), kd_ + 8192 + wid * 1024); } \
        else ATT_GLDS(kbu + (ksrc0 + kb_ * 1024u), kd_ + wid * 1024); \
        ATT_GLDS(vbu + (vsrc + kb_ * 1024u), lds + L_V + (buf) * VBUF + wid * 1024); } while (0)
#define ATT_WAITV(n) asm volatile("s_waitcnt vmcnt(" #n ")" ::: "memory")
#define ATT_BAR() do { asm volatile("s_waitcnt lgkmcnt(0)" ::: "memory"); __builtin_amdgcn_s_barrier(); asm volatile("" ::: "memory"); } while (0)
    const int vro = ((lane >> 4) & 1) * 32 + (lane & 3) * 8 + (4 * hi + ((lane & 15) >> 2)) * 64;
    float l_reg = 0.f; bool init = false; f16v o[2]; o[0] = f16v{}; o[1] = f16v{}; f16v negm = f16v{}; asm volatile("" : "+v"(negm));
    ATT_DMA(tb[0], 0);
    if (NT > 1) ATT_DMA(tb[1], 1);
    if (NT > 1) { if (NDMA == 3) ATT_WAITV(3); else ATT_WAITV(2); } else ATT_WAITV(0);
    ATT_BAR();
    if (STAGGER && wid >= 4) __builtin_amdgcn_s_barrier();
    int cur = 0;
    for (int t = 0; t < NT; ++t) {
        const int kb = tb[t], nxt = (cur == NBUF - 1) ? 0 : cur + 1;
        const int nx2 = (nxt == NBUF - 1) ? 0 : nxt + 1;
        if (ABL != 1 && t + 2 < NT) ATT_DMA(tb[t + 2], nx2);
        const bool ownblk = kb >= q0; const bool rowsel = MOBA ? (ownblk || ((sel >> (kb >> 8)) & 1u)) : true;
        const bool live = (kb <= qw0 + 31) && __any(rowsel);
        f16v p0, p1;
        if (live) {
            const LAS unsigned char* kl = lds + L_K + cur * KBUF;
            h8 kf[2 * ND];
#pragma unroll
            for (int d0 = 0; d0 < ND; ++d0) { kf[2 * d0] = *(const LAS h8*)(kl + kaddr<DK>(r32, 2 * d0 + hi)); kf[2 * d0 + 1] = *(const LAS h8*)(kl + kaddr<DK>(32 + r32, 2 * d0 + hi)); }
            __builtin_amdgcn_sched_barrier(0);
#pragma unroll
            for (int d0 = 0; d0 < ND; ++d0) { if (ABL == 3) { if (d0 == 0) { p0 = negm; p1 = negm; } asm volatile("" :: "v"(kf[2 * d0]), "v"(kf[2 * d0 + 1])); continue; }
                p0 = __builtin_amdgcn_mfma_f32_32x32x16_f16(kf[2 * d0], qr[d0], d0 == 0 ? negm : p0, 0, 0, 0); p1 = __builtin_amdgcn_mfma_f32_32x32x16_f16(kf[2 * d0 + 1], qr[d0], d0 == 0 ? negm : p1, 0, 0, 0); }
            if (kb + 63 > qw0) {
#pragma unroll
                for (int r = 0; r < 16; ++r) { const int kv = kb + crow(r, hi); if (kv > qrow) p0[r] = -INFINITY; if (kv + 32 > qrow) p1[r] = -INFINITY; }
            }
            asm volatile("s_nop 15\n\ts_nop 7" : "+v"(p0), "+v"(p1));
            float pa = max3f(p0[0], p0[1], p1[0]), pb = max3f(p0[2], p0[3], p1[1]); pa = max3f(pa, p1[2], p1[3]);
#pragma unroll
            for (int r = 4; r < 16; r += 4) { pa = max3f(pa, p0[r], p0[r + 1]); pb = max3f(pb, p0[r + 2], p0[r + 3]); pa = max3f(pa, p1[r], p1[r + 1]); pb = max3f(pb, p1[r + 2], p1[r + 3]); }
            float pmax = swapmax(fmaxf(pa, pb)); if (ABL == 2) pmax = p0[0];
            if (MOBA && !rowsel) pmax = -INFINITY;
            const bool move = init ? (pmax > THR) : (pmax > -INFINITY);
            if (__any(move)) {
                const float dl = move ? (init ? fmaxf(pmax, 0.f) : pmax) : 0.f; const float alpha = (move && init) ? __builtin_amdgcn_exp2f(-dl) : 1.f;
                init = init || move; l_reg *= alpha;
#pragma unroll
                for (int r = 0; r < 16; ++r) { p0[r] -= dl; p1[r] -= dl; negm[r] -= dl; }
                if (hi == 0) wsf[r32] = alpha; asm volatile("s_waitcnt lgkmcnt(0)" ::: "memory");
#pragma unroll
                for (int r = 0; r < 16; ++r) { const float a = wsf[crow(r, hi)]; o[0][r] *= a; o[1][r] *= a; }
            }
        }
        if (STAGGER) ATT_BAR();
        if (live) {
            const LAS unsigned char* vl = lds + L_V + cur * VBUF + vro; s4 vlo[8], vhi[8];
#pragma unroll
            for (int i = 0; i < 8; ++i) { vlo[i] = vtr(vl + (i >> 2) * 4096 + (i & 3) * 1024); vhi[i] = vtr(vl + (i >> 2) * 4096 + (i & 3) * 1024 + 512); }
            __builtin_amdgcn_sched_barrier(0);
            float ps = 0.f;
#pragma unroll
            for (int r = 0; r < 16; ++r) { if (ABL != 2) { p0[r] = __builtin_amdgcn_exp2f(p0[r]); p1[r] = __builtin_amdgcn_exp2f(p1[r]); ps += p0[r] + p1[r]; } }
            if (MOBA && !rowsel) ps = 0.f;
            l_reg += swapsum(ps);
            u4 pw[4];
#pragma unroll
            for (int k = 0; k < 2; ++k) { pw[k] = (u4){pkh(p0[8 * k], p0[8 * k + 1]), pkh(p0[8 * k + 2], p0[8 * k + 3]), pkh(p0[8 * k + 4], p0[8 * k + 5]), pkh(p0[8 * k + 6], p0[8 * k + 7])};
                pw[2 + k] = (u4){pkh(p1[8 * k], p1[8 * k + 1]), pkh(p1[8 * k + 2], p1[8 * k + 3]), pkh(p1[8 * k + 4], p1[8 * k + 5]), pkh(p1[8 * k + 6], p1[8 * k + 7])}; }
            if (MOBA) { const unsigned keep = rowsel ? 0xffffffffu : 0u;
#pragma unroll
                for (int k = 0; k < 4; ++k) pw[k] &= keep; }
#pragma unroll
            for (int d0 = 0; d0 < 2; ++d0)
#pragma unroll
                for (int k = 0; k < 4; ++k) { const s4 lo = vlo[d0 * 4 + k], hh = vhi[d0 * 4 + k];
                    const s8 vv = (s8){lo[0], lo[1], lo[2], lo[3], hh[0], hh[1], hh[2], hh[3]};
                    if (ABL == 3) { asm volatile("" :: "v"(pw[k]), "v"(vv)); continue; }
                    o[d0] = __builtin_amdgcn_mfma_f32_32x32x16_f16(__builtin_bit_cast(h8, pw[k]), __builtin_bit_cast(h8, vv), o[d0], 0, 0, 0); }
        }
        if (t + 2 < NT) { if (NDMA == 3) ATT_WAITV(3); else ATT_WAITV(2); } else ATT_WAITV(0);
        if (ABL != 4) ATT_BAR();
        cur = nxt;
    }
    if (STAGGER && wid < 4) __builtin_amdgcn_s_barrier();
    if (hi == 0) wsf[32 + r32] = l_reg; asm volatile("s_waitcnt lgkmcnt(0)" ::: "memory");
    LAS _Float16* stg = (LAS _Float16*)(lds + L_OST) + wid * 2048;
#pragma unroll
    for (int r = 0; r < 16; ++r) { const int orow = crow(r, hi); const float rl = 1.f / wsf[32 + orow];
        stg[orow * 64 + r32] = (_Float16)(o[0][r] * rl); stg[orow * 64 + 32 + r32] = (_Float16)(o[1][r] * rl); }
    asm volatile("s_waitcnt lgkmcnt(0)" ::: "memory");
    int lane_e = lane; asm volatile("" : "+v"(lane_e));
    unsigned char* zbu = (unsigned char*)(Zg + (rowbase + qw0) * 512 + h * 64);
#pragma unroll
    for (int i = 0; i < 4; ++i) { const int row = i * 8 + (lane_e >> 3), ch = lane_e & 7; const h8 v = *(const LAS h8*)(stg + row * 64 + ch * 8);
        _Float16* zp = (_Float16*)(zbu + (unsigned)(row * 512 + ch * 8) * 2u); const h8 z = *(const h8*)zp; h8 ov;
#pragma unroll
        for (int j = 0; j < 8; ++j) ov[j] = (_Float16)((float)v[j] * (float)z[j]);
        if (!dry) *(h8*)zp = ov; }
    __syncthreads();
#undef ATT_GLDS
#undef ATT_DMA
#undef ATT_WAITV
#undef ATT_BAR
}

__device__ __forceinline__ void attn_phase(unsigned char* ws, LAS unsigned char* lds, int vb, int nvb) {
    const int vcu = (nvb % 8 == 0) ? (vb % 8) * (nvb / 8) + vb / 8 : vb; const int per = (1024 + nvb - 1) / nvb;
    for (int it = vcu * per; it < (vcu + 1) * per && it < 1024; ++it) {
        const int bh = it >> 3, pr = it & 7, b = bh >> 3, h = bh & 7;
        if (PROBE == 2) for (int uu = 0; uu < 2; ++uu) attn_unit<96, false, PROBE_ABL>(ws, b, h, uu ? 15 - pr : pr, lds, true);
        for (int uu = 0; uu < 2; ++uu) attn_unit<96, false>(ws, b, h, uu ? 15 - pr : pr, lds);
        if (PROBE == 3) for (int uu = 0; uu < 2; ++uu) attn_unit<64, true, PROBE_ABL>(ws, b, h, uu ? 15 - pr : pr, lds, true);
        for (int uu = 0; uu < 2; ++uu) attn_unit<64, true>(ws, b, h, uu ? 15 - pr : pr, lds);
    }
}
}

constexpr int RING_BYTES = 131072, MISC_OFF = RING_BYTES + 320, LDS_BYTES = 147456;
constexpr int CW_BAR = 4096;

__global__ void __launch_bounds__(512, 2) mega(Params p) {
    extern __shared__ __attribute__((aligned(16))) unsigned char lds[];
    const int vb = blockIdx.x, nvb = gridDim.x, tid = threadIdx.x, lane = tid & 63, wave = tid >> 6;
    const int gtid = vb * 512 + tid, gsize = nvb * 512, gwave = vb * 8 + wave, nwaves = nvb * 8;
    volatile LAS unsigned* misc = (volatile LAS unsigned*)((LAS unsigned char*)lds + MISC_OFF);
    if (tid < 32) misc[tid] = 0u;
    __syncthreads();
    XcdBarrier bar = xcd_barrier_post((unsigned*)(p.ws + WS_CTL) + CW_BAR, misc + 8);
    LAS unsigned char* ldsl = (LAS unsigned char*)lds;
    { int t_ = threadIdx.x; asm volatile("" : "+v"(t_)); ph_prep(p, vb * 512 + t_, gsize); ph_weights(p, ldsl, vb * 8 + (t_ >> 6), nwaves, t_ >> 6, t_ & 63); }
    xcd_barrier(bar);
    for (int rep4 = 0; rep4 < (PROBE == 4 ? 2 : 1); ++rep4) { int t_ = threadIdx.x; asm volatile("" : "+v"(t_)); ph_hnorm(p, vb * 8 + (t_ >> 6), nwaves, t_ & 63); }
    xcd_barrier(bar);
    {
        pg8::Gemm g{(const pg8::bf16_t*)(p.ws + WS_H), (const pg8::bf16_t*)(p.ws + WT_IN), M_, 5120, 1024}; pg8::StaticOrder S; S.init(M_, 5120, nvb, vb);
        for (int rep = (PROBE == 1 ? 1 : 0); rep >= 0; --rep) { pg8::EpiInF E{p.ws, p.b_merge, rep}; pg8::gemm_phase<pg8::EpiInF, pg8::StaticOrder, true, true>(ldsl, g, S, E); }
    }
    xcd_barrier(bar);
    for (int rep4 = 0; rep4 < (PROBE == 4 ? 2 : 1); ++rep4) {
        pg8::Gemm g{(const pg8::bf16_t*)(p.ws + WS_QLAT), (const pg8::bf16_t*)(p.ws + WT_UQ), M_, 768, 256}; pg8::StaticOrder S; S.init(M_, 768, nvb, vb);
        pg8::EpiUqF E{p.ws}; pg8::gemm_phase<pg8::EpiUqF, pg8::StaticOrder, true, true>(ldsl, g, S, E);
    }
    for (int rep4 = 0; rep4 < (PROBE == 4 ? 2 : 1); ++rep4) {
        pg8::Gemm g{(const pg8::bf16_t*)(p.ws + WS_KVL), (const pg8::bf16_t*)(p.ws + WT_UKV), M_, 1024, 256}; pg8::StaticOrder S; S.init(M_, 1024, nvb, vb);
        pg8::EpiUkvF E{p.ws}; pg8::gemm_phase<pg8::EpiUkvF, pg8::StaticOrder, true, true>(ldsl, g, S, E);
    }
    xcd_barrier(bar);
    att::attn_phase(p.ws, ldsl, vb, nvb);
    xcd_barrier(bar);
    for (int rep4 = 0; rep4 < (PROBE == 4 ? 2 : 1); ++rep4) {
        pg8::Gemm g{(const pg8::bf16_t*)(p.ws + WS_ZMLA), (const pg8::bf16_t*)(p.ws + WT_OA), M_, 1024, 512}; pg8::StaticOrder S; S.init(M_, 1024, nvb, vb);
        pg8::EpiYabF<0> E{p.ws}; pg8::gemm_phase<pg8::EpiYabF<0>, pg8::StaticOrder, true, true>(ldsl, g, S, E);
    }
    for (int rep4 = 0; rep4 < (PROBE == 4 ? 2 : 1); ++rep4) {
        pg8::Gemm g{(const pg8::bf16_t*)(p.ws + WS_ZMB), (const pg8::bf16_t*)(p.ws + WT_OB), M_, 1024, 512}; pg8::StaticOrder S; S.init(M_, 1024, nvb, vb);
        pg8::EpiYabF<1> E{p.ws}; pg8::gemm_phase<pg8::EpiYabF<1>, pg8::StaticOrder, true, true>(ldsl, g, S, E);
    }
    xcd_barrier(bar);
    for (int rep4 = 0; rep4 < (PROBE == 4 ? 2 : 1); ++rep4) {
        pg8::Gemm g{(const pg8::bf16_t*)(p.ws + WS_YM), (const pg8::bf16_t*)(p.ws + WT_OUT), M_, 1024, 1024}; pg8::StaticOrder S; S.init(M_, 1024, nvb, vb);
        pg8::EpiYF E{p.ws}; pg8::gemm_phase<pg8::EpiYF, pg8::StaticOrder, true, true>(ldsl, g, S, E);
    }
    xcd_barrier(bar);
    for (int rep4 = 0; rep4 < (PROBE == 4 ? 2 : 1); ++rep4) { int t_ = threadIdx.x; asm volatile("" : "+v"(t_)); ph_final(p, vb * 8 + (t_ >> 6), nwaves, t_ & 63); }
}

template <int PH> __global__ void __launch_bounds__(512, 2) k_ph(Params p) {
    extern __shared__ __attribute__((aligned(16))) unsigned char lds[];
    const int vb = blockIdx.x, nvb = gridDim.x, tid = threadIdx.x, lane = tid & 63, wave = tid >> 6;
    const int gtid = vb * 512 + tid, gsize = nvb * 512, gwave = vb * 8 + wave, nwaves = nvb * 8;
    if (PH == 0) ph_prep(p, gtid, gsize);
    if (PH == 1) ph_hnorm(p, gwave, nwaves, lane);
    if (PH == 2) { EpiIn e{p.ws, p.b_merge}; gemm_naive<h16, EpiIn>((const h16*)(p.ws + WS_H), DM, p.w_in, D_IN, nullptr, DM, D_IN, e, (float*)lds, vb, nvb); }
    if (PH == 3) { EpiUq e{p.ws}; gemm_naive<h16, EpiUq>((const h16*)(p.ws + WS_QLAT), 256, p.w_uq, 768, p.g_q, 256, 768, e, (float*)lds, vb, nvb); }
    if (PH == 4) { EpiUkv e{p.ws}; gemm_naive<h16, EpiUkv>((const h16*)(p.ws + WS_KVL), 256, p.w_ukv, 1024, p.g_kv, 128, 1024, e, (float*)lds, vb, nvb); }
    if (PH == 5) ph_kmean(p, gtid, gsize);
    if (PH == 6) ph_attn_mla_naive(p, vb, nvb);
    if (PH == 7) ph_attn_moba_naive(p, vb, nvb);
    if (PH == 8) { EpiYa e{p.ws}; gemm_naive<h16, EpiYa>((const h16*)(p.ws + WS_ZMLA), 512, p.w_o_mla, 1024, nullptr, 512, 1024, e, (float*)lds, vb, nvb); }
    if (PH == 9) { EpiYb e{p.ws}; gemm_naive<h16, EpiYb>((const h16*)(p.ws + WS_ZMB), 512, p.w_o_moba, 1024, nullptr, 512, 1024, e, (float*)lds, vb, nvb); }
    if (PH == 10) { EpiY e{p.ws}; gemm_naive<h16, EpiY>((const h16*)(p.ws + WS_YM), 1024, p.w_out, 1024, nullptr, 1024, 1024, e, (float*)lds, vb, nvb); }
    if (PH == 11) ph_final(p, gwave, nwaves, lane);
}

extern "C" void kernel_launch(void* const* d_in, const int* in_sizes, int n_in, void* d_out, int out_size, void* d_ws, size_t ws_size, hipStream_t stream) {
    if (n_in != 16 || out_size != M_ * DM || ws_size < WS_END) { fprintf(stderr, "kernel_launch: unexpected shapes (n_in %d, out %d, ws %zu)\n", n_in, out_size, ws_size); return; }
    Params p{};
    p.x = (const float*)d_in[0]; p.c = (const float*)d_in[1]; p.pos = (const int*)d_in[2]; p.w_ada = (const float*)d_in[3]; p.b_ada = (const float*)d_in[4];
    p.g_pre = (const float*)d_in[5]; p.g_post = (const float*)d_in[6]; p.w_in = (const float*)d_in[7]; p.g_q = (const float*)d_in[8]; p.w_uq = (const float*)d_in[9];
    p.g_kv = (const float*)d_in[10]; p.w_ukv = (const float*)d_in[11]; p.w_o_mla = (const float*)d_in[12]; p.w_o_moba = (const float*)d_in[13]; p.b_merge = (const float*)d_in[14]; p.w_out = (const float*)d_in[15];
    p.out = (float*)d_out; p.ws = (unsigned char*)d_ws;
    static int grid = 0;
    if (grid == 0) {
        int dev = 0, cus = 0, per_cu = 0;
        if (hipGetDevice(&dev) != hipSuccess || hipDeviceGetAttribute(&cus, hipDeviceAttributeMultiprocessorCount, dev) != hipSuccess) { fprintf(stderr, "kernel_launch: device query failed\n"); grid = -1; return; }
        if (hipFuncSetAttribute((const void*)mega, hipFuncAttributeMaxDynamicSharedMemorySize, LDS_BYTES) != hipSuccess) { fprintf(stderr, "kernel_launch: hipFuncSetAttribute failed\n"); grid = -1; return; }
        if (hipOccupancyMaxActiveBlocksPerMultiprocessor(&per_cu, (const void*)mega, 512, LDS_BYTES) != hipSuccess || per_cu < 1) { fprintf(stderr, "kernel_launch: occupancy query says %d\n", per_cu); }
        (void)hipGetLastError();
        grid = cus;
    }
    if (grid < 0) return;
    (void)hipMemsetAsync(d_ws, 0, ZERO_BYTES, stream);
#if defined(MULTI_LAUNCH)
    const int G = 1024, L = 32768;
    hipLaunchKernelGGL(k_ph<0>, dim3(G), dim3(512), L, stream, p);
    hipLaunchKernelGGL(k_ph<1>, dim3(G), dim3(512), L, stream, p);
    hipLaunchKernelGGL(k_ph<2>, dim3(G), dim3(512), L, stream, p);
    hipLaunchKernelGGL(k_ph<3>, dim3(G), dim3(512), L, stream, p);
    hipLaunchKernelGGL(k_ph<4>, dim3(G), dim3(512), L, stream, p);
    hipLaunchKernelGGL(k_ph<5>, dim3(G), dim3(512), L, stream, p);
    hipLaunchKernelGGL(k_ph<6>, dim3(G), dim3(512), L, stream, p);
    hipLaunchKernelGGL(k_ph<7>, dim3(G), dim3(512), L, stream, p);
    hipLaunchKernelGGL(k_ph<8>, dim3(G), dim3(512), L, stream, p);
    hipLaunchKernelGGL(k_ph<9>, dim3(G), dim3(512), L, stream, p);
    hipLaunchKernelGGL(k_ph<10>, dim3(G), dim3(512), L, stream, p);
    hipLaunchKernelGGL(k_ph<11>, dim3(G), dim3(512), L, stream, p);
#else
    hipLaunchKernelGGL(mega, dim3(grid), dim3(512), LDS_BYTES, stream, p);
#endif
}
```

```cpp
#include <hip/hip_runtime.h>
#include <cstdio>
#ifndef PROBE
#define PROBE 0
#endif
#include <cstdint>

typedef _Float16 h16;
typedef _Float16 h16x4 __attribute__((ext_vector_type(4)));
typedef _Float16 h2n __attribute__((ext_vector_type(2)));

constexpr int NB = 16, SEQ = 4096, DM = 1024, M_ = NB * SEQ, NH = 8;
constexpr int D_IN = 5024;
constexpr int C_QLAT = 0, C_KVLAT = 256, C_KROPE = 384, C_ZMLA = 416, C_QMB = 928, C_KMB = 1440, C_VMB = 1952, C_ZMB = 2464, C_GA = 2976, C_GB = 4000;
constexpr float EPS = 1e-6f;
constexpr float LOG2E = 1.4426950408889634f;
constexpr float SC_MLA = 0.10206207261596577f * LOG2E;
constexpr float SC_MB = 0.125f * LOG2E;

constexpr size_t MiB = 1u << 20;
constexpr size_t WS_CTL = 0, WS_KMEAN = 512 * 1024, WS_SSQ = 1 * MiB, WS_SSQY = WS_SSQ + 2 * (size_t)M_ * 4, ZERO_BYTES = 2 * MiB;
constexpr size_t WS_MOD = 2 * MiB, WS_TAB = 4 * MiB, WS_WT = 20 * MiB;
constexpr size_t WS_H = 36 * MiB, WS_KN = 36 * MiB, WS_VM = 100 * MiB, WS_T = 36 * MiB;
constexpr size_t WS_QLAT = 164 * MiB, WS_KVL = 196 * MiB, WS_KPE = 228 * MiB, WS_ZMLA = 232 * MiB;
constexpr size_t WS_QMB = 296 * MiB, WS_KMB = 360 * MiB, WS_VMB = 424 * MiB, WS_ZMB = 488 * MiB, WS_YM = 296 * MiB;
constexpr size_t WS_GA = 552 * MiB, WS_GB = 680 * MiB, WS_Y = 552 * MiB, WS_QMLA = 808 * MiB, WS_END = 904 * MiB;

struct Params {
    const float *x, *c; const int* pos; const float *w_ada, *b_ada, *g_pre, *g_post, *w_in, *g_q, *w_uq, *g_kv, *w_ukv, *w_o_mla, *w_o_moba, *b_merge, *w_out;
    float* out; unsigned char* ws;
};

__device__ __forceinline__ float wave_sum(float v) {
#pragma unroll
    for (int o = 1; o < 64; o <<= 1) v += __shfl_xor(v, o);
    return v;
}
__device__ __forceinline__ float silu_f(float v) { return v / (1.f + __expf(-v)); }
__device__ __forceinline__ float sigmoid_f(float v) { return 1.f / (1.f + __expf(-v)); }

__device__ void ph_prep(const Params& p, int gtid, int gsize) {
    float* mod = (float*)(p.ws + WS_MOD);
    for (int i = gtid; i < NB * 3072; i += gsize) {
        const int b = i / 3072, j = i % 3072; float s = p.b_ada[j];
        for (int k = 0; k < DM; ++k) { const float cv = p.c[b * DM + k]; s += (cv / (1.f + expf(-cv))) * p.w_ada[(size_t)k * 3072 + j]; }
        mod[i] = s;
    }
    unsigned* tab = (unsigned*)(p.ws + WS_TAB);
    for (int i = gtid; i < M_ * 32; i += gsize) {
        const int m = i >> 5, f = i & 31;
        const double inv = exp2(-(double)f * (13.287712379549449 / 32.0));
        const double a = (double)p.pos[m] * inv;
        const double k = rint(a * 0.15915494309189535);
        const double r = (a - k * 6.283185307179586) - k * 2.4492935982947064e-16;
        { typedef _Float16 h2t __attribute__((ext_vector_type(2))); h2t cs; cs[0] = (_Float16)(float)cos(r); cs[1] = (_Float16)(float)sin(r); tab[i] = __builtin_bit_cast(unsigned, cs); }
    }
}

__device__ void ph_hnorm(const Params& p, int gwave, int nwaves, int lane) {
    const float* mod = (const float*)(p.ws + WS_MOD); h16* H = (h16*)(p.ws + WS_H);
    for (int m = gwave; m < M_; m += nwaves) {
        const int b = m >> 12; const float4* xr = (const float4*)(p.x + (size_t)m * DM);
        float4 v[4]; float ss = 0.f;
#pragma unroll
        for (int j = 0; j < 4; ++j) { v[j] = xr[lane + 64 * j]; ss += (v[j].x * v[j].x + v[j].y * v[j].y) + (v[j].z * v[j].z + v[j].w * v[j].w); }
        ss = wave_sum(ss); const float rstd = 1.f / sqrtf(ss * (1.f / DM) + EPS);
#pragma unroll
        for (int j = 0; j < 4; ++j) {
            const int col = 4 * (lane + 64 * j);
            const float4 g = *(const float4*)(p.g_pre + col), sc = *(const float4*)(mod + b * 3072 + 1024 + col), sh = *(const float4*)(mod + b * 3072 + col);
            h16x4 o; o[0] = (h16)(v[j].x * rstd * g.x * (1.f + sc.x) + sh.x); o[1] = (h16)(v[j].y * rstd * g.y * (1.f + sc.y) + sh.y);
            o[2] = (h16)(v[j].z * rstd * g.z * (1.f + sc.z) + sh.z); o[3] = (h16)(v[j].w * rstd * g.w * (1.f + sc.w) + sh.w);
            *(h16x4*)(H + (size_t)m * DM + col) = o;
        }
    }
}

template <typename AT, class Epi>
__device__ void gemm_naive(const AT* A, int lda, const float* W, int ldw, const float* kscale, int K, int Nv, const Epi& e, float* lds, int vb, int nvb) {
    float (*As)[132] = (float (*)[132])lds; float (*Bs)[132] = (float (*)[132])(lds + 16 * 132);
    const int tid = threadIdx.x, tx = tid & 31, ty = tid >> 5;
    const int ntn = (Nv + 127) / 128, ntiles = (M_ / 128) * ntn;
    for (int tile = vb; tile < ntiles; tile += nvb) {
        const int m0 = (tile / ntn) * 128, n0 = (tile % ntn) * 128;
        float acc[8][4];
#pragma unroll
        for (int i = 0; i < 8; ++i)
#pragma unroll
            for (int j = 0; j < 4; ++j) acc[i][j] = 0.f;
        for (int k0 = 0; k0 < K; k0 += 16) {
#pragma unroll
            for (int i = 0; i < 4; ++i) { const int idx = tid + i * 512, mm = idx >> 4, kk = idx & 15; float a = (float)A[(size_t)(m0 + mm) * lda + k0 + kk]; if (kscale) a *= kscale[k0 + kk]; As[kk][mm] = a; }
#pragma unroll
            for (int i = 0; i < 4; ++i) { const int idx = tid + i * 512, kk = idx >> 7, nn = idx & 127, j = n0 + nn; Bs[kk][nn] = (j < Nv) ? W[(size_t)(k0 + kk) * ldw + e.col(j)] : 0.f; }
            __syncthreads();
#pragma unroll
            for (int kk = 0; kk < 16; ++kk) {
                float a[8], b[4];
#pragma unroll
                for (int i = 0; i < 8; ++i) a[i] = As[kk][ty * 8 + i];
#pragma unroll
                for (int j = 0; j < 4; ++j) b[j] = Bs[kk][tx * 4 + j];
#pragma unroll
                for (int i = 0; i < 8; ++i)
#pragma unroll
                    for (int j = 0; j < 4; ++j) acc[i][j] = fmaf(a[i], b[j], acc[i][j]);
            }
            __syncthreads();
        }
        const int j0 = n0 + tx * 4;
        if (j0 < Nv) {
#pragma unroll
            for (int i = 0; i < 8; ++i) e.store(m0 + ty * 8 + i, j0, acc[i]);
        }
    }
}

struct EpiIn {
    unsigned char* ws; const float* b_merge;
    __device__ int col(int j) const {
        if (j >= C_KROPE && j < C_ZMLA) { const int w = j - C_KROPE; return C_KROPE + (w >> 1) + 16 * (w & 1); }
        if (j >= C_QMB && j < C_VMB) { const int w = (j - C_QMB) & 63, base = j - w; return base + (w >> 1) + 32 * (w & 1); }
        return j;
    }
    __device__ void store(int m, int j0, const float (&v)[4]) const {
        const h2n* tab = (const h2n*)(ws + WS_TAB) + (size_t)m * 32;
        if (j0 < C_KVLAT) {
            h16x4 o; o[0] = (h16)v[0]; o[1] = (h16)v[1]; o[2] = (h16)v[2]; o[3] = (h16)v[3];
            *(h16x4*)((h16*)(ws + WS_QLAT) + (size_t)m * 256 + j0) = o;
            atomicAdd((float*)(ws + WS_SSQ) + m, (v[0] * v[0] + v[1] * v[1]) + (v[2] * v[2] + v[3] * v[3]));
        } else if (j0 < C_KROPE) {
            h16x4 o; o[0] = (h16)v[0]; o[1] = (h16)v[1]; o[2] = (h16)v[2]; o[3] = (h16)v[3];
            *(h16x4*)((h16*)(ws + WS_KVL) + (size_t)m * 256 + (j0 - C_KVLAT)) = o;
            atomicAdd((float*)(ws + WS_SSQ) + M_ + m, (v[0] * v[0] + v[1] * v[1]) + (v[2] * v[2] + v[3] * v[3]));
        } else if (j0 < C_ZMLA) {
            const int i = (j0 - C_KROPE) >> 1; h16* kpe = (h16*)(ws + WS_KPE) + (size_t)m * 32; h16* kvl = (h16*)(ws + WS_KVL) + (size_t)m * 256;
#pragma unroll
            for (int q = 0; q < 2; ++q) { const h2n cs_ = tab[2 * (i + q)]; const float2 cs = make_float2((float)cs_[0], (float)cs_[1]); const float t1 = v[2 * q], t2 = v[2 * q + 1];
                kpe[i + q] = (h16)(t1 * cs.x - t2 * cs.y); kpe[i + q + 16] = (h16)(t2 * cs.x + t1 * cs.y);
                kvl[128 + i + q] = (h16)t1; kvl[128 + 16 + i + q] = (h16)t2; }
            const int z0 = 160 + (j0 - C_KROPE) * 3;
#pragma unroll
            for (int q = 0; q < 12; ++q) kvl[z0 + q] = (h16)0.f;
        } else if (j0 < C_QMB) {
            h16x4 o; o[0] = (h16)silu_f(v[0]); o[1] = (h16)silu_f(v[1]); o[2] = (h16)silu_f(v[2]); o[3] = (h16)silu_f(v[3]);
            *(h16x4*)((h16*)(ws + WS_ZMLA) + (size_t)m * 512 + (j0 - C_ZMLA)) = o;
        } else if (j0 < C_VMB) {
            const bool isq = j0 < C_KMB; const int w0 = j0 - (isq ? C_QMB : C_KMB), hh = w0 >> 6, i = (w0 & 63) >> 1;
            h16* dst = (h16*)(ws + (isq ? WS_QMB : WS_KMB)) + (size_t)m * 512 + hh * 64; const float sc = isq ? SC_MB : 1.f;
#pragma unroll
            for (int q = 0; q < 2; ++q) { const h2n cs_ = tab[i + q]; const float2 cs = make_float2((float)cs_[0], (float)cs_[1]); const float t1 = v[2 * q], t2 = v[2 * q + 1];
                dst[i + q] = (h16)((t1 * cs.x - t2 * cs.y) * sc); dst[i + q + 32] = (h16)((t2 * cs.x + t1 * cs.y) * sc); }
        } else if (j0 < C_ZMB) {
            h16x4 o; o[0] = (h16)v[0]; o[1] = (h16)v[1]; o[2] = (h16)v[2]; o[3] = (h16)v[3];
            *(h16x4*)((h16*)(ws + WS_VMB) + (size_t)m * 512 + (j0 - C_VMB)) = o;
        } else if (j0 < C_GA) {
            h16x4 o; o[0] = (h16)silu_f(v[0]); o[1] = (h16)silu_f(v[1]); o[2] = (h16)silu_f(v[2]); o[3] = (h16)silu_f(v[3]);
            *(h16x4*)((h16*)(ws + WS_ZMB) + (size_t)m * 512 + (j0 - C_ZMB)) = o;
        } else {
            const bool isa = j0 < C_GB; const int n = j0 - (isa ? C_GA : C_GB); const float* bm = b_merge + (isa ? 0 : 1024) + n;
            h16x4 o; o[0] = (h16)sigmoid_f(v[0] + bm[0]); o[1] = (h16)sigmoid_f(v[1] + bm[1]); o[2] = (h16)sigmoid_f(v[2] + bm[2]); o[3] = (h16)sigmoid_f(v[3] + bm[3]);
            *(h16x4*)((h16*)(ws + (isa ? WS_GA : WS_GB)) + (size_t)m * 1024 + n) = o;
        }
    }
};
struct EpiUq {
    unsigned char* ws;
    __device__ int col(int j) const { const int w = j % 96; if (w < 64) return j; const int u = w - 64; return j - w + 64 + (u >> 1) + 16 * (u & 1); }
    __device__ void store(int m, int j0, const float (&v)[4]) const {
        const float rstd = 1.f / sqrtf(((const float*)(ws + WS_SSQ))[m] * (1.f / 256.f) + EPS);
        const int hh = j0 / 96, w = j0 % 96; h16* dst = (h16*)(ws + WS_QMLA) + (size_t)m * 768 + hh * 96;
        if (w < 64) { h16x4 o; o[0] = (h16)(v[0] * rstd * SC_MLA); o[1] = (h16)(v[1] * rstd * SC_MLA); o[2] = (h16)(v[2] * rstd * SC_MLA); o[3] = (h16)(v[3] * rstd * SC_MLA); *(h16x4*)(dst + w) = o; }
        else { const h2n* tab = (const h2n*)(ws + WS_TAB) + (size_t)m * 32; const int i = (w - 64) >> 1;
#pragma unroll
            for (int q = 0; q < 2; ++q) { const h2n cs_ = tab[2 * (i + q)]; const float2 cs = make_float2((float)cs_[0], (float)cs_[1]); const float t1 = v[2 * q] * rstd * SC_MLA, t2 = v[2 * q + 1] * rstd * SC_MLA;
                dst[64 + i + q] = (h16)(t1 * cs.x - t2 * cs.y); dst[80 + i + q] = (h16)(t2 * cs.x + t1 * cs.y); } }
    }
};
struct EpiUkv {
    unsigned char* ws;
    __device__ int col(int j) const { return j; }
    __device__ void store(int m, int j0, const float (&v)[4]) const {
        const float rstd = 1.f / sqrtf(((const float*)(ws + WS_SSQ))[M_ + m] * (1.f / 128.f) + EPS);
        const int hh = j0 >> 7, w = j0 & 127; h16* dst = (h16*)(ws + (w < 64 ? WS_KN : WS_VM)) + (size_t)m * 512 + hh * 64 + (w & 63);
        h16x4 o; o[0] = (h16)(v[0] * rstd); o[1] = (h16)(v[1] * rstd); o[2] = (h16)(v[2] * rstd); o[3] = (h16)(v[3] * rstd); *(h16x4*)dst = o;
    }
};
struct EpiYa {
    unsigned char* ws;
    __device__ int col(int j) const { return j; }
    __device__ void store(int m, int j0, const float (&v)[4]) const {
        const h16x4 g = *(const h16x4*)((const h16*)(ws + WS_GA) + (size_t)m * 1024 + j0);
        h16x4 o; o[0] = (h16)(v[0] * (float)g[0]); o[1] = (h16)(v[1] * (float)g[1]); o[2] = (h16)(v[2] * (float)g[2]); o[3] = (h16)(v[3] * (float)g[3]);
        *(h16x4*)((h16*)(ws + WS_T) + (size_t)m * 1024 + j0) = o;
    }
};
struct EpiYb {
    unsigned char* ws;
    __device__ int col(int j) const { return j; }
    __device__ void store(int m, int j0, const float (&v)[4]) const {
        const h16x4 g = *(const h16x4*)((const h16*)(ws + WS_GB) + (size_t)m * 1024 + j0), t = *(const h16x4*)((const h16*)(ws + WS_T) + (size_t)m * 1024 + j0);
        h16x4 o; o[0] = (h16)((float)t[0] + v[0] * (float)g[0]); o[1] = (h16)((float)t[1] + v[1] * (float)g[1]); o[2] = (h16)((float)t[2] + v[2] * (float)g[2]); o[3] = (h16)((float)t[3] + v[3] * (float)g[3]);
        *(h16x4*)((h16*)(ws + WS_YM) + (size_t)m * 1024 + j0) = o;
    }
};
struct EpiY {
    unsigned char* ws;
    __device__ int col(int j) const { return j; }
    __device__ void store(int m, int j0, const float (&v)[4]) const { h16x4 o; o[0] = (h16)v[0]; o[1] = (h16)v[1]; o[2] = (h16)v[2]; o[3] = (h16)v[3]; *(h16x4*)((h16*)(ws + WS_Y) + (size_t)m * 1024 + j0) = o;
        atomicAdd((float*)(ws + WS_SSQY) + m, (v[0] * v[0] + v[1] * v[1]) + (v[2] * v[2] + v[3] * v[3])); }
};

__device__ void ph_kmean(const Params& p, int gtid, int gsize) {
    const h16* KMB = (const h16*)(p.ws + WS_KMB); float* km = (float*)(p.ws + WS_KMEAN);
    for (int i = gtid; i < NB * 16 * 512; i += gsize) {
        const int c = i & 511, n = (i >> 9) & 15, b = i >> 13; float s = 0.f;
        for (int r = 0; r < 256; ++r) s += (float)KMB[((size_t)b * SEQ + n * 256 + r) * 512 + c];
        km[i] = s * (1.f / 256.f);
    }
}

__device__ void ph_attn_mla_naive(const Params& p, int vb, int nvb) {
    const h16* Q = (const h16*)(p.ws + WS_QMLA); const h16* KN = (const h16*)(p.ws + WS_KN); const h16* KPE = (const h16*)(p.ws + WS_KPE); const h16* VM = (const h16*)(p.ws + WS_VM);
    h16* Z = (h16*)(p.ws + WS_ZMLA);
    for (int item = vb; item < NB * NH * 8; item += nvb) {
        const int ch = item & 7, h = (item >> 3) & 7, b = item >> 6;
        const int t = ch * 512 + threadIdx.x; const size_t m = (size_t)b * SEQ + t;
        float q[96], o[64];
#pragma unroll
        for (int d = 0; d < 96; ++d) q[d] = (float)Q[m * 768 + h * 96 + d];
#pragma unroll
        for (int d = 0; d < 64; ++d) o[d] = 0.f;
        float mx = -1e30f, l = 0.f;
        const int tmax = ch * 512 + (threadIdx.x | 63);
        for (int j = 0; j <= tmax; ++j) {
            const size_t mj = (size_t)b * SEQ + j; const h16* kn = KN + mj * 512 + h * 64; const h16* kp = KPE + mj * 32; const h16* vv = VM + mj * 512 + h * 64;
            float s = 0.f;
#pragma unroll
            for (int d = 0; d < 64; ++d) s = fmaf(q[d], (float)kn[d], s);
#pragma unroll
            for (int d = 0; d < 32; ++d) s = fmaf(q[64 + d], (float)kp[d], s);
            if (j <= t) {
                const float mn = fmaxf(mx, s), a = exp2f(mx - mn), pj = exp2f(s - mn); l = l * a + pj; mx = mn;
#pragma unroll
                for (int d = 0; d < 64; ++d) o[d] = fmaf(o[d], a, pj * (float)vv[d]);
            }
        }
        const float rl = 1.f / l;
#pragma unroll
        for (int d = 0; d < 64; ++d) { h16* zp = Z + m * 512 + h * 64 + d; *zp = (h16)(o[d] * rl * (float)*zp); }
    }
}

__device__ void ph_attn_moba_naive(const Params& p, int vb, int nvb) {
    const h16* Q = (const h16*)(p.ws + WS_QMB); const h16* KB = (const h16*)(p.ws + WS_KMB); const h16* VB = (const h16*)(p.ws + WS_VMB); const float* km = (const float*)(p.ws + WS_KMEAN);
    h16* Z = (h16*)(p.ws + WS_ZMB);
    for (int item = vb; item < NB * NH * 8; item += nvb) {
        const int ch = item & 7, h = (item >> 3) & 7, b = item >> 6;
        const int t = ch * 512 + threadIdx.x; const size_t m = (size_t)b * SEQ + t; const int own = t >> 8;
        float q[64], o[64];
#pragma unroll
        for (int d = 0; d < 64; ++d) { q[d] = (float)Q[m * 512 + h * 64 + d]; o[d] = 0.f; }
        unsigned sel = 0u;
        {
            float g0 = -INFINITY, g1 = -INFINITY, g2 = -INFINITY; int i0 = -1, i1 = -1, i2 = -1;
            for (int n = 0; n < own; ++n) {
                const float* kmp = km + ((size_t)(b * 16 + n)) * 512 + h * 64; float g = 0.f;
#pragma unroll
                for (int d = 0; d < 64; ++d) g = fmaf(q[d], kmp[d], g);
                if (g > g0) { g2 = g1; i2 = i1; g1 = g0; i1 = i0; g0 = g; i0 = n; }
                else if (g > g1) { g2 = g1; i2 = i1; g1 = g; i1 = n; }
                else if (g > g2) { g2 = g; i2 = n; }
            }
            if (i0 >= 0) sel |= 1u << i0; if (i1 >= 0) sel |= 1u << i1; if (i2 >= 0) sel |= 1u << i2;
        }
        float mx = -1e30f, l = 0.f;
        const int own_w = own;
        for (int n = 0; n <= own_w; ++n) {
            const bool isown = (n == own_w); const bool mine = isown || ((sel >> n) & 1u);
            if (!__any(mine)) continue;
            const int jend = isown ? ((t | 63) & 255) : 255;
            for (int jj = 0; jj <= jend; ++jj) {
                const int j = n * 256 + jj; const size_t mj = (size_t)b * SEQ + j; const h16* kk = KB + mj * 512 + h * 64; const h16* vv = VB + mj * 512 + h * 64;
                float s = 0.f;
#pragma unroll
                for (int d = 0; d < 64; ++d) s = fmaf(q[d], (float)kk[d], s);
                if (mine && j <= t) {
                    const float mn = fmaxf(mx, s), a = exp2f(mx - mn), pj = exp2f(s - mn); l = l * a + pj; mx = mn;
#pragma unroll
                    for (int d = 0; d < 64; ++d) o[d] = fmaf(o[d], a, pj * (float)vv[d]);
                }
            }
        }
        const float rl = 1.f / l;
#pragma unroll
        for (int d = 0; d < 64; ++d) { h16* zp = Z + m * 512 + h * 64 + d; *zp = (h16)(o[d] * rl * (float)*zp); }
    }
}

__device__ void ph_final(const Params& p, int gwave, int nwaves, int lane) {
    const float* mod = (const float*)(p.ws + WS_MOD); const h16* Y = (const h16*)(p.ws + WS_Y); const float* ssq = (const float*)(p.ws + WS_SSQY);
    for (int m = gwave; m < M_; m += nwaves) {
        const int b = m >> 12; const h16x4* yr = (const h16x4*)(Y + (size_t)m * DM); const float4* xr = (const float4*)(p.x + (size_t)m * DM); float4* orow = (float4*)(p.out + (size_t)m * DM);
        const float rstd = 1.f / sqrtf(ssq[m] * (1.f / DM) + EPS);
#pragma unroll
        for (int j = 0; j < 4; ++j) {
            const int col = 4 * (lane + 64 * j); const h16x4 yv = yr[lane + 64 * j];
            const float4 g = *(const float4*)(p.g_post + col), gt = *(const float4*)(mod + b * 3072 + 2048 + col), xv = xr[lane + 64 * j];
            orow[lane + 64 * j] = make_float4(xv.x + gt.x * (float)yv[0] * rstd * g.x, xv.y + gt.y * (float)yv[1] * rstd * g.y, xv.z + gt.z * (float)yv[2] * rstd * g.z, xv.w + gt.w * (float)yv[3] * rstd * g.w);
        }
    }
}


#define XB_TMO      128
#define XB_XCNT(j)  (256  + 64 * (j))
#define XB_XSUB(j)  (1280 + 64 * (j))
#define XB_XGEN(j)  (2304 + 64 * (j))
#define XB_TOP      3328
#define XB_TOPGEN   3392
#define XCD_BAR_WORDS 3456
#define XB_SPIN_CAP (1u << 27)
#define LAS __attribute__((address_space(3)))
__device__ __forceinline__ unsigned xb_ld(unsigned* p)              { return __hip_atomic_load(p, __ATOMIC_RELAXED, __HIP_MEMORY_SCOPE_AGENT); }
__device__ __forceinline__ unsigned xb_add(unsigned* p, unsigned v) { return __hip_atomic_fetch_add(p, v, __ATOMIC_RELAXED, __HIP_MEMORY_SCOPE_AGENT); }
__device__ __forceinline__ unsigned xb_xcc_id() { return (unsigned)__builtin_amdgcn_s_getreg((3 << 11) | 20) & 0xFu; }
#define XB_SPIN(cond, bar) do { unsigned _sp = 0; while (cond) { __builtin_amdgcn_s_sleep(1); \
    if ((++_sp & 255u) == 0u) { if (xb_ld(&(bar)[XB_TMO])) break; if (_sp > XB_SPIN_CAP) { atomicAdd(&(bar)[XB_TMO], 1u); break; } } } } while (0)
struct XcdBarrier { unsigned* bar; unsigned x; volatile LAS unsigned* st; };
__device__ __forceinline__ XcdBarrier xcd_barrier_post(unsigned* bar, volatile LAS unsigned* st) {
    XcdBarrier b; b.bar = bar; b.x = xb_xcc_id(); b.st = st;
    if (threadIdx.x == 0) (void)xb_add(&bar[XB_XCNT(b.x)], 1u);
    return b;
}
__device__ __forceinline__ void xcd_barrier_complete(unsigned* bar, unsigned x, unsigned& nloc, unsigned& nx) {
    const unsigned G = gridDim.x * gridDim.y * gridDim.z;
    unsigned sum, cnt, mine, sp = 0u;
    for (;;) {
        sum = 0u; cnt = 0u; mine = 0u;
#pragma unroll
        for (unsigned j = 0; j < 16; ++j) { const unsigned c = xb_ld(&bar[XB_XCNT(j)]); sum += c; cnt += (c > 0u) ? 1u : 0u; mine = (j == x) ? c : mine; }
        if (sum == G) break;
        __builtin_amdgcn_s_sleep(1);
        if ((++sp & 255u) == 0u) { if (xb_ld(&bar[XB_TMO])) break; if (sp > XB_SPIN_CAP) { atomicAdd(&bar[XB_TMO], 1u); break; } }
    }
    nloc = mine > 0u ? mine : 1u; nx = cnt > 0u ? cnt : 1u;
}
__device__ __forceinline__ void xcd_barrier(const XcdBarrier& b) {
    asm volatile("s_waitcnt vmcnt(0)" ::: "memory");
    __syncthreads();
    if (threadIdx.x == 0) {
        unsigned* bar = b.bar;
        __builtin_amdgcn_s_waitcnt(0);
        unsigned nloc = b.st[0], nx = b.st[1];
        if (nloc == 0u) { xcd_barrier_complete(bar, b.x, nloc, nx); b.st[0] = nloc; b.st[1] = nx; }
        const unsigned old = xb_add(&bar[XB_XSUB(b.x)], 1u);
        const unsigned gen = old / nloc;
        if (old + 1u == (gen + 1u) * nloc) {
            __builtin_amdgcn_fence(__ATOMIC_RELEASE, "agent");
            asm volatile("s_waitcnt vmcnt(0)" ::: "memory");
            const unsigned og = xb_add(&bar[XB_TOP], 1u);
            const unsigned tg = og / nx;
            if (og + 1u == (tg + 1u) * nx) xb_add(&bar[XB_TOPGEN], 1u);
            else XB_SPIN(xb_ld(&bar[XB_TOPGEN]) == tg, bar);
            __builtin_amdgcn_fence(__ATOMIC_ACQUIRE, "agent");
            xb_add(&bar[XB_XGEN(b.x)], 1u);
            asm volatile("s_waitcnt vmcnt(0)" ::: "memory");
        } else {
            XB_SPIN(xb_ld(&bar[XB_XGEN(b.x)]) == gen, bar);
            __builtin_amdgcn_fence(__ATOMIC_ACQUIRE, "agent");
            asm volatile("s_waitcnt vmcnt(0)" ::: "memory");
        }
    }
    __syncthreads();
}

namespace pg8 {
#define PG8_LAS __attribute__((address_space(3)))
typedef unsigned short bf16_t;
typedef _Float16 bf16x8 __attribute__((ext_vector_type(8)));
typedef float f32x4 __attribute__((ext_vector_type(4)));
typedef unsigned u32x4 __attribute__((ext_vector_type(4)));
constexpr int BM = 256, BK = 64, HALF = 128, HTB = HALF * BK * 2  , STAGE_BYTES = 8 * HTB, NXCD = 8, WGM = 8;

__host__ __device__ __forceinline__ int lds_byte(int r, int c) { const int st = (r >> 4) * 2 + (c >> 5), rr = r & 15, cc = c & 31, ob = rr * 64 + cc * 2; return st * 1024 + (ob ^ (((ob >> 9) & 1) << 5)); }
__host__ __device__ __forceinline__ void stage_rc(int b, int& R, int& C) { const int st = b / 1024, sb = b % 1024, swz = sb ^ (((sb >> 9) & 1) << 5); R = (st >> 1) * 16 + swz / 64; C = (st & 1) * 32 + (swz % 64) / 2; }
__host__ __device__ __forceinline__ int perm32(int rho) { const int n = rho >> 4, i = rho & 15; return 8 * (i >> 2) + 4 * n + (i & 3); }

struct Unit { int pm, pn; };
struct Gemm { const bf16_t* A; const bf16_t* Bt; int M, N, K; };

struct StaticOrder {
    int nM, nN, nwg, G, c;
    __host__ __device__ void init(int M, int N, int G_, int c_) { nM = M / BM; nN = N / BM; nwg = nM * nN; G = G_; c = c_; }
    __host__ __device__ bool next(int i, Unit& u) const {
        const long L = (long)i * G + c; if (L >= nwg) return false;
        int wgid = (int)L; { const int q = nwg / NXCD, r = nwg % NXCD, xcd = wgid % NXCD, off = wgid / NXCD; wgid = (xcd < r ? xcd * (q + 1) : r * (q + 1) + (xcd - r) * q) + off; }
        const int nig = WGM * nN, gid = wgid / nig, fm = gid * WGM, gsz = (nM - fm) < WGM ? (nM - fm) : WGM;
        u.pm = fm + ((wgid % nig) % gsz); u.pn = (wgid % nig) / gsz; return true;
    }
    __device__ __forceinline__ void a_ready(const Unit&) const {}
    __device__ __forceinline__ void done(const Unit&) const {}
};

template <class Epi, class Sched, bool ALIGN_EPI = false, bool SP2 = false>
__device__ __forceinline__ void gemm_phase(PG8_LAS unsigned char* lds, const Gemm g, const Sched& S, const Epi& E) {
    int tid_ = threadIdx.x; asm volatile("" : "+v"(tid_));
    const int tid = tid_, wid = __builtin_amdgcn_readfirstlane(tid >> 6), lane = tid & 63, wr = wid >> 2, wc = wid & 3, fr = lane & 15, fq = lane >> 4;
    const int K = g.K, nt = K / BK;
    unsigned voffA[2], voffB[2];
#pragma unroll
    for (int i = 0; i < 2; ++i) { int R, C; stage_rc(tid * 16 + i * 8192, R, C); const int Rb = Epi::PERM ? ((R & ~31) + perm32(R & 31)) : R;
        voffA[i] = (unsigned)(R * K + C) * 2u; voffB[i] = (unsigned)(Rb * K + C) * 2u; }
    const size_t kstep = (size_t)(BK * 2);
    const size_t hstep = (size_t)HALF * K * 2;
    const size_t tstep = 2 * hstep;
    const unsigned ldsw = (unsigned)wid * 1024u;
    const int aoff = lds_byte(wr * 64 + fr, fq * 8), boff = lds_byte(wc * 32 + fr, fq * 8);
#define PG8_SA(b, h) (((b) * 2 + (h)) * HTB)
#define PG8_SB(b, h) ((4 + (b) * 2 + (h)) * HTB)
#define PG8_STAGE(bufoff, gbase, voff) do { _Pragma("unroll") for (int _i = 0; _i < 2; ++_i) \
        __builtin_amdgcn_global_load_lds((const unsigned*)((const char*)(gbase) + (voff)[_i]), (PG8_LAS unsigned*)(lds + (bufoff) + ldsw + _i * 8192), 16, 0, 0); } while (0)
#define PG8_LDA(dst, b, h) do { _Pragma("unroll") for (int m = 0; m < 4; ++m) _Pragma("unroll") for (int k = 0; k < 2; ++k) dst[m][k] = *(const PG8_LAS bf16x8*)(lds + PG8_SA(b, h) + aoff + m * 2048 + k * 1024); } while (0)
#define PG8_LDB(dst, b, h) do { _Pragma("unroll") for (int n = 0; n < 2; ++n) _Pragma("unroll") for (int k = 0; k < 2; ++k) dst[n][k] = *(const PG8_LAS bf16x8*)(lds + PG8_SB(b, h) + boff + n * 2048 + k * 1024); } while (0)
#define PG8_MMA(ai, bj, At, Bt) do { __builtin_amdgcn_s_setprio(1); _Pragma("unroll") for (int m = 0; m < 4; ++m) _Pragma("unroll") for (int n = 0; n < 2; ++n) _Pragma("unroll") for (int k = 0; k < 2; ++k) \
        acc[ai][bj][m][n] = __builtin_amdgcn_mfma_f32_16x16x32_f16(Bt[n][k], At[m][k], acc[ai][bj][m][n], 0, 0, 0); __builtin_amdgcn_s_setprio(0); } while (0)
#define PG8_WAIT_V(n) asm volatile("s_waitcnt vmcnt(" #n ")" ::: "memory")
#define PG8_WAIT_L(n) asm volatile("s_waitcnt lgkmcnt(" #n ")" ::: "memory")
#define PG8_BAR __builtin_amdgcn_s_barrier()
#define PG8_SCHED __builtin_amdgcn_sched_barrier(0)
    Unit cur, nxt; int ui = 0;
    if (!S.next(0, cur)) return;
    f32x4 acc[2][2][4][2];
#pragma unroll
    for (int a = 0; a < 2; ++a)
#pragma unroll
        for (int b = 0; b < 2; ++b)
#pragma unroll
            for (int m = 0; m < 4; ++m)
#pragma unroll
                for (int n = 0; n < 2; ++n) acc[a][b][m][n] = (f32x4){0.f, 0.f, 0.f, 0.f};
    bf16x8 At[4][2], B0[2][2], B1[2][2];
    const char* cA = (const char*)g.A + (size_t)cur.pm * tstep; const char* cB = (const char*)g.Bt + (size_t)cur.pn * tstep;
    S.a_ready(cur);
    if constexpr (SP2) {
        PG8_STAGE(PG8_SB(0, 0), cB, voffB); PG8_STAGE(PG8_SB(0, 1), cB + hstep, voffB); PG8_STAGE(PG8_SA(0, 0), cA, voffA); PG8_STAGE(PG8_SA(0, 1), cA + hstep, voffA);
        if (wr == 1) PG8_BAR;
        PG8_WAIT_V(2); PG8_BAR;
        PG8_STAGE(PG8_SB(1, 0), cB + kstep, voffB); PG8_STAGE(PG8_SA(1, 0), cA + kstep, voffA); PG8_STAGE(PG8_SB(1, 1), cB + hstep + kstep, voffB);
        PG8_WAIT_V(6); PG8_BAR;
    } else {
        PG8_STAGE(PG8_SB(0, 0), cB, voffB); PG8_STAGE(PG8_SA(0, 0), cA, voffA); PG8_STAGE(PG8_SB(0, 1), cB + hstep, voffB); PG8_STAGE(PG8_SA(0, 1), cA + hstep, voffA);
        if (wr == 1) PG8_BAR;
        PG8_WAIT_V(4); PG8_BAR;
        PG8_STAGE(PG8_SB(1, 0), cB + kstep, voffB); PG8_STAGE(PG8_SA(1, 0), cA + kstep, voffA); PG8_STAGE(PG8_SB(1, 1), cB + hstep + kstep, voffB);
        PG8_WAIT_V(6); PG8_BAR;
    }
    for (;;) {
        const bool has_next = S.next(ui + 1, nxt);
        const char* nA = has_next ? (const char*)g.A + (size_t)nxt.pm * tstep : cA; const char* nB = has_next ? (const char*)g.Bt + (size_t)nxt.pn * tstep : cB;
#pragma nounroll
        for (int t = 0; t < nt; t += 2) {
            const bool last = (t == nt - 2);
            const char* a1 = cA + (size_t)(t + 1) * kstep;
            const char* a2 = last ? nA : cA + (size_t)(t + 2) * kstep; const char* b2 = last ? nB : cB + (size_t)(t + 2) * kstep;
            const char* a3 = a2 + kstep; const char* b3 = b2 + kstep;
            if (last && has_next) S.a_ready(nxt);
            if constexpr (SP2) {
            PG8_LDB(B0, 0, 0); PG8_LDB(B1, 0, 1); PG8_SCHED; PG8_LDA(At, 0, 0); PG8_STAGE(PG8_SA(1, 1), a1 + hstep, voffA);
            PG8_WAIT_V(8); PG8_WAIT_L(0); PG8_BAR; PG8_MMA(0, 0, At, B0); PG8_MMA(0, 1, At, B1); PG8_BAR; PG8_SCHED;
            PG8_LDA(At, 0, 1); PG8_STAGE(PG8_SB(0, 0), b2, voffB); PG8_STAGE(PG8_SB(0, 1), b2 + hstep, voffB); PG8_STAGE(PG8_SA(0, 0), a2, voffA);
            PG8_WAIT_V(8); PG8_WAIT_L(0); PG8_BAR; PG8_MMA(1, 0, At, B0); PG8_MMA(1, 1, At, B1); PG8_BAR; PG8_SCHED;
            PG8_LDB(B0, 1, 0); PG8_LDB(B1, 1, 1); PG8_SCHED; PG8_LDA(At, 1, 0); PG8_STAGE(PG8_SA(0, 1), a2 + hstep, voffA);
            PG8_WAIT_V(8); PG8_WAIT_L(0); PG8_BAR; PG8_MMA(0, 0, At, B0); PG8_MMA(0, 1, At, B1); PG8_BAR; PG8_SCHED;
            PG8_LDA(At, 1, 1); PG8_STAGE(PG8_SB(1, 0), b3, voffB); PG8_STAGE(PG8_SB(1, 1), b3 + hstep, voffB); PG8_STAGE(PG8_SA(1, 0), a3, voffA);
            PG8_WAIT_V(8); PG8_WAIT_L(0); PG8_BAR; PG8_MMA(1, 0, At, B0); PG8_MMA(1, 1, At, B1); PG8_BAR; PG8_SCHED;
            } else {
            PG8_LDB(B0, 0, 0); PG8_SCHED; PG8_LDA(At, 0, 0); PG8_STAGE(PG8_SA(1, 1), a1 + hstep, voffA);
            PG8_WAIT_L(8); PG8_BAR; PG8_WAIT_L(0); PG8_MMA(0, 0, At, B0); PG8_BAR; PG8_SCHED;
            PG8_LDB(B1, 0, 1); PG8_STAGE(PG8_SB(0, 0), b2, voffB);
            PG8_BAR; PG8_WAIT_L(0); PG8_MMA(0, 1, At, B1); PG8_BAR;
            PG8_LDA(At, 0, 1); PG8_STAGE(PG8_SA(0, 0), a2, voffA);
            PG8_BAR; PG8_WAIT_L(0); PG8_MMA(1, 0, At, B0); PG8_BAR; PG8_SCHED;
            PG8_STAGE(PG8_SB(0, 1), b2 + hstep, voffB);
            PG8_WAIT_V(6); PG8_BAR; PG8_MMA(1, 1, At, B1); PG8_BAR;
            PG8_LDB(B0, 1, 0); PG8_SCHED; PG8_LDA(At, 1, 0); PG8_STAGE(PG8_SA(0, 1), a2 + hstep, voffA);
            PG8_WAIT_L(8); PG8_BAR; PG8_WAIT_L(0); PG8_MMA(0, 0, At, B0); PG8_BAR; PG8_SCHED;
            PG8_LDB(B1, 1, 1); PG8_STAGE(PG8_SB(1, 0), b3, voffB);
            PG8_BAR; PG8_WAIT_L(0); PG8_MMA(0, 1, At, B1); PG8_BAR;
            PG8_LDA(At, 1, 1); PG8_STAGE(PG8_SA(1, 0), a3, voffA);
            PG8_BAR; PG8_WAIT_L(0); PG8_MMA(1, 0, At, B0); PG8_BAR; PG8_SCHED;
            PG8_STAGE(PG8_SB(1, 1), b3 + hstep, voffB);
            PG8_WAIT_V(6); PG8_BAR; PG8_MMA(1, 1, At, B1); PG8_BAR;
            }
        }
        if constexpr (ALIGN_EPI) { if (wr == 0) PG8_BAR; }
        if constexpr (!Epi::AFTER_DRAIN) { E(acc, cur, wr, wc, fr, fq); S.done(cur); }
        if (!has_next) break;
#pragma unroll
        for (int a = 0; a < 2; ++a)
#pragma unroll
            for (int b = 0; b < 2; ++b)
#pragma unroll
                for (int m = 0; m < 4; ++m)
#pragma unroll
                    for (int n = 0; n < 2; ++n) acc[a][b][m][n] = (f32x4){0.f, 0.f, 0.f, 0.f};
        cur = nxt; cA = nA; cB = nB; ++ui;
        if constexpr (ALIGN_EPI) { if (wr == 1) PG8_BAR; }
    }
    PG8_WAIT_V(0);
    if constexpr (!ALIGN_EPI) { if (wr == 0) PG8_BAR; }
    PG8_BAR;
    if constexpr (Epi::AFTER_DRAIN) { E.fused(acc, cur, wr, wc, fr, fq, lds, wid, lane); S.done(cur); }
#undef PG8_SA
#undef PG8_SB
#undef PG8_STAGE
#undef PG8_LDA
#undef PG8_LDB
#undef PG8_MMA
#undef PG8_WAIT_V
#undef PG8_WAIT_L
#undef PG8_BAR
#undef PG8_SCHED
}
typedef _Float16 h8v __attribute__((ext_vector_type(8)));
typedef _Float16 h2v __attribute__((ext_vector_type(2)));
__device__ __forceinline__ unsigned pk_h2(float lo, float hi) { h2v v; v[0] = (_Float16)lo; v[1] = (_Float16)hi; return __builtin_bit_cast(unsigned, v); }
__device__ __forceinline__ u32x4 pack8(const f32x4& a, const f32x4& b) { u32x4 w; w.x = pk_h2(a[0], a[1]); w.y = pk_h2(a[2], a[3]); w.z = pk_h2(b[0], b[1]); w.w = pk_h2(b[2], b[3]); return w; }
__device__ __forceinline__ float sigm1(float v) { return __builtin_amdgcn_rcpf(1.f + __builtin_amdgcn_exp2f(v * -1.4426950408889634f)); }
__device__ __forceinline__ float silu1(float v) { return v * sigm1(v); }
__device__ __forceinline__ f32x4 silu4(const f32x4& v) { return (f32x4){silu1(v[0]), silu1(v[1]), silu1(v[2]), silu1(v[3])}; }
__device__ __forceinline__ f32x4 sigm4(const f32x4& v) { return (f32x4){sigm1(v[0]), sigm1(v[1]), sigm1(v[2]), sigm1(v[3])}; }

#define PG8_OPAQUE(fr_, fq_) int lane_x; asm volatile("v_mbcnt_lo_u32_b32 %0, -1, 0\n\tv_mbcnt_hi_u32_b32 %0, -1, %0" : "=v"(lane_x)); const int frx = lane_x & 15, fqx = lane_x >> 4
__device__ __forceinline__ void st16(unsigned char* base, unsigned off, const u32x4& v) { *(u32x4*)(base + off) = v; }
__device__ __forceinline__ f32x4 ld16f(const unsigned char* base, unsigned off) { return *(const f32x4*)(base + off); }
__device__ __forceinline__ float ld4f(const unsigned char* base, unsigned off) { return *(const float*)(base + off); }
__device__ __forceinline__ h8v ld16h(const unsigned char* base, unsigned off) { return *(const h8v*)(base + off); }
__device__ __forceinline__ float sumsq8(const f32x4& a, const f32x4& b) { return (a[0] * a[0] + a[1] * a[1]) + (a[2] * a[2] + a[3] * a[3]) + (b[0] * b[0] + b[1] * b[1]) + (b[2] * b[2] + b[3] * b[3]); }
__device__ __forceinline__ void rope4(const f32x4& t1, const f32x4& t2, const u32x4& cs, f32x4& o1, f32x4& o2) {
#pragma unroll
    for (int j = 0; j < 4; ++j) { const unsigned wj = cs[j]; h2v w; __builtin_memcpy(&w, &wj, 4);
        const float c = (float)w[0], s = (float)w[1]; o1[j] = t1[j] * c - t2[j] * s; o2[j] = t2[j] * c + t1[j] * s; }
}
__device__ __forceinline__ u32x4 ld16u(const unsigned char* base, unsigned off) { return *(const u32x4*)(base + off); }

struct EpiInF {
    static constexpr bool PERM = true, AFTER_DRAIN = false;
    unsigned char* ws; const float* b_merge; int noatomic;
    template <bool ISQ> __device__ __forceinline__ void rope_tile(const f32x4 (&acc)[2][2][4][2], const Unit& u, int wr, int wc, int frx, int fqx) const {
        const int pn = u.pn; const unsigned row0 = (unsigned)(u.pm * 256 + wr * 64) + (unsigned)frx; const float sc = ISQ ? SC_MB : 1.f;
        unsigned char* dst = ws + (ISQ ? WS_QMB : WS_KMB); const unsigned char* tab = ws + WS_TAB;
        const unsigned o0 = row0 * 1024u + (((pn & 1) ? 256u : 0u) + 64u * wc + 8u * fqx) * 2u, t0 = row0 * 128u + 32u * fqx;
        f32x4 c1[2] = {{0.f, 0.f, 0.f, 0.f}, {0.f, 0.f, 0.f, 0.f}}, c2[2] = {{0.f, 0.f, 0.f, 0.f}, {0.f, 0.f, 0.f, 0.f}};
        u32x4 cs[2][4][2];
#pragma unroll
        for (int ai = 0; ai < 2; ++ai)
#pragma unroll
            for (int m = 0; m < 4; ++m) { const unsigned to = t0 + (unsigned)(ai * 128 + m * 16) * 128u; cs[ai][m][0] = ld16u(tab, to); cs[ai][m][1] = ld16u(tab, to + 16u); }
#pragma unroll
        for (int ai = 0; ai < 2; ++ai)
#pragma unroll
            for (int m = 0; m < 4; ++m) { const unsigned ro = o0 + (unsigned)(ai * 128 + m * 16) * 1024u;
                f32x4 o1[2], o2[2];
#pragma unroll
                for (int n = 0; n < 2; ++n) { rope4(acc[ai][0][m][n], acc[ai][1][m][n], cs[ai][m][n], o1[n], o2[n]);
                    if (!ISQ) { c1[n] += o1[n]; c2[n] += o2[n]; } }
                st16(dst, ro, pack8(o1[0] * sc, o1[1] * sc)); st16(dst, ro + 64u, pack8(o2[0] * sc, o2[1] * sc));
                if (!ISQ) asm volatile("" : "+v"(c1[0]), "+v"(c1[1]), "+v"(c2[0]), "+v"(c2[1])); }
        if (!ISQ) {
            float* km = (float*)(ws + WS_KMEAN) + (size_t)u.pm * 512 + ((pn & 1) ? 256 : 0) + 64 * wc + 8 * fqx;
#pragma unroll
            for (int n = 0; n < 2; ++n)
#pragma unroll
                for (int j = 0; j < 4; ++j) { float a = c1[n][j], b = c2[n][j];
#pragma unroll
                    for (int o = 1; o < 16; o <<= 1) { a += __shfl_xor(a, o); b += __shfl_xor(b, o); }
                    if (frx == 0 && !noatomic) { atomicAdd(km + 4 * n + j, a * (1.f / 256.f)); atomicAdd(km + 32 + 4 * n + j, b * (1.f / 256.f)); } }
        }
    }
    __device__ __forceinline__ void operator()(const f32x4 (&acc)[2][2][4][2], const Unit& u, int wr, int wc, int fr, int fq) const {
        PG8_OPAQUE(fr, fq);
        const int pn = u.pn; const unsigned row0 = (unsigned)(u.pm * 256 + wr * 64) + (unsigned)frx, cl = 32u * wc + 8u * fqx;
        if (pn == 0) {
            unsigned char* dst = ws + WS_QLAT; float* ssq = (float*)(ws + WS_SSQ); const unsigned o0 = row0 * 512u + cl * 2u;
#pragma unroll
            for (int ai = 0; ai < 2; ++ai)
#pragma unroll
                for (int m = 0; m < 4; ++m) { const unsigned ro = o0 + (unsigned)(ai * 128 + m * 16) * 512u; float s = 0.f;
#pragma unroll
                    for (int bj = 0; bj < 2; ++bj) { s += sumsq8(acc[ai][bj][m][0], acc[ai][bj][m][1]); st16(dst, ro + bj * 256u, pack8(acc[ai][bj][m][0], acc[ai][bj][m][1])); }
                    s += __shfl_xor(s, 16); s += __shfl_xor(s, 32);
                    if (fqx == 0 && !noatomic) atomicAdd(ssq + (row0 + ai * 128 + m * 16), s); }
        } else if (pn == 1) {
            unsigned char* kvl = ws + WS_KVL; unsigned char* kpe = ws + WS_KPE; float* ssq = (float*)(ws + WS_SSQ) + M_; const unsigned char* tab = ws + WS_TAB;
#pragma unroll
            for (int ai = 0; ai < 2; ++ai)
#pragma unroll
                for (int m = 0; m < 4; ++m) { const unsigned row = row0 + ai * 128 + m * 16;
                    if (wc < 2) { float s = 0.f;
#pragma unroll
                        for (int bj = 0; bj < 2; ++bj) { s += sumsq8(acc[ai][bj][m][0], acc[ai][bj][m][1]); st16(kvl, row * 512u + (bj * 64u + cl) * 2u, pack8(acc[ai][bj][m][0], acc[ai][bj][m][1])); }
                        s += __shfl_xor(s, 16); s += __shfl_xor(s, 32);
                        if (fqx == 0 && !noatomic) atomicAdd(ssq + row, s);
                    } else {
                        if (wc == 2 && fqx < 2) {
                            f32x4 o1[2], o2[2];
#pragma unroll
                            for (int n = 0; n < 2; ++n) { const unsigned to = row * 128u + (unsigned)(16 * fqx + 8 * n) * 4u; const u32x4 wa = ld16u(tab, to), wb = ld16u(tab, to + 16u);
                                rope4(acc[ai][0][m][n], acc[ai][1][m][n], (u32x4){wa[0], wa[2], wb[0], wb[2]}, o1[n], o2[n]); }
                            st16(kpe, row * 64u + 16u * fqx, pack8(o1[0], o1[1])); st16(kpe, row * 64u + 32u + 16u * fqx, pack8(o2[0], o2[1]));
                        }
                        const u32x4 z = {0u, 0u, 0u, 0u};
                        st16(kvl, row * 512u + (128u + (cl - 64u)) * 2u, z); st16(kvl, row * 512u + (192u + (cl - 64u)) * 2u, z);
                    }
                    asm volatile("" ::: "memory"); }
        } else if (pn < 4 || (pn >= 8 && pn < 12)) {
            const bool act = (pn < 4) || (pn >= 10);
            unsigned char* dst = ws + (pn < 4 ? WS_ZMLA : (pn < 10 ? WS_VMB : WS_ZMB)); const unsigned o0 = row0 * 1024u + (((pn & 1) ? 256u : 0u) + cl) * 2u;
#pragma unroll
            for (int ai = 0; ai < 2; ++ai)
#pragma unroll
                for (int m = 0; m < 4; ++m) { const unsigned ro = o0 + (unsigned)(ai * 128 + m * 16) * 1024u;
#pragma unroll
                    for (int bj = 0; bj < 2; ++bj) { f32x4 a = acc[ai][bj][m][0], b = acc[ai][bj][m][1]; if (act) { a = silu4(a); b = silu4(b); }
                        st16(dst, ro + bj * 256u, pack8(a, b)); } }
        } else if (pn < 6) { rope_tile<true>(acc, u, wr, wc, frx, fqx);
        } else if (pn < 8) { rope_tile<false>(acc, u, wr, wc, frx, fqx);
        } else {
            const bool isa = pn < 16; unsigned char* dst = ws + (isa ? WS_GA : WS_GB); const unsigned cg = 256u * ((pn - 12) & 3) + cl;
            const unsigned char* bm = (const unsigned char*)(b_merge + (isa ? 0 : 1024)); const unsigned o0 = row0 * 2048u + cg * 2u;
            f32x4 bv[2][2];
#pragma unroll
            for (int bj = 0; bj < 2; ++bj)
#pragma unroll
                for (int n = 0; n < 2; ++n) bv[bj][n] = ld16f(bm, (cg + bj * 128u + 4u * n) * 4u);
#pragma unroll
            for (int ai = 0; ai < 2; ++ai)
#pragma unroll
                for (int m = 0; m < 4; ++m) { const unsigned ro = o0 + (unsigned)(ai * 128 + m * 16) * 2048u;
#pragma unroll
                    for (int bj = 0; bj < 2; ++bj) st16(dst, ro + bj * 256u, pack8(sigm4(acc[ai][bj][m][0] + bv[bj][0]), sigm4(acc[ai][bj][m][1] + bv[bj][1]))); }
        }
    }
};
struct EpiNull {
    static constexpr bool PERM = true, AFTER_DRAIN = false;
    __device__ __forceinline__ void operator()(const f32x4 (&acc)[2][2][4][2], const Unit& u, int wr, int wc, int fr, int fq) const {
#pragma unroll
        for (int ai = 0; ai < 2; ++ai)
#pragma unroll
            for (int bj = 0; bj < 2; ++bj)
#pragma unroll
                for (int m = 0; m < 4; ++m) asm volatile("" :: "v"(acc[ai][bj][m][0]), "v"(acc[ai][bj][m][1]));
    }
};
struct EpiUqF {
    static constexpr bool PERM = true, AFTER_DRAIN = false;
    unsigned char* ws;
    __device__ __forceinline__ void operator()(const f32x4 (&acc)[2][2][4][2], const Unit& u, int wr, int wc, int fr, int fq) const {
        PG8_OPAQUE(fr, fq);
        const int pn = u.pn; const unsigned row0 = (unsigned)(u.pm * 256 + wr * 64) + (unsigned)frx; unsigned char* Q = ws + WS_QMLA; const unsigned char* ssq = ws + WS_SSQ; const unsigned char* tab = ws + WS_TAB;
        float rsv[2][4];
#pragma unroll
        for (int ai = 0; ai < 2; ++ai)
#pragma unroll
            for (int m = 0; m < 4; ++m) rsv[ai][m] = ld4f(ssq, (row0 + ai * 128 + m * 16) * 4u);
#pragma unroll
        for (int ai = 0; ai < 2; ++ai)
#pragma unroll
            for (int m = 0; m < 4; ++m) { const unsigned row = row0 + ai * 128 + m * 16; const float rs = SC_MLA * __builtin_amdgcn_rsqf(rsv[ai][m] * (1.f / 256.f) + EPS);
                if (pn < 2) {
#pragma unroll
                    for (int bj = 0; bj < 2; ++bj) { const unsigned head = 4u * pn + 2u * bj + (wc >> 1), d = 32u * (wc & 1) + 8u * fqx;
                        st16(Q, row * 1536u + (96u * head + d) * 2u, pack8(acc[ai][bj][m][0] * rs, acc[ai][bj][m][1] * rs)); }
                } else { const unsigned head = 2u * wc + ((unsigned)fqx >> 1), i0 = 8u * (fqx & 1); f32x4 o1[2], o2[2];
#pragma unroll
                    for (int n = 0; n < 2; ++n) { const unsigned to = row * 128u + (2u * (i0 + 4u * n)) * 4u; const u32x4 wa = ld16u(tab, to), wb = ld16u(tab, to + 16u);
                        rope4(acc[ai][0][m][n] * rs, acc[ai][1][m][n] * rs, (u32x4){wa[0], wa[2], wb[0], wb[2]}, o1[n], o2[n]); }
                    st16(Q, row * 1536u + (96u * head + 64u + i0) * 2u, pack8(o1[0], o1[1])); st16(Q, row * 1536u + (96u * head + 80u + i0) * 2u, pack8(o2[0], o2[1])); } }
    }
};
struct EpiUkvF {
    static constexpr bool PERM = true, AFTER_DRAIN = false;
    unsigned char* ws;
    __device__ __forceinline__ void operator()(const f32x4 (&acc)[2][2][4][2], const Unit& u, int wr, int wc, int fr, int fq) const {
        PG8_OPAQUE(fr, fq);
        const int pn = u.pn; const unsigned row0 = (unsigned)(u.pm * 256 + wr * 64) + (unsigned)frx; unsigned char* dst = ws + (pn < 2 ? WS_KN : WS_VM); const unsigned char* ssq = ws + WS_SSQ + (size_t)M_ * 4;
        float rsv[2][4];
#pragma unroll
        for (int ai = 0; ai < 2; ++ai)
#pragma unroll
            for (int m = 0; m < 4; ++m) rsv[ai][m] = ld4f(ssq, (row0 + ai * 128 + m * 16) * 4u);
#pragma unroll
        for (int ai = 0; ai < 2; ++ai)
#pragma unroll
            for (int m = 0; m < 4; ++m) { const unsigned row = row0 + ai * 128 + m * 16; const float rs = __builtin_amdgcn_rsqf(rsv[ai][m] * (1.f / 128.f) + EPS);
#pragma unroll
                for (int bj = 0; bj < 2; ++bj) { const unsigned head = 4u * (pn & 1) + 2u * bj + (wc >> 1), d = 32u * (wc & 1) + 8u * fqx;
                    st16(dst, row * 1024u + (64u * head + d) * 2u, pack8(acc[ai][bj][m][0] * rs, acc[ai][bj][m][1] * rs)); } }
    }
};
template <int MODE> struct EpiYabF {
    static constexpr bool PERM = true, AFTER_DRAIN = false;
    unsigned char* ws;
    __device__ __forceinline__ void operator()(const f32x4 (&acc)[2][2][4][2], const Unit& u, int wr, int wc, int fr, int fq) const {
        PG8_OPAQUE(fr, fq);
        const unsigned row0 = (unsigned)(u.pm * 256 + wr * 64) + (unsigned)frx, c0 = u.pn * 256u + 32u * wc + 8u * fqx, o0 = row0 * 2048u + c0 * 2u;
        const unsigned char* G = ws + (MODE == 0 ? WS_GA : WS_GB); unsigned char* T = ws + WS_T; unsigned char* YM = ws + WS_YM;
#pragma unroll
        for (int ai = 0; ai < 2; ++ai) {
            h8v gv[4][2], tv[4][2];
#pragma unroll
            for (int m = 0; m < 4; ++m)
#pragma unroll
                for (int bj = 0; bj < 2; ++bj) { const unsigned off = o0 + (unsigned)(ai * 128 + m * 16) * 2048u + bj * 256u; gv[m][bj] = ld16h(G, off); if (MODE == 1) tv[m][bj] = ld16h(T, off); }
#pragma unroll
            for (int m = 0; m < 4; ++m)
#pragma unroll
                for (int bj = 0; bj < 2; ++bj) { const unsigned off = o0 + (unsigned)(ai * 128 + m * 16) * 2048u + bj * 256u; const h8v g = gv[m][bj];
                    f32x4 a = acc[ai][bj][m][0], b = acc[ai][bj][m][1];
                    a = a * (f32x4){(float)g[0], (float)g[1], (float)g[2], (float)g[3]}; b = b * (f32x4){(float)g[4], (float)g[5], (float)g[6], (float)g[7]};
                    if (MODE == 1) { const h8v t = tv[m][bj]; a += (f32x4){(float)t[0], (float)t[1], (float)t[2], (float)t[3]}; b += (f32x4){(float)t[4], (float)t[5], (float)t[6], (float)t[7]}; }
                    st16(MODE == 0 ? T : YM, off, pack8(a, b)); }
            asm volatile("" ::: "memory"); }
    }
};
struct EpiYF {
    static constexpr bool PERM = true, AFTER_DRAIN = false;
    unsigned char* ws;
    __device__ __forceinline__ void operator()(const f32x4 (&acc)[2][2][4][2], const Unit& u, int wr, int wc, int fr, int fq) const {
        PG8_OPAQUE(fr, fq);
        const unsigned row0 = (unsigned)(u.pm * 256 + wr * 64) + (unsigned)frx, c0 = u.pn * 256u + 32u * wc + 8u * fqx, o0 = row0 * 2048u + c0 * 2u; unsigned char* Y = ws + WS_Y; float* ssq = (float*)(ws + WS_SSQY);
#pragma unroll
        for (int ai = 0; ai < 2; ++ai)
#pragma unroll
            for (int m = 0; m < 4; ++m) { float s = 0.f;
#pragma unroll
                for (int bj = 0; bj < 2; ++bj) { s += sumsq8(acc[ai][bj][m][0], acc[ai][bj][m][1]); st16(Y, o0 + (unsigned)(ai * 128 + m * 16) * 2048u + bj * 256u, pack8(acc[ai][bj][m][0], acc[ai][bj][m][1])); }
                s += __shfl_xor(s, 16); s += __shfl_xor(s, 32);
                if (fqx == 0) atomicAdd(ssq + (row0 + ai * 128 + m * 16), s); }
    }
};
}

struct MapIn { __device__ int operator()(int n) const { const int t = n >> 8, tc = n & 255, bj = tc >> 7, uu = tc & 127;
    if (t == 0) return n;
    if (t == 1) return uu < 64 ? C_KVLAT + 64 * bj + uu : (uu < 80 ? C_KROPE + 16 * bj + (uu - 64) : -1);
    if (t < 4) return C_ZMLA + (n - 512);
    if (t < 8) return (t < 6 ? C_QMB : C_KMB) + 256 * (t & 1) + 64 * (uu >> 5) + 32 * bj + (uu & 31);
    if (t < 10) return C_VMB + (n - 2048);
    if (t < 12) return C_ZMB + (n - 2560);
    if (t < 16) return C_GA + (n - 3072);
    return C_GB + (n - 4096); } };
struct MapUq { __device__ int operator()(int n) const { const int t = n >> 8, tc = n & 255, bj = tc >> 7, uu = tc & 127;
    if (t < 2) return 96 * (4 * t + (tc >> 6)) + (tc & 63);
    return 96 * (uu >> 4) + 64 + 16 * bj + (uu & 15); } };
struct MapUkv { __device__ int operator()(int n) const { const int t = n >> 8, tc = n & 255; return 128 * (4 * (t & 1) + (tc >> 6)) + (t < 2 ? 0 : 64) + (tc & 63); } };
struct MapId { __device__ int operator()(int n) const { return n; } };
template <class Map> __device__ __forceinline__ void wt_items(const float* W, int ldw, int Kreal, int K, int N, unsigned short* WT, const float* kscale, Map map, LAS float* scr, int gw, int ngw, int lane) {
    const int nblk = N / 32, nitems = (K / 64) * nblk;
    for (int it = gw; it < nitems; it += ngw) {
        const int kb = it / nblk, nb = it % nblk, k0 = 64 * kb, n0 = 32 * nb; const int src = map(n0 + (lane & 31));
#pragma unroll 8
        for (int i = 0; i < 32; ++i) { const int kk = 2 * i + (lane >> 5), k = k0 + kk; float v = 0.f; if (src >= 0 && k < Kreal) { v = W[(size_t)k * ldw + src]; if (kscale) v *= kscale[k]; } scr[kk * 33 + (lane & 31)] = v; }
        asm volatile("s_waitcnt lgkmcnt(0)" ::: "memory");
        const int c = lane & 7;
#pragma unroll
        for (int j = 0; j < 4; ++j) { const int n = (lane >> 3) + 8 * j; const LAS float* s = scr + (8 * c) * 33 + n;
            pg8::u32x4 o; o.x = pg8::pk_h2(s[0 * 33], s[1 * 33]); o.y = pg8::pk_h2(s[2 * 33], s[3 * 33]); o.z = pg8::pk_h2(s[4 * 33], s[5 * 33]); o.w = pg8::pk_h2(s[6 * 33], s[7 * 33]);
            *(pg8::u32x4*)(WT + (size_t)(n0 + n) * K + k0 + 8 * c) = o; }
        asm volatile("s_waitcnt lgkmcnt(0)" ::: "memory");
    }
}
constexpr size_t WT_IN = WS_WT, WT_UQ = WS_WT + 10 * MiB, WT_UKV = WT_UQ + 512 * 1024, WT_OA = WS_WT + 11 * MiB, WT_OB = WS_WT + 12 * MiB, WT_OUT = WS_WT + 13 * MiB;
__device__ __forceinline__ void ph_weights(const Params& p, LAS unsigned char* lds, int gw, int ngw, int wave, int lane) {
    LAS float* scr = (LAS float*)(lds + wave * 16384);
    wt_items(p.w_in, D_IN, 1024, 1024, 5120, (unsigned short*)(p.ws + WT_IN), nullptr, MapIn(), scr, gw, ngw, lane);
    wt_items(p.w_uq, 768, 256, 256, 768, (unsigned short*)(p.ws + WT_UQ), p.g_q, MapUq(), scr, gw, ngw, lane);
    wt_items(p.w_ukv, 1024, 128, 256, 1024, (unsigned short*)(p.ws + WT_UKV), p.g_kv, MapUkv(), scr, gw, ngw, lane);
    wt_items(p.w_o_mla, 1024, 512, 512, 1024, (unsigned short*)(p.ws + WT_OA), nullptr, MapId(), scr, gw, ngw, lane);
    wt_items(p.w_o_moba, 1024, 512, 512, 1024, (unsigned short*)(p.ws + WT_OB), nullptr, MapId(), scr, gw, ngw, lane);
    wt_items(p.w_out, 1024, 1024, 1024, 1024, (unsigned short*)(p.ws + WT_OUT), nullptr, MapId(), scr, gw, ngw, lane);
}

namespace att {
struct T1 { static constexpr bool value = true; }; struct T0 { static constexpr bool value = false; };
typedef _Float16 h8 __attribute__((ext_vector_type(8)));
typedef short s4 __attribute__((ext_vector_type(4)));
typedef short s8 __attribute__((ext_vector_type(8)));
typedef float f16v __attribute__((ext_vector_type(16)));
typedef unsigned u4 __attribute__((ext_vector_type(4)));
typedef short v4i16_t __attribute__((ext_vector_type(4)));
constexpr int KBUF = 16384, VBUF = 8192;
constexpr int NBUF = 4;
constexpr int L_K = 0, L_V = NBUF * KBUF, L_WS = L_V + NBUF * VBUF, L_TB = L_WS + 8 * 256, L_UN = L_TB + 256, L_END = L_UN + 64, L_OST = 0;
constexpr float THR = 8.f;
#ifndef PROBE_ABL
#define PROBE_ABL 0
#endif
#ifndef ATT_STAGGER
#define ATT_STAGGER 0
#endif
constexpr bool STAGGER = ATT_STAGGER;
__device__ __forceinline__ int crow(int r, int hi) { return (r & 3) + 8 * (r >> 2) + 4 * hi; }
template <int DK> __device__ __forceinline__ int kaddr(int row, int ch) { return DK == 64 ? row * 128 + ((ch ^ ((row >> 1) & 7)) << 4) : row * 256 + ((ch ^ (row & 15)) << 4); }
__device__ __forceinline__ s4 vtr(const LAS unsigned char* p) { return __builtin_bit_cast(s4, __builtin_amdgcn_ds_read_tr16_b64_v4i16((LAS v4i16_t*)p)); }
__device__ __forceinline__ float swapmax(float m) { auto rr = __builtin_amdgcn_permlane32_swap(__float_as_uint(m), __float_as_uint(m), false, false); return fmaxf(__uint_as_float(rr[0]), __uint_as_float(rr[1])); }
__device__ __forceinline__ float swapsum(float m) { auto rr = __builtin_amdgcn_permlane32_swap(__float_as_uint(m), __float_as_uint(m), false, false); return __uint_as_float(rr[0]) + __uint_as_float(rr[1]); }
__device__ __forceinline__ void glds16(const void* g, unsigned lds_base) { unsigned sv;
    asm volatile("s_mov_b32 %0, m0\n\ts_mov_b32 m0, %2\n\ts_nop 0\n\tglobal_load_lds_dwordx4 %1, off\n\ts_mov_b32 m0, %0" : "=&s"(sv) : "v"(g), "s"(lds_base) : "memory"); }
__device__ __forceinline__ float max3f(float a, float b, float c) { float r; asm("v_max3_f32 %0, %1, %2, %3" : "=v"(r) : "v"(a), "v"(b), "v"(c)); return r; }
__device__ __forceinline__ unsigned pkh(float lo, float hi) { typedef _Float16 h2 __attribute__((ext_vector_type(2))); h2 v; v[0] = (_Float16)lo; v[1] = (_Float16)hi; return __builtin_bit_cast(unsigned, v); }

template <int DK, bool MOBA, int ABL = 0>
__device__ __forceinline__ void attn_unit(unsigned char* ws, int b, int h, int qb, LAS unsigned char* lds, bool dry = false) {
    constexpr int ND = DK / 16, QP = MOBA ? 512 : 768, QH = MOBA ? 64 : 96;
    int tid_ = threadIdx.x; asm volatile("" : "+v"(tid_));
    const int tid = tid_, lane = tid & 63, r32 = lane & 31, hi = lane >> 5; const int wid = __builtin_amdgcn_readfirstlane(tid >> 6);
    const _Float16* Qg = (const _Float16*)(ws + (MOBA ? WS_QMB : WS_QMLA)); const _Float16* Kg = (const _Float16*)(ws + (MOBA ? WS_KMB : WS_KN));
    const _Float16* Vg = (const _Float16*)(ws + (MOBA ? WS_VMB : WS_VM)); const _Float16* Pg = (const _Float16*)(ws + WS_KPE); _Float16* Zg = (_Float16*)(ws + (MOBA ? WS_ZMB : WS_ZMLA));
    const size_t rowbase = (size_t)b * SEQ; const int q0 = qb * 256, qw0 = q0 + wid * 32, qrow = qw0 + r32;
    LAS float* wsf = (LAS float*)(lds + L_WS) + wid * 64; LAS int* tb = (LAS int*)(lds + L_TB); LAS unsigned* un = (LAS unsigned*)(lds + L_UN);
    h8 qr[ND];
#pragma unroll
    for (int d0 = 0; d0 < ND; ++d0) qr[d0] = *(const h8*)(Qg + (rowbase + qrow) * QP + h * QH + d0 * 16 + hi * 8);
#pragma unroll
    for (int d0 = 0; d0 < ND; ++d0) asm volatile("" : "+v"(qr[d0]));
    unsigned sel = 0u, blocks = (2u << qb) - 1u;
    if (MOBA) {
        const float* km = (const float*)(ws + WS_KMEAN) + (size_t)b * 16 * 512 + h * 64 + hi * 8;
        float g0 = -INFINITY, g1 = -INFINITY, g2 = -INFINITY; int i0 = -1, i1 = -1, i2 = -1;
        for (int m = 0; m < qb; ++m) {
            float part = 0.f;
#pragma unroll
            for (int d0 = 0; d0 < 4; ++d0) { const float4 a = *(const float4*)(km + m * 512 + d0 * 16), c = *(const float4*)(km + m * 512 + d0 * 16 + 4);
                part += (float)qr[d0][0] * a.x + (float)qr[d0][1] * a.y + (float)qr[d0][2] * a.z + (float)qr[d0][3] * a.w + (float)qr[d0][4] * c.x + (float)qr[d0][5] * c.y + (float)qr[d0][6] * c.z + (float)qr[d0][7] * c.w; }
            const float g = swapsum(part);
            if (g > g0) { g2 = g1; i2 = i1; g1 = g0; i1 = i0; g0 = g; i0 = m; }
            else if (g > g1) { g2 = g1; i2 = i1; g1 = g; i1 = m; }
            else if (g > g2) { g2 = g; i2 = m; }
        }
        if (i0 >= 0) sel |= 1u << i0; if (i1 >= 0) sel |= 1u << i1; if (i2 >= 0) sel |= 1u << i2;
        unsigned uw = sel;
#pragma unroll
        for (int o = 1; o < 64; o <<= 1) uw |= (unsigned)__shfl_xor((int)uw, o);
        if (lane == 0) un[wid] = uw;
        __syncthreads();
        unsigned ua = 0u;
#pragma unroll
        for (int w = 0; w < 8; ++w) ua |= un[w];
        blocks = (unsigned)__builtin_amdgcn_readfirstlane((int)(ua | (1u << qb)));
    }
    const int NT = 4 * __builtin_popcount(blocks);
    if (tid < 64 && tid < NT) { unsigned bm = blocks; for (int k = 0; k < (tid >> 2); ++k) bm &= bm - 1u; tb[tid] = (__builtin_ctz(bm) << 8) + ((tid & 3) << 6); }
    __syncthreads();
    const unsigned char* kbu = (const unsigned char*)(Kg + rowbase * 512 + h * 64); const unsigned char* vbu = (const unsigned char*)(Vg + rowbase * 512 + h * 64); const unsigned char* pbu = (const unsigned char*)(Pg + rowbase * 32);
    const unsigned char* kb0; const unsigned char* kb1 = nullptr; unsigned ksrc0, ksrc1 = 0u, kst0 = 1024u, kst1 = 1024u;
    if (DK == 96) { const int r0 = 4 * wid + (lane >> 4), r1 = r0 + 32; int c0 = (lane & 15) ^ (r0 & 15), c1 = (lane & 15) ^ (r1 & 15); if (c0 >= 12) c0 -= 4; if (c1 >= 12) c1 -= 4;
        const bool kpe0 = c0 >= 8, kpe1 = c1 >= 8;
        kb0 = kpe0 ? pbu : kbu; kst0 = kpe0 ? 64u : 1024u; ksrc0 = kpe0 ? (unsigned)(r0 * 32 + (c0 - 8) * 8) * 2u : (unsigned)(r0 * 512 + c0 * 8) * 2u;
        kb1 = kpe1 ? pbu : kbu; kst1 = kpe1 ? 64u : 1024u; ksrc1 = kpe1 ? (unsigned)(r1 * 32 + (c1 - 8) * 8) * 2u : (unsigned)(r1 * 512 + c1 * 8) * 2u;
    } else { const int r0 = 8 * wid + (lane >> 3), c0 = (lane & 7) ^ ((r0 >> 1) & 7); kb0 = kbu; ksrc0 = (unsigned)(r0 * 512 + c0 * 8) * 2u; }
    const unsigned vsrc = (unsigned)((16 * (wid & 3) + (lane >> 2)) * 512 + (wid >> 2) * 32 + (lane & 3) * 8) * 2u;
    constexpr int NDMA = (DK == 96) ? 3 : 2;
#define ATT_GLDS(src, dst) glds16((const void*)(src), (unsigned)__builtin_amdgcn_readfirstlane((int)(unsigned)(size_t)(dst)))
#define ATT_DMA(kb, buf) do { const unsigned kb_ = (unsigned)(kb); LAS unsigned char* kd_ = lds + L_K + (buf) * KBUF; \
        ATT_GLDS(kb0 + (ksrc0 + kb_ * kst0), kd_ + wid * 1024); \
        if (DK == 96) ATT_GLDS(kb1 + (ksrc1 + kb_ * kst1), kd_ + 8192 + wid * 1024); \
        ATT_GLDS(vbu + (vsrc + kb_ * 1024u), lds + L_V + (buf) * VBUF + wid * 1024); } while (0)
#define ATT_WAITV(n) asm volatile("s_waitcnt vmcnt(" #n ")" ::: "memory")
#define ATT_BAR() do { asm volatile("s_waitcnt lgkmcnt(0)" ::: "memory"); __builtin_amdgcn_s_barrier(); asm volatile("" ::: "memory"); } while (0)
    const int vro = ((lane >> 4) & 1) * 32 + (lane & 3) * 8 + (4 * hi + ((lane & 15) >> 2)) * 64;
    float l_reg = 0.f; bool init = false; f16v o[2]; o[0] = f16v{}; o[1] = f16v{}; f16v negm = f16v{}; asm volatile("" : "+v"(negm));
    constexpr int G = 2 * ND;
#define ATT_SBAR() __builtin_amdgcn_sched_barrier(0)
#define ATT_PIN(x) asm volatile("" : "+v"(x))
#define ATT_KF(buf, g) (*(const LAS h8*)(lds + L_K + (buf) * KBUF + kaddr<DK>(32 * ((g) & 1) + r32, 2 * ((g) >> 1) + hi)))
#define ATT_MF(a, b, c) __builtin_amdgcn_mfma_f32_32x32x16_f16(a, b, c, 0, 0, 0)
#define ATT_QK(P0, P1, buf) do { h8 kf_[G]; _Pragma("unroll") for (int g_ = 0; g_ < G; ++g_) kf_[g_] = ATT_KF(buf, g_); ATT_SBAR(); \
        _Pragma("unroll") for (int d_ = 0; d_ < ND; ++d_) { P0 = ATT_MF(kf_[2 * d_], qr[d_], d_ == 0 ? negm : P0); P1 = ATT_MF(kf_[2 * d_ + 1], qr[d_], d_ == 0 ? negm : P1); } } while (0)
#define ATT_MAXCHAIN(P0, P1, PM) do { float pa_ = max3f(P0[0], P0[1], P1[0]), pb_ = max3f(P0[2], P0[3], P1[1]); pa_ = max3f(pa_, P1[2], P1[3]); \
        _Pragma("unroll") for (int r_ = 4; r_ < 16; r_ += 4) { pa_ = max3f(pa_, P0[r_], P0[r_ + 1]); pb_ = max3f(pb_, P0[r_ + 2], P0[r_ + 3]); pa_ = max3f(pa_, P1[r_], P1[r_ + 1]); pb_ = max3f(pb_, P1[r_ + 2], P1[r_ + 3]); } \
        PM = swapmax(fmaxf(pa_, pb_)); } while (0)
#define ATT_MOVE(P0, P1, PM) do { const bool move_ = init ? ((PM) > THR) : ((PM) > -INFINITY); \
        if (__any(move_)) { const float dl_ = move_ ? (init ? fmaxf((PM), 0.f) : (PM)) : 0.f; const float al_ = (move_ && init) ? __builtin_amdgcn_exp2f(-dl_) : 1.f; \
            init = init || move_; l_reg *= al_; \
            _Pragma("unroll") for (int r_ = 0; r_ < 16; ++r_) { P0[r_] -= dl_; P1[r_] -= dl_; negm[r_] -= dl_; } \
            if (hi == 0) wsf[r32] = al_; asm volatile("s_waitcnt lgkmcnt(0)" ::: "memory"); \
            _Pragma("unroll") for (int r_ = 0; r_ < 16; ++r_) { const float a_ = wsf[crow(r_, hi)]; o[0][r_] *= a_; o[1][r_] *= a_; } } } while (0)
#define ATT_PACK(P0, P1, PW, KEEP) do { _Pragma("unroll") for (int k_ = 0; k_ < 2; ++k_) { \
            PW[k_] = (u4){pkh(P0[8 * k_], P0[8 * k_ + 1]), pkh(P0[8 * k_ + 2], P0[8 * k_ + 3]), pkh(P0[8 * k_ + 4], P0[8 * k_ + 5]), pkh(P0[8 * k_ + 6], P0[8 * k_ + 7])}; \
            PW[2 + k_] = (u4){pkh(P1[8 * k_], P1[8 * k_ + 1]), pkh(P1[8 * k_ + 2], P1[8 * k_ + 3]), pkh(P1[8 * k_ + 4], P1[8 * k_ + 5]), pkh(P1[8 * k_ + 6], P1[8 * k_ + 7])}; } \
        if (MOBA) { _Pragma("unroll") for (int k_ = 0; k_ < 4; ++k_) PW[k_] &= (KEEP); } } while (0)
#define ATT_VF(buf, i) (lds + L_V + (buf) * VBUF + vro + ((i) >> 2) * 4096 + ((i) & 3) * 1024)
#define ATT_WAIT_NEXT(t_) do { if ((t_) + 3 < NT) { if (NDMA == 3) ATT_WAITV(3); else ATT_WAITV(2); } else ATT_WAITV(0); } while (0)
#define ATT_TB(i) (MOBA ? tb[(i)] : 64 * (i))
    const int NF = NT - 4;
    ATT_DMA(ATT_TB(0), 0); ATT_DMA(ATT_TB(1), 1); ATT_DMA(ATT_TB(2), 2);
    if (NDMA == 3) ATT_WAITV(3); else ATT_WAITV(2);
    ATT_BAR();
    f16v pC0, pC1;
    if (NF > 0) { ATT_QK(pC0, pC1, 0); asm volatile("s_nop 15\n\ts_nop 7" : "+v"(pC0), "+v"(pC1)); float pm; ATT_MAXCHAIN(pC0, pC1, pm);
        if (MOBA && !((sel >> (ATT_TB(0) >> 8)) & 1u)) pm = -INFINITY; ATT_MOVE(pC0, pC1, pm); }
    auto step = [&](f16v& pC0, f16v& pC1, f16v& pN0, f16v& pN1, const int t, auto hn) __attribute__((always_inline)) {
        const int cur = t & 3, nx = (t + 1) & 3; constexpr bool hasn = decltype(hn)::value;
        ATT_DMA(ATT_TB(t + 3), (t + 3) & 3);
        const unsigned keepC = (!MOBA || ((sel >> (ATT_TB(t) >> 8)) & 1u)) ? 0xffffffffu : 0u;
        float ps = 0.f;
        if (hasn) {
            h8 kf[G];
#pragma unroll
            for (int g = 0; g < 4; ++g) kf[g] = ATT_KF(nx, g);
            ATT_SBAR();
#pragma unroll
            for (int g = 0; g < G; ++g) {
                if (g + 4 < G) kf[g + 4] = ATT_KF(nx, g + 4);
                if (g & 1) pN1 = ATT_MF(kf[g], qr[g >> 1], g == 1 ? negm : pN1); else pN0 = ATT_MF(kf[g], qr[g >> 1], g == 0 ? negm : pN0);
                constexpr int dummy = 0; (void)dummy;
                const int e0 = (ND == 4) ? 4 * g : (g < 8 ? 3 * g : 24 + 2 * (g - 8)), e1 = (ND == 4) ? 4 * g + 4 : (g < 8 ? 3 * g + 3 : 26 + 2 * (g - 8));
#pragma unroll
                for (int e = e0; e < e1; ++e) { if (e < 16) { pC0[e] = __builtin_amdgcn_exp2f(pC0[e]); ps += pC0[e]; } else { pC1[e - 16] = __builtin_amdgcn_exp2f(pC1[e - 16]); ps += pC1[e - 16]; } }
                ATT_PIN(pC0); ATT_PIN(pC1); ATT_PIN(ps); ATT_SBAR();
            }
        } else {
#pragma unroll
            for (int r = 0; r < 16; ++r) { pC0[r] = __builtin_amdgcn_exp2f(pC0[r]); pC1[r] = __builtin_amdgcn_exp2f(pC1[r]); ps += pC0[r] + pC1[r]; }
        }
        if (MOBA && !keepC) ps = 0.f;
        l_reg += swapsum(ps);
        u4 pw[4]; ATT_PACK(pC0, pC1, pw, keepC);
        {
            s4 vlo[8], vhi[8]; float pa = 0.f, pb = 0.f;
#pragma unroll
            for (int i = 0; i < 3; ++i) { vlo[i] = vtr(ATT_VF(cur, i)); vhi[i] = vtr(ATT_VF(cur, i) + 512); }
            if (hasn) asm volatile("s_nop 7" : "+v"(pN0), "+v"(pN1));
            ATT_SBAR();
#pragma unroll
            for (int i = 0; i < 8; ++i) {
                if (i + 3 < 8) { vlo[i + 3] = vtr(ATT_VF(cur, i + 3)); vhi[i + 3] = vtr(ATT_VF(cur, i + 3) + 512); }
                const s8 vv = (s8){vlo[i][0], vlo[i][1], vlo[i][2], vlo[i][3], vhi[i][0], vhi[i][1], vhi[i][2], vhi[i][3]};
                o[i >> 2] = ATT_MF(__builtin_bit_cast(h8, pw[i & 3]), __builtin_bit_cast(h8, vv), o[i >> 2]);
                if (hasn) {
                    if (i == 0) { pa = max3f(pN0[0], pN0[1], pN1[0]); pb = max3f(pN0[2], pN0[3], pN1[1]); }
                    else if (i == 1) { pa = max3f(pa, pN1[2], pN1[3]); pb = max3f(pb, pN0[6], pN0[7]); }
                    else if (i == 2) { pa = max3f(pa, pN0[4], pN0[5]); pb = max3f(pb, pN1[6], pN1[7]); }
                    else if (i == 3) { pa = max3f(pa, pN1[4], pN1[5]); pb = max3f(pb, pN0[10], pN0[11]); }
                    else if (i == 4) { pa = max3f(pa, pN0[8], pN0[9]); pb = max3f(pb, pN1[10], pN1[11]); }
                    else if (i == 5) { pa = max3f(pa, pN1[8], pN1[9]); pb = max3f(pb, pN0[14], pN0[15]); }
                    else if (i == 6) { pa = max3f(pa, pN0[12], pN0[13]); pb = max3f(pb, pN1[14], pN1[15]); }
                    else { pa = max3f(pa, pN1[12], pN1[13]); }
                    ATT_PIN(pa); ATT_PIN(pb);
                }
                ATT_SBAR();
            }
            if (hasn) { float pm = swapmax(fmaxf(pa, pb)); if (MOBA && !((sel >> (ATT_TB(t + 1) >> 8)) & 1u)) pm = -INFINITY; ATT_MOVE(pN0, pN1, pm); }
        }
        if (NDMA == 3) ATT_WAITV(3); else ATT_WAITV(2);
        ATT_BAR();
    };
    {
        f16v pD0, pD1; int t = 0;
        for (; t + 2 < NF; t += 2) { step(pC0, pC1, pD0, pD1, t, T1{}); step(pD0, pD1, pC0, pC1, t + 1, T1{}); }
        if (t + 1 < NF) { step(pC0, pC1, pD0, pD1, t, T1{}); step(pD0, pD1, pC0, pC1, t + 1, T0{}); }
        else if (t < NF) step(pC0, pC1, pD0, pD1, t, T0{});
    }
    for (int t = NF; t < NT; ++t) {
        const int cur = t & 3, kb = ATT_TB(t);
        if (t + 3 < NT) ATT_DMA(ATT_TB(t + 3), (t + 3) & 3);
        if (kb <= qw0 + 31) {
            f16v p0, p1; ATT_QK(p0, p1, cur);
            if (kb + 63 > qw0) {
#pragma unroll
                for (int r = 0; r < 16; ++r) { const int kv = kb + crow(r, hi); if (kv > qrow) p0[r] = -INFINITY; if (kv + 32 > qrow) p1[r] = -INFINITY; }
            }
            asm volatile("s_nop 15\n\ts_nop 7" : "+v"(p0), "+v"(p1));
            float pm; ATT_MAXCHAIN(p0, p1, pm); ATT_MOVE(p0, p1, pm);
            s4 vlo[8], vhi[8];
#pragma unroll
            for (int i = 0; i < 8; ++i) { vlo[i] = vtr(ATT_VF(cur, i)); vhi[i] = vtr(ATT_VF(cur, i) + 512); }
            ATT_SBAR();
            float ps = 0.f;
#pragma unroll
            for (int r = 0; r < 16; ++r) { p0[r] = __builtin_amdgcn_exp2f(p0[r]); p1[r] = __builtin_amdgcn_exp2f(p1[r]); ps += p0[r] + p1[r]; }
            l_reg += swapsum(ps);
            u4 pw[4]; ATT_PACK(p0, p1, pw, 0xffffffffu);
#pragma unroll
            for (int i = 0; i < 8; ++i) { const s8 vv = (s8){vlo[i][0], vlo[i][1], vlo[i][2], vlo[i][3], vhi[i][0], vhi[i][1], vhi[i][2], vhi[i][3]};
                o[i >> 2] = ATT_MF(__builtin_bit_cast(h8, pw[i & 3]), __builtin_bit_cast(h8, vv), o[i >> 2]); }
        }
        ATT_WAIT_NEXT(t);
        ATT_BAR();
    }
    if (hi == 0) wsf[32 + r32] = l_reg; asm volatile("s_waitcnt lgkmcnt(0)" ::: "memory");
    LAS _Float16* stg = (LAS _Float16*)(lds + L_OST) + wid * 2048;
#pragma unroll
    for (int r = 0; r < 16; ++r) { const int orow = crow(r, hi); const float rl = 1.f / wsf[32 + orow];
        stg[orow * 64 + r32] = (_Float16)(o[0][r] * rl); stg[orow * 64 + 32 + r32] = (_Float16)(o[1][r] * rl); }
    asm volatile("s_waitcnt lgkmcnt(0)" ::: "memory");
    int lane_e = lane; asm volatile("" : "+v"(lane_e));
    unsigned char* zbu = (unsigned char*)(Zg + (rowbase + qw0) * 512 + h * 64);
#pragma unroll
    for (int i = 0; i < 4; ++i) { const int row = i * 8 + (lane_e >> 3), ch = lane_e & 7; const h8 v = *(const LAS h8*)(stg + row * 64 + ch * 8);
        _Float16* zp = (_Float16*)(zbu + (unsigned)(row * 512 + ch * 8) * 2u); const h8 z = *(const h8*)zp; h8 ov;
#pragma unroll
        for (int j = 0; j < 8; ++j) ov[j] = (_Float16)((float)v[j] * (float)z[j]);
        if (!dry) *(h8*)zp = ov; }
    __syncthreads();
#undef ATT_GLDS
#undef ATT_DMA
#undef ATT_WAITV
#undef ATT_BAR
#undef ATT_SBAR
#undef ATT_PIN
#undef ATT_KF
#undef ATT_MF
#undef ATT_QK
#undef ATT_MAXCHAIN
#undef ATT_MOVE
#undef ATT_PACK
#undef ATT_VF
#undef ATT_WAIT_NEXT
#undef ATT_TB
}

__device__ __forceinline__ void attn_phase(unsigned char* ws, LAS unsigned char* lds, int vb, int nvb) {
    const int vcu = (nvb % 8 == 0) ? (vb % 8) * (nvb / 8) + vb / 8 : vb; const int per = (1024 + nvb - 1) / nvb;
    for (int k = 0; k < per; ++k) {
        int it;
        if (nvb == 256) { const int xg = vcu >> 5, lw = vcu & 31; it = ((16 * xg + 4 * k + (lw >> 3)) << 3) | (lw & 7); }
        else { it = vcu * per + k; if (it >= 1024) break; }
        const int bh = it >> 3, pr = it & 7, b = bh >> 3, h = bh & 7;
        if (PROBE == 2) for (int uu = 0; uu < 2; ++uu) attn_unit<96, false, PROBE_ABL>(ws, b, h, uu ? 15 - pr : pr, lds, true);
        for (int uu = 0; uu < 2; ++uu) attn_unit<96, false>(ws, b, h, uu ? 15 - pr : pr, lds);
        if (PROBE == 3) for (int uu = 0; uu < 2; ++uu) attn_unit<64, true, PROBE_ABL>(ws, b, h, uu ? 15 - pr : pr, lds, true);
        for (int uu = 0; uu < 2; ++uu) attn_unit<64, true>(ws, b, h, uu ? 15 - pr : pr, lds);
    }
}
}

constexpr int RING_BYTES = 131072, MISC_OFF = RING_BYTES + 320, LDS_BYTES = 147456;
constexpr int CW_BAR = 4096;

__global__ void __launch_bounds__(512, 2) mega(Params p) {
    extern __shared__ __attribute__((aligned(16))) unsigned char lds[];
    const int vb = blockIdx.x, nvb = gridDim.x, tid = threadIdx.x, lane = tid & 63, wave = tid >> 6;
    const int gtid = vb * 512 + tid, gsize = nvb * 512, gwave = vb * 8 + wave, nwaves = nvb * 8;
    volatile LAS unsigned* misc = (volatile LAS unsigned*)((LAS unsigned char*)lds + MISC_OFF);
    if (tid < 32) misc[tid] = 0u;
    __syncthreads();
    XcdBarrier bar = xcd_barrier_post((unsigned*)(p.ws + WS_CTL) + CW_BAR, misc + 8);
    LAS unsigned char* ldsl = (LAS unsigned char*)lds;
    { int t_ = threadIdx.x; asm volatile("" : "+v"(t_)); ph_prep(p, vb * 512 + t_, gsize); ph_weights(p, ldsl, vb * 8 + (t_ >> 6), nwaves, t_ >> 6, t_ & 63); }
    xcd_barrier(bar);
    for (int rep4 = 0; rep4 < (PROBE == 4 ? 2 : 1); ++rep4) { int t_ = threadIdx.x; asm volatile("" : "+v"(t_)); ph_hnorm(p, vb * 8 + (t_ >> 6), nwaves, t_ & 63); }
    xcd_barrier(bar);
    {
        pg8::Gemm g{(const pg8::bf16_t*)(p.ws + WS_H), (const pg8::bf16_t*)(p.ws + WT_IN), M_, 5120, 1024}; pg8::StaticOrder S; S.init(M_, 5120, nvb, vb);
        for (int rep = (PROBE == 1 ? 1 : 0); rep >= 0; --rep) { pg8::EpiInF E{p.ws, p.b_merge, rep}; pg8::gemm_phase<pg8::EpiInF, pg8::StaticOrder, true, true>(ldsl, g, S, E); }
        if (PROBE == 5) { pg8::EpiNull E; pg8::gemm_phase<pg8::EpiNull, pg8::StaticOrder, true, true>(ldsl, g, S, E); }
    }
    xcd_barrier(bar);
    for (int rep4 = 0; rep4 < (PROBE == 4 ? 2 : 1); ++rep4) {
        pg8::Gemm g{(const pg8::bf16_t*)(p.ws + WS_QLAT), (const pg8::bf16_t*)(p.ws + WT_UQ), M_, 768, 256}; pg8::StaticOrder S; S.init(M_, 768, nvb, vb);
        pg8::EpiUqF E{p.ws}; pg8::gemm_phase<pg8::EpiUqF, pg8::StaticOrder, true, true>(ldsl, g, S, E);
    }
    for (int rep4 = 0; rep4 < (PROBE == 4 ? 2 : 1); ++rep4) {
        pg8::Gemm g{(const pg8::bf16_t*)(p.ws + WS_KVL), (const pg8::bf16_t*)(p.ws + WT_UKV), M_, 1024, 256}; pg8::StaticOrder S; S.init(M_, 1024, nvb, vb);
        pg8::EpiUkvF E{p.ws}; pg8::gemm_phase<pg8::EpiUkvF, pg8::StaticOrder, true, true>(ldsl, g, S, E);
    }
    xcd_barrier(bar);
    att::attn_phase(p.ws, ldsl, vb, nvb);
    xcd_barrier(bar);
    for (int rep4 = 0; rep4 < (PROBE == 4 ? 2 : 1); ++rep4) {
        pg8::Gemm g{(const pg8::bf16_t*)(p.ws + WS_ZMLA), (const pg8::bf16_t*)(p.ws + WT_OA), M_, 1024, 512}; pg8::StaticOrder S; S.init(M_, 1024, nvb, vb);
        pg8::EpiYabF<0> E{p.ws}; pg8::gemm_phase<pg8::EpiYabF<0>, pg8::StaticOrder, true, true>(ldsl, g, S, E);
    }
    for (int rep4 = 0; rep4 < (PROBE == 4 ? 2 : 1); ++rep4) {
        pg8::Gemm g{(const pg8::bf16_t*)(p.ws + WS_ZMB), (const pg8::bf16_t*)(p.ws + WT_OB), M_, 1024, 512}; pg8::StaticOrder S; S.init(M_, 1024, nvb, vb);
        pg8::EpiYabF<1> E{p.ws}; pg8::gemm_phase<pg8::EpiYabF<1>, pg8::StaticOrder, true, true>(ldsl, g, S, E);
    }
    xcd_barrier(bar);
    for (int rep4 = 0; rep4 < (PROBE == 4 ? 2 : 1); ++rep4) {
        pg8::Gemm g{(const pg8::bf16_t*)(p.ws + WS_YM), (const pg8::bf16_t*)(p.ws + WT_OUT), M_, 1024, 1024}; pg8::StaticOrder S; S.init(M_, 1024, nvb, vb);
        pg8::EpiYF E{p.ws}; pg8::gemm_phase<pg8::EpiYF, pg8::StaticOrder, true, true>(ldsl, g, S, E);
    }
    xcd_barrier(bar);
    for (int rep4 = 0; rep4 < (PROBE == 4 ? 2 : 1); ++rep4) { int t_ = threadIdx.x; asm volatile("" : "+v"(t_)); ph_final(p, vb * 8 + (t_ >> 6), nwaves, t_ & 63); }
}

template <int PH> __global__ void __launch_bounds__(512, 2) k_ph(Params p) {
    extern __shared__ __attribute__((aligned(16))) unsigned char lds[];
    const int vb = blockIdx.x, nvb = gridDim.x, tid = threadIdx.x, lane = tid & 63, wave = tid >> 6;
    const int gtid = vb * 512 + tid, gsize = nvb * 512, gwave = vb * 8 + wave, nwaves = nvb * 8;
    if (PH == 0) ph_prep(p, gtid, gsize);
    if (PH == 1) ph_hnorm(p, gwave, nwaves, lane);
    if (PH == 2) { EpiIn e{p.ws, p.b_merge}; gemm_naive<h16, EpiIn>((const h16*)(p.ws + WS_H), DM, p.w_in, D_IN, nullptr, DM, D_IN, e, (float*)lds, vb, nvb); }
    if (PH == 3) { EpiUq e{p.ws}; gemm_naive<h16, EpiUq>((const h16*)(p.ws + WS_QLAT), 256, p.w_uq, 768, p.g_q, 256, 768, e, (float*)lds, vb, nvb); }
    if (PH == 4) { EpiUkv e{p.ws}; gemm_naive<h16, EpiUkv>((const h16*)(p.ws + WS_KVL), 256, p.w_ukv, 1024, p.g_kv, 128, 1024, e, (float*)lds, vb, nvb); }
    if (PH == 5) ph_kmean(p, gtid, gsize);
    if (PH == 6) ph_attn_mla_naive(p, vb, nvb);
    if (PH == 7) ph_attn_moba_naive(p, vb, nvb);
    if (PH == 8) { EpiYa e{p.ws}; gemm_naive<h16, EpiYa>((const h16*)(p.ws + WS_ZMLA), 512, p.w_o_mla, 1024, nullptr, 512, 1024, e, (float*)lds, vb, nvb); }
    if (PH == 9) { EpiYb e{p.ws}; gemm_naive<h16, EpiYb>((const h16*)(p.ws + WS_ZMB), 512, p.w_o_moba, 1024, nullptr, 512, 1024, e, (float*)lds, vb, nvb); }
    if (PH == 10) { EpiY e{p.ws}; gemm_naive<h16, EpiY>((const h16*)(p.ws + WS_YM), 1024, p.w_out, 1024, nullptr, 1024, 1024, e, (float*)lds, vb, nvb); }
    if (PH == 11) ph_final(p, gwave, nwaves, lane);
}

extern "C" void kernel_launch(void* const* d_in, const int* in_sizes, int n_in, void* d_out, int out_size, void* d_ws, size_t ws_size, hipStream_t stream) {
    if (n_in != 16 || out_size != M_ * DM || ws_size < WS_END) { fprintf(stderr, "kernel_launch: unexpected shapes (n_in %d, out %d, ws %zu)\n", n_in, out_size, ws_size); return; }
    Params p{};
    p.x = (const float*)d_in[0]; p.c = (const float*)d_in[1]; p.pos = (const int*)d_in[2]; p.w_ada = (const float*)d_in[3]; p.b_ada = (const float*)d_in[4];
    p.g_pre = (const float*)d_in[5]; p.g_post = (const float*)d_in[6]; p.w_in = (const float*)d_in[7]; p.g_q = (const float*)d_in[8]; p.w_uq = (const float*)d_in[9];
    p.g_kv = (const float*)d_in[10]; p.w_ukv = (const float*)d_in[11]; p.w_o_mla = (const float*)d_in[12]; p.w_o_moba = (const float*)d_in[13]; p.b_merge = (const float*)d_in[14]; p.w_out = (const float*)d_in[15];
    p.out = (float*)d_out; p.ws = (unsigned char*)d_ws;
    static int grid = 0;
    if (grid == 0) {
        int dev = 0, cus = 0, per_cu = 0;
        if (hipGetDevice(&dev) != hipSuccess || hipDeviceGetAttribute(&cus, hipDeviceAttributeMultiprocessorCount, dev) != hipSuccess) { fprintf(stderr, "kernel_launch: device query failed\n"); grid = -1; return; }
        if (hipFuncSetAttribute((const void*)mega, hipFuncAttributeMaxDynamicSharedMemorySize, LDS_BYTES) != hipSuccess) { fprintf(stderr, "kernel_launch: hipFuncSetAttribute failed\n"); grid = -1; return; }
        if (hipOccupancyMaxActiveBlocksPerMultiprocessor(&per_cu, (const void*)mega, 512, LDS_BYTES) != hipSuccess || per_cu < 1) { fprintf(stderr, "kernel_launch: occupancy query says %d\n", per_cu); }
        (void)hipGetLastError();
        grid = cus;
    }
    if (grid < 0) return;
    (void)hipMemsetAsync(d_ws, 0, ZERO_BYTES, stream);
#if defined(MULTI_LAUNCH)
    const int G = 1024, L = 32768;
    hipLaunchKernelGGL(k_ph<0>, dim3(G), dim3(512), L, stream, p);
    hipLaunchKernelGGL(k_ph<1>, dim3(G), dim3(512), L, stream, p);
    hipLaunchKernelGGL(k_ph<2>, dim3(G), dim3(512), L, stream, p);
    hipLaunchKernelGGL(k_ph<3>, dim3(G), dim3(512), L, stream, p);
    hipLaunchKernelGGL(k_ph<4>, dim3(G), dim3(512), L, stream, p);
    hipLaunchKernelGGL(k_ph<5>, dim3(G), dim3(512), L, stream, p);
    hipLaunchKernelGGL(k_ph<6>, dim3(G), dim3(512), L, stream, p);
    hipLaunchKernelGGL(k_ph<7>, dim3(G), dim3(512), L, stream, p);
    hipLaunchKernelGGL(k_ph<8>, dim3(G), dim3(512), L, stream, p);
    hipLaunchKernelGGL(k_ph<9>, dim3(G), dim3(512), L, stream, p);
    hipLaunchKernelGGL(k_ph<10>, dim3(G), dim3(512), L, stream, p);
    hipLaunchKernelGGL(k_ph<11>, dim3(G), dim3(512), L, stream, p);
#else
    hipLaunchKernelGGL(mega, dim3(grid), dim3(512), LDS_BYTES, stream, p);
#endif
}
```

```cpp
#include <hip/hip_runtime.h>
#include <cstdio>
#ifndef PROBE
#define PROBE 0
#endif
#include <cstdint>

typedef _Float16 h16;
typedef _Float16 h16x4 __attribute__((ext_vector_type(4)));
typedef _Float16 h2n __attribute__((ext_vector_type(2)));

constexpr int NB = 16, SEQ = 4096, DM = 1024, M_ = NB * SEQ, NH = 8;
constexpr int D_IN = 5024;
constexpr int C_QLAT = 0, C_KVLAT = 256, C_KROPE = 384, C_ZMLA = 416, C_QMB = 928, C_KMB = 1440, C_VMB = 1952, C_ZMB = 2464, C_GA = 2976, C_GB = 4000;
constexpr float EPS = 1e-6f;
constexpr float LOG2E = 1.4426950408889634f;
constexpr float SC_MLA = 0.10206207261596577f * LOG2E;
constexpr float SC_MB = 0.125f * LOG2E;

constexpr size_t MiB = 1u << 20;
constexpr size_t WS_CTL = 0, WS_KMEAN = 512 * 1024, WS_SSQ = 1 * MiB, WS_SSQY = WS_SSQ + 2 * (size_t)M_ * 4, ZERO_BYTES = 2 * MiB;
constexpr size_t WS_MOD = WS_SSQ + 3 * (size_t)M_ * 4, WS_TAB = 4 * MiB, WS_WT = 20 * MiB;
constexpr size_t WS_H = 36 * MiB, WS_KN = 36 * MiB, WS_VM = 100 * MiB;
constexpr size_t WS_QLAT = 164 * MiB, WS_KVL = 196 * MiB, WS_KPE = 228 * MiB, WS_VMB = 232 * MiB;
constexpr size_t WS_QMB = 296 * MiB, WS_KMB = 360 * MiB, WS_ZCAT = 424 * MiB, WS_YM = 296 * MiB;
constexpr size_t WS_GA = 552 * MiB, WS_GB = 616 * MiB, WS_Y = 680 * MiB,     WS_QMLA = 808 * MiB, WS_END = 904 * MiB;

static_assert(WS_MOD + (size_t)NB * 3072 * 4 <= ZERO_BYTES, "MOD inside the zeroed region");
struct Params {
    const float *x, *c; const int* pos; const float *w_ada, *b_ada, *g_pre, *g_post, *w_in, *g_q, *w_uq, *g_kv, *w_ukv, *w_o_mla, *w_o_moba, *b_merge, *w_out;
    float* out; unsigned char* ws;
};

__device__ __forceinline__ float wave_sum(float v) {
#pragma unroll
    for (int o = 1; o < 64; o <<= 1) v += __shfl_xor(v, o);
    return v;
}
__device__ __forceinline__ float silu_f(float v) { return v / (1.f + __expf(-v)); }
__device__ __forceinline__ float sigmoid_f(float v) { return 1.f / (1.f + __expf(-v)); }

__device__ void ph_prep(const Params& p, int gtid, int gsize) {
    float* mod = (float*)(p.ws + WS_MOD);
    { const int gw = gtid >> 6, ngw = gsize >> 6, ln = gtid & 63;
      for (int it = gw; it < 48 * 32; it += ngw) {
          const int cg = it % 48, kc = it / 48, j = cg * 64 + ln, k0 = kc * 32; float acc[NB];
#pragma unroll
          for (int b = 0; b < NB; ++b) acc[b] = (kc == 0) ? p.b_ada[j] : 0.f;
          for (int kk = 0; kk < 32; ++kk) { const float w = p.w_ada[(size_t)(k0 + kk) * 3072 + j];
#pragma unroll
              for (int b = 0; b < NB; ++b) { const float cv = p.c[b * DM + k0 + kk]; acc[b] = fmaf(cv / (1.f + __expf(-cv)), w, acc[b]); } }
#pragma unroll
          for (int b = 0; b < NB; ++b) atomicAdd(mod + b * 3072 + j, acc[b]);
      } }
    unsigned* tab = (unsigned*)(p.ws + WS_TAB);
    for (int i = gtid; i < M_ * 32; i += gsize) {
        const int m = i >> 5, f = i & 31;
        const double inv = exp2(-(double)f * (13.287712379549449 / 32.0));
        const double a = (double)p.pos[m] * inv;
        const double k = rint(a * 0.15915494309189535);
        const double r = (a - k * 6.283185307179586) - k * 2.4492935982947064e-16;
        { typedef _Float16 h2t __attribute__((ext_vector_type(2))); h2t cs; cs[0] = (_Float16)(float)cos(r); cs[1] = (_Float16)(float)sin(r); tab[i] = __builtin_bit_cast(unsigned, cs); }
    }
}

__device__ void ph_hnorm(const Params& p, int gwave, int nwaves, int lane) {
    const float* mod = (const float*)(p.ws + WS_MOD); h16* H = (h16*)(p.ws + WS_H);
    for (int m0 = 2 * gwave; m0 < M_; m0 += 2 * nwaves) {
        float4 v[2][4]; float ss[2];
#pragma unroll
        for (int r = 0; r < 2; ++r) { const float4* xr = (const float4*)(p.x + (size_t)(m0 + r) * DM);
#pragma unroll
            for (int j = 0; j < 4; ++j) v[r][j] = xr[lane + 64 * j]; }
#pragma unroll
        for (int r = 0; r < 2; ++r) { float s = 0.f;
#pragma unroll
            for (int j = 0; j < 4; ++j) s += (v[r][j].x * v[r][j].x + v[r][j].y * v[r][j].y) + (v[r][j].z * v[r][j].z + v[r][j].w * v[r][j].w);
            ss[r] = wave_sum(s); }
        const int b = m0 >> 12;
#pragma unroll
        for (int j = 0; j < 4; ++j) {
            const int col = 4 * (lane + 64 * j);
            const float4 g = *(const float4*)(p.g_pre + col), sc = *(const float4*)(mod + b * 3072 + 1024 + col), sh = *(const float4*)(mod + b * 3072 + col);
#pragma unroll
            for (int r = 0; r < 2; ++r) { const float rstd = 1.f / sqrtf(ss[r] * (1.f / DM) + EPS); const float4 x = v[r][j];
                h16x4 o; o[0] = (h16)(x.x * rstd * g.x * (1.f + sc.x) + sh.x); o[1] = (h16)(x.y * rstd * g.y * (1.f + sc.y) + sh.y);
                o[2] = (h16)(x.z * rstd * g.z * (1.f + sc.z) + sh.z); o[3] = (h16)(x.w * rstd * g.w * (1.f + sc.w) + sh.w);
                *(h16x4*)(H + (size_t)(m0 + r) * DM + col) = o; }
        }
    }
}

__device__ void ph_final(const Params& p, int gwave, int nwaves, int lane) {
    const float* mod = (const float*)(p.ws + WS_MOD); const h16* Y = (const h16*)(p.ws + WS_Y); const float* ssq = (const float*)(p.ws + WS_SSQY);
    for (int m0 = 2 * gwave; m0 < M_; m0 += 2 * nwaves) {
        const int b = m0 >> 12; h16x4 yv[2][4]; float4 xv[2][4]; float rstd[2];
#pragma unroll
        for (int r = 0; r < 2; ++r) { const h16x4* yr = (const h16x4*)(Y + (size_t)(m0 + r) * DM); const float4* xr = (const float4*)(p.x + (size_t)(m0 + r) * DM); rstd[r] = ssq[m0 + r];
#pragma unroll
            for (int j = 0; j < 4; ++j) { yv[r][j] = yr[lane + 64 * j]; xv[r][j] = xr[lane + 64 * j]; } }
#pragma unroll
        for (int j = 0; j < 4; ++j) {
            const int col = 4 * (lane + 64 * j); const float4 g = *(const float4*)(p.g_post + col), gt = *(const float4*)(mod + b * 3072 + 2048 + col);
#pragma unroll
            for (int r = 0; r < 2; ++r) { const float rs = 1.f / sqrtf(rstd[r] * (1.f / DM) + EPS); const h16x4 y = yv[r][j]; const float4 x = xv[r][j];
                ((float4*)(p.out + (size_t)(m0 + r) * DM))[lane + 64 * j] = make_float4(x.x + gt.x * (float)y[0] * rs * g.x, x.y + gt.y * (float)y[1] * rs * g.y, x.z + gt.z * (float)y[2] * rs * g.z, x.w + gt.w * (float)y[3] * rs * g.w); }
        }
    }
}


#define XB_TMO      128
#define XB_XCNT(j)  (256  + 64 * (j))
#define XB_XSUB(j)  (1280 + 64 * (j))
#define XB_XGEN(j)  (2304 + 64 * (j))
#define XB_TOP      3328
#define XB_TOPGEN   3392
#define XCD_BAR_WORDS 3456
#define XB_SPIN_CAP (1u << 27)
#define LAS __attribute__((address_space(3)))
__device__ __forceinline__ unsigned xb_ld(unsigned* p)              { return __hip_atomic_load(p, __ATOMIC_RELAXED, __HIP_MEMORY_SCOPE_AGENT); }
__device__ __forceinline__ unsigned xb_add(unsigned* p, unsigned v) { return __hip_atomic_fetch_add(p, v, __ATOMIC_RELAXED, __HIP_MEMORY_SCOPE_AGENT); }
__device__ __forceinline__ unsigned xb_xcc_id() { return (unsigned)__builtin_amdgcn_s_getreg((3 << 11) | 20) & 0xFu; }
#define XB_SPIN(cond, bar) do { unsigned _sp = 0; while (cond) { __builtin_amdgcn_s_sleep(1); \
    if ((++_sp & 255u) == 0u) { if (xb_ld(&(bar)[XB_TMO])) break; if (_sp > XB_SPIN_CAP) { atomicAdd(&(bar)[XB_TMO], 1u); break; } } } } while (0)
struct XcdBarrier { unsigned* bar; unsigned x; volatile LAS unsigned* st; };
__device__ __forceinline__ XcdBarrier xcd_barrier_post(unsigned* bar, volatile LAS unsigned* st) {
    XcdBarrier b; b.bar = bar; b.x = xb_xcc_id(); b.st = st;
    if (threadIdx.x == 0) (void)xb_add(&bar[XB_XCNT(b.x)], 1u);
    return b;
}
__device__ __forceinline__ void xcd_barrier_complete(unsigned* bar, unsigned x, unsigned& nloc, unsigned& nx) {
    const unsigned G = gridDim.x * gridDim.y * gridDim.z;
    unsigned sum, cnt, mine, sp = 0u;
    for (;;) {
        sum = 0u; cnt = 0u; mine = 0u;
#pragma unroll
        for (unsigned j = 0; j < 16; ++j) { const unsigned c = xb_ld(&bar[XB_XCNT(j)]); sum += c; cnt += (c > 0u) ? 1u : 0u; mine = (j == x) ? c : mine; }
        if (sum == G) break;
        __builtin_amdgcn_s_sleep(1);
        if ((++sp & 255u) == 0u) { if (xb_ld(&bar[XB_TMO])) break; if (sp > XB_SPIN_CAP) { atomicAdd(&bar[XB_TMO], 1u); break; } }
    }
    nloc = mine > 0u ? mine : 1u; nx = cnt > 0u ? cnt : 1u;
}
__device__ __forceinline__ void xcd_barrier(const XcdBarrier& b) {
    asm volatile("s_waitcnt vmcnt(0)" ::: "memory");
    __syncthreads();
    if (threadIdx.x == 0) {
        unsigned* bar = b.bar;
        __builtin_amdgcn_s_waitcnt(0);
        unsigned nloc = b.st[0], nx = b.st[1];
        if (nloc == 0u) { xcd_barrier_complete(bar, b.x, nloc, nx); b.st[0] = nloc; b.st[1] = nx; }
        const unsigned old = xb_add(&bar[XB_XSUB(b.x)], 1u);
        const unsigned gen = old / nloc;
        if (old + 1u == (gen + 1u) * nloc) {
            __builtin_amdgcn_fence(__ATOMIC_RELEASE, "agent");
            asm volatile("s_waitcnt vmcnt(0)" ::: "memory");
            const unsigned og = xb_add(&bar[XB_TOP], 1u);
            const unsigned tg = og / nx;
            if (og + 1u == (tg + 1u) * nx) xb_add(&bar[XB_TOPGEN], 1u);
            else XB_SPIN(xb_ld(&bar[XB_TOPGEN]) == tg, bar);
            __builtin_amdgcn_fence(__ATOMIC_ACQUIRE, "agent");
            xb_add(&bar[XB_XGEN(b.x)], 1u);
            asm volatile("s_waitcnt vmcnt(0)" ::: "memory");
        } else {
            XB_SPIN(xb_ld(&bar[XB_XGEN(b.x)]) == gen, bar);
            __builtin_amdgcn_fence(__ATOMIC_ACQUIRE, "agent");
            asm volatile("s_waitcnt vmcnt(0)" ::: "memory");
        }
    }
    __syncthreads();
}

namespace pg8 {
#define PG8_LAS __attribute__((address_space(3)))
typedef unsigned short bf16_t;
typedef _Float16 bf16x8 __attribute__((ext_vector_type(8)));
typedef float f32x4 __attribute__((ext_vector_type(4)));
typedef unsigned u32x4 __attribute__((ext_vector_type(4)));
constexpr int BM = 256, BK = 64, HALF = 128, HTB = HALF * BK * 2  , STAGE_BYTES = 8 * HTB, NXCD = 8, WGM = 8;

__host__ __device__ __forceinline__ int lds_byte(int r, int c) { const int st = (r >> 4) * 2 + (c >> 5), rr = r & 15, cc = c & 31, ob = rr * 64 + cc * 2; return st * 1024 + (ob ^ (((ob >> 9) & 1) << 5)); }
__host__ __device__ __forceinline__ void stage_rc(int b, int& R, int& C) { const int st = b / 1024, sb = b % 1024, swz = sb ^ (((sb >> 9) & 1) << 5); R = (st >> 1) * 16 + swz / 64; C = (st & 1) * 32 + (swz % 64) / 2; }
__host__ __device__ __forceinline__ int perm32(int rho) { const int n = rho >> 4, i = rho & 15; return 8 * (i >> 2) + 4 * n + (i & 3); }

struct Unit { int pm, pn; };
struct Gemm { const bf16_t* A; const bf16_t* Bt; int M, N, K; };

struct StaticOrder {
    int nM, nN, nwg, G, c;
    __host__ __device__ void init(int M, int N, int G_, int c_) { nM = M / BM; nN = N / BM; nwg = nM * nN; G = G_; c = c_; }
    __host__ __device__ bool next(int i, Unit& u) const {
        const long L = (long)i * G + c; if (L >= nwg) return false;
        int wgid = (int)L; { const int q = nwg / NXCD, r = nwg % NXCD, xcd = wgid % NXCD, off = wgid / NXCD; wgid = (xcd < r ? xcd * (q + 1) : r * (q + 1) + (xcd - r) * q) + off; }
        const int nig = WGM * nN, gid = wgid / nig, fm = gid * WGM, gsz = (nM - fm) < WGM ? (nM - fm) : WGM;
        u.pm = fm + ((wgid % nig) % gsz); u.pn = (wgid % nig) / gsz; return true;
    }
    __device__ __forceinline__ void a_ready(const Unit&) const {}
    __device__ __forceinline__ void done(const Unit&) const {}
};

template <class Epi, class Sched, bool ALIGN_EPI = false, bool SP2 = false>
__device__ __forceinline__ void gemm_phase(PG8_LAS unsigned char* lds, const Gemm g, const Sched& S, const Epi& E) {
    int tid_ = threadIdx.x; asm volatile("" : "+v"(tid_));
    const int tid = tid_, wid = __builtin_amdgcn_readfirstlane(tid >> 6), lane = tid & 63, wr = wid >> 2, wc = wid & 3, fr = lane & 15, fq = lane >> 4;
    const int K = g.K, nt = K / BK;
    unsigned voffA[2], voffB[2];
#pragma unroll
    for (int i = 0; i < 2; ++i) { int R, C; stage_rc(tid * 16 + i * 8192, R, C); const int Rb = Epi::PERM ? ((R & ~31) + perm32(R & 31)) : R;
        voffA[i] = (unsigned)(R * K + C) * 2u; voffB[i] = (unsigned)(Rb * K + C) * 2u; }
    const size_t kstep = (size_t)(BK * 2);
    const size_t hstep = (size_t)HALF * K * 2;
    const size_t tstep = 2 * hstep;
    const unsigned ldsw = (unsigned)wid * 1024u;
    const int aoff = lds_byte(wr * 64 + fr, fq * 8), boff = lds_byte(wc * 32 + fr, fq * 8);
#define PG8_SA(b, h) (((b) * 2 + (h)) * HTB)
#define PG8_SB(b, h) ((4 + (b) * 2 + (h)) * HTB)
#define PG8_STAGE(bufoff, gbase, voff) do { _Pragma("unroll") for (int _i = 0; _i < 2; ++_i) \
        __builtin_amdgcn_global_load_lds((const unsigned*)((const char*)(gbase) + (voff)[_i]), (PG8_LAS unsigned*)(lds + (bufoff) + ldsw + _i * 8192), 16, 0, 0); } while (0)
#define PG8_LDA(dst, b, h) do { _Pragma("unroll") for (int m = 0; m < 4; ++m) _Pragma("unroll") for (int k = 0; k < 2; ++k) dst[m][k] = *(const PG8_LAS bf16x8*)(lds + PG8_SA(b, h) + aoff + m * 2048 + k * 1024); } while (0)
#define PG8_LDB(dst, b, h) do { _Pragma("unroll") for (int n = 0; n < 2; ++n) _Pragma("unroll") for (int k = 0; k < 2; ++k) dst[n][k] = *(const PG8_LAS bf16x8*)(lds + PG8_SB(b, h) + boff + n * 2048 + k * 1024); } while (0)
#define PG8_MMA(ai, bj, At, Bt) do { __builtin_amdgcn_s_setprio(1); _Pragma("unroll") for (int m = 0; m < 4; ++m) _Pragma("unroll") for (int n = 0; n < 2; ++n) _Pragma("unroll") for (int k = 0; k < 2; ++k) \
        acc[ai][bj][m][n] = __builtin_amdgcn_mfma_f32_16x16x32_f16(Bt[n][k], At[m][k], acc[ai][bj][m][n], 0, 0, 0); __builtin_amdgcn_s_setprio(0); } while (0)
#define PG8_WAIT_V(n) asm volatile("s_waitcnt vmcnt(" #n ")" ::: "memory")
#define PG8_WAIT_L(n) asm volatile("s_waitcnt lgkmcnt(" #n ")" ::: "memory")
#define PG8_BAR __builtin_amdgcn_s_barrier()
#define PG8_SCHED __builtin_amdgcn_sched_barrier(0)
    Unit cur, nxt; int ui = 0;
    if (!S.next(0, cur)) return;
    f32x4 acc[2][2][4][2];
#pragma unroll
    for (int a = 0; a < 2; ++a)
#pragma unroll
        for (int b = 0; b < 2; ++b)
#pragma unroll
            for (int m = 0; m < 4; ++m)
#pragma unroll
                for (int n = 0; n < 2; ++n) acc[a][b][m][n] = (f32x4){0.f, 0.f, 0.f, 0.f};
    bf16x8 At[4][2], B0[2][2], B1[2][2];
    const char* cA = (const char*)g.A + (size_t)cur.pm * tstep; const char* cB = (const char*)g.Bt + (size_t)cur.pn * tstep;
    S.a_ready(cur);
    if constexpr (SP2) {
        PG8_STAGE(PG8_SB(0, 0), cB, voffB); PG8_STAGE(PG8_SB(0, 1), cB + hstep, voffB); PG8_STAGE(PG8_SA(0, 0), cA, voffA); PG8_STAGE(PG8_SA(0, 1), cA + hstep, voffA);
        if (wr == 1) PG8_BAR;
        PG8_WAIT_V(2); PG8_BAR;
        PG8_STAGE(PG8_SB(1, 0), cB + kstep, voffB); PG8_STAGE(PG8_SA(1, 0), cA + kstep, voffA); PG8_STAGE(PG8_SB(1, 1), cB + hstep + kstep, voffB);
        PG8_WAIT_V(6); PG8_BAR;
    } else {
        PG8_STAGE(PG8_SB(0, 0), cB, voffB); PG8_STAGE(PG8_SA(0, 0), cA, voffA); PG8_STAGE(PG8_SB(0, 1), cB + hstep, voffB); PG8_STAGE(PG8_SA(0, 1), cA + hstep, voffA);
        if (wr == 1) PG8_BAR;
        PG8_WAIT_V(4); PG8_BAR;
        PG8_STAGE(PG8_SB(1, 0), cB + kstep, voffB); PG8_STAGE(PG8_SA(1, 0), cA + kstep, voffA); PG8_STAGE(PG8_SB(1, 1), cB + hstep + kstep, voffB);
        PG8_WAIT_V(6); PG8_BAR;
    }
    for (;;) {
        const bool has_next = S.next(ui + 1, nxt);
        const char* nA = has_next ? (const char*)g.A + (size_t)nxt.pm * tstep : cA; const char* nB = has_next ? (const char*)g.Bt + (size_t)nxt.pn * tstep : cB;
#pragma nounroll
        for (int t = 0; t < nt; t += 2) {
            const bool last = (t == nt - 2);
            if constexpr (Epi::MID_T > 0) { if (t == Epi::MID_T) E.mid(acc, cur, wr, wc); }
            const char* a1 = cA + (size_t)(t + 1) * kstep;
            const char* a2 = last ? nA : cA + (size_t)(t + 2) * kstep; const char* b2 = last ? nB : cB + (size_t)(t + 2) * kstep;
            const char* a3 = a2 + kstep; const char* b3 = b2 + kstep;
            if (last && has_next) S.a_ready(nxt);
            if constexpr (SP2) {
            PG8_LDB(B0, 0, 0); PG8_LDB(B1, 0, 1); PG8_SCHED; PG8_LDA(At, 0, 0); PG8_STAGE(PG8_SA(1, 1), a1 + hstep, voffA);
            PG8_WAIT_V(8); PG8_WAIT_L(0); PG8_BAR; PG8_MMA(0, 0, At, B0); PG8_MMA(0, 1, At, B1); PG8_BAR; PG8_SCHED;
            PG8_LDA(At, 0, 1); PG8_STAGE(PG8_SB(0, 0), b2, voffB); PG8_STAGE(PG8_SB(0, 1), b2 + hstep, voffB); PG8_STAGE(PG8_SA(0, 0), a2, voffA);
            PG8_WAIT_V(8); PG8_WAIT_L(0); PG8_BAR; PG8_MMA(1, 0, At, B0); PG8_MMA(1, 1, At, B1); PG8_BAR; PG8_SCHED;
            PG8_LDB(B0, 1, 0); PG8_LDB(B1, 1, 1); PG8_SCHED; PG8_LDA(At, 1, 0); PG8_STAGE(PG8_SA(0, 1), a2 + hstep, voffA);
            PG8_WAIT_V(8); PG8_WAIT_L(0); PG8_BAR; PG8_MMA(0, 0, At, B0); PG8_MMA(0, 1, At, B1); PG8_BAR; PG8_SCHED;
            PG8_LDA(At, 1, 1); PG8_STAGE(PG8_SB(1, 0), b3, voffB); PG8_STAGE(PG8_SB(1, 1), b3 + hstep, voffB); PG8_STAGE(PG8_SA(1, 0), a3, voffA);
            PG8_WAIT_V(8); PG8_WAIT_L(0); PG8_BAR; PG8_MMA(1, 0, At, B0); PG8_MMA(1, 1, At, B1); PG8_BAR; PG8_SCHED;
            } else {
            PG8_LDB(B0, 0, 0); PG8_SCHED; PG8_LDA(At, 0, 0); PG8_STAGE(PG8_SA(1, 1), a1 + hstep, voffA);
            PG8_WAIT_L(8); PG8_BAR; PG8_WAIT_L(0); PG8_MMA(0, 0, At, B0); PG8_BAR; PG8_SCHED;
            PG8_LDB(B1, 0, 1); PG8_STAGE(PG8_SB(0, 0), b2, voffB);
            PG8_BAR; PG8_WAIT_L(0); PG8_MMA(0, 1, At, B1); PG8_BAR;
            PG8_LDA(At, 0, 1); PG8_STAGE(PG8_SA(0, 0), a2, voffA);
            PG8_BAR; PG8_WAIT_L(0); PG8_MMA(1, 0, At, B0); PG8_BAR; PG8_SCHED;
            PG8_STAGE(PG8_SB(0, 1), b2 + hstep, voffB);
            PG8_WAIT_V(6); PG8_BAR; PG8_MMA(1, 1, At, B1); PG8_BAR;
            PG8_LDB(B0, 1, 0); PG8_SCHED; PG8_LDA(At, 1, 0); PG8_STAGE(PG8_SA(0, 1), a2 + hstep, voffA);
            PG8_WAIT_L(8); PG8_BAR; PG8_WAIT_L(0); PG8_MMA(0, 0, At, B0); PG8_BAR; PG8_SCHED;
            PG8_LDB(B1, 1, 1); PG8_STAGE(PG8_SB(1, 0), b3, voffB);
            PG8_BAR; PG8_WAIT_L(0); PG8_MMA(0, 1, At, B1); PG8_BAR;
            PG8_LDA(At, 1, 1); PG8_STAGE(PG8_SA(1, 0), a3, voffA);
            PG8_BAR; PG8_WAIT_L(0); PG8_MMA(1, 0, At, B0); PG8_BAR; PG8_SCHED;
            PG8_STAGE(PG8_SB(1, 1), b3 + hstep, voffB);
            PG8_WAIT_V(6); PG8_BAR; PG8_MMA(1, 1, At, B1); PG8_BAR;
            }
        }
        if constexpr (ALIGN_EPI) { if (wr == 0) PG8_BAR; }
        if constexpr (!Epi::AFTER_DRAIN) { E(acc, cur, wr, wc, fr, fq); S.done(cur); }
        if (!has_next) break;
#pragma unroll
        for (int a = 0; a < 2; ++a)
#pragma unroll
            for (int b = 0; b < 2; ++b)
#pragma unroll
                for (int m = 0; m < 4; ++m)
#pragma unroll
                    for (int n = 0; n < 2; ++n) acc[a][b][m][n] = (f32x4){0.f, 0.f, 0.f, 0.f};
        cur = nxt; cA = nA; cB = nB; ++ui;
        if constexpr (ALIGN_EPI) { if (wr == 1) PG8_BAR; }
    }
    PG8_WAIT_V(0);
    if constexpr (!ALIGN_EPI) { if (wr == 0) PG8_BAR; }
    PG8_BAR;
    if constexpr (Epi::AFTER_DRAIN) { E.fused(acc, cur, wr, wc, fr, fq, lds, wid, lane); S.done(cur); }
#undef PG8_SA
#undef PG8_SB
#undef PG8_STAGE
#undef PG8_LDA
#undef PG8_LDB
#undef PG8_MMA
#undef PG8_WAIT_V
#undef PG8_WAIT_L
#undef PG8_BAR
#undef PG8_SCHED
}
typedef _Float16 h8v __attribute__((ext_vector_type(8)));
typedef unsigned u32x2 __attribute__((ext_vector_type(2)));
typedef _Float16 h2v __attribute__((ext_vector_type(2)));
__device__ __forceinline__ unsigned pk_h2(float lo, float hi) { h2v v; v[0] = (_Float16)lo; v[1] = (_Float16)hi; return __builtin_bit_cast(unsigned, v); }
__device__ __forceinline__ u32x4 pack8(const f32x4& a, const f32x4& b) { u32x4 w; w.x = pk_h2(a[0], a[1]); w.y = pk_h2(a[2], a[3]); w.z = pk_h2(b[0], b[1]); w.w = pk_h2(b[2], b[3]); return w; }
__device__ __forceinline__ float sigm1(float v) { return __builtin_amdgcn_rcpf(1.f + __builtin_amdgcn_exp2f(v * -1.4426950408889634f)); }
__device__ __forceinline__ float silu1(float v) { return v * sigm1(v); }
__device__ __forceinline__ f32x4 silu4(const f32x4& v) { return (f32x4){silu1(v[0]), silu1(v[1]), silu1(v[2]), silu1(v[3])}; }
__device__ __forceinline__ f32x4 sigm4(const f32x4& v) { return (f32x4){sigm1(v[0]), sigm1(v[1]), sigm1(v[2]), sigm1(v[3])}; }

#define PG8_OPAQUE(fr_, fq_) int lane_x; asm volatile("v_mbcnt_lo_u32_b32 %0, -1, 0\n\tv_mbcnt_hi_u32_b32 %0, -1, %0" : "=v"(lane_x)); const int frx = lane_x & 15, fqx = lane_x >> 4
__device__ __forceinline__ void st16(unsigned char* base, unsigned off, const u32x4& v) { *(u32x4*)(base + off) = v; }
__device__ __forceinline__ f32x4 ld16f(const unsigned char* base, unsigned off) { return *(const f32x4*)(base + off); }
__device__ __forceinline__ float ld4f(const unsigned char* base, unsigned off) { return *(const float*)(base + off); }
__device__ __forceinline__ h8v ld16h(const unsigned char* base, unsigned off) { return *(const h8v*)(base + off); }
__device__ __forceinline__ float sumsq8(const f32x4& a, const f32x4& b) { return (a[0] * a[0] + a[1] * a[1]) + (a[2] * a[2] + a[3] * a[3]) + (b[0] * b[0] + b[1] * b[1]) + (b[2] * b[2] + b[3] * b[3]); }
__device__ __forceinline__ void rope4(const f32x4& t1, const f32x4& t2, const u32x4& cs, f32x4& o1, f32x4& o2) {
#pragma unroll
    for (int j = 0; j < 4; ++j) { const unsigned wj = cs[j]; h2v w; __builtin_memcpy(&w, &wj, 4);
        const float c = (float)w[0], s = (float)w[1]; o1[j] = t1[j] * c - t2[j] * s; o2[j] = t2[j] * c + t1[j] * s; }
}
__device__ __forceinline__ u32x4 ld16u(const unsigned char* base, unsigned off) { return *(const u32x4*)(base + off); }

struct EpiInF {
    static constexpr bool PERM = true, AFTER_DRAIN = false; static constexpr int MID_T = 0;
    unsigned char* ws; const float* b_merge; int noatomic;
    template <bool ISQ> __device__ __forceinline__ void rope_tile(const f32x4 (&acc)[2][2][4][2], const Unit& u, int wr, int wc, int frx, int fqx) const {
        const int pn = u.pn; const unsigned row0 = (unsigned)(u.pm * 256 + wr * 64) + (unsigned)frx; const float sc = ISQ ? SC_MB : 1.f;
        unsigned char* dst = ws + (ISQ ? WS_QMB : WS_KMB); const unsigned char* tab = ws + WS_TAB;
        const unsigned o0 = row0 * 1024u + (((pn & 1) ? 256u : 0u) + 64u * wc + 8u * fqx) * 2u, t0 = row0 * 128u + 32u * fqx;
        f32x4 c1[2] = {{0.f, 0.f, 0.f, 0.f}, {0.f, 0.f, 0.f, 0.f}}, c2[2] = {{0.f, 0.f, 0.f, 0.f}, {0.f, 0.f, 0.f, 0.f}};
        u32x4 cs[2][4][2];
#pragma unroll
        for (int ai = 0; ai < 2; ++ai)
#pragma unroll
            for (int m = 0; m < 4; ++m) { const unsigned to = t0 + (unsigned)(ai * 128 + m * 16) * 128u; cs[ai][m][0] = ld16u(tab, to); cs[ai][m][1] = ld16u(tab, to + 16u); }
#pragma unroll
        for (int ai = 0; ai < 2; ++ai)
#pragma unroll
            for (int m = 0; m < 4; ++m) { const unsigned ro = o0 + (unsigned)(ai * 128 + m * 16) * 1024u;
                f32x4 o1[2], o2[2];
#pragma unroll
                for (int n = 0; n < 2; ++n) { rope4(acc[ai][0][m][n], acc[ai][1][m][n], cs[ai][m][n], o1[n], o2[n]);
                    if (!ISQ) { c1[n] += o1[n]; c2[n] += o2[n]; } }
                st16(dst, ro, pack8(o1[0] * sc, o1[1] * sc)); st16(dst, ro + 64u, pack8(o2[0] * sc, o2[1] * sc));
                if (!ISQ) asm volatile("" : "+v"(c1[0]), "+v"(c1[1]), "+v"(c2[0]), "+v"(c2[1])); }
        if (!ISQ) {
            float* km = (float*)(ws + WS_KMEAN) + (size_t)u.pm * 512 + ((pn & 1) ? 256 : 0) + 64 * wc + 8 * fqx;
#pragma unroll
            for (int n = 0; n < 2; ++n)
#pragma unroll
                for (int j = 0; j < 4; ++j) { float a = c1[n][j], b = c2[n][j];
#pragma unroll
                    for (int o = 1; o < 16; o <<= 1) { a += __shfl_xor(a, o); b += __shfl_xor(b, o); }
                    if (frx == 0 && !noatomic) { atomicAdd(km + 4 * n + j, a * (1.f / 256.f)); atomicAdd(km + 32 + 4 * n + j, b * (1.f / 256.f)); } }
        }
    }
    __device__ __forceinline__ void operator()(const f32x4 (&acc)[2][2][4][2], const Unit& u, int wr, int wc, int fr, int fq) const {
        PG8_OPAQUE(fr, fq);
        const int pn = u.pn; const unsigned row0 = (unsigned)(u.pm * 256 + wr * 64) + (unsigned)frx, cl = 32u * wc + 8u * fqx;
        if (pn == 0) {
            unsigned char* dst = ws + WS_QLAT; float* ssq = (float*)(ws + WS_SSQ); const unsigned o0 = row0 * 512u + cl * 2u;
#pragma unroll
            for (int ai = 0; ai < 2; ++ai)
#pragma unroll
                for (int m = 0; m < 4; ++m) { const unsigned ro = o0 + (unsigned)(ai * 128 + m * 16) * 512u; float s = 0.f;
#pragma unroll
                    for (int bj = 0; bj < 2; ++bj) { s += sumsq8(acc[ai][bj][m][0], acc[ai][bj][m][1]); st16(dst, ro + bj * 256u, pack8(acc[ai][bj][m][0], acc[ai][bj][m][1])); }
                    s += __shfl_xor(s, 16); s += __shfl_xor(s, 32);
                    if (fqx == 0 && !noatomic) atomicAdd(ssq + (row0 + ai * 128 + m * 16), s); }
        } else if (pn == 1) {
            unsigned char* kvl = ws + WS_KVL; unsigned char* kpe = ws + WS_KPE; float* ssq = (float*)(ws + WS_SSQ) + M_; const unsigned char* tab = ws + WS_TAB;
#pragma unroll
            for (int ai = 0; ai < 2; ++ai)
#pragma unroll
                for (int m = 0; m < 4; ++m) { const unsigned row = row0 + ai * 128 + m * 16;
                    if (wc < 2) { float s = 0.f;
#pragma unroll
                        for (int bj = 0; bj < 2; ++bj) { s += sumsq8(acc[ai][bj][m][0], acc[ai][bj][m][1]); st16(kvl, row * 512u + (bj * 64u + cl) * 2u, pack8(acc[ai][bj][m][0], acc[ai][bj][m][1])); }
                        s += __shfl_xor(s, 16); s += __shfl_xor(s, 32);
                        if (fqx == 0 && !noatomic) atomicAdd(ssq + row, s);
                    } else {
                        if (wc == 2 && fqx < 2) {
                            f32x4 o1[2], o2[2];
#pragma unroll
                            for (int n = 0; n < 2; ++n) { const unsigned to = row * 128u + (unsigned)(16 * fqx + 8 * n) * 4u; const u32x4 wa = ld16u(tab, to), wb = ld16u(tab, to + 16u);
                                rope4(acc[ai][0][m][n], acc[ai][1][m][n], (u32x4){wa[0], wa[2], wb[0], wb[2]}, o1[n], o2[n]); }
                            st16(kpe, row * 64u + 16u * fqx, pack8(o1[0], o1[1])); st16(kpe, row * 64u + 32u + 16u * fqx, pack8(o2[0], o2[1]));
                        }
                        const u32x4 z = {0u, 0u, 0u, 0u};
                        st16(kvl, row * 512u + (128u + (cl - 64u)) * 2u, z); st16(kvl, row * 512u + (192u + (cl - 64u)) * 2u, z);
                    }
                    asm volatile("" ::: "memory"); }
        } else if (pn < 4 || (pn >= 8 && pn < 12)) {
            const bool act = (pn < 4) || (pn >= 10); const unsigned pitch = act ? 2048u : 1024u;
            unsigned char* dst = ws + (act ? WS_ZCAT : WS_VMB); const unsigned o0 = row0 * pitch + ((pn >= 10 ? 512u : 0u) + ((pn & 1) ? 256u : 0u) + cl) * 2u;
#pragma unroll
            for (int ai = 0; ai < 2; ++ai)
#pragma unroll
                for (int m = 0; m < 4; ++m) { const unsigned ro = o0 + (unsigned)(ai * 128 + m * 16) * pitch;
#pragma unroll
                    for (int bj = 0; bj < 2; ++bj) { f32x4 a = acc[ai][bj][m][0], b = acc[ai][bj][m][1]; if (act) { a = silu4(a); b = silu4(b); }
                        st16(dst, ro + bj * 256u, pack8(a, b)); } }
        } else if (pn < 6) { rope_tile<true>(acc, u, wr, wc, frx, fqx);
        } else if (pn < 8) { rope_tile<false>(acc, u, wr, wc, frx, fqx);
        } else {
            const bool isa = pn < 16; unsigned char* dst = ws + (isa ? WS_GA : WS_GB); const unsigned cg = 256u * ((pn - 12) & 3) + cl;
            const unsigned char* bm = (const unsigned char*)(b_merge + (isa ? 0 : 1024)); const unsigned o0 = row0 * 1024u + cg;
            f32x4 bv[2][2];
#pragma unroll
            for (int bj = 0; bj < 2; ++bj)
#pragma unroll
                for (int n = 0; n < 2; ++n) bv[bj][n] = ld16f(bm, (cg + bj * 128u + 4u * n) * 4u);
#pragma unroll
            for (int ai = 0; ai < 2; ++ai)
#pragma unroll
                for (int m = 0; m < 4; ++m) { const unsigned ro = o0 + (unsigned)(ai * 128 + m * 16) * 1024u;
#pragma unroll
                    for (int bj = 0; bj < 2; ++bj) { const f32x4 a = sigm4(acc[ai][bj][m][0] + bv[bj][0]) * 255.f + 0.5f, b = sigm4(acc[ai][bj][m][1] + bv[bj][1]) * 255.f + 0.5f;
                        u32x2 w; w.x = (unsigned)a[0] | ((unsigned)a[1] << 8) | ((unsigned)a[2] << 16) | ((unsigned)a[3] << 24); w.y = (unsigned)b[0] | ((unsigned)b[1] << 8) | ((unsigned)b[2] << 16) | ((unsigned)b[3] << 24);
                        *(u32x2*)(dst + (ro + bj * 128u)) = w; } }
        }
    }
};
struct EpiNull {
    static constexpr bool PERM = true, AFTER_DRAIN = false; static constexpr int MID_T = 0;
    __device__ __forceinline__ void operator()(const f32x4 (&acc)[2][2][4][2], const Unit& u, int wr, int wc, int fr, int fq) const {
#pragma unroll
        for (int ai = 0; ai < 2; ++ai)
#pragma unroll
            for (int bj = 0; bj < 2; ++bj)
#pragma unroll
                for (int m = 0; m < 4; ++m) asm volatile("" :: "v"(acc[ai][bj][m][0]), "v"(acc[ai][bj][m][1]));
    }
};
struct EpiUqF {
    static constexpr bool PERM = true, AFTER_DRAIN = false; static constexpr int MID_T = 0;
    unsigned char* ws;
    __device__ __forceinline__ void operator()(const f32x4 (&acc)[2][2][4][2], const Unit& u, int wr, int wc, int fr, int fq) const {
        PG8_OPAQUE(fr, fq);
        const int pn = u.pn; const unsigned row0 = (unsigned)(u.pm * 256 + wr * 64) + (unsigned)frx; unsigned char* Q = ws + WS_QMLA; const unsigned char* ssq = ws + WS_SSQ; const unsigned char* tab = ws + WS_TAB;
        float rsv[2][4];
#pragma unroll
        for (int ai = 0; ai < 2; ++ai)
#pragma unroll
            for (int m = 0; m < 4; ++m) rsv[ai][m] = ld4f(ssq, (row0 + ai * 128 + m * 16) * 4u);
#pragma unroll
        for (int ai = 0; ai < 2; ++ai)
#pragma unroll
            for (int m = 0; m < 4; ++m) { const unsigned row = row0 + ai * 128 + m * 16; const float rs = SC_MLA * __builtin_amdgcn_rsqf(rsv[ai][m] * (1.f / 256.f) + EPS);
                if (pn < 2) {
#pragma unroll
                    for (int bj = 0; bj < 2; ++bj) { const unsigned head = 4u * pn + 2u * bj + (wc >> 1), d = 32u * (wc & 1) + 8u * fqx;
                        st16(Q, row * 1536u + (96u * head + d) * 2u, pack8(acc[ai][bj][m][0] * rs, acc[ai][bj][m][1] * rs)); }
                } else { const unsigned head = 2u * wc + ((unsigned)fqx >> 1), i0 = 8u * (fqx & 1); f32x4 o1[2], o2[2];
#pragma unroll
                    for (int n = 0; n < 2; ++n) { const unsigned to = row * 128u + (2u * (i0 + 4u * n)) * 4u; const u32x4 wa = ld16u(tab, to), wb = ld16u(tab, to + 16u);
                        rope4(acc[ai][0][m][n] * rs, acc[ai][1][m][n] * rs, (u32x4){wa[0], wa[2], wb[0], wb[2]}, o1[n], o2[n]); }
                    st16(Q, row * 1536u + (96u * head + 64u + i0) * 2u, pack8(o1[0], o1[1])); st16(Q, row * 1536u + (96u * head + 80u + i0) * 2u, pack8(o2[0], o2[1])); } }
    }
};
struct EpiUkvF {
    static constexpr bool PERM = true, AFTER_DRAIN = false; static constexpr int MID_T = 0;
    unsigned char* ws;
    __device__ __forceinline__ void operator()(const f32x4 (&acc)[2][2][4][2], const Unit& u, int wr, int wc, int fr, int fq) const {
        PG8_OPAQUE(fr, fq);
        const int pn = u.pn; const unsigned row0 = (unsigned)(u.pm * 256 + wr * 64) + (unsigned)frx; unsigned char* dst = ws + (pn < 2 ? WS_KN : WS_VM); const unsigned char* ssq = ws + WS_SSQ + (size_t)M_ * 4;
        float rsv[2][4];
#pragma unroll
        for (int ai = 0; ai < 2; ++ai)
#pragma unroll
            for (int m = 0; m < 4; ++m) rsv[ai][m] = ld4f(ssq, (row0 + ai * 128 + m * 16) * 4u);
#pragma unroll
        for (int ai = 0; ai < 2; ++ai)
#pragma unroll
            for (int m = 0; m < 4; ++m) { const unsigned row = row0 + ai * 128 + m * 16; const float rs = __builtin_amdgcn_rsqf(rsv[ai][m] * (1.f / 128.f) + EPS);
#pragma unroll
                for (int bj = 0; bj < 2; ++bj) { const unsigned head = 4u * (pn & 1) + 2u * bj + (wc >> 1), d = 32u * (wc & 1) + 8u * fqx;
                    st16(dst, row * 1024u + (64u * head + d) * 2u, pack8(acc[ai][bj][m][0] * rs, acc[ai][bj][m][1] * rs)); } }
    }
};
struct EpiYcatF {
    static constexpr bool PERM = true, AFTER_DRAIN = false; static constexpr int MID_T = 8;
    unsigned char* ws;
    template <bool MID> __device__ __forceinline__ void run(f32x4 (&acc)[2][2][4][2], const Unit& u, int wr, int wc) const {
        PG8_OPAQUE(0, 0);
        const unsigned row0 = (unsigned)(u.pm * 256 + wr * 64) + (unsigned)frx, c0 = u.pn * 256u + 32u * wc + 8u * fqx, o0 = row0 * 2048u + c0 * 2u, g0 = row0 * 1024u + c0;
        const unsigned char* GA = ws + WS_GA; const unsigned char* GB = ws + WS_GB; unsigned char* YM = ws + WS_YM;
#pragma unroll
        for (int ai = 0; ai < 2; ++ai) {
            u32x2 ga[4][2], gb[4][2];
#pragma unroll
            for (int m = 0; m < 4; ++m)
#pragma unroll
                for (int bj = 0; bj < 2; ++bj) { const unsigned go = g0 + (unsigned)(ai * 128 + m * 16) * 1024u + bj * 128u; gb[m][bj] = *(const u32x2*)(GB + go); if (MID) ga[m][bj] = *(const u32x2*)(GA + go); }
#pragma unroll
            for (int m = 0; m < 4; ++m)
#pragma unroll
                for (int bj = 0; bj < 2; ++bj) { const unsigned off = o0 + (unsigned)(ai * 128 + m * 16) * 2048u + bj * 256u; f32x4 s0, s1;
#pragma unroll
                    for (int j = 0; j < 4; ++j) { const float b0 = fmaxf((float)((gb[m][bj].x >> (8 * j)) & 0xffu), 0.5f), b1 = fmaxf((float)((gb[m][bj].y >> (8 * j)) & 0xffu), 0.5f);
                        s0[j] = MID ? (float)((ga[m][bj].x >> (8 * j)) & 0xffu) * __builtin_amdgcn_rcpf(b0) : b0 * (1.f / 255.f);
                        s1[j] = MID ? (float)((ga[m][bj].y >> (8 * j)) & 0xffu) * __builtin_amdgcn_rcpf(b1) : b1 * (1.f / 255.f); }
                    acc[ai][bj][m][0] *= s0; acc[ai][bj][m][1] *= s1;
                    if (!MID) st16(YM, off, pack8(acc[ai][bj][m][0], acc[ai][bj][m][1])); }
            asm volatile("" ::: "memory"); }
    }
    __device__ __forceinline__ void mid(f32x4 (&acc)[2][2][4][2], const Unit& u, int wr, int wc) const { run<true>(acc, u, wr, wc); }
    __device__ __forceinline__ void operator()(f32x4 (&acc)[2][2][4][2], const Unit& u, int wr, int wc, int fr, int fq) const { run<false>(acc, u, wr, wc); }
};
struct EpiYF {
    static constexpr bool PERM = true, AFTER_DRAIN = false; static constexpr int MID_T = 0;
    unsigned char* ws;
    __device__ __forceinline__ void operator()(const f32x4 (&acc)[2][2][4][2], const Unit& u, int wr, int wc, int fr, int fq) const {
        PG8_OPAQUE(fr, fq);
        const unsigned row0 = (unsigned)(u.pm * 256 + wr * 64) + (unsigned)frx, c0 = u.pn * 256u + 32u * wc + 8u * fqx, o0 = row0 * 2048u + c0 * 2u; unsigned char* Y = ws + WS_Y; float* ssq = (float*)(ws + WS_SSQY);
#pragma unroll
        for (int ai = 0; ai < 2; ++ai)
#pragma unroll
            for (int m = 0; m < 4; ++m) { float s = 0.f;
#pragma unroll
                for (int bj = 0; bj < 2; ++bj) { s += sumsq8(acc[ai][bj][m][0], acc[ai][bj][m][1]); st16(Y, o0 + (unsigned)(ai * 128 + m * 16) * 2048u + bj * 256u, pack8(acc[ai][bj][m][0], acc[ai][bj][m][1])); }
                s += __shfl_xor(s, 16); s += __shfl_xor(s, 32);
                if (fqx == 0) atomicAdd(ssq + (row0 + ai * 128 + m * 16), s); }
    }
};
}

struct MapIn { __device__ int operator()(int n) const { const int t = n >> 8, tc = n & 255, bj = tc >> 7, uu = tc & 127;
    if (t == 0) return n;
    if (t == 1) return uu < 64 ? C_KVLAT + 64 * bj + uu : (uu < 80 ? C_KROPE + 16 * bj + (uu - 64) : -1);
    if (t < 4) return C_ZMLA + (n - 512);
    if (t < 8) return (t < 6 ? C_QMB : C_KMB) + 256 * (t & 1) + 64 * (uu >> 5) + 32 * bj + (uu & 31);
    if (t < 10) return C_VMB + (n - 2048);
    if (t < 12) return C_ZMB + (n - 2560);
    if (t < 16) return C_GA + (n - 3072);
    return C_GB + (n - 4096); } };
struct MapUq { __device__ int operator()(int n) const { const int t = n >> 8, tc = n & 255, bj = tc >> 7, uu = tc & 127;
    if (t < 2) return 96 * (4 * t + (tc >> 6)) + (tc & 63);
    return 96 * (uu >> 4) + 64 + 16 * bj + (uu & 15); } };
struct MapUkv { __device__ int operator()(int n) const { const int t = n >> 8, tc = n & 255; return 128 * (4 * (t & 1) + (tc >> 6)) + (t < 2 ? 0 : 64) + (tc & 63); } };
struct MapId { __device__ int operator()(int n) const { return n; } };
template <class Map> __device__ __forceinline__ void wt_items(const float* W, int ldw, int Kreal, int K, int N, unsigned short* WT, const float* kscale, Map map, LAS float* scr, int gw, int ngw, int lane, int ldk = 0, int koff = 0) {
    if (ldk == 0) ldk = K;
    const int nblk = N / 32, nitems = (K / 64) * nblk;
    for (int it = gw; it < nitems; it += ngw) {
        const int kb = it / nblk, nb = it % nblk, k0 = 64 * kb, n0 = 32 * nb; const int src = map(n0 + (lane & 31));
#pragma unroll 8
        for (int i = 0; i < 32; ++i) { const int kk = 2 * i + (lane >> 5), k = k0 + kk; float v = 0.f; if (src >= 0 && k < Kreal) { v = W[(size_t)k * ldw + src]; if (kscale) v *= kscale[k]; } scr[kk * 33 + (lane & 31)] = v; }
        asm volatile("s_waitcnt lgkmcnt(0)" ::: "memory");
        const int c = lane & 7;
#pragma unroll
        for (int j = 0; j < 4; ++j) { const int n = (lane >> 3) + 8 * j; const LAS float* s = scr + (8 * c) * 33 + n;
            pg8::u32x4 o; o.x = pg8::pk_h2(s[0 * 33], s[1 * 33]); o.y = pg8::pk_h2(s[2 * 33], s[3 * 33]); o.z = pg8::pk_h2(s[4 * 33], s[5 * 33]); o.w = pg8::pk_h2(s[6 * 33], s[7 * 33]);
            *(pg8::u32x4*)(WT + (size_t)(n0 + n) * ldk + koff + k0 + 8 * c) = o; }
        asm volatile("s_waitcnt lgkmcnt(0)" ::: "memory");
    }
}
constexpr size_t WT_IN = WS_WT, WT_UQ = WS_WT + 10 * MiB, WT_UKV = WT_UQ + 512 * 1024, WT_OA = WS_WT + 11 * MiB, WT_OB = WS_WT + 12 * MiB, WT_OUT = WS_WT + 13 * MiB;
__device__ __forceinline__ void ph_weights(const Params& p, LAS unsigned char* lds, int gw, int ngw, int wave, int lane) {
    LAS float* scr = (LAS float*)(lds + wave * 16384);
    wt_items(p.w_in, D_IN, 1024, 1024, 5120, (unsigned short*)(p.ws + WT_IN), nullptr, MapIn(), scr, gw, ngw, lane);
    wt_items(p.w_uq, 768, 256, 256, 768, (unsigned short*)(p.ws + WT_UQ), p.g_q, MapUq(), scr, gw, ngw, lane);
    wt_items(p.w_ukv, 1024, 128, 256, 1024, (unsigned short*)(p.ws + WT_UKV), p.g_kv, MapUkv(), scr, gw, ngw, lane);
    wt_items(p.w_o_mla, 1024, 512, 512, 1024, (unsigned short*)(p.ws + WT_OA), nullptr, MapId(), scr, gw, ngw, lane, 1024, 0);
    wt_items(p.w_o_moba, 1024, 512, 512, 1024, (unsigned short*)(p.ws + WT_OA), nullptr, MapId(), scr, gw, ngw, lane, 1024, 512);
    wt_items(p.w_out, 1024, 1024, 1024, 1024, (unsigned short*)(p.ws + WT_OUT), nullptr, MapId(), scr, gw, ngw, lane);
}

namespace att {
struct T1 { static constexpr bool value = true; }; struct T0 { static constexpr bool value = false; };
typedef _Float16 h8 __attribute__((ext_vector_type(8)));
typedef short s4 __attribute__((ext_vector_type(4)));
typedef short s8 __attribute__((ext_vector_type(8)));
typedef float f16v __attribute__((ext_vector_type(16)));
typedef unsigned u4 __attribute__((ext_vector_type(4)));
typedef short v4i16_t __attribute__((ext_vector_type(4)));
constexpr int KBUF = 16384, VBUF = 8192;
constexpr int NBUF = 4;
constexpr int L_K = 0, L_V = NBUF * KBUF, L_WS = L_V + NBUF * VBUF, L_TB = L_WS + 8 * 256, L_UN = L_TB + 256, L_END = L_UN + 64, L_OST = 0;
constexpr float THR = 8.f;
#ifndef PROBE_ABL
#define PROBE_ABL 0
#endif
#ifndef ATT_STAGGER
#define ATT_STAGGER 0
#endif
constexpr bool STAGGER = ATT_STAGGER;
__device__ __forceinline__ int crow(int r, int hi) { return (r & 3) + 8 * (r >> 2) + 4 * hi; }
template <int DK> __device__ __forceinline__ int kaddr(int row, int ch) { return DK == 64 ? row * 128 + ((ch ^ ((row >> 1) & 7)) << 4) : row * 256 + ((ch ^ (row & 15)) << 4); }
__device__ __forceinline__ s4 vtr(const LAS unsigned char* p) { return __builtin_bit_cast(s4, __builtin_amdgcn_ds_read_tr16_b64_v4i16((LAS v4i16_t*)p)); }
__device__ __forceinline__ float swapmax(float m) { auto rr = __builtin_amdgcn_permlane32_swap(__float_as_uint(m), __float_as_uint(m), false, false); return fmaxf(__uint_as_float(rr[0]), __uint_as_float(rr[1])); }
__device__ __forceinline__ float swapsum(float m) { auto rr = __builtin_amdgcn_permlane32_swap(__float_as_uint(m), __float_as_uint(m), false, false); return __uint_as_float(rr[0]) + __uint_as_float(rr[1]); }
__device__ __forceinline__ void glds16(const void* g, unsigned lds_base) { unsigned sv;
    asm volatile("s_mov_b32 %0, m0\n\ts_mov_b32 m0, %2\n\ts_nop 0\n\tglobal_load_lds_dwordx4 %1, off\n\ts_mov_b32 m0, %0" : "=&s"(sv) : "v"(g), "s"(lds_base) : "memory"); }
__device__ __forceinline__ float max3f(float a, float b, float c) { float r; asm("v_max3_f32 %0, %1, %2, %3" : "=v"(r) : "v"(a), "v"(b), "v"(c)); return r; }
__device__ __forceinline__ unsigned pkh(float lo, float hi) { typedef _Float16 h2 __attribute__((ext_vector_type(2))); h2 v; v[0] = (_Float16)lo; v[1] = (_Float16)hi; return __builtin_bit_cast(unsigned, v); }

template <int DK, bool MOBA, int ABL = 0>
__device__ __forceinline__ void attn_unit(unsigned char* ws, int b, int h, int qb, LAS unsigned char* lds, bool dry = false) {
    constexpr int ND = DK / 16, QP = MOBA ? 512 : 768, QH = MOBA ? 64 : 96;
    int tid_ = threadIdx.x; asm volatile("" : "+v"(tid_));
    const int tid = tid_, lane = tid & 63, r32 = lane & 31, hi = lane >> 5; const int wid = __builtin_amdgcn_readfirstlane(tid >> 6);
    const _Float16* Qg = (const _Float16*)(ws + (MOBA ? WS_QMB : WS_QMLA)); const _Float16* Kg = (const _Float16*)(ws + (MOBA ? WS_KMB : WS_KN));
    const _Float16* Vg = (const _Float16*)(ws + (MOBA ? WS_VMB : WS_VM)); const _Float16* Pg = (const _Float16*)(ws + WS_KPE); _Float16* Zg = (_Float16*)(ws + WS_ZCAT) + (MOBA ? 512 : 0);
    const size_t rowbase = (size_t)b * SEQ; const int q0 = qb * 256, qw0 = q0 + wid * 32, qrow = qw0 + r32;
    LAS float* wsf = (LAS float*)(lds + L_WS) + wid * 64; LAS int* tb = (LAS int*)(lds + L_TB); LAS unsigned* un = (LAS unsigned*)(lds + L_UN);
    h8 qr[ND];
#pragma unroll
    for (int d0 = 0; d0 < ND; ++d0) qr[d0] = *(const h8*)(Qg + (rowbase + qrow) * QP + h * QH + d0 * 16 + hi * 8);
#pragma unroll
    for (int d0 = 0; d0 < ND; ++d0) asm volatile("" : "+v"(qr[d0]));
    unsigned sel = 0u, blocks = (2u << qb) - 1u;
    if (MOBA) {
        const float* km = (const float*)(ws + WS_KMEAN) + (size_t)b * 16 * 512 + h * 64 + hi * 8;
        float g0 = -INFINITY, g1 = -INFINITY, g2 = -INFINITY; int i0 = -1, i1 = -1, i2 = -1;
        for (int m = 0; m < qb; ++m) {
            float part = 0.f;
#pragma unroll
            for (int d0 = 0; d0 < 4; ++d0) { const float4 a = *(const float4*)(km + m * 512 + d0 * 16), c = *(const float4*)(km + m * 512 + d0 * 16 + 4);
                part += (float)qr[d0][0] * a.x + (float)qr[d0][1] * a.y + (float)qr[d0][2] * a.z + (float)qr[d0][3] * a.w + (float)qr[d0][4] * c.x + (float)qr[d0][5] * c.y + (float)qr[d0][6] * c.z + (float)qr[d0][7] * c.w; }
            const float g = swapsum(part);
            if (g > g0) { g2 = g1; i2 = i1; g1 = g0; i1 = i0; g0 = g; i0 = m; }
            else if (g > g1) { g2 = g1; i2 = i1; g1 = g; i1 = m; }
            else if (g > g2) { g2 = g; i2 = m; }
        }
        if (i0 >= 0) sel |= 1u << i0; if (i1 >= 0) sel |= 1u << i1; if (i2 >= 0) sel |= 1u << i2;
        unsigned uw = sel;
#pragma unroll
        for (int o = 1; o < 64; o <<= 1) uw |= (unsigned)__shfl_xor((int)uw, o);
        if (lane == 0) un[wid] = uw;
        __syncthreads();
        unsigned ua = 0u;
#pragma unroll
        for (int w = 0; w < 8; ++w) ua |= un[w];
        blocks = (unsigned)__builtin_amdgcn_readfirstlane((int)(ua | (1u << qb)));
    }
    const int NT = 4 * __builtin_popcount(blocks);
    if (tid < 64 && tid < NT) { unsigned bm = blocks; for (int k = 0; k < (tid >> 2); ++k) bm &= bm - 1u; tb[tid] = (__builtin_ctz(bm) << 8) + ((tid & 3) << 6); }
    __syncthreads();
    const unsigned char* kbu = (const unsigned char*)(Kg + rowbase * 512 + h * 64); const unsigned char* vbu = (const unsigned char*)(Vg + rowbase * 512 + h * 64); const unsigned char* pbu = (const unsigned char*)(Pg + rowbase * 32);
    const unsigned char* kb0; const unsigned char* kb1 = nullptr; unsigned ksrc0, ksrc1 = 0u, kst0 = 1024u, kst1 = 1024u;
    if (DK == 96) { const int r0 = 4 * wid + (lane >> 4), r1 = r0 + 32; int c0 = (lane & 15) ^ (r0 & 15), c1 = (lane & 15) ^ (r1 & 15); if (c0 >= 12) c0 -= 4; if (c1 >= 12) c1 -= 4;
        const bool kpe0 = c0 >= 8, kpe1 = c1 >= 8;
        kb0 = kpe0 ? pbu : kbu; kst0 = kpe0 ? 64u : 1024u; ksrc0 = kpe0 ? (unsigned)(r0 * 32 + (c0 - 8) * 8) * 2u : (unsigned)(r0 * 512 + c0 * 8) * 2u;
        kb1 = kpe1 ? pbu : kbu; kst1 = kpe1 ? 64u : 1024u; ksrc1 = kpe1 ? (unsigned)(r1 * 32 + (c1 - 8) * 8) * 2u : (unsigned)(r1 * 512 + c1 * 8) * 2u;
    } else { const int r0 = 8 * wid + (lane >> 3), c0 = (lane & 7) ^ ((r0 >> 1) & 7); kb0 = kbu; ksrc0 = (unsigned)(r0 * 512 + c0 * 8) * 2u; }
    const unsigned vsrc = (unsigned)((16 * (wid & 3) + (lane >> 2)) * 512 + (wid >> 2) * 32 + (lane & 3) * 8) * 2u;
    constexpr int NDMA = (DK == 96) ? 3 : 2;
#define ATT_GLDS(src, dst) glds16((const void*)(src), (unsigned)__builtin_amdgcn_readfirstlane((int)(unsigned)(size_t)(dst)))
#define ATT_DMA(kb, buf) do { const unsigned kb_ = (unsigned)(kb); LAS unsigned char* kd_ = lds + L_K + (buf) * KBUF; \
        ATT_GLDS(kb0 + (ksrc0 + kb_ * kst0), kd_ + wid * 1024); \
        if (DK == 96) ATT_GLDS(kb1 + (ksrc1 + kb_ * kst1), kd_ + 8192 + wid * 1024); \
        ATT_GLDS(vbu + (vsrc + kb_ * 1024u), lds + L_V + (buf) * VBUF + wid * 1024); } while (0)
#define ATT_WAITV(n) asm volatile("s_waitcnt vmcnt(" #n ")" ::: "memory")
#define ATT_BAR() do { asm volatile("s_waitcnt lgkmcnt(0)" ::: "memory"); __builtin_amdgcn_s_barrier(); asm volatile("" ::: "memory"); } while (0)
    const int vro = ((lane >> 4) & 1) * 32 + (lane & 3) * 8 + (4 * hi + ((lane & 15) >> 2)) * 64;
    float l_reg = 0.f; bool init = false; f16v o[2]; o[0] = f16v{}; o[1] = f16v{}; f16v negm = f16v{}; asm volatile("" : "+v"(negm));
    constexpr int G = 2 * ND;
#define ATT_SBAR() __builtin_amdgcn_sched_barrier(0)
#define ATT_PIN(x) asm volatile("" : "+v"(x))
#define ATT_KF(buf, g) (*(const LAS h8*)(lds + L_K + (buf) * KBUF + kaddr<DK>(32 * ((g) & 1) + r32, 2 * ((g) >> 1) + hi)))
#define ATT_MF(a, b, c) __builtin_amdgcn_mfma_f32_32x32x16_f16(a, b, c, 0, 0, 0)
#define ATT_QK(P0, P1, buf) do { h8 kf_[G]; _Pragma("unroll") for (int g_ = 0; g_ < G; ++g_) kf_[g_] = ATT_KF(buf, g_); ATT_SBAR(); \
        _Pragma("unroll") for (int d_ = 0; d_ < ND; ++d_) { P0 = ATT_MF(kf_[2 * d_], qr[d_], d_ == 0 ? negm : P0); P1 = ATT_MF(kf_[2 * d_ + 1], qr[d_], d_ == 0 ? negm : P1); } } while (0)
#define ATT_MAXCHAIN(P0, P1, PM) do { float pa_ = max3f(P0[0], P0[1], P1[0]), pb_ = max3f(P0[2], P0[3], P1[1]); pa_ = max3f(pa_, P1[2], P1[3]); \
        _Pragma("unroll") for (int r_ = 4; r_ < 16; r_ += 4) { pa_ = max3f(pa_, P0[r_], P0[r_ + 1]); pb_ = max3f(pb_, P0[r_ + 2], P0[r_ + 3]); pa_ = max3f(pa_, P1[r_], P1[r_ + 1]); pb_ = max3f(pb_, P1[r_ + 2], P1[r_ + 3]); } \
        PM = swapmax(fmaxf(pa_, pb_)); } while (0)
#define ATT_MOVE(P0, P1, PM) do { const bool move_ = init ? ((PM) > THR) : ((PM) > -INFINITY); \
        if (__any(move_)) { const float dl_ = move_ ? (init ? fmaxf((PM), 0.f) : (PM)) : 0.f; const float al_ = (move_ && init) ? __builtin_amdgcn_exp2f(-dl_) : 1.f; \
            init = init || move_; l_reg *= al_; \
            _Pragma("unroll") for (int r_ = 0; r_ < 16; ++r_) { P0[r_] -= dl_; P1[r_] -= dl_; negm[r_] -= dl_; } \
            if (hi == 0) wsf[r32] = al_; asm volatile("s_waitcnt lgkmcnt(0)" ::: "memory"); \
            _Pragma("unroll") for (int r_ = 0; r_ < 16; ++r_) { const float a_ = wsf[crow(r_, hi)]; o[0][r_] *= a_; o[1][r_] *= a_; } } } while (0)
#define ATT_PACK(P0, P1, PW, KEEP) do { _Pragma("unroll") for (int k_ = 0; k_ < 2; ++k_) { \
            PW[k_] = (u4){pkh(P0[8 * k_], P0[8 * k_ + 1]), pkh(P0[8 * k_ + 2], P0[8 * k_ + 3]), pkh(P0[8 * k_ + 4], P0[8 * k_ + 5]), pkh(P0[8 * k_ + 6], P0[8 * k_ + 7])}; \
            PW[2 + k_] = (u4){pkh(P1[8 * k_], P1[8 * k_ + 1]), pkh(P1[8 * k_ + 2], P1[8 * k_ + 3]), pkh(P1[8 * k_ + 4], P1[8 * k_ + 5]), pkh(P1[8 * k_ + 6], P1[8 * k_ + 7])}; } \
        if (MOBA) { _Pragma("unroll") for (int k_ = 0; k_ < 4; ++k_) PW[k_] &= (KEEP); } } while (0)
#define ATT_VF(buf, i) (lds + L_V + (buf) * VBUF + vro + ((i) >> 2) * 4096 + ((i) & 3) * 1024)
#define ATT_WAIT_NEXT(t_) do { if ((t_) + 3 < NT) { if (NDMA == 3) ATT_WAITV(3); else ATT_WAITV(2); } else ATT_WAITV(0); } while (0)
#define ATT_TB(i) (MOBA ? tb[(i)] : 64 * (i))
    const int NF = NT - 4;
    ATT_DMA(ATT_TB(0), 0); ATT_DMA(ATT_TB(1), 1); ATT_DMA(ATT_TB(2), 2);
    if (NDMA == 3) ATT_WAITV(3); else ATT_WAITV(2);
    ATT_BAR();
    f16v pC0, pC1;
    if (NF > 0) { ATT_QK(pC0, pC1, 0); asm volatile("s_nop 15\n\ts_nop 7" : "+v"(pC0), "+v"(pC1)); float pm; ATT_MAXCHAIN(pC0, pC1, pm);
        if (MOBA && !((sel >> (ATT_TB(0) >> 8)) & 1u)) pm = -INFINITY; ATT_MOVE(pC0, pC1, pm); }
    auto step = [&](f16v& pC0, f16v& pC1, f16v& pN0, f16v& pN1, const int t, auto hn) __attribute__((always_inline)) {
        const int cur = t & 3, nx = (t + 1) & 3; constexpr bool hasn = decltype(hn)::value;
        ATT_DMA(ATT_TB(t + 3), (t + 3) & 3);
        const unsigned keepC = (!MOBA || ((sel >> (ATT_TB(t) >> 8)) & 1u)) ? 0xffffffffu : 0u;
        float ps = 0.f;
        if (hasn) {
            h8 kf[G];
#pragma unroll
            for (int g = 0; g < 4; ++g) kf[g] = ATT_KF(nx, g);
            ATT_SBAR();
#pragma unroll
            for (int g = 0; g < G; ++g) {
                if (g + 4 < G) kf[g + 4] = ATT_KF(nx, g + 4);
                if (g & 1) pN1 = ATT_MF(kf[g], qr[g >> 1], g == 1 ? negm : pN1); else pN0 = ATT_MF(kf[g], qr[g >> 1], g == 0 ? negm : pN0);
                constexpr int dummy = 0; (void)dummy;
                const int e0 = (ND == 4) ? 4 * g : (g < 8 ? 3 * g : 24 + 2 * (g - 8)), e1 = (ND == 4) ? 4 * g + 4 : (g < 8 ? 3 * g + 3 : 26 + 2 * (g - 8));
#pragma unroll
                for (int e = e0; e < e1; ++e) { if (e < 16) { pC0[e] = __builtin_amdgcn_exp2f(pC0[e]); ps += pC0[e]; } else { pC1[e - 16] = __builtin_amdgcn_exp2f(pC1[e - 16]); ps += pC1[e - 16]; } }
                ATT_PIN(pC0); ATT_PIN(pC1); ATT_PIN(ps); ATT_SBAR();
            }
        } else {
#pragma unroll
            for (int r = 0; r < 16; ++r) { pC0[r] = __builtin_amdgcn_exp2f(pC0[r]); pC1[r] = __builtin_amdgcn_exp2f(pC1[r]); ps += pC0[r] + pC1[r]; }
        }
        if (MOBA && !keepC) ps = 0.f;
        l_reg += swapsum(ps);
        u4 pw[4]; ATT_PACK(pC0, pC1, pw, keepC);
        {
            s4 vlo[8], vhi[8]; float pa = 0.f, pb = 0.f;
#pragma unroll
            for (int i = 0; i < 3; ++i) { vlo[i] = vtr(ATT_VF(cur, i)); vhi[i] = vtr(ATT_VF(cur, i) + 512); }
            if (hasn) asm volatile("s_nop 7" : "+v"(pN0), "+v"(pN1));
            ATT_SBAR();
#pragma unroll
            for (int i = 0; i < 8; ++i) {
                if (i + 3 < 8) { vlo[i + 3] = vtr(ATT_VF(cur, i + 3)); vhi[i + 3] = vtr(ATT_VF(cur, i + 3) + 512); }
                const s8 vv = (s8){vlo[i][0], vlo[i][1], vlo[i][2], vlo[i][3], vhi[i][0], vhi[i][1], vhi[i][2], vhi[i][3]};
                o[i >> 2] = ATT_MF(__builtin_bit_cast(h8, pw[i & 3]), __builtin_bit_cast(h8, vv), o[i >> 2]);
                if (hasn) {
                    if (i == 0) { pa = max3f(pN0[0], pN0[1], pN1[0]); pb = max3f(pN0[2], pN0[3], pN1[1]); }
                    else if (i == 1) { pa = max3f(pa, pN1[2], pN1[3]); pb = max3f(pb, pN0[6], pN0[7]); }
                    else if (i == 2) { pa = max3f(pa, pN0[4], pN0[5]); pb = max3f(pb, pN1[6], pN1[7]); }
                    else if (i == 3) { pa = max3f(pa, pN1[4], pN1[5]); pb = max3f(pb, pN0[10], pN0[11]); }
                    else if (i == 4) { pa = max3f(pa, pN0[8], pN0[9]); pb = max3f(pb, pN1[10], pN1[11]); }
                    else if (i == 5) { pa = max3f(pa, pN1[8], pN1[9]); pb = max3f(pb, pN0[14], pN0[15]); }
                    else if (i == 6) { pa = max3f(pa, pN0[12], pN0[13]); pb = max3f(pb, pN1[14], pN1[15]); }
                    else { pa = max3f(pa, pN1[12], pN1[13]); }
                    ATT_PIN(pa); ATT_PIN(pb);
                }
                ATT_SBAR();
            }
            if (hasn) { float pm = swapmax(fmaxf(pa, pb)); if (MOBA && !((sel >> (ATT_TB(t + 1) >> 8)) & 1u)) pm = -INFINITY; ATT_MOVE(pN0, pN1, pm); }
        }
        if (NDMA == 3) ATT_WAITV(3); else ATT_WAITV(2);
        ATT_BAR();
    };
    {
        f16v pD0, pD1; int t = 0;
        for (; t + 2 < NF; t += 2) { step(pC0, pC1, pD0, pD1, t, T1{}); step(pD0, pD1, pC0, pC1, t + 1, T1{}); }
        if (t + 1 < NF) { step(pC0, pC1, pD0, pD1, t, T1{}); step(pD0, pD1, pC0, pC1, t + 1, T0{}); }
        else if (t < NF) step(pC0, pC1, pD0, pD1, t, T0{});
    }
    for (int t = NF; t < NT; ++t) {
        const int cur = t & 3, kb = ATT_TB(t);
        if (t + 3 < NT) ATT_DMA(ATT_TB(t + 3), (t + 3) & 3);
        if (kb <= qw0 + 31) {
            f16v p0, p1; ATT_QK(p0, p1, cur);
            if (kb + 63 > qw0) {
#pragma unroll
                for (int r = 0; r < 16; ++r) { const int kv = kb + crow(r, hi); if (kv > qrow) p0[r] = -INFINITY; if (kv + 32 > qrow) p1[r] = -INFINITY; }
            }
            asm volatile("s_nop 15\n\ts_nop 7" : "+v"(p0), "+v"(p1));
            float pm; ATT_MAXCHAIN(p0, p1, pm); ATT_MOVE(p0, p1, pm);
            s4 vlo[8], vhi[8];
#pragma unroll
            for (int i = 0; i < 8; ++i) { vlo[i] = vtr(ATT_VF(cur, i)); vhi[i] = vtr(ATT_VF(cur, i) + 512); }
            ATT_SBAR();
            float ps = 0.f;
#pragma unroll
            for (int r = 0; r < 16; ++r) { p0[r] = __builtin_amdgcn_exp2f(p0[r]); p1[r] = __builtin_amdgcn_exp2f(p1[r]); ps += p0[r] + p1[r]; }
            l_reg += swapsum(ps);
            u4 pw[4]; ATT_PACK(p0, p1, pw, 0xffffffffu);
#pragma unroll
            for (int i = 0; i < 8; ++i) { const s8 vv = (s8){vlo[i][0], vlo[i][1], vlo[i][2], vlo[i][3], vhi[i][0], vhi[i][1], vhi[i][2], vhi[i][3]};
                o[i >> 2] = ATT_MF(__builtin_bit_cast(h8, pw[i & 3]), __builtin_bit_cast(h8, vv), o[i >> 2]); }
        }
        ATT_WAIT_NEXT(t);
        ATT_BAR();
    }
    if (hi == 0) wsf[32 + r32] = l_reg; asm volatile("s_waitcnt lgkmcnt(0)" ::: "memory");
    LAS _Float16* stg = (LAS _Float16*)(lds + L_OST) + wid * 2048;
#pragma unroll
    for (int r = 0; r < 16; ++r) { const int orow = crow(r, hi); const float rl = 1.f / wsf[32 + orow];
        stg[orow * 64 + r32] = (_Float16)(o[0][r] * rl); stg[orow * 64 + 32 + r32] = (_Float16)(o[1][r] * rl); }
    asm volatile("s_waitcnt lgkmcnt(0)" ::: "memory");
    int lane_e = lane; asm volatile("" : "+v"(lane_e));
    unsigned char* zbu = (unsigned char*)(Zg + (rowbase + qw0) * 1024 + h * 64);
#pragma unroll
    for (int i = 0; i < 4; ++i) { const int row = i * 8 + (lane_e >> 3), ch = lane_e & 7; const h8 v = *(const LAS h8*)(stg + row * 64 + ch * 8);
        _Float16* zp = (_Float16*)(zbu + (unsigned)(row * 1024 + ch * 8) * 2u); const h8 z = *(const h8*)zp; h8 ov;
#pragma unroll
        for (int j = 0; j < 8; ++j) ov[j] = (_Float16)((float)v[j] * (float)z[j]);
        if (!dry) *(h8*)zp = ov; }
    __syncthreads();
#undef ATT_GLDS
#undef ATT_DMA
#undef ATT_WAITV
#undef ATT_BAR
#undef ATT_SBAR
#undef ATT_PIN
#undef ATT_KF
#undef ATT_MF
#undef ATT_QK
#undef ATT_MAXCHAIN
#undef ATT_MOVE
#undef ATT_PACK
#undef ATT_VF
#undef ATT_WAIT_NEXT
#undef ATT_TB
}

__device__ __forceinline__ void attn_phase(unsigned char* ws, LAS unsigned char* lds, int vb, int nvb) {
    const int vcu = (nvb % 8 == 0) ? (vb % 8) * (nvb / 8) + vb / 8 : vb; const int per = (1024 + nvb - 1) / nvb;
    for (int k = 0; k < per; ++k) {
        int it;
        if (nvb == 256) { const int xg = vcu >> 5, lw = vcu & 31; it = ((16 * xg + 4 * k + (lw >> 3)) << 3) | (lw & 7); }
        else { it = vcu * per + k; if (it >= 1024) break; }
        const int bh = it >> 3, pr = it & 7, b = bh >> 3, h = bh & 7;
        if (PROBE == 2) for (int uu = 0; uu < 2; ++uu) attn_unit<96, false, PROBE_ABL>(ws, b, h, uu ? 15 - pr : pr, lds, true);
        for (int uu = 0; uu < 2; ++uu) attn_unit<96, false>(ws, b, h, uu ? 15 - pr : pr, lds);
        if (PROBE == 3) for (int uu = 0; uu < 2; ++uu) attn_unit<64, true, PROBE_ABL>(ws, b, h, uu ? 15 - pr : pr, lds, true);
        for (int uu = 0; uu < 2; ++uu) attn_unit<64, true>(ws, b, h, uu ? 15 - pr : pr, lds);
    }
}
}

constexpr int RING_BYTES = 131072, MISC_OFF = RING_BYTES + 320, LDS_BYTES = 147456;
constexpr int CW_BAR = 4096;

__global__ void __launch_bounds__(512, 2) mega(Params p) {
    extern __shared__ __attribute__((aligned(16))) unsigned char lds[];
    const int vb = blockIdx.x, nvb = gridDim.x, tid = threadIdx.x, lane = tid & 63, wave = tid >> 6;
    const int gtid = vb * 512 + tid, gsize = nvb * 512, gwave = vb * 8 + wave, nwaves = nvb * 8;
    volatile LAS unsigned* misc = (volatile LAS unsigned*)((LAS unsigned char*)lds + MISC_OFF);
    if (tid < 32) misc[tid] = 0u;
    __syncthreads();
    XcdBarrier bar = xcd_barrier_post((unsigned*)(p.ws + WS_CTL) + CW_BAR, misc + 8);
    LAS unsigned char* ldsl = (LAS unsigned char*)lds;
    { int t_ = threadIdx.x; asm volatile("" : "+v"(t_)); ph_prep(p, vb * 512 + t_, gsize); ph_weights(p, ldsl, vb * 8 + (t_ >> 6), nwaves, t_ >> 6, t_ & 63); }
    xcd_barrier(bar);
    for (int rep4 = 0; rep4 < ((PROBE == 4 || PROBE == 6) ? 2 : 1); ++rep4) { int t_ = threadIdx.x; asm volatile("" : "+v"(t_)); ph_hnorm(p, vb * 8 + (t_ >> 6), nwaves, t_ & 63); }
    xcd_barrier(bar);
    {
        pg8::Gemm g{(const pg8::bf16_t*)(p.ws + WS_H), (const pg8::bf16_t*)(p.ws + WT_IN), M_, 5120, 1024}; pg8::StaticOrder S; S.init(M_, 5120, nvb, vb);
        for (int rep = (PROBE == 1 ? 1 : 0); rep >= 0; --rep) { pg8::EpiInF E{p.ws, p.b_merge, rep}; pg8::gemm_phase<pg8::EpiInF, pg8::StaticOrder, true, true>(ldsl, g, S, E); }
        if (PROBE == 5) { pg8::EpiNull E; pg8::gemm_phase<pg8::EpiNull, pg8::StaticOrder, true, true>(ldsl, g, S, E); }
    }
    xcd_barrier(bar);
    for (int rep4 = 0; rep4 < ((PROBE == 4 || PROBE == 7) ? 2 : 1); ++rep4) {
        pg8::Gemm g{(const pg8::bf16_t*)(p.ws + WS_QLAT), (const pg8::bf16_t*)(p.ws + WT_UQ), M_, 768, 256}; pg8::StaticOrder S; S.init(M_, 768, nvb, vb);
        pg8::EpiUqF E{p.ws}; pg8::gemm_phase<pg8::EpiUqF, pg8::StaticOrder, true, true>(ldsl, g, S, E);
    }
    for (int rep4 = 0; rep4 < ((PROBE == 4 || PROBE == 7) ? 2 : 1); ++rep4) {
        pg8::Gemm g{(const pg8::bf16_t*)(p.ws + WS_KVL), (const pg8::bf16_t*)(p.ws + WT_UKV), M_, 1024, 256}; pg8::StaticOrder S; S.init(M_, 1024, nvb, vb);
        pg8::EpiUkvF E{p.ws}; pg8::gemm_phase<pg8::EpiUkvF, pg8::StaticOrder, true, true>(ldsl, g, S, E);
    }
    xcd_barrier(bar);
    att::attn_phase(p.ws, ldsl, vb, nvb);
    xcd_barrier(bar);
    {
        pg8::Gemm g{(const pg8::bf16_t*)(p.ws + WS_ZCAT), (const pg8::bf16_t*)(p.ws + WT_OA), M_, 1024, 1024}; pg8::StaticOrder S; S.init(M_, 1024, nvb, vb);
        pg8::EpiYcatF E{p.ws}; pg8::gemm_phase<pg8::EpiYcatF, pg8::StaticOrder, true, true>(ldsl, g, S, E);
    }
    xcd_barrier(bar);
    for (int rep4 = 0; rep4 < ((PROBE == 4 || PROBE == 9) ? 2 : 1); ++rep4) {
        pg8::Gemm g{(const pg8::bf16_t*)(p.ws + WS_YM), (const pg8::bf16_t*)(p.ws + WT_OUT), M_, 1024, 1024}; pg8::StaticOrder S; S.init(M_, 1024, nvb, vb);
        pg8::EpiYF E{p.ws}; pg8::gemm_phase<pg8::EpiYF, pg8::StaticOrder, true, true>(ldsl, g, S, E);
    }
    xcd_barrier(bar);
    for (int rep4 = 0; rep4 < ((PROBE == 4 || PROBE == 9) ? 2 : 1); ++rep4) { int t_ = threadIdx.x; asm volatile("" : "+v"(t_)); ph_final(p, vb * 8 + (t_ >> 6), nwaves, t_ & 63); }
}

extern "C" void kernel_launch(void* const* d_in, const int* in_sizes, int n_in, void* d_out, int out_size, void* d_ws, size_t ws_size, hipStream_t stream) {
    if (n_in != 16 || out_size != M_ * DM || ws_size < WS_END) { fprintf(stderr, "kernel_launch: unexpected shapes (n_in %d, out %d, ws %zu)\n", n_in, out_size, ws_size); return; }
    Params p{};
    p.x = (const float*)d_in[0]; p.c = (const float*)d_in[1]; p.pos = (const int*)d_in[2]; p.w_ada = (const float*)d_in[3]; p.b_ada = (const float*)d_in[4];
    p.g_pre = (const float*)d_in[5]; p.g_post = (const float*)d_in[6]; p.w_in = (const float*)d_in[7]; p.g_q = (const float*)d_in[8]; p.w_uq = (const float*)d_in[9];
    p.g_kv = (const float*)d_in[10]; p.w_ukv = (const float*)d_in[11]; p.w_o_mla = (const float*)d_in[12]; p.w_o_moba = (const float*)d_in[13]; p.b_merge = (const float*)d_in[14]; p.w_out = (const float*)d_in[15];
    p.out = (float*)d_out; p.ws = (unsigned char*)d_ws;
    static int grid = 0;
    if (grid == 0) {
        int dev = 0, cus = 0, per_cu = 0;
        if (hipGetDevice(&dev) != hipSuccess || hipDeviceGetAttribute(&cus, hipDeviceAttributeMultiprocessorCount, dev) != hipSuccess) { fprintf(stderr, "kernel_launch: device query failed\n"); grid = -1; return; }
        if (hipFuncSetAttribute((const void*)mega, hipFuncAttributeMaxDynamicSharedMemorySize, LDS_BYTES) != hipSuccess) { fprintf(stderr, "kernel_launch: hipFuncSetAttribute failed\n"); grid = -1; return; }
        if (hipOccupancyMaxActiveBlocksPerMultiprocessor(&per_cu, (const void*)mega, 512, LDS_BYTES) != hipSuccess || per_cu < 1) { fprintf(stderr, "kernel_launch: occupancy query says %d\n", per_cu); }
        (void)hipGetLastError();
        grid = cus;
    }
    if (grid < 0) return;
    (void)hipMemsetAsync(d_ws, 0, ZERO_BYTES, stream);
    hipLaunchKernelGGL(mega, dim3(grid), dim3(512), LDS_BYTES, stream, p);
}
```

```cpp
#include <hip/hip_runtime.h>
#include <cstdio>
#ifndef PROBE
#define PROBE 0
#endif
#include <cstdint>

typedef _Float16 h16;
typedef _Float16 h16x4 __attribute__((ext_vector_type(4)));
typedef _Float16 h2n __attribute__((ext_vector_type(2)));

constexpr int NB = 16, SEQ = 4096, DM = 1024, M_ = NB * SEQ, NH = 8;
constexpr int D_IN = 5024;
constexpr int C_QLAT = 0, C_KVLAT = 256, C_KROPE = 384, C_ZMLA = 416, C_QMB = 928, C_KMB = 1440, C_VMB = 1952, C_ZMB = 2464, C_GA = 2976, C_GB = 4000;
constexpr float EPS = 1e-6f;
constexpr float LOG2E = 1.4426950408889634f;
constexpr float SC_MLA = 0.10206207261596577f * LOG2E;
constexpr float SC_MB = 0.125f * LOG2E;

constexpr size_t MiB = 1u << 20;
constexpr size_t WS_CTL = 0, WS_KMEAN = 512 * 1024, WS_SSQ = 1 * MiB, WS_SSQY = WS_SSQ + 2 * (size_t)M_ * 4, ZERO_BYTES = 2 * MiB;
constexpr size_t WS_MOD = WS_SSQ + 3 * (size_t)M_ * 4, WS_TAB = 4 * MiB, WS_WT = 20 * MiB;
constexpr size_t WS_H = 36 * MiB, WS_KN = 36 * MiB, WS_VM = 100 * MiB;
constexpr size_t WS_QLAT = 164 * MiB, WS_KVL = 196 * MiB, WS_KPE = 228 * MiB, WS_VMB = 232 * MiB;
constexpr size_t WS_QMB = 296 * MiB, WS_KMB = 360 * MiB, WS_ZCAT = 424 * MiB, WS_YM = 296 * MiB;
constexpr size_t WS_GA = 552 * MiB, WS_GB = 616 * MiB, WS_Y = 680 * MiB,     WS_QMLA = 808 * MiB, WS_END = 904 * MiB;

static_assert(WS_MOD + (size_t)NB * 3072 * 4 <= ZERO_BYTES, "MOD inside the zeroed region");
struct Params {
    const float *x, *c; const int* pos; const float *w_ada, *b_ada, *g_pre, *g_post, *w_in, *g_q, *w_uq, *g_kv, *w_ukv, *w_o_mla, *w_o_moba, *b_merge, *w_out;
    float* out; unsigned char* ws;
};

__device__ __forceinline__ float wave_sum(float v) {
#pragma unroll
    for (int o = 1; o < 64; o <<= 1) v += __shfl_xor(v, o);
    return v;
}
__device__ __forceinline__ float silu_f(float v) { return v / (1.f + __expf(-v)); }
__device__ __forceinline__ float sigmoid_f(float v) { return 1.f / (1.f + __expf(-v)); }

__device__ void ph_tab(const Params& p, int gtid, int gsize);
__device__ void ph_prep(const Params& p, int gtid, int gsize) {
    float* mod = (float*)(p.ws + WS_MOD);
    { const int gw = gtid >> 6, ngw = gsize >> 6, ln = gtid & 63;
      for (int it = gw; it < 48 * 32; it += ngw) {
          const int cg = it % 48, kc = it / 48, j = cg * 64 + ln, k0 = kc * 32; float acc[NB];
#pragma unroll
          for (int b = 0; b < NB; ++b) acc[b] = (kc == 0) ? p.b_ada[j] : 0.f;
          for (int kk = 0; kk < 32; ++kk) { const float w = p.w_ada[(size_t)(k0 + kk) * 3072 + j];
#pragma unroll
              for (int b = 0; b < NB; ++b) { const float cv = p.c[b * DM + k0 + kk]; acc[b] = fmaf(cv / (1.f + __expf(-cv)), w, acc[b]); } }
#pragma unroll
          for (int b = 0; b < NB; ++b) atomicAdd(mod + b * 3072 + j, acc[b]);
      } }
    ph_tab(p, gtid, gsize);
}
__device__ void ph_tab(const Params& p, int gtid, int gsize) {
    unsigned* tab = (unsigned*)(p.ws + WS_TAB);
    const int f = gtid & 31;
    const double c = exp2(-(double)f * (13.287712379549449 / 32.0)) * 0.15915494309189535;
    int ex; const double mant = frexp(c, &ex); const double c_hi_d = ldexp(rint(ldexp(mant, 11)), ex - 11);
    const float c_hi = (float)c_hi_d, c_lo = (float)(c - c_hi_d);
    for (int i = gtid; i < M_ * 32; i += gsize) {
        const float pos = (float)p.pos[i >> 5];
        float x = pos * c_hi; x = x - floorf(x); x = fmaf(pos, c_lo, x);
        typedef _Float16 h2t __attribute__((ext_vector_type(2))); h2t cs; cs[0] = (_Float16)__builtin_amdgcn_cosf(x); cs[1] = (_Float16)__builtin_amdgcn_sinf(x);
        tab[i] = __builtin_bit_cast(unsigned, cs);
    }
}

__device__ void ph_hnorm(const Params& p, int gwave, int nwaves, int lane) {
    constexpr int R = 4;
    typedef float f4 __attribute__((ext_vector_type(4)));
    const float* mod = (const float*)(p.ws + WS_MOD); h16* H = (h16*)(p.ws + WS_H);
    for (int m0 = R * gwave; m0 < M_; m0 += R * nwaves) {
        f4 v[R][4]; float ss[R];
#pragma unroll
        for (int r = 0; r < R; ++r) { const f4* xr = (const f4*)(p.x + (size_t)(m0 + r) * DM);
#pragma unroll
            for (int j = 0; j < 4; ++j) v[r][j] = __builtin_nontemporal_load(xr + lane + 64 * j); }
#pragma unroll
        for (int r = 0; r < R; ++r) { float s = 0.f;
#pragma unroll
            for (int j = 0; j < 4; ++j) s += (v[r][j][0] * v[r][j][0] + v[r][j][1] * v[r][j][1]) + (v[r][j][2] * v[r][j][2] + v[r][j][3] * v[r][j][3]);
            ss[r] = 1.f / sqrtf(wave_sum(s) * (1.f / DM) + EPS); }
        const int b = m0 >> 12;
#pragma unroll
        for (int j = 0; j < 4; ++j) {
            const int col = 4 * (lane + 64 * j);
            const float4 g = *(const float4*)(p.g_pre + col), sc = *(const float4*)(mod + b * 3072 + 1024 + col), sh = *(const float4*)(mod + b * 3072 + col);
            const float g0 = g.x * (1.f + sc.x), g1 = g.y * (1.f + sc.y), g2 = g.z * (1.f + sc.z), g3 = g.w * (1.f + sc.w);
#pragma unroll
            for (int r = 0; r < R; ++r) { const float rstd = ss[r]; const f4 x = v[r][j];
                h16x4 o; o[0] = (h16)(x[0] * rstd * g0 + sh.x); o[1] = (h16)(x[1] * rstd * g1 + sh.y); o[2] = (h16)(x[2] * rstd * g2 + sh.z); o[3] = (h16)(x[3] * rstd * g3 + sh.w);
                *(h16x4*)(H + (size_t)(m0 + r) * DM + col) = o; }
        }
    }
}

__device__ void ph_final(const Params& p, int gwave, int nwaves, int lane) {
    constexpr int R = 4; typedef float f4 __attribute__((ext_vector_type(4)));
    const float* mod = (const float*)(p.ws + WS_MOD); const h16* Y = (const h16*)(p.ws + WS_Y); const float* ssq = (const float*)(p.ws + WS_SSQY);
    for (int m0 = R * gwave; m0 < M_; m0 += R * nwaves) {
        const int b = m0 >> 12; h16x4 yv[R][4]; f4 xv[R][4]; float rs[R];
#pragma unroll
        for (int r = 0; r < R; ++r) { const h16x4* yr = (const h16x4*)(Y + (size_t)(m0 + r) * DM); const f4* xr = (const f4*)(p.x + (size_t)(m0 + r) * DM); rs[r] = ssq[m0 + r];
#pragma unroll
            for (int j = 0; j < 4; ++j) { yv[r][j] = yr[lane + 64 * j]; xv[r][j] = __builtin_nontemporal_load(xr + lane + 64 * j); } }
#pragma unroll
        for (int r = 0; r < R; ++r) rs[r] = 1.f / sqrtf(rs[r] * (1.f / DM) + EPS);
#pragma unroll
        for (int j = 0; j < 4; ++j) {
            const int col = 4 * (lane + 64 * j); const float4 g = *(const float4*)(p.g_post + col), gt = *(const float4*)(mod + b * 3072 + 2048 + col);
            const float g0 = g.x * gt.x, g1 = g.y * gt.y, g2 = g.z * gt.z, g3 = g.w * gt.w;
#pragma unroll
            for (int r = 0; r < R; ++r) { const h16x4 y = yv[r][j]; const f4 x = xv[r][j]; const float s = rs[r];
                f4 o; o[0] = x[0] + g0 * (float)y[0] * s; o[1] = x[1] + g1 * (float)y[1] * s; o[2] = x[2] + g2 * (float)y[2] * s; o[3] = x[3] + g3 * (float)y[3] * s;
                __builtin_nontemporal_store(o, (f4*)(p.out + (size_t)(m0 + r) * DM) + lane + 64 * j); }
        }
    }
}


#define XB_TMO      128
#define XB_XCNT(j)  (256  + 64 * (j))
#define XB_XSUB(j)  (1280 + 64 * (j))
#define XB_XGEN(j)  (2304 + 64 * (j))
#define XB_TOP      3328
#define XB_TOPGEN   3392
#define XCD_BAR_WORDS 3456
#define XB_SPIN_CAP (1u << 27)
#define LAS __attribute__((address_space(3)))
__device__ __forceinline__ unsigned xb_ld(unsigned* p)              { return __hip_atomic_load(p, __ATOMIC_RELAXED, __HIP_MEMORY_SCOPE_AGENT); }
__device__ __forceinline__ unsigned xb_add(unsigned* p, unsigned v) { return __hip_atomic_fetch_add(p, v, __ATOMIC_RELAXED, __HIP_MEMORY_SCOPE_AGENT); }
__device__ __forceinline__ unsigned xb_xcc_id() { return (unsigned)__builtin_amdgcn_s_getreg((3 << 11) | 20) & 0xFu; }
#define XB_SPIN(cond, bar) do { unsigned _sp = 0; while (cond) { __builtin_amdgcn_s_sleep(1); \
    if ((++_sp & 255u) == 0u) { if (xb_ld(&(bar)[XB_TMO])) break; if (_sp > XB_SPIN_CAP) { atomicAdd(&(bar)[XB_TMO], 1u); break; } } } } while (0)
struct XcdBarrier { unsigned* bar; unsigned x; volatile LAS unsigned* st; };
__device__ __forceinline__ XcdBarrier xcd_barrier_post(unsigned* bar, volatile LAS unsigned* st) {
    XcdBarrier b; b.bar = bar; b.x = xb_xcc_id(); b.st = st;
    if (threadIdx.x == 0) (void)xb_add(&bar[XB_XCNT(b.x)], 1u);
    return b;
}
__device__ __forceinline__ void xcd_barrier_complete(unsigned* bar, unsigned x, unsigned& nloc, unsigned& nx) {
    const unsigned G = gridDim.x * gridDim.y * gridDim.z;
    unsigned sum, cnt, mine, sp = 0u;
    for (;;) {
        sum = 0u; cnt = 0u; mine = 0u;
#pragma unroll
        for (unsigned j = 0; j < 16; ++j) { const unsigned c = xb_ld(&bar[XB_XCNT(j)]); sum += c; cnt += (c > 0u) ? 1u : 0u; mine = (j == x) ? c : mine; }
        if (sum == G) break;
        __builtin_amdgcn_s_sleep(1);
        if ((++sp & 255u) == 0u) { if (xb_ld(&bar[XB_TMO])) break; if (sp > XB_SPIN_CAP) { atomicAdd(&bar[XB_TMO], 1u); break; } }
    }
    nloc = mine > 0u ? mine : 1u; nx = cnt > 0u ? cnt : 1u;
}
__device__ __forceinline__ void xcd_barrier(const XcdBarrier& b) {
    asm volatile("s_waitcnt vmcnt(0)" ::: "memory");
    __syncthreads();
    if (threadIdx.x == 0) {
        unsigned* bar = b.bar;
        __builtin_amdgcn_s_waitcnt(0);
        unsigned nloc = b.st[0], nx = b.st[1];
        if (nloc == 0u) { xcd_barrier_complete(bar, b.x, nloc, nx); b.st[0] = nloc; b.st[1] = nx; }
        const unsigned old = xb_add(&bar[XB_XSUB(b.x)], 1u);
        const unsigned gen = old / nloc;
        if (old + 1u == (gen + 1u) * nloc) {
            __builtin_amdgcn_fence(__ATOMIC_RELEASE, "agent");
            asm volatile("s_waitcnt vmcnt(0)" ::: "memory");
            const unsigned og = xb_add(&bar[XB_TOP], 1u);
            const unsigned tg = og / nx;
            if (og + 1u == (tg + 1u) * nx) xb_add(&bar[XB_TOPGEN], 1u);
            else XB_SPIN(xb_ld(&bar[XB_TOPGEN]) == tg, bar);
            __builtin_amdgcn_fence(__ATOMIC_ACQUIRE, "agent");
            xb_add(&bar[XB_XGEN(b.x)], 1u);
            asm volatile("s_waitcnt vmcnt(0)" ::: "memory");
        } else {
            XB_SPIN(xb_ld(&bar[XB_XGEN(b.x)]) == gen, bar);
            __builtin_amdgcn_fence(__ATOMIC_ACQUIRE, "agent");
            asm volatile("s_waitcnt vmcnt(0)" ::: "memory");
        }
    }
    __syncthreads();
}

namespace pg8 {
#define PG8_LAS __attribute__((address_space(3)))
typedef unsigned short bf16_t;
typedef _Float16 bf16x8 __attribute__((ext_vector_type(8)));
typedef float f32x4 __attribute__((ext_vector_type(4)));
typedef unsigned u32x4 __attribute__((ext_vector_type(4)));
constexpr int BM = 256, BK = 64, HALF = 128, HTB = HALF * BK * 2  , STAGE_BYTES = 8 * HTB, NXCD = 8, WGM = 8;

__host__ __device__ __forceinline__ int lds_byte(int r, int c) { const int st = (r >> 4) * 2 + (c >> 5), rr = r & 15, cc = c & 31, ob = rr * 64 + cc * 2; return st * 1024 + (ob ^ (((ob >> 9) & 1) << 5)); }
__host__ __device__ __forceinline__ void stage_rc(int b, int& R, int& C) { const int st = b / 1024, sb = b % 1024, swz = sb ^ (((sb >> 9) & 1) << 5); R = (st >> 1) * 16 + swz / 64; C = (st & 1) * 32 + (swz % 64) / 2; }
__host__ __device__ __forceinline__ int perm32(int rho) { const int n = rho >> 4, i = rho & 15; return 8 * (i >> 2) + 4 * n + (i & 3); }

struct Unit { int pm, pn; };
struct Gemm { const bf16_t* A; const bf16_t* Bt; int M, N, K; };

struct StaticOrder {
    int nM, nN, nwg, G, c;
    __host__ __device__ void init(int M, int N, int G_, int c_) { nM = M / BM; nN = N / BM; nwg = nM * nN; G = G_; c = c_; }
    __host__ __device__ bool next(int i, Unit& u) const {
        const long L = (long)i * G + c; if (L >= nwg) return false;
        int wgid = (int)L; { const int q = nwg / NXCD, r = nwg % NXCD, xcd = wgid % NXCD, off = wgid / NXCD; wgid = (xcd < r ? xcd * (q + 1) : r * (q + 1) + (xcd - r) * q) + off; }
        const int nig = WGM * nN, gid = wgid / nig, fm = gid * WGM, gsz = (nM - fm) < WGM ? (nM - fm) : WGM;
        u.pm = fm + ((wgid % nig) % gsz); u.pn = (wgid % nig) / gsz; return true;
    }
    __device__ __forceinline__ void a_ready(const Unit&) const {}
    __device__ __forceinline__ void done(const Unit&) const {}
};

template <class Epi, class Sched, bool ALIGN_EPI = false, bool SP2 = false>
__device__ __forceinline__ void gemm_phase(PG8_LAS unsigned char* lds, const Gemm g, const Sched& S, const Epi& E) {
    int tid_ = threadIdx.x; asm volatile("" : "+v"(tid_));
    const int tid = tid_, wid = __builtin_amdgcn_readfirstlane(tid >> 6), lane = tid & 63, wr = wid >> 2, wc = wid & 3, fr = lane & 15, fq = lane >> 4;
    const int K = g.K, nt = K / BK;
    unsigned voffA[2], voffB[2];
#pragma unroll
    for (int i = 0; i < 2; ++i) { int R, C; stage_rc(tid * 16 + i * 8192, R, C); const int Rb = Epi::PERM ? ((R & ~31) + perm32(R & 31)) : R;
        voffA[i] = (unsigned)(R * K + C) * 2u; voffB[i] = (unsigned)(Rb * K + C) * 2u; }
    const size_t kstep = (size_t)(BK * 2);
    const size_t hstep = (size_t)HALF * K * 2;
    const size_t tstep = 2 * hstep;
    const unsigned ldsw = (unsigned)wid * 1024u;
    const int aoff = lds_byte(wr * 64 + fr, fq * 8), boff = lds_byte(wc * 32 + fr, fq * 8);
#define PG8_SA(b, h) (((b) * 2 + (h)) * HTB)
#define PG8_SB(b, h) ((4 + (b) * 2 + (h)) * HTB)
#define PG8_STAGE(bufoff, gbase, voff) do { _Pragma("unroll") for (int _i = 0; _i < 2; ++_i) \
        __builtin_amdgcn_global_load_lds((const unsigned*)((const char*)(gbase) + (voff)[_i]), (PG8_LAS unsigned*)(lds + (bufoff) + ldsw + _i * 8192), 16, 0, 0); } while (0)
#define PG8_LDA(dst, b, h) do { _Pragma("unroll") for (int m = 0; m < 4; ++m) _Pragma("unroll") for (int k = 0; k < 2; ++k) dst[m][k] = *(const PG8_LAS bf16x8*)(lds + PG8_SA(b, h) + aoff + m * 2048 + k * 1024); } while (0)
#define PG8_LDB(dst, b, h) do { _Pragma("unroll") for (int n = 0; n < 2; ++n) _Pragma("unroll") for (int k = 0; k < 2; ++k) dst[n][k] = *(const PG8_LAS bf16x8*)(lds + PG8_SB(b, h) + boff + n * 2048 + k * 1024); } while (0)
#define PG8_MMA(ai, bj, At, Bt) do { __builtin_amdgcn_s_setprio(1); _Pragma("unroll") for (int m = 0; m < 4; ++m) _Pragma("unroll") for (int n = 0; n < 2; ++n) _Pragma("unroll") for (int k = 0; k < 2; ++k) \
        acc[ai][bj][m][n] = __builtin_amdgcn_mfma_f32_16x16x32_f16(Bt[n][k], At[m][k], acc[ai][bj][m][n], 0, 0, 0); __builtin_amdgcn_s_setprio(0); } while (0)
#define PG8_WAIT_V(n) asm volatile("s_waitcnt vmcnt(" #n ")" ::: "memory")
#define PG8_WAIT_L(n) asm volatile("s_waitcnt lgkmcnt(" #n ")" ::: "memory")
#define PG8_BAR __builtin_amdgcn_s_barrier()
#define PG8_SCHED __builtin_amdgcn_sched_barrier(0)
    Unit cur, nxt; int ui = 0;
    if (!S.next(0, cur)) return;
    f32x4 acc[2][2][4][2];
#pragma unroll
    for (int a = 0; a < 2; ++a)
#pragma unroll
        for (int b = 0; b < 2; ++b)
#pragma unroll
            for (int m = 0; m < 4; ++m)
#pragma unroll
                for (int n = 0; n < 2; ++n) acc[a][b][m][n] = (f32x4){0.f, 0.f, 0.f, 0.f};
    bf16x8 At[4][2], B0[2][2], B1[2][2];
    const char* cA = (const char*)g.A + (size_t)cur.pm * tstep; const char* cB = (const char*)g.Bt + (size_t)cur.pn * tstep;
    S.a_ready(cur);
    if constexpr (SP2) {
        PG8_STAGE(PG8_SB(0, 0), cB, voffB); PG8_STAGE(PG8_SB(0, 1), cB + hstep, voffB); PG8_STAGE(PG8_SA(0, 0), cA, voffA); PG8_STAGE(PG8_SA(0, 1), cA + hstep, voffA);
        if (wr == 1) PG8_BAR;
        PG8_WAIT_V(2); PG8_BAR;
        PG8_STAGE(PG8_SB(1, 0), cB + kstep, voffB); PG8_STAGE(PG8_SA(1, 0), cA + kstep, voffA); PG8_STAGE(PG8_SB(1, 1), cB + hstep + kstep, voffB);
        PG8_WAIT_V(6); PG8_BAR;
    } else {
        PG8_STAGE(PG8_SB(0, 0), cB, voffB); PG8_STAGE(PG8_SA(0, 0), cA, voffA); PG8_STAGE(PG8_SB(0, 1), cB + hstep, voffB); PG8_STAGE(PG8_SA(0, 1), cA + hstep, voffA);
        if (wr == 1) PG8_BAR;
        PG8_WAIT_V(4); PG8_BAR;
        PG8_STAGE(PG8_SB(1, 0), cB + kstep, voffB); PG8_STAGE(PG8_SA(1, 0), cA + kstep, voffA); PG8_STAGE(PG8_SB(1, 1), cB + hstep + kstep, voffB);
        PG8_WAIT_V(6); PG8_BAR;
    }
    for (;;) {
        const bool has_next = S.next(ui + 1, nxt);
        const char* nA = has_next ? (const char*)g.A + (size_t)nxt.pm * tstep : cA; const char* nB = has_next ? (const char*)g.Bt + (size_t)nxt.pn * tstep : cB;
#pragma nounroll
        for (int t = 0; t < nt; t += 2) {
            const bool last = (t == nt - 2);
            if constexpr (Epi::MID_T > 0) { if (t == Epi::MID_T) E.mid(acc, cur, wr, wc); }
            const char* a1 = cA + (size_t)(t + 1) * kstep;
            const char* a2 = last ? nA : cA + (size_t)(t + 2) * kstep; const char* b2 = last ? nB : cB + (size_t)(t + 2) * kstep;
            const char* a3 = a2 + kstep; const char* b3 = b2 + kstep;
            if (last && has_next) S.a_ready(nxt);
            if constexpr (SP2) {
            PG8_LDB(B0, 0, 0); PG8_LDB(B1, 0, 1); PG8_SCHED; PG8_LDA(At, 0, 0); PG8_STAGE(PG8_SA(1, 1), a1 + hstep, voffA);
            PG8_WAIT_V(8); PG8_WAIT_L(0); PG8_BAR; PG8_MMA(0, 0, At, B0); PG8_MMA(0, 1, At, B1); PG8_BAR; PG8_SCHED;
            PG8_LDA(At, 0, 1); PG8_STAGE(PG8_SB(0, 0), b2, voffB); PG8_STAGE(PG8_SB(0, 1), b2 + hstep, voffB); PG8_STAGE(PG8_SA(0, 0), a2, voffA);
            PG8_WAIT_V(8); PG8_WAIT_L(0); PG8_BAR; PG8_MMA(1, 0, At, B0); PG8_MMA(1, 1, At, B1); PG8_BAR; PG8_SCHED;
            PG8_LDB(B0, 1, 0); PG8_LDB(B1, 1, 1); PG8_SCHED; PG8_LDA(At, 1, 0); PG8_STAGE(PG8_SA(0, 1), a2 + hstep, voffA);
            PG8_WAIT_V(8); PG8_WAIT_L(0); PG8_BAR; PG8_MMA(0, 0, At, B0); PG8_MMA(0, 1, At, B1); PG8_BAR; PG8_SCHED;
            PG8_LDA(At, 1, 1); PG8_STAGE(PG8_SB(1, 0), b3, voffB); PG8_STAGE(PG8_SB(1, 1), b3 + hstep, voffB); PG8_STAGE(PG8_SA(1, 0), a3, voffA);
            PG8_WAIT_V(8); PG8_WAIT_L(0); PG8_BAR; PG8_MMA(1, 0, At, B0); PG8_MMA(1, 1, At, B1); PG8_BAR; PG8_SCHED;
            } else {
            PG8_LDB(B0, 0, 0); PG8_SCHED; PG8_LDA(At, 0, 0); PG8_STAGE(PG8_SA(1, 1), a1 + hstep, voffA);
            PG8_WAIT_L(8); PG8_BAR; PG8_WAIT_L(0); PG8_MMA(0, 0, At, B0); PG8_BAR; PG8_SCHED;
            PG8_LDB(B1, 0, 1); PG8_STAGE(PG8_SB(0, 0), b2, voffB);
            PG8_BAR; PG8_WAIT_L(0); PG8_MMA(0, 1, At, B1); PG8_BAR;
            PG8_LDA(At, 0, 1); PG8_STAGE(PG8_SA(0, 0), a2, voffA);
            PG8_BAR; PG8_WAIT_L(0); PG8_MMA(1, 0, At, B0); PG8_BAR; PG8_SCHED;
            PG8_STAGE(PG8_SB(0, 1), b2 + hstep, voffB);
            PG8_WAIT_V(6); PG8_BAR; PG8_MMA(1, 1, At, B1); PG8_BAR;
            PG8_LDB(B0, 1, 0); PG8_SCHED; PG8_LDA(At, 1, 0); PG8_STAGE(PG8_SA(0, 1), a2 + hstep, voffA);
            PG8_WAIT_L(8); PG8_BAR; PG8_WAIT_L(0); PG8_MMA(0, 0, At, B0); PG8_BAR; PG8_SCHED;
            PG8_LDB(B1, 1, 1); PG8_STAGE(PG8_SB(1, 0), b3, voffB);
            PG8_BAR; PG8_WAIT_L(0); PG8_MMA(0, 1, At, B1); PG8_BAR;
            PG8_LDA(At, 1, 1); PG8_STAGE(PG8_SA(1, 0), a3, voffA);
            PG8_BAR; PG8_WAIT_L(0); PG8_MMA(1, 0, At, B0); PG8_BAR; PG8_SCHED;
            PG8_STAGE(PG8_SB(1, 1), b3 + hstep, voffB);
            PG8_WAIT_V(6); PG8_BAR; PG8_MMA(1, 1, At, B1); PG8_BAR;
            }
        }
        if constexpr (ALIGN_EPI) { if (wr == 0) PG8_BAR; }
        if constexpr (!Epi::AFTER_DRAIN) { E(acc, cur, wr, wc, fr, fq); S.done(cur); }
        if (!has_next) break;
#pragma unroll
        for (int a = 0; a < 2; ++a)
#pragma unroll
            for (int b = 0; b < 2; ++b)
#pragma unroll
                for (int m = 0; m < 4; ++m)
#pragma unroll
                    for (int n = 0; n < 2; ++n) acc[a][b][m][n] = (f32x4){0.f, 0.f, 0.f, 0.f};
        cur = nxt; cA = nA; cB = nB; ++ui;
        if constexpr (ALIGN_EPI) { if (wr == 1) PG8_BAR; }
    }
    PG8_WAIT_V(0);
    if constexpr (!ALIGN_EPI) { if (wr == 0) PG8_BAR; }
    PG8_BAR;
    if constexpr (Epi::AFTER_DRAIN) { E.fused(acc, cur, wr, wc, fr, fq, lds, wid, lane); S.done(cur); }
#undef PG8_SA
#undef PG8_SB
#undef PG8_STAGE
#undef PG8_LDA
#undef PG8_LDB
#undef PG8_MMA
#undef PG8_WAIT_V
#undef PG8_WAIT_L
#undef PG8_BAR
#undef PG8_SCHED
}
typedef _Float16 h8v __attribute__((ext_vector_type(8)));
typedef unsigned u32x2 __attribute__((ext_vector_type(2)));
typedef _Float16 h2v __attribute__((ext_vector_type(2)));
__device__ __forceinline__ unsigned pk_h2(float lo, float hi) { h2v v; v[0] = (_Float16)lo; v[1] = (_Float16)hi; return __builtin_bit_cast(unsigned, v); }
__device__ __forceinline__ u32x4 pack8(const f32x4& a, const f32x4& b) { u32x4 w; w.x = pk_h2(a[0], a[1]); w.y = pk_h2(a[2], a[3]); w.z = pk_h2(b[0], b[1]); w.w = pk_h2(b[2], b[3]); return w; }
__device__ __forceinline__ float sigm1(float v) { return __builtin_amdgcn_rcpf(1.f + __builtin_amdgcn_exp2f(v * -1.4426950408889634f)); }
__device__ __forceinline__ float silu1(float v) { return v * sigm1(v); }
__device__ __forceinline__ f32x4 silu4(const f32x4& v) { return (f32x4){silu1(v[0]), silu1(v[1]), silu1(v[2]), silu1(v[3])}; }
__device__ __forceinline__ f32x4 sigm4(const f32x4& v) { return (f32x4){sigm1(v[0]), sigm1(v[1]), sigm1(v[2]), sigm1(v[3])}; }

#define PG8_OPAQUE(fr_, fq_) int lane_x; asm volatile("v_mbcnt_lo_u32_b32 %0, -1, 0\n\tv_mbcnt_hi_u32_b32 %0, -1, %0" : "=v"(lane_x)); const int frx = lane_x & 15, fqx = lane_x >> 4
__device__ __forceinline__ void st16(unsigned char* base, unsigned off, const u32x4& v) { *(u32x4*)(base + off) = v; }
__device__ __forceinline__ f32x4 ld16f(const unsigned char* base, unsigned off) { return *(const f32x4*)(base + off); }
__device__ __forceinline__ float ld4f(const unsigned char* base, unsigned off) { return *(const float*)(base + off); }
__device__ __forceinline__ h8v ld16h(const unsigned char* base, unsigned off) { return *(const h8v*)(base + off); }
__device__ __forceinline__ float sumsq8(const f32x4& a, const f32x4& b) { return (a[0] * a[0] + a[1] * a[1]) + (a[2] * a[2] + a[3] * a[3]) + (b[0] * b[0] + b[1] * b[1]) + (b[2] * b[2] + b[3] * b[3]); }
__device__ __forceinline__ void rope4(const f32x4& t1, const f32x4& t2, const u32x4& cs, f32x4& o1, f32x4& o2) {
#pragma unroll
    for (int j = 0; j < 4; ++j) { const unsigned wj = cs[j]; h2v w; __builtin_memcpy(&w, &wj, 4);
        const float c = (float)w[0], s = (float)w[1]; o1[j] = t1[j] * c - t2[j] * s; o2[j] = t2[j] * c + t1[j] * s; }
}
__device__ __forceinline__ u32x4 ld16u(const unsigned char* base, unsigned off) { return *(const u32x4*)(base + off); }

struct EpiInF {
    static constexpr bool PERM = true, AFTER_DRAIN = false; static constexpr int MID_T = 0;
    unsigned char* ws; const float* b_merge; int noatomic;
    template <bool ISQ> __device__ __forceinline__ void rope_tile(const f32x4 (&acc)[2][2][4][2], const Unit& u, int wr, int wc, int frx, int fqx) const {
        const int pn = u.pn; const unsigned row0 = (unsigned)(u.pm * 256 + wr * 64) + (unsigned)frx; const float sc = ISQ ? SC_MB : 1.f;
        unsigned char* dst = ws + (ISQ ? WS_QMB : WS_KMB); const unsigned char* tab = ws + WS_TAB;
        const unsigned o0 = row0 * 1024u + (((pn & 1) ? 256u : 0u) + 64u * wc + 8u * fqx) * 2u, t0 = row0 * 128u + 32u * fqx;
        f32x4 c1[2] = {{0.f, 0.f, 0.f, 0.f}, {0.f, 0.f, 0.f, 0.f}}, c2[2] = {{0.f, 0.f, 0.f, 0.f}, {0.f, 0.f, 0.f, 0.f}};
        u32x4 cs[2][4][2];
#pragma unroll
        for (int ai = 0; ai < 2; ++ai)
#pragma unroll
            for (int m = 0; m < 4; ++m) { const unsigned to = t0 + (unsigned)(ai * 128 + m * 16) * 128u; cs[ai][m][0] = ld16u(tab, to); cs[ai][m][1] = ld16u(tab, to + 16u); }
#pragma unroll
        for (int ai = 0; ai < 2; ++ai)
#pragma unroll
            for (int m = 0; m < 4; ++m) { const unsigned ro = o0 + (unsigned)(ai * 128 + m * 16) * 1024u;
                f32x4 o1[2], o2[2];
#pragma unroll
                for (int n = 0; n < 2; ++n) { rope4(acc[ai][0][m][n], acc[ai][1][m][n], cs[ai][m][n], o1[n], o2[n]);
                    if (!ISQ) { c1[n] += o1[n]; c2[n] += o2[n]; } }
                st16(dst, ro, pack8(o1[0] * sc, o1[1] * sc)); st16(dst, ro + 64u, pack8(o2[0] * sc, o2[1] * sc));
                if (!ISQ) asm volatile("" : "+v"(c1[0]), "+v"(c1[1]), "+v"(c2[0]), "+v"(c2[1])); }
        if (!ISQ) {
            float* km = (float*)(ws + WS_KMEAN) + (size_t)u.pm * 512 + ((pn & 1) ? 256 : 0) + 64 * wc + 8 * fqx;
#pragma unroll
            for (int n = 0; n < 2; ++n)
#pragma unroll
                for (int j = 0; j < 4; ++j) { float a = c1[n][j], b = c2[n][j];
#pragma unroll
                    for (int o = 1; o < 16; o <<= 1) { a += __shfl_xor(a, o); b += __shfl_xor(b, o); }
                    if (frx == 0 && !noatomic) { atomicAdd(km + 4 * n + j, a * (1.f / 256.f)); atomicAdd(km + 32 + 4 * n + j, b * (1.f / 256.f)); } }
        }
    }
    __device__ __forceinline__ void operator()(const f32x4 (&acc)[2][2][4][2], const Unit& u, int wr, int wc, int fr, int fq) const {
        PG8_OPAQUE(fr, fq);
        const int pn = u.pn; const unsigned row0 = (unsigned)(u.pm * 256 + wr * 64) + (unsigned)frx, cl = 32u * wc + 8u * fqx;
        if (pn == 0) {
            unsigned char* dst = ws + WS_QLAT; float* ssq = (float*)(ws + WS_SSQ); const unsigned o0 = row0 * 512u + cl * 2u;
#pragma unroll
            for (int ai = 0; ai < 2; ++ai)
#pragma unroll
                for (int m = 0; m < 4; ++m) { const unsigned ro = o0 + (unsigned)(ai * 128 + m * 16) * 512u; float s = 0.f;
#pragma unroll
                    for (int bj = 0; bj < 2; ++bj) { s += sumsq8(acc[ai][bj][m][0], acc[ai][bj][m][1]); st16(dst, ro + bj * 256u, pack8(acc[ai][bj][m][0], acc[ai][bj][m][1])); }
                    s += __shfl_xor(s, 16); s += __shfl_xor(s, 32);
                    if (fqx == 0 && !noatomic) atomicAdd(ssq + (row0 + ai * 128 + m * 16), s); }
        } else if (pn == 1) {
            unsigned char* kvl = ws + WS_KVL; unsigned char* kpe = ws + WS_KPE; float* ssq = (float*)(ws + WS_SSQ) + M_; const unsigned char* tab = ws + WS_TAB;
#pragma unroll
            for (int ai = 0; ai < 2; ++ai)
#pragma unroll
                for (int m = 0; m < 4; ++m) { const unsigned row = row0 + ai * 128 + m * 16;
                    if (wc < 2) { float s = 0.f;
#pragma unroll
                        for (int bj = 0; bj < 2; ++bj) { s += sumsq8(acc[ai][bj][m][0], acc[ai][bj][m][1]); st16(kvl, row * 512u + (bj * 64u + cl) * 2u, pack8(acc[ai][bj][m][0], acc[ai][bj][m][1])); }
                        s += __shfl_xor(s, 16); s += __shfl_xor(s, 32);
                        if (fqx == 0 && !noatomic) atomicAdd(ssq + row, s);
                    } else {
                        if (wc == 2 && fqx < 2) {
                            f32x4 o1[2], o2[2];
#pragma unroll
                            for (int n = 0; n < 2; ++n) { const unsigned to = row * 128u + (unsigned)(16 * fqx + 8 * n) * 4u; const u32x4 wa = ld16u(tab, to), wb = ld16u(tab, to + 16u);
                                rope4(acc[ai][0][m][n], acc[ai][1][m][n], (u32x4){wa[0], wa[2], wb[0], wb[2]}, o1[n], o2[n]); }
                            st16(kpe, row * 64u + 16u * fqx, pack8(o1[0], o1[1])); st16(kpe, row * 64u + 32u + 16u * fqx, pack8(o2[0], o2[1]));
                        }
                        const u32x4 z = {0u, 0u, 0u, 0u};
                        st16(kvl, row * 512u + (128u + (cl - 64u)) * 2u, z); st16(kvl, row * 512u + (192u + (cl - 64u)) * 2u, z);
                    }
                    asm volatile("" ::: "memory"); }
        } else if (pn < 4 || (pn >= 8 && pn < 12)) {
            const bool act = (pn < 4) || (pn >= 10); const unsigned pitch = act ? 2048u : 1024u;
            unsigned char* dst = ws + (act ? WS_ZCAT : WS_VMB); const unsigned o0 = row0 * pitch + ((pn >= 10 ? 512u : 0u) + ((pn & 1) ? 256u : 0u) + cl) * 2u;
#pragma unroll
            for (int ai = 0; ai < 2; ++ai)
#pragma unroll
                for (int m = 0; m < 4; ++m) { const unsigned ro = o0 + (unsigned)(ai * 128 + m * 16) * pitch;
#pragma unroll
                    for (int bj = 0; bj < 2; ++bj) { f32x4 a = acc[ai][bj][m][0], b = acc[ai][bj][m][1]; if (act) { a = silu4(a); b = silu4(b); }
                        st16(dst, ro + bj * 256u, pack8(a, b)); } }
        } else if (pn < 6) { rope_tile<true>(acc, u, wr, wc, frx, fqx);
        } else if (pn < 8) { rope_tile<false>(acc, u, wr, wc, frx, fqx);
        } else {
            const bool isa = pn < 16; unsigned char* dst = ws + (isa ? WS_GA : WS_GB); const unsigned cg = 256u * ((pn - 12) & 3) + cl;
            const unsigned char* bm = (const unsigned char*)(b_merge + (isa ? 0 : 1024)); const unsigned o0 = row0 * 1024u + cg;
            f32x4 bv[2][2];
#pragma unroll
            for (int bj = 0; bj < 2; ++bj)
#pragma unroll
                for (int n = 0; n < 2; ++n) bv[bj][n] = ld16f(bm, (cg + bj * 128u + 4u * n) * 4u);
#pragma unroll
            for (int ai = 0; ai < 2; ++ai)
#pragma unroll
                for (int m = 0; m < 4; ++m) { const unsigned ro = o0 + (unsigned)(ai * 128 + m * 16) * 1024u;
#pragma unroll
                    for (int bj = 0; bj < 2; ++bj) { const f32x4 a = sigm4(acc[ai][bj][m][0] + bv[bj][0]) * 255.f + 0.5f, b = sigm4(acc[ai][bj][m][1] + bv[bj][1]) * 255.f + 0.5f;
                        u32x2 w; w.x = (unsigned)a[0] | ((unsigned)a[1] << 8) | ((unsigned)a[2] << 16) | ((unsigned)a[3] << 24); w.y = (unsigned)b[0] | ((unsigned)b[1] << 8) | ((unsigned)b[2] << 16) | ((unsigned)b[3] << 24);
                        *(u32x2*)(dst + (ro + bj * 128u)) = w; } }
        }
    }
};
struct EpiNull {
    static constexpr bool PERM = true, AFTER_DRAIN = false; static constexpr int MID_T = 0;
    __device__ __forceinline__ void operator()(const f32x4 (&acc)[2][2][4][2], const Unit& u, int wr, int wc, int fr, int fq) const {
#pragma unroll
        for (int ai = 0; ai < 2; ++ai)
#pragma unroll
            for (int bj = 0; bj < 2; ++bj)
#pragma unroll
                for (int m = 0; m < 4; ++m) asm volatile("" :: "v"(acc[ai][bj][m][0]), "v"(acc[ai][bj][m][1]));
    }
};
struct EpiUqF {
    static constexpr bool PERM = true, AFTER_DRAIN = false; static constexpr int MID_T = 0;
    unsigned char* ws;
    __device__ __forceinline__ void operator()(const f32x4 (&acc)[2][2][4][2], const Unit& u, int wr, int wc, int fr, int fq) const {
        PG8_OPAQUE(fr, fq);
        const int pn = u.pn; const unsigned row0 = (unsigned)(u.pm * 256 + wr * 64) + (unsigned)frx; unsigned char* Q = ws + WS_QMLA; const unsigned char* ssq = ws + WS_SSQ; const unsigned char* tab = ws + WS_TAB;
        float rsv[2][4];
#pragma unroll
        for (int ai = 0; ai < 2; ++ai)
#pragma unroll
            for (int m = 0; m < 4; ++m) rsv[ai][m] = ld4f(ssq, (row0 + ai * 128 + m * 16) * 4u);
#pragma unroll
        for (int ai = 0; ai < 2; ++ai)
#pragma unroll
            for (int m = 0; m < 4; ++m) { const unsigned row = row0 + ai * 128 + m * 16; const float rs = SC_MLA * __builtin_amdgcn_rsqf(rsv[ai][m] * (1.f / 256.f) + EPS);
                if (pn < 2) {
#pragma unroll
                    for (int bj = 0; bj < 2; ++bj) { const unsigned head = 4u * pn + 2u * bj + (wc >> 1), d = 32u * (wc & 1) + 8u * fqx;
                        st16(Q, row * 1536u + (96u * head + d) * 2u, pack8(acc[ai][bj][m][0] * rs, acc[ai][bj][m][1] * rs)); }
                } else { const unsigned head = 2u * wc + ((unsigned)fqx >> 1), i0 = 8u * (fqx & 1); f32x4 o1[2], o2[2];
#pragma unroll
                    for (int n = 0; n < 2; ++n) { const unsigned to = row * 128u + (2u * (i0 + 4u * n)) * 4u; const u32x4 wa = ld16u(tab, to), wb = ld16u(tab, to + 16u);
                        rope4(acc[ai][0][m][n] * rs, acc[ai][1][m][n] * rs, (u32x4){wa[0], wa[2], wb[0], wb[2]}, o1[n], o2[n]); }
                    st16(Q, row * 1536u + (96u * head + 64u + i0) * 2u, pack8(o1[0], o1[1])); st16(Q, row * 1536u + (96u * head + 80u + i0) * 2u, pack8(o2[0], o2[1])); } }
    }
};
struct EpiUkvF {
    static constexpr bool PERM = true, AFTER_DRAIN = false; static constexpr int MID_T = 0;
    unsigned char* ws;
    __device__ __forceinline__ void operator()(const f32x4 (&acc)[2][2][4][2], const Unit& u, int wr, int wc, int fr, int fq) const {
        PG8_OPAQUE(fr, fq);
        const int pn = u.pn; const unsigned row0 = (unsigned)(u.pm * 256 + wr * 64) + (unsigned)frx; unsigned char* dst = ws + (pn < 2 ? WS_KN : WS_VM); const unsigned char* ssq = ws + WS_SSQ + (size_t)M_ * 4;
        float rsv[2][4];
#pragma unroll
        for (int ai = 0; ai < 2; ++ai)
#pragma unroll
            for (int m = 0; m < 4; ++m) rsv[ai][m] = ld4f(ssq, (row0 + ai * 128 + m * 16) * 4u);
#pragma unroll
        for (int ai = 0; ai < 2; ++ai)
#pragma unroll
            for (int m = 0; m < 4; ++m) { const unsigned row = row0 + ai * 128 + m * 16; const float rs = __builtin_amdgcn_rsqf(rsv[ai][m] * (1.f / 128.f) + EPS);
#pragma unroll
                for (int bj = 0; bj < 2; ++bj) { const unsigned head = 4u * (pn & 1) + 2u * bj + (wc >> 1), d = 32u * (wc & 1) + 8u * fqx;
                    st16(dst, row * 1024u + (64u * head + d) * 2u, pack8(acc[ai][bj][m][0] * rs, acc[ai][bj][m][1] * rs)); } }
    }
};
struct EpiYcatF {
    static constexpr bool PERM = true, AFTER_DRAIN = false; static constexpr int MID_T = 8;
    unsigned char* ws;
    template <bool MID> __device__ __forceinline__ void run(f32x4 (&acc)[2][2][4][2], const Unit& u, int wr, int wc) const {
        PG8_OPAQUE(0, 0);
        const unsigned row0 = (unsigned)(u.pm * 256 + wr * 64) + (unsigned)frx, c0 = u.pn * 256u + 32u * wc + 8u * fqx, o0 = row0 * 2048u + c0 * 2u, g0 = row0 * 1024u + c0;
        const unsigned char* GA = ws + WS_GA; const unsigned char* GB = ws + WS_GB; unsigned char* YM = ws + WS_YM;
#pragma unroll
        for (int ai = 0; ai < 2; ++ai) {
            u32x2 ga[4][2], gb[4][2];
#pragma unroll
            for (int m = 0; m < 4; ++m)
#pragma unroll
                for (int bj = 0; bj < 2; ++bj) { const unsigned go = g0 + (unsigned)(ai * 128 + m * 16) * 1024u + bj * 128u; gb[m][bj] = *(const u32x2*)(GB + go); if (MID) ga[m][bj] = *(const u32x2*)(GA + go); }
#pragma unroll
            for (int m = 0; m < 4; ++m)
#pragma unroll
                for (int bj = 0; bj < 2; ++bj) { const unsigned off = o0 + (unsigned)(ai * 128 + m * 16) * 2048u + bj * 256u; f32x4 s0, s1;
#pragma unroll
                    for (int j = 0; j < 4; ++j) { const float b0 = fmaxf((float)((gb[m][bj].x >> (8 * j)) & 0xffu), 0.5f), b1 = fmaxf((float)((gb[m][bj].y >> (8 * j)) & 0xffu), 0.5f);
                        s0[j] = MID ? (float)((ga[m][bj].x >> (8 * j)) & 0xffu) * __builtin_amdgcn_rcpf(b0) : b0 * (1.f / 255.f);
                        s1[j] = MID ? (float)((ga[m][bj].y >> (8 * j)) & 0xffu) * __builtin_amdgcn_rcpf(b1) : b1 * (1.f / 255.f); }
                    acc[ai][bj][m][0] *= s0; acc[ai][bj][m][1] *= s1;
                    if (!MID) st16(YM, off, pack8(acc[ai][bj][m][0], acc[ai][bj][m][1])); }
            asm volatile("" ::: "memory"); }
    }
    __device__ __forceinline__ void mid(f32x4 (&acc)[2][2][4][2], const Unit& u, int wr, int wc) const { run<true>(acc, u, wr, wc); }
    __device__ __forceinline__ void operator()(f32x4 (&acc)[2][2][4][2], const Unit& u, int wr, int wc, int fr, int fq) const { run<false>(acc, u, wr, wc); }
};
struct EpiYF {
    static constexpr bool PERM = true, AFTER_DRAIN = false; static constexpr int MID_T = 0;
    unsigned char* ws;
    __device__ __forceinline__ void operator()(const f32x4 (&acc)[2][2][4][2], const Unit& u, int wr, int wc, int fr, int fq) const {
        PG8_OPAQUE(fr, fq);
        const unsigned row0 = (unsigned)(u.pm * 256 + wr * 64) + (unsigned)frx, c0 = u.pn * 256u + 32u * wc + 8u * fqx, o0 = row0 * 2048u + c0 * 2u; unsigned char* Y = ws + WS_Y; float* ssq = (float*)(ws + WS_SSQY);
#pragma unroll
        for (int ai = 0; ai < 2; ++ai)
#pragma unroll
            for (int m = 0; m < 4; ++m) { float s = 0.f;
#pragma unroll
                for (int bj = 0; bj < 2; ++bj) { s += sumsq8(acc[ai][bj][m][0], acc[ai][bj][m][1]); st16(Y, o0 + (unsigned)(ai * 128 + m * 16) * 2048u + bj * 256u, pack8(acc[ai][bj][m][0], acc[ai][bj][m][1])); }
                s += __shfl_xor(s, 16); s += __shfl_xor(s, 32);
                if (fqx == 0) atomicAdd(ssq + (row0 + ai * 128 + m * 16), s); }
    }
};
}

struct MapIn { __device__ int operator()(int n) const { const int t = n >> 8, tc = n & 255, bj = tc >> 7, uu = tc & 127;
    if (t == 0) return n;
    if (t == 1) return uu < 64 ? C_KVLAT + 64 * bj + uu : (uu < 80 ? C_KROPE + 16 * bj + (uu - 64) : -1);
    if (t < 4) return C_ZMLA + (n - 512);
    if (t < 8) return (t < 6 ? C_QMB : C_KMB) + 256 * (t & 1) + 64 * (uu >> 5) + 32 * bj + (uu & 31);
    if (t < 10) return C_VMB + (n - 2048);
    if (t < 12) return C_ZMB + (n - 2560);
    if (t < 16) return C_GA + (n - 3072);
    return C_GB + (n - 4096); } };
struct MapUq { __device__ int operator()(int n) const { const int t = n >> 8, tc = n & 255, bj = tc >> 7, uu = tc & 127;
    if (t < 2) return 96 * (4 * t + (tc >> 6)) + (tc & 63);
    return 96 * (uu >> 4) + 64 + 16 * bj + (uu & 15); } };
struct MapUkv { __device__ int operator()(int n) const { const int t = n >> 8, tc = n & 255; return 128 * (4 * (t & 1) + (tc >> 6)) + (t < 2 ? 0 : 64) + (tc & 63); } };
struct MapId { __device__ int operator()(int n) const { return n; } };
template <class Map> __device__ __forceinline__ void wt_items(const float* W, int ldw, int Kreal, int K, int N, unsigned short* WT, const float* kscale, Map map, LAS float* scr, int gw, int ngw, int lane, int ldk = 0, int koff = 0) {
    if (ldk == 0) ldk = K;
    const int nblk = N / 64, nitems = (K / 32) * nblk; typedef float f4 __attribute__((ext_vector_type(4)));
    for (int it = gw; it < nitems; it += ngw) {
        const int kb = it / nblk, nb = it % nblk, k0 = 32 * kb, n0 = 64 * nb; const int src = map(n0 + 4 * (lane & 15));
        f4 wv[8];
#pragma unroll
        for (int i = 0; i < 8; ++i) { const int k = k0 + 4 * i + (lane >> 4); wv[i] = (src >= 0 && k < Kreal) ? *(const f4*)(W + (size_t)k * ldw + src) : (f4){0.f, 0.f, 0.f, 0.f}; }
#pragma unroll
        for (int i = 0; i < 8; ++i) { const int kk = 4 * i + (lane >> 4), k = k0 + kk; f4 v = wv[i]; if (kscale && k < Kreal) v = v * kscale[k]; *(LAS f4*)(scr + kk * 68 + 4 * (lane & 15)) = v; }
        asm volatile("s_waitcnt lgkmcnt(0)" ::: "memory");
#pragma unroll
        for (int j = 0; j < 4; ++j) { const int q = lane + 64 * j, n = q >> 2, c = q & 3; const LAS float* s = scr + (8 * c) * 68 + n;
            pg8::u32x4 o; o.x = pg8::pk_h2(s[0 * 68], s[1 * 68]); o.y = pg8::pk_h2(s[2 * 68], s[3 * 68]); o.z = pg8::pk_h2(s[4 * 68], s[5 * 68]); o.w = pg8::pk_h2(s[6 * 68], s[7 * 68]);
            *(pg8::u32x4*)(WT + (size_t)(n0 + n) * ldk + koff + k0 + 8 * c) = o; }
        asm volatile("s_waitcnt lgkmcnt(0)" ::: "memory");
    }
}
constexpr size_t WT_IN = WS_WT, WT_UQ = WS_WT + 10 * MiB, WT_UKV = WT_UQ + 512 * 1024, WT_OA = WS_WT + 11 * MiB, WT_OB = WS_WT + 12 * MiB, WT_OUT = WS_WT + 13 * MiB;
__device__ __forceinline__ void ph_weights(const Params& p, LAS unsigned char* lds, int gw, int ngw, int wave, int lane) {
    LAS float* scr = (LAS float*)(lds + wave * 16384);
    wt_items(p.w_in, D_IN, 1024, 1024, 5120, (unsigned short*)(p.ws + WT_IN), nullptr, MapIn(), scr, gw, ngw, lane);
    wt_items(p.w_uq, 768, 256, 256, 768, (unsigned short*)(p.ws + WT_UQ), p.g_q, MapUq(), scr, gw, ngw, lane);
    wt_items(p.w_ukv, 1024, 128, 256, 1024, (unsigned short*)(p.ws + WT_UKV), p.g_kv, MapUkv(), scr, gw, ngw, lane);
    wt_items(p.w_o_mla, 1024, 512, 512, 1024, (unsigned short*)(p.ws + WT_OA), nullptr, MapId(), scr, gw, ngw, lane, 1024, 0);
    wt_items(p.w_o_moba, 1024, 512, 512, 1024, (unsigned short*)(p.ws + WT_OA), nullptr, MapId(), scr, gw, ngw, lane, 1024, 512);
    wt_items(p.w_out, 1024, 1024, 1024, 1024, (unsigned short*)(p.ws + WT_OUT), nullptr, MapId(), scr, gw, ngw, lane);
}

namespace att {
struct T1 { static constexpr bool value = true; }; struct T0 { static constexpr bool value = false; };
typedef _Float16 h8 __attribute__((ext_vector_type(8)));
typedef short s4 __attribute__((ext_vector_type(4)));
typedef short s8 __attribute__((ext_vector_type(8)));
typedef float f16v __attribute__((ext_vector_type(16)));
typedef unsigned u4 __attribute__((ext_vector_type(4)));
typedef short v4i16_t __attribute__((ext_vector_type(4)));
constexpr int KBUF = 16384, VBUF = 8192;
constexpr int NBUF = 4;
constexpr int L_K = 0, L_V = NBUF * KBUF, L_WS = L_V + NBUF * VBUF, L_TB = L_WS + 8 * 256, L_UN = L_TB + 256, L_END = L_UN + 64, L_OST = 0;
constexpr float THR = 8.f;
#ifndef PROBE_ABL
#define PROBE_ABL 0
#endif
#ifndef ATT_STAGGER
#define ATT_STAGGER 0
#endif
constexpr bool STAGGER = ATT_STAGGER;
__device__ __forceinline__ int crow(int r, int hi) { return (r & 3) + 8 * (r >> 2) + 4 * hi; }
template <int DK> __device__ __forceinline__ int kaddr(int row, int ch) { return DK == 64 ? row * 128 + ((ch ^ ((row >> 1) & 7)) << 4) : row * 256 + ((ch ^ (row & 15)) << 4); }
__device__ __forceinline__ s4 vtr(const LAS unsigned char* p) { return __builtin_bit_cast(s4, __builtin_amdgcn_ds_read_tr16_b64_v4i16((LAS v4i16_t*)p)); }
__device__ __forceinline__ float swapmax(float m) { auto rr = __builtin_amdgcn_permlane32_swap(__float_as_uint(m), __float_as_uint(m), false, false); return fmaxf(__uint_as_float(rr[0]), __uint_as_float(rr[1])); }
__device__ __forceinline__ float swapsum(float m) { auto rr = __builtin_amdgcn_permlane32_swap(__float_as_uint(m), __float_as_uint(m), false, false); return __uint_as_float(rr[0]) + __uint_as_float(rr[1]); }
__device__ __forceinline__ void glds16(const void* g, unsigned lds_base) { unsigned sv;
    asm volatile("s_mov_b32 %0, m0\n\ts_mov_b32 m0, %2\n\ts_nop 0\n\tglobal_load_lds_dwordx4 %1, off\n\ts_mov_b32 m0, %0" : "=&s"(sv) : "v"(g), "s"(lds_base) : "memory"); }
__device__ __forceinline__ float max3f(float a, float b, float c) { float r; asm("v_max3_f32 %0, %1, %2, %3" : "=v"(r) : "v"(a), "v"(b), "v"(c)); return r; }
__device__ __forceinline__ unsigned pkh(float lo, float hi) { typedef _Float16 h2 __attribute__((ext_vector_type(2))); h2 v; v[0] = (_Float16)lo; v[1] = (_Float16)hi; return __builtin_bit_cast(unsigned, v); }

template <int DK, bool MOBA, int ABL = 0>
__device__ __forceinline__ void attn_unit(unsigned char* ws, int b, int h, int qb, LAS unsigned char* lds, bool dry = false) {
    constexpr int ND = DK / 16, QP = MOBA ? 512 : 768, QH = MOBA ? 64 : 96;
    int tid_ = threadIdx.x; asm volatile("" : "+v"(tid_));
    const int tid = tid_, lane = tid & 63, r32 = lane & 31, hi = lane >> 5; const int wid = __builtin_amdgcn_readfirstlane(tid >> 6);
    const _Float16* Qg = (const _Float16*)(ws + (MOBA ? WS_QMB : WS_QMLA)); const _Float16* Kg = (const _Float16*)(ws + (MOBA ? WS_KMB : WS_KN));
    const _Float16* Vg = (const _Float16*)(ws + (MOBA ? WS_VMB : WS_VM)); const _Float16* Pg = (const _Float16*)(ws + WS_KPE); _Float16* Zg = (_Float16*)(ws + WS_ZCAT) + (MOBA ? 512 : 0);
    const size_t rowbase = (size_t)b * SEQ; const int q0 = qb * 256, qw0 = q0 + wid * 32, qrow = qw0 + r32;
    LAS float* wsf = (LAS float*)(lds + L_WS) + wid * 64; LAS int* tb = (LAS int*)(lds + L_TB); LAS unsigned* un = (LAS unsigned*)(lds + L_UN);
    h8 qr[ND];
#pragma unroll
    for (int d0 = 0; d0 < ND; ++d0) qr[d0] = *(const h8*)(Qg + (rowbase + qrow) * QP + h * QH + d0 * 16 + hi * 8);
#pragma unroll
    for (int d0 = 0; d0 < ND; ++d0) asm volatile("" : "+v"(qr[d0]));
    unsigned sel = 0u, blocks = (2u << qb) - 1u;
    if (MOBA) {
        const float* km = (const float*)(ws + WS_KMEAN) + (size_t)b * 16 * 512 + h * 64 + hi * 8;
        float g0 = -INFINITY, g1 = -INFINITY, g2 = -INFINITY; int i0 = -1, i1 = -1, i2 = -1;
        for (int m = 0; m < qb; ++m) {
            float part = 0.f;
#pragma unroll
            for (int d0 = 0; d0 < 4; ++d0) { const float4 a = *(const float4*)(km + m * 512 + d0 * 16), c = *(const float4*)(km + m * 512 + d0 * 16 + 4);
                part += (float)qr[d0][0] * a.x + (float)qr[d0][1] * a.y + (float)qr[d0][2] * a.z + (float)qr[d0][3] * a.w + (float)qr[d0][4] * c.x + (float)qr[d0][5] * c.y + (float)qr[d0][6] * c.z + (float)qr[d0][7] * c.w; }
            const float g = swapsum(part);
            if (g > g0) { g2 = g1; i2 = i1; g1 = g0; i1 = i0; g0 = g; i0 = m; }
            else if (g > g1) { g2 = g1; i2 = i1; g1 = g; i1 = m; }
            else if (g > g2) { g2 = g; i2 = m; }
        }
        if (i0 >= 0) sel |= 1u << i0; if (i1 >= 0) sel |= 1u << i1; if (i2 >= 0) sel |= 1u << i2;
        unsigned uw = sel;
#pragma unroll
        for (int o = 1; o < 64; o <<= 1) uw |= (unsigned)__shfl_xor((int)uw, o);
        if (lane == 0) un[wid] = uw;
        __syncthreads();
        unsigned ua = 0u;
#pragma unroll
        for (int w = 0; w < 8; ++w) ua |= un[w];
        blocks = (unsigned)__builtin_amdgcn_readfirstlane((int)(ua | (1u << qb)));
    }
    const int NT = 4 * __builtin_popcount(blocks);
    if (tid < 64 && tid < NT) { unsigned bm = blocks; for (int k = 0; k < (tid >> 2); ++k) bm &= bm - 1u; tb[tid] = (__builtin_ctz(bm) << 8) + ((tid & 3) << 6); }
    __syncthreads();
    const unsigned char* kbu = (const unsigned char*)(Kg + rowbase * 512 + h * 64); const unsigned char* vbu = (const unsigned char*)(Vg + rowbase * 512 + h * 64); const unsigned char* pbu = (const unsigned char*)(Pg + rowbase * 32);
    const unsigned char* kb0; const unsigned char* kb1 = nullptr; unsigned ksrc0, ksrc1 = 0u, kst0 = 1024u, kst1 = 1024u;
    if (DK == 96) { const int r0 = 4 * wid + (lane >> 4), r1 = r0 + 32; int c0 = (lane & 15) ^ (r0 & 15), c1 = (lane & 15) ^ (r1 & 15); if (c0 >= 12) c0 -= 4; if (c1 >= 12) c1 -= 4;
        const bool kpe0 = c0 >= 8, kpe1 = c1 >= 8;
        kb0 = kpe0 ? pbu : kbu; kst0 = kpe0 ? 64u : 1024u; ksrc0 = kpe0 ? (unsigned)(r0 * 32 + (c0 - 8) * 8) * 2u : (unsigned)(r0 * 512 + c0 * 8) * 2u;
        kb1 = kpe1 ? pbu : kbu; kst1 = kpe1 ? 64u : 1024u; ksrc1 = kpe1 ? (unsigned)(r1 * 32 + (c1 - 8) * 8) * 2u : (unsigned)(r1 * 512 + c1 * 8) * 2u;
    } else { const int r0 = 8 * wid + (lane >> 3), c0 = (lane & 7) ^ ((r0 >> 1) & 7); kb0 = kbu; ksrc0 = (unsigned)(r0 * 512 + c0 * 8) * 2u; }
    const unsigned vsrc = (unsigned)((16 * (wid & 3) + (lane >> 2)) * 512 + (wid >> 2) * 32 + (lane & 3) * 8) * 2u;
    constexpr int NDMA = (DK == 96) ? 3 : 2;
#define ATT_GLDS(src, dst) glds16((const void*)(src), (unsigned)__builtin_amdgcn_readfirstlane((int)(unsigned)(size_t)(dst)))
#define ATT_DMA(kb, buf) do { const unsigned kb_ = (unsigned)(kb); LAS unsigned char* kd_ = lds + L_K + (buf) * KBUF; \
        ATT_GLDS(kb0 + (ksrc0 + kb_ * kst0), kd_ + wid * 1024); \
        if (DK == 96) ATT_GLDS(kb1 + (ksrc1 + kb_ * kst1), kd_ + 8192 + wid * 1024); \
        ATT_GLDS(vbu + (vsrc + kb_ * 1024u), lds + L_V + (buf) * VBUF + wid * 1024); } while (0)
#define ATT_WAITV(n) asm volatile("s_waitcnt vmcnt(" #n ")" ::: "memory")
#define ATT_BAR() do { asm volatile("s_waitcnt lgkmcnt(0)" ::: "memory"); __builtin_amdgcn_s_barrier(); asm volatile("" ::: "memory"); } while (0)
    const int vro = ((lane >> 4) & 1) * 32 + (lane & 3) * 8 + (4 * hi + ((lane & 15) >> 2)) * 64;
    float l_reg = 0.f; bool init = false; f16v o[2]; o[0] = f16v{}; o[1] = f16v{}; f16v negm = f16v{}; asm volatile("" : "+v"(negm));
    constexpr int G = 2 * ND;
#define ATT_SBAR() __builtin_amdgcn_sched_barrier(0)
#define ATT_PIN(x) asm volatile("" : "+v"(x))
#define ATT_KF(buf, g) (*(const LAS h8*)(lds + L_K + (buf) * KBUF + kaddr<DK>(32 * ((g) & 1) + r32, 2 * ((g) >> 1) + hi)))
#define ATT_MF(a, b, c) __builtin_amdgcn_mfma_f32_32x32x16_f16(a, b, c, 0, 0, 0)
#define ATT_QK(P0, P1, buf) do { h8 kf_[G]; _Pragma("unroll") for (int g_ = 0; g_ < G; ++g_) kf_[g_] = ATT_KF(buf, g_); ATT_SBAR(); \
        _Pragma("unroll") for (int d_ = 0; d_ < ND; ++d_) { P0 = ATT_MF(kf_[2 * d_], qr[d_], d_ == 0 ? negm : P0); P1 = ATT_MF(kf_[2 * d_ + 1], qr[d_], d_ == 0 ? negm : P1); } } while (0)
#define ATT_MAXCHAIN(P0, P1, PM) do { float pa_ = max3f(P0[0], P0[1], P1[0]), pb_ = max3f(P0[2], P0[3], P1[1]); pa_ = max3f(pa_, P1[2], P1[3]); \
        _Pragma("unroll") for (int r_ = 4; r_ < 16; r_ += 4) { pa_ = max3f(pa_, P0[r_], P0[r_ + 1]); pb_ = max3f(pb_, P0[r_ + 2], P0[r_ + 3]); pa_ = max3f(pa_, P1[r_], P1[r_ + 1]); pb_ = max3f(pb_, P1[r_ + 2], P1[r_ + 3]); } \
        PM = swapmax(fmaxf(pa_, pb_)); } while (0)
#define ATT_MOVE(P0, P1, PM) do { const bool move_ = init ? ((PM) > THR) : ((PM) > -INFINITY); \
        if (__any(move_)) { const float dl_ = move_ ? (init ? fmaxf((PM), 0.f) : (PM)) : 0.f; const float al_ = (move_ && init) ? __builtin_amdgcn_exp2f(-dl_) : 1.f; \
            init = init || move_; l_reg *= al_; \
            _Pragma("unroll") for (int r_ = 0; r_ < 16; ++r_) { P0[r_] -= dl_; P1[r_] -= dl_; negm[r_] -= dl_; } \
            if (hi == 0) wsf[r32] = al_; asm volatile("s_waitcnt lgkmcnt(0)" ::: "memory"); \
            _Pragma("unroll") for (int r_ = 0; r_ < 16; ++r_) { const float a_ = wsf[crow(r_, hi)]; o[0][r_] *= a_; o[1][r_] *= a_; } } } while (0)
#define ATT_PACK(P0, P1, PW, KEEP) do { _Pragma("unroll") for (int k_ = 0; k_ < 2; ++k_) { \
            PW[k_] = (u4){pkh(P0[8 * k_], P0[8 * k_ + 1]), pkh(P0[8 * k_ + 2], P0[8 * k_ + 3]), pkh(P0[8 * k_ + 4], P0[8 * k_ + 5]), pkh(P0[8 * k_ + 6], P0[8 * k_ + 7])}; \
            PW[2 + k_] = (u4){pkh(P1[8 * k_], P1[8 * k_ + 1]), pkh(P1[8 * k_ + 2], P1[8 * k_ + 3]), pkh(P1[8 * k_ + 4], P1[8 * k_ + 5]), pkh(P1[8 * k_ + 6], P1[8 * k_ + 7])}; } \
        if (MOBA) { _Pragma("unroll") for (int k_ = 0; k_ < 4; ++k_) PW[k_] &= (KEEP); } } while (0)
#define ATT_VF(buf, i) (lds + L_V + (buf) * VBUF + vro + ((i) >> 2) * 4096 + ((i) & 3) * 1024)
#define ATT_WAIT_NEXT(t_) do { if ((t_) + 3 < NT) { if (NDMA == 3) ATT_WAITV(3); else ATT_WAITV(2); } else ATT_WAITV(0); } while (0)
#define ATT_TB(i) (MOBA ? tb[(i)] : 64 * (i))
    const int NF = NT - 4;
    ATT_DMA(ATT_TB(0), 0); ATT_DMA(ATT_TB(1), 1); ATT_DMA(ATT_TB(2), 2);
    if (NDMA == 3) ATT_WAITV(3); else ATT_WAITV(2);
    ATT_BAR();
    f16v pC0, pC1;
    if (NF > 0) { ATT_QK(pC0, pC1, 0); asm volatile("s_nop 15\n\ts_nop 7" : "+v"(pC0), "+v"(pC1)); float pm; ATT_MAXCHAIN(pC0, pC1, pm);
        if (MOBA && !((sel >> (ATT_TB(0) >> 8)) & 1u)) pm = -INFINITY; ATT_MOVE(pC0, pC1, pm); }
    auto step = [&](f16v& pC0, f16v& pC1, f16v& pN0, f16v& pN1, const int t, auto hn) __attribute__((always_inline)) {
        const int cur = t & 3, nx = (t + 1) & 3; constexpr bool hasn = decltype(hn)::value;
        ATT_DMA(ATT_TB(t + 3), (t + 3) & 3);
        const unsigned keepC = (!MOBA || ((sel >> (ATT_TB(t) >> 8)) & 1u)) ? 0xffffffffu : 0u;
        float ps = 0.f;
        if (hasn) {
            h8 kf[G];
#pragma unroll
            for (int g = 0; g < 4; ++g) kf[g] = ATT_KF(nx, g);
            ATT_SBAR();
#pragma unroll
            for (int g = 0; g < G; ++g) {
                if (g + 4 < G) kf[g + 4] = ATT_KF(nx, g + 4);
                if (g & 1) pN1 = ATT_MF(kf[g], qr[g >> 1], g == 1 ? negm : pN1); else pN0 = ATT_MF(kf[g], qr[g >> 1], g == 0 ? negm : pN0);
                constexpr int dummy = 0; (void)dummy;
                const int e0 = (ND == 4) ? 4 * g : (g < 8 ? 3 * g : 24 + 2 * (g - 8)), e1 = (ND == 4) ? 4 * g + 4 : (g < 8 ? 3 * g + 3 : 26 + 2 * (g - 8));
#pragma unroll
                for (int e = e0; e < e1; ++e) { if (e < 16) { pC0[e] = __builtin_amdgcn_exp2f(pC0[e]); ps += pC0[e]; } else { pC1[e - 16] = __builtin_amdgcn_exp2f(pC1[e - 16]); ps += pC1[e - 16]; } }
                ATT_PIN(pC0); ATT_PIN(pC1); ATT_PIN(ps); ATT_SBAR();
            }
        } else {
#pragma unroll
            for (int r = 0; r < 16; ++r) { pC0[r] = __builtin_amdgcn_exp2f(pC0[r]); pC1[r] = __builtin_amdgcn_exp2f(pC1[r]); ps += pC0[r] + pC1[r]; }
        }
        if (MOBA && !keepC) ps = 0.f;
        l_reg += swapsum(ps);
        u4 pw[4]; ATT_PACK(pC0, pC1, pw, keepC);
        {
            s4 vlo[8], vhi[8]; float pa = 0.f, pb = 0.f;
#pragma unroll
            for (int i = 0; i < 3; ++i) { vlo[i] = vtr(ATT_VF(cur, i)); vhi[i] = vtr(ATT_VF(cur, i) + 512); }
            if (hasn) asm volatile("s_nop 7" : "+v"(pN0), "+v"(pN1));
            ATT_SBAR();
#pragma unroll
            for (int i = 0; i < 8; ++i) {
                if (i + 3 < 8) { vlo[i + 3] = vtr(ATT_VF(cur, i + 3)); vhi[i + 3] = vtr(ATT_VF(cur, i + 3) + 512); }
                const s8 vv = (s8){vlo[i][0], vlo[i][1], vlo[i][2], vlo[i][3], vhi[i][0], vhi[i][1], vhi[i][2], vhi[i][3]};
                o[i >> 2] = ATT_MF(__builtin_bit_cast(h8, pw[i & 3]), __builtin_bit_cast(h8, vv), o[i >> 2]);
                if (hasn) {
                    if (i == 0) { pa = max3f(pN0[0], pN0[1], pN1[0]); pb = max3f(pN0[2], pN0[3], pN1[1]); }
                    else if (i == 1) { pa = max3f(pa, pN1[2], pN1[3]); pb = max3f(pb, pN0[6], pN0[7]); }
                    else if (i == 2) { pa = max3f(pa, pN0[4], pN0[5]); pb = max3f(pb, pN1[6], pN1[7]); }
                    else if (i == 3) { pa = max3f(pa, pN1[4], pN1[5]); pb = max3f(pb, pN0[10], pN0[11]); }
                    else if (i == 4) { pa = max3f(pa, pN0[8], pN0[9]); pb = max3f(pb, pN1[10], pN1[11]); }
                    else if (i == 5) { pa = max3f(pa, pN1[8], pN1[9]); pb = max3f(pb, pN0[14], pN0[15]); }
                    else if (i == 6) { pa = max3f(pa, pN0[12], pN0[13]); pb = max3f(pb, pN1[14], pN1[15]); }
                    else { pa = max3f(pa, pN1[12], pN1[13]); }
                    ATT_PIN(pa); ATT_PIN(pb);
                }
                ATT_SBAR();
            }
            if (hasn) { float pm = swapmax(fmaxf(pa, pb)); if (MOBA && !((sel >> (ATT_TB(t + 1) >> 8)) & 1u)) pm = -INFINITY; ATT_MOVE(pN0, pN1, pm); }
        }
        if (NDMA == 3) ATT_WAITV(3); else ATT_WAITV(2);
        ATT_BAR();
    };
    {
        f16v pD0, pD1; int t = 0;
        for (; t + 2 < NF; t += 2) { step(pC0, pC1, pD0, pD1, t, T1{}); step(pD0, pD1, pC0, pC1, t + 1, T1{}); }
        if (t + 1 < NF) { step(pC0, pC1, pD0, pD1, t, T1{}); step(pD0, pD1, pC0, pC1, t + 1, T0{}); }
        else if (t < NF) step(pC0, pC1, pD0, pD1, t, T0{});
    }
    for (int t = NF; t < NT; ++t) {
        const int cur = t & 3, kb = ATT_TB(t);
        if (t + 3 < NT) ATT_DMA(ATT_TB(t + 3), (t + 3) & 3);
        if (kb <= qw0 + 31) {
            f16v p0, p1; ATT_QK(p0, p1, cur);
            if (kb + 63 > qw0) {
#pragma unroll
                for (int r = 0; r < 16; ++r) { const int kv = kb + crow(r, hi); if (kv > qrow) p0[r] = -INFINITY; if (kv + 32 > qrow) p1[r] = -INFINITY; }
            }
            asm volatile("s_nop 15\n\ts_nop 7" : "+v"(p0), "+v"(p1));
            float pm; ATT_MAXCHAIN(p0, p1, pm); ATT_MOVE(p0, p1, pm);
            s4 vlo[8], vhi[8];
#pragma unroll
            for (int i = 0; i < 8; ++i) { vlo[i] = vtr(ATT_VF(cur, i)); vhi[i] = vtr(ATT_VF(cur, i) + 512); }
            ATT_SBAR();
            float ps = 0.f;
#pragma unroll
            for (int r = 0; r < 16; ++r) { p0[r] = __builtin_amdgcn_exp2f(p0[r]); p1[r] = __builtin_amdgcn_exp2f(p1[r]); ps += p0[r] + p1[r]; }
            l_reg += swapsum(ps);
            u4 pw[4]; ATT_PACK(p0, p1, pw, 0xffffffffu);
#pragma unroll
            for (int i = 0; i < 8; ++i) { const s8 vv = (s8){vlo[i][0], vlo[i][1], vlo[i][2], vlo[i][3], vhi[i][0], vhi[i][1], vhi[i][2], vhi[i][3]};
                o[i >> 2] = ATT_MF(__builtin_bit_cast(h8, pw[i & 3]), __builtin_bit_cast(h8, vv), o[i >> 2]); }
        }
        ATT_WAIT_NEXT(t);
        ATT_BAR();
    }
    if (hi == 0) wsf[32 + r32] = l_reg; asm volatile("s_waitcnt lgkmcnt(0)" ::: "memory");
    LAS _Float16* stg = (LAS _Float16*)(lds + L_OST) + wid * 2048;
#pragma unroll
    for (int r = 0; r < 16; ++r) { const int orow = crow(r, hi); const float rl = 1.f / wsf[32 + orow];
        stg[orow * 64 + r32] = (_Float16)(o[0][r] * rl); stg[orow * 64 + 32 + r32] = (_Float16)(o[1][r] * rl); }
    asm volatile("s_waitcnt lgkmcnt(0)" ::: "memory");
    int lane_e = lane; asm volatile("" : "+v"(lane_e));
    unsigned char* zbu = (unsigned char*)(Zg + (rowbase + qw0) * 1024 + h * 64);
#pragma unroll
    for (int i = 0; i < 4; ++i) { const int row = i * 8 + (lane_e >> 3), ch = lane_e & 7; const h8 v = *(const LAS h8*)(stg + row * 64 + ch * 8);
        _Float16* zp = (_Float16*)(zbu + (unsigned)(row * 1024 + ch * 8) * 2u); const h8 z = *(const h8*)zp; h8 ov;
#pragma unroll
        for (int j = 0; j < 8; ++j) ov[j] = (_Float16)((float)v[j] * (float)z[j]);
        if (!dry) *(h8*)zp = ov; }
    __syncthreads();
#undef ATT_GLDS
#undef ATT_DMA
#undef ATT_WAITV
#undef ATT_BAR
#undef ATT_SBAR
#undef ATT_PIN
#undef ATT_KF
#undef ATT_MF
#undef ATT_QK
#undef ATT_MAXCHAIN
#undef ATT_MOVE
#undef ATT_PACK
#undef ATT_VF
#undef ATT_WAIT_NEXT
#undef ATT_TB
}

__device__ __forceinline__ void attn_phase(unsigned char* ws, LAS unsigned char* lds, int vb, int nvb) {
    const int vcu = (nvb % 8 == 0) ? (vb % 8) * (nvb / 8) + vb / 8 : vb; const int per = (1024 + nvb - 1) / nvb;
    for (int k = 0; k < per; ++k) {
        int it;
        if (nvb == 256) { const int xg = vcu >> 5, lw = vcu & 31; it = ((16 * xg + 4 * k + (lw >> 3)) << 3) | (lw & 7); }
        else { it = vcu * per + k; if (it >= 1024) break; }
        const int bh = it >> 3, pr = it & 7, b = bh >> 3, h = bh & 7;
        if (PROBE == 2) for (int uu = 0; uu < 2; ++uu) attn_unit<96, false, PROBE_ABL>(ws, b, h, uu ? 15 - pr : pr, lds, true);
        for (int uu = 0; uu < 2; ++uu) attn_unit<96, false>(ws, b, h, uu ? 15 - pr : pr, lds);
        if (PROBE == 3) for (int uu = 0; uu < 2; ++uu) attn_unit<64, true, PROBE_ABL>(ws, b, h, uu ? 15 - pr : pr, lds, true);
        for (int uu = 0; uu < 2; ++uu) attn_unit<64, true>(ws, b, h, uu ? 15 - pr : pr, lds);
    }
}
}

constexpr int RING_BYTES = 131072, MISC_OFF = RING_BYTES + 320, LDS_BYTES = 147456;
constexpr int CW_BAR = 4096;

__global__ void __launch_bounds__(512, 2) mega(Params p) {
    extern __shared__ __attribute__((aligned(16))) unsigned char lds[];
    const int vb = blockIdx.x, nvb = gridDim.x, tid = threadIdx.x, lane = tid & 63, wave = tid >> 6;
    const int gtid = vb * 512 + tid, gsize = nvb * 512, gwave = vb * 8 + wave, nwaves = nvb * 8;
    volatile LAS unsigned* misc = (volatile LAS unsigned*)((LAS unsigned char*)lds + MISC_OFF);
    if (tid < 32) misc[tid] = 0u;
    __syncthreads();
    XcdBarrier bar = xcd_barrier_post((unsigned*)(p.ws + WS_CTL) + CW_BAR, misc + 8);
    LAS unsigned char* ldsl = (LAS unsigned char*)lds;
    { int t_ = threadIdx.x; asm volatile("" : "+v"(t_)); ph_prep(p, vb * 512 + t_, gsize); ph_weights(p, ldsl, vb * 8 + (t_ >> 6), nwaves, t_ >> 6, t_ & 63);
      if (PROBE == 10) ph_weights(p, ldsl, vb * 8 + (t_ >> 6), nwaves, t_ >> 6, t_ & 63);
      if (PROBE == 11) ph_tab(p, vb * 512 + t_, gsize); }
    xcd_barrier(bar);
    for (int rep4 = 0; rep4 < ((PROBE == 4 || PROBE == 6) ? 2 : 1); ++rep4) { int t_ = threadIdx.x; asm volatile("" : "+v"(t_)); ph_hnorm(p, vb * 8 + (t_ >> 6), nwaves, t_ & 63); }
    xcd_barrier(bar);
    {
        pg8::Gemm g{(const pg8::bf16_t*)(p.ws + WS_H), (const pg8::bf16_t*)(p.ws + WT_IN), M_, 5120, 1024}; pg8::StaticOrder S; S.init(M_, 5120, nvb, vb);
        for (int rep = (PROBE == 1 ? 1 : 0); rep >= 0; --rep) { pg8::EpiInF E{p.ws, p.b_merge, rep}; pg8::gemm_phase<pg8::EpiInF, pg8::StaticOrder, true, true>(ldsl, g, S, E); }
        if (PROBE == 5) { pg8::EpiNull E; pg8::gemm_phase<pg8::EpiNull, pg8::StaticOrder, true, true>(ldsl, g, S, E); }
    }
    xcd_barrier(bar);
    for (int rep4 = 0; rep4 < ((PROBE == 4 || PROBE == 7) ? 2 : 1); ++rep4) {
        pg8::Gemm g{(const pg8::bf16_t*)(p.ws + WS_QLAT), (const pg8::bf16_t*)(p.ws + WT_UQ), M_, 768, 256}; pg8::StaticOrder S; S.init(M_, 768, nvb, vb);
        pg8::EpiUqF E{p.ws}; pg8::gemm_phase<pg8::EpiUqF, pg8::StaticOrder, true, true>(ldsl, g, S, E);
    }
    for (int rep4 = 0; rep4 < ((PROBE == 4 || PROBE == 7) ? 2 : 1); ++rep4) {
        pg8::Gemm g{(const pg8::bf16_t*)(p.ws + WS_KVL), (const pg8::bf16_t*)(p.ws + WT_UKV), M_, 1024, 256}; pg8::StaticOrder S; S.init(M_, 1024, nvb, vb);
        pg8::EpiUkvF E{p.ws}; pg8::gemm_phase<pg8::EpiUkvF, pg8::StaticOrder, true, true>(ldsl, g, S, E);
    }
    xcd_barrier(bar);
    att::attn_phase(p.ws, ldsl, vb, nvb);
    xcd_barrier(bar);
    {
        pg8::Gemm g{(const pg8::bf16_t*)(p.ws + WS_ZCAT), (const pg8::bf16_t*)(p.ws + WT_OA), M_, 1024, 1024}; pg8::StaticOrder S; S.init(M_, 1024, nvb, vb);
        pg8::EpiYcatF E{p.ws}; pg8::gemm_phase<pg8::EpiYcatF, pg8::StaticOrder, true, true>(ldsl, g, S, E);
    }
    xcd_barrier(bar);
    for (int rep4 = 0; rep4 < ((PROBE == 4 || PROBE == 9) ? 2 : 1); ++rep4) {
        pg8::Gemm g{(const pg8::bf16_t*)(p.ws + WS_YM), (const pg8::bf16_t*)(p.ws + WT_OUT), M_, 1024, 1024}; pg8::StaticOrder S; S.init(M_, 1024, nvb, vb);
        pg8::EpiYF E{p.ws}; pg8::gemm_phase<pg8::EpiYF, pg8::StaticOrder, true, true>(ldsl, g, S, E);
    }
    xcd_barrier(bar);
    for (int rep4 = 0; rep4 < ((PROBE == 4 || PROBE == 9) ? 2 : 1); ++rep4) { int t_ = threadIdx.x; asm volatile("" : "+v"(t_)); ph_final(p, vb * 8 + (t_ >> 6), nwaves, t_ & 63); }
}

extern "C" void kernel_launch(void* const* d_in, const int* in_sizes, int n_in, void* d_out, int out_size, void* d_ws, size_t ws_size, hipStream_t stream) {
    if (n_in != 16 || out_size != M_ * DM || ws_size < WS_END) { fprintf(stderr, "kernel_launch: unexpected shapes (n_in %d, out %d, ws %zu)\n", n_in, out_size, ws_size); return; }
    Params p{};
    p.x = (const float*)d_in[0]; p.c = (const float*)d_in[1]; p.pos = (const int*)d_in[2]; p.w_ada = (const float*)d_in[3]; p.b_ada = (const float*)d_in[4];
    p.g_pre = (const float*)d_in[5]; p.g_post = (const float*)d_in[6]; p.w_in = (const float*)d_in[7]; p.g_q = (const float*)d_in[8]; p.w_uq = (const float*)d_in[9];
    p.g_kv = (const float*)d_in[10]; p.w_ukv = (const float*)d_in[11]; p.w_o_mla = (const float*)d_in[12]; p.w_o_moba = (const float*)d_in[13]; p.b_merge = (const float*)d_in[14]; p.w_out = (const float*)d_in[15];
    p.out = (float*)d_out; p.ws = (unsigned char*)d_ws;
    static int grid = 0;
    if (grid == 0) {
        int dev = 0, cus = 0, per_cu = 0;
        if (hipGetDevice(&dev) != hipSuccess || hipDeviceGetAttribute(&cus, hipDeviceAttributeMultiprocessorCount, dev) != hipSuccess) { fprintf(stderr, "kernel_launch: device query failed\n"); grid = -1; return; }
        if (hipFuncSetAttribute((const void*)mega, hipFuncAttributeMaxDynamicSharedMemorySize, LDS_BYTES) != hipSuccess) { fprintf(stderr, "kernel_launch: hipFuncSetAttribute failed\n"); grid = -1; return; }
        if (hipOccupancyMaxActiveBlocksPerMultiprocessor(&per_cu, (const void*)mega, 512, LDS_BYTES) != hipSuccess || per_cu < 1) { fprintf(stderr, "kernel_launch: occupancy query says %d\n", per_cu); }
        (void)hipGetLastError();
        grid = cus;
    }
    if (grid < 0) return;
    (void)hipMemsetAsync(d_ws, 0, ZERO_BYTES, stream);
    hipLaunchKernelGGL(mega, dim3(grid), dim3(512), LDS_BYTES, stream, p);
}
```

```cpp
#include <hip/hip_runtime.h>
#include <cstdio>
#ifndef PROBE
#define PROBE 0
#endif
#include <cstdint>

typedef _Float16 h16;
typedef _Float16 h16x4 __attribute__((ext_vector_type(4)));
typedef _Float16 h2n __attribute__((ext_vector_type(2)));

constexpr int NB = 16, SEQ = 4096, DM = 1024, M_ = NB * SEQ, NH = 8;
constexpr int D_IN = 5024;
constexpr int C_QLAT = 0, C_KVLAT = 256, C_KROPE = 384, C_ZMLA = 416, C_QMB = 928, C_KMB = 1440, C_VMB = 1952, C_ZMB = 2464, C_GA = 2976, C_GB = 4000;
constexpr float EPS = 1e-6f;
constexpr float LOG2E = 1.4426950408889634f;
constexpr float SC_MLA = 0.10206207261596577f * LOG2E;
constexpr float SC_MB = 0.125f * LOG2E;

constexpr size_t MiB = 1u << 20;
constexpr size_t WS_CTL = 0, WS_KMEAN = 512 * 1024, WS_SSQ = 1 * MiB, WS_SSQY = WS_SSQ + 2 * (size_t)M_ * 4, ZERO_BYTES = 2 * MiB;
constexpr size_t WS_MOD = WS_SSQ + 3 * (size_t)M_ * 4, WS_TAB = 4 * MiB, WS_WT = 20 * MiB;
constexpr size_t WS_H = 36 * MiB, WS_KN = 36 * MiB, WS_VM = 100 * MiB;
constexpr size_t WS_QLAT = 164 * MiB, WS_KVL = 196 * MiB, WS_KPE = 228 * MiB, WS_VMB = 232 * MiB;
constexpr size_t WS_QMB = 296 * MiB, WS_KMB = 360 * MiB, WS_ZCAT = 424 * MiB, WS_YM = 296 * MiB;
constexpr size_t WS_GA = 552 * MiB, WS_GB = 616 * MiB, WS_Y = 680 * MiB,     WS_QMLA = 808 * MiB, WS_END = 904 * MiB;

static_assert(WS_MOD + (size_t)NB * 3072 * 4 <= ZERO_BYTES, "MOD inside the zeroed region");
struct Params {
    const float *x, *c; const int* pos; const float *w_ada, *b_ada, *g_pre, *g_post, *w_in, *g_q, *w_uq, *g_kv, *w_ukv, *w_o_mla, *w_o_moba, *b_merge, *w_out;
    float* out; unsigned char* ws;
};

__device__ __forceinline__ float wave_sum(float v) {
#pragma unroll
    for (int o = 1; o < 64; o <<= 1) v += __shfl_xor(v, o);
    return v;
}
__device__ __forceinline__ float silu_f(float v) { return v / (1.f + __expf(-v)); }
__device__ __forceinline__ float sigmoid_f(float v) { return 1.f / (1.f + __expf(-v)); }

__device__ void ph_tab(const Params& p, int gtid, int gsize);
__device__ void ph_prep(const Params& p, int gtid, int gsize) {
    float* mod = (float*)(p.ws + WS_MOD);
    { const int gw = gtid >> 6, ngw = gsize >> 6, ln = gtid & 63;
      for (int it = gw; it < 48 * 32; it += ngw) {
          const int cg = it % 48, kc = it / 48, j = cg * 64 + ln, k0 = kc * 32; float acc[NB];
#pragma unroll
          for (int b = 0; b < NB; ++b) acc[b] = (kc == 0) ? p.b_ada[j] : 0.f;
          for (int kk = 0; kk < 32; ++kk) { const float w = p.w_ada[(size_t)(k0 + kk) * 3072 + j];
#pragma unroll
              for (int b = 0; b < NB; ++b) { const float cv = p.c[b * DM + k0 + kk]; acc[b] = fmaf(cv / (1.f + __expf(-cv)), w, acc[b]); } }
#pragma unroll
          for (int b = 0; b < NB; ++b) atomicAdd(mod + b * 3072 + j, acc[b]);
      } }
    ph_tab(p, gtid, gsize);
}
__device__ void ph_tab(const Params& p, int gtid, int gsize) {
    unsigned* tab = (unsigned*)(p.ws + WS_TAB);
    const int f = gtid & 31;
    const double c = exp2(-(double)f * (13.287712379549449 / 32.0)) * 0.15915494309189535;
    int ex; const double mant = frexp(c, &ex); const double c_hi_d = ldexp(rint(ldexp(mant, 11)), ex - 11);
    const float c_hi = (float)c_hi_d, c_lo = (float)(c - c_hi_d);
    for (int i = gtid; i < M_ * 32; i += gsize) {
        const float pos = (float)p.pos[i >> 5];
        float x = pos * c_hi; x = x - floorf(x); x = fmaf(pos, c_lo, x);
        typedef _Float16 h2t __attribute__((ext_vector_type(2))); h2t cs; cs[0] = (_Float16)__builtin_amdgcn_cosf(x); cs[1] = (_Float16)__builtin_amdgcn_sinf(x);
        tab[i] = __builtin_bit_cast(unsigned, cs);
    }
}

__device__ void ph_hnorm(const Params& p, int gwave, int nwaves, int lane) {
    constexpr int R = 4;
    typedef float f4 __attribute__((ext_vector_type(4)));
    const float* mod = (const float*)(p.ws + WS_MOD); h16* H = (h16*)(p.ws + WS_H);
    for (int m0 = R * gwave; m0 < M_; m0 += R * nwaves) {
        f4 v[R][4]; float ss[R];
#pragma unroll
        for (int r = 0; r < R; ++r) { const f4* xr = (const f4*)(p.x + (size_t)(m0 + r) * DM);
#pragma unroll
            for (int j = 0; j < 4; ++j) v[r][j] = __builtin_nontemporal_load(xr + lane + 64 * j); }
#pragma unroll
        for (int r = 0; r < R; ++r) { float s = 0.f;
#pragma unroll
            for (int j = 0; j < 4; ++j) s += (v[r][j][0] * v[r][j][0] + v[r][j][1] * v[r][j][1]) + (v[r][j][2] * v[r][j][2] + v[r][j][3] * v[r][j][3]);
            ss[r] = 1.f / sqrtf(wave_sum(s) * (1.f / DM) + EPS); }
        const int b = m0 >> 12;
#pragma unroll
        for (int j = 0; j < 4; ++j) {
            const int col = 4 * (lane + 64 * j);
            const float4 g = *(const float4*)(p.g_pre + col), sc = *(const float4*)(mod + b * 3072 + 1024 + col), sh = *(const float4*)(mod + b * 3072 + col);
            const float g0 = g.x * (1.f + sc.x), g1 = g.y * (1.f + sc.y), g2 = g.z * (1.f + sc.z), g3 = g.w * (1.f + sc.w);
#pragma unroll
            for (int r = 0; r < R; ++r) { const float rstd = ss[r]; const f4 x = v[r][j];
                h16x4 o; o[0] = (h16)(x[0] * rstd * g0 + sh.x); o[1] = (h16)(x[1] * rstd * g1 + sh.y); o[2] = (h16)(x[2] * rstd * g2 + sh.z); o[3] = (h16)(x[3] * rstd * g3 + sh.w);
                *(h16x4*)(H + (size_t)(m0 + r) * DM + col) = o; }
        }
    }
}

__device__ void ph_final(const Params& p, int gwave, int nwaves, int lane) {
    constexpr int R = 4; typedef float f4 __attribute__((ext_vector_type(4)));
    const float* mod = (const float*)(p.ws + WS_MOD); const h16* Y = (const h16*)(p.ws + WS_Y); const float* ssq = (const float*)(p.ws + WS_SSQY);
    for (int m0 = R * gwave; m0 < M_; m0 += R * nwaves) {
        const int b = m0 >> 12; h16x4 yv[R][4]; f4 xv[R][4]; float rs[R];
#pragma unroll
        for (int r = 0; r < R; ++r) { const h16x4* yr = (const h16x4*)(Y + (size_t)(m0 + r) * DM); const f4* xr = (const f4*)(p.x + (size_t)(m0 + r) * DM); rs[r] = ssq[m0 + r];
#pragma unroll
            for (int j = 0; j < 4; ++j) { yv[r][j] = yr[lane + 64 * j]; xv[r][j] = __builtin_nontemporal_load(xr + lane + 64 * j); } }
#pragma unroll
        for (int r = 0; r < R; ++r) rs[r] = 1.f / sqrtf(rs[r] * (1.f / DM) + EPS);
#pragma unroll
        for (int j = 0; j < 4; ++j) {
            const int col = 4 * (lane + 64 * j); const float4 g = *(const float4*)(p.g_post + col), gt = *(const float4*)(mod + b * 3072 + 2048 + col);
            const float g0 = g.x * gt.x, g1 = g.y * gt.y, g2 = g.z * gt.z, g3 = g.w * gt.w;
#pragma unroll
            for (int r = 0; r < R; ++r) { const h16x4 y = yv[r][j]; const f4 x = xv[r][j]; const float s = rs[r];
                f4 o; o[0] = x[0] + g0 * (float)y[0] * s; o[1] = x[1] + g1 * (float)y[1] * s; o[2] = x[2] + g2 * (float)y[2] * s; o[3] = x[3] + g3 * (float)y[3] * s;
                __builtin_nontemporal_store(o, (f4*)(p.out + (size_t)(m0 + r) * DM) + lane + 64 * j); }
        }
    }
}


#define XB_TMO      128
#define XB_XCNT(j)  (256  + 64 * (j))
#define XB_XSUB(j)  (1280 + 64 * (j))
#define XB_XGEN(j)  (2304 + 64 * (j))
#define XB_TOP      3328
#define XB_TOPGEN   3392
#define XCD_BAR_WORDS 3456
#define XB_SPIN_CAP (1u << 27)
#define LAS __attribute__((address_space(3)))
__device__ __forceinline__ unsigned xb_ld(unsigned* p)              { return __hip_atomic_load(p, __ATOMIC_RELAXED, __HIP_MEMORY_SCOPE_AGENT); }
__device__ __forceinline__ unsigned xb_add(unsigned* p, unsigned v) { return __hip_atomic_fetch_add(p, v, __ATOMIC_RELAXED, __HIP_MEMORY_SCOPE_AGENT); }
__device__ __forceinline__ unsigned xb_xcc_id() { return (unsigned)__builtin_amdgcn_s_getreg((3 << 11) | 20) & 0xFu; }
#define XB_SPIN(cond, bar) do { unsigned _sp = 0; while (cond) { __builtin_amdgcn_s_sleep(1); \
    if ((++_sp & 255u) == 0u) { if (xb_ld(&(bar)[XB_TMO])) break; if (_sp > XB_SPIN_CAP) { atomicAdd(&(bar)[XB_TMO], 1u); break; } } } } while (0)
struct XcdBarrier { unsigned* bar; unsigned x; volatile LAS unsigned* st; };
__device__ __forceinline__ XcdBarrier xcd_barrier_post(unsigned* bar, volatile LAS unsigned* st) {
    XcdBarrier b; b.bar = bar; b.x = xb_xcc_id(); b.st = st;
    if (threadIdx.x == 0) (void)xb_add(&bar[XB_XCNT(b.x)], 1u);
    return b;
}
__device__ __forceinline__ void xcd_barrier_complete(unsigned* bar, unsigned x, unsigned& nloc, unsigned& nx) {
    const unsigned G = gridDim.x * gridDim.y * gridDim.z;
    unsigned sum, cnt, mine, sp = 0u;
    for (;;) {
        sum = 0u; cnt = 0u; mine = 0u;
#pragma unroll
        for (unsigned j = 0; j < 16; ++j) { const unsigned c = xb_ld(&bar[XB_XCNT(j)]); sum += c; cnt += (c > 0u) ? 1u : 0u; mine = (j == x) ? c : mine; }
        if (sum == G) break;
        __builtin_amdgcn_s_sleep(1);
        if ((++sp & 255u) == 0u) { if (xb_ld(&bar[XB_TMO])) break; if (sp > XB_SPIN_CAP) { atomicAdd(&bar[XB_TMO], 1u); break; } }
    }
    nloc = mine > 0u ? mine : 1u; nx = cnt > 0u ? cnt : 1u;
}
__device__ __forceinline__ void xcd_barrier(const XcdBarrier& b) {
    asm volatile("s_waitcnt vmcnt(0)" ::: "memory");
    __syncthreads();
    if (threadIdx.x == 0) {
        unsigned* bar = b.bar;
        __builtin_amdgcn_s_waitcnt(0);
        unsigned nloc = b.st[0], nx = b.st[1];
        if (nloc == 0u) { xcd_barrier_complete(bar, b.x, nloc, nx); b.st[0] = nloc; b.st[1] = nx; }
        const unsigned old = xb_add(&bar[XB_XSUB(b.x)], 1u);
        const unsigned gen = old / nloc;
        if (old + 1u == (gen + 1u) * nloc) {
            __builtin_amdgcn_fence(__ATOMIC_RELEASE, "agent");
            asm volatile("s_waitcnt vmcnt(0)" ::: "memory");
            const unsigned og = xb_add(&bar[XB_TOP], 1u);
            const unsigned tg = og / nx;
            if (og + 1u == (tg + 1u) * nx) xb_add(&bar[XB_TOPGEN], 1u);
            else XB_SPIN(xb_ld(&bar[XB_TOPGEN]) == tg, bar);
            __builtin_amdgcn_fence(__ATOMIC_ACQUIRE, "agent");
            xb_add(&bar[XB_XGEN(b.x)], 1u);
            asm volatile("s_waitcnt vmcnt(0)" ::: "memory");
        } else {
            XB_SPIN(xb_ld(&bar[XB_XGEN(b.x)]) == gen, bar);
            __builtin_amdgcn_fence(__ATOMIC_ACQUIRE, "agent");
            asm volatile("s_waitcnt vmcnt(0)" ::: "memory");
        }
    }
    __syncthreads();
}

namespace pg8 {
#define PG8_LAS __attribute__((address_space(3)))
typedef unsigned short bf16_t;
typedef _Float16 bf16x8 __attribute__((ext_vector_type(8)));
typedef float f32x4 __attribute__((ext_vector_type(4)));
typedef unsigned u32x4 __attribute__((ext_vector_type(4)));
constexpr int BM = 256, BK = 64, HALF = 128, HTB = HALF * BK * 2  , STAGE_BYTES = 8 * HTB, NXCD = 8, WGM = 8;

__host__ __device__ __forceinline__ int lds_byte(int r, int c) { const int st = (r >> 4) * 2 + (c >> 5), rr = r & 15, cc = c & 31, ob = rr * 64 + cc * 2; return st * 1024 + (ob ^ (((ob >> 9) & 1) << 5)); }
__host__ __device__ __forceinline__ void stage_rc(int b, int& R, int& C) { const int st = b / 1024, sb = b % 1024, swz = sb ^ (((sb >> 9) & 1) << 5); R = (st >> 1) * 16 + swz / 64; C = (st & 1) * 32 + (swz % 64) / 2; }
__host__ __device__ __forceinline__ int perm32(int rho) { const int n = rho >> 4, i = rho & 15; return 8 * (i >> 2) + 4 * n + (i & 3); }

struct Unit { int pm, pn; };
struct Gemm { const bf16_t* A; const bf16_t* Bt; int M, N, K; };

struct StaticOrder {
    int nM, nN, nwg, G, c;
    __host__ __device__ void init(int M, int N, int G_, int c_) { nM = M / BM; nN = N / BM; nwg = nM * nN; G = G_; c = c_; }
    __host__ __device__ bool next(int i, Unit& u) const {
        const long L = (long)i * G + c; if (L >= nwg) return false;
        int wgid = (int)L; { const int q = nwg / NXCD, r = nwg % NXCD, xcd = wgid % NXCD, off = wgid / NXCD; wgid = (xcd < r ? xcd * (q + 1) : r * (q + 1) + (xcd - r) * q) + off; }
        const int nig = WGM * nN, gid = wgid / nig, fm = gid * WGM, gsz = (nM - fm) < WGM ? (nM - fm) : WGM;
        u.pm = fm + ((wgid % nig) % gsz); u.pn = (wgid % nig) / gsz; return true;
    }
    __device__ __forceinline__ void a_ready(const Unit&) const {}
    __device__ __forceinline__ void done(const Unit&) const {}
};

template <class Epi, class Sched, bool ALIGN_EPI = false, bool SP2 = false>
__device__ __forceinline__ void gemm_phase(PG8_LAS unsigned char* lds, const Gemm g, const Sched& S, const Epi& E) {
    int tid_ = threadIdx.x; asm volatile("" : "+v"(tid_));
    const int tid = tid_, wid = __builtin_amdgcn_readfirstlane(tid >> 6), lane = tid & 63, wr = wid >> 2, wc = wid & 3, fr = lane & 15, fq = lane >> 4;
    const int K = g.K, nt = K / BK;
    unsigned voffA[2], voffB[2];
#pragma unroll
    for (int i = 0; i < 2; ++i) { int R, C; stage_rc(tid * 16 + i * 8192, R, C); const int Rb = Epi::PERM ? ((R & ~31) + perm32(R & 31)) : R;
        voffA[i] = (unsigned)(R * K + C) * 2u; voffB[i] = (unsigned)(Rb * K + C) * 2u; }
    const size_t kstep = (size_t)(BK * 2);
    const size_t hstep = (size_t)HALF * K * 2;
    const size_t tstep = 2 * hstep;
    const unsigned ldsw = (unsigned)wid * 1024u;
    const int aoff = lds_byte(wr * 64 + fr, fq * 8), boff = lds_byte(wc * 32 + fr, fq * 8);
#define PG8_SA(b, h) (((b) * 2 + (h)) * HTB)
#define PG8_SB(b, h) ((4 + (b) * 2 + (h)) * HTB)
#define PG8_STAGE(bufoff, gbase, voff) do { _Pragma("unroll") for (int _i = 0; _i < 2; ++_i) \
        __builtin_amdgcn_global_load_lds((const unsigned*)((const char*)(gbase) + (voff)[_i]), (PG8_LAS unsigned*)(lds + (bufoff) + ldsw + _i * 8192), 16, 0, 0); } while (0)
#define PG8_LDA(dst, b, h) do { _Pragma("unroll") for (int m = 0; m < 4; ++m) _Pragma("unroll") for (int k = 0; k < 2; ++k) dst[m][k] = *(const PG8_LAS bf16x8*)(lds + PG8_SA(b, h) + aoff + m * 2048 + k * 1024); } while (0)
#define PG8_LDB(dst, b, h) do { _Pragma("unroll") for (int n = 0; n < 2; ++n) _Pragma("unroll") for (int k = 0; k < 2; ++k) dst[n][k] = *(const PG8_LAS bf16x8*)(lds + PG8_SB(b, h) + boff + n * 2048 + k * 1024); } while (0)
#define PG8_MMA(ai, bj, At, Bt) do { __builtin_amdgcn_s_setprio(1); _Pragma("unroll") for (int m = 0; m < 4; ++m) _Pragma("unroll") for (int n = 0; n < 2; ++n) _Pragma("unroll") for (int k = 0; k < 2; ++k) \
        acc[ai][bj][m][n] = __builtin_amdgcn_mfma_f32_16x16x32_f16(Bt[n][k], At[m][k], acc[ai][bj][m][n], 0, 0, 0); __builtin_amdgcn_s_setprio(0); } while (0)
#define PG8_WAIT_V(n) asm volatile("s_waitcnt vmcnt(" #n ")" ::: "memory")
#define PG8_WAIT_L(n) asm volatile("s_waitcnt lgkmcnt(" #n ")" ::: "memory")
#define PG8_BAR __builtin_amdgcn_s_barrier()
#define PG8_SCHED __builtin_amdgcn_sched_barrier(0)
    Unit cur, nxt; int ui = 0;
    if (!S.next(0, cur)) return;
    f32x4 acc[2][2][4][2];
#pragma unroll
    for (int a = 0; a < 2; ++a)
#pragma unroll
        for (int b = 0; b < 2; ++b)
#pragma unroll
            for (int m = 0; m < 4; ++m)
#pragma unroll
                for (int n = 0; n < 2; ++n) acc[a][b][m][n] = (f32x4){0.f, 0.f, 0.f, 0.f};
    bf16x8 At[4][2], B0[2][2], B1[2][2];
    const char* cA = (const char*)g.A + (size_t)cur.pm * tstep; const char* cB = (const char*)g.Bt + (size_t)cur.pn * tstep;
    S.a_ready(cur);
    if constexpr (SP2) {
        PG8_STAGE(PG8_SB(0, 0), cB, voffB); PG8_STAGE(PG8_SB(0, 1), cB + hstep, voffB); PG8_STAGE(PG8_SA(0, 0), cA, voffA); PG8_STAGE(PG8_SA(0, 1), cA + hstep, voffA);
        if (wr == 1) PG8_BAR;
        PG8_WAIT_V(2); PG8_BAR;
        PG8_STAGE(PG8_SB(1, 0), cB + kstep, voffB); PG8_STAGE(PG8_SA(1, 0), cA + kstep, voffA); PG8_STAGE(PG8_SB(1, 1), cB + hstep + kstep, voffB);
        PG8_WAIT_V(6); PG8_BAR;
    } else {
        PG8_STAGE(PG8_SB(0, 0), cB, voffB); PG8_STAGE(PG8_SA(0, 0), cA, voffA); PG8_STAGE(PG8_SB(0, 1), cB + hstep, voffB); PG8_STAGE(PG8_SA(0, 1), cA + hstep, voffA);
        if (wr == 1) PG8_BAR;
        PG8_WAIT_V(4); PG8_BAR;
        PG8_STAGE(PG8_SB(1, 0), cB + kstep, voffB); PG8_STAGE(PG8_SA(1, 0), cA + kstep, voffA); PG8_STAGE(PG8_SB(1, 1), cB + hstep + kstep, voffB);
        PG8_WAIT_V(6); PG8_BAR;
    }
    for (;;) {
        const bool has_next = S.next(ui + 1, nxt);
        const char* nA = has_next ? (const char*)g.A + (size_t)nxt.pm * tstep : cA; const char* nB = has_next ? (const char*)g.Bt + (size_t)nxt.pn * tstep : cB;
#pragma nounroll
        for (int t = 0; t < nt; t += 2) {
            const bool last = (t == nt - 2);
            if constexpr (Epi::MID_T > 0) { if (t == Epi::MID_T) E.mid(acc, cur, wr, wc); }
            const char* a1 = cA + (size_t)(t + 1) * kstep;
            const char* a2 = last ? nA : cA + (size_t)(t + 2) * kstep; const char* b2 = last ? nB : cB + (size_t)(t + 2) * kstep;
            const char* a3 = a2 + kstep; const char* b3 = b2 + kstep;
            if (last && has_next) S.a_ready(nxt);
            if constexpr (SP2) {
            PG8_LDB(B0, 0, 0); PG8_LDB(B1, 0, 1); PG8_SCHED; PG8_LDA(At, 0, 0); PG8_STAGE(PG8_SA(1, 1), a1 + hstep, voffA);
            PG8_WAIT_V(8); PG8_WAIT_L(0); PG8_BAR; PG8_MMA(0, 0, At, B0); PG8_MMA(0, 1, At, B1); PG8_BAR; PG8_SCHED;
            PG8_LDA(At, 0, 1); PG8_STAGE(PG8_SB(0, 0), b2, voffB); PG8_STAGE(PG8_SB(0, 1), b2 + hstep, voffB); PG8_STAGE(PG8_SA(0, 0), a2, voffA);
            PG8_WAIT_V(8); PG8_WAIT_L(0); PG8_BAR; PG8_MMA(1, 0, At, B0); PG8_MMA(1, 1, At, B1); PG8_BAR; PG8_SCHED;
            PG8_LDB(B0, 1, 0); PG8_LDB(B1, 1, 1); PG8_SCHED; PG8_LDA(At, 1, 0); PG8_STAGE(PG8_SA(0, 1), a2 + hstep, voffA);
            PG8_WAIT_V(8); PG8_WAIT_L(0); PG8_BAR; PG8_MMA(0, 0, At, B0); PG8_MMA(0, 1, At, B1); PG8_BAR; PG8_SCHED;
            PG8_LDA(At, 1, 1); PG8_STAGE(PG8_SB(1, 0), b3, voffB); PG8_STAGE(PG8_SB(1, 1), b3 + hstep, voffB); PG8_STAGE(PG8_SA(1, 0), a3, voffA);
            PG8_WAIT_V(8); PG8_WAIT_L(0); PG8_BAR; PG8_MMA(1, 0, At, B0); PG8_MMA(1, 1, At, B1); PG8_BAR; PG8_SCHED;
            } else {
            PG8_LDB(B0, 0, 0); PG8_SCHED; PG8_LDA(At, 0, 0); PG8_STAGE(PG8_SA(1, 1), a1 + hstep, voffA);
            PG8_WAIT_L(8); PG8_BAR; PG8_WAIT_L(0); PG8_MMA(0, 0, At, B0); PG8_BAR; PG8_SCHED;
            PG8_LDB(B1, 0, 1); PG8_STAGE(PG8_SB(0, 0), b2, voffB);
            PG8_BAR; PG8_WAIT_L(0); PG8_MMA(0, 1, At, B1); PG8_BAR;
            PG8_LDA(At, 0, 1); PG8_STAGE(PG8_SA(0, 0), a2, voffA);
            PG8_BAR; PG8_WAIT_L(0); PG8_MMA(1, 0, At, B0); PG8_BAR; PG8_SCHED;
            PG8_STAGE(PG8_SB(0, 1), b2 + hstep, voffB);
            PG8_WAIT_V(6); PG8_BAR; PG8_MMA(1, 1, At, B1); PG8_BAR;
            PG8_LDB(B0, 1, 0); PG8_SCHED; PG8_LDA(At, 1, 0); PG8_STAGE(PG8_SA(0, 1), a2 + hstep, voffA);
            PG8_WAIT_L(8); PG8_BAR; PG8_WAIT_L(0); PG8_MMA(0, 0, At, B0); PG8_BAR; PG8_SCHED;
            PG8_LDB(B1, 1, 1); PG8_STAGE(PG8_SB(1, 0), b3, voffB);
            PG8_BAR; PG8_WAIT_L(0); PG8_MMA(0, 1, At, B1); PG8_BAR;
            PG8_LDA(At, 1, 1); PG8_STAGE(PG8_SA(1, 0), a3, voffA);
            PG8_BAR; PG8_WAIT_L(0); PG8_MMA(1, 0, At, B0); PG8_BAR; PG8_SCHED;
            PG8_STAGE(PG8_SB(1, 1), b3 + hstep, voffB);
            PG8_WAIT_V(6); PG8_BAR; PG8_MMA(1, 1, At, B1); PG8_BAR;
            }
        }
        if constexpr (ALIGN_EPI) { if (wr == 0) PG8_BAR; }
        if constexpr (!Epi::AFTER_DRAIN) { E(acc, cur, wr, wc, fr, fq); S.done(cur); }
        if (!has_next) break;
#pragma unroll
        for (int a = 0; a < 2; ++a)
#pragma unroll
            for (int b = 0; b < 2; ++b)
#pragma unroll
                for (int m = 0; m < 4; ++m)
#pragma unroll
                    for (int n = 0; n < 2; ++n) acc[a][b][m][n] = (f32x4){0.f, 0.f, 0.f, 0.f};
        cur = nxt; cA = nA; cB = nB; ++ui;
        if constexpr (ALIGN_EPI) { if (wr == 1) PG8_BAR; }
    }
    PG8_WAIT_V(0);
    if constexpr (!ALIGN_EPI) { if (wr == 0) PG8_BAR; }
    PG8_BAR;
    if constexpr (Epi::AFTER_DRAIN) { E.fused(acc, cur, wr, wc, fr, fq, lds, wid, lane); S.done(cur); }
#undef PG8_SA
#undef PG8_SB
#undef PG8_STAGE
#undef PG8_LDA
#undef PG8_LDB
#undef PG8_MMA
#undef PG8_WAIT_V
#undef PG8_WAIT_L
#undef PG8_BAR
#undef PG8_SCHED
}
typedef _Float16 h8v __attribute__((ext_vector_type(8)));
typedef unsigned u32x2 __attribute__((ext_vector_type(2)));
typedef _Float16 h2v __attribute__((ext_vector_type(2)));
__device__ __forceinline__ unsigned pk_h2(float lo, float hi) { h2v v; v[0] = (_Float16)lo; v[1] = (_Float16)hi; return __builtin_bit_cast(unsigned, v); }
__device__ __forceinline__ u32x4 pack8(const f32x4& a, const f32x4& b) { u32x4 w; w.x = pk_h2(a[0], a[1]); w.y = pk_h2(a[2], a[3]); w.z = pk_h2(b[0], b[1]); w.w = pk_h2(b[2], b[3]); return w; }
__device__ __forceinline__ float sigm1(float v) { return __builtin_amdgcn_rcpf(1.f + __builtin_amdgcn_exp2f(v * -1.4426950408889634f)); }
__device__ __forceinline__ float silu1(float v) { return v * sigm1(v); }
__device__ __forceinline__ f32x4 silu4(const f32x4& v) { return (f32x4){silu1(v[0]), silu1(v[1]), silu1(v[2]), silu1(v[3])}; }
__device__ __forceinline__ f32x4 sigm4(const f32x4& v) { return (f32x4){sigm1(v[0]), sigm1(v[1]), sigm1(v[2]), sigm1(v[3])}; }

#define PG8_OPAQUE(fr_, fq_) int lane_x; asm volatile("v_mbcnt_lo_u32_b32 %0, -1, 0\n\tv_mbcnt_hi_u32_b32 %0, -1, %0" : "=v"(lane_x)); const int frx = lane_x & 15, fqx = lane_x >> 4
__device__ __forceinline__ void st16(unsigned char* base, unsigned off, const u32x4& v) { *(u32x4*)(base + off) = v; }
__device__ __forceinline__ f32x4 ld16f(const unsigned char* base, unsigned off) { return *(const f32x4*)(base + off); }
__device__ __forceinline__ float ld4f(const unsigned char* base, unsigned off) { return *(const float*)(base + off); }
__device__ __forceinline__ h8v ld16h(const unsigned char* base, unsigned off) { return *(const h8v*)(base + off); }
__device__ __forceinline__ float sumsq8(const f32x4& a, const f32x4& b) { return (a[0] * a[0] + a[1] * a[1]) + (a[2] * a[2] + a[3] * a[3]) + (b[0] * b[0] + b[1] * b[1]) + (b[2] * b[2] + b[3] * b[3]); }
__device__ __forceinline__ void rope4(const f32x4& t1, const f32x4& t2, const u32x4& cs, f32x4& o1, f32x4& o2) {
#pragma unroll
    for (int j = 0; j < 4; ++j) { const unsigned wj = cs[j]; h2v w; __builtin_memcpy(&w, &wj, 4);
        const float c = (float)w[0], s = (float)w[1]; o1[j] = t1[j] * c - t2[j] * s; o2[j] = t2[j] * c + t1[j] * s; }
}
__device__ __forceinline__ u32x4 ld16u(const unsigned char* base, unsigned off) { return *(const u32x4*)(base + off); }

struct EpiInF {
    static constexpr bool PERM = true, AFTER_DRAIN = false; static constexpr int MID_T = 0;
    unsigned char* ws; const float* b_merge; int noatomic;
    template <bool ISQ> __device__ __forceinline__ void rope_tile(const f32x4 (&acc)[2][2][4][2], const Unit& u, int wr, int wc, int frx, int fqx) const {
        const int pn = u.pn; const unsigned row0 = (unsigned)(u.pm * 256 + wr * 64) + (unsigned)frx; const float sc = ISQ ? SC_MB : 1.f;
        unsigned char* dst = ws + (ISQ ? WS_QMB : WS_KMB); const unsigned char* tab = ws + WS_TAB;
        const unsigned o0 = row0 * 1024u + (((pn & 1) ? 256u : 0u) + 64u * wc + 8u * fqx) * 2u, t0 = row0 * 128u + 32u * fqx;
        f32x4 c1[2] = {{0.f, 0.f, 0.f, 0.f}, {0.f, 0.f, 0.f, 0.f}}, c2[2] = {{0.f, 0.f, 0.f, 0.f}, {0.f, 0.f, 0.f, 0.f}};
        u32x4 cs[2][4][2];
#pragma unroll
        for (int ai = 0; ai < 2; ++ai)
#pragma unroll
            for (int m = 0; m < 4; ++m) { const unsigned to = t0 + (unsigned)(ai * 128 + m * 16) * 128u; cs[ai][m][0] = ld16u(tab, to); cs[ai][m][1] = ld16u(tab, to + 16u); }
#pragma unroll
        for (int ai = 0; ai < 2; ++ai)
#pragma unroll
            for (int m = 0; m < 4; ++m) { const unsigned ro = o0 + (unsigned)(ai * 128 + m * 16) * 1024u;
                f32x4 o1[2], o2[2];
#pragma unroll
                for (int n = 0; n < 2; ++n) { rope4(acc[ai][0][m][n], acc[ai][1][m][n], cs[ai][m][n], o1[n], o2[n]);
                    if (!ISQ) { c1[n] += o1[n]; c2[n] += o2[n]; } }
                st16(dst, ro, pack8(o1[0] * sc, o1[1] * sc)); st16(dst, ro + 64u, pack8(o2[0] * sc, o2[1] * sc));
                if (!ISQ) asm volatile("" : "+v"(c1[0]), "+v"(c1[1]), "+v"(c2[0]), "+v"(c2[1])); }
        if (!ISQ) {
            float* km = (float*)(ws + WS_KMEAN) + (size_t)u.pm * 512 + ((pn & 1) ? 256 : 0) + 64 * wc + 8 * fqx;
#pragma unroll
            for (int n = 0; n < 2; ++n)
#pragma unroll
                for (int j = 0; j < 4; ++j) { float a = c1[n][j], b = c2[n][j];
#pragma unroll
                    for (int o = 1; o < 16; o <<= 1) { a += __shfl_xor(a, o); b += __shfl_xor(b, o); }
                    if (frx == 0 && !noatomic) { atomicAdd(km + 4 * n + j, a * (1.f / 256.f)); atomicAdd(km + 32 + 4 * n + j, b * (1.f / 256.f)); } }
        }
    }
    __device__ __forceinline__ void operator()(const f32x4 (&acc)[2][2][4][2], const Unit& u, int wr, int wc, int fr, int fq) const {
        PG8_OPAQUE(fr, fq);
        const int pn = u.pn; const unsigned row0 = (unsigned)(u.pm * 256 + wr * 64) + (unsigned)frx, cl = 32u * wc + 8u * fqx;
        if (pn == 0) {
            unsigned char* dst = ws + WS_QLAT; float* ssq = (float*)(ws + WS_SSQ); const unsigned o0 = row0 * 512u + cl * 2u;
#pragma unroll
            for (int ai = 0; ai < 2; ++ai)
#pragma unroll
                for (int m = 0; m < 4; ++m) { const unsigned ro = o0 + (unsigned)(ai * 128 + m * 16) * 512u; float s = 0.f;
#pragma unroll
                    for (int bj = 0; bj < 2; ++bj) { s += sumsq8(acc[ai][bj][m][0], acc[ai][bj][m][1]); st16(dst, ro + bj * 256u, pack8(acc[ai][bj][m][0], acc[ai][bj][m][1])); }
                    s += __shfl_xor(s, 16); s += __shfl_xor(s, 32);
                    if (fqx == 0 && !noatomic) atomicAdd(ssq + (row0 + ai * 128 + m * 16), s); }
        } else if (pn == 1) {
            unsigned char* kvl = ws + WS_KVL; unsigned char* kpe = ws + WS_KPE; float* ssq = (float*)(ws + WS_SSQ) + M_; const unsigned char* tab = ws + WS_TAB;
#pragma unroll
            for (int ai = 0; ai < 2; ++ai)
#pragma unroll
                for (int m = 0; m < 4; ++m) { const unsigned row = row0 + ai * 128 + m * 16;
                    if (wc < 2) { float s = 0.f;
#pragma unroll
                        for (int bj = 0; bj < 2; ++bj) { s += sumsq8(acc[ai][bj][m][0], acc[ai][bj][m][1]); st16(kvl, row * 256u + (bj * 64u + cl) * 2u, pack8(acc[ai][bj][m][0], acc[ai][bj][m][1])); }
                        s += __shfl_xor(s, 16); s += __shfl_xor(s, 32);
                        if (fqx == 0 && !noatomic) atomicAdd(ssq + row, s);
                    } else {
                        if (wc == 2 && fqx < 2) {
                            f32x4 o1[2], o2[2];
#pragma unroll
                            for (int n = 0; n < 2; ++n) { const unsigned to = row * 128u + (unsigned)(16 * fqx + 8 * n) * 4u; const u32x4 wa = ld16u(tab, to), wb = ld16u(tab, to + 16u);
                                rope4(acc[ai][0][m][n], acc[ai][1][m][n], (u32x4){wa[0], wa[2], wb[0], wb[2]}, o1[n], o2[n]); }
                            st16(kpe, row * 64u + 16u * fqx, pack8(o1[0], o1[1])); st16(kpe, row * 64u + 32u + 16u * fqx, pack8(o2[0], o2[1]));
                        }
                    }
                    asm volatile("" ::: "memory"); }
        } else if (pn < 4 || (pn >= 8 && pn < 12)) {
            const bool act = (pn < 4) || (pn >= 10); const unsigned pitch = act ? 2048u : 1024u;
            unsigned char* dst = ws + (act ? WS_ZCAT : WS_VMB); const unsigned o0 = row0 * pitch + ((pn >= 10 ? 512u : 0u) + ((pn & 1) ? 256u : 0u) + cl) * 2u;
#pragma unroll
            for (int ai = 0; ai < 2; ++ai)
#pragma unroll
                for (int m = 0; m < 4; ++m) { const unsigned ro = o0 + (unsigned)(ai * 128 + m * 16) * pitch;
#pragma unroll
                    for (int bj = 0; bj < 2; ++bj) { f32x4 a = acc[ai][bj][m][0], b = acc[ai][bj][m][1]; if (act) { a = silu4(a); b = silu4(b); }
                        st16(dst, ro + bj * 256u, pack8(a, b)); } }
        } else if (pn < 6) { rope_tile<true>(acc, u, wr, wc, frx, fqx);
        } else if (pn < 8) { rope_tile<false>(acc, u, wr, wc, frx, fqx);
        } else {
            const bool isa = pn < 16; unsigned char* dst = ws + (isa ? WS_GA : WS_GB); const unsigned cg = 256u * ((pn - 12) & 3) + cl;
            const unsigned char* bm = (const unsigned char*)(b_merge + (isa ? 0 : 1024)); const unsigned o0 = row0 * 1024u + cg;
            f32x4 bv[2][2];
#pragma unroll
            for (int bj = 0; bj < 2; ++bj)
#pragma unroll
                for (int n = 0; n < 2; ++n) bv[bj][n] = ld16f(bm, (cg + bj * 128u + 4u * n) * 4u);
#pragma unroll
            for (int ai = 0; ai < 2; ++ai)
#pragma unroll
                for (int m = 0; m < 4; ++m) { const unsigned ro = o0 + (unsigned)(ai * 128 + m * 16) * 1024u;
#pragma unroll
                    for (int bj = 0; bj < 2; ++bj) { const f32x4 a = sigm4(acc[ai][bj][m][0] + bv[bj][0]) * 255.f + 0.5f, b = sigm4(acc[ai][bj][m][1] + bv[bj][1]) * 255.f + 0.5f;
                        u32x2 w; w.x = (unsigned)a[0] | ((unsigned)a[1] << 8) | ((unsigned)a[2] << 16) | ((unsigned)a[3] << 24); w.y = (unsigned)b[0] | ((unsigned)b[1] << 8) | ((unsigned)b[2] << 16) | ((unsigned)b[3] << 24);
                        *(u32x2*)(dst + (ro + bj * 128u)) = w; } }
        }
    }
};
struct EpiNull {
    static constexpr bool PERM = true, AFTER_DRAIN = false; static constexpr int MID_T = 0;
    __device__ __forceinline__ void operator()(const f32x4 (&acc)[2][2][4][2], const Unit& u, int wr, int wc, int fr, int fq) const {
#pragma unroll
        for (int ai = 0; ai < 2; ++ai)
#pragma unroll
            for (int bj = 0; bj < 2; ++bj)
#pragma unroll
                for (int m = 0; m < 4; ++m) asm volatile("" :: "v"(acc[ai][bj][m][0]), "v"(acc[ai][bj][m][1]));
    }
};
struct EpiUqF {
    static constexpr bool PERM = true, AFTER_DRAIN = false; static constexpr int MID_T = 0;
    unsigned char* ws;
    __device__ __forceinline__ void operator()(const f32x4 (&acc)[2][2][4][2], const Unit& u, int wr, int wc, int fr, int fq) const {
        PG8_OPAQUE(fr, fq);
        const int pn = u.pn; const unsigned row0 = (unsigned)(u.pm * 256 + wr * 64) + (unsigned)frx; unsigned char* Q = ws + WS_QMLA; const unsigned char* ssq = ws + WS_SSQ; const unsigned char* tab = ws + WS_TAB;
        float rsv[2][4];
#pragma unroll
        for (int ai = 0; ai < 2; ++ai)
#pragma unroll
            for (int m = 0; m < 4; ++m) rsv[ai][m] = ld4f(ssq, (row0 + ai * 128 + m * 16) * 4u);
#pragma unroll
        for (int ai = 0; ai < 2; ++ai)
#pragma unroll
            for (int m = 0; m < 4; ++m) { const unsigned row = row0 + ai * 128 + m * 16; const float rs = SC_MLA * __builtin_amdgcn_rsqf(rsv[ai][m] * (1.f / 256.f) + EPS);
                if (pn < 2) {
#pragma unroll
                    for (int bj = 0; bj < 2; ++bj) { const unsigned head = 4u * pn + 2u * bj + (wc >> 1), d = 32u * (wc & 1) + 8u * fqx;
                        st16(Q, row * 1536u + (96u * head + d) * 2u, pack8(acc[ai][bj][m][0] * rs, acc[ai][bj][m][1] * rs)); }
                } else { const unsigned head = 2u * wc + ((unsigned)fqx >> 1), i0 = 8u * (fqx & 1); f32x4 o1[2], o2[2];
#pragma unroll
                    for (int n = 0; n < 2; ++n) { const unsigned to = row * 128u + (2u * (i0 + 4u * n)) * 4u; const u32x4 wa = ld16u(tab, to), wb = ld16u(tab, to + 16u);
                        rope4(acc[ai][0][m][n] * rs, acc[ai][1][m][n] * rs, (u32x4){wa[0], wa[2], wb[0], wb[2]}, o1[n], o2[n]); }
                    st16(Q, row * 1536u + (96u * head + 64u + i0) * 2u, pack8(o1[0], o1[1])); st16(Q, row * 1536u + (96u * head + 80u + i0) * 2u, pack8(o2[0], o2[1])); } }
    }
};
struct EpiUkvF {
    static constexpr bool PERM = true, AFTER_DRAIN = false; static constexpr int MID_T = 0;
    unsigned char* ws;
    __device__ __forceinline__ void operator()(const f32x4 (&acc)[2][2][4][2], const Unit& u, int wr, int wc, int fr, int fq) const {
        PG8_OPAQUE(fr, fq);
        const int pn = u.pn; const unsigned row0 = (unsigned)(u.pm * 256 + wr * 64) + (unsigned)frx; unsigned char* dst = ws + (pn < 2 ? WS_KN : WS_VM); const unsigned char* ssq = ws + WS_SSQ + (size_t)M_ * 4;
        float rsv[2][4];
#pragma unroll
        for (int ai = 0; ai < 2; ++ai)
#pragma unroll
            for (int m = 0; m < 4; ++m) rsv[ai][m] = ld4f(ssq, (row0 + ai * 128 + m * 16) * 4u);
#pragma unroll
        for (int ai = 0; ai < 2; ++ai)
#pragma unroll
            for (int m = 0; m < 4; ++m) { const unsigned row = row0 + ai * 128 + m * 16; const float rs = __builtin_amdgcn_rsqf(rsv[ai][m] * (1.f / 128.f) + EPS);
#pragma unroll
                for (int bj = 0; bj < 2; ++bj) { const unsigned head = 4u * (pn & 1) + 2u * bj + (wc >> 1), d = 32u * (wc & 1) + 8u * fqx;
                    st16(dst, row * 1024u + (64u * head + d) * 2u, pack8(acc[ai][bj][m][0] * rs, acc[ai][bj][m][1] * rs)); } }
    }
};
struct EpiYcatF {
    static constexpr bool PERM = true, AFTER_DRAIN = false; static constexpr int MID_T = 8;
    unsigned char* ws;
    template <bool MID> __device__ __forceinline__ void run(f32x4 (&acc)[2][2][4][2], const Unit& u, int wr, int wc) const {
        PG8_OPAQUE(0, 0);
        const unsigned row0 = (unsigned)(u.pm * 256 + wr * 64) + (unsigned)frx, c0 = u.pn * 256u + 32u * wc + 8u * fqx, o0 = row0 * 2048u + c0 * 2u, g0 = row0 * 1024u + c0;
        const unsigned char* GA = ws + WS_GA; const unsigned char* GB = ws + WS_GB; unsigned char* YM = ws + WS_YM;
#pragma unroll
        for (int ai = 0; ai < 2; ++ai) {
            u32x2 ga[4][2], gb[4][2];
#pragma unroll
            for (int m = 0; m < 4; ++m)
#pragma unroll
                for (int bj = 0; bj < 2; ++bj) { const unsigned go = g0 + (unsigned)(ai * 128 + m * 16) * 1024u + bj * 128u; gb[m][bj] = *(const u32x2*)(GB + go); if (MID) ga[m][bj] = *(const u32x2*)(GA + go); }
#pragma unroll
            for (int m = 0; m < 4; ++m)
#pragma unroll
                for (int bj = 0; bj < 2; ++bj) { const unsigned off = o0 + (unsigned)(ai * 128 + m * 16) * 2048u + bj * 256u; f32x4 s0, s1;
#pragma unroll
                    for (int j = 0; j < 4; ++j) { const float b0 = fmaxf((float)((gb[m][bj].x >> (8 * j)) & 0xffu), 0.5f), b1 = fmaxf((float)((gb[m][bj].y >> (8 * j)) & 0xffu), 0.5f);
                        s0[j] = MID ? (float)((ga[m][bj].x >> (8 * j)) & 0xffu) * __builtin_amdgcn_rcpf(b0) : b0 * (1.f / 255.f);
                        s1[j] = MID ? (float)((ga[m][bj].y >> (8 * j)) & 0xffu) * __builtin_amdgcn_rcpf(b1) : b1 * (1.f / 255.f); }
                    acc[ai][bj][m][0] *= s0; acc[ai][bj][m][1] *= s1;
                    if (!MID) st16(YM, off, pack8(acc[ai][bj][m][0], acc[ai][bj][m][1])); }
            asm volatile("" ::: "memory"); }
    }
    __device__ __forceinline__ void mid(f32x4 (&acc)[2][2][4][2], const Unit& u, int wr, int wc) const { run<true>(acc, u, wr, wc); }
    __device__ __forceinline__ void operator()(f32x4 (&acc)[2][2][4][2], const Unit& u, int wr, int wc, int fr, int fq) const { run<false>(acc, u, wr, wc); }
};
struct EpiYF {
    static constexpr bool PERM = true, AFTER_DRAIN = false; static constexpr int MID_T = 0;
    unsigned char* ws;
    __device__ __forceinline__ void operator()(const f32x4 (&acc)[2][2][4][2], const Unit& u, int wr, int wc, int fr, int fq) const {
        PG8_OPAQUE(fr, fq);
        const unsigned row0 = (unsigned)(u.pm * 256 + wr * 64) + (unsigned)frx, c0 = u.pn * 256u + 32u * wc + 8u * fqx, o0 = row0 * 2048u + c0 * 2u; unsigned char* Y = ws + WS_Y; float* ssq = (float*)(ws + WS_SSQY);
#pragma unroll
        for (int ai = 0; ai < 2; ++ai)
#pragma unroll
            for (int m = 0; m < 4; ++m) { float s = 0.f;
#pragma unroll
                for (int bj = 0; bj < 2; ++bj) { s += sumsq8(acc[ai][bj][m][0], acc[ai][bj][m][1]); st16(Y, o0 + (unsigned)(ai * 128 + m * 16) * 2048u + bj * 256u, pack8(acc[ai][bj][m][0], acc[ai][bj][m][1])); }
                s += __shfl_xor(s, 16); s += __shfl_xor(s, 32);
                if (fqx == 0) atomicAdd(ssq + (row0 + ai * 128 + m * 16), s); }
    }
};
}

struct MapIn { __device__ int operator()(int n) const { const int t = n >> 8, tc = n & 255, bj = tc >> 7, uu = tc & 127;
    if (t == 0) return n;
    if (t == 1) return uu < 64 ? C_KVLAT + 64 * bj + uu : (uu < 80 ? C_KROPE + 16 * bj + (uu - 64) : -1);
    if (t < 4) return C_ZMLA + (n - 512);
    if (t < 8) return (t < 6 ? C_QMB : C_KMB) + 256 * (t & 1) + 64 * (uu >> 5) + 32 * bj + (uu & 31);
    if (t < 10) return C_VMB + (n - 2048);
    if (t < 12) return C_ZMB + (n - 2560);
    if (t < 16) return C_GA + (n - 3072);
    return C_GB + (n - 4096); } };
struct MapUq { __device__ int operator()(int n) const { const int t = n >> 8, tc = n & 255, bj = tc >> 7, uu = tc & 127;
    if (t < 2) return 96 * (4 * t + (tc >> 6)) + (tc & 63);
    return 96 * (uu >> 4) + 64 + 16 * bj + (uu & 15); } };
struct MapUkv { __device__ int operator()(int n) const { const int t = n >> 8, tc = n & 255; return 128 * (4 * (t & 1) + (tc >> 6)) + (t < 2 ? 0 : 64) + (tc & 63); } };
struct MapId { __device__ int operator()(int n) const { return n; } };
template <class Map> __device__ __forceinline__ void wt_items(const float* W, int ldw, int Kreal, int K, int N, unsigned short* WT, const float* kscale, Map map, LAS float* scr, int gw, int ngw, int lane, int ldk = 0, int koff = 0) {
    if (ldk == 0) ldk = K;
    const int nblk = N / 64, nitems = (K / 32) * nblk; typedef float f4 __attribute__((ext_vector_type(4)));
    for (int it = gw; it < nitems; it += ngw) {
        const int kb = it / nblk, nb = it % nblk, k0 = 32 * kb, n0 = 64 * nb; const int src = map(n0 + 4 * (lane & 15));
        f4 wv[8];
#pragma unroll
        for (int i = 0; i < 8; ++i) { const int k = k0 + 4 * i + (lane >> 4); wv[i] = (src >= 0 && k < Kreal) ? *(const f4*)(W + (size_t)k * ldw + src) : (f4){0.f, 0.f, 0.f, 0.f}; }
#pragma unroll
        for (int i = 0; i < 8; ++i) { const int kk = 4 * i + (lane >> 4), k = k0 + kk; f4 v = wv[i]; if (kscale && k < Kreal) v = v * kscale[k]; *(LAS f4*)(scr + kk * 68 + 4 * (lane & 15)) = v; }
        asm volatile("s_waitcnt lgkmcnt(0)" ::: "memory");
#pragma unroll
        for (int j = 0; j < 4; ++j) { const int q = lane + 64 * j, n = q >> 2, c = q & 3; const LAS float* s = scr + (8 * c) * 68 + n;
            pg8::u32x4 o; o.x = pg8::pk_h2(s[0 * 68], s[1 * 68]); o.y = pg8::pk_h2(s[2 * 68], s[3 * 68]); o.z = pg8::pk_h2(s[4 * 68], s[5 * 68]); o.w = pg8::pk_h2(s[6 * 68], s[7 * 68]);
            *(pg8::u32x4*)(WT + (size_t)(n0 + n) * ldk + koff + k0 + 8 * c) = o; }
        asm volatile("s_waitcnt lgkmcnt(0)" ::: "memory");
    }
}
constexpr size_t WT_IN = WS_WT, WT_UQ = WS_WT + 10 * MiB, WT_UKV = WT_UQ + 512 * 1024, WT_OA = WS_WT + 11 * MiB, WT_OB = WS_WT + 12 * MiB, WT_OUT = WS_WT + 13 * MiB;
__device__ __forceinline__ void ph_weights(const Params& p, LAS unsigned char* lds, int gw, int ngw, int wave, int lane) {
    LAS float* scr = (LAS float*)(lds + wave * 16384);
    wt_items(p.w_in, D_IN, 1024, 1024, 5120, (unsigned short*)(p.ws + WT_IN), nullptr, MapIn(), scr, gw, ngw, lane);
    wt_items(p.w_uq, 768, 256, 256, 768, (unsigned short*)(p.ws + WT_UQ), p.g_q, MapUq(), scr, gw, ngw, lane);
    wt_items(p.w_ukv, 1024, 128, 128, 1024, (unsigned short*)(p.ws + WT_UKV), p.g_kv, MapUkv(), scr, gw, ngw, lane);
    wt_items(p.w_o_mla, 1024, 512, 512, 1024, (unsigned short*)(p.ws + WT_OA), nullptr, MapId(), scr, gw, ngw, lane, 1024, 0);
    wt_items(p.w_o_moba, 1024, 512, 512, 1024, (unsigned short*)(p.ws + WT_OA), nullptr, MapId(), scr, gw, ngw, lane, 1024, 512);
    wt_items(p.w_out, 1024, 1024, 1024, 1024, (unsigned short*)(p.ws + WT_OUT), nullptr, MapId(), scr, gw, ngw, lane);
}

namespace att {
struct T1 { static constexpr bool value = true; }; struct T0 { static constexpr bool value = false; };
typedef _Float16 h8 __attribute__((ext_vector_type(8)));
typedef short s4 __attribute__((ext_vector_type(4)));
typedef short s8 __attribute__((ext_vector_type(8)));
typedef float f16v __attribute__((ext_vector_type(16)));
typedef unsigned u4 __attribute__((ext_vector_type(4)));
typedef short v4i16_t __attribute__((ext_vector_type(4)));
constexpr int KBUF = 16384, VBUF = 8192;
constexpr int NBUF = 4;
constexpr int L_K = 0, L_V = NBUF * KBUF, L_WS = L_V + NBUF * VBUF, L_TB = L_WS + 8 * 256, L_UN = L_TB + 256, L_END = L_UN + 64, L_OST = 0;
constexpr float THR = 8.f;
#ifndef PROBE_ABL
#define PROBE_ABL 0
#endif
#ifndef ATT_STAGGER
#define ATT_STAGGER 0
#endif
constexpr bool STAGGER = ATT_STAGGER;
__device__ __forceinline__ int crow(int r, int hi) { return (r & 3) + 8 * (r >> 2) + 4 * hi; }
template <int DK> __device__ __forceinline__ int kaddr(int row, int ch) { return DK == 64 ? row * 128 + ((ch ^ ((row >> 1) & 7)) << 4) : row * 256 + ((ch ^ (row & 15)) << 4); }
__device__ __forceinline__ s4 vtr(const LAS unsigned char* p) { return __builtin_bit_cast(s4, __builtin_amdgcn_ds_read_tr16_b64_v4i16((LAS v4i16_t*)p)); }
__device__ __forceinline__ float swapmax(float m) { auto rr = __builtin_amdgcn_permlane32_swap(__float_as_uint(m), __float_as_uint(m), false, false); return fmaxf(__uint_as_float(rr[0]), __uint_as_float(rr[1])); }
__device__ __forceinline__ float swapsum(float m) { auto rr = __builtin_amdgcn_permlane32_swap(__float_as_uint(m), __float_as_uint(m), false, false); return __uint_as_float(rr[0]) + __uint_as_float(rr[1]); }
__device__ __forceinline__ void glds16(const void* g, unsigned lds_base) { unsigned sv;
    asm volatile("s_mov_b32 %0, m0\n\ts_mov_b32 m0, %2\n\ts_nop 0\n\tglobal_load_lds_dwordx4 %1, off\n\ts_mov_b32 m0, %0" : "=&s"(sv) : "v"(g), "s"(lds_base) : "memory"); }
__device__ __forceinline__ float max3f(float a, float b, float c) { float r; asm("v_max3_f32 %0, %1, %2, %3" : "=v"(r) : "v"(a), "v"(b), "v"(c)); return r; }
__device__ __forceinline__ unsigned pkh(float lo, float hi) { typedef _Float16 h2 __attribute__((ext_vector_type(2))); h2 v; v[0] = (_Float16)lo; v[1] = (_Float16)hi; return __builtin_bit_cast(unsigned, v); }

template <int DK, bool MOBA, int ABL = 0>
__device__ __forceinline__ void attn_unit(unsigned char* ws, int b, int h, int qb, LAS unsigned char* lds, bool dry = false) {
    constexpr int ND = DK / 16, QP = MOBA ? 512 : 768, QH = MOBA ? 64 : 96;
    int tid_ = threadIdx.x; asm volatile("" : "+v"(tid_));
    const int tid = tid_, lane = tid & 63, r32 = lane & 31, hi = lane >> 5; const int wid = __builtin_amdgcn_readfirstlane(tid >> 6);
    const _Float16* Qg = (const _Float16*)(ws + (MOBA ? WS_QMB : WS_QMLA)); const _Float16* Kg = (const _Float16*)(ws + (MOBA ? WS_KMB : WS_KN));
    const _Float16* Vg = (const _Float16*)(ws + (MOBA ? WS_VMB : WS_VM)); const _Float16* Pg = (const _Float16*)(ws + WS_KPE); _Float16* Zg = (_Float16*)(ws + WS_ZCAT) + (MOBA ? 512 : 0);
    const size_t rowbase = (size_t)b * SEQ; const int q0 = qb * 256, qw0 = q0 + wid * 32, qrow = qw0 + r32;
    LAS float* wsf = (LAS float*)(lds + L_WS) + wid * 64; LAS int* tb = (LAS int*)(lds + L_TB); LAS unsigned* un = (LAS unsigned*)(lds + L_UN);
    h8 qr[ND];
#pragma unroll
    for (int d0 = 0; d0 < ND; ++d0) qr[d0] = *(const h8*)(Qg + (rowbase + qrow) * QP + h * QH + d0 * 16 + hi * 8);
#pragma unroll
    for (int d0 = 0; d0 < ND; ++d0) asm volatile("" : "+v"(qr[d0]));
    unsigned sel = 0u, blocks = (2u << qb) - 1u;
    if (MOBA) {
        const float* km = (const float*)(ws + WS_KMEAN) + (size_t)b * 16 * 512 + h * 64 + hi * 8;
        float g0 = -INFINITY, g1 = -INFINITY, g2 = -INFINITY; int i0 = -1, i1 = -1, i2 = -1;
        for (int m = 0; m < qb; ++m) {
            float part = 0.f;
#pragma unroll
            for (int d0 = 0; d0 < 4; ++d0) { const float4 a = *(const float4*)(km + m * 512 + d0 * 16), c = *(const float4*)(km + m * 512 + d0 * 16 + 4);
                part += (float)qr[d0][0] * a.x + (float)qr[d0][1] * a.y + (float)qr[d0][2] * a.z + (float)qr[d0][3] * a.w + (float)qr[d0][4] * c.x + (float)qr[d0][5] * c.y + (float)qr[d0][6] * c.z + (float)qr[d0][7] * c.w; }
            const float g = swapsum(part);
            if (g > g0) { g2 = g1; i2 = i1; g1 = g0; i1 = i0; g0 = g; i0 = m; }
            else if (g > g1) { g2 = g1; i2 = i1; g1 = g; i1 = m; }
            else if (g > g2) { g2 = g; i2 = m; }
        }
        if (i0 >= 0) sel |= 1u << i0; if (i1 >= 0) sel |= 1u << i1; if (i2 >= 0) sel |= 1u << i2;
        unsigned uw = sel;
#pragma unroll
        for (int o = 1; o < 64; o <<= 1) uw |= (unsigned)__shfl_xor((int)uw, o);
        if (lane == 0) un[wid] = uw;
        __syncthreads();
        unsigned ua = 0u;
#pragma unroll
        for (int w = 0; w < 8; ++w) ua |= un[w];
        blocks = (unsigned)__builtin_amdgcn_readfirstlane((int)(ua | (1u << qb)));
    }
    const int NT = 4 * __builtin_popcount(blocks);
    if (tid < 64 && tid < NT) { unsigned bm = blocks; for (int k = 0; k < (tid >> 2); ++k) bm &= bm - 1u; tb[tid] = (__builtin_ctz(bm) << 8) + ((tid & 3) << 6); }
    __syncthreads();
    const unsigned char* kbu = (const unsigned char*)(Kg + rowbase * 512 + h * 64); const unsigned char* vbu = (const unsigned char*)(Vg + rowbase * 512 + h * 64); const unsigned char* pbu = (const unsigned char*)(Pg + rowbase * 32);
    const unsigned char* kb0; const unsigned char* kb1 = nullptr; unsigned ksrc0, ksrc1 = 0u, kst0 = 1024u, kst1 = 1024u;
    if (DK == 96) { const int r0 = 4 * wid + (lane >> 4), r1 = r0 + 32; int c0 = (lane & 15) ^ (r0 & 15), c1 = (lane & 15) ^ (r1 & 15); if (c0 >= 12) c0 -= 4; if (c1 >= 12) c1 -= 4;
        const bool kpe0 = c0 >= 8, kpe1 = c1 >= 8;
        kb0 = kpe0 ? pbu : kbu; kst0 = kpe0 ? 64u : 1024u; ksrc0 = kpe0 ? (unsigned)(r0 * 32 + (c0 - 8) * 8) * 2u : (unsigned)(r0 * 512 + c0 * 8) * 2u;
        kb1 = kpe1 ? pbu : kbu; kst1 = kpe1 ? 64u : 1024u; ksrc1 = kpe1 ? (unsigned)(r1 * 32 + (c1 - 8) * 8) * 2u : (unsigned)(r1 * 512 + c1 * 8) * 2u;
    } else { const int r0 = 8 * wid + (lane >> 3), c0 = (lane & 7) ^ ((r0 >> 1) & 7); kb0 = kbu; ksrc0 = (unsigned)(r0 * 512 + c0 * 8) * 2u; }
    const unsigned vsrc = (unsigned)((16 * (wid & 3) + (lane >> 2)) * 512 + (wid >> 2) * 32 + (lane & 3) * 8) * 2u;
    constexpr int NDMA = (DK == 96) ? 3 : 2;
#define ATT_GLDS(src, dst) glds16((const void*)(src), (unsigned)__builtin_amdgcn_readfirstlane((int)(unsigned)(size_t)(dst)))
#define ATT_DMA(kb, buf) do { const unsigned kb_ = (unsigned)(kb); LAS unsigned char* kd_ = lds + L_K + (buf) * KBUF; \
        ATT_GLDS(kb0 + (ksrc0 + kb_ * kst0), kd_ + wid * 1024); \
        if (DK == 96) ATT_GLDS(kb1 + (ksrc1 + kb_ * kst1), kd_ + 8192 + wid * 1024); \
        ATT_GLDS(vbu + (vsrc + kb_ * 1024u), lds + L_V + (buf) * VBUF + wid * 1024); } while (0)
#define ATT_WAITV(n) asm volatile("s_waitcnt vmcnt(" #n ")" ::: "memory")
#define ATT_BAR() do { asm volatile("s_waitcnt lgkmcnt(0)" ::: "memory"); __builtin_amdgcn_s_barrier(); asm volatile("" ::: "memory"); } while (0)
    const int vro = ((lane >> 4) & 1) * 32 + (lane & 3) * 8 + (4 * hi + ((lane & 15) >> 2)) * 64;
    float l_reg = 0.f; bool init = false; f16v o[2]; o[0] = f16v{}; o[1] = f16v{}; f16v negm = f16v{}; asm volatile("" : "+v"(negm));
    constexpr int G = 2 * ND;
#define ATT_SBAR() __builtin_amdgcn_sched_barrier(0)
#define ATT_PIN(x) asm volatile("" : "+v"(x))
#define ATT_KF(buf, g) (*(const LAS h8*)(lds + L_K + (buf) * KBUF + kaddr<DK>(32 * ((g) & 1) + r32, 2 * ((g) >> 1) + hi)))
#define ATT_MF(a, b, c) __builtin_amdgcn_mfma_f32_32x32x16_f16(a, b, c, 0, 0, 0)
#define ATT_QK(P0, P1, buf) do { h8 kf_[G]; _Pragma("unroll") for (int g_ = 0; g_ < G; ++g_) kf_[g_] = ATT_KF(buf, g_); ATT_SBAR(); \
        _Pragma("unroll") for (int d_ = 0; d_ < ND; ++d_) { P0 = ATT_MF(kf_[2 * d_], qr[d_], d_ == 0 ? negm : P0); P1 = ATT_MF(kf_[2 * d_ + 1], qr[d_], d_ == 0 ? negm : P1); } } while (0)
#define ATT_MAXCHAIN(P0, P1, PM) do { float pa_ = max3f(P0[0], P0[1], P1[0]), pb_ = max3f(P0[2], P0[3], P1[1]); pa_ = max3f(pa_, P1[2], P1[3]); \
        _Pragma("unroll") for (int r_ = 4; r_ < 16; r_ += 4) { pa_ = max3f(pa_, P0[r_], P0[r_ + 1]); pb_ = max3f(pb_, P0[r_ + 2], P0[r_ + 3]); pa_ = max3f(pa_, P1[r_], P1[r_ + 1]); pb_ = max3f(pb_, P1[r_ + 2], P1[r_ + 3]); } \
        PM = swapmax(fmaxf(pa_, pb_)); } while (0)
#define ATT_MOVE(P0, P1, PM) do { const bool move_ = init ? ((PM) > THR) : ((PM) > -INFINITY); \
        if (__any(move_)) { const float dl_ = move_ ? (init ? fmaxf((PM), 0.f) : (PM)) : 0.f; const float al_ = (move_ && init) ? __builtin_amdgcn_exp2f(-dl_) : 1.f; \
            init = init || move_; l_reg *= al_; \
            _Pragma("unroll") for (int r_ = 0; r_ < 16; ++r_) { P0[r_] -= dl_; P1[r_] -= dl_; negm[r_] -= dl_; } \
            if (hi == 0) wsf[r32] = al_; asm volatile("s_waitcnt lgkmcnt(0)" ::: "memory"); \
            _Pragma("unroll") for (int r_ = 0; r_ < 16; ++r_) { const float a_ = wsf[crow(r_, hi)]; o[0][r_] *= a_; o[1][r_] *= a_; } } } while (0)
#define ATT_PACK(P0, P1, PW, KEEP) do { _Pragma("unroll") for (int k_ = 0; k_ < 2; ++k_) { \
            PW[k_] = (u4){pkh(P0[8 * k_], P0[8 * k_ + 1]), pkh(P0[8 * k_ + 2], P0[8 * k_ + 3]), pkh(P0[8 * k_ + 4], P0[8 * k_ + 5]), pkh(P0[8 * k_ + 6], P0[8 * k_ + 7])}; \
            PW[2 + k_] = (u4){pkh(P1[8 * k_], P1[8 * k_ + 1]), pkh(P1[8 * k_ + 2], P1[8 * k_ + 3]), pkh(P1[8 * k_ + 4], P1[8 * k_ + 5]), pkh(P1[8 * k_ + 6], P1[8 * k_ + 7])}; } \
        if (MOBA) { _Pragma("unroll") for (int k_ = 0; k_ < 4; ++k_) PW[k_] &= (KEEP); } } while (0)
#define ATT_VF(buf, i) (lds + L_V + (buf) * VBUF + vro + ((i) >> 2) * 4096 + ((i) & 3) * 1024)
#define ATT_WAIT_NEXT(t_) do { if ((t_) + 3 < NT) { if (NDMA == 3) ATT_WAITV(3); else ATT_WAITV(2); } else ATT_WAITV(0); } while (0)
#define ATT_TB(i) (MOBA ? tb[(i)] : 64 * (i))
    const int NF = NT - 4;
    ATT_DMA(ATT_TB(0), 0); ATT_DMA(ATT_TB(1), 1); ATT_DMA(ATT_TB(2), 2);
    if (NDMA == 3) ATT_WAITV(3); else ATT_WAITV(2);
    ATT_BAR();
    f16v pC0, pC1;
    if (NF > 0) { ATT_QK(pC0, pC1, 0); asm volatile("s_nop 15\n\ts_nop 7" : "+v"(pC0), "+v"(pC1)); float pm; ATT_MAXCHAIN(pC0, pC1, pm);
        if (MOBA && !((sel >> (ATT_TB(0) >> 8)) & 1u)) pm = -INFINITY; ATT_MOVE(pC0, pC1, pm); }
    auto step = [&](f16v& pC0, f16v& pC1, f16v& pN0, f16v& pN1, const int t, auto hn) __attribute__((always_inline)) {
        const int cur = t & 3, nx = (t + 1) & 3; constexpr bool hasn = decltype(hn)::value;
        ATT_DMA(ATT_TB(t + 3), (t + 3) & 3);
        const unsigned keepC = (!MOBA || ((sel >> (ATT_TB(t) >> 8)) & 1u)) ? 0xffffffffu : 0u;
        float ps = 0.f;
        if (hasn) {
            h8 kf[G];
#pragma unroll
            for (int g = 0; g < 4; ++g) kf[g] = ATT_KF(nx, g);
            ATT_SBAR();
#pragma unroll
            for (int g = 0; g < G; ++g) {
                if (g + 4 < G) kf[g + 4] = ATT_KF(nx, g + 4);
                if (g & 1) pN1 = ATT_MF(kf[g], qr[g >> 1], g == 1 ? negm : pN1); else pN0 = ATT_MF(kf[g], qr[g >> 1], g == 0 ? negm : pN0);
                constexpr int dummy = 0; (void)dummy;
                const int e0 = (ND == 4) ? 4 * g : (g < 8 ? 3 * g : 24 + 2 * (g - 8)), e1 = (ND == 4) ? 4 * g + 4 : (g < 8 ? 3 * g + 3 : 26 + 2 * (g - 8));
#pragma unroll
                for (int e = e0; e < e1; ++e) { if (e < 16) { pC0[e] = __builtin_amdgcn_exp2f(pC0[e]); ps += pC0[e]; } else { pC1[e - 16] = __builtin_amdgcn_exp2f(pC1[e - 16]); ps += pC1[e - 16]; } }
                ATT_PIN(pC0); ATT_PIN(pC1); ATT_PIN(ps); ATT_SBAR();
            }
        } else {
#pragma unroll
            for (int r = 0; r < 16; ++r) { pC0[r] = __builtin_amdgcn_exp2f(pC0[r]); pC1[r] = __builtin_amdgcn_exp2f(pC1[r]); ps += pC0[r] + pC1[r]; }
        }
        if (MOBA && !keepC) ps = 0.f;
        l_reg += swapsum(ps);
        u4 pw[4]; ATT_PACK(pC0, pC1, pw, keepC);
        {
            s4 vlo[8], vhi[8]; float pa = 0.f, pb = 0.f;
#pragma unroll
            for (int i = 0; i < 3; ++i) { vlo[i] = vtr(ATT_VF(cur, i)); vhi[i] = vtr(ATT_VF(cur, i) + 512); }
            if (hasn) asm volatile("s_nop 7" : "+v"(pN0), "+v"(pN1));
            ATT_SBAR();
#pragma unroll
            for (int i = 0; i < 8; ++i) {
                if (i + 3 < 8) { vlo[i + 3] = vtr(ATT_VF(cur, i + 3)); vhi[i + 3] = vtr(ATT_VF(cur, i + 3) + 512); }
                const s8 vv = (s8){vlo[i][0], vlo[i][1], vlo[i][2], vlo[i][3], vhi[i][0], vhi[i][1], vhi[i][2], vhi[i][3]};
                o[i >> 2] = ATT_MF(__builtin_bit_cast(h8, pw[i & 3]), __builtin_bit_cast(h8, vv), o[i >> 2]);
                if (hasn) {
                    if (i == 0) { pa = max3f(pN0[0], pN0[1], pN1[0]); pb = max3f(pN0[2], pN0[3], pN1[1]); }
                    else if (i == 1) { pa = max3f(pa, pN1[2], pN1[3]); pb = max3f(pb, pN0[6], pN0[7]); }
                    else if (i == 2) { pa = max3f(pa, pN0[4], pN0[5]); pb = max3f(pb, pN1[6], pN1[7]); }
                    else if (i == 3) { pa = max3f(pa, pN1[4], pN1[5]); pb = max3f(pb, pN0[10], pN0[11]); }
                    else if (i == 4) { pa = max3f(pa, pN0[8], pN0[9]); pb = max3f(pb, pN1[10], pN1[11]); }
                    else if (i == 5) { pa = max3f(pa, pN1[8], pN1[9]); pb = max3f(pb, pN0[14], pN0[15]); }
                    else if (i == 6) { pa = max3f(pa, pN0[12], pN0[13]); pb = max3f(pb, pN1[14], pN1[15]); }
                    else { pa = max3f(pa, pN1[12], pN1[13]); }
                    ATT_PIN(pa); ATT_PIN(pb);
                }
                ATT_SBAR();
            }
            if (hasn) { float pm = swapmax(fmaxf(pa, pb)); if (MOBA && !((sel >> (ATT_TB(t + 1) >> 8)) & 1u)) pm = -INFINITY; ATT_MOVE(pN0, pN1, pm); }
        }
        if (NDMA == 3) ATT_WAITV(3); else ATT_WAITV(2);
        ATT_BAR();
    };
    {
        f16v pD0, pD1; int t = 0;
        for (; t + 2 < NF; t += 2) { step(pC0, pC1, pD0, pD1, t, T1{}); step(pD0, pD1, pC0, pC1, t + 1, T1{}); }
        if (t + 1 < NF) { step(pC0, pC1, pD0, pD1, t, T1{}); step(pD0, pD1, pC0, pC1, t + 1, T0{}); }
        else if (t < NF) step(pC0, pC1, pD0, pD1, t, T0{});
    }
    for (int t = NF; t < NT; ++t) {
        const int cur = t & 3, kb = ATT_TB(t);
        if (t + 3 < NT) ATT_DMA(ATT_TB(t + 3), (t + 3) & 3);
        if (kb <= qw0 + 31) {
            f16v p0, p1; ATT_QK(p0, p1, cur);
            if (kb + 63 > qw0) {
#pragma unroll
                for (int r = 0; r < 16; ++r) { const int kv = kb + crow(r, hi); if (kv > qrow) p0[r] = -INFINITY; if (kv + 32 > qrow) p1[r] = -INFINITY; }
            }
            asm volatile("s_nop 15\n\ts_nop 7" : "+v"(p0), "+v"(p1));
            float pm; ATT_MAXCHAIN(p0, p1, pm); ATT_MOVE(p0, p1, pm);
            s4 vlo[8], vhi[8];
#pragma unroll
            for (int i = 0; i < 8; ++i) { vlo[i] = vtr(ATT_VF(cur, i)); vhi[i] = vtr(ATT_VF(cur, i) + 512); }
            ATT_SBAR();
            float ps = 0.f;
#pragma unroll
            for (int r = 0; r < 16; ++r) { p0[r] = __builtin_amdgcn_exp2f(p0[r]); p1[r] = __builtin_amdgcn_exp2f(p1[r]); ps += p0[r] + p1[r]; }
            l_reg += swapsum(ps);
            u4 pw[4]; ATT_PACK(p0, p1, pw, 0xffffffffu);
#pragma unroll
            for (int i = 0; i < 8; ++i) { const s8 vv = (s8){vlo[i][0], vlo[i][1], vlo[i][2], vlo[i][3], vhi[i][0], vhi[i][1], vhi[i][2], vhi[i][3]};
                o[i >> 2] = ATT_MF(__builtin_bit_cast(h8, pw[i & 3]), __builtin_bit_cast(h8, vv), o[i >> 2]); }
        }
        ATT_WAIT_NEXT(t);
        ATT_BAR();
    }
    if (hi == 0) wsf[32 + r32] = l_reg; asm volatile("s_waitcnt lgkmcnt(0)" ::: "memory");
    LAS _Float16* stg = (LAS _Float16*)(lds + L_OST) + wid * 2048;
#pragma unroll
    for (int r = 0; r < 16; ++r) { const int orow = crow(r, hi); const float rl = 1.f / wsf[32 + orow];
        stg[orow * 64 + r32] = (_Float16)(o[0][r] * rl); stg[orow * 64 + 32 + r32] = (_Float16)(o[1][r] * rl); }
    asm volatile("s_waitcnt lgkmcnt(0)" ::: "memory");
    int lane_e = lane; asm volatile("" : "+v"(lane_e));
    unsigned char* zbu = (unsigned char*)(Zg + (rowbase + qw0) * 1024 + h * 64);
#pragma unroll
    for (int i = 0; i < 4; ++i) { const int row = i * 8 + (lane_e >> 3), ch = lane_e & 7; const h8 v = *(const LAS h8*)(stg + row * 64 + ch * 8);
        _Float16* zp = (_Float16*)(zbu + (unsigned)(row * 1024 + ch * 8) * 2u); const h8 z = *(const h8*)zp; h8 ov;
#pragma unroll
        for (int j = 0; j < 8; ++j) ov[j] = (_Float16)((float)v[j] * (float)z[j]);
        if (!dry) *(h8*)zp = ov; }
    __syncthreads();
#undef ATT_GLDS
#undef ATT_DMA
#undef ATT_WAITV
#undef ATT_BAR
#undef ATT_SBAR
#undef ATT_PIN
#undef ATT_KF
#undef ATT_MF
#undef ATT_QK
#undef ATT_MAXCHAIN
#undef ATT_MOVE
#undef ATT_PACK
#undef ATT_VF
#undef ATT_WAIT_NEXT
#undef ATT_TB
}

__device__ __forceinline__ void attn_phase(unsigned char* ws, LAS unsigned char* lds, int vb, int nvb) {
    const int vcu = (nvb % 8 == 0) ? (vb % 8) * (nvb / 8) + vb / 8 : vb; const int per = (1024 + nvb - 1) / nvb;
    for (int k = 0; k < per; ++k) {
        int it;
        if (nvb == 256) { const int xg = vcu >> 5, lw = vcu & 31; it = ((16 * xg + 4 * k + (lw >> 3)) << 3) | (lw & 7); }
        else { it = vcu * per + k; if (it >= 1024) break; }
        const int bh = it >> 3, pr = it & 7, b = bh >> 3, h = bh & 7;
        if (PROBE == 2) for (int uu = 0; uu < 2; ++uu) attn_unit<96, false, PROBE_ABL>(ws, b, h, uu ? 15 - pr : pr, lds, true);
        for (int uu = 0; uu < 2; ++uu) attn_unit<96, false>(ws, b, h, uu ? 15 - pr : pr, lds);
        if (PROBE == 3) for (int uu = 0; uu < 2; ++uu) attn_unit<64, true, PROBE_ABL>(ws, b, h, uu ? 15 - pr : pr, lds, true);
        for (int uu = 0; uu < 2; ++uu) attn_unit<64, true>(ws, b, h, uu ? 15 - pr : pr, lds);
    }
}
}

constexpr int RING_BYTES = 131072, MISC_OFF = RING_BYTES + 320, LDS_BYTES = 147456;
constexpr int CW_BAR = 4096;

__global__ void __launch_bounds__(512, 2) mega(Params p) {
    extern __shared__ __attribute__((aligned(16))) unsigned char lds[];
    const int vb = blockIdx.x, nvb = gridDim.x, tid = threadIdx.x, lane = tid & 63, wave = tid >> 6;
    const int gtid = vb * 512 + tid, gsize = nvb * 512, gwave = vb * 8 + wave, nwaves = nvb * 8;
    volatile LAS unsigned* misc = (volatile LAS unsigned*)((LAS unsigned char*)lds + MISC_OFF);
    if (tid < 32) misc[tid] = 0u;
    __syncthreads();
    XcdBarrier bar = xcd_barrier_post((unsigned*)(p.ws + WS_CTL) + CW_BAR, misc + 8);
    LAS unsigned char* ldsl = (LAS unsigned char*)lds;
    { int t_ = threadIdx.x; asm volatile("" : "+v"(t_)); ph_prep(p, vb * 512 + t_, gsize); ph_weights(p, ldsl, vb * 8 + (t_ >> 6), nwaves, t_ >> 6, t_ & 63);
      if (PROBE == 10) ph_weights(p, ldsl, vb * 8 + (t_ >> 6), nwaves, t_ >> 6, t_ & 63);
      if (PROBE == 11) ph_tab(p, vb * 512 + t_, gsize); }
    xcd_barrier(bar);
    for (int rep4 = 0; rep4 < ((PROBE == 4 || PROBE == 6) ? 2 : 1); ++rep4) { int t_ = threadIdx.x; asm volatile("" : "+v"(t_)); ph_hnorm(p, vb * 8 + (t_ >> 6), nwaves, t_ & 63); }
    xcd_barrier(bar);
    {
        pg8::Gemm g{(const pg8::bf16_t*)(p.ws + WS_H), (const pg8::bf16_t*)(p.ws + WT_IN), M_, 5120, 1024}; pg8::StaticOrder S; S.init(M_, 5120, nvb, vb);
        for (int rep = (PROBE == 1 ? 1 : 0); rep >= 0; --rep) { pg8::EpiInF E{p.ws, p.b_merge, rep}; pg8::gemm_phase<pg8::EpiInF, pg8::StaticOrder, true, true>(ldsl, g, S, E); }
        if (PROBE == 5) { pg8::EpiNull E; pg8::gemm_phase<pg8::EpiNull, pg8::StaticOrder, true, true>(ldsl, g, S, E); }
    }
    xcd_barrier(bar);
    for (int rep4 = 0; rep4 < ((PROBE == 4 || PROBE == 7) ? 2 : 1); ++rep4) {
        pg8::Gemm g{(const pg8::bf16_t*)(p.ws + WS_QLAT), (const pg8::bf16_t*)(p.ws + WT_UQ), M_, 768, 256}; pg8::StaticOrder S; S.init(M_, 768, nvb, vb);
        pg8::EpiUqF E{p.ws}; pg8::gemm_phase<pg8::EpiUqF, pg8::StaticOrder, true, true>(ldsl, g, S, E);
    }
    for (int rep4 = 0; rep4 < ((PROBE == 4 || PROBE == 7) ? 2 : 1); ++rep4) {
        pg8::Gemm g{(const pg8::bf16_t*)(p.ws + WS_KVL), (const pg8::bf16_t*)(p.ws + WT_UKV), M_, 1024, 128};     pg8::StaticOrder S; S.init(M_, 1024, nvb, vb);
        pg8::EpiUkvF E{p.ws}; pg8::gemm_phase<pg8::EpiUkvF, pg8::StaticOrder, true, true>(ldsl, g, S, E);
    }
    xcd_barrier(bar);
    att::attn_phase(p.ws, ldsl, vb, nvb);
    xcd_barrier(bar);
    {
        pg8::Gemm g{(const pg8::bf16_t*)(p.ws + WS_ZCAT), (const pg8::bf16_t*)(p.ws + WT_OA), M_, 1024, 1024}; pg8::StaticOrder S; S.init(M_, 1024, nvb, vb);
        pg8::EpiYcatF E{p.ws}; pg8::gemm_phase<pg8::EpiYcatF, pg8::StaticOrder, true, true>(ldsl, g, S, E);
    }
    xcd_barrier(bar);
    for (int rep4 = 0; rep4 < ((PROBE == 4 || PROBE == 9) ? 2 : 1); ++rep4) {
        pg8::Gemm g{(const pg8::bf16_t*)(p.ws + WS_YM), (const pg8::bf16_t*)(p.ws + WT_OUT), M_, 1024, 1024}; pg8::StaticOrder S; S.init(M_, 1024, nvb, vb);
        pg8::EpiYF E{p.ws}; pg8::gemm_phase<pg8::EpiYF, pg8::StaticOrder, true, true>(ldsl, g, S, E);
    }
    xcd_barrier(bar);
    for (int rep4 = 0; rep4 < ((PROBE == 4 || PROBE == 9) ? 2 : 1); ++rep4) { int t_ = threadIdx.x; asm volatile("" : "+v"(t_)); ph_final(p, vb * 8 + (t_ >> 6), nwaves, t_ & 63); }
}

extern "C" void kernel_launch(void* const* d_in, const int* in_sizes, int n_in, void* d_out, int out_size, void* d_ws, size_t ws_size, hipStream_t stream) {
    if (n_in != 16 || out_size != M_ * DM || ws_size < WS_END) { fprintf(stderr, "kernel_launch: unexpected shapes (n_in %d, out %d, ws %zu)\n", n_in, out_size, ws_size); return; }
    Params p{};
    p.x = (const float*)d_in[0]; p.c = (const float*)d_in[1]; p.pos = (const int*)d_in[2]; p.w_ada = (const float*)d_in[3]; p.b_ada = (const float*)d_in[4];
    p.g_pre = (const float*)d_in[5]; p.g_post = (const float*)d_in[6]; p.w_in = (const float*)d_in[7]; p.g_q = (const float*)d_in[8]; p.w_uq = (const float*)d_in[9];
    p.g_kv = (const float*)d_in[10]; p.w_ukv = (const float*)d_in[11]; p.w_o_mla = (const float*)d_in[12]; p.w_o_moba = (const float*)d_in[13]; p.b_merge = (const float*)d_in[14]; p.w_out = (const float*)d_in[15];
    p.out = (float*)d_out; p.ws = (unsigned char*)d_ws;
    static int grid = 0;
    if (grid == 0) {
        int dev = 0, cus = 0, per_cu = 0;
        if (hipGetDevice(&dev) != hipSuccess || hipDeviceGetAttribute(&cus, hipDeviceAttributeMultiprocessorCount, dev) != hipSuccess) { fprintf(stderr, "kernel_launch: device query failed\n"); grid = -1; return; }
        if (hipFuncSetAttribute((const void*)mega, hipFuncAttributeMaxDynamicSharedMemorySize, LDS_BYTES) != hipSuccess) { fprintf(stderr, "kernel_launch: hipFuncSetAttribute failed\n"); grid = -1; return; }
        if (hipOccupancyMaxActiveBlocksPerMultiprocessor(&per_cu, (const void*)mega, 512, LDS_BYTES) != hipSuccess || per_cu < 1) { fprintf(stderr, "kernel_launch: occupancy query says %d\n", per_cu); }
        (void)hipGetLastError();
        grid = cus;
    }
    if (grid < 0) return;
    (void)hipMemsetAsync(d_ws, 0, ZERO_BYTES, stream);
    hipLaunchKernelGGL(mega, dim3(grid), dim3(512), LDS_BYTES, stream, p);
}
```

```cpp
#include <hip/hip_runtime.h>
#include <cstdio>
#ifndef PROBE
#define PROBE 0
#endif
#include <cstdint>

typedef _Float16 h16;
typedef _Float16 h16x4 __attribute__((ext_vector_type(4)));
typedef _Float16 h2n __attribute__((ext_vector_type(2)));

constexpr int NB = 16, SEQ = 4096, DM = 1024, M_ = NB * SEQ, NH = 8;
constexpr int D_IN = 5024;
constexpr int C_QLAT = 0, C_KVLAT = 256, C_KROPE = 384, C_ZMLA = 416, C_QMB = 928, C_KMB = 1440, C_VMB = 1952, C_ZMB = 2464, C_GA = 2976, C_GB = 4000;
constexpr float EPS = 1e-6f;
constexpr float LOG2E = 1.4426950408889634f;
constexpr float SC_MLA = 0.10206207261596577f * LOG2E;
constexpr float SC_MB = 0.125f * LOG2E;

constexpr size_t MiB = 1u << 20;
constexpr size_t WS_CTL = 0, WS_KMEAN = 512 * 1024, WS_SSQ = 1 * MiB, WS_SSQY = WS_SSQ + 2 * (size_t)M_ * 4, ZERO_BYTES = 2 * MiB;
constexpr size_t WS_MOD = WS_SSQ + 3 * (size_t)M_ * 4, WS_TAB = 4 * MiB, WS_WT = 20 * MiB;
constexpr size_t WS_H = 36 * MiB, WS_KN = 36 * MiB, WS_VM = 100 * MiB;
constexpr size_t WS_QLAT = 164 * MiB, WS_KVL = 196 * MiB, WS_KPE = 228 * MiB, WS_VMB = 232 * MiB;
constexpr size_t WS_QMB = 296 * MiB, WS_KMB = 360 * MiB, WS_ZCAT = 424 * MiB, WS_YM = 296 * MiB;
constexpr size_t WS_GA = 552 * MiB, WS_GB = 616 * MiB, WS_Y = 680 * MiB,     WS_QMLA = 808 * MiB, WS_END = 904 * MiB;

static_assert(WS_MOD + (size_t)NB * 3072 * 4 <= ZERO_BYTES, "MOD inside the zeroed region");
struct Params {
    const float *x, *c; const int* pos; const float *w_ada, *b_ada, *g_pre, *g_post, *w_in, *g_q, *w_uq, *g_kv, *w_ukv, *w_o_mla, *w_o_moba, *b_merge, *w_out;
    float* out; unsigned char* ws;
};

__device__ __forceinline__ float wave_sum(float v) {
#pragma unroll
    for (int o = 1; o < 64; o <<= 1) v += __shfl_xor(v, o);
    return v;
}
__device__ __forceinline__ float silu_f(float v) { return v / (1.f + __expf(-v)); }
__device__ __forceinline__ float sigmoid_f(float v) { return 1.f / (1.f + __expf(-v)); }

#define LAS __attribute__((address_space(3)))
__device__ void ph_tab(const Params& p, int gtid, int gsize);
__device__ void ph_prep(const Params& p, int gtid, int gsize, int vb, int nvb, LAS unsigned char* lds) {
    float* mod = (float*)(p.ws + WS_MOD);
    { const int tid = gtid - vb * 512; LAS float* sc = (LAS float*)lds; LAS float* part = (LAS float*)(lds + 65536);
      for (int i = tid; i < NB * DM; i += 512) { const float cv = p.c[i]; sc[i] = cv / (1.f + __expf(-cv)); }
      __syncthreads();
      for (int cg = vb; cg < 3072 / 12; cg += nvb) {
          if (tid < 384) { const int col = tid % 12, kc = tid / 12, j = cg * 12 + col, k0 = kc * 32;
              float w[32], acc[NB];
#pragma unroll
              for (int kk = 0; kk < 32; ++kk) w[kk] = p.w_ada[(size_t)(k0 + kk) * 3072 + j];
#pragma unroll
              for (int b = 0; b < NB; ++b) acc[b] = 0.f;
#pragma unroll
              for (int kk = 0; kk < 32; kk += 4) {
#pragma unroll
                  for (int b = 0; b < NB; ++b) { typedef float f4m __attribute__((ext_vector_type(4))); const f4m s4 = *(const LAS f4m*)(sc + b * DM + k0 + kk);
                      acc[b] = fmaf(s4.x, w[kk], acc[b]); acc[b] = fmaf(s4.y, w[kk + 1], acc[b]); acc[b] = fmaf(s4.z, w[kk + 2], acc[b]); acc[b] = fmaf(s4.w, w[kk + 3], acc[b]); } }
#pragma unroll
              for (int b = 0; b < NB; ++b) part[(kc * NB + b) * 12 + col] = acc[b]; }
          __syncthreads();
          if (tid < NB * 12) { const int b = tid / 12, c = tid % 12, j = cg * 12 + c; float s = p.b_ada[j];
#pragma unroll
              for (int kc = 0; kc < 32; ++kc) s += part[(kc * NB + b) * 12 + c];
              mod[b * 3072 + j] = s; }
          __syncthreads();
      } }
    ph_tab(p, gtid, gsize);
}
__device__ void ph_tab(const Params& p, int gtid, int gsize) {
    unsigned* tab = (unsigned*)(p.ws + WS_TAB);
    const int f = gtid & 31;
    const double c = exp2(-(double)f * (13.287712379549449 / 32.0)) * 0.15915494309189535;
    int ex; const double mant = frexp(c, &ex); const double c_hi_d = ldexp(rint(ldexp(mant, 11)), ex - 11);
    const float c_hi = (float)c_hi_d, c_lo = (float)(c - c_hi_d);
    for (int i = gtid; i < M_ * 32; i += gsize) {
        const float pos = (float)p.pos[i >> 5];
        float x = pos * c_hi; x = x - floorf(x); x = fmaf(pos, c_lo, x);
        typedef _Float16 h2t __attribute__((ext_vector_type(2))); h2t cs; cs[0] = (_Float16)__builtin_amdgcn_cosf(x); cs[1] = (_Float16)__builtin_amdgcn_sinf(x);
        tab[i] = __builtin_bit_cast(unsigned, cs);
    }
}

__device__ void ph_hnorm(const Params& p, int gwave, int nwaves, int lane) {
    constexpr int R = 4;
    typedef float f4 __attribute__((ext_vector_type(4)));
    const float* mod = (const float*)(p.ws + WS_MOD); h16* H = (h16*)(p.ws + WS_H);
    for (int m0 = R * gwave; m0 < M_; m0 += R * nwaves) {
        f4 v[R][4]; float ss[R];
#pragma unroll
        for (int r = 0; r < R; ++r) { const f4* xr = (const f4*)(p.x + (size_t)(m0 + r) * DM);
#pragma unroll
            for (int j = 0; j < 4; ++j) v[r][j] = __builtin_nontemporal_load(xr + lane + 64 * j); }
#pragma unroll
        for (int r = 0; r < R; ++r) { float s = 0.f;
#pragma unroll
            for (int j = 0; j < 4; ++j) s += (v[r][j][0] * v[r][j][0] + v[r][j][1] * v[r][j][1]) + (v[r][j][2] * v[r][j][2] + v[r][j][3] * v[r][j][3]);
            ss[r] = 1.f / sqrtf(wave_sum(s) * (1.f / DM) + EPS); }
        const int b = m0 >> 12;
#pragma unroll
        for (int j = 0; j < 4; ++j) {
            const int col = 4 * (lane + 64 * j);
            const float4 g = *(const float4*)(p.g_pre + col), sc = *(const float4*)(mod + b * 3072 + 1024 + col), sh = *(const float4*)(mod + b * 3072 + col);
            const float g0 = g.x * (1.f + sc.x), g1 = g.y * (1.f + sc.y), g2 = g.z * (1.f + sc.z), g3 = g.w * (1.f + sc.w);
#pragma unroll
            for (int r = 0; r < R; ++r) { const float rstd = ss[r]; const f4 x = v[r][j];
                h16x4 o; o[0] = (h16)(x[0] * rstd * g0 + sh.x); o[1] = (h16)(x[1] * rstd * g1 + sh.y); o[2] = (h16)(x[2] * rstd * g2 + sh.z); o[3] = (h16)(x[3] * rstd * g3 + sh.w);
                *(h16x4*)(H + (size_t)(m0 + r) * DM + col) = o; }
        }
    }
}

__device__ void ph_final(const Params& p, int gwave, int nwaves, int lane) {
    constexpr int R = 4; typedef float f4 __attribute__((ext_vector_type(4)));
    const float* mod = (const float*)(p.ws + WS_MOD); const h16* Y = (const h16*)(p.ws + WS_Y); const float* ssq = (const float*)(p.ws + WS_SSQY);
    for (int m0 = R * gwave; m0 < M_; m0 += R * nwaves) {
        const int b = m0 >> 12; h16x4 yv[R][4]; f4 xv[R][4]; float rs[R];
#pragma unroll
        for (int r = 0; r < R; ++r) { const h16x4* yr = (const h16x4*)(Y + (size_t)(m0 + r) * DM); const f4* xr = (const f4*)(p.x + (size_t)(m0 + r) * DM); rs[r] = ssq[m0 + r];
#pragma unroll
            for (int j = 0; j < 4; ++j) { yv[r][j] = yr[lane + 64 * j]; xv[r][j] = __builtin_nontemporal_load(xr + lane + 64 * j); } }
#pragma unroll
        for (int r = 0; r < R; ++r) rs[r] = 1.f / sqrtf(rs[r] * (1.f / DM) + EPS);
#pragma unroll
        for (int j = 0; j < 4; ++j) {
            const int col = 4 * (lane + 64 * j); const float4 g = *(const float4*)(p.g_post + col), gt = *(const float4*)(mod + b * 3072 + 2048 + col);
            const float g0 = g.x * gt.x, g1 = g.y * gt.y, g2 = g.z * gt.z, g3 = g.w * gt.w;
#pragma unroll
            for (int r = 0; r < R; ++r) { const h16x4 y = yv[r][j]; const f4 x = xv[r][j]; const float s = rs[r];
                f4 o; o[0] = x[0] + g0 * (float)y[0] * s; o[1] = x[1] + g1 * (float)y[1] * s; o[2] = x[2] + g2 * (float)y[2] * s; o[3] = x[3] + g3 * (float)y[3] * s;
                __builtin_nontemporal_store(o, (f4*)(p.out + (size_t)(m0 + r) * DM) + lane + 64 * j); }
        }
    }
}


#define XB_TMO      128
#define XB_XCNT(j)  (256  + 64 * (j))
#define XB_XSUB(j)  (1280 + 64 * (j))
#define XB_XGEN(j)  (2304 + 64 * (j))
#define XB_TOP      3328
#define XB_TOPGEN   3392
#define XCD_BAR_WORDS 3456
#define XB_SPIN_CAP (1u << 27)
__device__ __forceinline__ unsigned xb_ld(unsigned* p)              { return __hip_atomic_load(p, __ATOMIC_RELAXED, __HIP_MEMORY_SCOPE_AGENT); }
__device__ __forceinline__ unsigned xb_add(unsigned* p, unsigned v) { return __hip_atomic_fetch_add(p, v, __ATOMIC_RELAXED, __HIP_MEMORY_SCOPE_AGENT); }
__device__ __forceinline__ unsigned xb_xcc_id() { return (unsigned)__builtin_amdgcn_s_getreg((3 << 11) | 20) & 0xFu; }
#define XB_SPIN(cond, bar) do { unsigned _sp = 0; while (cond) { __builtin_amdgcn_s_sleep(1); \
    if ((++_sp & 255u) == 0u) { if (xb_ld(&(bar)[XB_TMO])) break; if (_sp > XB_SPIN_CAP) { atomicAdd(&(bar)[XB_TMO], 1u); break; } } } } while (0)
struct XcdBarrier { unsigned* bar; unsigned x; volatile LAS unsigned* st; };
__device__ __forceinline__ XcdBarrier xcd_barrier_post(unsigned* bar, volatile LAS unsigned* st) {
    XcdBarrier b; b.bar = bar; b.x = xb_xcc_id(); b.st = st;
    if (threadIdx.x == 0) (void)xb_add(&bar[XB_XCNT(b.x)], 1u);
    return b;
}
__device__ __forceinline__ void xcd_barrier_complete(unsigned* bar, unsigned x, unsigned& nloc, unsigned& nx) {
    const unsigned G = gridDim.x * gridDim.y * gridDim.z;
    unsigned sum, cnt, mine, sp = 0u;
    for (;;) {
        sum = 0u; cnt = 0u; mine = 0u;
#pragma unroll
        for (unsigned j = 0; j < 16; ++j) { const unsigned c = xb_ld(&bar[XB_XCNT(j)]); sum += c; cnt += (c > 0u) ? 1u : 0u; mine = (j == x) ? c : mine; }
        if (sum == G) break;
        __builtin_amdgcn_s_sleep(1);
        if ((++sp & 255u) == 0u) { if (xb_ld(&bar[XB_TMO])) break; if (sp > XB_SPIN_CAP) { atomicAdd(&bar[XB_TMO], 1u); break; } }
    }
    nloc = mine > 0u ? mine : 1u; nx = cnt > 0u ? cnt : 1u;
}
__device__ __forceinline__ void xcd_barrier(const XcdBarrier& b) {
    asm volatile("s_waitcnt vmcnt(0)" ::: "memory");
    __syncthreads();
    if (threadIdx.x == 0) {
        unsigned* bar = b.bar;
        __builtin_amdgcn_s_waitcnt(0);
        unsigned nloc = b.st[0], nx = b.st[1];
        if (nloc == 0u) { xcd_barrier_complete(bar, b.x, nloc, nx); b.st[0] = nloc; b.st[1] = nx; }
        const unsigned old = xb_add(&bar[XB_XSUB(b.x)], 1u);
        const unsigned gen = old / nloc;
        if (old + 1u == (gen + 1u) * nloc) {
            __builtin_amdgcn_fence(__ATOMIC_RELEASE, "agent");
            asm volatile("s_waitcnt vmcnt(0)" ::: "memory");
            const unsigned og = xb_add(&bar[XB_TOP], 1u);
            const unsigned tg = og / nx;
            if (og + 1u == (tg + 1u) * nx) xb_add(&bar[XB_TOPGEN], 1u);
            else XB_SPIN(xb_ld(&bar[XB_TOPGEN]) == tg, bar);
            __builtin_amdgcn_fence(__ATOMIC_ACQUIRE, "agent");
            xb_add(&bar[XB_XGEN(b.x)], 1u);
            asm volatile("s_waitcnt vmcnt(0)" ::: "memory");
        } else {
            XB_SPIN(xb_ld(&bar[XB_XGEN(b.x)]) == gen, bar);
            __builtin_amdgcn_fence(__ATOMIC_ACQUIRE, "agent");
            asm volatile("s_waitcnt vmcnt(0)" ::: "memory");
        }
    }
    __syncthreads();
}

namespace pg8 {
#define PG8_LAS __attribute__((address_space(3)))
typedef unsigned short bf16_t;
typedef _Float16 bf16x8 __attribute__((ext_vector_type(8)));
typedef float f32x4 __attribute__((ext_vector_type(4)));
typedef unsigned u32x4 __attribute__((ext_vector_type(4)));
constexpr int BM = 256, BK = 64, HALF = 128, HTB = HALF * BK * 2  , STAGE_BYTES = 8 * HTB, NXCD = 8, WGM = 8;

__host__ __device__ __forceinline__ int lds_byte(int r, int c) { const int st = (r >> 4) * 2 + (c >> 5), rr = r & 15, cc = c & 31, ob = rr * 64 + cc * 2; return st * 1024 + (ob ^ (((ob >> 9) & 1) << 5)); }
__host__ __device__ __forceinline__ void stage_rc(int b, int& R, int& C) { const int st = b / 1024, sb = b % 1024, swz = sb ^ (((sb >> 9) & 1) << 5); R = (st >> 1) * 16 + swz / 64; C = (st & 1) * 32 + (swz % 64) / 2; }
__host__ __device__ __forceinline__ int perm32(int rho) { const int n = rho >> 4, i = rho & 15; return 8 * (i >> 2) + 4 * n + (i & 3); }

struct Unit { int pm, pn; };
struct Gemm { const bf16_t* A; const bf16_t* Bt; int M, N, K; };

struct StaticOrder {
    int nM, nN, nwg, G, c;
    __host__ __device__ void init(int M, int N, int G_, int c_) { nM = M / BM; nN = N / BM; nwg = nM * nN; G = G_; c = c_; }
    __host__ __device__ bool next(int i, Unit& u) const {
        const long L = (long)i * G + c; if (L >= nwg) return false;
        int wgid = (int)L; { const int q = nwg / NXCD, r = nwg % NXCD, xcd = wgid % NXCD, off = wgid / NXCD; wgid = (xcd < r ? xcd * (q + 1) : r * (q + 1) + (xcd - r) * q) + off; }
        const int nig = WGM * nN, gid = wgid / nig, fm = gid * WGM, gsz = (nM - fm) < WGM ? (nM - fm) : WGM;
        u.pm = fm + ((wgid % nig) % gsz); u.pn = (wgid % nig) / gsz; return true;
    }
    __device__ __forceinline__ void a_ready(const Unit&) const {}
    __device__ __forceinline__ void done(const Unit&) const {}
};

template <class Epi, class Sched, bool ALIGN_EPI = false, bool SP2 = false>
__device__ __forceinline__ void gemm_phase(PG8_LAS unsigned char* lds, const Gemm g, const Sched& S, const Epi& E) {
    int tid_ = threadIdx.x; asm volatile("" : "+v"(tid_));
    const int tid = tid_, wid = __builtin_amdgcn_readfirstlane(tid >> 6), lane = tid & 63, wr = wid >> 2, wc = wid & 3, fr = lane & 15, fq = lane >> 4;
    const int K = g.K, nt = K / BK;
    unsigned voffA[2], voffB[2];
#pragma unroll
    for (int i = 0; i < 2; ++i) { int R, C; stage_rc(tid * 16 + i * 8192, R, C); const int Rb = Epi::PERM ? ((R & ~31) + perm32(R & 31)) : R;
        voffA[i] = (unsigned)(R * K + C) * 2u; voffB[i] = (unsigned)(Rb * K + C) * 2u; }
    const size_t kstep = (size_t)(BK * 2);
    const size_t hstep = (size_t)HALF * K * 2;
    const size_t tstep = 2 * hstep;
    const unsigned ldsw = (unsigned)wid * 1024u;
    const int aoff = lds_byte(wr * 64 + fr, fq * 8), boff = lds_byte(wc * 32 + fr, fq * 8);
#define PG8_SA(b, h) (((b) * 2 + (h)) * HTB)
#define PG8_SB(b, h) ((4 + (b) * 2 + (h)) * HTB)
#define PG8_STAGE(bufoff, gbase, voff) do { _Pragma("unroll") for (int _i = 0; _i < 2; ++_i) \
        __builtin_amdgcn_global_load_lds((const unsigned*)((const char*)(gbase) + (voff)[_i]), (PG8_LAS unsigned*)(lds + (bufoff) + ldsw + _i * 8192), 16, 0, 0); } while (0)
#define PG8_LDA(dst, b, h) do { _Pragma("unroll") for (int m = 0; m < 4; ++m) _Pragma("unroll") for (int k = 0; k < 2; ++k) dst[m][k] = *(const PG8_LAS bf16x8*)(lds + PG8_SA(b, h) + aoff + m * 2048 + k * 1024); } while (0)
#define PG8_LDB(dst, b, h) do { _Pragma("unroll") for (int n = 0; n < 2; ++n) _Pragma("unroll") for (int k = 0; k < 2; ++k) dst[n][k] = *(const PG8_LAS bf16x8*)(lds + PG8_SB(b, h) + boff + n * 2048 + k * 1024); } while (0)
#define PG8_MMA(ai, bj, At, Bt) do { __builtin_amdgcn_s_setprio(1); _Pragma("unroll") for (int m = 0; m < 4; ++m) _Pragma("unroll") for (int n = 0; n < 2; ++n) _Pragma("unroll") for (int k = 0; k < 2; ++k) \
        acc[ai][bj][m][n] = __builtin_amdgcn_mfma_f32_16x16x32_f16(Bt[n][k], At[m][k], acc[ai][bj][m][n], 0, 0, 0); __builtin_amdgcn_s_setprio(0); } while (0)
#define PG8_WAIT_V(n) asm volatile("s_waitcnt vmcnt(" #n ")" ::: "memory")
#define PG8_WAIT_L(n) asm volatile("s_waitcnt lgkmcnt(" #n ")" ::: "memory")
#define PG8_BAR __builtin_amdgcn_s_barrier()
#define PG8_SCHED __builtin_amdgcn_sched_barrier(0)
    Unit cur, nxt; int ui = 0;
    if (!S.next(0, cur)) return;
    f32x4 acc[2][2][4][2];
#pragma unroll
    for (int a = 0; a < 2; ++a)
#pragma unroll
        for (int b = 0; b < 2; ++b)
#pragma unroll
            for (int m = 0; m < 4; ++m)
#pragma unroll
                for (int n = 0; n < 2; ++n) acc[a][b][m][n] = (f32x4){0.f, 0.f, 0.f, 0.f};
    bf16x8 At[4][2], B0[2][2], B1[2][2];
    const char* cA = (const char*)g.A + (size_t)cur.pm * tstep; const char* cB = (const char*)g.Bt + (size_t)cur.pn * tstep;
    S.a_ready(cur);
    if constexpr (SP2) {
        PG8_STAGE(PG8_SB(0, 0), cB, voffB); PG8_STAGE(PG8_SB(0, 1), cB + hstep, voffB); PG8_STAGE(PG8_SA(0, 0), cA, voffA); PG8_STAGE(PG8_SA(0, 1), cA + hstep, voffA);
        if (wr == 1) PG8_BAR;
        PG8_WAIT_V(2); PG8_BAR;
        PG8_STAGE(PG8_SB(1, 0), cB + kstep, voffB); PG8_STAGE(PG8_SA(1, 0), cA + kstep, voffA); PG8_STAGE(PG8_SB(1, 1), cB + hstep + kstep, voffB);
        PG8_WAIT_V(6); PG8_BAR;
    } else {
        PG8_STAGE(PG8_SB(0, 0), cB, voffB); PG8_STAGE(PG8_SA(0, 0), cA, voffA); PG8_STAGE(PG8_SB(0, 1), cB + hstep, voffB); PG8_STAGE(PG8_SA(0, 1), cA + hstep, voffA);
        if (wr == 1) PG8_BAR;
        PG8_WAIT_V(4); PG8_BAR;
        PG8_STAGE(PG8_SB(1, 0), cB + kstep, voffB); PG8_STAGE(PG8_SA(1, 0), cA + kstep, voffA); PG8_STAGE(PG8_SB(1, 1), cB + hstep + kstep, voffB);
        PG8_WAIT_V(6); PG8_BAR;
    }
    for (;;) {
        const bool has_next = S.next(ui + 1, nxt);
        const char* nA = has_next ? (const char*)g.A + (size_t)nxt.pm * tstep : cA; const char* nB = has_next ? (const char*)g.Bt + (size_t)nxt.pn * tstep : cB;
#pragma nounroll
        for (int t = 0; t < nt; t += 2) {
            const bool last = (t == nt - 2);
            if constexpr (Epi::MID_T > 0) { if (t == Epi::MID_T) E.mid(acc, cur, wr, wc); }
            const char* a1 = cA + (size_t)(t + 1) * kstep;
            const char* a2 = last ? nA : cA + (size_t)(t + 2) * kstep; const char* b2 = last ? nB : cB + (size_t)(t + 2) * kstep;
            const char* a3 = a2 + kstep; const char* b3 = b2 + kstep;
            if (last && has_next) S.a_ready(nxt);
            if constexpr (SP2) {
            PG8_LDB(B0, 0, 0); PG8_LDB(B1, 0, 1); PG8_SCHED; PG8_LDA(At, 0, 0); PG8_STAGE(PG8_SA(1, 1), a1 + hstep, voffA);
            PG8_WAIT_V(8); PG8_WAIT_L(0); PG8_BAR; PG8_MMA(0, 0, At, B0); PG8_MMA(0, 1, At, B1); PG8_BAR; PG8_SCHED;
            PG8_LDA(At, 0, 1); PG8_STAGE(PG8_SB(0, 0), b2, voffB); PG8_STAGE(PG8_SB(0, 1), b2 + hstep, voffB); PG8_STAGE(PG8_SA(0, 0), a2, voffA);
            PG8_WAIT_V(8); PG8_WAIT_L(0); PG8_BAR; PG8_MMA(1, 0, At, B0); PG8_MMA(1, 1, At, B1); PG8_BAR; PG8_SCHED;
            PG8_LDB(B0, 1, 0); PG8_LDB(B1, 1, 1); PG8_SCHED; PG8_LDA(At, 1, 0); PG8_STAGE(PG8_SA(0, 1), a2 + hstep, voffA);
            PG8_WAIT_V(8); PG8_WAIT_L(0); PG8_BAR; PG8_MMA(0, 0, At, B0); PG8_MMA(0, 1, At, B1); PG8_BAR; PG8_SCHED;
            PG8_LDA(At, 1, 1); PG8_STAGE(PG8_SB(1, 0), b3, voffB); PG8_STAGE(PG8_SB(1, 1), b3 + hstep, voffB); PG8_STAGE(PG8_SA(1, 0), a3, voffA);
            PG8_WAIT_V(8); PG8_WAIT_L(0); PG8_BAR; PG8_MMA(1, 0, At, B0); PG8_MMA(1, 1, At, B1); PG8_BAR; PG8_SCHED;
            } else {
            PG8_LDB(B0, 0, 0); PG8_SCHED; PG8_LDA(At, 0, 0); PG8_STAGE(PG8_SA(1, 1), a1 + hstep, voffA);
            PG8_WAIT_L(8); PG8_BAR; PG8_WAIT_L(0); PG8_MMA(0, 0, At, B0); PG8_BAR; PG8_SCHED;
            PG8_LDB(B1, 0, 1); PG8_STAGE(PG8_SB(0, 0), b2, voffB);
            PG8_BAR; PG8_WAIT_L(0); PG8_MMA(0, 1, At, B1); PG8_BAR;
            PG8_LDA(At, 0, 1); PG8_STAGE(PG8_SA(0, 0), a2, voffA);
            PG8_BAR; PG8_WAIT_L(0); PG8_MMA(1, 0, At, B0); PG8_BAR; PG8_SCHED;
            PG8_STAGE(PG8_SB(0, 1), b2 + hstep, voffB);
            PG8_WAIT_V(6); PG8_BAR; PG8_MMA(1, 1, At, B1); PG8_BAR;
            PG8_LDB(B0, 1, 0); PG8_SCHED; PG8_LDA(At, 1, 0); PG8_STAGE(PG8_SA(0, 1), a2 + hstep, voffA);
            PG8_WAIT_L(8); PG8_BAR; PG8_WAIT_L(0); PG8_MMA(0, 0, At, B0); PG8_BAR; PG8_SCHED;
            PG8_LDB(B1, 1, 1); PG8_STAGE(PG8_SB(1, 0), b3, voffB);
            PG8_BAR; PG8_WAIT_L(0); PG8_MMA(0, 1, At, B1); PG8_BAR;
            PG8_LDA(At, 1, 1); PG8_STAGE(PG8_SA(1, 0), a3, voffA);
            PG8_BAR; PG8_WAIT_L(0); PG8_MMA(1, 0, At, B0); PG8_BAR; PG8_SCHED;
            PG8_STAGE(PG8_SB(1, 1), b3 + hstep, voffB);
            PG8_WAIT_V(6); PG8_BAR; PG8_MMA(1, 1, At, B1); PG8_BAR;
            }
        }
        if constexpr (ALIGN_EPI) { if (wr == 0) PG8_BAR; }
        if constexpr (!Epi::AFTER_DRAIN) { E(acc, cur, wr, wc, fr, fq); S.done(cur); }
        if (!has_next) break;
#pragma unroll
        for (int a = 0; a < 2; ++a)
#pragma unroll
            for (int b = 0; b < 2; ++b)
#pragma unroll
                for (int m = 0; m < 4; ++m)
#pragma unroll
                    for (int n = 0; n < 2; ++n) acc[a][b][m][n] = (f32x4){0.f, 0.f, 0.f, 0.f};
        cur = nxt; cA = nA; cB = nB; ++ui;
        if constexpr (ALIGN_EPI) { if (wr == 1) PG8_BAR; }
    }
    PG8_WAIT_V(0);
    if constexpr (!ALIGN_EPI) { if (wr == 0) PG8_BAR; }
    PG8_BAR;
    if constexpr (Epi::AFTER_DRAIN) { E.fused(acc, cur, wr, wc, fr, fq, lds, wid, lane); S.done(cur); }
#undef PG8_SA
#undef PG8_SB
#undef PG8_STAGE
#undef PG8_LDA
#undef PG8_LDB
#undef PG8_MMA
#undef PG8_WAIT_V
#undef PG8_WAIT_L
#undef PG8_BAR
#undef PG8_SCHED
}
typedef _Float16 h8v __attribute__((ext_vector_type(8)));
typedef unsigned u32x2 __attribute__((ext_vector_type(2)));
typedef _Float16 h2v __attribute__((ext_vector_type(2)));
__device__ __forceinline__ unsigned pk_h2(float lo, float hi) { h2v v; v[0] = (_Float16)lo; v[1] = (_Float16)hi; return __builtin_bit_cast(unsigned, v); }
__device__ __forceinline__ u32x4 pack8(const f32x4& a, const f32x4& b) { u32x4 w; w.x = pk_h2(a[0], a[1]); w.y = pk_h2(a[2], a[3]); w.z = pk_h2(b[0], b[1]); w.w = pk_h2(b[2], b[3]); return w; }
__device__ __forceinline__ float sigm1(float v) { return __builtin_amdgcn_rcpf(1.f + __builtin_amdgcn_exp2f(v * -1.4426950408889634f)); }
__device__ __forceinline__ float silu1(float v) { return v * sigm1(v); }
__device__ __forceinline__ f32x4 silu4(const f32x4& v) { return (f32x4){silu1(v[0]), silu1(v[1]), silu1(v[2]), silu1(v[3])}; }
__device__ __forceinline__ f32x4 sigm4(const f32x4& v) { return (f32x4){sigm1(v[0]), sigm1(v[1]), sigm1(v[2]), sigm1(v[3])}; }

#define PG8_OPAQUE(fr_, fq_) int lane_x; asm volatile("v_mbcnt_lo_u32_b32 %0, -1, 0\n\tv_mbcnt_hi_u32_b32 %0, -1, %0" : "=v"(lane_x)); const int frx = lane_x & 15, fqx = lane_x >> 4
__device__ __forceinline__ void st16(unsigned char* base, unsigned off, const u32x4& v) { *(u32x4*)(base + off) = v; }
__device__ __forceinline__ f32x4 ld16f(const unsigned char* base, unsigned off) { return *(const f32x4*)(base + off); }
__device__ __forceinline__ float ld4f(const unsigned char* base, unsigned off) { return *(const float*)(base + off); }
__device__ __forceinline__ h8v ld16h(const unsigned char* base, unsigned off) { return *(const h8v*)(base + off); }
__device__ __forceinline__ float sumsq8(const f32x4& a, const f32x4& b) { return (a[0] * a[0] + a[1] * a[1]) + (a[2] * a[2] + a[3] * a[3]) + (b[0] * b[0] + b[1] * b[1]) + (b[2] * b[2] + b[3] * b[3]); }
__device__ __forceinline__ void rope4(const f32x4& t1, const f32x4& t2, const u32x4& cs, f32x4& o1, f32x4& o2) {
#pragma unroll
    for (int j = 0; j < 4; ++j) { const unsigned wj = cs[j]; h2v w; __builtin_memcpy(&w, &wj, 4);
        const float c = (float)w[0], s = (float)w[1]; o1[j] = t1[j] * c - t2[j] * s; o2[j] = t2[j] * c + t1[j] * s; }
}
__device__ __forceinline__ u32x4 ld16u(const unsigned char* base, unsigned off) { return *(const u32x4*)(base + off); }

struct EpiInF {
    static constexpr bool PERM = true, AFTER_DRAIN = false; static constexpr int MID_T = 0;
    unsigned char* ws; const float* b_merge; int noatomic;
    template <bool ISQ> __device__ __forceinline__ void rope_tile(const f32x4 (&acc)[2][2][4][2], const Unit& u, int wr, int wc, int frx, int fqx) const {
        const int pn = u.pn; const unsigned row0 = (unsigned)(u.pm * 256 + wr * 64) + (unsigned)frx; const float sc = ISQ ? SC_MB : 1.f;
        unsigned char* dst = ws + (ISQ ? WS_QMB : WS_KMB); const unsigned char* tab = ws + WS_TAB;
        const unsigned o0 = row0 * 1024u + (((pn & 1) ? 256u : 0u) + 64u * wc + 8u * fqx) * 2u, t0 = row0 * 128u + 32u * fqx;
        f32x4 c1[2] = {{0.f, 0.f, 0.f, 0.f}, {0.f, 0.f, 0.f, 0.f}}, c2[2] = {{0.f, 0.f, 0.f, 0.f}, {0.f, 0.f, 0.f, 0.f}};
        u32x4 cs[2][4][2];
#pragma unroll
        for (int ai = 0; ai < 2; ++ai)
#pragma unroll
            for (int m = 0; m < 4; ++m) { const unsigned to = t0 + (unsigned)(ai * 128 + m * 16) * 128u; cs[ai][m][0] = ld16u(tab, to); cs[ai][m][1] = ld16u(tab, to + 16u); }
#pragma unroll
        for (int ai = 0; ai < 2; ++ai)
#pragma unroll
            for (int m = 0; m < 4; ++m) { const unsigned ro = o0 + (unsigned)(ai * 128 + m * 16) * 1024u;
                f32x4 o1[2], o2[2];
#pragma unroll
                for (int n = 0; n < 2; ++n) { rope4(acc[ai][0][m][n], acc[ai][1][m][n], cs[ai][m][n], o1[n], o2[n]);
                    if (!ISQ) { c1[n] += o1[n]; c2[n] += o2[n]; } }
                st16(dst, ro, pack8(o1[0] * sc, o1[1] * sc)); st16(dst, ro + 64u, pack8(o2[0] * sc, o2[1] * sc));
                if (!ISQ) asm volatile("" : "+v"(c1[0]), "+v"(c1[1]), "+v"(c2[0]), "+v"(c2[1])); }
        if (!ISQ) {
            float* km = (float*)(ws + WS_KMEAN) + (size_t)u.pm * 512 + ((pn & 1) ? 256 : 0) + 64 * wc + 8 * fqx;
#pragma unroll
            for (int n = 0; n < 2; ++n)
#pragma unroll
                for (int j = 0; j < 4; ++j) { float a = c1[n][j], b = c2[n][j];
#pragma unroll
                    for (int o = 1; o < 16; o <<= 1) { a += __shfl_xor(a, o); b += __shfl_xor(b, o); }
                    if (frx == 0 && !noatomic) { atomicAdd(km + 4 * n + j, a * (1.f / 256.f)); atomicAdd(km + 32 + 4 * n + j, b * (1.f / 256.f)); } }
        }
    }
    __device__ __forceinline__ void operator()(const f32x4 (&acc)[2][2][4][2], const Unit& u, int wr, int wc, int fr, int fq) const {
        PG8_OPAQUE(fr, fq);
        const int pn = u.pn; const unsigned row0 = (unsigned)(u.pm * 256 + wr * 64) + (unsigned)frx, cl = 32u * wc + 8u * fqx;
        if (pn == 0) {
            unsigned char* dst = ws + WS_QLAT; float* ssq = (float*)(ws + WS_SSQ); const unsigned o0 = row0 * 512u + cl * 2u;
#pragma unroll
            for (int ai = 0; ai < 2; ++ai)
#pragma unroll
                for (int m = 0; m < 4; ++m) { const unsigned ro = o0 + (unsigned)(ai * 128 + m * 16) * 512u; float s = 0.f;
#pragma unroll
                    for (int bj = 0; bj < 2; ++bj) { s += sumsq8(acc[ai][bj][m][0], acc[ai][bj][m][1]); st16(dst, ro + bj * 256u, pack8(acc[ai][bj][m][0], acc[ai][bj][m][1])); }
                    s += __shfl_xor(s, 16); s += __shfl_xor(s, 32);
                    if (fqx == 0 && !noatomic) atomicAdd(ssq + (row0 + ai * 128 + m * 16), s); }
        } else if (pn == 1) {
            unsigned char* kvl = ws + WS_KVL; unsigned char* kpe = ws + WS_KPE; float* ssq = (float*)(ws + WS_SSQ) + M_; const unsigned char* tab = ws + WS_TAB;
#pragma unroll
            for (int ai = 0; ai < 2; ++ai)
#pragma unroll
                for (int m = 0; m < 4; ++m) { const unsigned row = row0 + ai * 128 + m * 16;
                    if (wc < 2) { float s = 0.f;
#pragma unroll
                        for (int bj = 0; bj < 2; ++bj) { s += sumsq8(acc[ai][bj][m][0], acc[ai][bj][m][1]); st16(kvl, row * 256u + (bj * 64u + cl) * 2u, pack8(acc[ai][bj][m][0], acc[ai][bj][m][1])); }
                        s += __shfl_xor(s, 16); s += __shfl_xor(s, 32);
                        if (fqx == 0 && !noatomic) atomicAdd(ssq + row, s);
                    } else {
                        if (wc == 2 && fqx < 2) {
                            f32x4 o1[2], o2[2];
#pragma unroll
                            for (int n = 0; n < 2; ++n) { const unsigned to = row * 128u + (unsigned)(16 * fqx + 8 * n) * 4u; const u32x4 wa = ld16u(tab, to), wb = ld16u(tab, to + 16u);
                                rope4(acc[ai][0][m][n], acc[ai][1][m][n], (u32x4){wa[0], wa[2], wb[0], wb[2]}, o1[n], o2[n]); }
                            st16(kpe, row * 64u + 16u * fqx, pack8(o1[0], o1[1])); st16(kpe, row * 64u + 32u + 16u * fqx, pack8(o2[0], o2[1]));
                        }
                    }
                    asm volatile("" ::: "memory"); }
        } else if (pn < 4 || (pn >= 8 && pn < 12)) {
            const bool act = (pn < 4) || (pn >= 10); const unsigned pitch = act ? 2048u : 1024u;
            unsigned char* dst = ws + (act ? WS_ZCAT : WS_VMB); const unsigned o0 = row0 * pitch + ((pn >= 10 ? 512u : 0u) + ((pn & 1) ? 256u : 0u) + cl) * 2u;
#pragma unroll
            for (int ai = 0; ai < 2; ++ai)
#pragma unroll
                for (int m = 0; m < 4; ++m) { const unsigned ro = o0 + (unsigned)(ai * 128 + m * 16) * pitch;
#pragma unroll
                    for (int bj = 0; bj < 2; ++bj) { f32x4 a = acc[ai][bj][m][0], b = acc[ai][bj][m][1]; if (act) { a = silu4(a); b = silu4(b); }
                        st16(dst, ro + bj * 256u, pack8(a, b)); } }
        } else if (pn < 6) { rope_tile<true>(acc, u, wr, wc, frx, fqx);
        } else if (pn < 8) { rope_tile<false>(acc, u, wr, wc, frx, fqx);
        } else {
            const bool isa = pn < 16; unsigned char* dst = ws + (isa ? WS_GA : WS_GB); const unsigned cg = 256u * ((pn - 12) & 3) + cl;
            const unsigned char* bm = (const unsigned char*)(b_merge + (isa ? 0 : 1024)); const unsigned o0 = row0 * 1024u + cg;
            f32x4 bv[2][2];
#pragma unroll
            for (int bj = 0; bj < 2; ++bj)
#pragma unroll
                for (int n = 0; n < 2; ++n) bv[bj][n] = ld16f(bm, (cg + bj * 128u + 4u * n) * 4u);
#pragma unroll
            for (int ai = 0; ai < 2; ++ai)
#pragma unroll
                for (int m = 0; m < 4; ++m) { const unsigned ro = o0 + (unsigned)(ai * 128 + m * 16) * 1024u;
#pragma unroll
                    for (int bj = 0; bj < 2; ++bj) { const f32x4 a = sigm4(acc[ai][bj][m][0] + bv[bj][0]) * 255.f + 0.5f, b = sigm4(acc[ai][bj][m][1] + bv[bj][1]) * 255.f + 0.5f;
                        u32x2 w; w.x = (unsigned)a[0] | ((unsigned)a[1] << 8) | ((unsigned)a[2] << 16) | ((unsigned)a[3] << 24); w.y = (unsigned)b[0] | ((unsigned)b[1] << 8) | ((unsigned)b[2] << 16) | ((unsigned)b[3] << 24);
                        *(u32x2*)(dst + (ro + bj * 128u)) = w; } }
        }
    }
};
struct EpiNull {
    static constexpr bool PERM = true, AFTER_DRAIN = false; static constexpr int MID_T = 0;
    __device__ __forceinline__ void operator()(const f32x4 (&acc)[2][2][4][2], const Unit& u, int wr, int wc, int fr, int fq) const {
#pragma unroll
        for (int ai = 0; ai < 2; ++ai)
#pragma unroll
            for (int bj = 0; bj < 2; ++bj)
#pragma unroll
                for (int m = 0; m < 4; ++m) asm volatile("" :: "v"(acc[ai][bj][m][0]), "v"(acc[ai][bj][m][1]));
    }
};
struct EpiUqF {
    static constexpr bool PERM = true, AFTER_DRAIN = false; static constexpr int MID_T = 0;
    unsigned char* ws;
    __device__ __forceinline__ void operator()(const f32x4 (&acc)[2][2][4][2], const Unit& u, int wr, int wc, int fr, int fq) const {
        PG8_OPAQUE(fr, fq);
        const int pn = u.pn; const unsigned row0 = (unsigned)(u.pm * 256 + wr * 64) + (unsigned)frx; unsigned char* Q = ws + WS_QMLA; const unsigned char* ssq = ws + WS_SSQ; const unsigned char* tab = ws + WS_TAB;
        float rsv[2][4];
#pragma unroll
        for (int ai = 0; ai < 2; ++ai)
#pragma unroll
            for (int m = 0; m < 4; ++m) rsv[ai][m] = ld4f(ssq, (row0 + ai * 128 + m * 16) * 4u);
#pragma unroll
        for (int ai = 0; ai < 2; ++ai)
#pragma unroll
            for (int m = 0; m < 4; ++m) { const unsigned row = row0 + ai * 128 + m * 16; const float rs = SC_MLA * __builtin_amdgcn_rsqf(rsv[ai][m] * (1.f / 256.f) + EPS);
                if (pn < 2) {
#pragma unroll
                    for (int bj = 0; bj < 2; ++bj) { const unsigned head = 4u * pn + 2u * bj + (wc >> 1), d = 32u * (wc & 1) + 8u * fqx;
                        st16(Q, row * 1536u + (96u * head + d) * 2u, pack8(acc[ai][bj][m][0] * rs, acc[ai][bj][m][1] * rs)); }
                } else { const unsigned head = 2u * wc + ((unsigned)fqx >> 1), i0 = 8u * (fqx & 1); f32x4 o1[2], o2[2];
#pragma unroll
                    for (int n = 0; n < 2; ++n) { const unsigned to = row * 128u + (2u * (i0 + 4u * n)) * 4u; const u32x4 wa = ld16u(tab, to), wb = ld16u(tab, to + 16u);
                        rope4(acc[ai][0][m][n] * rs, acc[ai][1][m][n] * rs, (u32x4){wa[0], wa[2], wb[0], wb[2]}, o1[n], o2[n]); }
                    st16(Q, row * 1536u + (96u * head + 64u + i0) * 2u, pack8(o1[0], o1[1])); st16(Q, row * 1536u + (96u * head + 80u + i0) * 2u, pack8(o2[0], o2[1])); } }
    }
};
struct EpiUkvF {
    static constexpr bool PERM = true, AFTER_DRAIN = false; static constexpr int MID_T = 0;
    unsigned char* ws;
    __device__ __forceinline__ void operator()(const f32x4 (&acc)[2][2][4][2], const Unit& u, int wr, int wc, int fr, int fq) const {
        PG8_OPAQUE(fr, fq);
        const int pn = u.pn; const unsigned row0 = (unsigned)(u.pm * 256 + wr * 64) + (unsigned)frx; unsigned char* dst = ws + (pn < 2 ? WS_KN : WS_VM); const unsigned char* ssq = ws + WS_SSQ + (size_t)M_ * 4;
        float rsv[2][4];
#pragma unroll
        for (int ai = 0; ai < 2; ++ai)
#pragma unroll
            for (int m = 0; m < 4; ++m) rsv[ai][m] = ld4f(ssq, (row0 + ai * 128 + m * 16) * 4u);
#pragma unroll
        for (int ai = 0; ai < 2; ++ai)
#pragma unroll
            for (int m = 0; m < 4; ++m) { const unsigned row = row0 + ai * 128 + m * 16; const float rs = __builtin_amdgcn_rsqf(rsv[ai][m] * (1.f / 128.f) + EPS);
#pragma unroll
                for (int bj = 0; bj < 2; ++bj) { const unsigned head = 4u * (pn & 1) + 2u * bj + (wc >> 1), d = 32u * (wc & 1) + 8u * fqx;
                    st16(dst, row * 1024u + (64u * head + d) * 2u, pack8(acc[ai][bj][m][0] * rs, acc[ai][bj][m][1] * rs)); } }
    }
};
struct EpiYcatF {
    static constexpr bool PERM = true, AFTER_DRAIN = false; static constexpr int MID_T = 8;
    unsigned char* ws;
    template <bool MID> __device__ __forceinline__ void run(f32x4 (&acc)[2][2][4][2], const Unit& u, int wr, int wc) const {
        PG8_OPAQUE(0, 0);
        const unsigned row0 = (unsigned)(u.pm * 256 + wr * 64) + (unsigned)frx, c0 = u.pn * 256u + 32u * wc + 8u * fqx, o0 = row0 * 2048u + c0 * 2u, g0 = row0 * 1024u + c0;
        const unsigned char* GA = ws + WS_GA; const unsigned char* GB = ws + WS_GB; unsigned char* YM = ws + WS_YM;
#pragma unroll
        for (int ai = 0; ai < 2; ++ai) {
            u32x2 ga[4][2], gb[4][2];
#pragma unroll
            for (int m = 0; m < 4; ++m)
#pragma unroll
                for (int bj = 0; bj < 2; ++bj) { const unsigned go = g0 + (unsigned)(ai * 128 + m * 16) * 1024u + bj * 128u; gb[m][bj] = *(const u32x2*)(GB + go); if (MID) ga[m][bj] = *(const u32x2*)(GA + go); }
#pragma unroll
            for (int m = 0; m < 4; ++m)
#pragma unroll
                for (int bj = 0; bj < 2; ++bj) { const unsigned off = o0 + (unsigned)(ai * 128 + m * 16) * 2048u + bj * 256u; f32x4 s0, s1;
#pragma unroll
                    for (int j = 0; j < 4; ++j) { const float b0 = fmaxf((float)((gb[m][bj].x >> (8 * j)) & 0xffu), 0.5f), b1 = fmaxf((float)((gb[m][bj].y >> (8 * j)) & 0xffu), 0.5f);
                        s0[j] = MID ? (float)((ga[m][bj].x >> (8 * j)) & 0xffu) * __builtin_amdgcn_rcpf(b0) : b0 * (1.f / 255.f);
                        s1[j] = MID ? (float)((ga[m][bj].y >> (8 * j)) & 0xffu) * __builtin_amdgcn_rcpf(b1) : b1 * (1.f / 255.f); }
                    acc[ai][bj][m][0] *= s0; acc[ai][bj][m][1] *= s1;
                    if (!MID) st16(YM, off, pack8(acc[ai][bj][m][0], acc[ai][bj][m][1])); }
            asm volatile("" ::: "memory"); }
    }
    __device__ __forceinline__ void mid(f32x4 (&acc)[2][2][4][2], const Unit& u, int wr, int wc) const { run<true>(acc, u, wr, wc); }
    __device__ __forceinline__ void operator()(f32x4 (&acc)[2][2][4][2], const Unit& u, int wr, int wc, int fr, int fq) const { run<false>(acc, u, wr, wc); }
};
struct EpiYF {
    static constexpr bool PERM = true, AFTER_DRAIN = false; static constexpr int MID_T = 0;
    unsigned char* ws;
    __device__ __forceinline__ void operator()(const f32x4 (&acc)[2][2][4][2], const Unit& u, int wr, int wc, int fr, int fq) const {
        PG8_OPAQUE(fr, fq);
        const unsigned row0 = (unsigned)(u.pm * 256 + wr * 64) + (unsigned)frx, c0 = u.pn * 256u + 32u * wc + 8u * fqx, o0 = row0 * 2048u + c0 * 2u; unsigned char* Y = ws + WS_Y; float* ssq = (float*)(ws + WS_SSQY);
#pragma unroll
        for (int ai = 0; ai < 2; ++ai)
#pragma unroll
            for (int m = 0; m < 4; ++m) { float s = 0.f;
#pragma unroll
                for (int bj = 0; bj < 2; ++bj) { s += sumsq8(acc[ai][bj][m][0], acc[ai][bj][m][1]); st16(Y, o0 + (unsigned)(ai * 128 + m * 16) * 2048u + bj * 256u, pack8(acc[ai][bj][m][0], acc[ai][bj][m][1])); }
                s += __shfl_xor(s, 16); s += __shfl_xor(s, 32);
                if (fqx == 0) atomicAdd(ssq + (row0 + ai * 128 + m * 16), s); }
    }
};
}

struct MapIn { __device__ int operator()(int n) const { const int t = n >> 8, tc = n & 255, bj = tc >> 7, uu = tc & 127;
    if (t == 0) return n;
    if (t == 1) return uu < 64 ? C_KVLAT + 64 * bj + uu : (uu < 80 ? C_KROPE + 16 * bj + (uu - 64) : -1);
    if (t < 4) return C_ZMLA + (n - 512);
    if (t < 8) return (t < 6 ? C_QMB : C_KMB) + 256 * (t & 1) + 64 * (uu >> 5) + 32 * bj + (uu & 31);
    if (t < 10) return C_VMB + (n - 2048);
    if (t < 12) return C_ZMB + (n - 2560);
    if (t < 16) return C_GA + (n - 3072);
    return C_GB + (n - 4096); } };
struct MapUq { __device__ int operator()(int n) const { const int t = n >> 8, tc = n & 255, bj = tc >> 7, uu = tc & 127;
    if (t < 2) return 96 * (4 * t + (tc >> 6)) + (tc & 63);
    return 96 * (uu >> 4) + 64 + 16 * bj + (uu & 15); } };
struct MapUkv { __device__ int operator()(int n) const { const int t = n >> 8, tc = n & 255; return 128 * (4 * (t & 1) + (tc >> 6)) + (t < 2 ? 0 : 64) + (tc & 63); } };
struct MapId { __device__ int operator()(int n) const { return n; } };
template <class Map> __device__ __forceinline__ void wt_items(const float* W, int ldw, int Kreal, int K, int N, unsigned short* WT, const float* kscale, Map map, LAS float* scr, int gw, int ngw, int lane, int ldk = 0, int koff = 0) {
    if (ldk == 0) ldk = K;
    const int nblk = N / 64, nitems = (K / 32) * nblk; typedef float f4 __attribute__((ext_vector_type(4)));
    for (int it = gw; it < nitems; it += ngw) {
        const int kb = it / nblk, nb = it % nblk, k0 = 32 * kb, n0 = 64 * nb; const int src = map(n0 + 4 * (lane & 15));
        f4 wv[8];
#pragma unroll
        for (int i = 0; i < 8; ++i) { const int k = k0 + 4 * i + (lane >> 4); wv[i] = (src >= 0 && k < Kreal) ? *(const f4*)(W + (size_t)k * ldw + src) : (f4){0.f, 0.f, 0.f, 0.f}; }
#pragma unroll
        for (int i = 0; i < 8; ++i) { const int kk = 4 * i + (lane >> 4), k = k0 + kk; f4 v = wv[i]; if (kscale && k < Kreal) v = v * kscale[k]; *(LAS f4*)(scr + kk * 68 + 4 * (lane & 15)) = v; }
        asm volatile("s_waitcnt lgkmcnt(0)" ::: "memory");
#pragma unroll
        for (int j = 0; j < 4; ++j) { const int q = lane + 64 * j, n = q >> 2, c = q & 3; const LAS float* s = scr + (8 * c) * 68 + n;
            pg8::u32x4 o; o.x = pg8::pk_h2(s[0 * 68], s[1 * 68]); o.y = pg8::pk_h2(s[2 * 68], s[3 * 68]); o.z = pg8::pk_h2(s[4 * 68], s[5 * 68]); o.w = pg8::pk_h2(s[6 * 68], s[7 * 68]);
            *(pg8::u32x4*)(WT + (size_t)(n0 + n) * ldk + koff + k0 + 8 * c) = o; }
        asm volatile("s_waitcnt lgkmcnt(0)" ::: "memory");
    }
}
constexpr size_t WT_IN = WS_WT, WT_UQ = WS_WT + 10 * MiB, WT_UKV = WT_UQ + 512 * 1024, WT_OA = WS_WT + 11 * MiB, WT_OB = WS_WT + 12 * MiB, WT_OUT = WS_WT + 13 * MiB;
__device__ __forceinline__ void ph_weights(const Params& p, LAS unsigned char* lds, int gw, int ngw, int wave, int lane) {
    LAS float* scr = (LAS float*)(lds + wave * 16384);
    wt_items(p.w_in, D_IN, 1024, 1024, 5120, (unsigned short*)(p.ws + WT_IN), nullptr, MapIn(), scr, gw, ngw, lane);
    wt_items(p.w_uq, 768, 256, 256, 768, (unsigned short*)(p.ws + WT_UQ), p.g_q, MapUq(), scr, gw, ngw, lane);
    wt_items(p.w_ukv, 1024, 128, 128, 1024, (unsigned short*)(p.ws + WT_UKV), p.g_kv, MapUkv(), scr, gw, ngw, lane);
    wt_items(p.w_o_mla, 1024, 512, 512, 1024, (unsigned short*)(p.ws + WT_OA), nullptr, MapId(), scr, gw, ngw, lane, 1024, 0);
    wt_items(p.w_o_moba, 1024, 512, 512, 1024, (unsigned short*)(p.ws + WT_OA), nullptr, MapId(), scr, gw, ngw, lane, 1024, 512);
    wt_items(p.w_out, 1024, 1024, 1024, 1024, (unsigned short*)(p.ws + WT_OUT), nullptr, MapId(), scr, gw, ngw, lane);
}

namespace att {
struct T1 { static constexpr bool value = true; }; struct T0 { static constexpr bool value = false; };
typedef _Float16 h8 __attribute__((ext_vector_type(8)));
typedef short s4 __attribute__((ext_vector_type(4)));
typedef short s8 __attribute__((ext_vector_type(8)));
typedef float f16v __attribute__((ext_vector_type(16)));
typedef unsigned u4 __attribute__((ext_vector_type(4)));
typedef short v4i16_t __attribute__((ext_vector_type(4)));
constexpr int KBUF = 16384, VBUF = 8192;
constexpr int NBUF = 4;
constexpr int L_K = 0, L_V = NBUF * KBUF, L_WS = L_V + NBUF * VBUF, L_TB = L_WS + 8 * 256, L_UN = L_TB + 256, L_END = L_UN + 64, L_OST = 0;
constexpr float THR = 8.f;
#ifndef PROBE_ABL
#define PROBE_ABL 0
#endif
#ifndef ATT_STAGGER
#define ATT_STAGGER 0
#endif
constexpr bool STAGGER = ATT_STAGGER;
__device__ __forceinline__ int crow(int r, int hi) { return (r & 3) + 8 * (r >> 2) + 4 * hi; }
template <int DK> __device__ __forceinline__ int kaddr(int row, int ch) { return DK == 64 ? row * 128 + ((ch ^ ((row >> 1) & 7)) << 4) : row * 256 + ((ch ^ (row & 15)) << 4); }
__device__ __forceinline__ s4 vtr(const LAS unsigned char* p) { return __builtin_bit_cast(s4, __builtin_amdgcn_ds_read_tr16_b64_v4i16((LAS v4i16_t*)p)); }
__device__ __forceinline__ float swapmax(float m) { auto rr = __builtin_amdgcn_permlane32_swap(__float_as_uint(m), __float_as_uint(m), false, false); return fmaxf(__uint_as_float(rr[0]), __uint_as_float(rr[1])); }
__device__ __forceinline__ float swapsum(float m) { auto rr = __builtin_amdgcn_permlane32_swap(__float_as_uint(m), __float_as_uint(m), false, false); return __uint_as_float(rr[0]) + __uint_as_float(rr[1]); }
__device__ __forceinline__ void glds16(const void* g, unsigned lds_base) { unsigned sv;
    asm volatile("s_mov_b32 %0, m0\n\ts_mov_b32 m0, %2\n\ts_nop 0\n\tglobal_load_lds_dwordx4 %1, off\n\ts_mov_b32 m0, %0" : "=&s"(sv) : "v"(g), "s"(lds_base) : "memory"); }
__device__ __forceinline__ float max3f(float a, float b, float c) { float r; asm("v_max3_f32 %0, %1, %2, %3" : "=v"(r) : "v"(a), "v"(b), "v"(c)); return r; }
__device__ __forceinline__ unsigned pkh(float lo, float hi) { typedef _Float16 h2 __attribute__((ext_vector_type(2))); h2 v; v[0] = (_Float16)lo; v[1] = (_Float16)hi; return __builtin_bit_cast(unsigned, v); }

template <int DK, bool MOBA, int ABL = 0>
__device__ __forceinline__ void attn_unit(unsigned char* ws, int b, int h, int qb, LAS unsigned char* lds, bool dry = false) {
    constexpr int ND = DK / 16, QP = MOBA ? 512 : 768, QH = MOBA ? 64 : 96;
    int tid_ = threadIdx.x; asm volatile("" : "+v"(tid_));
    const int tid = tid_, lane = tid & 63, r32 = lane & 31, hi = lane >> 5; const int wid = __builtin_amdgcn_readfirstlane(tid >> 6);
    const _Float16* Qg = (const _Float16*)(ws + (MOBA ? WS_QMB : WS_QMLA)); const _Float16* Kg = (const _Float16*)(ws + (MOBA ? WS_KMB : WS_KN));
    const _Float16* Vg = (const _Float16*)(ws + (MOBA ? WS_VMB : WS_VM)); const _Float16* Pg = (const _Float16*)(ws + WS_KPE); _Float16* Zg = (_Float16*)(ws + WS_ZCAT) + (MOBA ? 512 : 0);
    const size_t rowbase = (size_t)b * SEQ; const int q0 = qb * 256, qw0 = q0 + wid * 32, qrow = qw0 + r32;
    LAS float* wsf = (LAS float*)(lds + L_WS) + wid * 64; LAS int* tb = (LAS int*)(lds + L_TB); LAS unsigned* un = (LAS unsigned*)(lds + L_UN);
    h8 qr[ND];
#pragma unroll
    for (int d0 = 0; d0 < ND; ++d0) qr[d0] = *(const h8*)(Qg + (rowbase + qrow) * QP + h * QH + d0 * 16 + hi * 8);
#pragma unroll
    for (int d0 = 0; d0 < ND; ++d0) asm volatile("" : "+v"(qr[d0]));
    unsigned sel = 0u, blocks = (2u << qb) - 1u;
    if (MOBA) {
        const float* km = (const float*)(ws + WS_KMEAN) + (size_t)b * 16 * 512 + h * 64 + hi * 8;
        float g0 = -INFINITY, g1 = -INFINITY, g2 = -INFINITY; int i0 = -1, i1 = -1, i2 = -1;
        for (int m = 0; m < qb; ++m) {
            float part = 0.f;
#pragma unroll
            for (int d0 = 0; d0 < 4; ++d0) { const float4 a = *(const float4*)(km + m * 512 + d0 * 16), c = *(const float4*)(km + m * 512 + d0 * 16 + 4);
                part += (float)qr[d0][0] * a.x + (float)qr[d0][1] * a.y + (float)qr[d0][2] * a.z + (float)qr[d0][3] * a.w + (float)qr[d0][4] * c.x + (float)qr[d0][5] * c.y + (float)qr[d0][6] * c.z + (float)qr[d0][7] * c.w; }
            const float g = swapsum(part);
            if (g > g0) { g2 = g1; i2 = i1; g1 = g0; i1 = i0; g0 = g; i0 = m; }
            else if (g > g1) { g2 = g1; i2 = i1; g1 = g; i1 = m; }
            else if (g > g2) { g2 = g; i2 = m; }
        }
        if (i0 >= 0) sel |= 1u << i0; if (i1 >= 0) sel |= 1u << i1; if (i2 >= 0) sel |= 1u << i2;
        unsigned uw = sel;
#pragma unroll
        for (int o = 1; o < 64; o <<= 1) uw |= (unsigned)__shfl_xor((int)uw, o);
        if (lane == 0) un[wid] = uw;
        __syncthreads();
        unsigned ua = 0u;
#pragma unroll
        for (int w = 0; w < 8; ++w) ua |= un[w];
        blocks = (unsigned)__builtin_amdgcn_readfirstlane((int)(ua | (1u << qb)));
    }
    const int NT = 4 * __builtin_popcount(blocks);
    if (tid < 64 && tid < NT) { unsigned bm = blocks; for (int k = 0; k < (tid >> 2); ++k) bm &= bm - 1u; tb[tid] = (__builtin_ctz(bm) << 8) + ((tid & 3) << 6); }
    __syncthreads();
    const unsigned char* kbu = (const unsigned char*)(Kg + rowbase * 512 + h * 64); const unsigned char* vbu = (const unsigned char*)(Vg + rowbase * 512 + h * 64); const unsigned char* pbu = (const unsigned char*)(Pg + rowbase * 32);
    const unsigned char* kb0; const unsigned char* kb1 = nullptr; unsigned ksrc0, ksrc1 = 0u, kst0 = 1024u, kst1 = 1024u;
    if (DK == 96) { const int r0 = 4 * wid + (lane >> 4), r1 = r0 + 32; int c0 = (lane & 15) ^ (r0 & 15), c1 = (lane & 15) ^ (r1 & 15); if (c0 >= 12) c0 -= 4; if (c1 >= 12) c1 -= 4;
        const bool kpe0 = c0 >= 8, kpe1 = c1 >= 8;
        kb0 = kpe0 ? pbu : kbu; kst0 = kpe0 ? 64u : 1024u; ksrc0 = kpe0 ? (unsigned)(r0 * 32 + (c0 - 8) * 8) * 2u : (unsigned)(r0 * 512 + c0 * 8) * 2u;
        kb1 = kpe1 ? pbu : kbu; kst1 = kpe1 ? 64u : 1024u; ksrc1 = kpe1 ? (unsigned)(r1 * 32 + (c1 - 8) * 8) * 2u : (unsigned)(r1 * 512 + c1 * 8) * 2u;
    } else { const int r0 = 8 * wid + (lane >> 3), c0 = (lane & 7) ^ ((r0 >> 1) & 7); kb0 = kbu; ksrc0 = (unsigned)(r0 * 512 + c0 * 8) * 2u; }
    const unsigned vsrc = (unsigned)((16 * (wid & 3) + (lane >> 2)) * 512 + (wid >> 2) * 32 + (lane & 3) * 8) * 2u;
    constexpr int NDMA = (DK == 96) ? 3 : 2;
#define ATT_GLDS(src, dst) glds16((const void*)(src), (unsigned)__builtin_amdgcn_readfirstlane((int)(unsigned)(size_t)(dst)))
#define ATT_DMA(kb, buf) do { const unsigned kb_ = (unsigned)(kb); LAS unsigned char* kd_ = lds + L_K + (buf) * KBUF; \
        ATT_GLDS(kb0 + (ksrc0 + kb_ * kst0), kd_ + wid * 1024); \
        if (DK == 96) ATT_GLDS(kb1 + (ksrc1 + kb_ * kst1), kd_ + 8192 + wid * 1024); \
        ATT_GLDS(vbu + (vsrc + kb_ * 1024u), lds + L_V + (buf) * VBUF + wid * 1024); } while (0)
#define ATT_WAITV(n) asm volatile("s_waitcnt vmcnt(" #n ")" ::: "memory")
#define ATT_BAR() do { asm volatile("s_waitcnt lgkmcnt(0)" ::: "memory"); __builtin_amdgcn_s_barrier(); asm volatile("" ::: "memory"); } while (0)
    const int vro = ((lane >> 4) & 1) * 32 + (lane & 3) * 8 + (4 * hi + ((lane & 15) >> 2)) * 64;
    float l_reg = 0.f; bool init = false; f16v o[2]; o[0] = f16v{}; o[1] = f16v{}; f16v negm = f16v{}; asm volatile("" : "+v"(negm));
    constexpr int G = 2 * ND;
#define ATT_SBAR() __builtin_amdgcn_sched_barrier(0)
#define ATT_PIN(x) asm volatile("" : "+v"(x))
#define ATT_KF(buf, g) (*(const LAS h8*)(lds + L_K + (buf) * KBUF + kaddr<DK>(32 * ((g) & 1) + r32, 2 * ((g) >> 1) + hi)))
#define ATT_MF(a, b, c) __builtin_amdgcn_mfma_f32_32x32x16_f16(a, b, c, 0, 0, 0)
#define ATT_QK(P0, P1, buf) do { h8 kf_[G]; _Pragma("unroll") for (int g_ = 0; g_ < G; ++g_) kf_[g_] = ATT_KF(buf, g_); ATT_SBAR(); \
        _Pragma("unroll") for (int d_ = 0; d_ < ND; ++d_) { P0 = ATT_MF(kf_[2 * d_], qr[d_], d_ == 0 ? negm : P0); P1 = ATT_MF(kf_[2 * d_ + 1], qr[d_], d_ == 0 ? negm : P1); } } while (0)
#define ATT_MAXCHAIN(P0, P1, PM) do { float pa_ = max3f(P0[0], P0[1], P1[0]), pb_ = max3f(P0[2], P0[3], P1[1]); pa_ = max3f(pa_, P1[2], P1[3]); \
        _Pragma("unroll") for (int r_ = 4; r_ < 16; r_ += 4) { pa_ = max3f(pa_, P0[r_], P0[r_ + 1]); pb_ = max3f(pb_, P0[r_ + 2], P0[r_ + 3]); pa_ = max3f(pa_, P1[r_], P1[r_ + 1]); pb_ = max3f(pb_, P1[r_ + 2], P1[r_ + 3]); } \
        PM = swapmax(fmaxf(pa_, pb_)); } while (0)
#define ATT_MOVE(P0, P1, PM) do { const bool move_ = init ? ((PM) > THR) : ((PM) > -INFINITY); \
        if (__any(move_)) { const float dl_ = move_ ? (init ? fmaxf((PM), 0.f) : (PM)) : 0.f; const float al_ = (move_ && init) ? __builtin_amdgcn_exp2f(-dl_) : 1.f; \
            init = init || move_; l_reg *= al_; \
            _Pragma("unroll") for (int r_ = 0; r_ < 16; ++r_) { P0[r_] -= dl_; P1[r_] -= dl_; negm[r_] -= dl_; } \
            if (hi == 0) wsf[r32] = al_; asm volatile("s_waitcnt lgkmcnt(0)" ::: "memory"); \
            _Pragma("unroll") for (int r_ = 0; r_ < 16; ++r_) { const float a_ = wsf[crow(r_, hi)]; o[0][r_] *= a_; o[1][r_] *= a_; } } } while (0)
#define ATT_PACK(P0, P1, PW, KEEP) do { _Pragma("unroll") for (int k_ = 0; k_ < 2; ++k_) { \
            PW[k_] = (u4){pkh(P0[8 * k_], P0[8 * k_ + 1]), pkh(P0[8 * k_ + 2], P0[8 * k_ + 3]), pkh(P0[8 * k_ + 4], P0[8 * k_ + 5]), pkh(P0[8 * k_ + 6], P0[8 * k_ + 7])}; \
            PW[2 + k_] = (u4){pkh(P1[8 * k_], P1[8 * k_ + 1]), pkh(P1[8 * k_ + 2], P1[8 * k_ + 3]), pkh(P1[8 * k_ + 4], P1[8 * k_ + 5]), pkh(P1[8 * k_ + 6], P1[8 * k_ + 7])}; } \
        if (MOBA) { _Pragma("unroll") for (int k_ = 0; k_ < 4; ++k_) PW[k_] &= (KEEP); } } while (0)
#define ATT_VF(buf, i) (lds + L_V + (buf) * VBUF + vro + ((i) >> 2) * 4096 + ((i) & 3) * 1024)
#define ATT_WAIT_NEXT(t_) do { if ((t_) + 3 < NT) { if (NDMA == 3) ATT_WAITV(3); else ATT_WAITV(2); } else ATT_WAITV(0); } while (0)
#define ATT_TB(i) (MOBA ? tb[(i)] : 64 * (i))
    const int NF = NT - 4;
    ATT_DMA(ATT_TB(0), 0); ATT_DMA(ATT_TB(1), 1); ATT_DMA(ATT_TB(2), 2);
    if (NDMA == 3) ATT_WAITV(3); else ATT_WAITV(2);
    ATT_BAR();
    f16v pC0, pC1;
    if (NF > 0) { ATT_QK(pC0, pC1, 0); asm volatile("s_nop 15\n\ts_nop 7" : "+v"(pC0), "+v"(pC1)); float pm; ATT_MAXCHAIN(pC0, pC1, pm);
        if (MOBA && !((sel >> (ATT_TB(0) >> 8)) & 1u)) pm = -INFINITY; ATT_MOVE(pC0, pC1, pm); }
    auto step = [&](f16v& pC0, f16v& pC1, f16v& pN0, f16v& pN1, const int t, auto hn) __attribute__((always_inline)) {
        const int cur = t & 3, nx = (t + 1) & 3; constexpr bool hasn = decltype(hn)::value;
        ATT_DMA(ATT_TB(t + 3), (t + 3) & 3);
        const unsigned keepC = (!MOBA || ((sel >> (ATT_TB(t) >> 8)) & 1u)) ? 0xffffffffu : 0u;
        float ps = 0.f;
        if (hasn) {
            h8 kf[G];
#pragma unroll
            for (int g = 0; g < 4; ++g) kf[g] = ATT_KF(nx, g);
            ATT_SBAR();
#pragma unroll
            for (int g = 0; g < G; ++g) {
                if (g + 4 < G) kf[g + 4] = ATT_KF(nx, g + 4);
                if (g & 1) pN1 = ATT_MF(kf[g], qr[g >> 1], g == 1 ? negm : pN1); else pN0 = ATT_MF(kf[g], qr[g >> 1], g == 0 ? negm : pN0);
                constexpr int dummy = 0; (void)dummy;
                const int e0 = (ND == 4) ? 4 * g : (g < 8 ? 3 * g : 24 + 2 * (g - 8)), e1 = (ND == 4) ? 4 * g + 4 : (g < 8 ? 3 * g + 3 : 26 + 2 * (g - 8));
#pragma unroll
                for (int e = e0; e < e1; ++e) { if (e < 16) { pC0[e] = __builtin_amdgcn_exp2f(pC0[e]); ps += pC0[e]; } else { pC1[e - 16] = __builtin_amdgcn_exp2f(pC1[e - 16]); ps += pC1[e - 16]; } }
                ATT_PIN(pC0); ATT_PIN(pC1); ATT_PIN(ps); ATT_SBAR();
            }
        } else {
#pragma unroll
            for (int r = 0; r < 16; ++r) { pC0[r] = __builtin_amdgcn_exp2f(pC0[r]); pC1[r] = __builtin_amdgcn_exp2f(pC1[r]); ps += pC0[r] + pC1[r]; }
        }
        if (MOBA && !keepC) ps = 0.f;
        l_reg += swapsum(ps);
        u4 pw[4]; ATT_PACK(pC0, pC1, pw, keepC);
        {
            s4 vlo[8], vhi[8]; float pa = 0.f, pb = 0.f;
#pragma unroll
            for (int i = 0; i < 3; ++i) { vlo[i] = vtr(ATT_VF(cur, i)); vhi[i] = vtr(ATT_VF(cur, i) + 512); }
            if (hasn) asm volatile("s_nop 7" : "+v"(pN0), "+v"(pN1));
            ATT_SBAR();
#pragma unroll
            for (int i = 0; i < 8; ++i) {
                if (i + 3 < 8) { vlo[i + 3] = vtr(ATT_VF(cur, i + 3)); vhi[i + 3] = vtr(ATT_VF(cur, i + 3) + 512); }
                const s8 vv = (s8){vlo[i][0], vlo[i][1], vlo[i][2], vlo[i][3], vhi[i][0], vhi[i][1], vhi[i][2], vhi[i][3]};
                o[i >> 2] = ATT_MF(__builtin_bit_cast(h8, pw[i & 3]), __builtin_bit_cast(h8, vv), o[i >> 2]);
                if (hasn) {
                    if (i == 0) { pa = max3f(pN0[0], pN0[1], pN1[0]); pb = max3f(pN0[2], pN0[3], pN1[1]); }
                    else if (i == 1) { pa = max3f(pa, pN1[2], pN1[3]); pb = max3f(pb, pN0[6], pN0[7]); }
                    else if (i == 2) { pa = max3f(pa, pN0[4], pN0[5]); pb = max3f(pb, pN1[6], pN1[7]); }
                    else if (i == 3) { pa = max3f(pa, pN1[4], pN1[5]); pb = max3f(pb, pN0[10], pN0[11]); }
                    else if (i == 4) { pa = max3f(pa, pN0[8], pN0[9]); pb = max3f(pb, pN1[10], pN1[11]); }
                    else if (i == 5) { pa = max3f(pa, pN1[8], pN1[9]); pb = max3f(pb, pN0[14], pN0[15]); }
                    else if (i == 6) { pa = max3f(pa, pN0[12], pN0[13]); pb = max3f(pb, pN1[14], pN1[15]); }
                    else { pa = max3f(pa, pN1[12], pN1[13]); }
                    ATT_PIN(pa); ATT_PIN(pb);
                }
                ATT_SBAR();
            }
            if (hasn) { float pm = swapmax(fmaxf(pa, pb)); if (MOBA && !((sel >> (ATT_TB(t + 1) >> 8)) & 1u)) pm = -INFINITY; ATT_MOVE(pN0, pN1, pm); }
        }
        if (NDMA == 3) ATT_WAITV(3); else ATT_WAITV(2);
        ATT_BAR();
    };
    {
        f16v pD0, pD1; int t = 0;
        for (; t + 2 < NF; t += 2) { step(pC0, pC1, pD0, pD1, t, T1{}); step(pD0, pD1, pC0, pC1, t + 1, T1{}); }
        if (t + 1 < NF) { step(pC0, pC1, pD0, pD1, t, T1{}); step(pD0, pD1, pC0, pC1, t + 1, T0{}); }
        else if (t < NF) step(pC0, pC1, pD0, pD1, t, T0{});
    }
    for (int t = NF; t < NT; ++t) {
        const int cur = t & 3, kb = ATT_TB(t);
        if (t + 3 < NT) ATT_DMA(ATT_TB(t + 3), (t + 3) & 3);
        if (kb <= qw0 + 31) {
            f16v p0, p1; ATT_QK(p0, p1, cur);
            if (kb + 63 > qw0) {
#pragma unroll
                for (int r = 0; r < 16; ++r) { const int kv = kb + crow(r, hi); if (kv > qrow) p0[r] = -INFINITY; if (kv + 32 > qrow) p1[r] = -INFINITY; }
            }
            asm volatile("s_nop 15\n\ts_nop 7" : "+v"(p0), "+v"(p1));
            float pm; ATT_MAXCHAIN(p0, p1, pm); ATT_MOVE(p0, p1, pm);
            s4 vlo[8], vhi[8];
#pragma unroll
            for (int i = 0; i < 8; ++i) { vlo[i] = vtr(ATT_VF(cur, i)); vhi[i] = vtr(ATT_VF(cur, i) + 512); }
            ATT_SBAR();
            float ps = 0.f;
#pragma unroll
            for (int r = 0; r < 16; ++r) { p0[r] = __builtin_amdgcn_exp2f(p0[r]); p1[r] = __builtin_amdgcn_exp2f(p1[r]); ps += p0[r] + p1[r]; }
            l_reg += swapsum(ps);
            u4 pw[4]; ATT_PACK(p0, p1, pw, 0xffffffffu);
#pragma unroll
            for (int i = 0; i < 8; ++i) { const s8 vv = (s8){vlo[i][0], vlo[i][1], vlo[i][2], vlo[i][3], vhi[i][0], vhi[i][1], vhi[i][2], vhi[i][3]};
                o[i >> 2] = ATT_MF(__builtin_bit_cast(h8, pw[i & 3]), __builtin_bit_cast(h8, vv), o[i >> 2]); }
        }
        ATT_WAIT_NEXT(t);
        ATT_BAR();
    }
    if (hi == 0) wsf[32 + r32] = l_reg; asm volatile("s_waitcnt lgkmcnt(0)" ::: "memory");
    LAS _Float16* stg = (LAS _Float16*)(lds + L_OST) + wid * 2048;
#pragma unroll
    for (int r = 0; r < 16; ++r) { const int orow = crow(r, hi); const float rl = 1.f / wsf[32 + orow];
        stg[orow * 64 + r32] = (_Float16)(o[0][r] * rl); stg[orow * 64 + 32 + r32] = (_Float16)(o[1][r] * rl); }
    asm volatile("s_waitcnt lgkmcnt(0)" ::: "memory");
    int lane_e = lane; asm volatile("" : "+v"(lane_e));
    unsigned char* zbu = (unsigned char*)(Zg + (rowbase + qw0) * 1024 + h * 64);
#pragma unroll
    for (int i = 0; i < 4; ++i) { const int row = i * 8 + (lane_e >> 3), ch = lane_e & 7; const h8 v = *(const LAS h8*)(stg + row * 64 + ch * 8);
        _Float16* zp = (_Float16*)(zbu + (unsigned)(row * 1024 + ch * 8) * 2u); const h8 z = *(const h8*)zp; h8 ov;
#pragma unroll
        for (int j = 0; j < 8; ++j) ov[j] = (_Float16)((float)v[j] * (float)z[j]);
        if (!dry) *(h8*)zp = ov; }
    __syncthreads();
#undef ATT_GLDS
#undef ATT_DMA
#undef ATT_WAITV
#undef ATT_BAR
#undef ATT_SBAR
#undef ATT_PIN
#undef ATT_KF
#undef ATT_MF
#undef ATT_QK
#undef ATT_MAXCHAIN
#undef ATT_MOVE
#undef ATT_PACK
#undef ATT_VF
#undef ATT_WAIT_NEXT
#undef ATT_TB
}

__device__ __forceinline__ void attn_phase(unsigned char* ws, LAS unsigned char* lds, int vb, int nvb) {
    const int vcu = (nvb % 8 == 0) ? (vb % 8) * (nvb / 8) + vb / 8 : vb; const int per = (1024 + nvb - 1) / nvb;
    for (int k = 0; k < per; ++k) {
        int it;
        if (nvb == 256) { const int xg = vcu >> 5, lw = vcu & 31; it = ((16 * xg + 4 * k + (lw >> 3)) << 3) | (lw & 7); }
        else { it = vcu * per + k; if (it >= 1024) break; }
        const int bh = it >> 3, pr = it & 7, b = bh >> 3, h = bh & 7;
        if (PROBE == 2) for (int uu = 0; uu < 2; ++uu) attn_unit<96, false, PROBE_ABL>(ws, b, h, uu ? 15 - pr : pr, lds, true);
        for (int uu = 0; uu < 2; ++uu) attn_unit<96, false>(ws, b, h, uu ? 15 - pr : pr, lds);
        if (PROBE == 3) for (int uu = 0; uu < 2; ++uu) attn_unit<64, true, PROBE_ABL>(ws, b, h, uu ? 15 - pr : pr, lds, true);
        for (int uu = 0; uu < 2; ++uu) attn_unit<64, true>(ws, b, h, uu ? 15 - pr : pr, lds);
    }
}
}

constexpr int RING_BYTES = 131072, MISC_OFF = RING_BYTES + 320, LDS_BYTES = 147456;
constexpr int CW_BAR = 4096;

__global__ void __launch_bounds__(512, 2) mega(Params p) {
    extern __shared__ __attribute__((aligned(16))) unsigned char lds[];
    const int vb = blockIdx.x, nvb = gridDim.x, tid = threadIdx.x, lane = tid & 63, wave = tid >> 6;
    const int gtid = vb * 512 + tid, gsize = nvb * 512, gwave = vb * 8 + wave, nwaves = nvb * 8;
    volatile LAS unsigned* misc = (volatile LAS unsigned*)((LAS unsigned char*)lds + MISC_OFF);
    if (tid < 32) misc[tid] = 0u;
    __syncthreads();
    XcdBarrier bar = xcd_barrier_post((unsigned*)(p.ws + WS_CTL) + CW_BAR, misc + 8);
    LAS unsigned char* ldsl = (LAS unsigned char*)lds;
    { int t_ = threadIdx.x; asm volatile("" : "+v"(t_)); ph_prep(p, vb * 512 + t_, gsize, vb, nvb, ldsl); ph_weights(p, ldsl, vb * 8 + (t_ >> 6), nwaves, t_ >> 6, t_ & 63);
      if (PROBE == 10) ph_weights(p, ldsl, vb * 8 + (t_ >> 6), nwaves, t_ >> 6, t_ & 63);
      if (PROBE == 11) ph_tab(p, vb * 512 + t_, gsize); }
    xcd_barrier(bar);
    for (int rep4 = 0; rep4 < ((PROBE == 4 || PROBE == 6) ? 2 : 1); ++rep4) { int t_ = threadIdx.x; asm volatile("" : "+v"(t_)); ph_hnorm(p, vb * 8 + (t_ >> 6), nwaves, t_ & 63); }
    xcd_barrier(bar);
    {
        pg8::Gemm g{(const pg8::bf16_t*)(p.ws + WS_H), (const pg8::bf16_t*)(p.ws + WT_IN), M_, 5120, 1024}; pg8::StaticOrder S; S.init(M_, 5120, nvb, vb);
        for (int rep = (PROBE == 1 ? 1 : 0); rep >= 0; --rep) { pg8::EpiInF E{p.ws, p.b_merge, rep}; pg8::gemm_phase<pg8::EpiInF, pg8::StaticOrder, true, true>(ldsl, g, S, E); }
        if (PROBE == 5) { pg8::EpiNull E; pg8::gemm_phase<pg8::EpiNull, pg8::StaticOrder, true, true>(ldsl, g, S, E); }
    }
    xcd_barrier(bar);
    for (int rep4 = 0; rep4 < ((PROBE == 4 || PROBE == 7) ? 2 : 1); ++rep4) {
        pg8::Gemm g{(const pg8::bf16_t*)(p.ws + WS_QLAT), (const pg8::bf16_t*)(p.ws + WT_UQ), M_, 768, 256}; pg8::StaticOrder S; S.init(M_, 768, nvb, vb);
        pg8::EpiUqF E{p.ws}; pg8::gemm_phase<pg8::EpiUqF, pg8::StaticOrder, true, true>(ldsl, g, S, E);
    }
    for (int rep4 = 0; rep4 < ((PROBE == 4 || PROBE == 7) ? 2 : 1); ++rep4) {
        pg8::Gemm g{(const pg8::bf16_t*)(p.ws + WS_KVL), (const pg8::bf16_t*)(p.ws + WT_UKV), M_, 1024, 128};     pg8::StaticOrder S; S.init(M_, 1024, nvb, vb);
        pg8::EpiUkvF E{p.ws}; pg8::gemm_phase<pg8::EpiUkvF, pg8::StaticOrder, true, true>(ldsl, g, S, E);
    }
    xcd_barrier(bar);
    att::attn_phase(p.ws, ldsl, vb, nvb);
    xcd_barrier(bar);
    {
        pg8::Gemm g{(const pg8::bf16_t*)(p.ws + WS_ZCAT), (const pg8::bf16_t*)(p.ws + WT_OA), M_, 1024, 1024}; pg8::StaticOrder S; S.init(M_, 1024, nvb, vb);
        pg8::EpiYcatF E{p.ws}; pg8::gemm_phase<pg8::EpiYcatF, pg8::StaticOrder, true, true>(ldsl, g, S, E);
    }
    xcd_barrier(bar);
    for (int rep4 = 0; rep4 < ((PROBE == 4 || PROBE == 9) ? 2 : 1); ++rep4) {
        pg8::Gemm g{(const pg8::bf16_t*)(p.ws + WS_YM), (const pg8::bf16_t*)(p.ws + WT_OUT), M_, 1024, 1024}; pg8::StaticOrder S; S.init(M_, 1024, nvb, vb);
        pg8::EpiYF E{p.ws}; pg8::gemm_phase<pg8::EpiYF, pg8::StaticOrder, true, true>(ldsl, g, S, E);
    }
    xcd_barrier(bar);
    for (int rep4 = 0; rep4 < ((PROBE == 4 || PROBE == 9) ? 2 : 1); ++rep4) { int t_ = threadIdx.x; asm volatile("" : "+v"(t_)); ph_final(p, vb * 8 + (t_ >> 6), nwaves, t_ & 63); }
}

extern "C" void kernel_launch(void* const* d_in, const int* in_sizes, int n_in, void* d_out, int out_size, void* d_ws, size_t ws_size, hipStream_t stream) {
    if (n_in != 16 || out_size != M_ * DM || ws_size < WS_END) { fprintf(stderr, "kernel_launch: unexpected shapes (n_in %d, out %d, ws %zu)\n", n_in, out_size, ws_size); return; }
    Params p{};
    p.x = (const float*)d_in[0]; p.c = (const float*)d_in[1]; p.pos = (const int*)d_in[2]; p.w_ada = (const float*)d_in[3]; p.b_ada = (const float*)d_in[4];
    p.g_pre = (const float*)d_in[5]; p.g_post = (const float*)d_in[6]; p.w_in = (const float*)d_in[7]; p.g_q = (const float*)d_in[8]; p.w_uq = (const float*)d_in[9];
    p.g_kv = (const float*)d_in[10]; p.w_ukv = (const float*)d_in[11]; p.w_o_mla = (const float*)d_in[12]; p.w_o_moba = (const float*)d_in[13]; p.b_merge = (const float*)d_in[14]; p.w_out = (const float*)d_in[15];
    p.out = (float*)d_out; p.ws = (unsigned char*)d_ws;
    static int grid = 0;
    if (grid == 0) {
        int dev = 0, cus = 0, per_cu = 0;
        if (hipGetDevice(&dev) != hipSuccess || hipDeviceGetAttribute(&cus, hipDeviceAttributeMultiprocessorCount, dev) != hipSuccess) { fprintf(stderr, "kernel_launch: device query failed\n"); grid = -1; return; }
        if (hipFuncSetAttribute((const void*)mega, hipFuncAttributeMaxDynamicSharedMemorySize, LDS_BYTES) != hipSuccess) { fprintf(stderr, "kernel_launch: hipFuncSetAttribute failed\n"); grid = -1; return; }
        if (hipOccupancyMaxActiveBlocksPerMultiprocessor(&per_cu, (const void*)mega, 512, LDS_BYTES) != hipSuccess || per_cu < 1) { fprintf(stderr, "kernel_launch: occupancy query says %d\n", per_cu); }
        (void)hipGetLastError();
        grid = cus;
    }
    if (grid < 0) return;
    (void)hipMemsetAsync(d_ws, 0, ZERO_BYTES, stream);
    hipLaunchKernelGGL(mega, dim3(grid), dim3(512), LDS_BYTES, stream, p);
}
```

```cpp
#include <hip/hip_runtime.h>
#include <cstdio>
#ifndef PROBE
#define PROBE 0
#endif
#include <cstdint>

typedef _Float16 h16;
typedef _Float16 h16x4 __attribute__((ext_vector_type(4)));
typedef _Float16 h2n __attribute__((ext_vector_type(2)));

constexpr int NB = 16, SEQ = 4096, DM = 1024, M_ = NB * SEQ, NH = 8;
constexpr int D_IN = 5024;
constexpr int C_QLAT = 0, C_KVLAT = 256, C_KROPE = 384, C_ZMLA = 416, C_QMB = 928, C_KMB = 1440, C_VMB = 1952, C_ZMB = 2464, C_GA = 2976, C_GB = 4000;
constexpr float EPS = 1e-6f;
constexpr float LOG2E = 1.4426950408889634f;
constexpr float SC_MLA = 0.10206207261596577f * LOG2E;
constexpr float SC_MB = 0.125f * LOG2E;

constexpr size_t MiB = 1u << 20;
constexpr size_t WS_CTL = 0, WS_KMEAN = 512 * 1024, WS_SSQ = 1 * MiB, WS_SSQY = WS_SSQ + 2 * (size_t)M_ * 4, ZERO_BYTES = 2 * MiB;
constexpr size_t WS_MOD = WS_SSQ + 3 * (size_t)M_ * 4, WS_TAB = 4 * MiB, WS_WT = 20 * MiB;
constexpr size_t WS_H = 36 * MiB, WS_KN = 36 * MiB, WS_VM = 100 * MiB;
constexpr size_t WS_QLAT = 164 * MiB, WS_KVL = 196 * MiB, WS_KPE = 228 * MiB, WS_VMB = 232 * MiB;
constexpr size_t WS_QMB = 296 * MiB, WS_KMB = 360 * MiB, WS_ZCAT = 424 * MiB, WS_YM = 296 * MiB;
constexpr size_t WS_GA = 552 * MiB, WS_GB = 616 * MiB, WS_Y = 680 * MiB,     WS_QMLA = 808 * MiB, WS_LIST = 904 * MiB, WS_ML = 920 * MiB, WS_END = 936 * MiB;
constexpr size_t WS_CNT = 64 * 1024;
__device__ __forceinline__ unsigned opart_off(int slot) { return slot < 2 ? (unsigned)(WS_Y + (size_t)slot * 64 * MiB) : (unsigned)WS_QLAT; }

static_assert(WS_MOD + (size_t)NB * 3072 * 4 <= ZERO_BYTES, "MOD inside the zeroed region");
struct Params {
    const float *x, *c; const int* pos; const float *w_ada, *b_ada, *g_pre, *g_post, *w_in, *g_q, *w_uq, *g_kv, *w_ukv, *w_o_mla, *w_o_moba, *b_merge, *w_out;
    float* out; unsigned char* ws;
};

__device__ __forceinline__ float wave_sum(float v) {
#pragma unroll
    for (int o = 1; o < 64; o <<= 1) v += __shfl_xor(v, o);
    return v;
}
__device__ __forceinline__ float silu_f(float v) { return v / (1.f + __expf(-v)); }
__device__ __forceinline__ float sigmoid_f(float v) { return 1.f / (1.f + __expf(-v)); }

#define LAS __attribute__((address_space(3)))
__device__ void ph_tab(const Params& p, int gtid, int gsize);
__device__ void ph_prep(const Params& p, int gtid, int gsize, int vb, int nvb, LAS unsigned char* lds) {
    float* mod = (float*)(p.ws + WS_MOD);
    { const int tid = gtid - vb * 512; LAS float* sc = (LAS float*)lds; LAS float* part = (LAS float*)(lds + 65536);
      for (int i = tid; i < NB * DM; i += 512) { const float cv = p.c[i]; sc[i] = cv / (1.f + __expf(-cv)); }
      __syncthreads();
      for (int cg = vb; cg < 3072 / 12; cg += nvb) {
          if (tid < 384) { const int col = tid % 12, kc = tid / 12, j = cg * 12 + col, k0 = kc * 32;
              float w[32], acc[NB];
#pragma unroll
              for (int kk = 0; kk < 32; ++kk) w[kk] = p.w_ada[(size_t)(k0 + kk) * 3072 + j];
#pragma unroll
              for (int b = 0; b < NB; ++b) acc[b] = 0.f;
#pragma unroll
              for (int kk = 0; kk < 32; kk += 4) {
#pragma unroll
                  for (int b = 0; b < NB; ++b) { typedef float f4m __attribute__((ext_vector_type(4))); const f4m s4 = *(const LAS f4m*)(sc + b * DM + k0 + kk);
                      acc[b] = fmaf(s4.x, w[kk], acc[b]); acc[b] = fmaf(s4.y, w[kk + 1], acc[b]); acc[b] = fmaf(s4.z, w[kk + 2], acc[b]); acc[b] = fmaf(s4.w, w[kk + 3], acc[b]); } }
#pragma unroll
              for (int b = 0; b < NB; ++b) part[(kc * NB + b) * 12 + col] = acc[b]; }
          __syncthreads();
          if (tid < NB * 12) { const int b = tid / 12, c = tid % 12, j = cg * 12 + c; float s = p.b_ada[j];
#pragma unroll
              for (int kc = 0; kc < 32; ++kc) s += part[(kc * NB + b) * 12 + c];
              mod[b * 3072 + j] = s; }
          __syncthreads();
      } }
    ph_tab(p, gtid, gsize);
}
__device__ void ph_tab(const Params& p, int gtid, int gsize) {
    unsigned* tab = (unsigned*)(p.ws + WS_TAB);
    const int f = gtid & 31;
    const double c = exp2(-(double)f * (13.287712379549449 / 32.0)) * 0.15915494309189535;
    int ex; const double mant = frexp(c, &ex); const double c_hi_d = ldexp(rint(ldexp(mant, 11)), ex - 11);
    const float c_hi = (float)c_hi_d, c_lo = (float)(c - c_hi_d);
    for (int i = gtid; i < M_ * 32; i += gsize) {
        const float pos = (float)p.pos[i >> 5];
        float x = pos * c_hi; x = x - floorf(x); x = fmaf(pos, c_lo, x);
        typedef _Float16 h2t __attribute__((ext_vector_type(2))); h2t cs; cs[0] = (_Float16)__builtin_amdgcn_cosf(x); cs[1] = (_Float16)__builtin_amdgcn_sinf(x);
        tab[i] = __builtin_bit_cast(unsigned, cs);
    }
}

__device__ void ph_hnorm(const Params& p, int gwave, int nwaves, int lane) {
    constexpr int R = 4;
    typedef float f4 __attribute__((ext_vector_type(4)));
    const float* mod = (const float*)(p.ws + WS_MOD); h16* H = (h16*)(p.ws + WS_H);
    for (int m0 = R * gwave; m0 < M_; m0 += R * nwaves) {
        f4 v[R][4]; float ss[R];
#pragma unroll
        for (int r = 0; r < R; ++r) { const f4* xr = (const f4*)(p.x + (size_t)(m0 + r) * DM);
#pragma unroll
            for (int j = 0; j < 4; ++j) v[r][j] = __builtin_nontemporal_load(xr + lane + 64 * j); }
#pragma unroll
        for (int r = 0; r < R; ++r) { float s = 0.f;
#pragma unroll
            for (int j = 0; j < 4; ++j) s += (v[r][j][0] * v[r][j][0] + v[r][j][1] * v[r][j][1]) + (v[r][j][2] * v[r][j][2] + v[r][j][3] * v[r][j][3]);
            ss[r] = 1.f / sqrtf(wave_sum(s) * (1.f / DM) + EPS); }
        const int b = m0 >> 12;
#pragma unroll
        for (int j = 0; j < 4; ++j) {
            const int col = 4 * (lane + 64 * j);
            const float4 g = *(const float4*)(p.g_pre + col), sc = *(const float4*)(mod + b * 3072 + 1024 + col), sh = *(const float4*)(mod + b * 3072 + col);
            const float g0 = g.x * (1.f + sc.x), g1 = g.y * (1.f + sc.y), g2 = g.z * (1.f + sc.z), g3 = g.w * (1.f + sc.w);
#pragma unroll
            for (int r = 0; r < R; ++r) { const float rstd = ss[r]; const f4 x = v[r][j];
                h16x4 o; o[0] = (h16)(x[0] * rstd * g0 + sh.x); o[1] = (h16)(x[1] * rstd * g1 + sh.y); o[2] = (h16)(x[2] * rstd * g2 + sh.z); o[3] = (h16)(x[3] * rstd * g3 + sh.w);
                *(h16x4*)(H + (size_t)(m0 + r) * DM + col) = o; }
        }
    }
}

__device__ void ph_final(const Params& p, int gwave, int nwaves, int lane) {
    constexpr int R = 4; typedef float f4 __attribute__((ext_vector_type(4)));
    const float* mod = (const float*)(p.ws + WS_MOD); const h16* Y = (const h16*)(p.ws + WS_Y); const float* ssq = (const float*)(p.ws + WS_SSQY);
    for (int m0 = R * gwave; m0 < M_; m0 += R * nwaves) {
        const int b = m0 >> 12; h16x4 yv[R][4]; f4 xv[R][4]; float rs[R];
#pragma unroll
        for (int r = 0; r < R; ++r) { const h16x4* yr = (const h16x4*)(Y + (size_t)(m0 + r) * DM); const f4* xr = (const f4*)(p.x + (size_t)(m0 + r) * DM); rs[r] = ssq[m0 + r];
#pragma unroll
            for (int j = 0; j < 4; ++j) { yv[r][j] = yr[lane + 64 * j]; xv[r][j] = __builtin_nontemporal_load(xr + lane + 64 * j); } }
#pragma unroll
        for (int r = 0; r < R; ++r) rs[r] = 1.f / sqrtf(rs[r] * (1.f / DM) + EPS);
#pragma unroll
        for (int j = 0; j < 4; ++j) {
            const int col = 4 * (lane + 64 * j); const float4 g = *(const float4*)(p.g_post + col), gt = *(const float4*)(mod + b * 3072 + 2048 + col);
            const float g0 = g.x * gt.x, g1 = g.y * gt.y, g2 = g.z * gt.z, g3 = g.w * gt.w;
#pragma unroll
            for (int r = 0; r < R; ++r) { const h16x4 y = yv[r][j]; const f4 x = xv[r][j]; const float s = rs[r];
                f4 o; o[0] = x[0] + g0 * (float)y[0] * s; o[1] = x[1] + g1 * (float)y[1] * s; o[2] = x[2] + g2 * (float)y[2] * s; o[3] = x[3] + g3 * (float)y[3] * s;
                __builtin_nontemporal_store(o, (f4*)(p.out + (size_t)(m0 + r) * DM) + lane + 64 * j); }
        }
    }
}


#define XB_TMO      128
#define XB_XCNT(j)  (256  + 64 * (j))
#define XB_XSUB(j)  (1280 + 64 * (j))
#define XB_XGEN(j)  (2304 + 64 * (j))
#define XB_TOP      3328
#define XB_TOPGEN   3392
#define XCD_BAR_WORDS 3456
#define XB_SPIN_CAP (1u << 27)
__device__ __forceinline__ unsigned xb_ld(unsigned* p)              { return __hip_atomic_load(p, __ATOMIC_RELAXED, __HIP_MEMORY_SCOPE_AGENT); }
__device__ __forceinline__ unsigned xb_add(unsigned* p, unsigned v) { return __hip_atomic_fetch_add(p, v, __ATOMIC_RELAXED, __HIP_MEMORY_SCOPE_AGENT); }
__device__ __forceinline__ unsigned xb_xcc_id() { return (unsigned)__builtin_amdgcn_s_getreg((3 << 11) | 20) & 0xFu; }
#define XB_SPIN(cond, bar) do { unsigned _sp = 0; while (cond) { __builtin_amdgcn_s_sleep(1); \
    if ((++_sp & 255u) == 0u) { if (xb_ld(&(bar)[XB_TMO])) break; if (_sp > XB_SPIN_CAP) { atomicAdd(&(bar)[XB_TMO], 1u); break; } } } } while (0)
struct XcdBarrier { unsigned* bar; unsigned x; volatile LAS unsigned* st; };
__device__ __forceinline__ XcdBarrier xcd_barrier_post(unsigned* bar, volatile LAS unsigned* st) {
    XcdBarrier b; b.bar = bar; b.x = xb_xcc_id(); b.st = st;
    if (threadIdx.x == 0) (void)xb_add(&bar[XB_XCNT(b.x)], 1u);
    return b;
}
__device__ __forceinline__ void xcd_barrier_complete(unsigned* bar, unsigned x, unsigned& nloc, unsigned& nx) {
    const unsigned G = gridDim.x * gridDim.y * gridDim.z;
    unsigned sum, cnt, mine, sp = 0u;
    for (;;) {
        sum = 0u; cnt = 0u; mine = 0u;
#pragma unroll
        for (unsigned j = 0; j < 16; ++j) { const unsigned c = xb_ld(&bar[XB_XCNT(j)]); sum += c; cnt += (c > 0u) ? 1u : 0u; mine = (j == x) ? c : mine; }
        if (sum == G) break;
        __builtin_amdgcn_s_sleep(1);
        if ((++sp & 255u) == 0u) { if (xb_ld(&bar[XB_TMO])) break; if (sp > XB_SPIN_CAP) { atomicAdd(&bar[XB_TMO], 1u); break; } }
    }
    nloc = mine > 0u ? mine : 1u; nx = cnt > 0u ? cnt : 1u;
}
__device__ __forceinline__ void xcd_barrier(const XcdBarrier& b) {
    asm volatile("s_waitcnt vmcnt(0)" ::: "memory");
    __syncthreads();
    if (threadIdx.x == 0) {
        unsigned* bar = b.bar;
        __builtin_amdgcn_s_waitcnt(0);
        unsigned nloc = b.st[0], nx = b.st[1];
        if (nloc == 0u) { xcd_barrier_complete(bar, b.x, nloc, nx); b.st[0] = nloc; b.st[1] = nx; }
        const unsigned old = xb_add(&bar[XB_XSUB(b.x)], 1u);
        const unsigned gen = old / nloc;
        if (old + 1u == (gen + 1u) * nloc) {
            __builtin_amdgcn_fence(__ATOMIC_RELEASE, "agent");
            asm volatile("s_waitcnt vmcnt(0)" ::: "memory");
            const unsigned og = xb_add(&bar[XB_TOP], 1u);
            const unsigned tg = og / nx;
            if (og + 1u == (tg + 1u) * nx) xb_add(&bar[XB_TOPGEN], 1u);
            else XB_SPIN(xb_ld(&bar[XB_TOPGEN]) == tg, bar);
            __builtin_amdgcn_fence(__ATOMIC_ACQUIRE, "agent");
            xb_add(&bar[XB_XGEN(b.x)], 1u);
            asm volatile("s_waitcnt vmcnt(0)" ::: "memory");
        } else {
            XB_SPIN(xb_ld(&bar[XB_XGEN(b.x)]) == gen, bar);
            __builtin_amdgcn_fence(__ATOMIC_ACQUIRE, "agent");
            asm volatile("s_waitcnt vmcnt(0)" ::: "memory");
        }
    }
    __syncthreads();
}

namespace pg8 {
#define PG8_LAS __attribute__((address_space(3)))
typedef unsigned short bf16_t;
typedef _Float16 bf16x8 __attribute__((ext_vector_type(8)));
typedef float f32x4 __attribute__((ext_vector_type(4)));
typedef unsigned u32x4 __attribute__((ext_vector_type(4)));
constexpr int BM = 256, BK = 64, HALF = 128, HTB = HALF * BK * 2  , STAGE_BYTES = 8 * HTB, NXCD = 8, WGM = 8;

__host__ __device__ __forceinline__ int lds_byte(int r, int c) { const int st = (r >> 4) * 2 + (c >> 5), rr = r & 15, cc = c & 31, ob = rr * 64 + cc * 2; return st * 1024 + (ob ^ (((ob >> 9) & 1) << 5)); }
__host__ __device__ __forceinline__ void stage_rc(int b, int& R, int& C) { const int st = b / 1024, sb = b % 1024, swz = sb ^ (((sb >> 9) & 1) << 5); R = (st >> 1) * 16 + swz / 64; C = (st & 1) * 32 + (swz % 64) / 2; }
__host__ __device__ __forceinline__ int perm32(int rho) { const int n = rho >> 4, i = rho & 15; return 8 * (i >> 2) + 4 * n + (i & 3); }

struct Unit { int pm, pn; };
struct Gemm { const bf16_t* A; const bf16_t* Bt; int M, N, K; };

struct StaticOrder {
    int nM, nN, nwg, G, c;
    __host__ __device__ void init(int M, int N, int G_, int c_) { nM = M / BM; nN = N / BM; nwg = nM * nN; G = G_; c = c_; }
    __host__ __device__ bool next(int i, Unit& u) const {
        const long L = (long)i * G + c; if (L >= nwg) return false;
        int wgid = (int)L; { const int q = nwg / NXCD, r = nwg % NXCD, xcd = wgid % NXCD, off = wgid / NXCD; wgid = (xcd < r ? xcd * (q + 1) : r * (q + 1) + (xcd - r) * q) + off; }
        const int nig = WGM * nN, gid = wgid / nig, fm = gid * WGM, gsz = (nM - fm) < WGM ? (nM - fm) : WGM;
        u.pm = fm + ((wgid % nig) % gsz); u.pn = (wgid % nig) / gsz; return true;
    }
    __device__ __forceinline__ void a_ready(const Unit&) const {}
    __device__ __forceinline__ void done(const Unit&) const {}
};

template <class Epi, class Sched, bool ALIGN_EPI = false, bool SP2 = false>
__device__ __forceinline__ void gemm_phase(PG8_LAS unsigned char* lds, const Gemm g, const Sched& S, const Epi& E) {
    int tid_ = threadIdx.x; asm volatile("" : "+v"(tid_));
    const int tid = tid_, wid = __builtin_amdgcn_readfirstlane(tid >> 6), lane = tid & 63, wr = wid >> 2, wc = wid & 3, fr = lane & 15, fq = lane >> 4;
    const int K = g.K, nt = K / BK;
    unsigned voffA[2], voffB[2];
#pragma unroll
    for (int i = 0; i < 2; ++i) { int R, C; stage_rc(tid * 16 + i * 8192, R, C); const int Rb = Epi::PERM ? ((R & ~31) + perm32(R & 31)) : R;
        voffA[i] = (unsigned)(R * K + C) * 2u; voffB[i] = (unsigned)(Rb * K + C) * 2u; }
    const size_t kstep = (size_t)(BK * 2);
    const size_t hstep = (size_t)HALF * K * 2;
    const size_t tstep = 2 * hstep;
    const unsigned ldsw = (unsigned)wid * 1024u;
    const int aoff = lds_byte(wr * 64 + fr, fq * 8), boff = lds_byte(wc * 32 + fr, fq * 8);
#define PG8_SA(b, h) (((b) * 2 + (h)) * HTB)
#define PG8_SB(b, h) ((4 + (b) * 2 + (h)) * HTB)
#define PG8_STAGE(bufoff, gbase, voff) do { _Pragma("unroll") for (int _i = 0; _i < 2; ++_i) \
        __builtin_amdgcn_global_load_lds((const unsigned*)((const char*)(gbase) + (voff)[_i]), (PG8_LAS unsigned*)(lds + (bufoff) + ldsw + _i * 8192), 16, 0, 0); } while (0)
#define PG8_LDA(dst, b, h) do { _Pragma("unroll") for (int m = 0; m < 4; ++m) _Pragma("unroll") for (int k = 0; k < 2; ++k) dst[m][k] = *(const PG8_LAS bf16x8*)(lds + PG8_SA(b, h) + aoff + m * 2048 + k * 1024); } while (0)
#define PG8_LDB(dst, b, h) do { _Pragma("unroll") for (int n = 0; n < 2; ++n) _Pragma("unroll") for (int k = 0; k < 2; ++k) dst[n][k] = *(const PG8_LAS bf16x8*)(lds + PG8_SB(b, h) + boff + n * 2048 + k * 1024); } while (0)
#define PG8_MMA(ai, bj, At, Bt) do { __builtin_amdgcn_s_setprio(1); _Pragma("unroll") for (int m = 0; m < 4; ++m) _Pragma("unroll") for (int n = 0; n < 2; ++n) _Pragma("unroll") for (int k = 0; k < 2; ++k) \
        acc[ai][bj][m][n] = __builtin_amdgcn_mfma_f32_16x16x32_f16(Bt[n][k], At[m][k], acc[ai][bj][m][n], 0, 0, 0); __builtin_amdgcn_s_setprio(0); } while (0)
#define PG8_WAIT_V(n) asm volatile("s_waitcnt vmcnt(" #n ")" ::: "memory")
#define PG8_WAIT_L(n) asm volatile("s_waitcnt lgkmcnt(" #n ")" ::: "memory")
#define PG8_BAR __builtin_amdgcn_s_barrier()
#define PG8_SCHED __builtin_amdgcn_sched_barrier(0)
    Unit cur, nxt; int ui = 0;
    if (!S.next(0, cur)) return;
    f32x4 acc[2][2][4][2];
#pragma unroll
    for (int a = 0; a < 2; ++a)
#pragma unroll
        for (int b = 0; b < 2; ++b)
#pragma unroll
            for (int m = 0; m < 4; ++m)
#pragma unroll
                for (int n = 0; n < 2; ++n) acc[a][b][m][n] = (f32x4){0.f, 0.f, 0.f, 0.f};
    bf16x8 At[4][2], B0[2][2], B1[2][2];
    const char* cA = (const char*)g.A + (size_t)cur.pm * tstep; const char* cB = (const char*)g.Bt + (size_t)cur.pn * tstep;
    S.a_ready(cur);
    if constexpr (SP2) {
        PG8_STAGE(PG8_SB(0, 0), cB, voffB); PG8_STAGE(PG8_SB(0, 1), cB + hstep, voffB); PG8_STAGE(PG8_SA(0, 0), cA, voffA); PG8_STAGE(PG8_SA(0, 1), cA + hstep, voffA);
        if (wr == 1) PG8_BAR;
        PG8_WAIT_V(2); PG8_BAR;
        PG8_STAGE(PG8_SB(1, 0), cB + kstep, voffB); PG8_STAGE(PG8_SA(1, 0), cA + kstep, voffA); PG8_STAGE(PG8_SB(1, 1), cB + hstep + kstep, voffB);
        PG8_WAIT_V(6); PG8_BAR;
    } else {
        PG8_STAGE(PG8_SB(0, 0), cB, voffB); PG8_STAGE(PG8_SA(0, 0), cA, voffA); PG8_STAGE(PG8_SB(0, 1), cB + hstep, voffB); PG8_STAGE(PG8_SA(0, 1), cA + hstep, voffA);
        if (wr == 1) PG8_BAR;
        PG8_WAIT_V(4); PG8_BAR;
        PG8_STAGE(PG8_SB(1, 0), cB + kstep, voffB); PG8_STAGE(PG8_SA(1, 0), cA + kstep, voffA); PG8_STAGE(PG8_SB(1, 1), cB + hstep + kstep, voffB);
        PG8_WAIT_V(6); PG8_BAR;
    }
    for (;;) {
        const bool has_next = S.next(ui + 1, nxt);
        const char* nA = has_next ? (const char*)g.A + (size_t)nxt.pm * tstep : cA; const char* nB = has_next ? (const char*)g.Bt + (size_t)nxt.pn * tstep : cB;
#pragma nounroll
        for (int t = 0; t < nt; t += 2) {
            const bool last = (t == nt - 2);
            if constexpr (Epi::MID_T > 0) { if (t == Epi::MID_T) E.mid(acc, cur, wr, wc); }
            const char* a1 = cA + (size_t)(t + 1) * kstep;
            const char* a2 = last ? nA : cA + (size_t)(t + 2) * kstep; const char* b2 = last ? nB : cB + (size_t)(t + 2) * kstep;
            const char* a3 = a2 + kstep; const char* b3 = b2 + kstep;
            if (last && has_next) S.a_ready(nxt);
            if constexpr (SP2) {
            PG8_LDB(B0, 0, 0); PG8_LDB(B1, 0, 1); PG8_SCHED; PG8_LDA(At, 0, 0); PG8_STAGE(PG8_SA(1, 1), a1 + hstep, voffA);
            PG8_WAIT_V(8); PG8_WAIT_L(0); PG8_BAR; PG8_MMA(0, 0, At, B0); PG8_MMA(0, 1, At, B1); PG8_BAR; PG8_SCHED;
            PG8_LDA(At, 0, 1); PG8_STAGE(PG8_SB(0, 0), b2, voffB); PG8_STAGE(PG8_SB(0, 1), b2 + hstep, voffB); PG8_STAGE(PG8_SA(0, 0), a2, voffA);
            PG8_WAIT_V(8); PG8_WAIT_L(0); PG8_BAR; PG8_MMA(1, 0, At, B0); PG8_MMA(1, 1, At, B1); PG8_BAR; PG8_SCHED;
            PG8_LDB(B0, 1, 0); PG8_LDB(B1, 1, 1); PG8_SCHED; PG8_LDA(At, 1, 0); PG8_STAGE(PG8_SA(0, 1), a2 + hstep, voffA);
            PG8_WAIT_V(8); PG8_WAIT_L(0); PG8_BAR; PG8_MMA(0, 0, At, B0); PG8_MMA(0, 1, At, B1); PG8_BAR; PG8_SCHED;
            PG8_LDA(At, 1, 1); PG8_STAGE(PG8_SB(1, 0), b3, voffB); PG8_STAGE(PG8_SB(1, 1), b3 + hstep, voffB); PG8_STAGE(PG8_SA(1, 0), a3, voffA);
            PG8_WAIT_V(8); PG8_WAIT_L(0); PG8_BAR; PG8_MMA(1, 0, At, B0); PG8_MMA(1, 1, At, B1); PG8_BAR; PG8_SCHED;
            } else {
            PG8_LDB(B0, 0, 0); PG8_SCHED; PG8_LDA(At, 0, 0); PG8_STAGE(PG8_SA(1, 1), a1 + hstep, voffA);
            PG8_WAIT_L(8); PG8_BAR; PG8_WAIT_L(0); PG8_MMA(0, 0, At, B0); PG8_BAR; PG8_SCHED;
            PG8_LDB(B1, 0, 1); PG8_STAGE(PG8_SB(0, 0), b2, voffB);
            PG8_BAR; PG8_WAIT_L(0); PG8_MMA(0, 1, At, B1); PG8_BAR;
            PG8_LDA(At, 0, 1); PG8_STAGE(PG8_SA(0, 0), a2, voffA);
            PG8_BAR; PG8_WAIT_L(0); PG8_MMA(1, 0, At, B0); PG8_BAR; PG8_SCHED;
            PG8_STAGE(PG8_SB(0, 1), b2 + hstep, voffB);
            PG8_WAIT_V(6); PG8_BAR; PG8_MMA(1, 1, At, B1); PG8_BAR;
            PG8_LDB(B0, 1, 0); PG8_SCHED; PG8_LDA(At, 1, 0); PG8_STAGE(PG8_SA(0, 1), a2 + hstep, voffA);
            PG8_WAIT_L(8); PG8_BAR; PG8_WAIT_L(0); PG8_MMA(0, 0, At, B0); PG8_BAR; PG8_SCHED;
            PG8_LDB(B1, 1, 1); PG8_STAGE(PG8_SB(1, 0), b3, voffB);
            PG8_BAR; PG8_WAIT_L(0); PG8_MMA(0, 1, At, B1); PG8_BAR;
            PG8_LDA(At, 1, 1); PG8_STAGE(PG8_SA(1, 0), a3, voffA);
            PG8_BAR; PG8_WAIT_L(0); PG8_MMA(1, 0, At, B0); PG8_BAR; PG8_SCHED;
            PG8_STAGE(PG8_SB(1, 1), b3 + hstep, voffB);
            PG8_WAIT_V(6); PG8_BAR; PG8_MMA(1, 1, At, B1); PG8_BAR;
            }
        }
        if constexpr (ALIGN_EPI) { if (wr == 0) PG8_BAR; }
        if constexpr (!Epi::AFTER_DRAIN) { E(acc, cur, wr, wc, fr, fq); S.done(cur); }
        if (!has_next) break;
#pragma unroll
        for (int a = 0; a < 2; ++a)
#pragma unroll
            for (int b = 0; b < 2; ++b)
#pragma unroll
                for (int m = 0; m < 4; ++m)
#pragma unroll
                    for (int n = 0; n < 2; ++n) acc[a][b][m][n] = (f32x4){0.f, 0.f, 0.f, 0.f};
        cur = nxt; cA = nA; cB = nB; ++ui;
        if constexpr (ALIGN_EPI) { if (wr == 1) PG8_BAR; }
    }
    PG8_WAIT_V(0);
    if constexpr (!ALIGN_EPI) { if (wr == 0) PG8_BAR; }
    PG8_BAR;
    if constexpr (Epi::AFTER_DRAIN) { E.fused(acc, cur, wr, wc, fr, fq, lds, wid, lane); S.done(cur); }
#undef PG8_SA
#undef PG8_SB
#undef PG8_STAGE
#undef PG8_LDA
#undef PG8_LDB
#undef PG8_MMA
#undef PG8_WAIT_V
#undef PG8_WAIT_L
#undef PG8_BAR
#undef PG8_SCHED
}
typedef _Float16 h8v __attribute__((ext_vector_type(8)));
typedef unsigned u32x2 __attribute__((ext_vector_type(2)));
typedef _Float16 h2v __attribute__((ext_vector_type(2)));
__device__ __forceinline__ unsigned pk_h2(float lo, float hi) { h2v v; v[0] = (_Float16)lo; v[1] = (_Float16)hi; return __builtin_bit_cast(unsigned, v); }
__device__ __forceinline__ u32x4 pack8(const f32x4& a, const f32x4& b) { u32x4 w; w.x = pk_h2(a[0], a[1]); w.y = pk_h2(a[2], a[3]); w.z = pk_h2(b[0], b[1]); w.w = pk_h2(b[2], b[3]); return w; }
__device__ __forceinline__ float sigm1(float v) { return __builtin_amdgcn_rcpf(1.f + __builtin_amdgcn_exp2f(v * -1.4426950408889634f)); }
__device__ __forceinline__ float silu1(float v) { return v * sigm1(v); }
__device__ __forceinline__ f32x4 silu4(const f32x4& v) { return (f32x4){silu1(v[0]), silu1(v[1]), silu1(v[2]), silu1(v[3])}; }
__device__ __forceinline__ f32x4 sigm4(const f32x4& v) { return (f32x4){sigm1(v[0]), sigm1(v[1]), sigm1(v[2]), sigm1(v[3])}; }

#define PG8_OPAQUE(fr_, fq_) int lane_x; asm volatile("v_mbcnt_lo_u32_b32 %0, -1, 0\n\tv_mbcnt_hi_u32_b32 %0, -1, %0" : "=v"(lane_x)); const int frx = lane_x & 15, fqx = lane_x >> 4
__device__ __forceinline__ void st16(unsigned char* base, unsigned off, const u32x4& v) { *(u32x4*)(base + off) = v; }
__device__ __forceinline__ f32x4 ld16f(const unsigned char* base, unsigned off) { return *(const f32x4*)(base + off); }
__device__ __forceinline__ float ld4f(const unsigned char* base, unsigned off) { return *(const float*)(base + off); }
__device__ __forceinline__ h8v ld16h(const unsigned char* base, unsigned off) { return *(const h8v*)(base + off); }
__device__ __forceinline__ float sumsq8(const f32x4& a, const f32x4& b) { return (a[0] * a[0] + a[1] * a[1]) + (a[2] * a[2] + a[3] * a[3]) + (b[0] * b[0] + b[1] * b[1]) + (b[2] * b[2] + b[3] * b[3]); }
__device__ __forceinline__ void rope4(const f32x4& t1, const f32x4& t2, const u32x4& cs, f32x4& o1, f32x4& o2) {
#pragma unroll
    for (int j = 0; j < 4; ++j) { const unsigned wj = cs[j]; h2v w; __builtin_memcpy(&w, &wj, 4);
        const float c = (float)w[0], s = (float)w[1]; o1[j] = t1[j] * c - t2[j] * s; o2[j] = t2[j] * c + t1[j] * s; }
}
__device__ __forceinline__ u32x4 ld16u(const unsigned char* base, unsigned off) { return *(const u32x4*)(base + off); }

struct EpiInF {
    static constexpr bool PERM = true, AFTER_DRAIN = false; static constexpr int MID_T = 0;
    unsigned char* ws; const float* b_merge; int noatomic;
    template <bool ISQ> __device__ __forceinline__ void rope_tile(const f32x4 (&acc)[2][2][4][2], const Unit& u, int wr, int wc, int frx, int fqx) const {
        const int pn = u.pn; const unsigned row0 = (unsigned)(u.pm * 256 + wr * 64) + (unsigned)frx; const float sc = ISQ ? SC_MB : 1.f;
        unsigned char* dst = ws + (ISQ ? WS_QMB : WS_KMB); const unsigned char* tab = ws + WS_TAB;
        const unsigned o0 = row0 * 1024u + (((pn & 1) ? 256u : 0u) + 64u * wc + 8u * fqx) * 2u, t0 = row0 * 128u + 32u * fqx;
        f32x4 c1[2] = {{0.f, 0.f, 0.f, 0.f}, {0.f, 0.f, 0.f, 0.f}}, c2[2] = {{0.f, 0.f, 0.f, 0.f}, {0.f, 0.f, 0.f, 0.f}};
        u32x4 cs[2][4][2];
#pragma unroll
        for (int ai = 0; ai < 2; ++ai)
#pragma unroll
            for (int m = 0; m < 4; ++m) { const unsigned to = t0 + (unsigned)(ai * 128 + m * 16) * 128u; cs[ai][m][0] = ld16u(tab, to); cs[ai][m][1] = ld16u(tab, to + 16u); }
#pragma unroll
        for (int ai = 0; ai < 2; ++ai)
#pragma unroll
            for (int m = 0; m < 4; ++m) { const unsigned ro = o0 + (unsigned)(ai * 128 + m * 16) * 1024u;
                f32x4 o1[2], o2[2];
#pragma unroll
                for (int n = 0; n < 2; ++n) { rope4(acc[ai][0][m][n], acc[ai][1][m][n], cs[ai][m][n], o1[n], o2[n]);
                    if (!ISQ) { c1[n] += o1[n]; c2[n] += o2[n]; } }
                st16(dst, ro, pack8(o1[0] * sc, o1[1] * sc)); st16(dst, ro + 64u, pack8(o2[0] * sc, o2[1] * sc));
                if (!ISQ) asm volatile("" : "+v"(c1[0]), "+v"(c1[1]), "+v"(c2[0]), "+v"(c2[1])); }
        if (!ISQ) {
            float* km = (float*)(ws + WS_KMEAN) + (size_t)u.pm * 512 + ((pn & 1) ? 256 : 0) + 64 * wc + 8 * fqx;
#pragma unroll
            for (int n = 0; n < 2; ++n)
#pragma unroll
                for (int j = 0; j < 4; ++j) { float a = c1[n][j], b = c2[n][j];
#pragma unroll
                    for (int o = 1; o < 16; o <<= 1) { a += __shfl_xor(a, o); b += __shfl_xor(b, o); }
                    if (frx == 0 && !noatomic) { atomicAdd(km + 4 * n + j, a * (1.f / 256.f)); atomicAdd(km + 32 + 4 * n + j, b * (1.f / 256.f)); } }
        }
    }
    __device__ __forceinline__ void operator()(const f32x4 (&acc)[2][2][4][2], const Unit& u, int wr, int wc, int fr, int fq) const {
        PG8_OPAQUE(fr, fq);
        const int pn = u.pn; const unsigned row0 = (unsigned)(u.pm * 256 + wr * 64) + (unsigned)frx, cl = 32u * wc + 8u * fqx;
        if (pn == 0) {
            unsigned char* dst = ws + WS_QLAT; float* ssq = (float*)(ws + WS_SSQ); const unsigned o0 = row0 * 512u + cl * 2u;
#pragma unroll
            for (int ai = 0; ai < 2; ++ai)
#pragma unroll
                for (int m = 0; m < 4; ++m) { const unsigned ro = o0 + (unsigned)(ai * 128 + m * 16) * 512u; float s = 0.f;
#pragma unroll
                    for (int bj = 0; bj < 2; ++bj) { s += sumsq8(acc[ai][bj][m][0], acc[ai][bj][m][1]); st16(dst, ro + bj * 256u, pack8(acc[ai][bj][m][0], acc[ai][bj][m][1])); }
                    s += __shfl_xor(s, 16); s += __shfl_xor(s, 32);
                    if (fqx == 0 && !noatomic) atomicAdd(ssq + (row0 + ai * 128 + m * 16), s); }
        } else if (pn == 1) {
            unsigned char* kvl = ws + WS_KVL; unsigned char* kpe = ws + WS_KPE; float* ssq = (float*)(ws + WS_SSQ) + M_; const unsigned char* tab = ws + WS_TAB;
#pragma unroll
            for (int ai = 0; ai < 2; ++ai)
#pragma unroll
                for (int m = 0; m < 4; ++m) { const unsigned row = row0 + ai * 128 + m * 16;
                    if (wc < 2) { float s = 0.f;
#pragma unroll
                        for (int bj = 0; bj < 2; ++bj) { s += sumsq8(acc[ai][bj][m][0], acc[ai][bj][m][1]); st16(kvl, row * 256u + (bj * 64u + cl) * 2u, pack8(acc[ai][bj][m][0], acc[ai][bj][m][1])); }
                        s += __shfl_xor(s, 16); s += __shfl_xor(s, 32);
                        if (fqx == 0 && !noatomic) atomicAdd(ssq + row, s);
                    } else {
                        if (wc == 2 && fqx < 2) {
                            f32x4 o1[2], o2[2];
#pragma unroll
                            for (int n = 0; n < 2; ++n) { const unsigned to = row * 128u + (unsigned)(16 * fqx + 8 * n) * 4u; const u32x4 wa = ld16u(tab, to), wb = ld16u(tab, to + 16u);
                                rope4(acc[ai][0][m][n], acc[ai][1][m][n], (u32x4){wa[0], wa[2], wb[0], wb[2]}, o1[n], o2[n]); }
                            st16(kpe, row * 64u + 16u * fqx, pack8(o1[0], o1[1])); st16(kpe, row * 64u + 32u + 16u * fqx, pack8(o2[0], o2[1]));
                        }
                    }
                    asm volatile("" ::: "memory"); }
        } else if (pn < 4 || (pn >= 8 && pn < 12)) {
            const bool act = (pn < 4) || (pn >= 10); const unsigned pitch = act ? 2048u : 1024u;
            unsigned char* dst = ws + (act ? WS_ZCAT : WS_VMB); const unsigned o0 = row0 * pitch + ((pn >= 10 ? 512u : 0u) + ((pn & 1) ? 256u : 0u) + cl) * 2u;
#pragma unroll
            for (int ai = 0; ai < 2; ++ai)
#pragma unroll
                for (int m = 0; m < 4; ++m) { const unsigned ro = o0 + (unsigned)(ai * 128 + m * 16) * pitch;
#pragma unroll
                    for (int bj = 0; bj < 2; ++bj) { f32x4 a = acc[ai][bj][m][0], b = acc[ai][bj][m][1]; if (act) { a = silu4(a); b = silu4(b); }
                        st16(dst, ro + bj * 256u, pack8(a, b)); } }
        } else if (pn < 6) { rope_tile<true>(acc, u, wr, wc, frx, fqx);
        } else if (pn < 8) { rope_tile<false>(acc, u, wr, wc, frx, fqx);
        } else {
            const bool isa = pn < 16; unsigned char* dst = ws + (isa ? WS_GA : WS_GB); const unsigned cg = 256u * ((pn - 12) & 3) + cl;
            const unsigned char* bm = (const unsigned char*)(b_merge + (isa ? 0 : 1024)); const unsigned o0 = row0 * 1024u + cg;
            f32x4 bv[2][2];
#pragma unroll
            for (int bj = 0; bj < 2; ++bj)
#pragma unroll
                for (int n = 0; n < 2; ++n) bv[bj][n] = ld16f(bm, (cg + bj * 128u + 4u * n) * 4u);
#pragma unroll
            for (int ai = 0; ai < 2; ++ai)
#pragma unroll
                for (int m = 0; m < 4; ++m) { const unsigned ro = o0 + (unsigned)(ai * 128 + m * 16) * 1024u;
#pragma unroll
                    for (int bj = 0; bj < 2; ++bj) { const f32x4 a = sigm4(acc[ai][bj][m][0] + bv[bj][0]) * 255.f + 0.5f, b = sigm4(acc[ai][bj][m][1] + bv[bj][1]) * 255.f + 0.5f;
                        u32x2 w; w.x = (unsigned)a[0] | ((unsigned)a[1] << 8) | ((unsigned)a[2] << 16) | ((unsigned)a[3] << 24); w.y = (unsigned)b[0] | ((unsigned)b[1] << 8) | ((unsigned)b[2] << 16) | ((unsigned)b[3] << 24);
                        *(u32x2*)(dst + (ro + bj * 128u)) = w; } }
        }
    }
};
struct EpiNull {
    static constexpr bool PERM = true, AFTER_DRAIN = false; static constexpr int MID_T = 0;
    __device__ __forceinline__ void operator()(const f32x4 (&acc)[2][2][4][2], const Unit& u, int wr, int wc, int fr, int fq) const {
#pragma unroll
        for (int ai = 0; ai < 2; ++ai)
#pragma unroll
            for (int bj = 0; bj < 2; ++bj)
#pragma unroll
                for (int m = 0; m < 4; ++m) asm volatile("" :: "v"(acc[ai][bj][m][0]), "v"(acc[ai][bj][m][1]));
    }
};
struct EpiUqF {
    static constexpr bool PERM = true, AFTER_DRAIN = false; static constexpr int MID_T = 0;
    unsigned char* ws;
    __device__ __forceinline__ void operator()(const f32x4 (&acc)[2][2][4][2], const Unit& u, int wr, int wc, int fr, int fq) const {
        PG8_OPAQUE(fr, fq);
        const int pn = u.pn; const unsigned row0 = (unsigned)(u.pm * 256 + wr * 64) + (unsigned)frx; unsigned char* Q = ws + WS_QMLA; const unsigned char* ssq = ws + WS_SSQ; const unsigned char* tab = ws + WS_TAB;
        float rsv[2][4];
#pragma unroll
        for (int ai = 0; ai < 2; ++ai)
#pragma unroll
            for (int m = 0; m < 4; ++m) rsv[ai][m] = ld4f(ssq, (row0 + ai * 128 + m * 16) * 4u);
#pragma unroll
        for (int ai = 0; ai < 2; ++ai)
#pragma unroll
            for (int m = 0; m < 4; ++m) { const unsigned row = row0 + ai * 128 + m * 16; const float rs = SC_MLA * __builtin_amdgcn_rsqf(rsv[ai][m] * (1.f / 256.f) + EPS);
                if (pn < 2) {
#pragma unroll
                    for (int bj = 0; bj < 2; ++bj) { const unsigned head = 4u * pn + 2u * bj + (wc >> 1), d = 32u * (wc & 1) + 8u * fqx;
                        st16(Q, row * 1536u + (96u * head + d) * 2u, pack8(acc[ai][bj][m][0] * rs, acc[ai][bj][m][1] * rs)); }
                } else { const unsigned head = 2u * wc + ((unsigned)fqx >> 1), i0 = 8u * (fqx & 1); f32x4 o1[2], o2[2];
#pragma unroll
                    for (int n = 0; n < 2; ++n) { const unsigned to = row * 128u + (2u * (i0 + 4u * n)) * 4u; const u32x4 wa = ld16u(tab, to), wb = ld16u(tab, to + 16u);
                        rope4(acc[ai][0][m][n] * rs, acc[ai][1][m][n] * rs, (u32x4){wa[0], wa[2], wb[0], wb[2]}, o1[n], o2[n]); }
                    st16(Q, row * 1536u + (96u * head + 64u + i0) * 2u, pack8(o1[0], o1[1])); st16(Q, row * 1536u + (96u * head + 80u + i0) * 2u, pack8(o2[0], o2[1])); } }
    }
};
struct EpiUkvF {
    static constexpr bool PERM = true, AFTER_DRAIN = false; static constexpr int MID_T = 0;
    unsigned char* ws;
    __device__ __forceinline__ void operator()(const f32x4 (&acc)[2][2][4][2], const Unit& u, int wr, int wc, int fr, int fq) const {
        PG8_OPAQUE(fr, fq);
        const int pn = u.pn; const unsigned row0 = (unsigned)(u.pm * 256 + wr * 64) + (unsigned)frx; unsigned char* dst = ws + (pn < 2 ? WS_KN : WS_VM); const unsigned char* ssq = ws + WS_SSQ + (size_t)M_ * 4;
        float rsv[2][4];
#pragma unroll
        for (int ai = 0; ai < 2; ++ai)
#pragma unroll
            for (int m = 0; m < 4; ++m) rsv[ai][m] = ld4f(ssq, (row0 + ai * 128 + m * 16) * 4u);
#pragma unroll
        for (int ai = 0; ai < 2; ++ai)
#pragma unroll
            for (int m = 0; m < 4; ++m) { const unsigned row = row0 + ai * 128 + m * 16; const float rs = __builtin_amdgcn_rsqf(rsv[ai][m] * (1.f / 128.f) + EPS);
#pragma unroll
                for (int bj = 0; bj < 2; ++bj) { const unsigned head = 4u * (pn & 1) + 2u * bj + (wc >> 1), d = 32u * (wc & 1) + 8u * fqx;
                    st16(dst, row * 1024u + (64u * head + d) * 2u, pack8(acc[ai][bj][m][0] * rs, acc[ai][bj][m][1] * rs)); } }
    }
};
struct EpiYcatF {
    static constexpr bool PERM = true, AFTER_DRAIN = false; static constexpr int MID_T = 8;
    unsigned char* ws;
    template <bool MID> __device__ __forceinline__ void run(f32x4 (&acc)[2][2][4][2], const Unit& u, int wr, int wc) const {
        PG8_OPAQUE(0, 0);
        const unsigned row0 = (unsigned)(u.pm * 256 + wr * 64) + (unsigned)frx, c0 = u.pn * 256u + 32u * wc + 8u * fqx, o0 = row0 * 2048u + c0 * 2u, g0 = row0 * 1024u + c0;
        const unsigned char* GA = ws + WS_GA; const unsigned char* GB = ws + WS_GB; unsigned char* YM = ws + WS_YM;
#pragma unroll
        for (int ai = 0; ai < 2; ++ai) {
            u32x2 ga[4][2], gb[4][2];
#pragma unroll
            for (int m = 0; m < 4; ++m)
#pragma unroll
                for (int bj = 0; bj < 2; ++bj) { const unsigned go = g0 + (unsigned)(ai * 128 + m * 16) * 1024u + bj * 128u; gb[m][bj] = *(const u32x2*)(GB + go); if (MID) ga[m][bj] = *(const u32x2*)(GA + go); }
#pragma unroll
            for (int m = 0; m < 4; ++m)
#pragma unroll
                for (int bj = 0; bj < 2; ++bj) { const unsigned off = o0 + (unsigned)(ai * 128 + m * 16) * 2048u + bj * 256u; f32x4 s0, s1;
#pragma unroll
                    for (int j = 0; j < 4; ++j) { const float b0 = fmaxf((float)((gb[m][bj].x >> (8 * j)) & 0xffu), 0.5f), b1 = fmaxf((float)((gb[m][bj].y >> (8 * j)) & 0xffu), 0.5f);
                        s0[j] = MID ? (float)((ga[m][bj].x >> (8 * j)) & 0xffu) * __builtin_amdgcn_rcpf(b0) : b0 * (1.f / 255.f);
                        s1[j] = MID ? (float)((ga[m][bj].y >> (8 * j)) & 0xffu) * __builtin_amdgcn_rcpf(b1) : b1 * (1.f / 255.f); }
                    acc[ai][bj][m][0] *= s0; acc[ai][bj][m][1] *= s1;
                    if (!MID) st16(YM, off, pack8(acc[ai][bj][m][0], acc[ai][bj][m][1])); }
            asm volatile("" ::: "memory"); }
    }
    __device__ __forceinline__ void mid(f32x4 (&acc)[2][2][4][2], const Unit& u, int wr, int wc) const { run<true>(acc, u, wr, wc); }
    __device__ __forceinline__ void operator()(f32x4 (&acc)[2][2][4][2], const Unit& u, int wr, int wc, int fr, int fq) const { run<false>(acc, u, wr, wc); }
};
struct EpiYF {
    static constexpr bool PERM = true, AFTER_DRAIN = false; static constexpr int MID_T = 0;
    unsigned char* ws;
    __device__ __forceinline__ void operator()(const f32x4 (&acc)[2][2][4][2], const Unit& u, int wr, int wc, int fr, int fq) const {
        PG8_OPAQUE(fr, fq);
        const unsigned row0 = (unsigned)(u.pm * 256 + wr * 64) + (unsigned)frx, c0 = u.pn * 256u + 32u * wc + 8u * fqx, o0 = row0 * 2048u + c0 * 2u; unsigned char* Y = ws + WS_Y; float* ssq = (float*)(ws + WS_SSQY);
#pragma unroll
        for (int ai = 0; ai < 2; ++ai)
#pragma unroll
            for (int m = 0; m < 4; ++m) { float s = 0.f;
#pragma unroll
                for (int bj = 0; bj < 2; ++bj) { s += sumsq8(acc[ai][bj][m][0], acc[ai][bj][m][1]); st16(Y, o0 + (unsigned)(ai * 128 + m * 16) * 2048u + bj * 256u, pack8(acc[ai][bj][m][0], acc[ai][bj][m][1])); }
                s += __shfl_xor(s, 16); s += __shfl_xor(s, 32);
                if (fqx == 0) atomicAdd(ssq + (row0 + ai * 128 + m * 16), s); }
    }
};
}

struct MapIn { __device__ int operator()(int n) const { const int t = n >> 8, tc = n & 255, bj = tc >> 7, uu = tc & 127;
    if (t == 0) return n;
    if (t == 1) return uu < 64 ? C_KVLAT + 64 * bj + uu : (uu < 80 ? C_KROPE + 16 * bj + (uu - 64) : -1);
    if (t < 4) return C_ZMLA + (n - 512);
    if (t < 8) return (t < 6 ? C_QMB : C_KMB) + 256 * (t & 1) + 64 * (uu >> 5) + 32 * bj + (uu & 31);
    if (t < 10) return C_VMB + (n - 2048);
    if (t < 12) return C_ZMB + (n - 2560);
    if (t < 16) return C_GA + (n - 3072);
    return C_GB + (n - 4096); } };
struct MapUq { __device__ int operator()(int n) const { const int t = n >> 8, tc = n & 255, bj = tc >> 7, uu = tc & 127;
    if (t < 2) return 96 * (4 * t + (tc >> 6)) + (tc & 63);
    return 96 * (uu >> 4) + 64 + 16 * bj + (uu & 15); } };
struct MapUkv { __device__ int operator()(int n) const { const int t = n >> 8, tc = n & 255; return 128 * (4 * (t & 1) + (tc >> 6)) + (t < 2 ? 0 : 64) + (tc & 63); } };
struct MapId { __device__ int operator()(int n) const { return n; } };
template <class Map> __device__ __forceinline__ void wt_items(const float* W, int ldw, int Kreal, int K, int N, unsigned short* WT, const float* kscale, Map map, LAS float* scr, int gw, int ngw, int lane, int ldk = 0, int koff = 0) {
    if (ldk == 0) ldk = K;
    const int nblk = N / 64, nitems = (K / 32) * nblk; typedef float f4 __attribute__((ext_vector_type(4)));
    for (int it = gw; it < nitems; it += ngw) {
        const int kb = it / nblk, nb = it % nblk, k0 = 32 * kb, n0 = 64 * nb; const int src = map(n0 + 4 * (lane & 15));
        f4 wv[8];
#pragma unroll
        for (int i = 0; i < 8; ++i) { const int k = k0 + 4 * i + (lane >> 4); wv[i] = (src >= 0 && k < Kreal) ? *(const f4*)(W + (size_t)k * ldw + src) : (f4){0.f, 0.f, 0.f, 0.f}; }
#pragma unroll
        for (int i = 0; i < 8; ++i) { const int kk = 4 * i + (lane >> 4), k = k0 + kk; f4 v = wv[i]; if (kscale && k < Kreal) v = v * kscale[k]; *(LAS f4*)(scr + kk * 68 + 4 * (lane & 15)) = v; }
        asm volatile("s_waitcnt lgkmcnt(0)" ::: "memory");
#pragma unroll
        for (int j = 0; j < 4; ++j) { const int q = lane + 64 * j, n = q >> 2, c = q & 3; const LAS float* s = scr + (8 * c) * 68 + n;
            pg8::u32x4 o; o.x = pg8::pk_h2(s[0 * 68], s[1 * 68]); o.y = pg8::pk_h2(s[2 * 68], s[3 * 68]); o.z = pg8::pk_h2(s[4 * 68], s[5 * 68]); o.w = pg8::pk_h2(s[6 * 68], s[7 * 68]);
            *(pg8::u32x4*)(WT + (size_t)(n0 + n) * ldk + koff + k0 + 8 * c) = o; }
        asm volatile("s_waitcnt lgkmcnt(0)" ::: "memory");
    }
}
constexpr size_t WT_IN = WS_WT, WT_UQ = WS_WT + 10 * MiB, WT_UKV = WT_UQ + 512 * 1024, WT_OA = WS_WT + 11 * MiB, WT_OB = WS_WT + 12 * MiB, WT_OUT = WS_WT + 13 * MiB;
__device__ __forceinline__ void ph_weights(const Params& p, LAS unsigned char* lds, int gw, int ngw, int wave, int lane) {
    LAS float* scr = (LAS float*)(lds + wave * 16384);
    wt_items(p.w_in, D_IN, 1024, 1024, 5120, (unsigned short*)(p.ws + WT_IN), nullptr, MapIn(), scr, gw, ngw, lane);
    wt_items(p.w_uq, 768, 256, 256, 768, (unsigned short*)(p.ws + WT_UQ), p.g_q, MapUq(), scr, gw, ngw, lane);
    wt_items(p.w_ukv, 1024, 128, 128, 1024, (unsigned short*)(p.ws + WT_UKV), p.g_kv, MapUkv(), scr, gw, ngw, lane);
    wt_items(p.w_o_mla, 1024, 512, 512, 1024, (unsigned short*)(p.ws + WT_OA), nullptr, MapId(), scr, gw, ngw, lane, 1024, 0);
    wt_items(p.w_o_moba, 1024, 512, 512, 1024, (unsigned short*)(p.ws + WT_OA), nullptr, MapId(), scr, gw, ngw, lane, 1024, 512);
    wt_items(p.w_out, 1024, 1024, 1024, 1024, (unsigned short*)(p.ws + WT_OUT), nullptr, MapId(), scr, gw, ngw, lane);
}

namespace att {
struct T1 { static constexpr bool value = true; }; struct T0 { static constexpr bool value = false; };
typedef _Float16 h8 __attribute__((ext_vector_type(8)));
typedef short s4 __attribute__((ext_vector_type(4)));
typedef short s8 __attribute__((ext_vector_type(8)));
typedef float f16v __attribute__((ext_vector_type(16)));
typedef unsigned u4 __attribute__((ext_vector_type(4)));
typedef short v4i16_t __attribute__((ext_vector_type(4)));
constexpr int KBUF = 16384, VBUF = 8192;
constexpr int NBUF = 4;
constexpr int L_K = 0, L_V = NBUF * KBUF, L_WS = L_V + NBUF * VBUF, L_TB = L_WS + 8 * 256, L_UN = L_TB + 256, L_END = L_UN + 64, L_OST = 0;
constexpr float THR = 8.f;
#ifndef PROBE_ABL
#define PROBE_ABL 0
#endif
#ifndef ATT_STAGGER
#define ATT_STAGGER 0
#endif
constexpr bool STAGGER = ATT_STAGGER;
__device__ __forceinline__ int crow(int r, int hi) { return (r & 3) + 8 * (r >> 2) + 4 * hi; }
template <int DK> __device__ __forceinline__ int kaddr(int row, int ch) { return DK == 64 ? row * 128 + ((ch ^ ((row >> 1) & 7)) << 4) : row * 256 + ((ch ^ (row & 15)) << 4); }
__device__ __forceinline__ s4 vtr(const LAS unsigned char* p) { return __builtin_bit_cast(s4, __builtin_amdgcn_ds_read_tr16_b64_v4i16((LAS v4i16_t*)p)); }
__device__ __forceinline__ float swapmax(float m) { auto rr = __builtin_amdgcn_permlane32_swap(__float_as_uint(m), __float_as_uint(m), false, false); return fmaxf(__uint_as_float(rr[0]), __uint_as_float(rr[1])); }
__device__ __forceinline__ float swapsum(float m) { auto rr = __builtin_amdgcn_permlane32_swap(__float_as_uint(m), __float_as_uint(m), false, false); return __uint_as_float(rr[0]) + __uint_as_float(rr[1]); }
__device__ __forceinline__ void glds16(const void* g, unsigned lds_base) { unsigned sv;
    asm volatile("s_mov_b32 %0, m0\n\ts_mov_b32 m0, %2\n\ts_nop 0\n\tglobal_load_lds_dwordx4 %1, off\n\ts_mov_b32 m0, %0" : "=&s"(sv) : "v"(g), "s"(lds_base) : "memory"); }
__device__ __forceinline__ float max3f(float a, float b, float c) { float r; asm("v_max3_f32 %0, %1, %2, %3" : "=v"(r) : "v"(a), "v"(b), "v"(c)); return r; }
__device__ __forceinline__ unsigned pkh(float lo, float hi) { typedef _Float16 h2 __attribute__((ext_vector_type(2))); h2 v; v[0] = (_Float16)lo; v[1] = (_Float16)hi; return __builtin_bit_cast(unsigned, v); }

template <int DK, bool MOBA, int ABL = 0, bool OWN = false>
__device__ __forceinline__ void attn_unit(unsigned char* ws, int b, int h, int qb, LAS unsigned char* lds, bool dry = false) {
    constexpr int ND = DK / 16, QP = MOBA ? 512 : 768, QH = MOBA ? 64 : 96;
    int tid_ = threadIdx.x; asm volatile("" : "+v"(tid_));
    const int tid = tid_, lane = tid & 63, r32 = lane & 31, hi = lane >> 5; const int wid = __builtin_amdgcn_readfirstlane(tid >> 6);
    const _Float16* Qg = (const _Float16*)(ws + (MOBA ? WS_QMB : WS_QMLA)); const _Float16* Kg = (const _Float16*)(ws + (MOBA ? WS_KMB : WS_KN));
    const _Float16* Vg = (const _Float16*)(ws + (MOBA ? WS_VMB : WS_VM)); const _Float16* Pg = (const _Float16*)(ws + WS_KPE); _Float16* Zg = (_Float16*)(ws + WS_ZCAT) + (MOBA ? 512 : 0);
    const size_t rowbase = (size_t)b * SEQ; const int q0 = qb * 256, qw0 = q0 + wid * 32, qrow = qw0 + r32;
    LAS float* wsf = (LAS float*)(lds + L_WS) + wid * 64; LAS int* tb = (LAS int*)(lds + L_TB); LAS unsigned* un = (LAS unsigned*)(lds + L_UN);
    h8 qr[ND];
#pragma unroll
    for (int d0 = 0; d0 < ND; ++d0) qr[d0] = *(const h8*)(Qg + (rowbase + qrow) * QP + h * QH + d0 * 16 + hi * 8);
#pragma unroll
    for (int d0 = 0; d0 < ND; ++d0) asm volatile("" : "+v"(qr[d0]));
    unsigned sel = 0u, blocks = OWN ? (1u << qb) : (2u << qb) - 1u;
    if (MOBA && !OWN) {
        const float* km = (const float*)(ws + WS_KMEAN) + (size_t)b * 16 * 512 + h * 64 + hi * 8;
        float g0 = -INFINITY, g1 = -INFINITY, g2 = -INFINITY; int i0 = -1, i1 = -1, i2 = -1;
        for (int m = 0; m < qb; ++m) {
            float part = 0.f;
#pragma unroll
            for (int d0 = 0; d0 < 4; ++d0) { const float4 a = *(const float4*)(km + m * 512 + d0 * 16), c = *(const float4*)(km + m * 512 + d0 * 16 + 4);
                part += (float)qr[d0][0] * a.x + (float)qr[d0][1] * a.y + (float)qr[d0][2] * a.z + (float)qr[d0][3] * a.w + (float)qr[d0][4] * c.x + (float)qr[d0][5] * c.y + (float)qr[d0][6] * c.z + (float)qr[d0][7] * c.w; }
            const float g = swapsum(part);
            if (g > g0) { g2 = g1; i2 = i1; g1 = g0; i1 = i0; g0 = g; i0 = m; }
            else if (g > g1) { g2 = g1; i2 = i1; g1 = g; i1 = m; }
            else if (g > g2) { g2 = g; i2 = m; }
        }
        if (i0 >= 0) sel |= 1u << i0; if (i1 >= 0) sel |= 1u << i1; if (i2 >= 0) sel |= 1u << i2;
        unsigned uw = sel;
#pragma unroll
        for (int o = 1; o < 64; o <<= 1) uw |= (unsigned)__shfl_xor((int)uw, o);
        if (lane == 0) un[wid] = uw;
        __syncthreads();
        unsigned ua = 0u;
#pragma unroll
        for (int w = 0; w < 8; ++w) ua |= un[w];
        blocks = (unsigned)__builtin_amdgcn_readfirstlane((int)(ua | (1u << qb)));
    }
    const int NT = OWN ? 4 : 4 * __builtin_popcount(blocks);
    if (tid < 64 && tid < NT) { unsigned bm = blocks; for (int k = 0; k < (tid >> 2); ++k) bm &= bm - 1u; tb[tid] = (__builtin_ctz(bm) << 8) + ((tid & 3) << 6); }
    __syncthreads();
    const unsigned char* kbu = (const unsigned char*)(Kg + rowbase * 512 + h * 64); const unsigned char* vbu = (const unsigned char*)(Vg + rowbase * 512 + h * 64); const unsigned char* pbu = (const unsigned char*)(Pg + rowbase * 32);
    const unsigned char* kb0; const unsigned char* kb1 = nullptr; unsigned ksrc0, ksrc1 = 0u, kst0 = 1024u, kst1 = 1024u;
    if (DK == 96) { const int r0 = 4 * wid + (lane >> 4), r1 = r0 + 32; int c0 = (lane & 15) ^ (r0 & 15), c1 = (lane & 15) ^ (r1 & 15); if (c0 >= 12) c0 -= 4; if (c1 >= 12) c1 -= 4;
        const bool kpe0 = c0 >= 8, kpe1 = c1 >= 8;
        kb0 = kpe0 ? pbu : kbu; kst0 = kpe0 ? 64u : 1024u; ksrc0 = kpe0 ? (unsigned)(r0 * 32 + (c0 - 8) * 8) * 2u : (unsigned)(r0 * 512 + c0 * 8) * 2u;
        kb1 = kpe1 ? pbu : kbu; kst1 = kpe1 ? 64u : 1024u; ksrc1 = kpe1 ? (unsigned)(r1 * 32 + (c1 - 8) * 8) * 2u : (unsigned)(r1 * 512 + c1 * 8) * 2u;
    } else { const int r0 = 8 * wid + (lane >> 3), c0 = (lane & 7) ^ ((r0 >> 1) & 7); kb0 = kbu; ksrc0 = (unsigned)(r0 * 512 + c0 * 8) * 2u; }
    const unsigned vsrc = (unsigned)((16 * (wid & 3) + (lane >> 2)) * 512 + (wid >> 2) * 32 + (lane & 3) * 8) * 2u;
    constexpr int NDMA = (DK == 96) ? 3 : 2;
#define ATT_GLDS(src, dst) glds16((const void*)(src), (unsigned)__builtin_amdgcn_readfirstlane((int)(unsigned)(size_t)(dst)))
#define ATT_DMA(kb, buf) do { const unsigned kb_ = (unsigned)(kb); LAS unsigned char* kd_ = lds + L_K + (buf) * KBUF; \
        ATT_GLDS(kb0 + (ksrc0 + kb_ * kst0), kd_ + wid * 1024); \
        if (DK == 96) ATT_GLDS(kb1 + (ksrc1 + kb_ * kst1), kd_ + 8192 + wid * 1024); \
        ATT_GLDS(vbu + (vsrc + kb_ * 1024u), lds + L_V + (buf) * VBUF + wid * 1024); } while (0)
#define ATT_WAITV(n) asm volatile("s_waitcnt vmcnt(" #n ")" ::: "memory")
#define ATT_BAR() do { asm volatile("s_waitcnt lgkmcnt(0)" ::: "memory"); __builtin_amdgcn_s_barrier(); asm volatile("" ::: "memory"); } while (0)
    const int vro = ((lane >> 4) & 1) * 32 + (lane & 3) * 8 + (4 * hi + ((lane & 15) >> 2)) * 64;
    float l_reg = 0.f; bool init = false; f16v o[2]; o[0] = f16v{}; o[1] = f16v{}; f16v negm = f16v{}; asm volatile("" : "+v"(negm));
    constexpr int G = 2 * ND;
#define ATT_SBAR() __builtin_amdgcn_sched_barrier(0)
#define ATT_PIN(x) asm volatile("" : "+v"(x))
#define ATT_KF(buf, g) (*(const LAS h8*)(lds + L_K + (buf) * KBUF + kaddr<DK>(32 * ((g) & 1) + r32, 2 * ((g) >> 1) + hi)))
#define ATT_MF(a, b, c) __builtin_amdgcn_mfma_f32_32x32x16_f16(a, b, c, 0, 0, 0)
#define ATT_QK(P0, P1, buf) do { h8 kf_[G]; _Pragma("unroll") for (int g_ = 0; g_ < G; ++g_) kf_[g_] = ATT_KF(buf, g_); ATT_SBAR(); \
        _Pragma("unroll") for (int d_ = 0; d_ < ND; ++d_) { P0 = ATT_MF(kf_[2 * d_], qr[d_], d_ == 0 ? negm : P0); P1 = ATT_MF(kf_[2 * d_ + 1], qr[d_], d_ == 0 ? negm : P1); } } while (0)
#define ATT_MAXCHAIN(P0, P1, PM) do { float pa_ = max3f(P0[0], P0[1], P1[0]), pb_ = max3f(P0[2], P0[3], P1[1]); pa_ = max3f(pa_, P1[2], P1[3]); \
        _Pragma("unroll") for (int r_ = 4; r_ < 16; r_ += 4) { pa_ = max3f(pa_, P0[r_], P0[r_ + 1]); pb_ = max3f(pb_, P0[r_ + 2], P0[r_ + 3]); pa_ = max3f(pa_, P1[r_], P1[r_ + 1]); pb_ = max3f(pb_, P1[r_ + 2], P1[r_ + 3]); } \
        PM = swapmax(fmaxf(pa_, pb_)); } while (0)
#define ATT_MOVE(P0, P1, PM) do { const bool move_ = init ? ((PM) > THR) : ((PM) > -INFINITY); \
        if (__any(move_)) { const float dl_ = move_ ? (init ? fmaxf((PM), 0.f) : (PM)) : 0.f; const float al_ = (move_ && init) ? __builtin_amdgcn_exp2f(-dl_) : 1.f; \
            init = init || move_; l_reg *= al_; \
            _Pragma("unroll") for (int r_ = 0; r_ < 16; ++r_) { P0[r_] -= dl_; P1[r_] -= dl_; negm[r_] -= dl_; } \
            if (hi == 0) wsf[r32] = al_; asm volatile("s_waitcnt lgkmcnt(0)" ::: "memory"); \
            _Pragma("unroll") for (int r_ = 0; r_ < 16; ++r_) { const float a_ = wsf[crow(r_, hi)]; o[0][r_] *= a_; o[1][r_] *= a_; } } } while (0)
#define ATT_PACK(P0, P1, PW, KEEP) do { _Pragma("unroll") for (int k_ = 0; k_ < 2; ++k_) { \
            PW[k_] = (u4){pkh(P0[8 * k_], P0[8 * k_ + 1]), pkh(P0[8 * k_ + 2], P0[8 * k_ + 3]), pkh(P0[8 * k_ + 4], P0[8 * k_ + 5]), pkh(P0[8 * k_ + 6], P0[8 * k_ + 7])}; \
            PW[2 + k_] = (u4){pkh(P1[8 * k_], P1[8 * k_ + 1]), pkh(P1[8 * k_ + 2], P1[8 * k_ + 3]), pkh(P1[8 * k_ + 4], P1[8 * k_ + 5]), pkh(P1[8 * k_ + 6], P1[8 * k_ + 7])}; } \
        if (MOBA) { _Pragma("unroll") for (int k_ = 0; k_ < 4; ++k_) PW[k_] &= (KEEP); } } while (0)
#define ATT_VF(buf, i) (lds + L_V + (buf) * VBUF + vro + ((i) >> 2) * 4096 + ((i) & 3) * 1024)
#define ATT_WAIT_NEXT(t_) do { if ((t_) + 3 < NT) { if (NDMA == 3) ATT_WAITV(3); else ATT_WAITV(2); } else ATT_WAITV(0); } while (0)
#define ATT_TB(i) (MOBA ? tb[(i)] : 64 * (i))
    const int NF = OWN ? 0 : NT - 4;
    ATT_DMA(ATT_TB(0), 0); ATT_DMA(ATT_TB(1), 1); ATT_DMA(ATT_TB(2), 2);
    if (NDMA == 3) ATT_WAITV(3); else ATT_WAITV(2);
    ATT_BAR();
    f16v pC0, pC1;
    if (NF > 0) { ATT_QK(pC0, pC1, 0); asm volatile("s_nop 15\n\ts_nop 7" : "+v"(pC0), "+v"(pC1)); float pm; ATT_MAXCHAIN(pC0, pC1, pm);
        if (MOBA && !((sel >> (ATT_TB(0) >> 8)) & 1u)) pm = -INFINITY; ATT_MOVE(pC0, pC1, pm); }
    auto step = [&](f16v& pC0, f16v& pC1, f16v& pN0, f16v& pN1, const int t, auto hn) __attribute__((always_inline)) {
        const int cur = t & 3, nx = (t + 1) & 3; constexpr bool hasn = decltype(hn)::value;
        ATT_DMA(ATT_TB(t + 3), (t + 3) & 3);
        const unsigned keepC = (!MOBA || ((sel >> (ATT_TB(t) >> 8)) & 1u)) ? 0xffffffffu : 0u;
        float ps = 0.f;
        if (hasn) {
            h8 kf[G];
#pragma unroll
            for (int g = 0; g < 4; ++g) kf[g] = ATT_KF(nx, g);
            ATT_SBAR();
#pragma unroll
            for (int g = 0; g < G; ++g) {
                if (g + 4 < G) kf[g + 4] = ATT_KF(nx, g + 4);
                if (g & 1) pN1 = ATT_MF(kf[g], qr[g >> 1], g == 1 ? negm : pN1); else pN0 = ATT_MF(kf[g], qr[g >> 1], g == 0 ? negm : pN0);
                constexpr int dummy = 0; (void)dummy;
                const int e0 = (ND == 4) ? 4 * g : (g < 8 ? 3 * g : 24 + 2 * (g - 8)), e1 = (ND == 4) ? 4 * g + 4 : (g < 8 ? 3 * g + 3 : 26 + 2 * (g - 8));
#pragma unroll
                for (int e = e0; e < e1; ++e) { if (e < 16) { pC0[e] = __builtin_amdgcn_exp2f(pC0[e]); ps += pC0[e]; } else { pC1[e - 16] = __builtin_amdgcn_exp2f(pC1[e - 16]); ps += pC1[e - 16]; } }
                ATT_PIN(pC0); ATT_PIN(pC1); ATT_PIN(ps); ATT_SBAR();
            }
        } else {
#pragma unroll
            for (int r = 0; r < 16; ++r) { pC0[r] = __builtin_amdgcn_exp2f(pC0[r]); pC1[r] = __builtin_amdgcn_exp2f(pC1[r]); ps += pC0[r] + pC1[r]; }
        }
        if (MOBA && !keepC) ps = 0.f;
        l_reg += swapsum(ps);
        u4 pw[4]; ATT_PACK(pC0, pC1, pw, keepC);
        {
            s4 vlo[8], vhi[8]; float pa = 0.f, pb = 0.f;
#pragma unroll
            for (int i = 0; i < 3; ++i) { vlo[i] = vtr(ATT_VF(cur, i)); vhi[i] = vtr(ATT_VF(cur, i) + 512); }
            if (hasn) asm volatile("s_nop 7" : "+v"(pN0), "+v"(pN1));
            ATT_SBAR();
#pragma unroll
            for (int i = 0; i < 8; ++i) {
                if (i + 3 < 8) { vlo[i + 3] = vtr(ATT_VF(cur, i + 3)); vhi[i + 3] = vtr(ATT_VF(cur, i + 3) + 512); }
                const s8 vv = (s8){vlo[i][0], vlo[i][1], vlo[i][2], vlo[i][3], vhi[i][0], vhi[i][1], vhi[i][2], vhi[i][3]};
                o[i >> 2] = ATT_MF(__builtin_bit_cast(h8, pw[i & 3]), __builtin_bit_cast(h8, vv), o[i >> 2]);
                if (hasn) {
                    if (i == 0) { pa = max3f(pN0[0], pN0[1], pN1[0]); pb = max3f(pN0[2], pN0[3], pN1[1]); }
                    else if (i == 1) { pa = max3f(pa, pN1[2], pN1[3]); pb = max3f(pb, pN0[6], pN0[7]); }
                    else if (i == 2) { pa = max3f(pa, pN0[4], pN0[5]); pb = max3f(pb, pN1[6], pN1[7]); }
                    else if (i == 3) { pa = max3f(pa, pN1[4], pN1[5]); pb = max3f(pb, pN0[10], pN0[11]); }
                    else if (i == 4) { pa = max3f(pa, pN0[8], pN0[9]); pb = max3f(pb, pN1[10], pN1[11]); }
                    else if (i == 5) { pa = max3f(pa, pN1[8], pN1[9]); pb = max3f(pb, pN0[14], pN0[15]); }
                    else if (i == 6) { pa = max3f(pa, pN0[12], pN0[13]); pb = max3f(pb, pN1[14], pN1[15]); }
                    else { pa = max3f(pa, pN1[12], pN1[13]); }
                    ATT_PIN(pa); ATT_PIN(pb);
                }
                ATT_SBAR();
            }
            if (hasn) { float pm = swapmax(fmaxf(pa, pb)); if (MOBA && !((sel >> (ATT_TB(t + 1) >> 8)) & 1u)) pm = -INFINITY; ATT_MOVE(pN0, pN1, pm); }
        }
        if (NDMA == 3) ATT_WAITV(3); else ATT_WAITV(2);
        ATT_BAR();
    };
    {
        f16v pD0, pD1; int t = 0;
        for (; t + 2 < NF; t += 2) { step(pC0, pC1, pD0, pD1, t, T1{}); step(pD0, pD1, pC0, pC1, t + 1, T1{}); }
        if (t + 1 < NF) { step(pC0, pC1, pD0, pD1, t, T1{}); step(pD0, pD1, pC0, pC1, t + 1, T0{}); }
        else if (t < NF) step(pC0, pC1, pD0, pD1, t, T0{});
    }
    for (int t = NF; t < NT; ++t) {
        const int cur = t & 3, kb = ATT_TB(t);
        if (t + 3 < NT) ATT_DMA(ATT_TB(t + 3), (t + 3) & 3);
        if (kb <= qw0 + 31) {
            f16v p0, p1; ATT_QK(p0, p1, cur);
            if (kb + 63 > qw0) {
#pragma unroll
                for (int r = 0; r < 16; ++r) { const int kv = kb + crow(r, hi); if (kv > qrow) p0[r] = -INFINITY; if (kv + 32 > qrow) p1[r] = -INFINITY; }
            }
            asm volatile("s_nop 15\n\ts_nop 7" : "+v"(p0), "+v"(p1));
            float pm; ATT_MAXCHAIN(p0, p1, pm); ATT_MOVE(p0, p1, pm);
            s4 vlo[8], vhi[8];
#pragma unroll
            for (int i = 0; i < 8; ++i) { vlo[i] = vtr(ATT_VF(cur, i)); vhi[i] = vtr(ATT_VF(cur, i) + 512); }
            ATT_SBAR();
            float ps = 0.f;
#pragma unroll
            for (int r = 0; r < 16; ++r) { p0[r] = __builtin_amdgcn_exp2f(p0[r]); p1[r] = __builtin_amdgcn_exp2f(p1[r]); ps += p0[r] + p1[r]; }
            l_reg += swapsum(ps);
            u4 pw[4]; ATT_PACK(p0, p1, pw, 0xffffffffu);
#pragma unroll
            for (int i = 0; i < 8; ++i) { const s8 vv = (s8){vlo[i][0], vlo[i][1], vlo[i][2], vlo[i][3], vhi[i][0], vhi[i][1], vhi[i][2], vhi[i][3]};
                o[i >> 2] = ATT_MF(__builtin_bit_cast(h8, pw[i & 3]), __builtin_bit_cast(h8, vv), o[i >> 2]); }
        }
        ATT_WAIT_NEXT(t);
        ATT_BAR();
    }
    if (hi == 0) { wsf[32 + r32] = l_reg; if (OWN) wsf[r32] = -negm[0]; } asm volatile("s_waitcnt lgkmcnt(0)" ::: "memory");
    LAS _Float16* stg = (LAS _Float16*)(lds + L_OST) + wid * 2048;
#pragma unroll
    for (int r = 0; r < 16; ++r) { const int orow = crow(r, hi); const float rl = 1.f / wsf[32 + orow];
        stg[orow * 64 + r32] = (_Float16)(o[0][r] * rl); stg[orow * 64 + 32 + r32] = (_Float16)(o[1][r] * rl); }
    asm volatile("s_waitcnt lgkmcnt(0)" ::: "memory");
    int lane_e = lane; asm volatile("" : "+v"(lane_e));
    unsigned char* zbu = (unsigned char*)(Zg + (rowbase + qw0) * 1024 + h * 64);
#pragma unroll
    for (int i = 0; i < 4; ++i) { const int row = i * 8 + (lane_e >> 3), ch = lane_e & 7; const h8 v = *(const LAS h8*)(stg + row * 64 + ch * 8);
        _Float16* zp = (_Float16*)(zbu + (unsigned)(row * 1024 + ch * 8) * 2u); const h8 z = *(const h8*)zp; h8 ov;
        if (OWN) {
            const int nsl = qb < 3 ? qb : 3; const unsigned gr = (unsigned)((b * 8 + h) * 4096 + qw0 + row);
            const float m_own = wsf[row], l_own = wsf[32 + row]; float M = m_own; float2 ml[3]; h8 po[3];
#pragma unroll
            for (int s = 0; s < 3; ++s) if (s < nsl) { ml[s] = ((const float2*)(ws + WS_ML))[(unsigned)s * 524288u + gr]; po[s] = *(const h8*)(ws + opart_off(s) + gr * 128u + (unsigned)ch * 16u); M = fmaxf(M, ml[s].x); }
            const float w0 = l_own * __builtin_amdgcn_exp2f(m_own - M); float W = w0; float acc[8];
#pragma unroll
            for (int j = 0; j < 8; ++j) acc[j] = w0 * (float)v[j];
#pragma unroll
            for (int s = 0; s < 3; ++s) if (s < nsl) { const float w = ml[s].y * __builtin_amdgcn_exp2f(ml[s].x - M); W += w;
#pragma unroll
                for (int j = 0; j < 8; ++j) acc[j] = fmaf(w, (float)po[s][j], acc[j]); }
            const float rW = 1.f / W;
#pragma unroll
            for (int j = 0; j < 8; ++j) ov[j] = (_Float16)(acc[j] * rW * (float)z[j]);
        } else {
#pragma unroll
            for (int j = 0; j < 8; ++j) ov[j] = (_Float16)((float)v[j] * (float)z[j]);
        }
        if (!dry) *(h8*)zp = ov; }
    __syncthreads();
#undef ATT_GLDS
#undef ATT_DMA
#undef ATT_WAITV
#undef ATT_BAR
#undef ATT_SBAR
#undef ATT_PIN
#undef ATT_KF
#undef ATT_MF
#undef ATT_QK
#undef ATT_MAXCHAIN
#undef ATT_MOVE
#undef ATT_PACK
#undef ATT_VF
#undef ATT_WAIT_NEXT
#undef ATT_TB
}


__device__ __forceinline__ void ph_gate(unsigned char* ws, int gw_, int ngw, int lane) {
    const int gw = __builtin_amdgcn_readfirstlane(gw_);
    unsigned* cnt = (unsigned*)(ws + WS_CNT); unsigned short* lists = (unsigned short*)(ws + WS_LIST);
    for (int it = gw; it < 128 * 60; it += ngw) {
        const int bh = it / 60, rr = it - bh * 60, qb = 1 + (rr >> 2), ch = rr & 3, b = bh >> 3, h = bh & 7;
        const int row = qb * 256 + ch * 64 + lane;
        const _Float16* q = (const _Float16*)(ws + WS_QMB) + ((size_t)b * SEQ + row) * 512 + h * 64;
        h8 qv[8];
#pragma unroll
        for (int i = 0; i < 8; ++i) qv[i] = *(const h8*)(q + 8 * i);
        const float* km = (const float*)(ws + WS_KMEAN) + (size_t)b * 16 * 512 + h * 64;
        float g0 = -INFINITY, g1 = -INFINITY, g2 = -INFINITY; int i0 = -1, i1 = -1, i2 = -1;
        for (int m = 0; m < qb; ++m) {
            float s0 = 0.f, s1 = 0.f;
#pragma unroll
            for (int d = 0; d < 64; d += 2) { s0 = fmaf((float)qv[d >> 3][d & 7], km[m * 512 + d], s0); s1 = fmaf((float)qv[d >> 3][(d & 7) + 1], km[m * 512 + d + 1], s1); }
            const float g = s0 + s1;
            if (g > g0) { g2 = g1; i2 = i1; g1 = g0; i1 = i0; g0 = g; i0 = m; }
            else if (g > g1) { g2 = g1; i2 = i1; g1 = g; i1 = m; }
            else if (g > g2) { g2 = g; i2 = m; }
        }
        unsigned mycnt = 0u;
#pragma unroll
        for (int j = 0; j < 15; ++j) { const bool s = (i0 == j) | (i1 == j) | (i2 == j); const unsigned long long mk = __ballot(s); if (lane == j) mycnt = (unsigned)__popcll(mk); }
        unsigned basev = 0u; if (lane < 15 && mycnt) basev = atomicAdd(&cnt[bh * 16 + lane], mycnt);
#pragma unroll
        for (int j = 0; j < 15; ++j) { const bool s = (i0 == j) | (i1 == j) | (i2 == j); const unsigned long long mk = __ballot(s); const unsigned base = (unsigned)__builtin_amdgcn_readlane((int)basev, j);
            if (s) { const unsigned rank = (unsigned)__popcll(mk & ((1ull << lane) - 1ull)); const int slot = (i0 == j) ? 0 : ((i1 == j) ? 1 : 2);
                lists[(size_t)(bh * 16 + j) * 4096 + base + rank] = (unsigned short)(row | (slot << 12)); } }
    }
}

constexpr int GBUF = 65536, G_V = 32768, G_WS = 131072 + 1024;
__device__ __forceinline__ void gather_dma(unsigned char* ws, int b, int h, int j, LAS unsigned char* lds, int X) {
    int tid_ = threadIdx.x; asm volatile("" : "+v"(tid_)); const int lane = tid_ & 63; const int wid = __builtin_amdgcn_readfirstlane(tid_ >> 6);
    const size_t rowbase = (size_t)b * SEQ + j * 256;
    const unsigned char* kbu = (const unsigned char*)((const _Float16*)(ws + WS_KMB) + rowbase * 512 + h * 64); const unsigned char* vbu = (const unsigned char*)((const _Float16*)(ws + WS_VMB) + rowbase * 512 + h * 64);
    const int r0 = 8 * wid + (lane >> 3), c0 = (lane & 7) ^ ((r0 >> 1) & 7);
    const unsigned ksrc = (unsigned)(r0 * 512 + c0 * 8) * 2u, vsrc = (unsigned)((16 * (wid & 3) + (lane >> 2)) * 512 + (wid >> 2) * 32 + (lane & 3) * 8) * 2u;
    LAS unsigned char* lb = lds + X * GBUF + wid * 1024;
#pragma unroll
    for (int t = 0; t < 4; ++t) {
        glds16((const void*)(kbu + (ksrc + (unsigned)t * 65536u)), (unsigned)__builtin_amdgcn_readfirstlane((int)(unsigned)(size_t)(lb + t * 8192)));
        glds16((const void*)(vbu + (vsrc + (unsigned)t * 65536u)), (unsigned)__builtin_amdgcn_readfirstlane((int)(unsigned)(size_t)(lb + G_V + t * 8192))); }
}
__device__ __forceinline__ void gather_unit(unsigned char* ws, int b, int h, int j, LAS unsigned char* lds, int X) {
    constexpr int ND = 4, G = 8;
    int tid_ = threadIdx.x; asm volatile("" : "+v"(tid_));
    const int tid = tid_, lane = tid & 63, r32 = lane & 31, hi = lane >> 5; const int wid = __builtin_amdgcn_readfirstlane(tid >> 6);
    const int bh = b * 8 + h;
    const _Float16* Qg = (const _Float16*)(ws + WS_QMB) + (size_t)b * SEQ * 512 + h * 64;
    const unsigned short* lst = (const unsigned short*)(ws + WS_LIST) + (size_t)(bh * 16 + j) * 4096;
    const int cnt = __builtin_amdgcn_readfirstlane((int)((const unsigned*)(ws + WS_CNT))[bh * 16 + j]);
    const int ngr = (cnt + 31) >> 5;
    LAS unsigned char* kfb = lds + X * GBUF; LAS unsigned char* vfb = kfb + G_V;
    LAS float* wsf = (LAS float*)(lds + G_WS) + wid * 128; LAS unsigned* wsu = (LAS unsigned*)wsf;
    const int vro = ((lane >> 4) & 1) * 32 + (lane & 3) * 8 + (4 * hi + ((lane & 15) >> 2)) * 64;
#define GT_SBAR() __builtin_amdgcn_sched_barrier(0)
#define GT_PIN(x) asm volatile("" : "+v"(x))
#define GT_KF(buf, g) (*(const LAS h8*)(kfb + (buf) * 8192 + kaddr<64>(32 * ((g) & 1) + r32, 2 * ((g) >> 1) + hi)))
#define GT_VF(buf, i) (vfb + (buf) * 8192 + vro + ((i) >> 2) * 4096 + ((i) & 3) * 1024)
#define GT_MF(a, b, c) __builtin_amdgcn_mfma_f32_32x32x16_f16(a, b, c, 0, 0, 0)
#define GT_MOVE(P0, P1, PM) do { const bool move_ = init ? ((PM) > THR) : ((PM) > -INFINITY); \
        if (__any(move_)) { const float dl_ = move_ ? (init ? fmaxf((PM), 0.f) : (PM)) : 0.f; const float al_ = (move_ && init) ? __builtin_amdgcn_exp2f(-dl_) : 1.f; \
            init = init || move_; l_reg *= al_; \
            _Pragma("unroll") for (int r_ = 0; r_ < 16; ++r_) { P0[r_] -= dl_; P1[r_] -= dl_; negm[r_] -= dl_; } \
            if (hi == 0) wsf[r32] = al_; asm volatile("s_waitcnt lgkmcnt(0)" ::: "memory"); \
            _Pragma("unroll") for (int r_ = 0; r_ < 16; ++r_) { const float a_ = wsf[crow(r_, hi)]; o[0][r_] *= a_; o[1][r_] *= a_; } } } while (0)
    for (int g = wid; g < ngr; g += 8) {
        const int idx = g * 32 + r32; const bool valid = idx < cnt; const unsigned ent = valid ? (unsigned)lst[idx] : 0u; const int row = (int)(ent & 4095u), slot = (int)(ent >> 12) & 3;
        h8 qr[ND];
#pragma unroll
        for (int d0 = 0; d0 < ND; ++d0) qr[d0] = *(const h8*)(Qg + (size_t)row * 512 + d0 * 16 + hi * 8);
#pragma unroll
        for (int d0 = 0; d0 < ND; ++d0) asm volatile("" : "+v"(qr[d0]));
        float l_reg = 0.f; bool init = false; f16v o[2]; o[0] = f16v{}; o[1] = f16v{}; f16v negm = f16v{}; asm volatile("" : "+v"(negm));
        f16v pC0, pC1, pD0, pD1;
        {
            h8 kf_[G];
#pragma unroll
            for (int g_ = 0; g_ < G; ++g_) kf_[g_] = GT_KF(0, g_);
            GT_SBAR();
#pragma unroll
            for (int d_ = 0; d_ < ND; ++d_) { pC0 = GT_MF(kf_[2 * d_], qr[d_], d_ == 0 ? negm : pC0); pC1 = GT_MF(kf_[2 * d_ + 1], qr[d_], d_ == 0 ? negm : pC1); }
            asm volatile("s_nop 15\n\ts_nop 7" : "+v"(pC0), "+v"(pC1));
            float pa_ = max3f(pC0[0], pC0[1], pC1[0]), pb_ = max3f(pC0[2], pC0[3], pC1[1]); pa_ = max3f(pa_, pC1[2], pC1[3]);
#pragma unroll
            for (int r_ = 4; r_ < 16; r_ += 4) { pa_ = max3f(pa_, pC0[r_], pC0[r_ + 1]); pb_ = max3f(pb_, pC0[r_ + 2], pC0[r_ + 3]); pa_ = max3f(pa_, pC1[r_], pC1[r_ + 1]); pb_ = max3f(pb_, pC1[r_ + 2], pC1[r_ + 3]); }
            const float pm = swapmax(fmaxf(pa_, pb_)); GT_MOVE(pC0, pC1, pm);
        }
        auto gstep = [&](f16v& pC0, f16v& pC1, f16v& pN0, f16v& pN1, const int t, auto hn) __attribute__((always_inline)) {
            constexpr bool hasn = decltype(hn)::value;
            float ps = 0.f;
            if (hasn) {
                h8 kf[G];
#pragma unroll
                for (int g_ = 0; g_ < 4; ++g_) kf[g_] = GT_KF(t + 1, g_);
                GT_SBAR();
#pragma unroll
                for (int g_ = 0; g_ < G; ++g_) {
                    if (g_ + 4 < G) kf[g_ + 4] = GT_KF(t + 1, g_ + 4);
                    if (g_ & 1) pN1 = GT_MF(kf[g_], qr[g_ >> 1], g_ == 1 ? negm : pN1); else pN0 = GT_MF(kf[g_], qr[g_ >> 1], g_ == 0 ? negm : pN0);
#pragma unroll
                    for (int e = 4 * g_; e < 4 * g_ + 4; ++e) { if (e < 16) { pC0[e] = __builtin_amdgcn_exp2f(pC0[e]); ps += pC0[e]; } else { pC1[e - 16] = __builtin_amdgcn_exp2f(pC1[e - 16]); ps += pC1[e - 16]; } }
                    GT_PIN(pC0); GT_PIN(pC1); GT_PIN(ps); GT_SBAR();
                }
            } else {
#pragma unroll
                for (int r = 0; r < 16; ++r) { pC0[r] = __builtin_amdgcn_exp2f(pC0[r]); pC1[r] = __builtin_amdgcn_exp2f(pC1[r]); ps += pC0[r] + pC1[r]; }
            }
            l_reg += swapsum(ps);
            u4 pw[4];
#pragma unroll
            for (int k_ = 0; k_ < 2; ++k_) {
                pw[k_] = (u4){pkh(pC0[8 * k_], pC0[8 * k_ + 1]), pkh(pC0[8 * k_ + 2], pC0[8 * k_ + 3]), pkh(pC0[8 * k_ + 4], pC0[8 * k_ + 5]), pkh(pC0[8 * k_ + 6], pC0[8 * k_ + 7])};
                pw[2 + k_] = (u4){pkh(pC1[8 * k_], pC1[8 * k_ + 1]), pkh(pC1[8 * k_ + 2], pC1[8 * k_ + 3]), pkh(pC1[8 * k_ + 4], pC1[8 * k_ + 5]), pkh(pC1[8 * k_ + 6], pC1[8 * k_ + 7])}; }
            s4 vlo[8], vhi[8]; float pa = 0.f, pb = 0.f;
#pragma unroll
            for (int i = 0; i < 3; ++i) { vlo[i] = vtr(GT_VF(t, i)); vhi[i] = vtr(GT_VF(t, i) + 512); }
            if (hasn) asm volatile("s_nop 7" : "+v"(pN0), "+v"(pN1));
            GT_SBAR();
#pragma unroll
            for (int i = 0; i < 8; ++i) {
                if (i + 3 < 8) { vlo[i + 3] = vtr(GT_VF(t, i + 3)); vhi[i + 3] = vtr(GT_VF(t, i + 3) + 512); }
                const s8 vv = (s8){vlo[i][0], vlo[i][1], vlo[i][2], vlo[i][3], vhi[i][0], vhi[i][1], vhi[i][2], vhi[i][3]};
                o[i >> 2] = GT_MF(__builtin_bit_cast(h8, pw[i & 3]), __builtin_bit_cast(h8, vv), o[i >> 2]);
                if (hasn) {
                    if (i == 0) { pa = max3f(pN0[0], pN0[1], pN1[0]); pb = max3f(pN0[2], pN0[3], pN1[1]); }
                    else if (i == 1) { pa = max3f(pa, pN1[2], pN1[3]); pb = max3f(pb, pN0[6], pN0[7]); }
                    else if (i == 2) { pa = max3f(pa, pN0[4], pN0[5]); pb = max3f(pb, pN1[6], pN1[7]); }
                    else if (i == 3) { pa = max3f(pa, pN1[4], pN1[5]); pb = max3f(pb, pN0[10], pN0[11]); }
                    else if (i == 4) { pa = max3f(pa, pN0[8], pN0[9]); pb = max3f(pb, pN1[10], pN1[11]); }
                    else if (i == 5) { pa = max3f(pa, pN1[8], pN1[9]); pb = max3f(pb, pN0[14], pN0[15]); }
                    else if (i == 6) { pa = max3f(pa, pN0[12], pN0[13]); pb = max3f(pb, pN1[14], pN1[15]); }
                    else { pa = max3f(pa, pN1[12], pN1[13]); }
                    GT_PIN(pa); GT_PIN(pb);
                }
                GT_SBAR();
            }
            if (hasn) { const float pm = swapmax(fmaxf(pa, pb)); GT_MOVE(pN0, pN1, pm); }
        };
        gstep(pC0, pC1, pD0, pD1, 0, T1{}); gstep(pD0, pD1, pC0, pC1, 1, T1{}); gstep(pC0, pC1, pD0, pD1, 2, T1{}); gstep(pD0, pD1, pC0, pC1, 3, T0{});
        const unsigned gr = (unsigned)(bh * 4096 + row);
        if (hi == 0) { wsf[32 + r32] = l_reg; wsu[64 + r32] = valid ? opart_off(slot) + gr * 128u : 0xFFFFFFFFu;
            if (valid) ((float2*)(ws + WS_ML))[(unsigned)slot * 524288u + gr] = make_float2(-negm[0], l_reg); }
        asm volatile("s_waitcnt lgkmcnt(0)" ::: "memory");
#pragma unroll
        for (int r = 0; r < 16; ++r) { const int orow = crow(r, hi); const float rl = 1.f / wsf[32 + orow]; const unsigned off = wsu[64 + orow];
            if (off != 0xFFFFFFFFu) { *(_Float16*)(ws + off + (unsigned)r32 * 2u) = (_Float16)(o[0][r] * rl); *(_Float16*)(ws + off + 64u + (unsigned)r32 * 2u) = (_Float16)(o[1][r] * rl); } }
    }
#undef GT_SBAR
#undef GT_PIN
#undef GT_KF
#undef GT_VF
#undef GT_MF
#undef GT_MOVE
}

__device__ __forceinline__ void attn_phase(unsigned char* ws, LAS unsigned char* lds, int vb, int nvb) {
    const int vcu = (nvb % 8 == 0) ? (vb % 8) * (nvb / 8) + vb / 8 : vb; const int per = (1024 + nvb - 1) / nvb;
    for (int k = 0; k < per; ++k) {
        int it;
        if (nvb == 256) { const int xg = vcu >> 5, lw = vcu & 31; it = ((16 * xg + 4 * k + (lw >> 3)) << 3) | (lw & 7); }
        else { it = vcu * per + k; if (it >= 1024) break; }
        const int bh = it >> 3, pr = it & 7, b = bh >> 3, h = bh & 7;
        if (PROBE == 2) for (int uu = 0; uu < 2; ++uu) attn_unit<96, false, PROBE_ABL>(ws, b, h, uu ? 15 - pr : pr, lds, true);
        for (int uu = 0; uu < 2; ++uu) attn_unit<96, false>(ws, b, h, uu ? 15 - pr : pr, lds);
    }
    int nu = 0;
    for (int k = 0; k < per; ++k) { int it; if (nvb == 256) { const int xg = vcu >> 5, lw = vcu & 31; it = ((16 * xg + 4 * k + (lw >> 3)) << 3) | (lw & 7); } else { it = vcu * per + k; if (it >= 1024) break; } nu += ((it & 7) < 4 ? 0 : 0) + 2; }
    auto unit_of = [&](int u, int& b, int& h, int& j) {
        const int k = u >> 1; int it; if (nvb == 256) { const int xg = vcu >> 5, lw = vcu & 31; it = ((16 * xg + 4 * k + (lw >> 3)) << 3) | (lw & 7); } else it = vcu * per + k;
        const int bh = it >> 3, pr = it & 7, rot = (bh >> 2) & 3; b = bh >> 3; h = bh & 7;
        const int sl = ((pr & 3) + rot) & 3; const int x = pr < 4 ? ((0x6170 >> (4 * sl)) & 15) : ((0x4352 >> (4 * sl)) & 15);
        j = (u & 1) ? 14 - x : x; return !((u & 1) && x == 7); };
    int X = 0;
    { int b, h, j; if (nu > 0) { unit_of(0, b, h, j); gather_dma(ws, b, h, j, lds, 0); } }
    for (int u = 0; u < nu; ++u) {
        asm volatile("s_waitcnt vmcnt(0)" ::: "memory"); __syncthreads();
        int b, h, j; const bool ok = unit_of(u, b, h, j);
        { int b2, h2, j2; if (u + 1 < nu) { const bool ok2 = unit_of(u + 1, b2, h2, j2); if (ok2) gather_dma(ws, b2, h2, j2, lds, X ^ 1); } }
        if (ok) gather_unit(ws, b, h, j, lds, X);
        X ^= 1;
    }
    __syncthreads();
}
__device__ __forceinline__ void attn_phase2(unsigned char* ws, LAS unsigned char* lds, int vb, int nvb) {
    for (int it = vb; it < 2048; it += nvb) { const int bh = it >> 4, qb = it & 15; attn_unit<64, true, 0, true>(ws, bh >> 3, bh & 7, qb, lds); }
}
}

constexpr int RING_BYTES = 131072, MISC_OFF = RING_BYTES + 320, LDS_BYTES = 147456;
constexpr int CW_BAR = 4096;

__global__ void __launch_bounds__(512, 2) mega(Params p) {
    extern __shared__ __attribute__((aligned(16))) unsigned char lds[];
    const int vb = blockIdx.x, nvb = gridDim.x, tid = threadIdx.x, lane = tid & 63, wave = tid >> 6;
    const int gtid = vb * 512 + tid, gsize = nvb * 512, gwave = vb * 8 + wave, nwaves = nvb * 8;
    volatile LAS unsigned* misc = (volatile LAS unsigned*)((LAS unsigned char*)lds + MISC_OFF);
    if (tid < 32) misc[tid] = 0u;
    __syncthreads();
    XcdBarrier bar = xcd_barrier_post((unsigned*)(p.ws + WS_CTL) + CW_BAR, misc + 8);
    LAS unsigned char* ldsl = (LAS unsigned char*)lds;
    { int t_ = threadIdx.x; asm volatile("" : "+v"(t_)); ph_prep(p, vb * 512 + t_, gsize, vb, nvb, ldsl); ph_weights(p, ldsl, vb * 8 + (t_ >> 6), nwaves, t_ >> 6, t_ & 63);
      if (PROBE == 10) ph_weights(p, ldsl, vb * 8 + (t_ >> 6), nwaves, t_ >> 6, t_ & 63);
      if (PROBE == 11) ph_tab(p, vb * 512 + t_, gsize); }
    xcd_barrier(bar);
    for (int rep4 = 0; rep4 < ((PROBE == 4 || PROBE == 6) ? 2 : 1); ++rep4) { int t_ = threadIdx.x; asm volatile("" : "+v"(t_)); ph_hnorm(p, vb * 8 + (t_ >> 6), nwaves, t_ & 63); }
    xcd_barrier(bar);
    {
        pg8::Gemm g{(const pg8::bf16_t*)(p.ws + WS_H), (const pg8::bf16_t*)(p.ws + WT_IN), M_, 5120, 1024}; pg8::StaticOrder S; S.init(M_, 5120, nvb, vb);
        for (int rep = (PROBE == 1 ? 1 : 0); rep >= 0; --rep) { pg8::EpiInF E{p.ws, p.b_merge, rep}; pg8::gemm_phase<pg8::EpiInF, pg8::StaticOrder, true, true>(ldsl, g, S, E); }
        if (PROBE == 5) { pg8::EpiNull E; pg8::gemm_phase<pg8::EpiNull, pg8::StaticOrder, true, true>(ldsl, g, S, E); }
    }
    xcd_barrier(bar);
    { int t_ = threadIdx.x; asm volatile("" : "+v"(t_)); att::ph_gate(p.ws, vb * 8 + (t_ >> 6), nwaves, t_ & 63); }
    for (int rep4 = 0; rep4 < ((PROBE == 4 || PROBE == 7) ? 2 : 1); ++rep4) {
        pg8::Gemm g{(const pg8::bf16_t*)(p.ws + WS_QLAT), (const pg8::bf16_t*)(p.ws + WT_UQ), M_, 768, 256}; pg8::StaticOrder S; S.init(M_, 768, nvb, vb);
        pg8::EpiUqF E{p.ws}; pg8::gemm_phase<pg8::EpiUqF, pg8::StaticOrder, true, true>(ldsl, g, S, E);
    }
    for (int rep4 = 0; rep4 < ((PROBE == 4 || PROBE == 7) ? 2 : 1); ++rep4) {
        pg8::Gemm g{(const pg8::bf16_t*)(p.ws + WS_KVL), (const pg8::bf16_t*)(p.ws + WT_UKV), M_, 1024, 128};     pg8::StaticOrder S; S.init(M_, 1024, nvb, vb);
        pg8::EpiUkvF E{p.ws}; pg8::gemm_phase<pg8::EpiUkvF, pg8::StaticOrder, true, true>(ldsl, g, S, E);
    }
    xcd_barrier(bar);
    att::attn_phase(p.ws, ldsl, vb, nvb);
    xcd_barrier(bar);
    att::attn_phase2(p.ws, ldsl, vb, nvb);
    xcd_barrier(bar);
    {
        pg8::Gemm g{(const pg8::bf16_t*)(p.ws + WS_ZCAT), (const pg8::bf16_t*)(p.ws + WT_OA), M_, 1024, 1024}; pg8::StaticOrder S; S.init(M_, 1024, nvb, vb);
        pg8::EpiYcatF E{p.ws}; pg8::gemm_phase<pg8::EpiYcatF, pg8::StaticOrder, true, true>(ldsl, g, S, E);
    }
    xcd_barrier(bar);
    for (int rep4 = 0; rep4 < ((PROBE == 4 || PROBE == 9) ? 2 : 1); ++rep4) {
        pg8::Gemm g{(const pg8::bf16_t*)(p.ws + WS_YM), (const pg8::bf16_t*)(p.ws + WT_OUT), M_, 1024, 1024}; pg8::StaticOrder S; S.init(M_, 1024, nvb, vb);
        pg8::EpiYF E{p.ws}; pg8::gemm_phase<pg8::EpiYF, pg8::StaticOrder, true, true>(ldsl, g, S, E);
    }
    xcd_barrier(bar);
    for (int rep4 = 0; rep4 < ((PROBE == 4 || PROBE == 9) ? 2 : 1); ++rep4) { int t_ = threadIdx.x; asm volatile("" : "+v"(t_)); ph_final(p, vb * 8 + (t_ >> 6), nwaves, t_ & 63); }
}

extern "C" void kernel_launch(void* const* d_in, const int* in_sizes, int n_in, void* d_out, int out_size, void* d_ws, size_t ws_size, hipStream_t stream) {
    if (n_in != 16 || out_size != M_ * DM || ws_size < WS_END) { fprintf(stderr, "kernel_launch: unexpected shapes (n_in %d, out %d, ws %zu)\n", n_in, out_size, ws_size); return; }
    Params p{};
    p.x = (const float*)d_in[0]; p.c = (const float*)d_in[1]; p.pos = (const int*)d_in[2]; p.w_ada = (const float*)d_in[3]; p.b_ada = (const float*)d_in[4];
    p.g_pre = (const float*)d_in[5]; p.g_post = (const float*)d_in[6]; p.w_in = (const float*)d_in[7]; p.g_q = (const float*)d_in[8]; p.w_uq = (const float*)d_in[9];
    p.g_kv = (const float*)d_in[10]; p.w_ukv = (const float*)d_in[11]; p.w_o_mla = (const float*)d_in[12]; p.w_o_moba = (const float*)d_in[13]; p.b_merge = (const float*)d_in[14]; p.w_out = (const float*)d_in[15];
    p.out = (float*)d_out; p.ws = (unsigned char*)d_ws;
    static int grid = 0;
    if (grid == 0) {
        int dev = 0, cus = 0, per_cu = 0;
        if (hipGetDevice(&dev) != hipSuccess || hipDeviceGetAttribute(&cus, hipDeviceAttributeMultiprocessorCount, dev) != hipSuccess) { fprintf(stderr, "kernel_launch: device query failed\n"); grid = -1; return; }
        if (hipFuncSetAttribute((const void*)mega, hipFuncAttributeMaxDynamicSharedMemorySize, LDS_BYTES) != hipSuccess) { fprintf(stderr, "kernel_launch: hipFuncSetAttribute failed\n"); grid = -1; return; }
        if (hipOccupancyMaxActiveBlocksPerMultiprocessor(&per_cu, (const void*)mega, 512, LDS_BYTES) != hipSuccess || per_cu < 1) { fprintf(stderr, "kernel_launch: occupancy query says %d\n", per_cu); }
        (void)hipGetLastError();
        grid = cus;
    }
    if (grid < 0) return;
    (void)hipMemsetAsync(d_ws, 0, ZERO_BYTES, stream);
    hipLaunchKernelGGL(mega, dim3(grid), dim3(512), LDS_BYTES, stream, p);
}
```

```cpp
#include <hip/hip_runtime.h>
#include <cstdio>
#ifndef PROBE
#define PROBE 0
#endif
#include <cstdint>

typedef _Float16 h16;
typedef _Float16 h16x4 __attribute__((ext_vector_type(4)));
typedef _Float16 h2n __attribute__((ext_vector_type(2)));

constexpr int NB = 16, SEQ = 4096, DM = 1024, M_ = NB * SEQ, NH = 8;
constexpr int D_IN = 5024;
constexpr int C_QLAT = 0, C_KVLAT = 256, C_KROPE = 384, C_ZMLA = 416, C_QMB = 928, C_KMB = 1440, C_VMB = 1952, C_ZMB = 2464, C_GA = 2976, C_GB = 4000;
constexpr float EPS = 1e-6f;
constexpr float LOG2E = 1.4426950408889634f;
constexpr float SC_MLA = 0.10206207261596577f * LOG2E;
constexpr float SC_MB = 0.125f * LOG2E;

constexpr size_t MiB = 1u << 20;
constexpr size_t WS_CTL = 0, WS_KMEAN = 512 * 1024, WS_SSQ = 1 * MiB, WS_SSQY = WS_SSQ + 2 * (size_t)M_ * 4, ZERO_BYTES = 2 * MiB;
constexpr size_t WS_MOD = WS_SSQ + 3 * (size_t)M_ * 4, WS_TAB = 4 * MiB, WS_WT = 20 * MiB;
constexpr size_t WS_H = 36 * MiB, WS_KN = 36 * MiB, WS_VM = 100 * MiB;
constexpr size_t WS_QLAT = 164 * MiB, WS_KVL = 196 * MiB, WS_KPE = 228 * MiB, WS_VMB = 232 * MiB;
constexpr size_t WS_QMB = 296 * MiB, WS_KMB = 360 * MiB, WS_ZCAT = 424 * MiB, WS_YM = 296 * MiB;
constexpr size_t WS_GA = 552 * MiB, WS_GB = 616 * MiB, WS_Y = 680 * MiB,     WS_QMLA = 808 * MiB, WS_LIST = 904 * MiB, WS_ML = 920 * MiB, WS_END = 936 * MiB;
constexpr size_t WS_CNT = 64 * 1024;
__device__ __forceinline__ unsigned opart_off(int slot) { return slot < 2 ? (unsigned)(WS_Y + (size_t)slot * 64 * MiB) : (unsigned)WS_QLAT; }

static_assert(WS_MOD + (size_t)NB * 3072 * 4 <= ZERO_BYTES, "MOD inside the zeroed region");
struct Params {
    const float *x, *c; const int* pos; const float *w_ada, *b_ada, *g_pre, *g_post, *w_in, *g_q, *w_uq, *g_kv, *w_ukv, *w_o_mla, *w_o_moba, *b_merge, *w_out;
    float* out; unsigned char* ws;
};

__device__ __forceinline__ float wave_sum(float v) {
#pragma unroll
    for (int o = 1; o < 64; o <<= 1) v += __shfl_xor(v, o);
    return v;
}
__device__ __forceinline__ float silu_f(float v) { return v / (1.f + __expf(-v)); }
__device__ __forceinline__ float sigmoid_f(float v) { return 1.f / (1.f + __expf(-v)); }

#define LAS __attribute__((address_space(3)))
__device__ void ph_tab(const Params& p, int gtid, int gsize);
__device__ void ph_prep(const Params& p, int gtid, int gsize, int vb, int nvb, LAS unsigned char* lds) {
    float* mod = (float*)(p.ws + WS_MOD);
    { const int tid = gtid - vb * 512; LAS float* sc = (LAS float*)lds; LAS float* part = (LAS float*)(lds + 65536);
      for (int i = tid; i < NB * DM; i += 512) { const float cv = p.c[i]; sc[i] = cv / (1.f + __expf(-cv)); }
      __syncthreads();
      for (int cg = vb; cg < 3072 / 12; cg += nvb) {
          if (tid < 384) { const int col = tid % 12, kc = tid / 12, j = cg * 12 + col, k0 = kc * 32;
              float w[32], acc[NB];
#pragma unroll
              for (int kk = 0; kk < 32; ++kk) w[kk] = p.w_ada[(size_t)(k0 + kk) * 3072 + j];
#pragma unroll
              for (int b = 0; b < NB; ++b) acc[b] = 0.f;
#pragma unroll
              for (int kk = 0; kk < 32; kk += 4) {
#pragma unroll
                  for (int b = 0; b < NB; ++b) { typedef float f4m __attribute__((ext_vector_type(4))); const f4m s4 = *(const LAS f4m*)(sc + b * DM + k0 + kk);
                      acc[b] = fmaf(s4.x, w[kk], acc[b]); acc[b] = fmaf(s4.y, w[kk + 1], acc[b]); acc[b] = fmaf(s4.z, w[kk + 2], acc[b]); acc[b] = fmaf(s4.w, w[kk + 3], acc[b]); } }
#pragma unroll
              for (int b = 0; b < NB; ++b) part[(kc * NB + b) * 12 + col] = acc[b]; }
          __syncthreads();
          if (tid < NB * 12) { const int b = tid / 12, c = tid % 12, j = cg * 12 + c; float s = p.b_ada[j];
#pragma unroll
              for (int kc = 0; kc < 32; ++kc) s += part[(kc * NB + b) * 12 + c];
              mod[b * 3072 + j] = s; }
          __syncthreads();
      } }
    ph_tab(p, gtid, gsize);
}
__device__ void ph_tab(const Params& p, int gtid, int gsize) {
    unsigned* tab = (unsigned*)(p.ws + WS_TAB);
    const int f = gtid & 31;
    const double c = exp2(-(double)f * (13.287712379549449 / 32.0)) * 0.15915494309189535;
    int ex; const double mant = frexp(c, &ex); const double c_hi_d = ldexp(rint(ldexp(mant, 11)), ex - 11);
    const float c_hi = (float)c_hi_d, c_lo = (float)(c - c_hi_d);
    for (int i = gtid; i < M_ * 32; i += gsize) {
        const float pos = (float)p.pos[i >> 5];
        float x = pos * c_hi; x = x - floorf(x); x = fmaf(pos, c_lo, x);
        typedef _Float16 h2t __attribute__((ext_vector_type(2))); h2t cs; cs[0] = (_Float16)__builtin_amdgcn_cosf(x); cs[1] = (_Float16)__builtin_amdgcn_sinf(x);
        tab[i] = __builtin_bit_cast(unsigned, cs);
    }
}

__device__ void ph_hnorm(const Params& p, int gwave, int nwaves, int lane) {
    constexpr int R = 4;
    typedef float f4 __attribute__((ext_vector_type(4)));
    const float* mod = (const float*)(p.ws + WS_MOD); h16* H = (h16*)(p.ws + WS_H);
    for (int m0 = R * gwave; m0 < M_; m0 += R * nwaves) {
        f4 v[R][4]; float ss[R];
#pragma unroll
        for (int r = 0; r < R; ++r) { const f4* xr = (const f4*)(p.x + (size_t)(m0 + r) * DM);
#pragma unroll
            for (int j = 0; j < 4; ++j) v[r][j] = __builtin_nontemporal_load(xr + lane + 64 * j); }
#pragma unroll
        for (int r = 0; r < R; ++r) { float s = 0.f;
#pragma unroll
            for (int j = 0; j < 4; ++j) s += (v[r][j][0] * v[r][j][0] + v[r][j][1] * v[r][j][1]) + (v[r][j][2] * v[r][j][2] + v[r][j][3] * v[r][j][3]);
            ss[r] = 1.f / sqrtf(wave_sum(s) * (1.f / DM) + EPS); }
        const int b = m0 >> 12;
#pragma unroll
        for (int j = 0; j < 4; ++j) {
            const int col = 4 * (lane + 64 * j);
            const float4 g = *(const float4*)(p.g_pre + col), sc = *(const float4*)(mod + b * 3072 + 1024 + col), sh = *(const float4*)(mod + b * 3072 + col);
            const float g0 = g.x * (1.f + sc.x), g1 = g.y * (1.f + sc.y), g2 = g.z * (1.f + sc.z), g3 = g.w * (1.f + sc.w);
#pragma unroll
            for (int r = 0; r < R; ++r) { const float rstd = ss[r]; const f4 x = v[r][j];
                h16x4 o; o[0] = (h16)(x[0] * rstd * g0 + sh.x); o[1] = (h16)(x[1] * rstd * g1 + sh.y); o[2] = (h16)(x[2] * rstd * g2 + sh.z); o[3] = (h16)(x[3] * rstd * g3 + sh.w);
                *(h16x4*)(H + (size_t)(m0 + r) * DM + col) = o; }
        }
    }
}

__device__ void ph_final(const Params& p, int gwave, int nwaves, int lane) {
    constexpr int R = 4; typedef float f4 __attribute__((ext_vector_type(4)));
    const float* mod = (const float*)(p.ws + WS_MOD); const h16* Y = (const h16*)(p.ws + WS_Y); const float* ssq = (const float*)(p.ws + WS_SSQY);
    for (int m0 = R * gwave; m0 < M_; m0 += R * nwaves) {
        const int b = m0 >> 12; h16x4 yv[R][4]; f4 xv[R][4]; float rs[R];
#pragma unroll
        for (int r = 0; r < R; ++r) { const h16x4* yr = (const h16x4*)(Y + (size_t)(m0 + r) * DM); const f4* xr = (const f4*)(p.x + (size_t)(m0 + r) * DM); rs[r] = ssq[m0 + r];
#pragma unroll
            for (int j = 0; j < 4; ++j) { yv[r][j] = yr[lane + 64 * j]; xv[r][j] = __builtin_nontemporal_load(xr + lane + 64 * j); } }
#pragma unroll
        for (int r = 0; r < R; ++r) rs[r] = 1.f / sqrtf(rs[r] * (1.f / DM) + EPS);
#pragma unroll
        for (int j = 0; j < 4; ++j) {
            const int col = 4 * (lane + 64 * j); const float4 g = *(const float4*)(p.g_post + col), gt = *(const float4*)(mod + b * 3072 + 2048 + col);
            const float g0 = g.x * gt.x, g1 = g.y * gt.y, g2 = g.z * gt.z, g3 = g.w * gt.w;
#pragma unroll
            for (int r = 0; r < R; ++r) { const h16x4 y = yv[r][j]; const f4 x = xv[r][j]; const float s = rs[r];
                f4 o; o[0] = x[0] + g0 * (float)y[0] * s; o[1] = x[1] + g1 * (float)y[1] * s; o[2] = x[2] + g2 * (float)y[2] * s; o[3] = x[3] + g3 * (float)y[3] * s;
                __builtin_nontemporal_store(o, (f4*)(p.out + (size_t)(m0 + r) * DM) + lane + 64 * j); }
        }
    }
}


#define XB_TMO      128
#define XB_XCNT(j)  (256  + 64 * (j))
#define XB_XSUB(j)  (1280 + 64 * (j))
#define XB_XGEN(j)  (2304 + 64 * (j))
#define XB_TOP      3328
#define XB_TOPGEN   3392
#define XCD_BAR_WORDS 3456
#define XB_SPIN_CAP (1u << 27)
__device__ __forceinline__ unsigned xb_ld(unsigned* p)              { return __hip_atomic_load(p, __ATOMIC_RELAXED, __HIP_MEMORY_SCOPE_AGENT); }
__device__ __forceinline__ unsigned xb_add(unsigned* p, unsigned v) { return __hip_atomic_fetch_add(p, v, __ATOMIC_RELAXED, __HIP_MEMORY_SCOPE_AGENT); }
__device__ __forceinline__ unsigned xb_xcc_id() { return (unsigned)__builtin_amdgcn_s_getreg((3 << 11) | 20) & 0xFu; }
#define XB_SPIN(cond, bar) do { unsigned _sp = 0; while (cond) { __builtin_amdgcn_s_sleep(1); \
    if ((++_sp & 255u) == 0u) { if (xb_ld(&(bar)[XB_TMO])) break; if (_sp > XB_SPIN_CAP) { atomicAdd(&(bar)[XB_TMO], 1u); break; } } } } while (0)
struct XcdBarrier { unsigned* bar; unsigned x; volatile LAS unsigned* st; };
__device__ __forceinline__ XcdBarrier xcd_barrier_post(unsigned* bar, volatile LAS unsigned* st) {
    XcdBarrier b; b.bar = bar; b.x = xb_xcc_id(); b.st = st;
    if (threadIdx.x == 0) (void)xb_add(&bar[XB_XCNT(b.x)], 1u);
    return b;
}
__device__ __forceinline__ void xcd_barrier_complete(unsigned* bar, unsigned x, unsigned& nloc, unsigned& nx) {
    const unsigned G = gridDim.x * gridDim.y * gridDim.z;
    unsigned sum, cnt, mine, sp = 0u;
    for (;;) {
        sum = 0u; cnt = 0u; mine = 0u;
#pragma unroll
        for (unsigned j = 0; j < 16; ++j) { const unsigned c = xb_ld(&bar[XB_XCNT(j)]); sum += c; cnt += (c > 0u) ? 1u : 0u; mine = (j == x) ? c : mine; }
        if (sum == G) break;
        __builtin_amdgcn_s_sleep(1);
        if ((++sp & 255u) == 0u) { if (xb_ld(&bar[XB_TMO])) break; if (sp > XB_SPIN_CAP) { atomicAdd(&bar[XB_TMO], 1u); break; } }
    }
    nloc = mine > 0u ? mine : 1u; nx = cnt > 0u ? cnt : 1u;
}
__device__ __forceinline__ void xcd_barrier(const XcdBarrier& b) {
    asm volatile("s_waitcnt vmcnt(0)" ::: "memory");
    __syncthreads();
    if (threadIdx.x == 0) {
        unsigned* bar = b.bar;
        __builtin_amdgcn_s_waitcnt(0);
        unsigned nloc = b.st[0], nx = b.st[1];
        if (nloc == 0u) { xcd_barrier_complete(bar, b.x, nloc, nx); b.st[0] = nloc; b.st[1] = nx; }
        const unsigned old = xb_add(&bar[XB_XSUB(b.x)], 1u);
        const unsigned gen = old / nloc;
        if (old + 1u == (gen + 1u) * nloc) {
            __builtin_amdgcn_fence(__ATOMIC_RELEASE, "agent");
            asm volatile("s_waitcnt vmcnt(0)" ::: "memory");
            const unsigned og = xb_add(&bar[XB_TOP], 1u);
            const unsigned tg = og / nx;
            if (og + 1u == (tg + 1u) * nx) xb_add(&bar[XB_TOPGEN], 1u);
            else XB_SPIN(xb_ld(&bar[XB_TOPGEN]) == tg, bar);
            __builtin_amdgcn_fence(__ATOMIC_ACQUIRE, "agent");
            xb_add(&bar[XB_XGEN(b.x)], 1u);
            asm volatile("s_waitcnt vmcnt(0)" ::: "memory");
        } else {
            XB_SPIN(xb_ld(&bar[XB_XGEN(b.x)]) == gen, bar);
            __builtin_amdgcn_fence(__ATOMIC_ACQUIRE, "agent");
            asm volatile("s_waitcnt vmcnt(0)" ::: "memory");
        }
    }
    __syncthreads();
}

namespace pg8 {
#define PG8_LAS __attribute__((address_space(3)))
typedef unsigned short bf16_t;
typedef _Float16 bf16x8 __attribute__((ext_vector_type(8)));
typedef float f32x4 __attribute__((ext_vector_type(4)));
typedef unsigned u32x4 __attribute__((ext_vector_type(4)));
constexpr int BM = 256, BK = 64, HALF = 128, HTB = HALF * BK * 2  , STAGE_BYTES = 8 * HTB, NXCD = 8, WGM = 8;

__host__ __device__ __forceinline__ int lds_byte(int r, int c) { const int st = (r >> 4) * 2 + (c >> 5), rr = r & 15, cc = c & 31, ob = rr * 64 + cc * 2; return st * 1024 + (ob ^ (((ob >> 9) & 1) << 5)); }
__host__ __device__ __forceinline__ void stage_rc(int b, int& R, int& C) { const int st = b / 1024, sb = b % 1024, swz = sb ^ (((sb >> 9) & 1) << 5); R = (st >> 1) * 16 + swz / 64; C = (st & 1) * 32 + (swz % 64) / 2; }
__host__ __device__ __forceinline__ int perm32(int rho) { const int n = rho >> 4, i = rho & 15; return 8 * (i >> 2) + 4 * n + (i & 3); }

struct Unit { int pm, pn; };
struct Gemm { const bf16_t* A; const bf16_t* Bt; int M, N, K; };

struct StaticOrder {
    int nM, nN, nwg, G, c;
    __host__ __device__ void init(int M, int N, int G_, int c_) { nM = M / BM; nN = N / BM; nwg = nM * nN; G = G_; c = c_; }
    __host__ __device__ bool next(int i, Unit& u) const {
        const long L = (long)i * G + c; if (L >= nwg) return false;
        int wgid = (int)L; { const int q = nwg / NXCD, r = nwg % NXCD, xcd = wgid % NXCD, off = wgid / NXCD; wgid = (xcd < r ? xcd * (q + 1) : r * (q + 1) + (xcd - r) * q) + off; }
        const int nig = WGM * nN, gid = wgid / nig, fm = gid * WGM, gsz = (nM - fm) < WGM ? (nM - fm) : WGM;
        u.pm = fm + ((wgid % nig) % gsz); u.pn = (wgid % nig) / gsz; return true;
    }
    __device__ __forceinline__ void a_ready(const Unit&) const {}
    __device__ __forceinline__ void done(const Unit&) const {}
};

template <class Epi, class Sched, bool ALIGN_EPI = false, bool SP2 = false>
__device__ __forceinline__ void gemm_phase(PG8_LAS unsigned char* lds, const Gemm g, const Sched& S, const Epi& E) {
    int tid_ = threadIdx.x; asm volatile("" : "+v"(tid_));
    const int tid = tid_, wid = __builtin_amdgcn_readfirstlane(tid >> 6), lane = tid & 63, wr = wid >> 2, wc = wid & 3, fr = lane & 15, fq = lane >> 4;
    const int K = g.K, nt = K / BK;
    unsigned voffA[2], voffB[2];
#pragma unroll
    for (int i = 0; i < 2; ++i) { int R, C; stage_rc(tid * 16 + i * 8192, R, C); const int Rb = Epi::PERM ? ((R & ~31) + perm32(R & 31)) : R;
        voffA[i] = (unsigned)(R * K + C) * 2u; voffB[i] = (unsigned)(Rb * K + C) * 2u; }
    const size_t kstep = (size_t)(BK * 2);
    const size_t hstep = (size_t)HALF * K * 2;
    const size_t tstep = 2 * hstep;
    const unsigned ldsw = (unsigned)wid * 1024u;
    const int aoff = lds_byte(wr * 64 + fr, fq * 8), boff = lds_byte(wc * 32 + fr, fq * 8);
#define PG8_SA(b, h) (((b) * 2 + (h)) * HTB)
#define PG8_SB(b, h) ((4 + (b) * 2 + (h)) * HTB)
#define PG8_STAGE(bufoff, gbase, voff) do { _Pragma("unroll") for (int _i = 0; _i < 2; ++_i) \
        __builtin_amdgcn_global_load_lds((const unsigned*)((const char*)(gbase) + (voff)[_i]), (PG8_LAS unsigned*)(lds + (bufoff) + ldsw + _i * 8192), 16, 0, 0); } while (0)
#define PG8_LDA(dst, b, h) do { _Pragma("unroll") for (int m = 0; m < 4; ++m) _Pragma("unroll") for (int k = 0; k < 2; ++k) dst[m][k] = *(const PG8_LAS bf16x8*)(lds + PG8_SA(b, h) + aoff + m * 2048 + k * 1024); } while (0)
#define PG8_LDB(dst, b, h) do { _Pragma("unroll") for (int n = 0; n < 2; ++n) _Pragma("unroll") for (int k = 0; k < 2; ++k) dst[n][k] = *(const PG8_LAS bf16x8*)(lds + PG8_SB(b, h) + boff + n * 2048 + k * 1024); } while (0)
#define PG8_MMA(ai, bj, At, Bt) do { __builtin_amdgcn_s_setprio(1); _Pragma("unroll") for (int m = 0; m < 4; ++m) _Pragma("unroll") for (int n = 0; n < 2; ++n) _Pragma("unroll") for (int k = 0; k < 2; ++k) \
        acc[ai][bj][m][n] = __builtin_amdgcn_mfma_f32_16x16x32_f16(Bt[n][k], At[m][k], acc[ai][bj][m][n], 0, 0, 0); __builtin_amdgcn_s_setprio(0); } while (0)
#define PG8_WAIT_V(n) asm volatile("s_waitcnt vmcnt(" #n ")" ::: "memory")
#define PG8_WAIT_L(n) asm volatile("s_waitcnt lgkmcnt(" #n ")" ::: "memory")
#define PG8_BAR __builtin_amdgcn_s_barrier()
#define PG8_SCHED __builtin_amdgcn_sched_barrier(0)
    Unit cur, nxt; int ui = 0;
    if (!S.next(0, cur)) return;
    f32x4 acc[2][2][4][2];
#pragma unroll
    for (int a = 0; a < 2; ++a)
#pragma unroll
        for (int b = 0; b < 2; ++b)
#pragma unroll
            for (int m = 0; m < 4; ++m)
#pragma unroll
                for (int n = 0; n < 2; ++n) acc[a][b][m][n] = (f32x4){0.f, 0.f, 0.f, 0.f};
    bf16x8 At[4][2], B0[2][2], B1[2][2];
    const char* cA = (const char*)g.A + (size_t)cur.pm * tstep; const char* cB = (const char*)g.Bt + (size_t)cur.pn * tstep;
    S.a_ready(cur);
    if constexpr (SP2) {
        PG8_STAGE(PG8_SB(0, 0), cB, voffB); PG8_STAGE(PG8_SB(0, 1), cB + hstep, voffB); PG8_STAGE(PG8_SA(0, 0), cA, voffA); PG8_STAGE(PG8_SA(0, 1), cA + hstep, voffA);
        if (wr == 1) PG8_BAR;
        PG8_WAIT_V(2); PG8_BAR;
        PG8_STAGE(PG8_SB(1, 0), cB + kstep, voffB); PG8_STAGE(PG8_SA(1, 0), cA + kstep, voffA); PG8_STAGE(PG8_SB(1, 1), cB + hstep + kstep, voffB);
        PG8_WAIT_V(6); PG8_BAR;
    } else {
        PG8_STAGE(PG8_SB(0, 0), cB, voffB); PG8_STAGE(PG8_SA(0, 0), cA, voffA); PG8_STAGE(PG8_SB(0, 1), cB + hstep, voffB); PG8_STAGE(PG8_SA(0, 1), cA + hstep, voffA);
        if (wr == 1) PG8_BAR;
        PG8_WAIT_V(4); PG8_BAR;
        PG8_STAGE(PG8_SB(1, 0), cB + kstep, voffB); PG8_STAGE(PG8_SA(1, 0), cA + kstep, voffA); PG8_STAGE(PG8_SB(1, 1), cB + hstep + kstep, voffB);
        PG8_WAIT_V(6); PG8_BAR;
    }
    for (;;) {
        const bool has_next = S.next(ui + 1, nxt);
        const char* nA = has_next ? (const char*)g.A + (size_t)nxt.pm * tstep : cA; const char* nB = has_next ? (const char*)g.Bt + (size_t)nxt.pn * tstep : cB;
#pragma nounroll
        for (int t = 0; t < nt; t += 2) {
            const bool last = (t == nt - 2);
            if constexpr (Epi::MID_T > 0) { if (t == Epi::MID_T) E.mid(acc, cur, wr, wc); }
            const char* a1 = cA + (size_t)(t + 1) * kstep;
            const char* a2 = last ? nA : cA + (size_t)(t + 2) * kstep; const char* b2 = last ? nB : cB + (size_t)(t + 2) * kstep;
            const char* a3 = a2 + kstep; const char* b3 = b2 + kstep;
            if (last && has_next) S.a_ready(nxt);
            if constexpr (SP2) {
            PG8_LDB(B0, 0, 0); PG8_LDB(B1, 0, 1); PG8_SCHED; PG8_LDA(At, 0, 0); PG8_STAGE(PG8_SA(1, 1), a1 + hstep, voffA);
            PG8_WAIT_V(8); PG8_WAIT_L(0); PG8_BAR; PG8_MMA(0, 0, At, B0); PG8_MMA(0, 1, At, B1); PG8_BAR; PG8_SCHED;
            PG8_LDA(At, 0, 1); PG8_STAGE(PG8_SB(0, 0), b2, voffB); PG8_STAGE(PG8_SB(0, 1), b2 + hstep, voffB); PG8_STAGE(PG8_SA(0, 0), a2, voffA);
            PG8_WAIT_V(8); PG8_WAIT_L(0); PG8_BAR; PG8_MMA(1, 0, At, B0); PG8_MMA(1, 1, At, B1); PG8_BAR; PG8_SCHED;
            PG8_LDB(B0, 1, 0); PG8_LDB(B1, 1, 1); PG8_SCHED; PG8_LDA(At, 1, 0); PG8_STAGE(PG8_SA(0, 1), a2 + hstep, voffA);
            PG8_WAIT_V(8); PG8_WAIT_L(0); PG8_BAR; PG8_MMA(0, 0, At, B0); PG8_MMA(0, 1, At, B1); PG8_BAR; PG8_SCHED;
            PG8_LDA(At, 1, 1); PG8_STAGE(PG8_SB(1, 0), b3, voffB); PG8_STAGE(PG8_SB(1, 1), b3 + hstep, voffB); PG8_STAGE(PG8_SA(1, 0), a3, voffA);
            PG8_WAIT_V(8); PG8_WAIT_L(0); PG8_BAR; PG8_MMA(1, 0, At, B0); PG8_MMA(1, 1, At, B1); PG8_BAR; PG8_SCHED;
            } else {
            PG8_LDB(B0, 0, 0); PG8_SCHED; PG8_LDA(At, 0, 0); PG8_STAGE(PG8_SA(1, 1), a1 + hstep, voffA);
            PG8_WAIT_L(8); PG8_BAR; PG8_WAIT_L(0); PG8_MMA(0, 0, At, B0); PG8_BAR; PG8_SCHED;
            PG8_LDB(B1, 0, 1); PG8_STAGE(PG8_SB(0, 0), b2, voffB);
            PG8_BAR; PG8_WAIT_L(0); PG8_MMA(0, 1, At, B1); PG8_BAR;
            PG8_LDA(At, 0, 1); PG8_STAGE(PG8_SA(0, 0), a2, voffA);
            PG8_BAR; PG8_WAIT_L(0); PG8_MMA(1, 0, At, B0); PG8_BAR; PG8_SCHED;
            PG8_STAGE(PG8_SB(0, 1), b2 + hstep, voffB);
            PG8_WAIT_V(6); PG8_BAR; PG8_MMA(1, 1, At, B1); PG8_BAR;
            PG8_LDB(B0, 1, 0); PG8_SCHED; PG8_LDA(At, 1, 0); PG8_STAGE(PG8_SA(0, 1), a2 + hstep, voffA);
            PG8_WAIT_L(8); PG8_BAR; PG8_WAIT_L(0); PG8_MMA(0, 0, At, B0); PG8_BAR; PG8_SCHED;
            PG8_LDB(B1, 1, 1); PG8_STAGE(PG8_SB(1, 0), b3, voffB);
            PG8_BAR; PG8_WAIT_L(0); PG8_MMA(0, 1, At, B1); PG8_BAR;
            PG8_LDA(At, 1, 1); PG8_STAGE(PG8_SA(1, 0), a3, voffA);
            PG8_BAR; PG8_WAIT_L(0); PG8_MMA(1, 0, At, B0); PG8_BAR; PG8_SCHED;
            PG8_STAGE(PG8_SB(1, 1), b3 + hstep, voffB);
            PG8_WAIT_V(6); PG8_BAR; PG8_MMA(1, 1, At, B1); PG8_BAR;
            }
        }
        if constexpr (ALIGN_EPI) { if (wr == 0) PG8_BAR; }
        if constexpr (!Epi::AFTER_DRAIN) { E(acc, cur, wr, wc, fr, fq); S.done(cur); }
        if (!has_next) break;
#pragma unroll
        for (int a = 0; a < 2; ++a)
#pragma unroll
            for (int b = 0; b < 2; ++b)
#pragma unroll
                for (int m = 0; m < 4; ++m)
#pragma unroll
                    for (int n = 0; n < 2; ++n) acc[a][b][m][n] = (f32x4){0.f, 0.f, 0.f, 0.f};
        cur = nxt; cA = nA; cB = nB; ++ui;
        if constexpr (ALIGN_EPI) { if (wr == 1) PG8_BAR; }
    }
    PG8_WAIT_V(0);
    if constexpr (!ALIGN_EPI) { if (wr == 0) PG8_BAR; }
    PG8_BAR;
    if constexpr (Epi::AFTER_DRAIN) { E.fused(acc, cur, wr, wc, fr, fq, lds, wid, lane); S.done(cur); }
#undef PG8_SA
#undef PG8_SB
#undef PG8_STAGE
#undef PG8_LDA
#undef PG8_LDB
#undef PG8_MMA
#undef PG8_WAIT_V
#undef PG8_WAIT_L
#undef PG8_BAR
#undef PG8_SCHED
}
typedef _Float16 h8v __attribute__((ext_vector_type(8)));
typedef unsigned u32x2 __attribute__((ext_vector_type(2)));
typedef _Float16 h2v __attribute__((ext_vector_type(2)));
__device__ __forceinline__ unsigned pk_h2(float lo, float hi) { h2v v; v[0] = (_Float16)lo; v[1] = (_Float16)hi; return __builtin_bit_cast(unsigned, v); }
__device__ __forceinline__ u32x4 pack8(const f32x4& a, const f32x4& b) { u32x4 w; w.x = pk_h2(a[0], a[1]); w.y = pk_h2(a[2], a[3]); w.z = pk_h2(b[0], b[1]); w.w = pk_h2(b[2], b[3]); return w; }
__device__ __forceinline__ float sigm1(float v) { return __builtin_amdgcn_rcpf(1.f + __builtin_amdgcn_exp2f(v * -1.4426950408889634f)); }
__device__ __forceinline__ float silu1(float v) { return v * sigm1(v); }
__device__ __forceinline__ f32x4 silu4(const f32x4& v) { return (f32x4){silu1(v[0]), silu1(v[1]), silu1(v[2]), silu1(v[3])}; }
__device__ __forceinline__ f32x4 sigm4(const f32x4& v) { return (f32x4){sigm1(v[0]), sigm1(v[1]), sigm1(v[2]), sigm1(v[3])}; }

#define PG8_OPAQUE(fr_, fq_) int lane_x; asm volatile("v_mbcnt_lo_u32_b32 %0, -1, 0\n\tv_mbcnt_hi_u32_b32 %0, -1, %0" : "=v"(lane_x)); const int frx = lane_x & 15, fqx = lane_x >> 4
__device__ __forceinline__ void st16(unsigned char* base, unsigned off, const u32x4& v) { *(u32x4*)(base + off) = v; }
__device__ __forceinline__ f32x4 ld16f(const unsigned char* base, unsigned off) { return *(const f32x4*)(base + off); }
__device__ __forceinline__ float ld4f(const unsigned char* base, unsigned off) { return *(const float*)(base + off); }
__device__ __forceinline__ h8v ld16h(const unsigned char* base, unsigned off) { return *(const h8v*)(base + off); }
__device__ __forceinline__ float sumsq8(const f32x4& a, const f32x4& b) { return (a[0] * a[0] + a[1] * a[1]) + (a[2] * a[2] + a[3] * a[3]) + (b[0] * b[0] + b[1] * b[1]) + (b[2] * b[2] + b[3] * b[3]); }
__device__ __forceinline__ void rope4(const f32x4& t1, const f32x4& t2, const u32x4& cs, f32x4& o1, f32x4& o2) {
#pragma unroll
    for (int j = 0; j < 4; ++j) { const unsigned wj = cs[j]; h2v w; __builtin_memcpy(&w, &wj, 4);
        const float c = (float)w[0], s = (float)w[1]; o1[j] = t1[j] * c - t2[j] * s; o2[j] = t2[j] * c + t1[j] * s; }
}
__device__ __forceinline__ u32x4 ld16u(const unsigned char* base, unsigned off) { return *(const u32x4*)(base + off); }

struct EpiInF {
    static constexpr bool PERM = true, AFTER_DRAIN = false; static constexpr int MID_T = 0;
    unsigned char* ws; const float* b_merge; int noatomic;
    template <bool ISQ> __device__ __forceinline__ void rope_tile(const f32x4 (&acc)[2][2][4][2], const Unit& u, int wr, int wc, int frx, int fqx) const {
        const int pn = u.pn; const unsigned row0 = (unsigned)(u.pm * 256 + wr * 64) + (unsigned)frx; const float sc = ISQ ? SC_MB : 1.f;
        unsigned char* dst = ws + (ISQ ? WS_QMB : WS_KMB); const unsigned char* tab = ws + WS_TAB;
        const unsigned o0 = row0 * 1024u + (((pn & 1) ? 256u : 0u) + 64u * wc + 8u * fqx) * 2u, t0 = row0 * 128u + 32u * fqx;
        f32x4 c1[2] = {{0.f, 0.f, 0.f, 0.f}, {0.f, 0.f, 0.f, 0.f}}, c2[2] = {{0.f, 0.f, 0.f, 0.f}, {0.f, 0.f, 0.f, 0.f}};
        u32x4 cs[2][4][2];
#pragma unroll
        for (int ai = 0; ai < 2; ++ai)
#pragma unroll
            for (int m = 0; m < 4; ++m) { const unsigned to = t0 + (unsigned)(ai * 128 + m * 16) * 128u; cs[ai][m][0] = ld16u(tab, to); cs[ai][m][1] = ld16u(tab, to + 16u); }
#pragma unroll
        for (int ai = 0; ai < 2; ++ai)
#pragma unroll
            for (int m = 0; m < 4; ++m) { const unsigned ro = o0 + (unsigned)(ai * 128 + m * 16) * 1024u;
                f32x4 o1[2], o2[2];
#pragma unroll
                for (int n = 0; n < 2; ++n) { rope4(acc[ai][0][m][n], acc[ai][1][m][n], cs[ai][m][n], o1[n], o2[n]);
                    if (!ISQ) { c1[n] += o1[n]; c2[n] += o2[n]; } }
                st16(dst, ro, pack8(o1[0] * sc, o1[1] * sc)); st16(dst, ro + 64u, pack8(o2[0] * sc, o2[1] * sc));
                if (!ISQ) asm volatile("" : "+v"(c1[0]), "+v"(c1[1]), "+v"(c2[0]), "+v"(c2[1])); }
        if (!ISQ) {
            float* km = (float*)(ws + WS_KMEAN) + (size_t)u.pm * 512 + ((pn & 1) ? 256 : 0) + 64 * wc + 8 * fqx;
#pragma unroll
            for (int n = 0; n < 2; ++n)
#pragma unroll
                for (int j = 0; j < 4; ++j) { float a = c1[n][j], b = c2[n][j];
#pragma unroll
                    for (int o = 1; o < 16; o <<= 1) { a += __shfl_xor(a, o); b += __shfl_xor(b, o); }
                    if (frx == 0 && !noatomic) { atomicAdd(km + 4 * n + j, a * (1.f / 256.f)); atomicAdd(km + 32 + 4 * n + j, b * (1.f / 256.f)); } }
        }
    }
    __device__ __forceinline__ void operator()(const f32x4 (&acc)[2][2][4][2], const Unit& u, int wr, int wc, int fr, int fq) const {
        PG8_OPAQUE(fr, fq);
        const int pn = u.pn; const unsigned row0 = (unsigned)(u.pm * 256 + wr * 64) + (unsigned)frx, cl = 32u * wc + 8u * fqx;
        if (pn == 0) {
            unsigned char* dst = ws + WS_QLAT; float* ssq = (float*)(ws + WS_SSQ); const unsigned o0 = row0 * 512u + cl * 2u;
#pragma unroll
            for (int ai = 0; ai < 2; ++ai)
#pragma unroll
                for (int m = 0; m < 4; ++m) { const unsigned ro = o0 + (unsigned)(ai * 128 + m * 16) * 512u; float s = 0.f;
#pragma unroll
                    for (int bj = 0; bj < 2; ++bj) { s += sumsq8(acc[ai][bj][m][0], acc[ai][bj][m][1]); st16(dst, ro + bj * 256u, pack8(acc[ai][bj][m][0], acc[ai][bj][m][1])); }
                    s += __shfl_xor(s, 16); s += __shfl_xor(s, 32);
                    if (fqx == 0 && !noatomic) atomicAdd(ssq + (row0 + ai * 128 + m * 16), s); }
        } else if (pn == 1) {
            unsigned char* kvl = ws + WS_KVL; unsigned char* kpe = ws + WS_KPE; float* ssq = (float*)(ws + WS_SSQ) + M_; const unsigned char* tab = ws + WS_TAB;
#pragma unroll
            for (int ai = 0; ai < 2; ++ai)
#pragma unroll
                for (int m = 0; m < 4; ++m) { const unsigned row = row0 + ai * 128 + m * 16;
                    if (wc < 2) { float s = 0.f;
#pragma unroll
                        for (int bj = 0; bj < 2; ++bj) { s += sumsq8(acc[ai][bj][m][0], acc[ai][bj][m][1]); st16(kvl, row * 256u + (bj * 64u + cl) * 2u, pack8(acc[ai][bj][m][0], acc[ai][bj][m][1])); }
                        s += __shfl_xor(s, 16); s += __shfl_xor(s, 32);
                        if (fqx == 0 && !noatomic) atomicAdd(ssq + row, s);
                    } else {
                        if (wc == 2 && fqx < 2) {
                            f32x4 o1[2], o2[2];
#pragma unroll
                            for (int n = 0; n < 2; ++n) { const unsigned to = row * 128u + (unsigned)(16 * fqx + 8 * n) * 4u; const u32x4 wa = ld16u(tab, to), wb = ld16u(tab, to + 16u);
                                rope4(acc[ai][0][m][n], acc[ai][1][m][n], (u32x4){wa[0], wa[2], wb[0], wb[2]}, o1[n], o2[n]); }
                            st16(kpe, row * 64u + 16u * fqx, pack8(o1[0], o1[1])); st16(kpe, row * 64u + 32u + 16u * fqx, pack8(o2[0], o2[1]));
                        }
                    }
                    asm volatile("" ::: "memory"); }
        } else if (pn < 4 || (pn >= 8 && pn < 12)) {
            const bool act = (pn < 4) || (pn >= 10); const unsigned pitch = act ? 2048u : 1024u;
            unsigned char* dst = ws + (act ? WS_ZCAT : WS_VMB); const unsigned o0 = row0 * pitch + ((pn >= 10 ? 512u : 0u) + ((pn & 1) ? 256u : 0u) + cl) * 2u;
#pragma unroll
            for (int ai = 0; ai < 2; ++ai)
#pragma unroll
                for (int m = 0; m < 4; ++m) { const unsigned ro = o0 + (unsigned)(ai * 128 + m * 16) * pitch;
#pragma unroll
                    for (int bj = 0; bj < 2; ++bj) { f32x4 a = acc[ai][bj][m][0], b = acc[ai][bj][m][1]; if (act) { a = silu4(a); b = silu4(b); }
                        st16(dst, ro + bj * 256u, pack8(a, b)); } }
        } else if (pn < 6) { rope_tile<true>(acc, u, wr, wc, frx, fqx);
        } else if (pn < 8) { rope_tile<false>(acc, u, wr, wc, frx, fqx);
        } else {
            const bool isa = pn < 16; unsigned char* dst = ws + (isa ? WS_GA : WS_GB); const unsigned cg = 256u * ((pn - 12) & 3) + cl;
            const unsigned char* bm = (const unsigned char*)(b_merge + (isa ? 0 : 1024)); const unsigned o0 = row0 * 1024u + cg;
            f32x4 bv[2][2];
#pragma unroll
            for (int bj = 0; bj < 2; ++bj)
#pragma unroll
                for (int n = 0; n < 2; ++n) bv[bj][n] = ld16f(bm, (cg + bj * 128u + 4u * n) * 4u);
#pragma unroll
            for (int ai = 0; ai < 2; ++ai)
#pragma unroll
                for (int m = 0; m < 4; ++m) { const unsigned ro = o0 + (unsigned)(ai * 128 + m * 16) * 1024u;
#pragma unroll
                    for (int bj = 0; bj < 2; ++bj) { const f32x4 a = sigm4(acc[ai][bj][m][0] + bv[bj][0]) * 255.f + 0.5f, b = sigm4(acc[ai][bj][m][1] + bv[bj][1]) * 255.f + 0.5f;
                        u32x2 w; w.x = (unsigned)a[0] | ((unsigned)a[1] << 8) | ((unsigned)a[2] << 16) | ((unsigned)a[3] << 24); w.y = (unsigned)b[0] | ((unsigned)b[1] << 8) | ((unsigned)b[2] << 16) | ((unsigned)b[3] << 24);
                        *(u32x2*)(dst + (ro + bj * 128u)) = w; } }
        }
    }
};
struct EpiNull {
    static constexpr bool PERM = true, AFTER_DRAIN = false; static constexpr int MID_T = 0;
    __device__ __forceinline__ void operator()(const f32x4 (&acc)[2][2][4][2], const Unit& u, int wr, int wc, int fr, int fq) const {
#pragma unroll
        for (int ai = 0; ai < 2; ++ai)
#pragma unroll
            for (int bj = 0; bj < 2; ++bj)
#pragma unroll
                for (int m = 0; m < 4; ++m) asm volatile("" :: "v"(acc[ai][bj][m][0]), "v"(acc[ai][bj][m][1]));
    }
};
struct EpiUqF {
    static constexpr bool PERM = true, AFTER_DRAIN = false; static constexpr int MID_T = 0;
    unsigned char* ws;
    __device__ __forceinline__ void operator()(const f32x4 (&acc)[2][2][4][2], const Unit& u, int wr, int wc, int fr, int fq) const {
        PG8_OPAQUE(fr, fq);
        const int pn = u.pn; const unsigned row0 = (unsigned)(u.pm * 256 + wr * 64) + (unsigned)frx; unsigned char* Q = ws + WS_QMLA; const unsigned char* ssq = ws + WS_SSQ; const unsigned char* tab = ws + WS_TAB;
        float rsv[2][4];
#pragma unroll
        for (int ai = 0; ai < 2; ++ai)
#pragma unroll
            for (int m = 0; m < 4; ++m) rsv[ai][m] = ld4f(ssq, (row0 + ai * 128 + m * 16) * 4u);
#pragma unroll
        for (int ai = 0; ai < 2; ++ai)
#pragma unroll
            for (int m = 0; m < 4; ++m) { const unsigned row = row0 + ai * 128 + m * 16; const float rs = SC_MLA * __builtin_amdgcn_rsqf(rsv[ai][m] * (1.f / 256.f) + EPS);
                if (pn < 2) {
#pragma unroll
                    for (int bj = 0; bj < 2; ++bj) { const unsigned head = 4u * pn + 2u * bj + (wc >> 1), d = 32u * (wc & 1) + 8u * fqx;
                        st16(Q, row * 1536u + (96u * head + d) * 2u, pack8(acc[ai][bj][m][0] * rs, acc[ai][bj][m][1] * rs)); }
                } else { const unsigned head = 2u * wc + ((unsigned)fqx >> 1), i0 = 8u * (fqx & 1); f32x4 o1[2], o2[2];
#pragma unroll
                    for (int n = 0; n < 2; ++n) { const unsigned to = row * 128u + (2u * (i0 + 4u * n)) * 4u; const u32x4 wa = ld16u(tab, to), wb = ld16u(tab, to + 16u);
                        rope4(acc[ai][0][m][n] * rs, acc[ai][1][m][n] * rs, (u32x4){wa[0], wa[2], wb[0], wb[2]}, o1[n], o2[n]); }
                    st16(Q, row * 1536u + (96u * head + 64u + i0) * 2u, pack8(o1[0], o1[1])); st16(Q, row * 1536u + (96u * head + 80u + i0) * 2u, pack8(o2[0], o2[1])); } }
    }
};
struct EpiUkvF {
    static constexpr bool PERM = true, AFTER_DRAIN = false; static constexpr int MID_T = 0;
    unsigned char* ws;
    __device__ __forceinline__ void operator()(const f32x4 (&acc)[2][2][4][2], const Unit& u, int wr, int wc, int fr, int fq) const {
        PG8_OPAQUE(fr, fq);
        const int pn = u.pn; const unsigned row0 = (unsigned)(u.pm * 256 + wr * 64) + (unsigned)frx; unsigned char* dst = ws + (pn < 2 ? WS_KN : WS_VM); const unsigned char* ssq = ws + WS_SSQ + (size_t)M_ * 4;
        float rsv[2][4];
#pragma unroll
        for (int ai = 0; ai < 2; ++ai)
#pragma unroll
            for (int m = 0; m < 4; ++m) rsv[ai][m] = ld4f(ssq, (row0 + ai * 128 + m * 16) * 4u);
#pragma unroll
        for (int ai = 0; ai < 2; ++ai)
#pragma unroll
            for (int m = 0; m < 4; ++m) { const unsigned row = row0 + ai * 128 + m * 16; const float rs = __builtin_amdgcn_rsqf(rsv[ai][m] * (1.f / 128.f) + EPS);
#pragma unroll
                for (int bj = 0; bj < 2; ++bj) { const unsigned head = 4u * (pn & 1) + 2u * bj + (wc >> 1), d = 32u * (wc & 1) + 8u * fqx;
                    st16(dst, row * 1024u + (64u * head + d) * 2u, pack8(acc[ai][bj][m][0] * rs, acc[ai][bj][m][1] * rs)); } }
    }
};
struct EpiYcatF {
    static constexpr bool PERM = true, AFTER_DRAIN = false; static constexpr int MID_T = 8;
    unsigned char* ws;
    template <bool MID> __device__ __forceinline__ void run(f32x4 (&acc)[2][2][4][2], const Unit& u, int wr, int wc) const {
        PG8_OPAQUE(0, 0);
        const unsigned row0 = (unsigned)(u.pm * 256 + wr * 64) + (unsigned)frx, c0 = u.pn * 256u + 32u * wc + 8u * fqx, o0 = row0 * 2048u + c0 * 2u, g0 = row0 * 1024u + c0;
        const unsigned char* GA = ws + WS_GA; const unsigned char* GB = ws + WS_GB; unsigned char* YM = ws + WS_YM;
#pragma unroll
        for (int ai = 0; ai < 2; ++ai) {
            u32x2 ga[4][2], gb[4][2];
#pragma unroll
            for (int m = 0; m < 4; ++m)
#pragma unroll
                for (int bj = 0; bj < 2; ++bj) { const unsigned go = g0 + (unsigned)(ai * 128 + m * 16) * 1024u + bj * 128u; gb[m][bj] = *(const u32x2*)(GB + go); if (MID) ga[m][bj] = *(const u32x2*)(GA + go); }
#pragma unroll
            for (int m = 0; m < 4; ++m)
#pragma unroll
                for (int bj = 0; bj < 2; ++bj) { const unsigned off = o0 + (unsigned)(ai * 128 + m * 16) * 2048u + bj * 256u; f32x4 s0, s1;
#pragma unroll
                    for (int j = 0; j < 4; ++j) { const float b0 = fmaxf((float)((gb[m][bj].x >> (8 * j)) & 0xffu), 0.5f), b1 = fmaxf((float)((gb[m][bj].y >> (8 * j)) & 0xffu), 0.5f);
                        s0[j] = MID ? (float)((ga[m][bj].x >> (8 * j)) & 0xffu) * __builtin_amdgcn_rcpf(b0) : b0 * (1.f / 255.f);
                        s1[j] = MID ? (float)((ga[m][bj].y >> (8 * j)) & 0xffu) * __builtin_amdgcn_rcpf(b1) : b1 * (1.f / 255.f); }
                    acc[ai][bj][m][0] *= s0; acc[ai][bj][m][1] *= s1;
                    if (!MID) st16(YM, off, pack8(acc[ai][bj][m][0], acc[ai][bj][m][1])); }
            asm volatile("" ::: "memory"); }
    }
    __device__ __forceinline__ void mid(f32x4 (&acc)[2][2][4][2], const Unit& u, int wr, int wc) const { run<true>(acc, u, wr, wc); }
    __device__ __forceinline__ void operator()(f32x4 (&acc)[2][2][4][2], const Unit& u, int wr, int wc, int fr, int fq) const { run<false>(acc, u, wr, wc); }
};
struct EpiYF {
    static constexpr bool PERM = true, AFTER_DRAIN = false; static constexpr int MID_T = 0;
    unsigned char* ws;
    __device__ __forceinline__ void operator()(const f32x4 (&acc)[2][2][4][2], const Unit& u, int wr, int wc, int fr, int fq) const {
        PG8_OPAQUE(fr, fq);
        const unsigned row0 = (unsigned)(u.pm * 256 + wr * 64) + (unsigned)frx, c0 = u.pn * 256u + 32u * wc + 8u * fqx, o0 = row0 * 2048u + c0 * 2u; unsigned char* Y = ws + WS_Y; float* ssq = (float*)(ws + WS_SSQY);
#pragma unroll
        for (int ai = 0; ai < 2; ++ai)
#pragma unroll
            for (int m = 0; m < 4; ++m) { float s = 0.f;
#pragma unroll
                for (int bj = 0; bj < 2; ++bj) { s += sumsq8(acc[ai][bj][m][0], acc[ai][bj][m][1]); st16(Y, o0 + (unsigned)(ai * 128 + m * 16) * 2048u + bj * 256u, pack8(acc[ai][bj][m][0], acc[ai][bj][m][1])); }
                s += __shfl_xor(s, 16); s += __shfl_xor(s, 32);
                if (fqx == 0) atomicAdd(ssq + (row0 + ai * 128 + m * 16), s); }
    }
};
}

struct MapIn { __device__ int operator()(int n) const { const int t = n >> 8, tc = n & 255, bj = tc >> 7, uu = tc & 127;
    if (t == 0) return n;
    if (t == 1) return uu < 64 ? C_KVLAT + 64 * bj + uu : (uu < 80 ? C_KROPE + 16 * bj + (uu - 64) : -1);
    if (t < 4) return C_ZMLA + (n - 512);
    if (t < 8) return (t < 6 ? C_QMB : C_KMB) + 256 * (t & 1) + 64 * (uu >> 5) + 32 * bj + (uu & 31);
    if (t < 10) return C_VMB + (n - 2048);
    if (t < 12) return C_ZMB + (n - 2560);
    if (t < 16) return C_GA + (n - 3072);
    return C_GB + (n - 4096); } };
struct MapUq { __device__ int operator()(int n) const { const int t = n >> 8, tc = n & 255, bj = tc >> 7, uu = tc & 127;
    if (t < 2) return 96 * (4 * t + (tc >> 6)) + (tc & 63);
    return 96 * (uu >> 4) + 64 + 16 * bj + (uu & 15); } };
struct MapUkv { __device__ int operator()(int n) const { const int t = n >> 8, tc = n & 255; return 128 * (4 * (t & 1) + (tc >> 6)) + (t < 2 ? 0 : 64) + (tc & 63); } };
struct MapId { __device__ int operator()(int n) const { return n; } };
template <class Map> __device__ __forceinline__ void wt_items(const float* W, int ldw, int Kreal, int K, int N, unsigned short* WT, const float* kscale, Map map, LAS float* scr, int gw, int ngw, int lane, int ldk = 0, int koff = 0) {
    if (ldk == 0) ldk = K;
    const int nblk = N / 64, nitems = (K / 32) * nblk; typedef float f4 __attribute__((ext_vector_type(4)));
    for (int it = gw; it < nitems; it += ngw) {
        const int kb = it / nblk, nb = it % nblk, k0 = 32 * kb, n0 = 64 * nb; const int src = map(n0 + 4 * (lane & 15));
        f4 wv[8];
#pragma unroll
        for (int i = 0; i < 8; ++i) { const int k = k0 + 4 * i + (lane >> 4); wv[i] = (src >= 0 && k < Kreal) ? *(const f4*)(W + (size_t)k * ldw + src) : (f4){0.f, 0.f, 0.f, 0.f}; }
#pragma unroll
        for (int i = 0; i < 8; ++i) { const int kk = 4 * i + (lane >> 4), k = k0 + kk; f4 v = wv[i]; if (kscale && k < Kreal) v = v * kscale[k]; *(LAS f4*)(scr + kk * 68 + 4 * (lane & 15)) = v; }
        asm volatile("s_waitcnt lgkmcnt(0)" ::: "memory");
#pragma unroll
        for (int j = 0; j < 4; ++j) { const int q = lane + 64 * j, n = q >> 2, c = q & 3; const LAS float* s = scr + (8 * c) * 68 + n;
            pg8::u32x4 o; o.x = pg8::pk_h2(s[0 * 68], s[1 * 68]); o.y = pg8::pk_h2(s[2 * 68], s[3 * 68]); o.z = pg8::pk_h2(s[4 * 68], s[5 * 68]); o.w = pg8::pk_h2(s[6 * 68], s[7 * 68]);
            *(pg8::u32x4*)(WT + (size_t)(n0 + n) * ldk + koff + k0 + 8 * c) = o; }
        asm volatile("s_waitcnt lgkmcnt(0)" ::: "memory");
    }
}
constexpr size_t WT_IN = WS_WT, WT_UQ = WS_WT + 10 * MiB, WT_UKV = WT_UQ + 512 * 1024, WT_OA = WS_WT + 11 * MiB, WT_OB = WS_WT + 12 * MiB, WT_OUT = WS_WT + 13 * MiB;
__device__ __forceinline__ void ph_weights(const Params& p, LAS unsigned char* lds, int gw, int ngw, int wave, int lane) {
    LAS float* scr = (LAS float*)(lds + wave * 16384);
    wt_items(p.w_in, D_IN, 1024, 1024, 5120, (unsigned short*)(p.ws + WT_IN), nullptr, MapIn(), scr, gw, ngw, lane);
    wt_items(p.w_uq, 768, 256, 256, 768, (unsigned short*)(p.ws + WT_UQ), p.g_q, MapUq(), scr, gw, ngw, lane);
    wt_items(p.w_ukv, 1024, 128, 128, 1024, (unsigned short*)(p.ws + WT_UKV), p.g_kv, MapUkv(), scr, gw, ngw, lane);
    wt_items(p.w_o_mla, 1024, 512, 512, 1024, (unsigned short*)(p.ws + WT_OA), nullptr, MapId(), scr, gw, ngw, lane, 1024, 0);
    wt_items(p.w_o_moba, 1024, 512, 512, 1024, (unsigned short*)(p.ws + WT_OA), nullptr, MapId(), scr, gw, ngw, lane, 1024, 512);
    wt_items(p.w_out, 1024, 1024, 1024, 1024, (unsigned short*)(p.ws + WT_OUT), nullptr, MapId(), scr, gw, ngw, lane);
}

namespace att {
struct T1 { static constexpr bool value = true; }; struct T0 { static constexpr bool value = false; };
typedef _Float16 h8 __attribute__((ext_vector_type(8)));
typedef short s4 __attribute__((ext_vector_type(4)));
typedef short s8 __attribute__((ext_vector_type(8)));
typedef float f16v __attribute__((ext_vector_type(16)));
typedef float f2v __attribute__((ext_vector_type(2)));
typedef unsigned u4 __attribute__((ext_vector_type(4)));
typedef short v4i16_t __attribute__((ext_vector_type(4)));
constexpr int KBUF = 16384, VBUF = 8192;
constexpr int NBUF = 4;
constexpr int L_K = 0, L_V = NBUF * KBUF, L_WS = L_V + NBUF * VBUF, L_TB = L_WS + 8 * 256, L_UN = L_TB + 256, L_END = L_UN + 64, L_OST = 0;
constexpr float THR = 8.f;
#ifndef PROBE_ABL
#define PROBE_ABL 0
#endif
#ifndef ATT_STAGGER
#define ATT_STAGGER 0
#endif
constexpr bool STAGGER = ATT_STAGGER;
__device__ __forceinline__ int crow(int r, int hi) { return (r & 3) + 8 * (r >> 2) + 4 * hi; }
template <int DK> __device__ __forceinline__ int kaddr(int row, int ch) { return DK == 64 ? row * 128 + ((ch ^ ((row >> 1) & 7)) << 4) : row * 256 + ((ch ^ (row & 15)) << 4); }
__device__ __forceinline__ s4 vtr(const LAS unsigned char* p) { return __builtin_bit_cast(s4, __builtin_amdgcn_ds_read_tr16_b64_v4i16((LAS v4i16_t*)p)); }
__device__ __forceinline__ float swapmax(float m) { auto rr = __builtin_amdgcn_permlane32_swap(__float_as_uint(m), __float_as_uint(m), false, false); return fmaxf(__uint_as_float(rr[0]), __uint_as_float(rr[1])); }
__device__ __forceinline__ float swapsum(float m) { auto rr = __builtin_amdgcn_permlane32_swap(__float_as_uint(m), __float_as_uint(m), false, false); return __uint_as_float(rr[0]) + __uint_as_float(rr[1]); }
__device__ __forceinline__ void glds16(const void* g, unsigned lds_base) { unsigned sv;
    asm volatile("s_mov_b32 %0, m0\n\ts_mov_b32 m0, %2\n\ts_nop 0\n\tglobal_load_lds_dwordx4 %1, off\n\ts_mov_b32 m0, %0" : "=&s"(sv) : "v"(g), "s"(lds_base) : "memory"); }
__device__ __forceinline__ float max3f(float a, float b, float c) { float r; asm("v_max3_f32 %0, %1, %2, %3" : "=v"(r) : "v"(a), "v"(b), "v"(c)); return r; }
__device__ __forceinline__ unsigned pkh(float lo, float hi) { typedef _Float16 h2 __attribute__((ext_vector_type(2))); h2 v; v[0] = (_Float16)lo; v[1] = (_Float16)hi; return __builtin_bit_cast(unsigned, v); }

template <int DK, bool MOBA, int ABL = 0, bool OWN = false>
__device__ __forceinline__ void attn_unit(unsigned char* ws, int b, int h, int qb, LAS unsigned char* lds, bool dry = false) {
    constexpr int ND = DK / 16, QP = MOBA ? 512 : 768, QH = MOBA ? 64 : 96;
    int tid_ = threadIdx.x; asm volatile("" : "+v"(tid_));
    const int tid = tid_, lane = tid & 63, r32 = lane & 31, hi = lane >> 5; const int wid = __builtin_amdgcn_readfirstlane(tid >> 6);
    const _Float16* Qg = (const _Float16*)(ws + (MOBA ? WS_QMB : WS_QMLA)); const _Float16* Kg = (const _Float16*)(ws + (MOBA ? WS_KMB : WS_KN));
    const _Float16* Vg = (const _Float16*)(ws + (MOBA ? WS_VMB : WS_VM)); const _Float16* Pg = (const _Float16*)(ws + WS_KPE); _Float16* Zg = (_Float16*)(ws + WS_ZCAT) + (MOBA ? 512 : 0);
    const size_t rowbase = (size_t)b * SEQ; const int q0 = qb * 256, qw0 = q0 + wid * 32, qrow = qw0 + r32;
    LAS float* wsf = (LAS float*)(lds + L_WS) + wid * 64; LAS int* tb = (LAS int*)(lds + L_TB); LAS unsigned* un = (LAS unsigned*)(lds + L_UN);
    h8 qr[ND];
#pragma unroll
    for (int d0 = 0; d0 < ND; ++d0) qr[d0] = *(const h8*)(Qg + (rowbase + qrow) * QP + h * QH + d0 * 16 + hi * 8);
#pragma unroll
    for (int d0 = 0; d0 < ND; ++d0) asm volatile("" : "+v"(qr[d0]));
    unsigned sel = 0u, blocks = OWN ? (1u << qb) : (2u << qb) - 1u;
    if (MOBA && !OWN) {
        const float* km = (const float*)(ws + WS_KMEAN) + (size_t)b * 16 * 512 + h * 64 + hi * 8;
        float g0 = -INFINITY, g1 = -INFINITY, g2 = -INFINITY; int i0 = -1, i1 = -1, i2 = -1;
        for (int m = 0; m < qb; ++m) {
            float part = 0.f;
#pragma unroll
            for (int d0 = 0; d0 < 4; ++d0) { const float4 a = *(const float4*)(km + m * 512 + d0 * 16), c = *(const float4*)(km + m * 512 + d0 * 16 + 4);
                part += (float)qr[d0][0] * a.x + (float)qr[d0][1] * a.y + (float)qr[d0][2] * a.z + (float)qr[d0][3] * a.w + (float)qr[d0][4] * c.x + (float)qr[d0][5] * c.y + (float)qr[d0][6] * c.z + (float)qr[d0][7] * c.w; }
            const float g = swapsum(part);
            if (g > g0) { g2 = g1; i2 = i1; g1 = g0; i1 = i0; g0 = g; i0 = m; }
            else if (g > g1) { g2 = g1; i2 = i1; g1 = g; i1 = m; }
            else if (g > g2) { g2 = g; i2 = m; }
        }
        if (i0 >= 0) sel |= 1u << i0; if (i1 >= 0) sel |= 1u << i1; if (i2 >= 0) sel |= 1u << i2;
        unsigned uw = sel;
#pragma unroll
        for (int o = 1; o < 64; o <<= 1) uw |= (unsigned)__shfl_xor((int)uw, o);
        if (lane == 0) un[wid] = uw;
        __syncthreads();
        unsigned ua = 0u;
#pragma unroll
        for (int w = 0; w < 8; ++w) ua |= un[w];
        blocks = (unsigned)__builtin_amdgcn_readfirstlane((int)(ua | (1u << qb)));
    }
    const int NT = OWN ? 4 : 4 * __builtin_popcount(blocks);
    if (tid < 64 && tid < NT) { unsigned bm = blocks; for (int k = 0; k < (tid >> 2); ++k) bm &= bm - 1u; tb[tid] = (__builtin_ctz(bm) << 8) + ((tid & 3) << 6); }
    __syncthreads();
    const unsigned char* kbu = (const unsigned char*)(Kg + rowbase * 512 + h * 64); const unsigned char* vbu = (const unsigned char*)(Vg + rowbase * 512 + h * 64); const unsigned char* pbu = (const unsigned char*)(Pg + rowbase * 32);
    const unsigned char* kb0; const unsigned char* kb1 = nullptr; unsigned ksrc0, ksrc1 = 0u, kst0 = 1024u, kst1 = 1024u;
    if (DK == 96) { const int r0 = 4 * wid + (lane >> 4), r1 = r0 + 32; int c0 = (lane & 15) ^ (r0 & 15), c1 = (lane & 15) ^ (r1 & 15); if (c0 >= 12) c0 -= 4; if (c1 >= 12) c1 -= 4;
        const bool kpe0 = c0 >= 8, kpe1 = c1 >= 8;
        kb0 = kpe0 ? pbu : kbu; kst0 = kpe0 ? 64u : 1024u; ksrc0 = kpe0 ? (unsigned)(r0 * 32 + (c0 - 8) * 8) * 2u : (unsigned)(r0 * 512 + c0 * 8) * 2u;
        kb1 = kpe1 ? pbu : kbu; kst1 = kpe1 ? 64u : 1024u; ksrc1 = kpe1 ? (unsigned)(r1 * 32 + (c1 - 8) * 8) * 2u : (unsigned)(r1 * 512 + c1 * 8) * 2u;
    } else { const int r0 = 8 * wid + (lane >> 3), c0 = (lane & 7) ^ ((r0 >> 1) & 7); kb0 = kbu; ksrc0 = (unsigned)(r0 * 512 + c0 * 8) * 2u; }
    const unsigned vsrc = (unsigned)((16 * (wid & 3) + (lane >> 2)) * 512 + (wid >> 2) * 32 + (lane & 3) * 8) * 2u;
    constexpr int NDMA = (DK == 96) ? 3 : 2;
#define ATT_GLDS(src, dst) glds16((const void*)(src), (unsigned)__builtin_amdgcn_readfirstlane((int)(unsigned)(size_t)(dst)))
#define ATT_DMA(kb, buf) do { const unsigned kb_ = (unsigned)(kb); LAS unsigned char* kd_ = lds + L_K + (buf) * KBUF; \
        ATT_GLDS(kb0 + (ksrc0 + kb_ * kst0), kd_ + wid * 1024); \
        if (DK == 96) ATT_GLDS(kb1 + (ksrc1 + kb_ * kst1), kd_ + 8192 + wid * 1024); \
        ATT_GLDS(vbu + (vsrc + kb_ * 1024u), lds + L_V + (buf) * VBUF + wid * 1024); } while (0)
#define ATT_WAITV(n) asm volatile("s_waitcnt vmcnt(" #n ")" ::: "memory")
#define ATT_BAR() do { asm volatile("s_waitcnt lgkmcnt(0)" ::: "memory"); __builtin_amdgcn_s_barrier(); asm volatile("" ::: "memory"); } while (0)
    const int vro = ((lane >> 4) & 1) * 32 + (lane & 3) * 8 + (4 * hi + ((lane & 15) >> 2)) * 64;
    LAS unsigned char* ldsv = lds + L_V + vro; asm volatile("" : "+v"(ldsv));
    float l_reg = 0.f; bool init = false; f16v o[2]; o[0] = f16v{}; o[1] = f16v{}; f16v negm = f16v{}; asm volatile("" : "+v"(negm));
    constexpr int G = 2 * ND;
#define ATT_SBAR() __builtin_amdgcn_sched_barrier(0)
#define ATT_PIN(x) asm volatile("" : "+v"(x))
#define ATT_KF(buf, g) (*(const LAS h8*)(lds + L_K + (buf) * KBUF + kaddr<DK>(32 * ((g) & 1) + r32, 2 * ((g) >> 1) + hi)))
#define ATT_MF(a, b, c) __builtin_amdgcn_mfma_f32_32x32x16_f16(a, b, c, 0, 0, 0)
#define ATT_QK(P0, P1, buf) do { h8 kf_[G]; _Pragma("unroll") for (int g_ = 0; g_ < G; ++g_) kf_[g_] = ATT_KF(buf, g_); ATT_SBAR(); \
        _Pragma("unroll") for (int d_ = 0; d_ < ND; ++d_) { P0 = ATT_MF(kf_[2 * d_], qr[d_], d_ == 0 ? negm : P0); P1 = ATT_MF(kf_[2 * d_ + 1], qr[d_], d_ == 0 ? negm : P1); } } while (0)
#define ATT_MAXCHAIN(P0, P1, PM) do { float pa_ = max3f(P0[0], P0[1], P1[0]), pb_ = max3f(P0[2], P0[3], P1[1]); pa_ = max3f(pa_, P1[2], P1[3]); \
        _Pragma("unroll") for (int r_ = 4; r_ < 16; r_ += 4) { pa_ = max3f(pa_, P0[r_], P0[r_ + 1]); pb_ = max3f(pb_, P0[r_ + 2], P0[r_ + 3]); pa_ = max3f(pa_, P1[r_], P1[r_ + 1]); pb_ = max3f(pb_, P1[r_ + 2], P1[r_ + 3]); } \
        PM = swapmax(fmaxf(pa_, pb_)); } while (0)
#define ATT_MOVE(P0, P1, PM) do { const bool move_ = init ? ((PM) > THR) : ((PM) > -INFINITY); \
        if (__any(move_)) { const float dl_ = move_ ? (init ? fmaxf((PM), 0.f) : (PM)) : 0.f; const float al_ = (move_ && init) ? __builtin_amdgcn_exp2f(-dl_) : 1.f; \
            init = init || move_; l_reg *= al_; \
            _Pragma("unroll") for (int r_ = 0; r_ < 16; ++r_) { P0[r_] -= dl_; P1[r_] -= dl_; negm[r_] -= dl_; } \
            if (hi == 0) wsf[r32] = al_; asm volatile("s_waitcnt lgkmcnt(0)" ::: "memory"); \
            _Pragma("unroll") for (int r_ = 0; r_ < 16; ++r_) { const float a_ = wsf[crow(r_, hi)]; o[0][r_] *= a_; o[1][r_] *= a_; } } } while (0)
#define ATT_PACK(P0, P1, PW, KEEP) do { _Pragma("unroll") for (int k_ = 0; k_ < 2; ++k_) { \
            PW[k_] = (u4){pkh(P0[8 * k_], P0[8 * k_ + 1]), pkh(P0[8 * k_ + 2], P0[8 * k_ + 3]), pkh(P0[8 * k_ + 4], P0[8 * k_ + 5]), pkh(P0[8 * k_ + 6], P0[8 * k_ + 7])}; \
            PW[2 + k_] = (u4){pkh(P1[8 * k_], P1[8 * k_ + 1]), pkh(P1[8 * k_ + 2], P1[8 * k_ + 3]), pkh(P1[8 * k_ + 4], P1[8 * k_ + 5]), pkh(P1[8 * k_ + 6], P1[8 * k_ + 7])}; } \
        if (MOBA) { _Pragma("unroll") for (int k_ = 0; k_ < 4; ++k_) PW[k_] &= (KEEP); } } while (0)
#define ATT_VF(buf, i) (ldsv + (buf) * VBUF + ((i) >> 2) * 4096 + ((i) & 3) * 1024)
#define ATT_WAIT_NEXT(t_) do { if ((t_) + 3 < NT) { if (NDMA == 3) ATT_WAITV(3); else ATT_WAITV(2); } else ATT_WAITV(0); } while (0)
#define ATT_TB(i) (MOBA ? tb[(i)] : 64 * (i))
    const int NF = OWN ? 0 : NT - 4;
    ATT_DMA(ATT_TB(0), 0); ATT_DMA(ATT_TB(1), 1); ATT_DMA(ATT_TB(2), 2);
    if (NDMA == 3) ATT_WAITV(3); else ATT_WAITV(2);
    ATT_BAR();
    f16v pC0, pC1;
    if (NF > 0) { ATT_QK(pC0, pC1, 0); asm volatile("s_nop 15\n\ts_nop 7" : "+v"(pC0), "+v"(pC1)); float pm; ATT_MAXCHAIN(pC0, pC1, pm);
        if (MOBA && !((sel >> (ATT_TB(0) >> 8)) & 1u)) pm = -INFINITY; ATT_MOVE(pC0, pC1, pm); }
    auto step = [&](f16v& pC0, f16v& pC1, f16v& pN0, f16v& pN1, const int t, auto hn) __attribute__((always_inline)) {
        const int cur = t & 3, nx = (t + 1) & 3; constexpr bool hasn = decltype(hn)::value;
        ATT_DMA(ATT_TB(t + 3), (t + 3) & 3);
        const unsigned keepC = (!MOBA || ((sel >> (ATT_TB(t) >> 8)) & 1u)) ? 0xffffffffu : 0u;
        float ps = 0.f; f2v ps2 = (f2v){0.f, 0.f};
        if (hasn) {
            h8 kf[G];
#pragma unroll
            for (int g = 0; g < 4; ++g) kf[g] = ATT_KF(nx, g);
            ATT_SBAR();
#pragma unroll
            for (int g = 0; g < G; ++g) {
                if (g + 4 < G) kf[g + 4] = ATT_KF(nx, g + 4);
                if (g & 1) pN1 = ATT_MF(kf[g], qr[g >> 1], g == 1 ? negm : pN1); else pN0 = ATT_MF(kf[g], qr[g >> 1], g == 0 ? negm : pN0);
                constexpr int dummy = 0; (void)dummy;
                const int e0 = (ND == 4) ? 4 * g : (g < 8 ? 3 * g : 24 + 2 * (g - 8)), e1 = (ND == 4) ? 4 * g + 4 : (g < 8 ? 3 * g + 3 : 26 + 2 * (g - 8));
#pragma unroll
                for (int e = e0; e < e1; ++e) { if (e < 16) pC0[e] = __builtin_amdgcn_exp2f(pC0[e]); else pC1[e - 16] = __builtin_amdgcn_exp2f(pC1[e - 16]);
                    if (e & 1) { if (e < 16) ps2 += (f2v){pC0[e - 1], pC0[e]}; else ps2 += (f2v){pC1[e - 17], pC1[e - 16]}; } }
                ATT_PIN(pC0); ATT_PIN(pC1); ATT_PIN(ps2); ATT_SBAR();
            }
        } else {
#pragma unroll
            for (int r = 0; r < 16; ++r) { pC0[r] = __builtin_amdgcn_exp2f(pC0[r]); pC1[r] = __builtin_amdgcn_exp2f(pC1[r]); ps += pC0[r] + pC1[r]; }
        }
        ps += ps2[0] + ps2[1];
        if (MOBA && !keepC) ps = 0.f;
        l_reg += swapsum(ps);
        u4 pw[4]; ATT_PACK(pC0, pC1, pw, keepC);
        {
            s4 vlo[8], vhi[8]; float pa = 0.f, pb = 0.f;
#pragma unroll
            for (int i = 0; i < 3; ++i) { vlo[i] = vtr(ATT_VF(cur, i)); vhi[i] = vtr(ATT_VF(cur, i) + 512); }
            if (hasn) asm volatile("s_nop 7" : "+v"(pN0), "+v"(pN1));
            ATT_SBAR();
#pragma unroll
            for (int i = 0; i < 8; ++i) {
                if (i + 3 < 8) { vlo[i + 3] = vtr(ATT_VF(cur, i + 3)); vhi[i + 3] = vtr(ATT_VF(cur, i + 3) + 512); }
                const s8 vv = (s8){vlo[i][0], vlo[i][1], vlo[i][2], vlo[i][3], vhi[i][0], vhi[i][1], vhi[i][2], vhi[i][3]};
                o[i >> 2] = ATT_MF(__builtin_bit_cast(h8, pw[i & 3]), __builtin_bit_cast(h8, vv), o[i >> 2]);
                if (hasn) {
                    if (i == 0) { pa = max3f(pN0[0], pN0[1], pN1[0]); pb = max3f(pN0[2], pN0[3], pN1[1]); }
                    else if (i == 1) { pa = max3f(pa, pN1[2], pN1[3]); pb = max3f(pb, pN0[6], pN0[7]); }
                    else if (i == 2) { pa = max3f(pa, pN0[4], pN0[5]); pb = max3f(pb, pN1[6], pN1[7]); }
                    else if (i == 3) { pa = max3f(pa, pN1[4], pN1[5]); pb = max3f(pb, pN0[10], pN0[11]); }
                    else if (i == 4) { pa = max3f(pa, pN0[8], pN0[9]); pb = max3f(pb, pN1[10], pN1[11]); }
                    else if (i == 5) { pa = max3f(pa, pN1[8], pN1[9]); pb = max3f(pb, pN0[14], pN0[15]); }
                    else if (i == 6) { pa = max3f(pa, pN0[12], pN0[13]); pb = max3f(pb, pN1[14], pN1[15]); }
                    else { pa = max3f(pa, pN1[12], pN1[13]); }
                    ATT_PIN(pa); ATT_PIN(pb);
                }
                ATT_SBAR();
            }
            if (hasn) { float pm = swapmax(fmaxf(pa, pb)); if (MOBA && !((sel >> (ATT_TB(t + 1) >> 8)) & 1u)) pm = -INFINITY; ATT_MOVE(pN0, pN1, pm); }
        }
        if (NDMA == 3) ATT_WAITV(3); else ATT_WAITV(2);
        ATT_BAR();
    };
    {
        f16v pD0, pD1; int t = 0;
        for (; t + 2 < NF; t += 2) { step(pC0, pC1, pD0, pD1, t, T1{}); step(pD0, pD1, pC0, pC1, t + 1, T1{}); }
        if (t + 1 < NF) { step(pC0, pC1, pD0, pD1, t, T1{}); step(pD0, pD1, pC0, pC1, t + 1, T0{}); }
        else if (t < NF) step(pC0, pC1, pD0, pD1, t, T0{});
    }
    for (int t = NF; t < NT; ++t) {
        const int cur = t & 3, kb = ATT_TB(t);
        if (t + 3 < NT) ATT_DMA(ATT_TB(t + 3), (t + 3) & 3);
        if (kb <= qw0 + 31) {
            f16v p0, p1; ATT_QK(p0, p1, cur);
            if (kb + 63 > qw0) {
#pragma unroll
                for (int r = 0; r < 16; ++r) { const int kv = kb + crow(r, hi); if (kv > qrow) p0[r] = -INFINITY; if (kv + 32 > qrow) p1[r] = -INFINITY; }
            }
            asm volatile("s_nop 15\n\ts_nop 7" : "+v"(p0), "+v"(p1));
            float pm; ATT_MAXCHAIN(p0, p1, pm); ATT_MOVE(p0, p1, pm);
            s4 vlo[8], vhi[8];
#pragma unroll
            for (int i = 0; i < 8; ++i) { vlo[i] = vtr(ATT_VF(cur, i)); vhi[i] = vtr(ATT_VF(cur, i) + 512); }
            ATT_SBAR();
            float ps = 0.f;
#pragma unroll
            for (int r = 0; r < 16; ++r) { p0[r] = __builtin_amdgcn_exp2f(p0[r]); p1[r] = __builtin_amdgcn_exp2f(p1[r]); ps += p0[r] + p1[r]; }
            l_reg += swapsum(ps);
            u4 pw[4]; ATT_PACK(p0, p1, pw, 0xffffffffu);
#pragma unroll
            for (int i = 0; i < 8; ++i) { const s8 vv = (s8){vlo[i][0], vlo[i][1], vlo[i][2], vlo[i][3], vhi[i][0], vhi[i][1], vhi[i][2], vhi[i][3]};
                o[i >> 2] = ATT_MF(__builtin_bit_cast(h8, pw[i & 3]), __builtin_bit_cast(h8, vv), o[i >> 2]); }
        }
        ATT_WAIT_NEXT(t);
        ATT_BAR();
    }
    if (hi == 0) { wsf[32 + r32] = l_reg; if (OWN) wsf[r32] = -negm[0]; } asm volatile("s_waitcnt lgkmcnt(0)" ::: "memory");
    LAS _Float16* stg = (LAS _Float16*)(lds + L_OST) + wid * 2048;
#pragma unroll
    for (int r = 0; r < 16; ++r) { const int orow = crow(r, hi); const float rl = 1.f / wsf[32 + orow];
        stg[orow * 64 + r32] = (_Float16)(o[0][r] * rl); stg[orow * 64 + 32 + r32] = (_Float16)(o[1][r] * rl); }
    asm volatile("s_waitcnt lgkmcnt(0)" ::: "memory");
    int lane_e = lane; asm volatile("" : "+v"(lane_e));
    unsigned char* zbu = (unsigned char*)(Zg + (rowbase + qw0) * 1024 + h * 64);
#pragma unroll
    for (int i = 0; i < 4; ++i) { const int row = i * 8 + (lane_e >> 3), ch = lane_e & 7; const h8 v = *(const LAS h8*)(stg + row * 64 + ch * 8);
        _Float16* zp = (_Float16*)(zbu + (unsigned)(row * 1024 + ch * 8) * 2u); const h8 z = *(const h8*)zp; h8 ov;
        if (OWN) {
            const int nsl = qb < 3 ? qb : 3; const unsigned gr = (unsigned)((b * 8 + h) * 4096 + qw0 + row);
            const float m_own = wsf[row], l_own = wsf[32 + row]; float M = m_own; float2 ml[3]; h8 po[3];
#pragma unroll
            for (int s = 0; s < 3; ++s) if (s < nsl) { ml[s] = ((const float2*)(ws + WS_ML))[(unsigned)s * 524288u + gr]; po[s] = *(const h8*)(ws + opart_off(s) + gr * 128u + (unsigned)ch * 16u); M = fmaxf(M, ml[s].x); }
            const float w0 = l_own * __builtin_amdgcn_exp2f(m_own - M); float W = w0; float acc[8];
#pragma unroll
            for (int j = 0; j < 8; ++j) acc[j] = w0 * (float)v[j];
#pragma unroll
            for (int s = 0; s < 3; ++s) if (s < nsl) { const float w = ml[s].y * __builtin_amdgcn_exp2f(ml[s].x - M); W += w;
#pragma unroll
                for (int j = 0; j < 8; ++j) acc[j] = fmaf(w, (float)po[s][j], acc[j]); }
            const float rW = 1.f / W;
#pragma unroll
            for (int j = 0; j < 8; ++j) ov[j] = (_Float16)(acc[j] * rW * (float)z[j]);
        } else {
#pragma unroll
            for (int j = 0; j < 8; ++j) ov[j] = (_Float16)((float)v[j] * (float)z[j]);
        }
        if (!dry) *(h8*)zp = ov; }
    __syncthreads();
#undef ATT_GLDS
#undef ATT_DMA
#undef ATT_WAITV
#undef ATT_BAR
#undef ATT_SBAR
#undef ATT_PIN
#undef ATT_KF
#undef ATT_MF
#undef ATT_QK
#undef ATT_MAXCHAIN
#undef ATT_MOVE
#undef ATT_PACK
#undef ATT_VF
#undef ATT_WAIT_NEXT
#undef ATT_TB
}


__device__ __forceinline__ void ph_gate(unsigned char* ws, int gw_, int ngw, int lane) {
    const int gw = __builtin_amdgcn_readfirstlane(gw_);
    unsigned* cnt = (unsigned*)(ws + WS_CNT); unsigned short* lists = (unsigned short*)(ws + WS_LIST);
    for (int it = gw; it < 128 * 60; it += ngw) {
        const int bh = it / 60, rr = it - bh * 60, qb = 1 + (rr >> 2), ch = rr & 3, b = bh >> 3, h = bh & 7;
        const int row = qb * 256 + ch * 64 + lane;
        const _Float16* q = (const _Float16*)(ws + WS_QMB) + ((size_t)b * SEQ + row) * 512 + h * 64;
        h8 qv[8];
#pragma unroll
        for (int i = 0; i < 8; ++i) qv[i] = *(const h8*)(q + 8 * i);
        const float* km = (const float*)(ws + WS_KMEAN) + (size_t)b * 16 * 512 + h * 64;
        float g0 = -INFINITY, g1 = -INFINITY, g2 = -INFINITY; int i0 = -1, i1 = -1, i2 = -1;
        for (int m = 0; m < qb; ++m) {
            float s0 = 0.f, s1 = 0.f;
#pragma unroll
            for (int d = 0; d < 64; d += 2) { s0 = fmaf((float)qv[d >> 3][d & 7], km[m * 512 + d], s0); s1 = fmaf((float)qv[d >> 3][(d & 7) + 1], km[m * 512 + d + 1], s1); }
            const float g = s0 + s1;
            if (g > g0) { g2 = g1; i2 = i1; g1 = g0; i1 = i0; g0 = g; i0 = m; }
            else if (g > g1) { g2 = g1; i2 = i1; g1 = g; i1 = m; }
            else if (g > g2) { g2 = g; i2 = m; }
        }
        unsigned mycnt = 0u;
#pragma unroll
        for (int j = 0; j < 15; ++j) { const bool s = (i0 == j) | (i1 == j) | (i2 == j); const unsigned long long mk = __ballot(s); if (lane == j) mycnt = (unsigned)__popcll(mk); }
        unsigned basev = 0u; if (lane < 15 && mycnt) basev = atomicAdd(&cnt[bh * 16 + lane], mycnt);
#pragma unroll
        for (int j = 0; j < 15; ++j) { const bool s = (i0 == j) | (i1 == j) | (i2 == j); const unsigned long long mk = __ballot(s); const unsigned base = (unsigned)__builtin_amdgcn_readlane((int)basev, j);
            if (s) { const unsigned rank = (unsigned)__popcll(mk & ((1ull << lane) - 1ull)); const int slot = (i0 == j) ? 0 : ((i1 == j) ? 1 : 2);
                lists[(size_t)(bh * 16 + j) * 4096 + base + rank] = (unsigned short)(row | (slot << 12)); } }
    }
}

constexpr int GBUF = 65536, G_V = 32768, G_WS = 131072 + 1024, G_CTL = G_WS + 4096;
constexpr unsigned G_SINK = 256 * 1024;
__device__ __forceinline__ void gather_dma(unsigned char* ws, int b, int h, int j, LAS unsigned char* lds, int X) {
    int tid_ = threadIdx.x; asm volatile("" : "+v"(tid_)); const int lane = tid_ & 63; const int wid = __builtin_amdgcn_readfirstlane(tid_ >> 6);
    const size_t rowbase = (size_t)b * SEQ + j * 256;
    const unsigned char* kbu = (const unsigned char*)((const _Float16*)(ws + WS_KMB) + rowbase * 512 + h * 64); const unsigned char* vbu = (const unsigned char*)((const _Float16*)(ws + WS_VMB) + rowbase * 512 + h * 64);
    const int r0 = 8 * wid + (lane >> 3), c0 = (lane & 7) ^ ((r0 >> 1) & 7);
    const unsigned ksrc = (unsigned)(r0 * 512 + c0 * 8) * 2u, vsrc = (unsigned)((16 * (wid & 3) + (lane >> 2)) * 512 + (wid >> 2) * 32 + (lane & 3) * 8) * 2u;
    LAS unsigned char* lb = lds + X * GBUF + wid * 1024;
#pragma unroll
    for (int t = 0; t < 4; ++t) {
        glds16((const void*)(kbu + (ksrc + (unsigned)t * 65536u)), (unsigned)__builtin_amdgcn_readfirstlane((int)(unsigned)(size_t)(lb + t * 8192)));
        glds16((const void*)(vbu + (vsrc + (unsigned)t * 65536u)), (unsigned)__builtin_amdgcn_readfirstlane((int)(unsigned)(size_t)(lb + G_V + t * 8192))); }
}
__device__ __forceinline__ void gather_dma_all(unsigned char* ws, int b, int h, int j, LAS unsigned char* lds, int X) {
    int tid_ = threadIdx.x; asm volatile("" : "+v"(tid_)); const int lane = tid_ & 63;
    const size_t rowbase = (size_t)b * SEQ + j * 256;
    const unsigned char* kbu = (const unsigned char*)((const _Float16*)(ws + WS_KMB) + rowbase * 512 + h * 64); const unsigned char* vbu = (const unsigned char*)((const _Float16*)(ws + WS_VMB) + rowbase * 512 + h * 64);
    for (int w = 0; w < 8; ++w) {
        const int r0 = 8 * w + (lane >> 3), c0 = (lane & 7) ^ ((r0 >> 1) & 7);
        const unsigned ksrc = (unsigned)(r0 * 512 + c0 * 8) * 2u, vsrc = (unsigned)((16 * (w & 3) + (lane >> 2)) * 512 + (w >> 2) * 32 + (lane & 3) * 8) * 2u;
        LAS unsigned char* lb = lds + X * GBUF + w * 1024;
#pragma unroll
        for (int t = 0; t < 4; ++t) {
            glds16((const void*)(kbu + (ksrc + (unsigned)t * 65536u)), (unsigned)__builtin_amdgcn_readfirstlane((int)(unsigned)(size_t)(lb + t * 8192)));
            glds16((const void*)(vbu + (vsrc + (unsigned)t * 65536u)), (unsigned)__builtin_amdgcn_readfirstlane((int)(unsigned)(size_t)(lb + G_V + t * 8192))); }
    }
}
__device__ __forceinline__ void gather_unit(unsigned char* ws, int b, int h, int j, LAS unsigned char* lds, int X, LAS unsigned* ctr) {
    constexpr int ND = 4, G = 8;
    int tid_ = threadIdx.x; asm volatile("" : "+v"(tid_));
    const int tid = tid_, lane = tid & 63, r32 = lane & 31, hi = lane >> 5; const int wid = __builtin_amdgcn_readfirstlane(tid >> 6);
    const int bh = b * 8 + h;
    const _Float16* Qg = (const _Float16*)(ws + WS_QMB) + (size_t)b * SEQ * 512 + h * 64;
    const unsigned short* lst = (const unsigned short*)(ws + WS_LIST) + (size_t)(bh * 16 + j) * 4096;
    const int cnt = __builtin_amdgcn_readfirstlane((int)((const unsigned*)(ws + WS_CNT))[bh * 16 + j]);
    const int ngr = (cnt + 31) >> 5;
    LAS unsigned char* kfb = lds + X * GBUF; LAS unsigned char* vfb = kfb + G_V;
    LAS float* wsf = (LAS float*)(lds + G_WS) + wid * 128; LAS unsigned* wsu = (LAS unsigned*)wsf;
    const int vro = ((lane >> 4) & 1) * 32 + (lane & 3) * 8 + (4 * hi + ((lane & 15) >> 2)) * 64;
#define GT_SBAR() __builtin_amdgcn_sched_barrier(0)
#define GT_PIN(x) asm volatile("" : "+v"(x))
#define GT_KF(buf, g) (*(const LAS h8*)(kfb + (buf) * 8192 + kaddr<64>(32 * ((g) & 1) + r32, 2 * ((g) >> 1) + hi)))
#define GT_VF(buf, i) (vfb + (buf) * 8192 + vro + ((i) >> 2) * 4096 + ((i) & 3) * 1024)
#define GT_MF(a, b, c) __builtin_amdgcn_mfma_f32_32x32x16_f16(a, b, c, 0, 0, 0)
#define GT_MOVE(P0, P1, PM) do { const bool move_ = init ? ((PM) > THR) : ((PM) > -INFINITY); \
        if (__any(move_)) { const float dl_ = move_ ? (init ? fmaxf((PM), 0.f) : (PM)) : 0.f; const float al_ = (move_ && init) ? __builtin_amdgcn_exp2f(-dl_) : 1.f; \
            init = init || move_; l_reg *= al_; \
            _Pragma("unroll") for (int r_ = 0; r_ < 16; ++r_) { P0[r_] -= dl_; P1[r_] -= dl_; negm[r_] -= dl_; } \
            if (hi == 0) wsf[r32] = al_; asm volatile("s_waitcnt lgkmcnt(0)" ::: "memory"); \
            _Pragma("unroll") for (int r_ = 0; r_ < 16; ++r_) { const float a_ = wsf[crow(r_, hi)]; o[0][r_] *= a_; o[1][r_] *= a_; } } } while (0)
#define GT_TAKE() ({ unsigned v_ = 0u; if (lane == 0) v_ = __hip_atomic_fetch_add(ctr, 1u, __ATOMIC_RELAXED, __HIP_MEMORY_SCOPE_WORKGROUP); (int)__builtin_amdgcn_readfirstlane((int)v_); })
    h8 qr[ND]; bool validn = false; unsigned entn = 0u;
    int g = GT_TAKE(), gn = ngr;
    if (g < ngr) { const int idx = g * 32 + r32; validn = idx < cnt; entn = validn ? (unsigned)lst[idx] : 0u;
#pragma unroll
        for (int d0 = 0; d0 < ND; ++d0) qr[d0] = *(const h8*)(Qg + (size_t)(entn & 4095u) * 512 + d0 * 16 + hi * 8); }
    for (; g < ngr; g = gn) {
        const bool valid = validn; const unsigned ent = entn; const int row = (int)(ent & 4095u), slot = (int)(ent >> 12) & 3;
        gn = GT_TAKE(); { const int idx = gn * 32 + r32; validn = idx < cnt; entn = validn ? (unsigned)lst[idx] : 0u; }
#pragma unroll
        for (int d0 = 0; d0 < ND; ++d0) asm volatile("" : "+v"(qr[d0]));
        float l_reg = 0.f; bool init = false; f16v o[2]; o[0] = f16v{}; o[1] = f16v{}; f16v negm = f16v{}; asm volatile("" : "+v"(negm));
        f16v pC0, pC1, pD0, pD1;
        {
            h8 kf_[G];
#pragma unroll
            for (int g_ = 0; g_ < G; ++g_) kf_[g_] = GT_KF(0, g_);
            GT_SBAR();
#pragma unroll
            for (int d_ = 0; d_ < ND; ++d_) { pC0 = GT_MF(kf_[2 * d_], qr[d_], d_ == 0 ? negm : pC0); pC1 = GT_MF(kf_[2 * d_ + 1], qr[d_], d_ == 0 ? negm : pC1); }
            asm volatile("s_nop 15\n\ts_nop 7" : "+v"(pC0), "+v"(pC1));
            float pa_ = max3f(pC0[0], pC0[1], pC1[0]), pb_ = max3f(pC0[2], pC0[3], pC1[1]); pa_ = max3f(pa_, pC1[2], pC1[3]);
#pragma unroll
            for (int r_ = 4; r_ < 16; r_ += 4) { pa_ = max3f(pa_, pC0[r_], pC0[r_ + 1]); pb_ = max3f(pb_, pC0[r_ + 2], pC0[r_ + 3]); pa_ = max3f(pa_, pC1[r_], pC1[r_ + 1]); pb_ = max3f(pb_, pC1[r_ + 2], pC1[r_ + 3]); }
            const float pm = swapmax(fmaxf(pa_, pb_)); GT_MOVE(pC0, pC1, pm);
        }
        auto gstep = [&](f16v& pC0, f16v& pC1, f16v& pN0, f16v& pN1, const int t, auto hn) __attribute__((always_inline)) {
            constexpr bool hasn = decltype(hn)::value;
            float ps = 0.f;
            if (hasn) {
                h8 kf[G];
#pragma unroll
                for (int g_ = 0; g_ < 4; ++g_) kf[g_] = GT_KF(t + 1, g_);
                GT_SBAR();
#pragma unroll
                for (int g_ = 0; g_ < G; ++g_) {
                    if (g_ + 4 < G) kf[g_ + 4] = GT_KF(t + 1, g_ + 4);
                    if (g_ & 1) pN1 = GT_MF(kf[g_], qr[g_ >> 1], g_ == 1 ? negm : pN1); else pN0 = GT_MF(kf[g_], qr[g_ >> 1], g_ == 0 ? negm : pN0);
#pragma unroll
                    for (int e = 4 * g_; e < 4 * g_ + 4; ++e) { if (e < 16) { pC0[e] = __builtin_amdgcn_exp2f(pC0[e]); ps += pC0[e]; } else { pC1[e - 16] = __builtin_amdgcn_exp2f(pC1[e - 16]); ps += pC1[e - 16]; } }
                    GT_PIN(pC0); GT_PIN(pC1); GT_PIN(ps); GT_SBAR();
                }
            } else {
#pragma unroll
                for (int r = 0; r < 16; ++r) { pC0[r] = __builtin_amdgcn_exp2f(pC0[r]); pC1[r] = __builtin_amdgcn_exp2f(pC1[r]); ps += pC0[r] + pC1[r]; }
            }
            l_reg += swapsum(ps);
            u4 pw[4];
#pragma unroll
            for (int k_ = 0; k_ < 2; ++k_) {
                pw[k_] = (u4){pkh(pC0[8 * k_], pC0[8 * k_ + 1]), pkh(pC0[8 * k_ + 2], pC0[8 * k_ + 3]), pkh(pC0[8 * k_ + 4], pC0[8 * k_ + 5]), pkh(pC0[8 * k_ + 6], pC0[8 * k_ + 7])};
                pw[2 + k_] = (u4){pkh(pC1[8 * k_], pC1[8 * k_ + 1]), pkh(pC1[8 * k_ + 2], pC1[8 * k_ + 3]), pkh(pC1[8 * k_ + 4], pC1[8 * k_ + 5]), pkh(pC1[8 * k_ + 6], pC1[8 * k_ + 7])}; }
            s4 vlo[8], vhi[8]; float pa = 0.f, pb = 0.f;
#pragma unroll
            for (int i = 0; i < 3; ++i) { vlo[i] = vtr(GT_VF(t, i)); vhi[i] = vtr(GT_VF(t, i) + 512); }
            if (hasn) asm volatile("s_nop 7" : "+v"(pN0), "+v"(pN1));
            GT_SBAR();
#pragma unroll
            for (int i = 0; i < 8; ++i) {
                if (i + 3 < 8) { vlo[i + 3] = vtr(GT_VF(t, i + 3)); vhi[i + 3] = vtr(GT_VF(t, i + 3) + 512); }
                const s8 vv = (s8){vlo[i][0], vlo[i][1], vlo[i][2], vlo[i][3], vhi[i][0], vhi[i][1], vhi[i][2], vhi[i][3]};
                o[i >> 2] = GT_MF(__builtin_bit_cast(h8, pw[i & 3]), __builtin_bit_cast(h8, vv), o[i >> 2]);
                if (hasn) {
                    if (i == 0) { pa = max3f(pN0[0], pN0[1], pN1[0]); pb = max3f(pN0[2], pN0[3], pN1[1]); }
                    else if (i == 1) { pa = max3f(pa, pN1[2], pN1[3]); pb = max3f(pb, pN0[6], pN0[7]); }
                    else if (i == 2) { pa = max3f(pa, pN0[4], pN0[5]); pb = max3f(pb, pN1[6], pN1[7]); }
                    else if (i == 3) { pa = max3f(pa, pN1[4], pN1[5]); pb = max3f(pb, pN0[10], pN0[11]); }
                    else if (i == 4) { pa = max3f(pa, pN0[8], pN0[9]); pb = max3f(pb, pN1[10], pN1[11]); }
                    else if (i == 5) { pa = max3f(pa, pN1[8], pN1[9]); pb = max3f(pb, pN0[14], pN0[15]); }
                    else if (i == 6) { pa = max3f(pa, pN0[12], pN0[13]); pb = max3f(pb, pN1[14], pN1[15]); }
                    else { pa = max3f(pa, pN1[12], pN1[13]); }
                    GT_PIN(pa); GT_PIN(pb);
                }
                GT_SBAR();
            }
            if (hasn) { const float pm = swapmax(fmaxf(pa, pb)); GT_MOVE(pN0, pN1, pm); }
        };
        gstep(pC0, pC1, pD0, pD1, 0, T1{}); gstep(pD0, pD1, pC0, pC1, 1, T1{}); gstep(pC0, pC1, pD0, pD1, 2, T1{}); gstep(pD0, pD1, pC0, pC1, 3, T0{});
        if (gn < ngr) {
#pragma unroll
            for (int d0 = 0; d0 < ND; ++d0) qr[d0] = *(const h8*)(Qg + (size_t)(entn & 4095u) * 512 + d0 * 16 + hi * 8); }
        const unsigned gr = (unsigned)(bh * 4096 + row);
        if (hi == 0) { wsf[32 + r32] = 1.f / l_reg; wsu[64 + r32] = valid ? opart_off(slot) + gr * 128u : G_SINK;
            if (valid) ((float2*)(ws + WS_ML))[(unsigned)slot * 524288u + gr] = make_float2(-negm[0], l_reg); }
        asm volatile("s_waitcnt lgkmcnt(0)" ::: "memory");
#pragma unroll
        for (int k = 0; k < 4; ++k) {
            typedef float f4e __attribute__((ext_vector_type(4)));
            const f4e rl4 = *(const LAS f4e*)(wsf + 32 + 8 * k + 4 * hi); const u4 of4 = *(const LAS u4*)(wsu + 64 + 8 * k + 4 * hi);
#pragma unroll
            for (int i = 0; i < 4; ++i) { const int r = 4 * k + i; const unsigned off = of4[i] + (unsigned)r32 * 2u;
                *(_Float16*)(ws + off) = (_Float16)(o[0][r] * rl4[i]); *(_Float16*)(ws + off + 64u) = (_Float16)(o[1][r] * rl4[i]); } }
    }
#undef GT_TAKE
#undef GT_SBAR
#undef GT_PIN
#undef GT_KF
#undef GT_VF
#undef GT_MF
#undef GT_MOVE
}


__device__ __forceinline__ void own_unit(unsigned char* ws, int b, int h, int qb, LAS unsigned char* lds, int X, bool dry) {
    constexpr int ND = 4, G = 8;
    int tid_ = threadIdx.x; asm volatile("" : "+v"(tid_));
    const int tid = tid_, lane = tid & 63, r32 = lane & 31, hi = lane >> 5; const int wid = __builtin_amdgcn_readfirstlane(tid >> 6);
    const int bh = b * 8 + h, nt = (wid >> 1) + 1; const bool odd = wid & 1; const int qw0 = qb * 256 + wid * 32;
    const _Float16* Qg = (const _Float16*)(ws + WS_QMB) + ((size_t)b * SEQ + qw0) * 512 + h * 64;
    LAS unsigned char* kfb = lds + X * GBUF; LAS unsigned char* vfb = kfb + G_V;
    LAS float* wsf = (LAS float*)(lds + G_WS) + wid * 128;
    const int vro = ((lane >> 4) & 1) * 32 + (lane & 3) * 8 + (4 * hi + ((lane & 15) >> 2)) * 64;
    const int dl = r32 - 4 * hi;
#define GT_SBAR() __builtin_amdgcn_sched_barrier(0)
#define GT_PIN(x) asm volatile("" : "+v"(x))
#define GT_KF(buf, g) (*(const LAS h8*)(kfb + (buf) * 8192 + kaddr<64>(32 * ((g) & 1) + r32, 2 * ((g) >> 1) + hi)))
#define GT_VF(buf, i) (vfb + (buf) * 8192 + vro + ((i) >> 2) * 4096 + ((i) & 3) * 1024)
#define GT_MF(a, b, c) __builtin_amdgcn_mfma_f32_32x32x16_f16(a, b, c, 0, 0, 0)
#define GT_MOVE(P0, P1, PM) do { const bool move_ = init ? ((PM) > THR) : ((PM) > -INFINITY); \
        if (__any(move_)) { const float dl_ = move_ ? (init ? fmaxf((PM), 0.f) : (PM)) : 0.f; const float al_ = (move_ && init) ? __builtin_amdgcn_exp2f(-dl_) : 1.f; \
            init = init || move_; l_reg *= al_; \
            _Pragma("unroll") for (int r_ = 0; r_ < 16; ++r_) { P0[r_] -= dl_; P1[r_] -= dl_; negm[r_] -= dl_; } \
            if (hi == 0) wsf[r32] = al_; asm volatile("s_waitcnt lgkmcnt(0)" ::: "memory"); \
            _Pragma("unroll") for (int r_ = 0; r_ < 16; ++r_) { const float a_ = wsf[crow(r_, hi)]; o[0][r_] *= a_; o[1][r_] *= a_; } } } while (0)
#define GT_MASK(P0, P1) do { _Pragma("unroll") for (int r_ = 0; r_ < 16; ++r_) { const bool dg_ = ((r_ & 3) + 8 * (r_ >> 2)) > dl; \
            if (!odd) { if (dg_) P0[r_] = -INFINITY; P1[r_] = -INFINITY; } else { if (dg_) P1[r_] = -INFINITY; } } } while (0)
    h8 qr[ND];
#pragma unroll
    for (int d0 = 0; d0 < ND; ++d0) qr[d0] = *(const h8*)(Qg + (size_t)r32 * 512 + d0 * 16 + hi * 8);
#pragma unroll
    for (int d0 = 0; d0 < ND; ++d0) asm volatile("" : "+v"(qr[d0]));
    float l_reg = 0.f; bool init = false; f16v o[2]; o[0] = f16v{}; o[1] = f16v{}; f16v negm = f16v{}; asm volatile("" : "+v"(negm));
    f16v pC0, pC1, pD0, pD1;
    {
        h8 kf_[G];
#pragma unroll
        for (int g_ = 0; g_ < G; ++g_) kf_[g_] = GT_KF(0, g_);
        GT_SBAR();
#pragma unroll
        for (int d_ = 0; d_ < ND; ++d_) { pC0 = GT_MF(kf_[2 * d_], qr[d_], d_ == 0 ? negm : pC0); pC1 = GT_MF(kf_[2 * d_ + 1], qr[d_], d_ == 0 ? negm : pC1); }
        asm volatile("s_nop 15\n\ts_nop 7" : "+v"(pC0), "+v"(pC1));
        if (nt == 1) GT_MASK(pC0, pC1);
        float pa_ = max3f(pC0[0], pC0[1], pC1[0]), pb_ = max3f(pC0[2], pC0[3], pC1[1]); pa_ = max3f(pa_, pC1[2], pC1[3]);
#pragma unroll
        for (int r_ = 4; r_ < 16; r_ += 4) { pa_ = max3f(pa_, pC0[r_], pC0[r_ + 1]); pb_ = max3f(pb_, pC0[r_ + 2], pC0[r_ + 3]); pa_ = max3f(pa_, pC1[r_], pC1[r_ + 1]); pb_ = max3f(pb_, pC1[r_ + 2], pC1[r_ + 3]); }
        const float pm = swapmax(fmaxf(pa_, pb_)); GT_MOVE(pC0, pC1, pm);
    }
    auto gstep = [&](f16v& pC0, f16v& pC1, f16v& pN0, f16v& pN1, const int t, auto hn, const bool mk) __attribute__((always_inline)) {
        constexpr bool hasn = decltype(hn)::value;
        float ps = 0.f; f2v ps2 = (f2v){0.f, 0.f};
        if (hasn) {
            h8 kf[G];
#pragma unroll
            for (int g_ = 0; g_ < 4; ++g_) kf[g_] = GT_KF(t + 1, g_);
            GT_SBAR();
#pragma unroll
            for (int g_ = 0; g_ < G; ++g_) {
                if (g_ + 4 < G) kf[g_ + 4] = GT_KF(t + 1, g_ + 4);
                if (g_ & 1) pN1 = GT_MF(kf[g_], qr[g_ >> 1], g_ == 1 ? negm : pN1); else pN0 = GT_MF(kf[g_], qr[g_ >> 1], g_ == 0 ? negm : pN0);
#pragma unroll
                for (int e = 4 * g_; e < 4 * g_ + 4; ++e) { if (e < 16) { pC0[e] = __builtin_amdgcn_exp2f(pC0[e]); ps += pC0[e]; } else { pC1[e - 16] = __builtin_amdgcn_exp2f(pC1[e - 16]); ps += pC1[e - 16]; } }
                GT_PIN(pC0); GT_PIN(pC1); GT_PIN(ps); GT_SBAR();
            }
        } else {
#pragma unroll
            for (int r = 0; r < 16; ++r) { pC0[r] = __builtin_amdgcn_exp2f(pC0[r]); pC1[r] = __builtin_amdgcn_exp2f(pC1[r]); ps += pC0[r] + pC1[r]; }
        }
        l_reg += swapsum(ps);
        u4 pw[4];
#pragma unroll
        for (int k_ = 0; k_ < 2; ++k_) {
            pw[k_] = (u4){pkh(pC0[8 * k_], pC0[8 * k_ + 1]), pkh(pC0[8 * k_ + 2], pC0[8 * k_ + 3]), pkh(pC0[8 * k_ + 4], pC0[8 * k_ + 5]), pkh(pC0[8 * k_ + 6], pC0[8 * k_ + 7])};
            pw[2 + k_] = (u4){pkh(pC1[8 * k_], pC1[8 * k_ + 1]), pkh(pC1[8 * k_ + 2], pC1[8 * k_ + 3]), pkh(pC1[8 * k_ + 4], pC1[8 * k_ + 5]), pkh(pC1[8 * k_ + 6], pC1[8 * k_ + 7])}; }
        s4 vlo[8], vhi[8]; float pa = 0.f, pb = 0.f;
#pragma unroll
        for (int i = 0; i < 3; ++i) { vlo[i] = vtr(GT_VF(t, i)); vhi[i] = vtr(GT_VF(t, i) + 512); }
        if (hasn) { asm volatile("s_nop 7" : "+v"(pN0), "+v"(pN1)); if (mk) GT_MASK(pN0, pN1); }
        GT_SBAR();
#pragma unroll
        for (int i = 0; i < 8; ++i) {
            if (i + 3 < 8) { vlo[i + 3] = vtr(GT_VF(t, i + 3)); vhi[i + 3] = vtr(GT_VF(t, i + 3) + 512); }
            const s8 vv = (s8){vlo[i][0], vlo[i][1], vlo[i][2], vlo[i][3], vhi[i][0], vhi[i][1], vhi[i][2], vhi[i][3]};
            o[i >> 2] = GT_MF(__builtin_bit_cast(h8, pw[i & 3]), __builtin_bit_cast(h8, vv), o[i >> 2]);
            if (hasn) {
                if (i == 0) { pa = max3f(pN0[0], pN0[1], pN1[0]); pb = max3f(pN0[2], pN0[3], pN1[1]); }
                else if (i == 1) { pa = max3f(pa, pN1[2], pN1[3]); pb = max3f(pb, pN0[6], pN0[7]); }
                else if (i == 2) { pa = max3f(pa, pN0[4], pN0[5]); pb = max3f(pb, pN1[6], pN1[7]); }
                else if (i == 3) { pa = max3f(pa, pN1[4], pN1[5]); pb = max3f(pb, pN0[10], pN0[11]); }
                else if (i == 4) { pa = max3f(pa, pN0[8], pN0[9]); pb = max3f(pb, pN1[10], pN1[11]); }
                else if (i == 5) { pa = max3f(pa, pN1[8], pN1[9]); pb = max3f(pb, pN0[14], pN0[15]); }
                else if (i == 6) { pa = max3f(pa, pN0[12], pN0[13]); pb = max3f(pb, pN1[14], pN1[15]); }
                else { pa = max3f(pa, pN1[12], pN1[13]); }
                GT_PIN(pa); GT_PIN(pb);
            }
            GT_SBAR();
        }
        if (hasn) { const float pm = swapmax(fmaxf(pa, pb)); GT_MOVE(pN0, pN1, pm); }
    };
    for (int t = 0; t < nt - 1; ++t) { gstep(pC0, pC1, pD0, pD1, t, T1{}, t + 2 == nt); pC0 = pD0; pC1 = pD1; }
    gstep(pC0, pC1, pD0, pD1, nt - 1, T0{}, false);
    if (hi == 0) { wsf[32 + r32] = l_reg; wsf[r32] = -negm[0]; }
    __syncthreads();
    LAS _Float16* stg = (LAS _Float16*)(lds + X * GBUF) + wid * 2048;
#pragma unroll
    for (int r = 0; r < 16; ++r) { const int orow = crow(r, hi); const float rl = 1.f / wsf[32 + orow];
        stg[orow * 64 + r32] = (_Float16)(o[0][r] * rl); stg[orow * 64 + 32 + r32] = (_Float16)(o[1][r] * rl); }
    asm volatile("s_waitcnt lgkmcnt(0)" ::: "memory");
    int lane_e = lane; asm volatile("" : "+v"(lane_e));
    unsigned char* zbu = (unsigned char*)((_Float16*)(ws + WS_ZCAT) + 512 + ((size_t)b * SEQ + qw0) * 1024 + h * 64);
    const int nsl = qb < 3 ? qb : 3;
#pragma unroll
    for (int i = 0; i < 4; ++i) { const int row = i * 8 + (lane_e >> 3), ch = lane_e & 7; const h8 v = *(const LAS h8*)(stg + row * 64 + ch * 8);
        _Float16* zp = (_Float16*)(zbu + (unsigned)(row * 1024 + ch * 8) * 2u); const h8 z = *(const h8*)zp; h8 ov;
        const unsigned gr = (unsigned)(bh * 4096 + qw0 + row);
        const float m_own = wsf[row], l_own = wsf[32 + row]; float M = m_own; float2 ml[3]; h8 po[3];
#pragma unroll
        for (int s = 0; s < 3; ++s) if (s < nsl) { ml[s] = ((const float2*)(ws + WS_ML))[(unsigned)s * 524288u + gr]; po[s] = *(const h8*)(ws + opart_off(s) + gr * 128u + (unsigned)ch * 16u); M = fmaxf(M, ml[s].x); }
        const float w0 = l_own * __builtin_amdgcn_exp2f(m_own - M); float W = w0; float acc[8];
#pragma unroll
        for (int j = 0; j < 8; ++j) acc[j] = w0 * (float)v[j];
#pragma unroll
        for (int s = 0; s < 3; ++s) if (s < nsl) { const float w = ml[s].y * __builtin_amdgcn_exp2f(ml[s].x - M); W += w;
#pragma unroll
            for (int j = 0; j < 8; ++j) acc[j] = fmaf(w, (float)po[s][j], acc[j]); }
        const float rW = 1.f / W;
#pragma unroll
        for (int j = 0; j < 8; ++j) ov[j] = (_Float16)(acc[j] * rW * (float)z[j]);
        if (!dry) *(h8*)zp = ov; }
#undef GT_SBAR
#undef GT_PIN
#undef GT_KF
#undef GT_VF
#undef GT_MF
#undef GT_MOVE
#undef GT_MASK
}

__device__ __forceinline__ void attn_phase(unsigned char* ws, LAS unsigned char* lds, int vb, int nvb) {
    const int vcu = (nvb % 8 == 0) ? (vb % 8) * (nvb / 8) + vb / 8 : vb; const int per = (1024 + nvb - 1) / nvb;
    for (int k = 0; k < per; ++k) {
        int it;
        if (nvb == 256) { const int xg = vcu >> 5, lw = vcu & 31; it = ((16 * xg + 4 * k + (lw >> 3)) << 3) | (lw & 7); }
        else { it = vcu * per + k; if (it >= 1024) break; }
        const int bh = it >> 3, pr = it & 7, b = bh >> 3, h = bh & 7;
        if (PROBE == 2) for (int uu = 0; uu < 2; ++uu) attn_unit<96, false, PROBE_ABL>(ws, b, h, uu ? 15 - pr : pr, lds, true);
        for (int uu = 0; uu < 2; ++uu) attn_unit<96, false>(ws, b, h, uu ? 15 - pr : pr, lds);
    }
    int nu = 0;
    for (int k = 0; k < per; ++k) { int it; if (nvb == 256) { const int xg = vcu >> 5, lw = vcu & 31; it = ((16 * xg + 4 * k + (lw >> 3)) << 3) | (lw & 7); } else { it = vcu * per + k; if (it >= 1024) break; } nu += 2; }
    auto unit_of = [&](int u, int& b, int& h, int& j) {
        const int k = u >> 1; int it; if (nvb == 256) { const int xg = vcu >> 5, lw = vcu & 31; it = ((16 * xg + 4 * k + (lw >> 3)) << 3) | (lw & 7); } else it = vcu * per + k;
        const int bh = it >> 3, pr = it & 7, rot = (bh >> 2) & 3; b = bh >> 3; h = bh & 7;
        const int sl = ((pr & 3) + rot) & 3; const int x = pr < 4 ? ((0x6170 >> (4 * sl)) & 15) : ((0x4352 >> (4 * sl)) & 15);
        j = (u & 1) ? 14 - x : x; return !((u & 1) && x == 7); };
    LAS unsigned* gc = (LAS unsigned*)(lds + G_CTL);
    int tid_g = threadIdx.x; asm volatile("" : "+v"(tid_g)); const int lane_g = tid_g & 63;
    for (int rep = 0; rep < (PROBE == 12 ? 2 : 1); ++rep)
    for (int u0 = 0; u0 < nu; u0 += 64) {
        const int nc = nu - u0 < 64 ? nu - u0 : 64;
        if (tid_g < 192) gc[tid_g] = 0u;
        { int b, h, j; if (unit_of(u0, b, h, j)) gather_dma(ws, b, h, j, lds, 0); if (nc > 1 && unit_of(u0 + 1, b, h, j)) gather_dma(ws, b, h, j, lds, 1); }
        asm volatile("s_waitcnt vmcnt(0)" ::: "memory"); __syncthreads();
        for (int uc = 0; uc < nc; ++uc) {
            int b, h, j; const bool ok = unit_of(u0 + uc, b, h, j);
            if (uc >= 2) while (((volatile LAS unsigned*)gc)[128 + uc] == 0u) __builtin_amdgcn_s_sleep(4);
            if (ok) gather_unit(ws, b, h, j, lds, uc & 1, gc + uc);
            unsigned n = 0u; if (lane_g == 0) n = __hip_atomic_fetch_add(gc + 64 + uc, 1u, __ATOMIC_RELAXED, __HIP_MEMORY_SCOPE_WORKGROUP);
            n = (unsigned)__builtin_amdgcn_readfirstlane((int)n) + 1u;
            if (n == 8u && uc + 2 < nc) { int b2, h2, j2;
                if (unit_of(u0 + uc + 2, b2, h2, j2)) { gather_dma_all(ws, b2, h2, j2, lds, uc & 1); asm volatile("s_waitcnt vmcnt(0)" ::: "memory"); }
                if (lane_g == 0) ((volatile LAS unsigned*)gc)[128 + uc + 2] = 1u; }
        }
        __syncthreads();
    }
}
template <bool DRY> __device__ __forceinline__ void attn_phase2_pass(unsigned char* ws, LAS unsigned char* lds, int vb, int nvb) {
    int X = 0;
    if (vb < 2048) gather_dma(ws, vb >> 7, (vb >> 4) & 7, vb & 15, lds, 0);
    for (int it = vb; it < 2048; it += nvb) {
        asm volatile("s_waitcnt vmcnt(0)" ::: "memory"); __syncthreads();
        const int nx = it + nvb; if (nx < 2048) gather_dma(ws, nx >> 7, (nx >> 4) & 7, nx & 15, lds, X ^ 1);
        own_unit(ws, it >> 7, (it >> 4) & 7, it & 15, lds, X, DRY);
        X ^= 1;
    }
    __syncthreads();
}
__device__ __forceinline__ void attn_phase2(unsigned char* ws, LAS unsigned char* lds, int vb, int nvb) {
    if (PROBE == 13) attn_phase2_pass<true>(ws, lds, vb, nvb);
    attn_phase2_pass<false>(ws, lds, vb, nvb);
}
}

constexpr int RING_BYTES = 131072, MISC_OFF = RING_BYTES + 320, LDS_BYTES = 147456;
constexpr int CW_BAR = 4096;

__global__ void __launch_bounds__(512, 2) mega(Params p) {
    extern __shared__ __attribute__((aligned(16))) unsigned char lds[];
    const int vb = blockIdx.x, nvb = gridDim.x, tid = threadIdx.x, lane = tid & 63, wave = tid >> 6;
    const int gtid = vb * 512 + tid, gsize = nvb * 512, gwave = vb * 8 + wave, nwaves = nvb * 8;
    volatile LAS unsigned* misc = (volatile LAS unsigned*)((LAS unsigned char*)lds + MISC_OFF);
    if (tid < 32) misc[tid] = 0u;
    __syncthreads();
    XcdBarrier bar = xcd_barrier_post((unsigned*)(p.ws + WS_CTL) + CW_BAR, misc + 8);
    LAS unsigned char* ldsl = (LAS unsigned char*)lds;
    { int t_ = threadIdx.x; asm volatile("" : "+v"(t_)); ph_prep(p, vb * 512 + t_, gsize, vb, nvb, ldsl); ph_weights(p, ldsl, vb * 8 + (t_ >> 6), nwaves, t_ >> 6, t_ & 63);
      if (PROBE == 10) ph_weights(p, ldsl, vb * 8 + (t_ >> 6), nwaves, t_ >> 6, t_ & 63);
      if (PROBE == 11) ph_tab(p, vb * 512 + t_, gsize); }
    xcd_barrier(bar);
    for (int rep4 = 0; rep4 < ((PROBE == 4 || PROBE == 6) ? 2 : 1); ++rep4) { int t_ = threadIdx.x; asm volatile("" : "+v"(t_)); ph_hnorm(p, vb * 8 + (t_ >> 6), nwaves, t_ & 63); }
    xcd_barrier(bar);
    {
        pg8::Gemm g{(const pg8::bf16_t*)(p.ws + WS_H), (const pg8::bf16_t*)(p.ws + WT_IN), M_, 5120, 1024}; pg8::StaticOrder S; S.init(M_, 5120, nvb, vb);
        for (int rep = (PROBE == 1 ? 1 : 0); rep >= 0; --rep) { pg8::EpiInF E{p.ws, p.b_merge, rep}; pg8::gemm_phase<pg8::EpiInF, pg8::StaticOrder, true, true>(ldsl, g, S, E); }
        if (PROBE == 5) { pg8::EpiNull E; pg8::gemm_phase<pg8::EpiNull, pg8::StaticOrder, true, true>(ldsl, g, S, E); }
    }
    xcd_barrier(bar);
    { int t_ = threadIdx.x; asm volatile("" : "+v"(t_)); att::ph_gate(p.ws, vb * 8 + (t_ >> 6), nwaves, t_ & 63); }
    for (int rep4 = 0; rep4 < ((PROBE == 4 || PROBE == 7) ? 2 : 1); ++rep4) {
        pg8::Gemm g{(const pg8::bf16_t*)(p.ws + WS_QLAT), (const pg8::bf16_t*)(p.ws + WT_UQ), M_, 768, 256}; pg8::StaticOrder S; S.init(M_, 768, nvb, vb);
        pg8::EpiUqF E{p.ws}; pg8::gemm_phase<pg8::EpiUqF, pg8::StaticOrder, true, true>(ldsl, g, S, E);
    }
    for (int rep4 = 0; rep4 < ((PROBE == 4 || PROBE == 7) ? 2 : 1); ++rep4) {
        pg8::Gemm g{(const pg8::bf16_t*)(p.ws + WS_KVL), (const pg8::bf16_t*)(p.ws + WT_UKV), M_, 1024, 128};     pg8::StaticOrder S; S.init(M_, 1024, nvb, vb);
        pg8::EpiUkvF E{p.ws}; pg8::gemm_phase<pg8::EpiUkvF, pg8::StaticOrder, true, true>(ldsl, g, S, E);
    }
    xcd_barrier(bar);
    att::attn_phase(p.ws, ldsl, vb, nvb);
    xcd_barrier(bar);
    att::attn_phase2(p.ws, ldsl, vb, nvb);
    xcd_barrier(bar);
    {
        pg8::Gemm g{(const pg8::bf16_t*)(p.ws + WS_ZCAT), (const pg8::bf16_t*)(p.ws + WT_OA), M_, 1024, 1024}; pg8::StaticOrder S; S.init(M_, 1024, nvb, vb);
        pg8::EpiYcatF E{p.ws}; pg8::gemm_phase<pg8::EpiYcatF, pg8::StaticOrder, true, true>(ldsl, g, S, E);
    }
    xcd_barrier(bar);
    for (int rep4 = 0; rep4 < ((PROBE == 4 || PROBE == 9) ? 2 : 1); ++rep4) {
        pg8::Gemm g{(const pg8::bf16_t*)(p.ws + WS_YM), (const pg8::bf16_t*)(p.ws + WT_OUT), M_, 1024, 1024}; pg8::StaticOrder S; S.init(M_, 1024, nvb, vb);
        pg8::EpiYF E{p.ws}; pg8::gemm_phase<pg8::EpiYF, pg8::StaticOrder, true, true>(ldsl, g, S, E);
    }
    xcd_barrier(bar);
    for (int rep4 = 0; rep4 < ((PROBE == 4 || PROBE == 9) ? 2 : 1); ++rep4) { int t_ = threadIdx.x; asm volatile("" : "+v"(t_)); ph_final(p, vb * 8 + (t_ >> 6), nwaves, t_ & 63); }
}

extern "C" void kernel_launch(void* const* d_in, const int* in_sizes, int n_in, void* d_out, int out_size, void* d_ws, size_t ws_size, hipStream_t stream) {
    if (n_in != 16 || out_size != M_ * DM || ws_size < WS_END) { fprintf(stderr, "kernel_launch: unexpected shapes (n_in %d, out %d, ws %zu)\n", n_in, out_size, ws_size); return; }
    Params p{};
    p.x = (const float*)d_in[0]; p.c = (const float*)d_in[1]; p.pos = (const int*)d_in[2]; p.w_ada = (const float*)d_in[3]; p.b_ada = (const float*)d_in[4];
    p.g_pre = (const float*)d_in[5]; p.g_post = (const float*)d_in[6]; p.w_in = (const float*)d_in[7]; p.g_q = (const float*)d_in[8]; p.w_uq = (const float*)d_in[9];
    p.g_kv = (const float*)d_in[10]; p.w_ukv = (const float*)d_in[11]; p.w_o_mla = (const float*)d_in[12]; p.w_o_moba = (const float*)d_in[13]; p.b_merge = (const float*)d_in[14]; p.w_out = (const float*)d_in[15];
    p.out = (float*)d_out; p.ws = (unsigned char*)d_ws;
    static int grid = 0;
    if (grid == 0) {
        int dev = 0, cus = 0, per_cu = 0;
        if (hipGetDevice(&dev) != hipSuccess || hipDeviceGetAttribute(&cus, hipDeviceAttributeMultiprocessorCount, dev) != hipSuccess) { fprintf(stderr, "kernel_launch: device query failed\n"); grid = -1; return; }
        if (hipFuncSetAttribute((const void*)mega, hipFuncAttributeMaxDynamicSharedMemorySize, LDS_BYTES) != hipSuccess) { fprintf(stderr, "kernel_launch: hipFuncSetAttribute failed\n"); grid = -1; return; }
        if (hipOccupancyMaxActiveBlocksPerMultiprocessor(&per_cu, (const void*)mega, 512, LDS_BYTES) != hipSuccess || per_cu < 1) { fprintf(stderr, "kernel_launch: occupancy query says %d\n", per_cu); }
        (void)hipGetLastError();
        grid = cus;
    }
    if (grid < 0) return;
    (void)hipMemsetAsync(d_ws, 0, ZERO_BYTES, stream);
    hipLaunchKernelGGL(mega, dim3(grid), dim3(512), LDS_BYTES, stream, p);
}
```

```cpp
#include <hip/hip_runtime.h>
#include <cstdio>
#ifndef PROBE
#define PROBE 0
#endif
#include <cstdint>

typedef _Float16 h16;
typedef _Float16 h16x4 __attribute__((ext_vector_type(4)));
typedef _Float16 h2n __attribute__((ext_vector_type(2)));

constexpr int NB = 16, SEQ = 4096, DM = 1024, M_ = NB * SEQ, NH = 8;
constexpr int D_IN = 5024;
constexpr int C_QLAT = 0, C_KVLAT = 256, C_KROPE = 384, C_ZMLA = 416, C_QMB = 928, C_KMB = 1440, C_VMB = 1952, C_ZMB = 2464, C_GA = 2976, C_GB = 4000;
constexpr float EPS = 1e-6f;
constexpr float LOG2E = 1.4426950408889634f;
constexpr float SC_MLA = 0.10206207261596577f * LOG2E;
constexpr float SC_MB = 0.125f * LOG2E;

constexpr size_t MiB = 1u << 20;
constexpr size_t WS_CTL = 0, WS_KMEAN = 512 * 1024, WS_SSQ = 1 * MiB, WS_SSQY = WS_SSQ + 2 * (size_t)M_ * 4, ZERO_BYTES = 2 * MiB;
constexpr size_t WS_MOD = WS_SSQ + 3 * (size_t)M_ * 4, WS_TAB = 4 * MiB, WS_WT = 20 * MiB;
constexpr size_t WS_H = 36 * MiB, WS_KN = 36 * MiB, WS_VM = 100 * MiB;
constexpr size_t WS_QLAT = 164 * MiB, WS_KVL = 196 * MiB, WS_KPE = 228 * MiB, WS_VMB = 232 * MiB;
constexpr size_t WS_QMB = 296 * MiB, WS_KMB = 360 * MiB, WS_ZCAT = 424 * MiB, WS_YM = 296 * MiB;
constexpr size_t WS_GA = 552 * MiB, WS_GB = 616 * MiB, WS_Y = 680 * MiB,     WS_QMLA = 808 * MiB, WS_LIST = 904 * MiB, WS_ML = 920 * MiB, WS_END = 936 * MiB;
constexpr size_t WS_CNT = 64 * 1024;
__device__ __forceinline__ unsigned opart_off(int slot) { return slot < 2 ? (unsigned)(WS_Y + (size_t)slot * 64 * MiB) : (unsigned)WS_QLAT; }

static_assert(WS_MOD + (size_t)NB * 3072 * 4 <= ZERO_BYTES, "MOD inside the zeroed region");
struct Params {
    const float *x, *c; const int* pos; const float *w_ada, *b_ada, *g_pre, *g_post, *w_in, *g_q, *w_uq, *g_kv, *w_ukv, *w_o_mla, *w_o_moba, *b_merge, *w_out;
    float* out; unsigned char* ws;
};

__device__ __forceinline__ float wave_sum(float v) {
#pragma unroll
    for (int o = 1; o < 64; o <<= 1) v += __shfl_xor(v, o);
    return v;
}
__device__ __forceinline__ float silu_f(float v) { return v / (1.f + __expf(-v)); }
__device__ __forceinline__ float sigmoid_f(float v) { return 1.f / (1.f + __expf(-v)); }

#define LAS __attribute__((address_space(3)))
__device__ void ph_tab(const Params& p, int gtid, int gsize);
__device__ void ph_prep(const Params& p, int gtid, int gsize, int vb, int nvb, LAS unsigned char* lds) {
    float* mod = (float*)(p.ws + WS_MOD);
    { const int tid = gtid - vb * 512; LAS float* sc = (LAS float*)lds; LAS float* part = (LAS float*)(lds + 65536);
      for (int i = tid; i < NB * DM; i += 512) { const float cv = p.c[i]; sc[i] = cv / (1.f + __expf(-cv)); }
      __syncthreads();
      for (int cg = vb; cg < 3072 / 12; cg += nvb) {
          if (tid < 384) { const int col = tid % 12, kc = tid / 12, j = cg * 12 + col, k0 = kc * 32;
              float w[32], acc[NB];
#pragma unroll
              for (int kk = 0; kk < 32; ++kk) w[kk] = p.w_ada[(size_t)(k0 + kk) * 3072 + j];
#pragma unroll
              for (int b = 0; b < NB; ++b) acc[b] = 0.f;
#pragma unroll
              for (int kk = 0; kk < 32; kk += 4) {
#pragma unroll
                  for (int b = 0; b < NB; ++b) { typedef float f4m __attribute__((ext_vector_type(4))); const f4m s4 = *(const LAS f4m*)(sc + b * DM + k0 + kk);
                      acc[b] = fmaf(s4.x, w[kk], acc[b]); acc[b] = fmaf(s4.y, w[kk + 1], acc[b]); acc[b] = fmaf(s4.z, w[kk + 2], acc[b]); acc[b] = fmaf(s4.w, w[kk + 3], acc[b]); } }
#pragma unroll
              for (int b = 0; b < NB; ++b) part[(kc * NB + b) * 12 + col] = acc[b]; }
          __syncthreads();
          if (tid < NB * 12) { const int b = tid / 12, c = tid % 12, j = cg * 12 + c; float s = p.b_ada[j];
#pragma unroll
              for (int kc = 0; kc < 32; ++kc) s += part[(kc * NB + b) * 12 + c];
              mod[b * 3072 + j] = s; }
          __syncthreads();
      } }
    ph_tab(p, gtid, gsize);
}
__device__ void ph_tab(const Params& p, int gtid, int gsize) {
    unsigned* tab = (unsigned*)(p.ws + WS_TAB);
    const int f = gtid & 31;
    const double c = exp2(-(double)f * (13.287712379549449 / 32.0)) * 0.15915494309189535;
    int ex; const double mant = frexp(c, &ex); const double c_hi_d = ldexp(rint(ldexp(mant, 11)), ex - 11);
    const float c_hi = (float)c_hi_d, c_lo = (float)(c - c_hi_d);
    for (int i = gtid; i < M_ * 32; i += gsize) {
        const float pos = (float)p.pos[i >> 5];
        float x = pos * c_hi; x = x - floorf(x); x = fmaf(pos, c_lo, x);
        typedef _Float16 h2t __attribute__((ext_vector_type(2))); h2t cs; cs[0] = (_Float16)__builtin_amdgcn_cosf(x); cs[1] = (_Float16)__builtin_amdgcn_sinf(x);
        tab[i] = __builtin_bit_cast(unsigned, cs);
    }
}

__device__ void ph_hnorm(const Params& p, int gwave, int nwaves, int lane) {
    constexpr int R = 4;
    typedef float f4 __attribute__((ext_vector_type(4)));
    const float* mod = (const float*)(p.ws + WS_MOD); h16* H = (h16*)(p.ws + WS_H);
    for (int m0 = R * gwave; m0 < M_; m0 += R * nwaves) {
        f4 v[R][4]; float ss[R];
#pragma unroll
        for (int r = 0; r < R; ++r) { const f4* xr = (const f4*)(p.x + (size_t)(m0 + r) * DM);
#pragma unroll
            for (int j = 0; j < 4; ++j) v[r][j] = __builtin_nontemporal_load(xr + lane + 64 * j); }
#pragma unroll
        for (int r = 0; r < R; ++r) { float s = 0.f;
#pragma unroll
            for (int j = 0; j < 4; ++j) s += (v[r][j][0] * v[r][j][0] + v[r][j][1] * v[r][j][1]) + (v[r][j][2] * v[r][j][2] + v[r][j][3] * v[r][j][3]);
            ss[r] = 1.f / sqrtf(wave_sum(s) * (1.f / DM) + EPS); }
        const int b = m0 >> 12;
#pragma unroll
        for (int j = 0; j < 4; ++j) {
            const int col = 4 * (lane + 64 * j);
            const float4 g = *(const float4*)(p.g_pre + col), sc = *(const float4*)(mod + b * 3072 + 1024 + col), sh = *(const float4*)(mod + b * 3072 + col);
            const float g0 = g.x * (1.f + sc.x), g1 = g.y * (1.f + sc.y), g2 = g.z * (1.f + sc.z), g3 = g.w * (1.f + sc.w);
#pragma unroll
            for (int r = 0; r < R; ++r) { const float rstd = ss[r]; const f4 x = v[r][j];
                h16x4 o; o[0] = (h16)(x[0] * rstd * g0 + sh.x); o[1] = (h16)(x[1] * rstd * g1 + sh.y); o[2] = (h16)(x[2] * rstd * g2 + sh.z); o[3] = (h16)(x[3] * rstd * g3 + sh.w);
                *(h16x4*)(H + (size_t)(m0 + r) * DM + col) = o; }
        }
    }
}

__device__ void ph_final(const Params& p, int gwave, int nwaves, int lane) {
    constexpr int R = 4; typedef float f4 __attribute__((ext_vector_type(4)));
    const float* mod = (const float*)(p.ws + WS_MOD); const h16* Y = (const h16*)(p.ws + WS_Y); const float* ssq = (const float*)(p.ws + WS_SSQY);
    for (int m0 = R * gwave; m0 < M_; m0 += R * nwaves) {
        const int b = m0 >> 12; h16x4 yv[R][4]; f4 xv[R][4]; float rs[R];
#pragma unroll
        for (int r = 0; r < R; ++r) { const h16x4* yr = (const h16x4*)(Y + (size_t)(m0 + r) * DM); const f4* xr = (const f4*)(p.x + (size_t)(m0 + r) * DM); rs[r] = ssq[m0 + r];
#pragma unroll
            for (int j = 0; j < 4; ++j) { yv[r][j] = yr[lane + 64 * j]; xv[r][j] = __builtin_nontemporal_load(xr + lane + 64 * j); } }
#pragma unroll
        for (int r = 0; r < R; ++r) rs[r] = 1.f / sqrtf(rs[r] * (1.f / DM) + EPS);
#pragma unroll
        for (int j = 0; j < 4; ++j) {
            const int col = 4 * (lane + 64 * j); const float4 g = *(const float4*)(p.g_post + col), gt = *(const float4*)(mod + b * 3072 + 2048 + col);
            const float g0 = g.x * gt.x, g1 = g.y * gt.y, g2 = g.z * gt.z, g3 = g.w * gt.w;
#pragma unroll
            for (int r = 0; r < R; ++r) { const h16x4 y = yv[r][j]; const f4 x = xv[r][j]; const float s = rs[r];
                f4 o; o[0] = x[0] + g0 * (float)y[0] * s; o[1] = x[1] + g1 * (float)y[1] * s; o[2] = x[2] + g2 * (float)y[2] * s; o[3] = x[3] + g3 * (float)y[3] * s;
                __builtin_nontemporal_store(o, (f4*)(p.out + (size_t)(m0 + r) * DM) + lane + 64 * j); }
        }
    }
}


#define XB_TMO      128
#define XB_XCNT(j)  (256  + 64 * (j))
#define XB_XSUB(j)  (1280 + 64 * (j))
#define XB_XGEN(j)  (2304 + 64 * (j))
#define XB_TOP      3328
#define XB_TOPGEN   3392
#define XCD_BAR_WORDS 3456
#define XB_SPIN_CAP (1u << 27)
__device__ __forceinline__ unsigned xb_ld(unsigned* p)              { return __hip_atomic_load(p, __ATOMIC_RELAXED, __HIP_MEMORY_SCOPE_AGENT); }
__device__ __forceinline__ unsigned xb_add(unsigned* p, unsigned v) { return __hip_atomic_fetch_add(p, v, __ATOMIC_RELAXED, __HIP_MEMORY_SCOPE_AGENT); }
__device__ __forceinline__ unsigned xb_xcc_id() { return (unsigned)__builtin_amdgcn_s_getreg((3 << 11) | 20) & 0xFu; }
#define XB_SPIN(cond, bar) do { unsigned _sp = 0; while (cond) { __builtin_amdgcn_s_sleep(1); \
    if ((++_sp & 255u) == 0u) { if (xb_ld(&(bar)[XB_TMO])) break; if (_sp > XB_SPIN_CAP) { atomicAdd(&(bar)[XB_TMO], 1u); break; } } } } while (0)
struct XcdBarrier { unsigned* bar; unsigned x; volatile LAS unsigned* st; };
__device__ __forceinline__ XcdBarrier xcd_barrier_post(unsigned* bar, volatile LAS unsigned* st) {
    XcdBarrier b; b.bar = bar; b.x = xb_xcc_id(); b.st = st;
    if (threadIdx.x == 0) (void)xb_add(&bar[XB_XCNT(b.x)], 1u);
    return b;
}
__device__ __forceinline__ void xcd_barrier_complete(unsigned* bar, unsigned x, unsigned& nloc, unsigned& nx) {
    const unsigned G = gridDim.x * gridDim.y * gridDim.z;
    unsigned sum, cnt, mine, sp = 0u;
    for (;;) {
        sum = 0u; cnt = 0u; mine = 0u;
#pragma unroll
        for (unsigned j = 0; j < 16; ++j) { const unsigned c = xb_ld(&bar[XB_XCNT(j)]); sum += c; cnt += (c > 0u) ? 1u : 0u; mine = (j == x) ? c : mine; }
        if (sum == G) break;
        __builtin_amdgcn_s_sleep(1);
        if ((++sp & 255u) == 0u) { if (xb_ld(&bar[XB_TMO])) break; if (sp > XB_SPIN_CAP) { atomicAdd(&bar[XB_TMO], 1u); break; } }
    }
    nloc = mine > 0u ? mine : 1u; nx = cnt > 0u ? cnt : 1u;
}
__device__ __forceinline__ void xcd_barrier(const XcdBarrier& b) {
    asm volatile("s_waitcnt vmcnt(0)" ::: "memory");
    __syncthreads();
    if (threadIdx.x == 0) {
        unsigned* bar = b.bar;
        __builtin_amdgcn_s_waitcnt(0);
        unsigned nloc = b.st[0], nx = b.st[1];
        if (nloc == 0u) { xcd_barrier_complete(bar, b.x, nloc, nx); b.st[0] = nloc; b.st[1] = nx; }
        const unsigned old = xb_add(&bar[XB_XSUB(b.x)], 1u);
        const unsigned gen = old / nloc;
        if (old + 1u == (gen + 1u) * nloc) {
            __builtin_amdgcn_fence(__ATOMIC_RELEASE, "agent");
            asm volatile("s_waitcnt vmcnt(0)" ::: "memory");
            const unsigned og = xb_add(&bar[XB_TOP], 1u);
            const unsigned tg = og / nx;
            if (og + 1u == (tg + 1u) * nx) xb_add(&bar[XB_TOPGEN], 1u);
            else XB_SPIN(xb_ld(&bar[XB_TOPGEN]) == tg, bar);
            __builtin_amdgcn_fence(__ATOMIC_ACQUIRE, "agent");
            xb_add(&bar[XB_XGEN(b.x)], 1u);
            asm volatile("s_waitcnt vmcnt(0)" ::: "memory");
        } else {
            XB_SPIN(xb_ld(&bar[XB_XGEN(b.x)]) == gen, bar);
            __builtin_amdgcn_fence(__ATOMIC_ACQUIRE, "agent");
            asm volatile("s_waitcnt vmcnt(0)" ::: "memory");
        }
    }
    __syncthreads();
}

namespace pg8 {
#define PG8_LAS __attribute__((address_space(3)))
typedef unsigned short bf16_t;
typedef _Float16 bf16x8 __attribute__((ext_vector_type(8)));
typedef float f32x4 __attribute__((ext_vector_type(4)));
typedef unsigned u32x4 __attribute__((ext_vector_type(4)));
constexpr int BM = 256, BK = 64, HALF = 128, HTB = HALF * BK * 2  , STAGE_BYTES = 8 * HTB, NXCD = 8, WGM = 8;

__host__ __device__ __forceinline__ int lds_byte(int r, int c) { const int st = (r >> 4) * 2 + (c >> 5), rr = r & 15, cc = c & 31, ob = rr * 64 + cc * 2; return st * 1024 + (ob ^ (((ob >> 9) & 1) << 5)); }
__host__ __device__ __forceinline__ void stage_rc(int b, int& R, int& C) { const int st = b / 1024, sb = b % 1024, swz = sb ^ (((sb >> 9) & 1) << 5); R = (st >> 1) * 16 + swz / 64; C = (st & 1) * 32 + (swz % 64) / 2; }
__host__ __device__ __forceinline__ int perm32(int rho) { const int n = rho >> 4, i = rho & 15; return 8 * (i >> 2) + 4 * n + (i & 3); }

struct Unit { int pm, pn; };
struct Gemm { const bf16_t* A; const bf16_t* Bt; int M, N, K; };

struct StaticOrder {
    int nM, nN, nwg, G, c;
    __host__ __device__ void init(int M, int N, int G_, int c_) { nM = M / BM; nN = N / BM; nwg = nM * nN; G = G_; c = c_; }
    __host__ __device__ bool next(int i, Unit& u) const {
        const long L = (long)i * G + c; if (L >= nwg) return false;
        int wgid = (int)L; { const int q = nwg / NXCD, r = nwg % NXCD, xcd = wgid % NXCD, off = wgid / NXCD; wgid = (xcd < r ? xcd * (q + 1) : r * (q + 1) + (xcd - r) * q) + off; }
        const int nig = WGM * nN, gid = wgid / nig, fm = gid * WGM, gsz = (nM - fm) < WGM ? (nM - fm) : WGM;
        u.pm = fm + ((wgid % nig) % gsz); u.pn = (wgid % nig) / gsz; return true;
    }
    __device__ __forceinline__ void a_ready(const Unit&) const {}
    __device__ __forceinline__ void done(const Unit&) const {}
};

template <class Epi, class Sched, bool ALIGN_EPI = false, bool SP2 = false>
__device__ __forceinline__ void gemm_phase(PG8_LAS unsigned char* lds, const Gemm g, const Sched& S, const Epi& E) {
    int tid_ = threadIdx.x; asm volatile("" : "+v"(tid_));
    const int tid = tid_, wid = __builtin_amdgcn_readfirstlane(tid >> 6), lane = tid & 63, wr = wid >> 2, wc = wid & 3, fr = lane & 15, fq = lane >> 4;
    const int K = g.K, nt = K / BK;
    unsigned voffA[2], voffB[2];
#pragma unroll
    for (int i = 0; i < 2; ++i) { int R, C; stage_rc(tid * 16 + i * 8192, R, C); const int Rb = Epi::PERM ? ((R & ~31) + perm32(R & 31)) : R;
        voffA[i] = (unsigned)(R * K + C) * 2u; voffB[i] = (unsigned)(Rb * K + C) * 2u; }
    const size_t kstep = (size_t)(BK * 2);
    const size_t hstep = (size_t)HALF * K * 2;
    const size_t tstep = 2 * hstep;
    const unsigned ldsw = (unsigned)wid * 1024u;
    const int aoff = lds_byte(wr * 64 + fr, fq * 8), boff = lds_byte(wc * 32 + fr, fq * 8);
#define PG8_SA(b, h) (((b) * 2 + (h)) * HTB)
#define PG8_SB(b, h) ((4 + (b) * 2 + (h)) * HTB)
#define PG8_STAGE(bufoff, gbase, voff) do { _Pragma("unroll") for (int _i = 0; _i < 2; ++_i) \
        __builtin_amdgcn_global_load_lds((const unsigned*)((const char*)(gbase) + (voff)[_i]), (PG8_LAS unsigned*)(lds + (bufoff) + ldsw + _i * 8192), 16, 0, 0); } while (0)
#define PG8_LDA(dst, b, h) do { _Pragma("unroll") for (int m = 0; m < 4; ++m) _Pragma("unroll") for (int k = 0; k < 2; ++k) dst[m][k] = *(const PG8_LAS bf16x8*)(lds + PG8_SA(b, h) + aoff + m * 2048 + k * 1024); } while (0)
#define PG8_LDB(dst, b, h) do { _Pragma("unroll") for (int n = 0; n < 2; ++n) _Pragma("unroll") for (int k = 0; k < 2; ++k) dst[n][k] = *(const PG8_LAS bf16x8*)(lds + PG8_SB(b, h) + boff + n * 2048 + k * 1024); } while (0)
#define PG8_MMA(ai, bj, At, Bt) do { __builtin_amdgcn_s_setprio(1); _Pragma("unroll") for (int m = 0; m < 4; ++m) _Pragma("unroll") for (int n = 0; n < 2; ++n) _Pragma("unroll") for (int k = 0; k < 2; ++k) \
        acc[ai][bj][m][n] = __builtin_amdgcn_mfma_f32_16x16x32_f16(Bt[n][k], At[m][k], acc[ai][bj][m][n], 0, 0, 0); __builtin_amdgcn_s_setprio(0); } while (0)
#define PG8_WAIT_V(n) asm volatile("s_waitcnt vmcnt(" #n ")" ::: "memory")
#define PG8_WAIT_L(n) asm volatile("s_waitcnt lgkmcnt(" #n ")" ::: "memory")
#define PG8_BAR __builtin_amdgcn_s_barrier()
#define PG8_SCHED __builtin_amdgcn_sched_barrier(0)
    Unit cur, nxt; int ui = 0;
    if (!S.next(0, cur)) return;
    f32x4 acc[2][2][4][2];
#pragma unroll
    for (int a = 0; a < 2; ++a)
#pragma unroll
        for (int b = 0; b < 2; ++b)
#pragma unroll
            for (int m = 0; m < 4; ++m)
#pragma unroll
                for (int n = 0; n < 2; ++n) acc[a][b][m][n] = (f32x4){0.f, 0.f, 0.f, 0.f};
    bf16x8 At[4][2], B0[2][2], B1[2][2];
    const char* cA = (const char*)g.A + (size_t)cur.pm * tstep; const char* cB = (const char*)g.Bt + (size_t)cur.pn * tstep;
    S.a_ready(cur);
    if constexpr (SP2) {
        PG8_STAGE(PG8_SB(0, 0), cB, voffB); PG8_STAGE(PG8_SB(0, 1), cB + hstep, voffB); PG8_STAGE(PG8_SA(0, 0), cA, voffA); PG8_STAGE(PG8_SA(0, 1), cA + hstep, voffA);
        if (wr == 1) PG8_BAR;
        PG8_WAIT_V(2); PG8_BAR;
        PG8_STAGE(PG8_SB(1, 0), cB + kstep, voffB); PG8_STAGE(PG8_SA(1, 0), cA + kstep, voffA); PG8_STAGE(PG8_SB(1, 1), cB + hstep + kstep, voffB);
        PG8_WAIT_V(6); PG8_BAR;
    } else {
        PG8_STAGE(PG8_SB(0, 0), cB, voffB); PG8_STAGE(PG8_SA(0, 0), cA, voffA); PG8_STAGE(PG8_SB(0, 1), cB + hstep, voffB); PG8_STAGE(PG8_SA(0, 1), cA + hstep, voffA);
        if (wr == 1) PG8_BAR;
        PG8_WAIT_V(4); PG8_BAR;
        PG8_STAGE(PG8_SB(1, 0), cB + kstep, voffB); PG8_STAGE(PG8_SA(1, 0), cA + kstep, voffA); PG8_STAGE(PG8_SB(1, 1), cB + hstep + kstep, voffB);
        PG8_WAIT_V(6); PG8_BAR;
    }
    for (;;) {
        const bool has_next = S.next(ui + 1, nxt);
        const char* nA = has_next ? (const char*)g.A + (size_t)nxt.pm * tstep : cA; const char* nB = has_next ? (const char*)g.Bt + (size_t)nxt.pn * tstep : cB;
#pragma nounroll
        for (int t = 0; t < nt; t += 2) {
            const bool last = (t == nt - 2);
            if constexpr (Epi::MID_T > 0) { if (t == Epi::MID_T) E.mid(acc, cur, wr, wc); }
            const char* a1 = cA + (size_t)(t + 1) * kstep;
            const char* a2 = last ? nA : cA + (size_t)(t + 2) * kstep; const char* b2 = last ? nB : cB + (size_t)(t + 2) * kstep;
            const char* a3 = a2 + kstep; const char* b3 = b2 + kstep;
            if (last && has_next) S.a_ready(nxt);
            if constexpr (SP2) {
            PG8_LDB(B0, 0, 0); PG8_LDB(B1, 0, 1); PG8_SCHED; PG8_LDA(At, 0, 0); PG8_STAGE(PG8_SA(1, 1), a1 + hstep, voffA);
            PG8_WAIT_V(8); PG8_WAIT_L(0); PG8_BAR; PG8_MMA(0, 0, At, B0); PG8_MMA(0, 1, At, B1); PG8_BAR; PG8_SCHED;
            PG8_LDA(At, 0, 1); PG8_STAGE(PG8_SB(0, 0), b2, voffB); PG8_STAGE(PG8_SB(0, 1), b2 + hstep, voffB); PG8_STAGE(PG8_SA(0, 0), a2, voffA);
            PG8_WAIT_V(8); PG8_WAIT_L(0); PG8_BAR; PG8_MMA(1, 0, At, B0); PG8_MMA(1, 1, At, B1); PG8_BAR; PG8_SCHED;
            PG8_LDB(B0, 1, 0); PG8_LDB(B1, 1, 1); PG8_SCHED; PG8_LDA(At, 1, 0); PG8_STAGE(PG8_SA(0, 1), a2 + hstep, voffA);
            PG8_WAIT_V(8); PG8_WAIT_L(0); PG8_BAR; PG8_MMA(0, 0, At, B0); PG8_MMA(0, 1, At, B1); PG8_BAR; PG8_SCHED;
            PG8_LDA(At, 1, 1); PG8_STAGE(PG8_SB(1, 0), b3, voffB); PG8_STAGE(PG8_SB(1, 1), b3 + hstep, voffB); PG8_STAGE(PG8_SA(1, 0), a3, voffA);
            PG8_WAIT_V(8); PG8_WAIT_L(0); PG8_BAR; PG8_MMA(1, 0, At, B0); PG8_MMA(1, 1, At, B1); PG8_BAR; PG8_SCHED;
            } else {
            PG8_LDB(B0, 0, 0); PG8_SCHED; PG8_LDA(At, 0, 0); PG8_STAGE(PG8_SA(1, 1), a1 + hstep, voffA);
            PG8_WAIT_L(8); PG8_BAR; PG8_WAIT_L(0); PG8_MMA(0, 0, At, B0); PG8_BAR; PG8_SCHED;
            PG8_LDB(B1, 0, 1); PG8_STAGE(PG8_SB(0, 0), b2, voffB);
            PG8_BAR; PG8_WAIT_L(0); PG8_MMA(0, 1, At, B1); PG8_BAR;
            PG8_LDA(At, 0, 1); PG8_STAGE(PG8_SA(0, 0), a2, voffA);
            PG8_BAR; PG8_WAIT_L(0); PG8_MMA(1, 0, At, B0); PG8_BAR; PG8_SCHED;
            PG8_STAGE(PG8_SB(0, 1), b2 + hstep, voffB);
            PG8_WAIT_V(6); PG8_BAR; PG8_MMA(1, 1, At, B1); PG8_BAR;
            PG8_LDB(B0, 1, 0); PG8_SCHED; PG8_LDA(At, 1, 0); PG8_STAGE(PG8_SA(0, 1), a2 + hstep, voffA);
            PG8_WAIT_L(8); PG8_BAR; PG8_WAIT_L(0); PG8_MMA(0, 0, At, B0); PG8_BAR; PG8_SCHED;
            PG8_LDB(B1, 1, 1); PG8_STAGE(PG8_SB(1, 0), b3, voffB);
            PG8_BAR; PG8_WAIT_L(0); PG8_MMA(0, 1, At, B1); PG8_BAR;
            PG8_LDA(At, 1, 1); PG8_STAGE(PG8_SA(1, 0), a3, voffA);
            PG8_BAR; PG8_WAIT_L(0); PG8_MMA(1, 0, At, B0); PG8_BAR; PG8_SCHED;
            PG8_STAGE(PG8_SB(1, 1), b3 + hstep, voffB);
            PG8_WAIT_V(6); PG8_BAR; PG8_MMA(1, 1, At, B1); PG8_BAR;
            }
        }
        if constexpr (ALIGN_EPI) { if (wr == 0) PG8_BAR; }
        if constexpr (!Epi::AFTER_DRAIN) { E(acc, cur, wr, wc, fr, fq); S.done(cur); }
        if (!has_next) break;
#pragma unroll
        for (int a = 0; a < 2; ++a)
#pragma unroll
            for (int b = 0; b < 2; ++b)
#pragma unroll
                for (int m = 0; m < 4; ++m)
#pragma unroll
                    for (int n = 0; n < 2; ++n) acc[a][b][m][n] = (f32x4){0.f, 0.f, 0.f, 0.f};
        cur = nxt; cA = nA; cB = nB; ++ui;
        if constexpr (ALIGN_EPI) { if (wr == 1) PG8_BAR; }
    }
    PG8_WAIT_V(0);
    if constexpr (!ALIGN_EPI) { if (wr == 0) PG8_BAR; }
    PG8_BAR;
    if constexpr (Epi::AFTER_DRAIN) { E.fused(acc, cur, wr, wc, fr, fq, lds, wid, lane); S.done(cur); }
#undef PG8_SA
#undef PG8_SB
#undef PG8_STAGE
#undef PG8_LDA
#undef PG8_LDB
#undef PG8_MMA
#undef PG8_WAIT_V
#undef PG8_WAIT_L
#undef PG8_BAR
#undef PG8_SCHED
}
typedef _Float16 h8v __attribute__((ext_vector_type(8)));
typedef unsigned u32x2 __attribute__((ext_vector_type(2)));
typedef _Float16 h2v __attribute__((ext_vector_type(2)));
__device__ __forceinline__ unsigned pk_h2(float lo, float hi) { h2v v; v[0] = (_Float16)lo; v[1] = (_Float16)hi; return __builtin_bit_cast(unsigned, v); }
__device__ __forceinline__ u32x4 pack8(const f32x4& a, const f32x4& b) { u32x4 w; w.x = pk_h2(a[0], a[1]); w.y = pk_h2(a[2], a[3]); w.z = pk_h2(b[0], b[1]); w.w = pk_h2(b[2], b[3]); return w; }
__device__ __forceinline__ float sigm1(float v) { return __builtin_amdgcn_rcpf(1.f + __builtin_amdgcn_exp2f(v * -1.4426950408889634f)); }
__device__ __forceinline__ float silu1(float v) { return v * sigm1(v); }
__device__ __forceinline__ f32x4 silu4(const f32x4& v) { return (f32x4){silu1(v[0]), silu1(v[1]), silu1(v[2]), silu1(v[3])}; }
__device__ __forceinline__ f32x4 sigm4(const f32x4& v) { return (f32x4){sigm1(v[0]), sigm1(v[1]), sigm1(v[2]), sigm1(v[3])}; }

#define PG8_OPAQUE(fr_, fq_) int lane_x; asm volatile("v_mbcnt_lo_u32_b32 %0, -1, 0\n\tv_mbcnt_hi_u32_b32 %0, -1, %0" : "=v"(lane_x)); const int frx = lane_x & 15, fqx = lane_x >> 4
__device__ __forceinline__ void st16(unsigned char* base, unsigned off, const u32x4& v) { *(u32x4*)(base + off) = v; }
__device__ __forceinline__ f32x4 ld16f(const unsigned char* base, unsigned off) { return *(const f32x4*)(base + off); }
__device__ __forceinline__ float ld4f(const unsigned char* base, unsigned off) { return *(const float*)(base + off); }
__device__ __forceinline__ h8v ld16h(const unsigned char* base, unsigned off) { return *(const h8v*)(base + off); }
__device__ __forceinline__ float sumsq8(const f32x4& a, const f32x4& b) { return (a[0] * a[0] + a[1] * a[1]) + (a[2] * a[2] + a[3] * a[3]) + (b[0] * b[0] + b[1] * b[1]) + (b[2] * b[2] + b[3] * b[3]); }
__device__ __forceinline__ void rope4(const f32x4& t1, const f32x4& t2, const u32x4& cs, f32x4& o1, f32x4& o2) {
#pragma unroll
    for (int j = 0; j < 4; ++j) { const unsigned wj = cs[j]; h2v w; __builtin_memcpy(&w, &wj, 4);
        const float c = (float)w[0], s = (float)w[1]; o1[j] = t1[j] * c - t2[j] * s; o2[j] = t2[j] * c + t1[j] * s; }
}
__device__ __forceinline__ u32x4 ld16u(const unsigned char* base, unsigned off) { return *(const u32x4*)(base + off); }

struct EpiInF {
    static constexpr bool PERM = true, AFTER_DRAIN = false; static constexpr int MID_T = 0;
    unsigned char* ws; const float* b_merge; int noatomic;
    template <bool ISQ> __device__ __forceinline__ void rope_tile(const f32x4 (&acc)[2][2][4][2], const Unit& u, int wr, int wc, int frx, int fqx) const {
        const int pn = u.pn; const unsigned row0 = (unsigned)(u.pm * 256 + wr * 64) + (unsigned)frx; const float sc = ISQ ? SC_MB : 1.f;
        unsigned char* dst = ws + (ISQ ? WS_QMB : WS_KMB); const unsigned char* tab = ws + WS_TAB;
        const unsigned o0 = row0 * 1024u + (((pn & 1) ? 256u : 0u) + 64u * wc + 8u * fqx) * 2u, t0 = row0 * 128u + 32u * fqx;
        f32x4 c1[2] = {{0.f, 0.f, 0.f, 0.f}, {0.f, 0.f, 0.f, 0.f}}, c2[2] = {{0.f, 0.f, 0.f, 0.f}, {0.f, 0.f, 0.f, 0.f}};
        u32x4 cs[2][4][2];
#pragma unroll
        for (int ai = 0; ai < 2; ++ai)
#pragma unroll
            for (int m = 0; m < 4; ++m) { const unsigned to = t0 + (unsigned)(ai * 128 + m * 16) * 128u; cs[ai][m][0] = ld16u(tab, to); cs[ai][m][1] = ld16u(tab, to + 16u); }
#pragma unroll
        for (int ai = 0; ai < 2; ++ai)
#pragma unroll
            for (int m = 0; m < 4; ++m) { const unsigned ro = o0 + (unsigned)(ai * 128 + m * 16) * 1024u;
                f32x4 o1[2], o2[2];
#pragma unroll
                for (int n = 0; n < 2; ++n) { rope4(acc[ai][0][m][n], acc[ai][1][m][n], cs[ai][m][n], o1[n], o2[n]);
                    if (!ISQ) { c1[n] += o1[n]; c2[n] += o2[n]; } }
                st16(dst, ro, pack8(o1[0] * sc, o1[1] * sc)); st16(dst, ro + 64u, pack8(o2[0] * sc, o2[1] * sc));
                if (!ISQ) asm volatile("" : "+v"(c1[0]), "+v"(c1[1]), "+v"(c2[0]), "+v"(c2[1])); }
        if (!ISQ) {
            float* km = (float*)(ws + WS_KMEAN) + (size_t)u.pm * 512 + ((pn & 1) ? 256 : 0) + 64 * wc + 8 * fqx;
#pragma unroll
            for (int n = 0; n < 2; ++n)
#pragma unroll
                for (int j = 0; j < 4; ++j) { float a = c1[n][j], b = c2[n][j];
#pragma unroll
                    for (int o = 1; o < 16; o <<= 1) { a += __shfl_xor(a, o); b += __shfl_xor(b, o); }
                    if (frx == 0 && !noatomic) { atomicAdd(km + 4 * n + j, a * (1.f / 256.f)); atomicAdd(km + 32 + 4 * n + j, b * (1.f / 256.f)); } }
        }
    }
    __device__ __forceinline__ void operator()(const f32x4 (&acc)[2][2][4][2], const Unit& u, int wr, int wc, int fr, int fq) const {
        PG8_OPAQUE(fr, fq);
        const int pn = u.pn; const unsigned row0 = (unsigned)(u.pm * 256 + wr * 64) + (unsigned)frx, cl = 32u * wc + 8u * fqx;
        if (pn == 0) {
            unsigned char* dst = ws + WS_QLAT; float* ssq = (float*)(ws + WS_SSQ); const unsigned o0 = row0 * 512u + cl * 2u;
#pragma unroll
            for (int ai = 0; ai < 2; ++ai)
#pragma unroll
                for (int m = 0; m < 4; ++m) { const unsigned ro = o0 + (unsigned)(ai * 128 + m * 16) * 512u; float s = 0.f;
#pragma unroll
                    for (int bj = 0; bj < 2; ++bj) { s += sumsq8(acc[ai][bj][m][0], acc[ai][bj][m][1]); st16(dst, ro + bj * 256u, pack8(acc[ai][bj][m][0], acc[ai][bj][m][1])); }
                    s += __shfl_xor(s, 16); s += __shfl_xor(s, 32);
                    if (fqx == 0 && !noatomic) atomicAdd(ssq + (row0 + ai * 128 + m * 16), s); }
        } else if (pn == 1) {
            unsigned char* kvl = ws + WS_KVL; unsigned char* kpe = ws + WS_KPE; float* ssq = (float*)(ws + WS_SSQ) + M_; const unsigned char* tab = ws + WS_TAB;
#pragma unroll
            for (int ai = 0; ai < 2; ++ai)
#pragma unroll
                for (int m = 0; m < 4; ++m) { const unsigned row = row0 + ai * 128 + m * 16;
                    if (wc < 2) { float s = 0.f;
#pragma unroll
                        for (int bj = 0; bj < 2; ++bj) { s += sumsq8(acc[ai][bj][m][0], acc[ai][bj][m][1]); st16(kvl, row * 256u + (bj * 64u + cl) * 2u, pack8(acc[ai][bj][m][0], acc[ai][bj][m][1])); }
                        s += __shfl_xor(s, 16); s += __shfl_xor(s, 32);
                        if (fqx == 0 && !noatomic) atomicAdd(ssq + row, s);
                    } else {
                        if (wc == 2 && fqx < 2) {
                            f32x4 o1[2], o2[2];
#pragma unroll
                            for (int n = 0; n < 2; ++n) { const unsigned to = row * 128u + (unsigned)(16 * fqx + 8 * n) * 4u; const u32x4 wa = ld16u(tab, to), wb = ld16u(tab, to + 16u);
                                rope4(acc[ai][0][m][n], acc[ai][1][m][n], (u32x4){wa[0], wa[2], wb[0], wb[2]}, o1[n], o2[n]); }
                            st16(kpe, row * 64u + 16u * fqx, pack8(o1[0], o1[1])); st16(kpe, row * 64u + 32u + 16u * fqx, pack8(o2[0], o2[1]));
                        }
                    }
                    asm volatile("" ::: "memory"); }
        } else if (pn < 4 || (pn >= 8 && pn < 12)) {
            const bool act = (pn < 4) || (pn >= 10); const unsigned pitch = act ? 2048u : 1024u;
            unsigned char* dst = ws + (act ? WS_ZCAT : WS_VMB); const unsigned o0 = row0 * pitch + ((pn >= 10 ? 512u : 0u) + ((pn & 1) ? 256u : 0u) + cl) * 2u;
#pragma unroll
            for (int ai = 0; ai < 2; ++ai)
#pragma unroll
                for (int m = 0; m < 4; ++m) { const unsigned ro = o0 + (unsigned)(ai * 128 + m * 16) * pitch;
#pragma unroll
                    for (int bj = 0; bj < 2; ++bj) { f32x4 a = acc[ai][bj][m][0], b = acc[ai][bj][m][1]; if (act) { a = silu4(a); b = silu4(b); }
                        st16(dst, ro + bj * 256u, pack8(a, b)); } }
        } else if (pn < 6) { rope_tile<true>(acc, u, wr, wc, frx, fqx);
        } else if (pn < 8) { rope_tile<false>(acc, u, wr, wc, frx, fqx);
        } else {
            const bool isa = pn < 16; unsigned char* dst = ws + (isa ? WS_GA : WS_GB); const unsigned cg = 256u * ((pn - 12) & 3) + cl;
            const unsigned char* bm = (const unsigned char*)(b_merge + (isa ? 0 : 1024)); const unsigned o0 = row0 * 1024u + cg;
            f32x4 bv[2][2];
#pragma unroll
            for (int bj = 0; bj < 2; ++bj)
#pragma unroll
                for (int n = 0; n < 2; ++n) bv[bj][n] = ld16f(bm, (cg + bj * 128u + 4u * n) * 4u);
#pragma unroll
            for (int ai = 0; ai < 2; ++ai)
#pragma unroll
                for (int m = 0; m < 4; ++m) { const unsigned ro = o0 + (unsigned)(ai * 128 + m * 16) * 1024u;
#pragma unroll
                    for (int bj = 0; bj < 2; ++bj) { const f32x4 a = sigm4(acc[ai][bj][m][0] + bv[bj][0]) * 255.f + 0.5f, b = sigm4(acc[ai][bj][m][1] + bv[bj][1]) * 255.f + 0.5f;
                        u32x2 w; w.x = (unsigned)a[0] | ((unsigned)a[1] << 8) | ((unsigned)a[2] << 16) | ((unsigned)a[3] << 24); w.y = (unsigned)b[0] | ((unsigned)b[1] << 8) | ((unsigned)b[2] << 16) | ((unsigned)b[3] << 24);
                        *(u32x2*)(dst + (ro + bj * 128u)) = w; } }
        }
    }
};
struct EpiNull {
    static constexpr bool PERM = true, AFTER_DRAIN = false; static constexpr int MID_T = 0;
    __device__ __forceinline__ void operator()(const f32x4 (&acc)[2][2][4][2], const Unit& u, int wr, int wc, int fr, int fq) const {
#pragma unroll
        for (int ai = 0; ai < 2; ++ai)
#pragma unroll
            for (int bj = 0; bj < 2; ++bj)
#pragma unroll
                for (int m = 0; m < 4; ++m) asm volatile("" :: "v"(acc[ai][bj][m][0]), "v"(acc[ai][bj][m][1]));
    }
};
struct EpiUqF {
    static constexpr bool PERM = true, AFTER_DRAIN = false; static constexpr int MID_T = 0;
    unsigned char* ws;
    __device__ __forceinline__ void operator()(const f32x4 (&acc)[2][2][4][2], const Unit& u, int wr, int wc, int fr, int fq) const {
        PG8_OPAQUE(fr, fq);
        const int pn = u.pn; const unsigned row0 = (unsigned)(u.pm * 256 + wr * 64) + (unsigned)frx; unsigned char* Q = ws + WS_QMLA; const unsigned char* ssq = ws + WS_SSQ; const unsigned char* tab = ws + WS_TAB;
        float rsv[2][4];
#pragma unroll
        for (int ai = 0; ai < 2; ++ai)
#pragma unroll
            for (int m = 0; m < 4; ++m) rsv[ai][m] = ld4f(ssq, (row0 + ai * 128 + m * 16) * 4u);
#pragma unroll
        for (int ai = 0; ai < 2; ++ai)
#pragma unroll
            for (int m = 0; m < 4; ++m) { const unsigned row = row0 + ai * 128 + m * 16; const float rs = SC_MLA * __builtin_amdgcn_rsqf(rsv[ai][m] * (1.f / 256.f) + EPS);
                if (pn < 2) {
#pragma unroll
                    for (int bj = 0; bj < 2; ++bj) { const unsigned head = 4u * pn + 2u * bj + (wc >> 1), d = 32u * (wc & 1) + 8u * fqx;
                        st16(Q, row * 1536u + (96u * head + d) * 2u, pack8(acc[ai][bj][m][0] * rs, acc[ai][bj][m][1] * rs)); }
                } else { const unsigned head = 2u * wc + ((unsigned)fqx >> 1), i0 = 8u * (fqx & 1); f32x4 o1[2], o2[2];
#pragma unroll
                    for (int n = 0; n < 2; ++n) { const unsigned to = row * 128u + (2u * (i0 + 4u * n)) * 4u; const u32x4 wa = ld16u(tab, to), wb = ld16u(tab, to + 16u);
                        rope4(acc[ai][0][m][n] * rs, acc[ai][1][m][n] * rs, (u32x4){wa[0], wa[2], wb[0], wb[2]}, o1[n], o2[n]); }
                    st16(Q, row * 1536u + (96u * head + 64u + i0) * 2u, pack8(o1[0], o1[1])); st16(Q, row * 1536u + (96u * head + 80u + i0) * 2u, pack8(o2[0], o2[1])); } }
    }
};
struct EpiUkvF {
    static constexpr bool PERM = true, AFTER_DRAIN = false; static constexpr int MID_T = 0;
    unsigned char* ws;
    __device__ __forceinline__ void operator()(const f32x4 (&acc)[2][2][4][2], const Unit& u, int wr, int wc, int fr, int fq) const {
        PG8_OPAQUE(fr, fq);
        const int pn = u.pn; const unsigned row0 = (unsigned)(u.pm * 256 + wr * 64) + (unsigned)frx; unsigned char* dst = ws + (pn < 2 ? WS_KN : WS_VM); const unsigned char* ssq = ws + WS_SSQ + (size_t)M_ * 4;
        float rsv[2][4];
#pragma unroll
        for (int ai = 0; ai < 2; ++ai)
#pragma unroll
            for (int m = 0; m < 4; ++m) rsv[ai][m] = ld4f(ssq, (row0 + ai * 128 + m * 16) * 4u);
#pragma unroll
        for (int ai = 0; ai < 2; ++ai)
#pragma unroll
            for (int m = 0; m < 4; ++m) { const unsigned row = row0 + ai * 128 + m * 16; const float rs = __builtin_amdgcn_rsqf(rsv[ai][m] * (1.f / 128.f) + EPS);
#pragma unroll
                for (int bj = 0; bj < 2; ++bj) { const unsigned head = 4u * (pn & 1) + 2u * bj + (wc >> 1), d = 32u * (wc & 1) + 8u * fqx;
                    st16(dst, row * 1024u + (64u * head + d) * 2u, pack8(acc[ai][bj][m][0] * rs, acc[ai][bj][m][1] * rs)); } }
    }
};
struct EpiYcatF {
    static constexpr bool PERM = true, AFTER_DRAIN = false; static constexpr int MID_T = 8;
    unsigned char* ws;
    template <bool MID> __device__ __forceinline__ void run(f32x4 (&acc)[2][2][4][2], const Unit& u, int wr, int wc) const {
        PG8_OPAQUE(0, 0);
        const unsigned row0 = (unsigned)(u.pm * 256 + wr * 64) + (unsigned)frx, c0 = u.pn * 256u + 32u * wc + 8u * fqx, o0 = row0 * 2048u + c0 * 2u, g0 = row0 * 1024u + c0;
        const unsigned char* GA = ws + WS_GA; const unsigned char* GB = ws + WS_GB; unsigned char* YM = ws + WS_YM;
#pragma unroll
        for (int ai = 0; ai < 2; ++ai) {
            u32x2 ga[4][2], gb[4][2];
#pragma unroll
            for (int m = 0; m < 4; ++m)
#pragma unroll
                for (int bj = 0; bj < 2; ++bj) { const unsigned go = g0 + (unsigned)(ai * 128 + m * 16) * 1024u + bj * 128u; gb[m][bj] = *(const u32x2*)(GB + go); if (MID) ga[m][bj] = *(const u32x2*)(GA + go); }
#pragma unroll
            for (int m = 0; m < 4; ++m)
#pragma unroll
                for (int bj = 0; bj < 2; ++bj) { const unsigned off = o0 + (unsigned)(ai * 128 + m * 16) * 2048u + bj * 256u; f32x4 s0, s1;
#pragma unroll
                    for (int j = 0; j < 4; ++j) { const float b0 = fmaxf((float)((gb[m][bj].x >> (8 * j)) & 0xffu), 0.5f), b1 = fmaxf((float)((gb[m][bj].y >> (8 * j)) & 0xffu), 0.5f);
                        s0[j] = MID ? (float)((ga[m][bj].x >> (8 * j)) & 0xffu) * __builtin_amdgcn_rcpf(b0) : b0 * (1.f / 255.f);
                        s1[j] = MID ? (float)((ga[m][bj].y >> (8 * j)) & 0xffu) * __builtin_amdgcn_rcpf(b1) : b1 * (1.f / 255.f); }
                    acc[ai][bj][m][0] *= s0; acc[ai][bj][m][1] *= s1;
                    if (!MID) st16(YM, off, pack8(acc[ai][bj][m][0], acc[ai][bj][m][1])); }
            asm volatile("" ::: "memory"); }
    }
    __device__ __forceinline__ void mid(f32x4 (&acc)[2][2][4][2], const Unit& u, int wr, int wc) const { run<true>(acc, u, wr, wc); }
    __device__ __forceinline__ void operator()(f32x4 (&acc)[2][2][4][2], const Unit& u, int wr, int wc, int fr, int fq) const { run<false>(acc, u, wr, wc); }
};
struct EpiYF {
    static constexpr bool PERM = true, AFTER_DRAIN = false; static constexpr int MID_T = 0;
    unsigned char* ws;
    __device__ __forceinline__ void operator()(const f32x4 (&acc)[2][2][4][2], const Unit& u, int wr, int wc, int fr, int fq) const {
        PG8_OPAQUE(fr, fq);
        const unsigned row0 = (unsigned)(u.pm * 256 + wr * 64) + (unsigned)frx, c0 = u.pn * 256u + 32u * wc + 8u * fqx, o0 = row0 * 2048u + c0 * 2u; unsigned char* Y = ws + WS_Y; float* ssq = (float*)(ws + WS_SSQY);
#pragma unroll
        for (int ai = 0; ai < 2; ++ai)
#pragma unroll
            for (int m = 0; m < 4; ++m) { float s = 0.f;
#pragma unroll
                for (int bj = 0; bj < 2; ++bj) { s += sumsq8(acc[ai][bj][m][0], acc[ai][bj][m][1]); st16(Y, o0 + (unsigned)(ai * 128 + m * 16) * 2048u + bj * 256u, pack8(acc[ai][bj][m][0], acc[ai][bj][m][1])); }
                s += __shfl_xor(s, 16); s += __shfl_xor(s, 32);
                if (fqx == 0) atomicAdd(ssq + (row0 + ai * 128 + m * 16), s); }
    }
};
}

struct MapIn { __device__ int operator()(int n) const { const int t = n >> 8, tc = n & 255, bj = tc >> 7, uu = tc & 127;
    if (t == 0) return n;
    if (t == 1) return uu < 64 ? C_KVLAT + 64 * bj + uu : (uu < 80 ? C_KROPE + 16 * bj + (uu - 64) : -1);
    if (t < 4) return C_ZMLA + (n - 512);
    if (t < 8) return (t < 6 ? C_QMB : C_KMB) + 256 * (t & 1) + 64 * (uu >> 5) + 32 * bj + (uu & 31);
    if (t < 10) return C_VMB + (n - 2048);
    if (t < 12) return C_ZMB + (n - 2560);
    if (t < 16) return C_GA + (n - 3072);
    return C_GB + (n - 4096); } };
struct MapUq { __device__ int operator()(int n) const { const int t = n >> 8, tc = n & 255, bj = tc >> 7, uu = tc & 127;
    if (t < 2) return 96 * (4 * t + (tc >> 6)) + (tc & 63);
    return 96 * (uu >> 4) + 64 + 16 * bj + (uu & 15); } };
struct MapUkv { __device__ int operator()(int n) const { const int t = n >> 8, tc = n & 255; return 128 * (4 * (t & 1) + (tc >> 6)) + (t < 2 ? 0 : 64) + (tc & 63); } };
struct MapId { __device__ int operator()(int n) const { return n; } };
template <class Map> __device__ __forceinline__ void wt_items(const float* W, int ldw, int Kreal, int K, int N, unsigned short* WT, const float* kscale, Map map, LAS float* scr, int gw, int ngw, int lane, int ldk = 0, int koff = 0) {
    if (ldk == 0) ldk = K;
    const int nblk = N / 64, nitems = (K / 32) * nblk; typedef float f4 __attribute__((ext_vector_type(4)));
    for (int it = gw; it < nitems; it += ngw) {
        const int kb = it / nblk, nb = it % nblk, k0 = 32 * kb, n0 = 64 * nb; const int src = map(n0 + 4 * (lane & 15));
        f4 wv[8];
#pragma unroll
        for (int i = 0; i < 8; ++i) { const int k = k0 + 4 * i + (lane >> 4); wv[i] = (src >= 0 && k < Kreal) ? *(const f4*)(W + (size_t)k * ldw + src) : (f4){0.f, 0.f, 0.f, 0.f}; }
#pragma unroll
        for (int i = 0; i < 8; ++i) { const int kk = 4 * i + (lane >> 4), k = k0 + kk; f4 v = wv[i]; if (kscale && k < Kreal) v = v * kscale[k]; *(LAS f4*)(scr + kk * 68 + 4 * (lane & 15)) = v; }
        asm volatile("s_waitcnt lgkmcnt(0)" ::: "memory");
#pragma unroll
        for (int j = 0; j < 4; ++j) { const int q = lane + 64 * j, n = q >> 2, c = q & 3; const LAS float* s = scr + (8 * c) * 68 + n;
            pg8::u32x4 o; o.x = pg8::pk_h2(s[0 * 68], s[1 * 68]); o.y = pg8::pk_h2(s[2 * 68], s[3 * 68]); o.z = pg8::pk_h2(s[4 * 68], s[5 * 68]); o.w = pg8::pk_h2(s[6 * 68], s[7 * 68]);
            *(pg8::u32x4*)(WT + (size_t)(n0 + n) * ldk + koff + k0 + 8 * c) = o; }
        asm volatile("s_waitcnt lgkmcnt(0)" ::: "memory");
    }
}
constexpr size_t WT_IN = WS_WT, WT_UQ = WS_WT + 10 * MiB, WT_UKV = WT_UQ + 512 * 1024, WT_OA = WS_WT + 11 * MiB, WT_OB = WS_WT + 12 * MiB, WT_OUT = WS_WT + 13 * MiB;
__device__ __forceinline__ void ph_weights(const Params& p, LAS unsigned char* lds, int gw, int ngw, int wave, int lane) {
    LAS float* scr = (LAS float*)(lds + wave * 16384);
    wt_items(p.w_in, D_IN, 1024, 1024, 5120, (unsigned short*)(p.ws + WT_IN), nullptr, MapIn(), scr, gw, ngw, lane);
    wt_items(p.w_uq, 768, 256, 256, 768, (unsigned short*)(p.ws + WT_UQ), p.g_q, MapUq(), scr, gw, ngw, lane);
    wt_items(p.w_ukv, 1024, 128, 128, 1024, (unsigned short*)(p.ws + WT_UKV), p.g_kv, MapUkv(), scr, gw, ngw, lane);
    wt_items(p.w_o_mla, 1024, 512, 512, 1024, (unsigned short*)(p.ws + WT_OA), nullptr, MapId(), scr, gw, ngw, lane, 1024, 0);
    wt_items(p.w_o_moba, 1024, 512, 512, 1024, (unsigned short*)(p.ws + WT_OA), nullptr, MapId(), scr, gw, ngw, lane, 1024, 512);
    wt_items(p.w_out, 1024, 1024, 1024, 1024, (unsigned short*)(p.ws + WT_OUT), nullptr, MapId(), scr, gw, ngw, lane);
}

namespace att {
struct T1 { static constexpr bool value = true; }; struct T0 { static constexpr bool value = false; };
typedef _Float16 h8 __attribute__((ext_vector_type(8)));
typedef short s4 __attribute__((ext_vector_type(4)));
typedef short s8 __attribute__((ext_vector_type(8)));
typedef float f16v __attribute__((ext_vector_type(16)));
typedef float f2v __attribute__((ext_vector_type(2)));
typedef unsigned u4 __attribute__((ext_vector_type(4)));
typedef short v4i16_t __attribute__((ext_vector_type(4)));
constexpr int KBUF = 16384, VBUF = 8192;
constexpr int NBUF = 4;
constexpr int L_K = 0, L_V = NBUF * KBUF, L_WS = L_V + NBUF * VBUF, L_TB = L_WS + 8 * 256, L_UN = L_TB + 256, L_END = L_UN + 64, L_OST = 0;
constexpr float THR = 8.f;
#ifndef PROBE_ABL
#define PROBE_ABL 0
#endif
#ifndef ATT_STAGGER
#define ATT_STAGGER 0
#endif
constexpr bool STAGGER = ATT_STAGGER;
__device__ __forceinline__ int crow(int r, int hi) { return (r & 3) + 8 * (r >> 2) + 4 * hi; }
template <int DK> __device__ __forceinline__ int kaddr(int row, int ch) { return DK == 64 ? row * 128 + ((ch ^ ((row >> 1) & 7)) << 4) : row * 256 + ((ch ^ (row & 15)) << 4); }
__device__ __forceinline__ s4 vtr(const LAS unsigned char* p) { return __builtin_bit_cast(s4, __builtin_amdgcn_ds_read_tr16_b64_v4i16((LAS v4i16_t*)p)); }
__device__ __forceinline__ float swapmax(float m) { auto rr = __builtin_amdgcn_permlane32_swap(__float_as_uint(m), __float_as_uint(m), false, false); return fmaxf(__uint_as_float(rr[0]), __uint_as_float(rr[1])); }
__device__ __forceinline__ float swapsum(float m) { auto rr = __builtin_amdgcn_permlane32_swap(__float_as_uint(m), __float_as_uint(m), false, false); return __uint_as_float(rr[0]) + __uint_as_float(rr[1]); }
__device__ __forceinline__ void glds16(const void* g, unsigned lds_base) { unsigned sv;
    asm volatile("s_mov_b32 %0, m0\n\ts_mov_b32 m0, %2\n\ts_nop 0\n\tglobal_load_lds_dwordx4 %1, off\n\ts_mov_b32 m0, %0" : "=&s"(sv) : "v"(g), "s"(lds_base) : "memory"); }
__device__ __forceinline__ float max3f(float a, float b, float c) { float r; asm("v_max3_f32 %0, %1, %2, %3" : "=v"(r) : "v"(a), "v"(b), "v"(c)); return r; }
__device__ __forceinline__ unsigned pkh(float lo, float hi) { typedef _Float16 h2 __attribute__((ext_vector_type(2))); h2 v; v[0] = (_Float16)lo; v[1] = (_Float16)hi; return __builtin_bit_cast(unsigned, v); }

template <int DK, bool MOBA, int ABL = 0, bool OWN = false>
__device__ __forceinline__ void attn_unit(unsigned char* ws, int b, int h, int qb, LAS unsigned char* lds, bool dry = false) {
    constexpr int ND = DK / 16, QP = MOBA ? 512 : 768, QH = MOBA ? 64 : 96;
    int tid_ = threadIdx.x; asm volatile("" : "+v"(tid_));
    const int tid = tid_, lane = tid & 63, r32 = lane & 31, hi = lane >> 5; const int wid = __builtin_amdgcn_readfirstlane(tid >> 6);
    const _Float16* Qg = (const _Float16*)(ws + (MOBA ? WS_QMB : WS_QMLA)); const _Float16* Kg = (const _Float16*)(ws + (MOBA ? WS_KMB : WS_KN));
    const _Float16* Vg = (const _Float16*)(ws + (MOBA ? WS_VMB : WS_VM)); const _Float16* Pg = (const _Float16*)(ws + WS_KPE); _Float16* Zg = (_Float16*)(ws + WS_ZCAT) + (MOBA ? 512 : 0);
    const size_t rowbase = (size_t)b * SEQ; const int q0 = qb * 256, qw0 = q0 + wid * 32, qrow = qw0 + r32;
    LAS float* wsf = (LAS float*)(lds + L_WS) + wid * 64; LAS int* tb = (LAS int*)(lds + L_TB); LAS unsigned* un = (LAS unsigned*)(lds + L_UN);
    h8 qr[ND];
#pragma unroll
    for (int d0 = 0; d0 < ND; ++d0) qr[d0] = *(const h8*)(Qg + (rowbase + qrow) * QP + h * QH + d0 * 16 + hi * 8);
#pragma unroll
    for (int d0 = 0; d0 < ND; ++d0) asm volatile("" : "+v"(qr[d0]));
    unsigned sel = 0u, blocks = OWN ? (1u << qb) : (2u << qb) - 1u;
    if (MOBA && !OWN) {
        const float* km = (const float*)(ws + WS_KMEAN) + (size_t)b * 16 * 512 + h * 64 + hi * 8;
        float g0 = -INFINITY, g1 = -INFINITY, g2 = -INFINITY; int i0 = -1, i1 = -1, i2 = -1;
        for (int m = 0; m < qb; ++m) {
            float part = 0.f;
#pragma unroll
            for (int d0 = 0; d0 < 4; ++d0) { const float4 a = *(const float4*)(km + m * 512 + d0 * 16), c = *(const float4*)(km + m * 512 + d0 * 16 + 4);
                part += (float)qr[d0][0] * a.x + (float)qr[d0][1] * a.y + (float)qr[d0][2] * a.z + (float)qr[d0][3] * a.w + (float)qr[d0][4] * c.x + (float)qr[d0][5] * c.y + (float)qr[d0][6] * c.z + (float)qr[d0][7] * c.w; }
            const float g = swapsum(part);
            if (g > g0) { g2 = g1; i2 = i1; g1 = g0; i1 = i0; g0 = g; i0 = m; }
            else if (g > g1) { g2 = g1; i2 = i1; g1 = g; i1 = m; }
            else if (g > g2) { g2 = g; i2 = m; }
        }
        if (i0 >= 0) sel |= 1u << i0; if (i1 >= 0) sel |= 1u << i1; if (i2 >= 0) sel |= 1u << i2;
        unsigned uw = sel;
#pragma unroll
        for (int o = 1; o < 64; o <<= 1) uw |= (unsigned)__shfl_xor((int)uw, o);
        if (lane == 0) un[wid] = uw;
        __syncthreads();
        unsigned ua = 0u;
#pragma unroll
        for (int w = 0; w < 8; ++w) ua |= un[w];
        blocks = (unsigned)__builtin_amdgcn_readfirstlane((int)(ua | (1u << qb)));
    }
    const int NT = OWN ? 4 : 4 * __builtin_popcount(blocks);
    if (tid < 64 && tid < NT) { unsigned bm = blocks; for (int k = 0; k < (tid >> 2); ++k) bm &= bm - 1u; tb[tid] = (__builtin_ctz(bm) << 8) + ((tid & 3) << 6); }
    __syncthreads();
    const unsigned char* kbu = (const unsigned char*)(Kg + rowbase * 512 + h * 64); const unsigned char* vbu = (const unsigned char*)(Vg + rowbase * 512 + h * 64); const unsigned char* pbu = (const unsigned char*)(Pg + rowbase * 32);
    const unsigned char* kb0; const unsigned char* kb1 = nullptr; unsigned ksrc0, ksrc1 = 0u, kst0 = 1024u, kst1 = 1024u;
    if (DK == 96) { const int r0 = 4 * wid + (lane >> 4), r1 = r0 + 32; int c0 = (lane & 15) ^ (r0 & 15), c1 = (lane & 15) ^ (r1 & 15); if (c0 >= 12) c0 -= 4; if (c1 >= 12) c1 -= 4;
        const bool kpe0 = c0 >= 8, kpe1 = c1 >= 8;
        kb0 = kpe0 ? pbu : kbu; kst0 = kpe0 ? 64u : 1024u; ksrc0 = kpe0 ? (unsigned)(r0 * 32 + (c0 - 8) * 8) * 2u : (unsigned)(r0 * 512 + c0 * 8) * 2u;
        kb1 = kpe1 ? pbu : kbu; kst1 = kpe1 ? 64u : 1024u; ksrc1 = kpe1 ? (unsigned)(r1 * 32 + (c1 - 8) * 8) * 2u : (unsigned)(r1 * 512 + c1 * 8) * 2u;
    } else { const int r0 = 8 * wid + (lane >> 3), c0 = (lane & 7) ^ ((r0 >> 1) & 7); kb0 = kbu; ksrc0 = (unsigned)(r0 * 512 + c0 * 8) * 2u; }
    const unsigned vsrc = (unsigned)((16 * (wid & 3) + (lane >> 2)) * 512 + (wid >> 2) * 32 + (lane & 3) * 8) * 2u;
    constexpr int NDMA = (DK == 96) ? 3 : 2;
#define ATT_GLDS(src, dst) glds16((const void*)(src), (unsigned)__builtin_amdgcn_readfirstlane((int)(unsigned)(size_t)(dst)))
#define ATT_DMA(kb, buf) do { const unsigned kb_ = (unsigned)(kb); LAS unsigned char* kd_ = lds + L_K + (buf) * KBUF; \
        ATT_GLDS(kb0 + (ksrc0 + kb_ * kst0), kd_ + wid * 1024); \
        if (DK == 96) ATT_GLDS(kb1 + (ksrc1 + kb_ * kst1), kd_ + 8192 + wid * 1024); \
        ATT_GLDS(vbu + (vsrc + kb_ * 1024u), lds + L_V + (buf) * VBUF + wid * 1024); } while (0)
#define ATT_WAITV(n) asm volatile("s_waitcnt vmcnt(" #n ")" ::: "memory")
#define ATT_BAR() do { asm volatile("s_waitcnt lgkmcnt(0)" ::: "memory"); __builtin_amdgcn_s_barrier(); asm volatile("" ::: "memory"); } while (0)
    const int vro = ((lane >> 4) & 1) * 32 + (lane & 3) * 8 + (4 * hi + ((lane & 15) >> 2)) * 64;
    LAS unsigned char* ldsv = lds + L_V + vro; asm volatile("" : "+v"(ldsv));
    float l_reg = 0.f; bool init = false; f16v o[2]; o[0] = f16v{}; o[1] = f16v{}; f16v negm = f16v{}; asm volatile("" : "+v"(negm));
    constexpr int G = 2 * ND;
#define ATT_SBAR() __builtin_amdgcn_sched_barrier(0)
#define ATT_PIN(x) asm volatile("" : "+v"(x))
#define ATT_KF(buf, g) (*(const LAS h8*)(lds + L_K + (buf) * KBUF + kaddr<DK>(32 * ((g) & 1) + r32, 2 * ((g) >> 1) + hi)))
#define ATT_MF(a, b, c) __builtin_amdgcn_mfma_f32_32x32x16_f16(a, b, c, 0, 0, 0)
#define ATT_QK(P0, P1, buf) do { h8 kf_[G]; _Pragma("unroll") for (int g_ = 0; g_ < G; ++g_) kf_[g_] = ATT_KF(buf, g_); ATT_SBAR(); \
        _Pragma("unroll") for (int d_ = 0; d_ < ND; ++d_) { P0 = ATT_MF(kf_[2 * d_], qr[d_], d_ == 0 ? negm : P0); P1 = ATT_MF(kf_[2 * d_ + 1], qr[d_], d_ == 0 ? negm : P1); } } while (0)
#define ATT_MAXCHAIN(P0, P1, PM) do { float pa_ = max3f(P0[0], P0[1], P1[0]), pb_ = max3f(P0[2], P0[3], P1[1]); pa_ = max3f(pa_, P1[2], P1[3]); \
        _Pragma("unroll") for (int r_ = 4; r_ < 16; r_ += 4) { pa_ = max3f(pa_, P0[r_], P0[r_ + 1]); pb_ = max3f(pb_, P0[r_ + 2], P0[r_ + 3]); pa_ = max3f(pa_, P1[r_], P1[r_ + 1]); pb_ = max3f(pb_, P1[r_ + 2], P1[r_ + 3]); } \
        PM = swapmax(fmaxf(pa_, pb_)); } while (0)
#define ATT_MOVE(P0, P1, PM) do { const bool move_ = init ? ((PM) > THR) : ((PM) > -INFINITY); \
        if (__any(move_)) { const float dl_ = move_ ? (init ? fmaxf((PM), 0.f) : (PM)) : 0.f; const float al_ = (move_ && init) ? __builtin_amdgcn_exp2f(-dl_) : 1.f; \
            init = init || move_; l_reg *= al_; \
            _Pragma("unroll") for (int r_ = 0; r_ < 16; ++r_) { P0[r_] -= dl_; P1[r_] -= dl_; negm[r_] -= dl_; } \
            if (hi == 0) wsf[r32] = al_; asm volatile("s_waitcnt lgkmcnt(0)" ::: "memory"); \
            _Pragma("unroll") for (int r_ = 0; r_ < 16; ++r_) { const float a_ = wsf[crow(r_, hi)]; o[0][r_] *= a_; o[1][r_] *= a_; } } } while (0)
#define ATT_PACK(P0, P1, PW, KEEP) do { _Pragma("unroll") for (int k_ = 0; k_ < 2; ++k_) { \
            PW[k_] = (u4){pkh(P0[8 * k_], P0[8 * k_ + 1]), pkh(P0[8 * k_ + 2], P0[8 * k_ + 3]), pkh(P0[8 * k_ + 4], P0[8 * k_ + 5]), pkh(P0[8 * k_ + 6], P0[8 * k_ + 7])}; \
            PW[2 + k_] = (u4){pkh(P1[8 * k_], P1[8 * k_ + 1]), pkh(P1[8 * k_ + 2], P1[8 * k_ + 3]), pkh(P1[8 * k_ + 4], P1[8 * k_ + 5]), pkh(P1[8 * k_ + 6], P1[8 * k_ + 7])}; } \
        if (MOBA) { _Pragma("unroll") for (int k_ = 0; k_ < 4; ++k_) PW[k_] &= (KEEP); } } while (0)
#define ATT_VF(buf, i) (ldsv + (buf) * VBUF + ((i) >> 2) * 4096 + ((i) & 3) * 1024)
#define ATT_WAIT_NEXT(t_) do { if ((t_) + 3 < NT) { if (NDMA == 3) ATT_WAITV(3); else ATT_WAITV(2); } else ATT_WAITV(0); } while (0)
#define ATT_TB(i) (MOBA ? tb[(i)] : 64 * (i))
    const int NF = OWN ? 0 : NT - 4;
    ATT_DMA(ATT_TB(0), 0); ATT_DMA(ATT_TB(1), 1); ATT_DMA(ATT_TB(2), 2);
    if (NDMA == 3) ATT_WAITV(3); else ATT_WAITV(2);
    ATT_BAR();
    f16v pC0, pC1;
    if (NF > 0) { ATT_QK(pC0, pC1, 0); asm volatile("s_nop 15\n\ts_nop 7" : "+v"(pC0), "+v"(pC1)); float pm; ATT_MAXCHAIN(pC0, pC1, pm);
        if (MOBA && !((sel >> (ATT_TB(0) >> 8)) & 1u)) pm = -INFINITY; ATT_MOVE(pC0, pC1, pm); }
    auto step = [&](f16v& pC0, f16v& pC1, f16v& pN0, f16v& pN1, const int t, auto hn) __attribute__((always_inline)) {
        const int cur = t & 3, nx = (t + 1) & 3; constexpr bool hasn = decltype(hn)::value;
        ATT_DMA(ATT_TB(t + 3), (t + 3) & 3);
        const unsigned keepC = (!MOBA || ((sel >> (ATT_TB(t) >> 8)) & 1u)) ? 0xffffffffu : 0u;
        float ps = 0.f; f2v ps2 = (f2v){0.f, 0.f};
        if (hasn) {
            h8 kf[G];
#pragma unroll
            for (int g = 0; g < 4; ++g) kf[g] = ATT_KF(nx, g);
            ATT_SBAR();
#pragma unroll
            for (int g = 0; g < G; ++g) {
                if (g + 4 < G) kf[g + 4] = ATT_KF(nx, g + 4);
                if (g & 1) pN1 = ATT_MF(kf[g], qr[g >> 1], g == 1 ? negm : pN1); else pN0 = ATT_MF(kf[g], qr[g >> 1], g == 0 ? negm : pN0);
                constexpr int dummy = 0; (void)dummy;
                const int e0 = (ND == 4) ? 4 * g : (g < 8 ? 3 * g : 24 + 2 * (g - 8)), e1 = (ND == 4) ? 4 * g + 4 : (g < 8 ? 3 * g + 3 : 26 + 2 * (g - 8));
#pragma unroll
                for (int e = e0; e < e1; ++e) { if (e < 16) pC0[e] = __builtin_amdgcn_exp2f(pC0[e]); else pC1[e - 16] = __builtin_amdgcn_exp2f(pC1[e - 16]);
                    if (e & 1) { if (e < 16) ps2 += (f2v){pC0[e - 1], pC0[e]}; else ps2 += (f2v){pC1[e - 17], pC1[e - 16]}; } }
                ATT_PIN(pC0); ATT_PIN(pC1); ATT_PIN(ps2); ATT_SBAR();
            }
        } else {
#pragma unroll
            for (int r = 0; r < 16; ++r) { pC0[r] = __builtin_amdgcn_exp2f(pC0[r]); pC1[r] = __builtin_amdgcn_exp2f(pC1[r]); ps += pC0[r] + pC1[r]; }
        }
        ps += ps2[0] + ps2[1];
        if (MOBA && !keepC) ps = 0.f;
        l_reg += swapsum(ps);
        u4 pw[4]; ATT_PACK(pC0, pC1, pw, keepC);
        {
            s4 vlo[8], vhi[8]; float pa = 0.f, pb = 0.f;
#pragma unroll
            for (int i = 0; i < 3; ++i) { vlo[i] = vtr(ATT_VF(cur, i)); vhi[i] = vtr(ATT_VF(cur, i) + 512); }
            if (hasn) asm volatile("s_nop 7" : "+v"(pN0), "+v"(pN1));
            ATT_SBAR();
#pragma unroll
            for (int i = 0; i < 8; ++i) {
                if (i + 3 < 8) { vlo[i + 3] = vtr(ATT_VF(cur, i + 3)); vhi[i + 3] = vtr(ATT_VF(cur, i + 3) + 512); }
                const s8 vv = (s8){vlo[i][0], vlo[i][1], vlo[i][2], vlo[i][3], vhi[i][0], vhi[i][1], vhi[i][2], vhi[i][3]};
                o[i >> 2] = ATT_MF(__builtin_bit_cast(h8, pw[i & 3]), __builtin_bit_cast(h8, vv), o[i >> 2]);
                if (hasn) {
                    if (i == 0) { pa = max3f(pN0[0], pN0[1], pN1[0]); pb = max3f(pN0[2], pN0[3], pN1[1]); }
                    else if (i == 1) { pa = max3f(pa, pN1[2], pN1[3]); pb = max3f(pb, pN0[6], pN0[7]); }
                    else if (i == 2) { pa = max3f(pa, pN0[4], pN0[5]); pb = max3f(pb, pN1[6], pN1[7]); }
                    else if (i == 3) { pa = max3f(pa, pN1[4], pN1[5]); pb = max3f(pb, pN0[10], pN0[11]); }
                    else if (i == 4) { pa = max3f(pa, pN0[8], pN0[9]); pb = max3f(pb, pN1[10], pN1[11]); }
                    else if (i == 5) { pa = max3f(pa, pN1[8], pN1[9]); pb = max3f(pb, pN0[14], pN0[15]); }
                    else if (i == 6) { pa = max3f(pa, pN0[12], pN0[13]); pb = max3f(pb, pN1[14], pN1[15]); }
                    else { pa = max3f(pa, pN1[12], pN1[13]); }
                    ATT_PIN(pa); ATT_PIN(pb);
                }
                ATT_SBAR();
            }
            if (hasn) { float pm = swapmax(fmaxf(pa, pb)); if (MOBA && !((sel >> (ATT_TB(t + 1) >> 8)) & 1u)) pm = -INFINITY; ATT_MOVE(pN0, pN1, pm); }
        }
        if (NDMA == 3) ATT_WAITV(3); else ATT_WAITV(2);
        ATT_BAR();
    };
    {
        f16v pD0, pD1; int t = 0;
        for (; t + 2 < NF; t += 2) { step(pC0, pC1, pD0, pD1, t, T1{}); step(pD0, pD1, pC0, pC1, t + 1, T1{}); }
        if (t + 1 < NF) { step(pC0, pC1, pD0, pD1, t, T1{}); step(pD0, pD1, pC0, pC1, t + 1, T0{}); }
        else if (t < NF) step(pC0, pC1, pD0, pD1, t, T0{});
    }
    for (int t = NF; t < NT; ++t) {
        const int cur = t & 3, kb = ATT_TB(t);
        if (t + 3 < NT) ATT_DMA(ATT_TB(t + 3), (t + 3) & 3);
        if (kb <= qw0 + 31) {
            f16v p0, p1; ATT_QK(p0, p1, cur);
            if (kb + 63 > qw0) {
#pragma unroll
                for (int r = 0; r < 16; ++r) { const int kv = kb + crow(r, hi); if (kv > qrow) p0[r] = -INFINITY; if (kv + 32 > qrow) p1[r] = -INFINITY; }
            }
            asm volatile("s_nop 15\n\ts_nop 7" : "+v"(p0), "+v"(p1));
            float pm; ATT_MAXCHAIN(p0, p1, pm); ATT_MOVE(p0, p1, pm);
            s4 vlo[8], vhi[8];
#pragma unroll
            for (int i = 0; i < 8; ++i) { vlo[i] = vtr(ATT_VF(cur, i)); vhi[i] = vtr(ATT_VF(cur, i) + 512); }
            ATT_SBAR();
            float ps = 0.f;
#pragma unroll
            for (int r = 0; r < 16; ++r) { p0[r] = __builtin_amdgcn_exp2f(p0[r]); p1[r] = __builtin_amdgcn_exp2f(p1[r]); ps += p0[r] + p1[r]; }
            l_reg += swapsum(ps);
            u4 pw[4]; ATT_PACK(p0, p1, pw, 0xffffffffu);
#pragma unroll
            for (int i = 0; i < 8; ++i) { const s8 vv = (s8){vlo[i][0], vlo[i][1], vlo[i][2], vlo[i][3], vhi[i][0], vhi[i][1], vhi[i][2], vhi[i][3]};
                o[i >> 2] = ATT_MF(__builtin_bit_cast(h8, pw[i & 3]), __builtin_bit_cast(h8, vv), o[i >> 2]); }
        }
        ATT_WAIT_NEXT(t);
        ATT_BAR();
    }
    if (hi == 0) { wsf[32 + r32] = l_reg; if (OWN) wsf[r32] = -negm[0]; } asm volatile("s_waitcnt lgkmcnt(0)" ::: "memory");
    LAS _Float16* stg = (LAS _Float16*)(lds + L_OST) + wid * 2048;
#pragma unroll
    for (int r = 0; r < 16; ++r) { const int orow = crow(r, hi); const float rl = 1.f / wsf[32 + orow];
        stg[orow * 64 + r32] = (_Float16)(o[0][r] * rl); stg[orow * 64 + 32 + r32] = (_Float16)(o[1][r] * rl); }
    asm volatile("s_waitcnt lgkmcnt(0)" ::: "memory");
    int lane_e = lane; asm volatile("" : "+v"(lane_e));
    unsigned char* zbu = (unsigned char*)(Zg + (rowbase + qw0) * 1024 + h * 64);
#pragma unroll
    for (int i = 0; i < 4; ++i) { const int row = i * 8 + (lane_e >> 3), ch = lane_e & 7; const h8 v = *(const LAS h8*)(stg + row * 64 + ch * 8);
        _Float16* zp = (_Float16*)(zbu + (unsigned)(row * 1024 + ch * 8) * 2u); const h8 z = *(const h8*)zp; h8 ov;
        if (OWN) {
            const int nsl = qb < 3 ? qb : 3; const unsigned gr = (unsigned)((b * 8 + h) * 4096 + qw0 + row);
            const float m_own = wsf[row], l_own = wsf[32 + row]; float M = m_own; float2 ml[3]; h8 po[3];
#pragma unroll
            for (int s = 0; s < 3; ++s) if (s < nsl) { ml[s] = ((const float2*)(ws + WS_ML))[(unsigned)s * 524288u + gr]; po[s] = *(const h8*)(ws + opart_off(s) + gr * 128u + (unsigned)ch * 16u); M = fmaxf(M, ml[s].x); }
            const float w0 = l_own * __builtin_amdgcn_exp2f(m_own - M); float W = w0; float acc[8];
#pragma unroll
            for (int j = 0; j < 8; ++j) acc[j] = w0 * (float)v[j];
#pragma unroll
            for (int s = 0; s < 3; ++s) if (s < nsl) { const float w = ml[s].y * __builtin_amdgcn_exp2f(ml[s].x - M); W += w;
#pragma unroll
                for (int j = 0; j < 8; ++j) acc[j] = fmaf(w, (float)po[s][j], acc[j]); }
            const float rW = 1.f / W;
#pragma unroll
            for (int j = 0; j < 8; ++j) ov[j] = (_Float16)(acc[j] * rW * (float)z[j]);
        } else {
#pragma unroll
            for (int j = 0; j < 8; ++j) ov[j] = (_Float16)((float)v[j] * (float)z[j]);
        }
        if (!dry) *(h8*)zp = ov; }
    __syncthreads();
#undef ATT_GLDS
#undef ATT_DMA
#undef ATT_WAITV
#undef ATT_BAR
#undef ATT_SBAR
#undef ATT_PIN
#undef ATT_KF
#undef ATT_MF
#undef ATT_QK
#undef ATT_MAXCHAIN
#undef ATT_MOVE
#undef ATT_PACK
#undef ATT_VF
#undef ATT_WAIT_NEXT
#undef ATT_TB
}


__device__ __forceinline__ void ph_gate(unsigned char* ws, int gw_, int ngw, int lane) {
    const int gw = __builtin_amdgcn_readfirstlane(gw_);
    unsigned* cnt = (unsigned*)(ws + WS_CNT); unsigned short* lists = (unsigned short*)(ws + WS_LIST);
    for (int it = gw; it < 128 * 60; it += ngw) {
        const int bh = it / 60, rr = it - bh * 60, qb = 1 + (rr >> 2), ch = rr & 3, b = bh >> 3, h = bh & 7;
        const int row = qb * 256 + ch * 64 + lane;
        const _Float16* q = (const _Float16*)(ws + WS_QMB) + ((size_t)b * SEQ + row) * 512 + h * 64;
        h8 qv[8];
#pragma unroll
        for (int i = 0; i < 8; ++i) qv[i] = *(const h8*)(q + 8 * i);
        const float* km = (const float*)(ws + WS_KMEAN) + (size_t)b * 16 * 512 + h * 64;
        float g0 = -INFINITY, g1 = -INFINITY, g2 = -INFINITY; int i0 = -1, i1 = -1, i2 = -1;
        for (int m = 0; m < qb; ++m) {
            float s0 = 0.f, s1 = 0.f;
#pragma unroll
            for (int d = 0; d < 64; d += 2) { s0 = fmaf((float)qv[d >> 3][d & 7], km[m * 512 + d], s0); s1 = fmaf((float)qv[d >> 3][(d & 7) + 1], km[m * 512 + d + 1], s1); }
            const float g = s0 + s1;
            if (g > g0) { g2 = g1; i2 = i1; g1 = g0; i1 = i0; g0 = g; i0 = m; }
            else if (g > g1) { g2 = g1; i2 = i1; g1 = g; i1 = m; }
            else if (g > g2) { g2 = g; i2 = m; }
        }
        unsigned mycnt = 0u;
#pragma unroll
        for (int j = 0; j < 15; ++j) { const bool s = (i0 == j) | (i1 == j) | (i2 == j); const unsigned long long mk = __ballot(s); if (lane == j) mycnt = (unsigned)__popcll(mk); }
        unsigned basev = 0u; if (lane < 15 && mycnt) basev = atomicAdd(&cnt[bh * 16 + lane], mycnt);
#pragma unroll
        for (int j = 0; j < 15; ++j) { const bool s = (i0 == j) | (i1 == j) | (i2 == j); const unsigned long long mk = __ballot(s); const unsigned base = (unsigned)__builtin_amdgcn_readlane((int)basev, j);
            if (s) { const unsigned rank = (unsigned)__popcll(mk & ((1ull << lane) - 1ull)); const int slot = (i0 == j) ? 0 : ((i1 == j) ? 1 : 2);
                lists[(size_t)(bh * 16 + j) * 4096 + base + rank] = (unsigned short)(row | (slot << 12)); } }
    }
}

constexpr int GBUF = 65536, G_V = 32768, G_WS = 131072 + 1024, G_CTL = G_WS + 4096, G_ST = G_CTL + 768;
constexpr unsigned G_SINK = 256 * 1024;
__device__ __forceinline__ void gather_dma(unsigned char* ws, int b, int h, int j, LAS unsigned char* lds, int X) {
    int tid_ = threadIdx.x; asm volatile("" : "+v"(tid_)); const int lane = tid_ & 63; const int wid = __builtin_amdgcn_readfirstlane(tid_ >> 6);
    const size_t rowbase = (size_t)b * SEQ + j * 256;
    const unsigned char* kbu = (const unsigned char*)((const _Float16*)(ws + WS_KMB) + rowbase * 512 + h * 64); const unsigned char* vbu = (const unsigned char*)((const _Float16*)(ws + WS_VMB) + rowbase * 512 + h * 64);
    const int r0 = 8 * wid + (lane >> 3), c0 = (lane & 7) ^ ((r0 >> 1) & 7);
    const unsigned ksrc = (unsigned)(r0 * 512 + c0 * 8) * 2u, vsrc = (unsigned)((16 * (wid & 3) + (lane >> 2)) * 512 + (wid >> 2) * 32 + (lane & 3) * 8) * 2u;
    LAS unsigned char* lb = lds + X * GBUF + wid * 1024;
#pragma unroll
    for (int t = 0; t < 4; ++t) {
        glds16((const void*)(kbu + (ksrc + (unsigned)t * 65536u)), (unsigned)__builtin_amdgcn_readfirstlane((int)(unsigned)(size_t)(lb + t * 8192)));
        glds16((const void*)(vbu + (vsrc + (unsigned)t * 65536u)), (unsigned)__builtin_amdgcn_readfirstlane((int)(unsigned)(size_t)(lb + G_V + t * 8192))); }
}
__device__ __forceinline__ void gather_dma_all(unsigned char* ws, int b, int h, int j, LAS unsigned char* lds, int X) {
    int tid_ = threadIdx.x; asm volatile("" : "+v"(tid_)); const int lane = tid_ & 63;
    const size_t rowbase = (size_t)b * SEQ + j * 256;
    const unsigned char* kbu = (const unsigned char*)((const _Float16*)(ws + WS_KMB) + rowbase * 512 + h * 64); const unsigned char* vbu = (const unsigned char*)((const _Float16*)(ws + WS_VMB) + rowbase * 512 + h * 64);
    for (int w = 0; w < 8; ++w) {
        const int r0 = 8 * w + (lane >> 3), c0 = (lane & 7) ^ ((r0 >> 1) & 7);
        const unsigned ksrc = (unsigned)(r0 * 512 + c0 * 8) * 2u, vsrc = (unsigned)((16 * (w & 3) + (lane >> 2)) * 512 + (w >> 2) * 32 + (lane & 3) * 8) * 2u;
        LAS unsigned char* lb = lds + X * GBUF + w * 1024;
#pragma unroll
        for (int t = 0; t < 4; ++t) {
            glds16((const void*)(kbu + (ksrc + (unsigned)t * 65536u)), (unsigned)__builtin_amdgcn_readfirstlane((int)(unsigned)(size_t)(lb + t * 8192)));
            glds16((const void*)(vbu + (vsrc + (unsigned)t * 65536u)), (unsigned)__builtin_amdgcn_readfirstlane((int)(unsigned)(size_t)(lb + G_V + t * 8192))); }
    }
}
__device__ __forceinline__ void gather_unit(unsigned char* ws, int b, int h, int j, LAS unsigned char* lds, int X, LAS unsigned* ctr) {
    constexpr int ND = 4, G = 8;
    int tid_ = threadIdx.x; asm volatile("" : "+v"(tid_));
    const int tid = tid_, lane = tid & 63, r32 = lane & 31, hi = lane >> 5; const int wid = __builtin_amdgcn_readfirstlane(tid >> 6);
    const int bh = b * 8 + h;
    const _Float16* Qg = (const _Float16*)(ws + WS_QMB) + (size_t)b * SEQ * 512 + h * 64;
    const unsigned short* lst = (const unsigned short*)(ws + WS_LIST) + (size_t)(bh * 16 + j) * 4096;
    const int cnt = __builtin_amdgcn_readfirstlane((int)((const unsigned*)(ws + WS_CNT))[bh * 16 + j]);
    const int ngr = (cnt + 31) >> 5;
    LAS unsigned char* kfb = lds + X * GBUF; LAS unsigned char* vfb = kfb + G_V;
    LAS float* wsf = (LAS float*)(lds + G_WS) + wid * 128; LAS unsigned* wsu = (LAS unsigned*)wsf;
    const int vro = ((lane >> 4) & 1) * 32 + (lane & 3) * 8 + (4 * hi + ((lane & 15) >> 2)) * 64;
#define GT_SBAR() __builtin_amdgcn_sched_barrier(0)
#define GT_PIN(x) asm volatile("" : "+v"(x))
#define GT_KF(buf, g) (*(const LAS h8*)(kfb + (buf) * 8192 + kaddr<64>(32 * ((g) & 1) + r32, 2 * ((g) >> 1) + hi)))
#define GT_VF(buf, i) (vfb + (buf) * 8192 + vro + ((i) >> 2) * 4096 + ((i) & 3) * 1024)
#define GT_MF(a, b, c) __builtin_amdgcn_mfma_f32_32x32x16_f16(a, b, c, 0, 0, 0)
#define GT_MOVE(P0, P1, PM) do { const bool move_ = init ? ((PM) > THR) : ((PM) > -INFINITY); \
        if (__any(move_)) { const float dl_ = move_ ? (init ? fmaxf((PM), 0.f) : (PM)) : 0.f; const float al_ = (move_ && init) ? __builtin_amdgcn_exp2f(-dl_) : 1.f; \
            init = init || move_; l_reg *= al_; \
            _Pragma("unroll") for (int r_ = 0; r_ < 16; ++r_) { P0[r_] -= dl_; P1[r_] -= dl_; negm[r_] -= dl_; } \
            if (hi == 0) wsf[r32] = al_; asm volatile("s_waitcnt lgkmcnt(0)" ::: "memory"); \
            _Pragma("unroll") for (int r_ = 0; r_ < 16; ++r_) { const float a_ = wsf[crow(r_, hi)]; o[0][r_] *= a_; o[1][r_] *= a_; } } } while (0)
#define GT_TAKE() ({ unsigned v_ = 0u; if (lane == 0) v_ = __hip_atomic_fetch_add(ctr, 1u, __ATOMIC_RELAXED, __HIP_MEMORY_SCOPE_WORKGROUP); (int)__builtin_amdgcn_readfirstlane((int)v_); })
    h8 qr[ND]; bool validn = false; unsigned entn = 0u;
    int g = GT_TAKE(), gn = ngr;
    if (g < ngr) { const int idx = g * 32 + r32; validn = idx < cnt; entn = validn ? (unsigned)lst[idx] : 0u;
#pragma unroll
        for (int d0 = 0; d0 < ND; ++d0) qr[d0] = *(const h8*)(Qg + (size_t)(entn & 4095u) * 512 + d0 * 16 + hi * 8); }
    for (; g < ngr; g = gn) {
        const bool valid = validn; const unsigned ent = entn; const int row = (int)(ent & 4095u), slot = (int)(ent >> 12) & 3;
        gn = GT_TAKE(); { const int idx = gn * 32 + r32; validn = idx < cnt; entn = validn ? (unsigned)lst[idx] : 0u; }
#pragma unroll
        for (int d0 = 0; d0 < ND; ++d0) asm volatile("" : "+v"(qr[d0]));
        float l_reg = 0.f; bool init = false; f16v o[2]; o[0] = f16v{}; o[1] = f16v{}; f16v negm = f16v{}; asm volatile("" : "+v"(negm));
        f16v pC0, pC1, pD0, pD1;
        {
            h8 kf_[G];
#pragma unroll
            for (int g_ = 0; g_ < G; ++g_) kf_[g_] = GT_KF(0, g_);
            GT_SBAR();
#pragma unroll
            for (int d_ = 0; d_ < ND; ++d_) { pC0 = GT_MF(kf_[2 * d_], qr[d_], d_ == 0 ? negm : pC0); pC1 = GT_MF(kf_[2 * d_ + 1], qr[d_], d_ == 0 ? negm : pC1); }
            asm volatile("s_nop 15\n\ts_nop 7" : "+v"(pC0), "+v"(pC1));
            float pa_ = max3f(pC0[0], pC0[1], pC1[0]), pb_ = max3f(pC0[2], pC0[3], pC1[1]); pa_ = max3f(pa_, pC1[2], pC1[3]);
#pragma unroll
            for (int r_ = 4; r_ < 16; r_ += 4) { pa_ = max3f(pa_, pC0[r_], pC0[r_ + 1]); pb_ = max3f(pb_, pC0[r_ + 2], pC0[r_ + 3]); pa_ = max3f(pa_, pC1[r_], pC1[r_ + 1]); pb_ = max3f(pb_, pC1[r_ + 2], pC1[r_ + 3]); }
            const float pm = swapmax(fmaxf(pa_, pb_)); GT_MOVE(pC0, pC1, pm);
        }
        auto gstep = [&](f16v& pC0, f16v& pC1, f16v& pN0, f16v& pN1, const int t, auto hn) __attribute__((always_inline)) {
            constexpr bool hasn = decltype(hn)::value;
            float ps = 0.f;
            if (hasn) {
                h8 kf[G];
#pragma unroll
                for (int g_ = 0; g_ < 4; ++g_) kf[g_] = GT_KF(t + 1, g_);
                GT_SBAR();
#pragma unroll
                for (int g_ = 0; g_ < G; ++g_) {
                    if (g_ + 4 < G) kf[g_ + 4] = GT_KF(t + 1, g_ + 4);
                    if (g_ & 1) pN1 = GT_MF(kf[g_], qr[g_ >> 1], g_ == 1 ? negm : pN1); else pN0 = GT_MF(kf[g_], qr[g_ >> 1], g_ == 0 ? negm : pN0);
#pragma unroll
                    for (int e = 4 * g_; e < 4 * g_ + 4; ++e) { if (e < 16) { pC0[e] = __builtin_amdgcn_exp2f(pC0[e]); ps += pC0[e]; } else { pC1[e - 16] = __builtin_amdgcn_exp2f(pC1[e - 16]); ps += pC1[e - 16]; } }
                    GT_PIN(pC0); GT_PIN(pC1); GT_PIN(ps); GT_SBAR();
                }
            } else {
#pragma unroll
                for (int r = 0; r < 16; ++r) { pC0[r] = __builtin_amdgcn_exp2f(pC0[r]); pC1[r] = __builtin_amdgcn_exp2f(pC1[r]); ps += pC0[r] + pC1[r]; }
            }
            l_reg += swapsum(ps);
            u4 pw[4];
#pragma unroll
            for (int k_ = 0; k_ < 2; ++k_) {
                pw[k_] = (u4){pkh(pC0[8 * k_], pC0[8 * k_ + 1]), pkh(pC0[8 * k_ + 2], pC0[8 * k_ + 3]), pkh(pC0[8 * k_ + 4], pC0[8 * k_ + 5]), pkh(pC0[8 * k_ + 6], pC0[8 * k_ + 7])};
                pw[2 + k_] = (u4){pkh(pC1[8 * k_], pC1[8 * k_ + 1]), pkh(pC1[8 * k_ + 2], pC1[8 * k_ + 3]), pkh(pC1[8 * k_ + 4], pC1[8 * k_ + 5]), pkh(pC1[8 * k_ + 6], pC1[8 * k_ + 7])}; }
            s4 vlo[8], vhi[8]; float pa = 0.f, pb = 0.f;
#pragma unroll
            for (int i = 0; i < 3; ++i) { vlo[i] = vtr(GT_VF(t, i)); vhi[i] = vtr(GT_VF(t, i) + 512); }
            if (hasn) asm volatile("s_nop 7" : "+v"(pN0), "+v"(pN1));
            GT_SBAR();
#pragma unroll
            for (int i = 0; i < 8; ++i) {
                if (i + 3 < 8) { vlo[i + 3] = vtr(GT_VF(t, i + 3)); vhi[i + 3] = vtr(GT_VF(t, i + 3) + 512); }
                const s8 vv = (s8){vlo[i][0], vlo[i][1], vlo[i][2], vlo[i][3], vhi[i][0], vhi[i][1], vhi[i][2], vhi[i][3]};
                o[i >> 2] = GT_MF(__builtin_bit_cast(h8, pw[i & 3]), __builtin_bit_cast(h8, vv), o[i >> 2]);
                if (hasn) {
                    if (i == 0) { pa = max3f(pN0[0], pN0[1], pN1[0]); pb = max3f(pN0[2], pN0[3], pN1[1]); }
                    else if (i == 1) { pa = max3f(pa, pN1[2], pN1[3]); pb = max3f(pb, pN0[6], pN0[7]); }
                    else if (i == 2) { pa = max3f(pa, pN0[4], pN0[5]); pb = max3f(pb, pN1[6], pN1[7]); }
                    else if (i == 3) { pa = max3f(pa, pN1[4], pN1[5]); pb = max3f(pb, pN0[10], pN0[11]); }
                    else if (i == 4) { pa = max3f(pa, pN0[8], pN0[9]); pb = max3f(pb, pN1[10], pN1[11]); }
                    else if (i == 5) { pa = max3f(pa, pN1[8], pN1[9]); pb = max3f(pb, pN0[14], pN0[15]); }
                    else if (i == 6) { pa = max3f(pa, pN0[12], pN0[13]); pb = max3f(pb, pN1[14], pN1[15]); }
                    else { pa = max3f(pa, pN1[12], pN1[13]); }
                    GT_PIN(pa); GT_PIN(pb);
                }
                GT_SBAR();
            }
            if (hasn) { const float pm = swapmax(fmaxf(pa, pb)); GT_MOVE(pN0, pN1, pm); }
        };
        gstep(pC0, pC1, pD0, pD1, 0, T1{}); gstep(pD0, pD1, pC0, pC1, 1, T1{}); gstep(pC0, pC1, pD0, pD1, 2, T1{}); gstep(pD0, pD1, pC0, pC1, 3, T0{});
        if (gn < ngr) {
#pragma unroll
            for (int d0 = 0; d0 < ND; ++d0) qr[d0] = *(const h8*)(Qg + (size_t)(entn & 4095u) * 512 + d0 * 16 + hi * 8); }
        const unsigned gr = (unsigned)(bh * 4096 + row);
        if (hi == 0) { wsf[32 + r32] = 1.f / l_reg; wsu[64 + r32] = valid ? opart_off(slot) + gr * 128u : G_SINK;
            if (valid) ((float2*)(ws + WS_ML))[(unsigned)slot * 524288u + gr] = make_float2(-negm[0], l_reg); }
        asm volatile("s_waitcnt lgkmcnt(0)" ::: "memory");
#pragma unroll
        for (int k = 0; k < 4; ++k) {
            typedef float f4e __attribute__((ext_vector_type(4)));
            const f4e rl4 = *(const LAS f4e*)(wsf + 32 + 8 * k + 4 * hi); const u4 of4 = *(const LAS u4*)(wsu + 64 + 8 * k + 4 * hi);
#pragma unroll
            for (int i = 0; i < 4; ++i) { const int r = 4 * k + i; const unsigned off = of4[i] + (unsigned)r32 * 2u;
                *(_Float16*)(ws + off) = (_Float16)(o[0][r] * rl4[i]); *(_Float16*)(ws + off + 64u) = (_Float16)(o[1][r] * rl4[i]); } }
    }
#undef GT_TAKE
#undef GT_SBAR
#undef GT_PIN
#undef GT_KF
#undef GT_VF
#undef GT_MF
#undef GT_MOVE
}


__device__ __forceinline__ void own_unit(unsigned char* ws, int b, int h, int qb, LAS unsigned char* lds, int X, bool dry) {
    constexpr int ND = 4, G = 8;
    int tid_ = threadIdx.x; asm volatile("" : "+v"(tid_));
    const int tid = tid_, lane = tid & 63, r32 = lane & 31, hi = lane >> 5; const int wid = __builtin_amdgcn_readfirstlane(tid >> 6);
    const int bh = b * 8 + h, nt = (wid >> 1) + 1; const bool odd = wid & 1; const int qw0 = qb * 256 + wid * 32;
    const _Float16* Qg = (const _Float16*)(ws + WS_QMB) + ((size_t)b * SEQ + qw0) * 512 + h * 64;
    LAS unsigned char* kfb = lds + X * GBUF; LAS unsigned char* vfb = kfb + G_V;
    LAS float* wsf = (LAS float*)(lds + G_WS) + wid * 128;
    const int vro = ((lane >> 4) & 1) * 32 + (lane & 3) * 8 + (4 * hi + ((lane & 15) >> 2)) * 64;
    const int dl = r32 - 4 * hi;
#define GT_SBAR() __builtin_amdgcn_sched_barrier(0)
#define GT_PIN(x) asm volatile("" : "+v"(x))
#define GT_KF(buf, g) (*(const LAS h8*)(kfb + (buf) * 8192 + kaddr<64>(32 * ((g) & 1) + r32, 2 * ((g) >> 1) + hi)))
#define GT_VF(buf, i) (vfb + (buf) * 8192 + vro + ((i) >> 2) * 4096 + ((i) & 3) * 1024)
#define GT_MF(a, b, c) __builtin_amdgcn_mfma_f32_32x32x16_f16(a, b, c, 0, 0, 0)
#define GT_MOVE(P0, P1, PM) do { const bool move_ = init ? ((PM) > THR) : ((PM) > -INFINITY); \
        if (__any(move_)) { const float dl_ = move_ ? (init ? fmaxf((PM), 0.f) : (PM)) : 0.f; const float al_ = (move_ && init) ? __builtin_amdgcn_exp2f(-dl_) : 1.f; \
            init = init || move_; l_reg *= al_; \
            _Pragma("unroll") for (int r_ = 0; r_ < 16; ++r_) { P0[r_] -= dl_; P1[r_] -= dl_; negm[r_] -= dl_; } \
            if (hi == 0) wsf[r32] = al_; asm volatile("s_waitcnt lgkmcnt(0)" ::: "memory"); \
            _Pragma("unroll") for (int r_ = 0; r_ < 16; ++r_) { const float a_ = wsf[crow(r_, hi)]; o[0][r_] *= a_; o[1][r_] *= a_; } } } while (0)
#define GT_MASK(P0, P1) do { _Pragma("unroll") for (int r_ = 0; r_ < 16; ++r_) { const bool dg_ = ((r_ & 3) + 8 * (r_ >> 2)) > dl; \
            if (!odd) { if (dg_) P0[r_] = -INFINITY; P1[r_] = -INFINITY; } else { if (dg_) P1[r_] = -INFINITY; } } } while (0)
    h8 qr[ND];
#pragma unroll
    for (int d0 = 0; d0 < ND; ++d0) qr[d0] = *(const h8*)(Qg + (size_t)r32 * 512 + d0 * 16 + hi * 8);
#pragma unroll
    for (int d0 = 0; d0 < ND; ++d0) asm volatile("" : "+v"(qr[d0]));
    float l_reg = 0.f; bool init = false; f16v o[2]; o[0] = f16v{}; o[1] = f16v{}; f16v negm = f16v{}; asm volatile("" : "+v"(negm));
    f16v pC0, pC1, pD0, pD1;
    {
        h8 kf_[G];
#pragma unroll
        for (int g_ = 0; g_ < G; ++g_) kf_[g_] = GT_KF(0, g_);
        GT_SBAR();
#pragma unroll
        for (int d_ = 0; d_ < ND; ++d_) { pC0 = GT_MF(kf_[2 * d_], qr[d_], d_ == 0 ? negm : pC0); pC1 = GT_MF(kf_[2 * d_ + 1], qr[d_], d_ == 0 ? negm : pC1); }
        asm volatile("s_nop 15\n\ts_nop 7" : "+v"(pC0), "+v"(pC1));
        if (nt == 1) GT_MASK(pC0, pC1);
        float pa_ = max3f(pC0[0], pC0[1], pC1[0]), pb_ = max3f(pC0[2], pC0[3], pC1[1]); pa_ = max3f(pa_, pC1[2], pC1[3]);
#pragma unroll
        for (int r_ = 4; r_ < 16; r_ += 4) { pa_ = max3f(pa_, pC0[r_], pC0[r_ + 1]); pb_ = max3f(pb_, pC0[r_ + 2], pC0[r_ + 3]); pa_ = max3f(pa_, pC1[r_], pC1[r_ + 1]); pb_ = max3f(pb_, pC1[r_ + 2], pC1[r_ + 3]); }
        const float pm = swapmax(fmaxf(pa_, pb_)); GT_MOVE(pC0, pC1, pm);
    }
    auto gstep = [&](f16v& pC0, f16v& pC1, f16v& pN0, f16v& pN1, const int t, auto hn, const bool mk) __attribute__((always_inline)) {
        constexpr bool hasn = decltype(hn)::value;
        float ps = 0.f; f2v ps2 = (f2v){0.f, 0.f};
        if (hasn) {
            h8 kf[G];
#pragma unroll
            for (int g_ = 0; g_ < 4; ++g_) kf[g_] = GT_KF(t + 1, g_);
            GT_SBAR();
#pragma unroll
            for (int g_ = 0; g_ < G; ++g_) {
                if (g_ + 4 < G) kf[g_ + 4] = GT_KF(t + 1, g_ + 4);
                if (g_ & 1) pN1 = GT_MF(kf[g_], qr[g_ >> 1], g_ == 1 ? negm : pN1); else pN0 = GT_MF(kf[g_], qr[g_ >> 1], g_ == 0 ? negm : pN0);
#pragma unroll
                for (int e = 4 * g_; e < 4 * g_ + 4; ++e) { if (e < 16) { pC0[e] = __builtin_amdgcn_exp2f(pC0[e]); ps += pC0[e]; } else { pC1[e - 16] = __builtin_amdgcn_exp2f(pC1[e - 16]); ps += pC1[e - 16]; } }
                GT_PIN(pC0); GT_PIN(pC1); GT_PIN(ps); GT_SBAR();
            }
        } else {
#pragma unroll
            for (int r = 0; r < 16; ++r) { pC0[r] = __builtin_amdgcn_exp2f(pC0[r]); pC1[r] = __builtin_amdgcn_exp2f(pC1[r]); ps += pC0[r] + pC1[r]; }
        }
        l_reg += swapsum(ps);
        u4 pw[4];
#pragma unroll
        for (int k_ = 0; k_ < 2; ++k_) {
            pw[k_] = (u4){pkh(pC0[8 * k_], pC0[8 * k_ + 1]), pkh(pC0[8 * k_ + 2], pC0[8 * k_ + 3]), pkh(pC0[8 * k_ + 4], pC0[8 * k_ + 5]), pkh(pC0[8 * k_ + 6], pC0[8 * k_ + 7])};
            pw[2 + k_] = (u4){pkh(pC1[8 * k_], pC1[8 * k_ + 1]), pkh(pC1[8 * k_ + 2], pC1[8 * k_ + 3]), pkh(pC1[8 * k_ + 4], pC1[8 * k_ + 5]), pkh(pC1[8 * k_ + 6], pC1[8 * k_ + 7])}; }
        s4 vlo[8], vhi[8]; float pa = 0.f, pb = 0.f;
#pragma unroll
        for (int i = 0; i < 3; ++i) { vlo[i] = vtr(GT_VF(t, i)); vhi[i] = vtr(GT_VF(t, i) + 512); }
        if (hasn) { asm volatile("s_nop 7" : "+v"(pN0), "+v"(pN1)); if (mk) GT_MASK(pN0, pN1); }
        GT_SBAR();
#pragma unroll
        for (int i = 0; i < 8; ++i) {
            if (i + 3 < 8) { vlo[i + 3] = vtr(GT_VF(t, i + 3)); vhi[i + 3] = vtr(GT_VF(t, i + 3) + 512); }
            const s8 vv = (s8){vlo[i][0], vlo[i][1], vlo[i][2], vlo[i][3], vhi[i][0], vhi[i][1], vhi[i][2], vhi[i][3]};
            o[i >> 2] = GT_MF(__builtin_bit_cast(h8, pw[i & 3]), __builtin_bit_cast(h8, vv), o[i >> 2]);
            if (hasn) {
                if (i == 0) { pa = max3f(pN0[0], pN0[1], pN1[0]); pb = max3f(pN0[2], pN0[3], pN1[1]); }
                else if (i == 1) { pa = max3f(pa, pN1[2], pN1[3]); pb = max3f(pb, pN0[6], pN0[7]); }
                else if (i == 2) { pa = max3f(pa, pN0[4], pN0[5]); pb = max3f(pb, pN1[6], pN1[7]); }
                else if (i == 3) { pa = max3f(pa, pN1[4], pN1[5]); pb = max3f(pb, pN0[10], pN0[11]); }
                else if (i == 4) { pa = max3f(pa, pN0[8], pN0[9]); pb = max3f(pb, pN1[10], pN1[11]); }
                else if (i == 5) { pa = max3f(pa, pN1[8], pN1[9]); pb = max3f(pb, pN0[14], pN0[15]); }
                else if (i == 6) { pa = max3f(pa, pN0[12], pN0[13]); pb = max3f(pb, pN1[14], pN1[15]); }
                else { pa = max3f(pa, pN1[12], pN1[13]); }
                GT_PIN(pa); GT_PIN(pb);
            }
            GT_SBAR();
        }
        if (hasn) { const float pm = swapmax(fmaxf(pa, pb)); GT_MOVE(pN0, pN1, pm); }
    };
    for (int t = 0; t < nt - 1; ++t) { gstep(pC0, pC1, pD0, pD1, t, T1{}, t + 2 == nt); pC0 = pD0; pC1 = pD1; }
    gstep(pC0, pC1, pD0, pD1, nt - 1, T0{}, false);
    if (hi == 0) { wsf[32 + r32] = 1.f / l_reg; wsf[64 + r32] = l_reg; wsf[r32] = -negm[0]; }
    int lane_e = lane; asm volatile("" : "+v"(lane_e));
    const int row8 = lane_e >> 3, ch = lane_e & 7, nsl = qb < 3 ? qb : 3;
    unsigned char* zbu = (unsigned char*)((_Float16*)(ws + WS_ZCAT) + 512 + ((size_t)b * SEQ + qw0) * 1024 + h * 64);
    h8 zz[4], po[4][3]; float2 ml[4][3];
#pragma unroll
    for (int k = 0; k < 4; ++k) { const int row = 8 * k + row8; const unsigned gr = (unsigned)(bh * 4096 + qw0 + row);
        zz[k] = *(const h8*)(zbu + (unsigned)(row * 1024 + ch * 8) * 2u);
#pragma unroll
        for (int s = 0; s < 3; ++s) if (s < nsl) { ml[k][s] = ((const float2*)(ws + WS_ML))[(unsigned)s * 524288u + gr]; po[k][s] = *(const h8*)(ws + opart_off(s) + gr * 128u + (unsigned)ch * 16u); } }
    asm volatile("s_waitcnt lgkmcnt(0)" ::: "memory");
    LAS _Float16* stg = (LAS _Float16*)(lds + G_ST) + wid * 512;
#pragma unroll
    for (int k = 0; k < 4; ++k) {
        typedef float f4e __attribute__((ext_vector_type(4)));
        const f4e rl4 = *(const LAS f4e*)(wsf + 32 + 8 * k + 4 * hi);
#pragma unroll
        for (int i = 0; i < 4; ++i) { stg[(4 * hi + i) * 64 + r32] = (_Float16)(o[0][4 * k + i] * rl4[i]); stg[(4 * hi + i) * 64 + 32 + r32] = (_Float16)(o[1][4 * k + i] * rl4[i]); }
        asm volatile("s_waitcnt lgkmcnt(0)" ::: "memory");
        const int row = 8 * k + row8; const h8 v = *(const LAS h8*)(stg + row8 * 64 + ch * 8);
        const float m_own = wsf[row], l_own = wsf[64 + row]; float M = m_own;
#pragma unroll
        for (int s = 0; s < 3; ++s) if (s < nsl) M = fmaxf(M, ml[k][s].x);
        const float w0 = l_own * __builtin_amdgcn_exp2f(m_own - M); float W = w0; float acc[8];
#pragma unroll
        for (int j = 0; j < 8; ++j) acc[j] = w0 * (float)v[j];
#pragma unroll
        for (int s = 0; s < 3; ++s) if (s < nsl) { const float w = ml[k][s].y * __builtin_amdgcn_exp2f(ml[k][s].x - M); W += w;
#pragma unroll
            for (int j = 0; j < 8; ++j) acc[j] = fmaf(w, (float)po[k][s][j], acc[j]); }
        const float rW = 1.f / W; h8 ov;
#pragma unroll
        for (int j = 0; j < 8; ++j) ov[j] = (_Float16)(acc[j] * rW * (float)zz[k][j]);
        if (!dry) *(h8*)(zbu + (unsigned)(row * 1024 + ch * 8) * 2u) = ov;
    }
#undef GT_SBAR
#undef GT_PIN
#undef GT_KF
#undef GT_VF
#undef GT_MF
#undef GT_MOVE
#undef GT_MASK
}

__device__ __forceinline__ void attn_phase(unsigned char* ws, LAS unsigned char* lds, int vb, int nvb) {
    const int vcu = (nvb % 8 == 0) ? (vb % 8) * (nvb / 8) + vb / 8 : vb; const int per = (1024 + nvb - 1) / nvb;
    for (int k = 0; k < per; ++k) {
        int it;
        if (nvb == 256) { const int xg = vcu >> 5, lw = vcu & 31; it = ((16 * xg + 4 * k + (lw >> 3)) << 3) | (lw & 7); }
        else { it = vcu * per + k; if (it >= 1024) break; }
        const int bh = it >> 3, pr = it & 7, b = bh >> 3, h = bh & 7;
        if (PROBE == 2) for (int uu = 0; uu < 2; ++uu) attn_unit<96, false, PROBE_ABL>(ws, b, h, uu ? 15 - pr : pr, lds, true);
        for (int uu = 0; uu < 2; ++uu) attn_unit<96, false>(ws, b, h, uu ? 15 - pr : pr, lds);
    }
    int nu = 0;
    for (int k = 0; k < per; ++k) { int it; if (nvb == 256) { const int xg = vcu >> 5, lw = vcu & 31; it = ((16 * xg + 4 * k + (lw >> 3)) << 3) | (lw & 7); } else { it = vcu * per + k; if (it >= 1024) break; } nu += 2; }
    auto unit_of = [&](int u, int& b, int& h, int& j) {
        const int k = u >> 1; int it; if (nvb == 256) { const int xg = vcu >> 5, lw = vcu & 31; it = ((16 * xg + 4 * k + (lw >> 3)) << 3) | (lw & 7); } else it = vcu * per + k;
        const int bh = it >> 3, pr = it & 7, rot = (bh >> 2) & 3; b = bh >> 3; h = bh & 7;
        const int sl = ((pr & 3) + rot) & 3; const int x = pr < 4 ? ((0x6170 >> (4 * sl)) & 15) : ((0x4352 >> (4 * sl)) & 15);
        j = (u & 1) ? 14 - x : x; return !((u & 1) && x == 7); };
    LAS unsigned* gc = (LAS unsigned*)(lds + G_CTL);
    int tid_g = threadIdx.x; asm volatile("" : "+v"(tid_g)); const int lane_g = tid_g & 63;
    for (int rep = 0; rep < (PROBE == 12 ? 2 : 1); ++rep)
    for (int u0 = 0; u0 < nu; u0 += 64) {
        const int nc = nu - u0 < 64 ? nu - u0 : 64;
        if (tid_g < 192) gc[tid_g] = 0u;
        { int b, h, j; if (unit_of(u0, b, h, j)) gather_dma(ws, b, h, j, lds, 0); if (nc > 1 && unit_of(u0 + 1, b, h, j)) gather_dma(ws, b, h, j, lds, 1); }
        asm volatile("s_waitcnt vmcnt(0)" ::: "memory"); __syncthreads();
        for (int uc = 0; uc < nc; ++uc) {
            int b, h, j; const bool ok = unit_of(u0 + uc, b, h, j);
            if (uc >= 2) while (((volatile LAS unsigned*)gc)[128 + uc] == 0u) __builtin_amdgcn_s_sleep(4);
            if (ok) gather_unit(ws, b, h, j, lds, uc & 1, gc + uc);
            unsigned n = 0u; if (lane_g == 0) n = __hip_atomic_fetch_add(gc + 64 + uc, 1u, __ATOMIC_RELAXED, __HIP_MEMORY_SCOPE_WORKGROUP);
            n = (unsigned)__builtin_amdgcn_readfirstlane((int)n) + 1u;
            if (n == 8u && uc + 2 < nc) { int b2, h2, j2;
                if (unit_of(u0 + uc + 2, b2, h2, j2)) { gather_dma_all(ws, b2, h2, j2, lds, uc & 1); asm volatile("s_waitcnt vmcnt(0)" ::: "memory"); }
                if (lane_g == 0) ((volatile LAS unsigned*)gc)[128 + uc + 2] = 1u; }
        }
        __syncthreads();
    }
}
template <bool DRY> __device__ __forceinline__ void attn_phase2_pass(unsigned char* ws, LAS unsigned char* lds, int vb, int nvb) {
    int X = 0;
    if (vb < 2048) gather_dma(ws, vb >> 7, (vb >> 4) & 7, vb & 15, lds, 0);
    for (int it = vb; it < 2048; it += nvb) {
        asm volatile("s_waitcnt vmcnt(0)" ::: "memory"); __syncthreads();
        const int nx = it + nvb; if (nx < 2048) gather_dma(ws, nx >> 7, (nx >> 4) & 7, nx & 15, lds, X ^ 1);
        own_unit(ws, it >> 7, (it >> 4) & 7, it & 15, lds, X, DRY);
        X ^= 1;
    }
    __syncthreads();
}
__device__ __forceinline__ void attn_phase2(unsigned char* ws, LAS unsigned char* lds, int vb, int nvb) {
    if (PROBE == 13) attn_phase2_pass<true>(ws, lds, vb, nvb);
    attn_phase2_pass<false>(ws, lds, vb, nvb);
}
}

constexpr int RING_BYTES = 131072, MISC_OFF = RING_BYTES + 320, LDS_BYTES = 147456;
constexpr int CW_BAR = 4096;

__global__ void __launch_bounds__(512, 2) mega(Params p) {
    extern __shared__ __attribute__((aligned(16))) unsigned char lds[];
    const int vb = blockIdx.x, nvb = gridDim.x, tid = threadIdx.x, lane = tid & 63, wave = tid >> 6;
    const int gtid = vb * 512 + tid, gsize = nvb * 512, gwave = vb * 8 + wave, nwaves = nvb * 8;
    volatile LAS unsigned* misc = (volatile LAS unsigned*)((LAS unsigned char*)lds + MISC_OFF);
    if (tid < 32) misc[tid] = 0u;
    __syncthreads();
    XcdBarrier bar = xcd_barrier_post((unsigned*)(p.ws + WS_CTL) + CW_BAR, misc + 8);
    LAS unsigned char* ldsl = (LAS unsigned char*)lds;
    { int t_ = threadIdx.x; asm volatile("" : "+v"(t_)); ph_prep(p, vb * 512 + t_, gsize, vb, nvb, ldsl); ph_weights(p, ldsl, vb * 8 + (t_ >> 6), nwaves, t_ >> 6, t_ & 63);
      if (PROBE == 10) ph_weights(p, ldsl, vb * 8 + (t_ >> 6), nwaves, t_ >> 6, t_ & 63);
      if (PROBE == 11) ph_tab(p, vb * 512 + t_, gsize); }
    xcd_barrier(bar);
    for (int rep4 = 0; rep4 < ((PROBE == 4 || PROBE == 6) ? 2 : 1); ++rep4) { int t_ = threadIdx.x; asm volatile("" : "+v"(t_)); ph_hnorm(p, vb * 8 + (t_ >> 6), nwaves, t_ & 63); }
    xcd_barrier(bar);
    {
        pg8::Gemm g{(const pg8::bf16_t*)(p.ws + WS_H), (const pg8::bf16_t*)(p.ws + WT_IN), M_, 5120, 1024}; pg8::StaticOrder S; S.init(M_, 5120, nvb, vb);
        for (int rep = (PROBE == 1 ? 1 : 0); rep >= 0; --rep) { pg8::EpiInF E{p.ws, p.b_merge, rep}; pg8::gemm_phase<pg8::EpiInF, pg8::StaticOrder, true, true>(ldsl, g, S, E); }
        if (PROBE == 5) { pg8::EpiNull E; pg8::gemm_phase<pg8::EpiNull, pg8::StaticOrder, true, true>(ldsl, g, S, E); }
    }
    xcd_barrier(bar);
    { int t_ = threadIdx.x; asm volatile("" : "+v"(t_)); att::ph_gate(p.ws, vb * 8 + (t_ >> 6), nwaves, t_ & 63); }
    for (int rep4 = 0; rep4 < ((PROBE == 4 || PROBE == 7) ? 2 : 1); ++rep4) {
        pg8::Gemm g{(const pg8::bf16_t*)(p.ws + WS_QLAT), (const pg8::bf16_t*)(p.ws + WT_UQ), M_, 768, 256}; pg8::StaticOrder S; S.init(M_, 768, nvb, vb);
        pg8::EpiUqF E{p.ws}; pg8::gemm_phase<pg8::EpiUqF, pg8::StaticOrder, true, true>(ldsl, g, S, E);
    }
    for (int rep4 = 0; rep4 < ((PROBE == 4 || PROBE == 7) ? 2 : 1); ++rep4) {
        pg8::Gemm g{(const pg8::bf16_t*)(p.ws + WS_KVL), (const pg8::bf16_t*)(p.ws + WT_UKV), M_, 1024, 128};     pg8::StaticOrder S; S.init(M_, 1024, nvb, vb);
        pg8::EpiUkvF E{p.ws}; pg8::gemm_phase<pg8::EpiUkvF, pg8::StaticOrder, true, true>(ldsl, g, S, E);
    }
    xcd_barrier(bar);
    att::attn_phase(p.ws, ldsl, vb, nvb);
    xcd_barrier(bar);
    att::attn_phase2(p.ws, ldsl, vb, nvb);
    xcd_barrier(bar);
    {
        pg8::Gemm g{(const pg8::bf16_t*)(p.ws + WS_ZCAT), (const pg8::bf16_t*)(p.ws + WT_OA), M_, 1024, 1024}; pg8::StaticOrder S; S.init(M_, 1024, nvb, vb);
        pg8::EpiYcatF E{p.ws}; pg8::gemm_phase<pg8::EpiYcatF, pg8::StaticOrder, true, true>(ldsl, g, S, E);
    }
    xcd_barrier(bar);
    for (int rep4 = 0; rep4 < ((PROBE == 4 || PROBE == 9) ? 2 : 1); ++rep4) {
        pg8::Gemm g{(const pg8::bf16_t*)(p.ws + WS_YM), (const pg8::bf16_t*)(p.ws + WT_OUT), M_, 1024, 1024}; pg8::StaticOrder S; S.init(M_, 1024, nvb, vb);
        pg8::EpiYF E{p.ws}; pg8::gemm_phase<pg8::EpiYF, pg8::StaticOrder, true, true>(ldsl, g, S, E);
    }
    xcd_barrier(bar);
    for (int rep4 = 0; rep4 < ((PROBE == 4 || PROBE == 9) ? 2 : 1); ++rep4) { int t_ = threadIdx.x; asm volatile("" : "+v"(t_)); ph_final(p, vb * 8 + (t_ >> 6), nwaves, t_ & 63); }
}

extern "C" void kernel_launch(void* const* d_in, const int* in_sizes, int n_in, void* d_out, int out_size, void* d_ws, size_t ws_size, hipStream_t stream) {
    if (n_in != 16 || out_size != M_ * DM || ws_size < WS_END) { fprintf(stderr, "kernel_launch: unexpected shapes (n_in %d, out %d, ws %zu)\n", n_in, out_size, ws_size); return; }
    Params p{};
    p.x = (const float*)d_in[0]; p.c = (const float*)d_in[1]; p.pos = (const int*)d_in[2]; p.w_ada = (const float*)d_in[3]; p.b_ada = (const float*)d_in[4];
    p.g_pre = (const float*)d_in[5]; p.g_post = (const float*)d_in[6]; p.w_in = (const float*)d_in[7]; p.g_q = (const float*)d_in[8]; p.w_uq = (const float*)d_in[9];
    p.g_kv = (const float*)d_in[10]; p.w_ukv = (const float*)d_in[11]; p.w_o_mla = (const float*)d_in[12]; p.w_o_moba = (const float*)d_in[13]; p.b_merge = (const float*)d_in[14]; p.w_out = (const float*)d_in[15];
    p.out = (float*)d_out; p.ws = (unsigned char*)d_ws;
    static int grid = 0;
    if (grid == 0) {
        int dev = 0, cus = 0, per_cu = 0;
        if (hipGetDevice(&dev) != hipSuccess || hipDeviceGetAttribute(&cus, hipDeviceAttributeMultiprocessorCount, dev) != hipSuccess) { fprintf(stderr, "kernel_launch: device query failed\n"); grid = -1; return; }
        if (hipFuncSetAttribute((const void*)mega, hipFuncAttributeMaxDynamicSharedMemorySize, LDS_BYTES) != hipSuccess) { fprintf(stderr, "kernel_launch: hipFuncSetAttribute failed\n"); grid = -1; return; }
        if (hipOccupancyMaxActiveBlocksPerMultiprocessor(&per_cu, (const void*)mega, 512, LDS_BYTES) != hipSuccess || per_cu < 1) { fprintf(stderr, "kernel_launch: occupancy query says %d\n", per_cu); }
        (void)hipGetLastError();
        grid = cus;
    }
    if (grid < 0) return;
    (void)hipMemsetAsync(d_ws, 0, ZERO_BYTES, stream);
    hipLaunchKernelGGL(mega, dim3(grid), dim3(512), LDS_BYTES, stream, p);
}
```

```cpp
#include <hip/hip_runtime.h>
#include <cstdio>
#ifndef PROBE
#define PROBE 0
#endif
#include <cstdint>

typedef _Float16 h16;
typedef _Float16 h16x4 __attribute__((ext_vector_type(4)));
typedef _Float16 h2n __attribute__((ext_vector_type(2)));

constexpr int NB = 16, SEQ = 4096, DM = 1024, M_ = NB * SEQ, NH = 8;
constexpr int D_IN = 5024;
constexpr int C_QLAT = 0, C_KVLAT = 256, C_KROPE = 384, C_ZMLA = 416, C_QMB = 928, C_KMB = 1440, C_VMB = 1952, C_ZMB = 2464, C_GA = 2976, C_GB = 4000;
constexpr float EPS = 1e-6f;
constexpr float LOG2E = 1.4426950408889634f;
constexpr float SC_MLA = 0.10206207261596577f * LOG2E;
constexpr float SC_MB = 0.125f * LOG2E;

constexpr size_t MiB = 1u << 20;
constexpr size_t WS_CTL = 0, WS_KMEAN = 512 * 1024, WS_SSQ = 1 * MiB, WS_SSQY = WS_SSQ + 2 * (size_t)M_ * 4, ZERO_BYTES = 2 * MiB;
constexpr size_t WS_MOD = WS_SSQ + 3 * (size_t)M_ * 4, WS_TAB = 4 * MiB, WS_WT = 20 * MiB;
constexpr size_t WS_H = 36 * MiB, WS_KN = 36 * MiB, WS_VM = 100 * MiB;
constexpr size_t WS_QLAT = 164 * MiB, WS_KVL = 196 * MiB, WS_KPE = 228 * MiB, WS_VMB = 232 * MiB;
constexpr size_t WS_QMB = 296 * MiB, WS_KMB = 360 * MiB, WS_ZCAT = 424 * MiB, WS_YM = 296 * MiB;
constexpr size_t WS_GA = 552 * MiB, WS_GB = 616 * MiB, WS_Y = 680 * MiB,     WS_QMLA = 808 * MiB, WS_LIST = 904 * MiB, WS_ML = 920 * MiB, WS_END = 936 * MiB;
constexpr size_t WS_CNT = 64 * 1024;
__device__ __forceinline__ unsigned opart_off(int slot) { return slot < 2 ? (unsigned)(WS_Y + (size_t)slot * 64 * MiB) : (unsigned)WS_QLAT; }

static_assert(WS_MOD + (size_t)NB * 3072 * 4 <= ZERO_BYTES, "MOD inside the zeroed region");
struct Params {
    const float *x, *c; const int* pos; const float *w_ada, *b_ada, *g_pre, *g_post, *w_in, *g_q, *w_uq, *g_kv, *w_ukv, *w_o_mla, *w_o_moba, *b_merge, *w_out;
    float* out; unsigned char* ws;
};

__device__ __forceinline__ float wave_sum(float v) {
#pragma unroll
    for (int o = 1; o < 64; o <<= 1) v += __shfl_xor(v, o);
    return v;
}
__device__ __forceinline__ float silu_f(float v) { return v / (1.f + __expf(-v)); }
__device__ __forceinline__ float sigmoid_f(float v) { return 1.f / (1.f + __expf(-v)); }

#define LAS __attribute__((address_space(3)))
__device__ void ph_tab(const Params& p, int gtid, int gsize);
__device__ void ph_prep(const Params& p, int gtid, int gsize, int vb, int nvb, LAS unsigned char* lds) {
    float* mod = (float*)(p.ws + WS_MOD);
    { const int tid = gtid - vb * 512; LAS float* sc = (LAS float*)lds; LAS float* part = (LAS float*)(lds + 65536);
      for (int i = tid; i < NB * DM; i += 512) { const float cv = p.c[i]; sc[i] = cv / (1.f + __expf(-cv)); }
      __syncthreads();
      for (int cg = vb; cg < 3072 / 12; cg += nvb) {
          if (tid < 384) { const int col = tid % 12, kc = tid / 12, j = cg * 12 + col, k0 = kc * 32;
              float w[32], acc[NB];
#pragma unroll
              for (int kk = 0; kk < 32; ++kk) w[kk] = p.w_ada[(size_t)(k0 + kk) * 3072 + j];
#pragma unroll
              for (int b = 0; b < NB; ++b) acc[b] = 0.f;
#pragma unroll
              for (int kk = 0; kk < 32; kk += 4) {
#pragma unroll
                  for (int b = 0; b < NB; ++b) { typedef float f4m __attribute__((ext_vector_type(4))); const f4m s4 = *(const LAS f4m*)(sc + b * DM + k0 + kk);
                      acc[b] = fmaf(s4.x, w[kk], acc[b]); acc[b] = fmaf(s4.y, w[kk + 1], acc[b]); acc[b] = fmaf(s4.z, w[kk + 2], acc[b]); acc[b] = fmaf(s4.w, w[kk + 3], acc[b]); } }
#pragma unroll
              for (int b = 0; b < NB; ++b) part[(kc * NB + b) * 12 + col] = acc[b]; }
          __syncthreads();
          if (tid < NB * 12) { const int b = tid / 12, c = tid % 12, j = cg * 12 + c; float s = p.b_ada[j];
#pragma unroll
              for (int kc = 0; kc < 32; ++kc) s += part[(kc * NB + b) * 12 + c];
              mod[b * 3072 + j] = s; }
          __syncthreads();
      } }
    ph_tab(p, gtid, gsize);
}
__device__ void ph_tab(const Params& p, int gtid, int gsize) {
    unsigned* tab = (unsigned*)(p.ws + WS_TAB);
    const int f = gtid & 31;
    const double c = exp2(-(double)f * (13.287712379549449 / 32.0)) * 0.15915494309189535;
    int ex; const double mant = frexp(c, &ex); const double c_hi_d = ldexp(rint(ldexp(mant, 11)), ex - 11);
    const float c_hi = (float)c_hi_d, c_lo = (float)(c - c_hi_d);
    for (int i = gtid; i < M_ * 32; i += gsize) {
        const float pos = (float)p.pos[i >> 5];
        float x = pos * c_hi; x = x - floorf(x); x = fmaf(pos, c_lo, x);
        typedef _Float16 h2t __attribute__((ext_vector_type(2))); h2t cs; cs[0] = (_Float16)__builtin_amdgcn_cosf(x); cs[1] = (_Float16)__builtin_amdgcn_sinf(x);
        tab[i] = __builtin_bit_cast(unsigned, cs);
    }
}

__device__ void ph_hnorm(const Params& p, int gwave, int nwaves, int lane) {
    constexpr int R = 4;
    typedef float f4 __attribute__((ext_vector_type(4)));
    const float* mod = (const float*)(p.ws + WS_MOD); h16* H = (h16*)(p.ws + WS_H);
    for (int m0 = R * gwave; m0 < M_; m0 += R * nwaves) {
        f4 v[R][4]; float ss[R];
#pragma unroll
        for (int r = 0; r < R; ++r) { const f4* xr = (const f4*)(p.x + (size_t)(m0 + r) * DM);
#pragma unroll
            for (int j = 0; j < 4; ++j) v[r][j] = __builtin_nontemporal_load(xr + lane + 64 * j); }
#pragma unroll
        for (int r = 0; r < R; ++r) { float s = 0.f;
#pragma unroll
            for (int j = 0; j < 4; ++j) s += (v[r][j][0] * v[r][j][0] + v[r][j][1] * v[r][j][1]) + (v[r][j][2] * v[r][j][2] + v[r][j][3] * v[r][j][3]);
            ss[r] = 1.f / sqrtf(wave_sum(s) * (1.f / DM) + EPS); }
        const int b = m0 >> 12;
#pragma unroll
        for (int j = 0; j < 4; ++j) {
            const int col = 4 * (lane + 64 * j);
            const float4 g = *(const float4*)(p.g_pre + col), sc = *(const float4*)(mod + b * 3072 + 1024 + col), sh = *(const float4*)(mod + b * 3072 + col);
            const float g0 = g.x * (1.f + sc.x), g1 = g.y * (1.f + sc.y), g2 = g.z * (1.f + sc.z), g3 = g.w * (1.f + sc.w);
#pragma unroll
            for (int r = 0; r < R; ++r) { const float rstd = ss[r]; const f4 x = v[r][j];
                h16x4 o; o[0] = (h16)(x[0] * rstd * g0 + sh.x); o[1] = (h16)(x[1] * rstd * g1 + sh.y); o[2] = (h16)(x[2] * rstd * g2 + sh.z); o[3] = (h16)(x[3] * rstd * g3 + sh.w);
                *(h16x4*)(H + (size_t)(m0 + r) * DM + col) = o; }
        }
    }
}

__device__ void ph_final(const Params& p, int gwave, int nwaves, int lane) {
    constexpr int R = 4; typedef float f4 __attribute__((ext_vector_type(4)));
    const float* mod = (const float*)(p.ws + WS_MOD); const h16* Y = (const h16*)(p.ws + WS_Y); const float* ssq = (const float*)(p.ws + WS_SSQY);
    for (int m0 = R * gwave; m0 < M_; m0 += R * nwaves) {
        const int b = m0 >> 12; h16x4 yv[R][4]; f4 xv[R][4]; float rs[R];
#pragma unroll
        for (int r = 0; r < R; ++r) { const h16x4* yr = (const h16x4*)(Y + (size_t)(m0 + r) * DM); const f4* xr = (const f4*)(p.x + (size_t)(m0 + r) * DM); rs[r] = ssq[m0 + r];
#pragma unroll
            for (int j = 0; j < 4; ++j) { yv[r][j] = yr[lane + 64 * j]; xv[r][j] = __builtin_nontemporal_load(xr + lane + 64 * j); } }
#pragma unroll
        for (int r = 0; r < R; ++r) rs[r] = 1.f / sqrtf(rs[r] * (1.f / DM) + EPS);
#pragma unroll
        for (int j = 0; j < 4; ++j) {
            const int col = 4 * (lane + 64 * j); const float4 g = *(const float4*)(p.g_post + col), gt = *(const float4*)(mod + b * 3072 + 2048 + col);
            const float g0 = g.x * gt.x, g1 = g.y * gt.y, g2 = g.z * gt.z, g3 = g.w * gt.w;
#pragma unroll
            for (int r = 0; r < R; ++r) { const h16x4 y = yv[r][j]; const f4 x = xv[r][j]; const float s = rs[r];
                f4 o; o[0] = x[0] + g0 * (float)y[0] * s; o[1] = x[1] + g1 * (float)y[1] * s; o[2] = x[2] + g2 * (float)y[2] * s; o[3] = x[3] + g3 * (float)y[3] * s;
                __builtin_nontemporal_store(o, (f4*)(p.out + (size_t)(m0 + r) * DM) + lane + 64 * j); }
        }
    }
}


#define XB_TMO      128
#define XB_XCNT(j)  (256  + 64 * (j))
#define XB_XSUB(j)  (1280 + 64 * (j))
#define XB_XGEN(j)  (2304 + 64 * (j))
#define XB_TOP      3328
#define XB_TOPGEN   3392
#define XCD_BAR_WORDS 3456
#define XB_SPIN_CAP (1u << 27)
__device__ __forceinline__ unsigned xb_ld(unsigned* p)              { return __hip_atomic_load(p, __ATOMIC_RELAXED, __HIP_MEMORY_SCOPE_AGENT); }
__device__ __forceinline__ unsigned xb_add(unsigned* p, unsigned v) { return __hip_atomic_fetch_add(p, v, __ATOMIC_RELAXED, __HIP_MEMORY_SCOPE_AGENT); }
__device__ __forceinline__ unsigned xb_xcc_id() { return (unsigned)__builtin_amdgcn_s_getreg((3 << 11) | 20) & 0xFu; }
#define XB_SPIN(cond, bar) do { unsigned _sp = 0; while (cond) { __builtin_amdgcn_s_sleep(1); \
    if ((++_sp & 255u) == 0u) { if (xb_ld(&(bar)[XB_TMO])) break; if (_sp > XB_SPIN_CAP) { atomicAdd(&(bar)[XB_TMO], 1u); break; } } } } while (0)
struct XcdBarrier { unsigned* bar; unsigned x; volatile LAS unsigned* st; };
__device__ __forceinline__ XcdBarrier xcd_barrier_post(unsigned* bar, volatile LAS unsigned* st) {
    XcdBarrier b; b.bar = bar; b.x = xb_xcc_id(); b.st = st;
    if (threadIdx.x == 0) (void)xb_add(&bar[XB_XCNT(b.x)], 1u);
    return b;
}
__device__ __forceinline__ void xcd_barrier_complete(unsigned* bar, unsigned x, unsigned& nloc, unsigned& nx) {
    const unsigned G = gridDim.x * gridDim.y * gridDim.z;
    unsigned sum, cnt, mine, sp = 0u;
    for (;;) {
        sum = 0u; cnt = 0u; mine = 0u;
#pragma unroll
        for (unsigned j = 0; j < 16; ++j) { const unsigned c = xb_ld(&bar[XB_XCNT(j)]); sum += c; cnt += (c > 0u) ? 1u : 0u; mine = (j == x) ? c : mine; }
        if (sum == G) break;
        __builtin_amdgcn_s_sleep(1);
        if ((++sp & 255u) == 0u) { if (xb_ld(&bar[XB_TMO])) break; if (sp > XB_SPIN_CAP) { atomicAdd(&bar[XB_TMO], 1u); break; } }
    }
    nloc = mine > 0u ? mine : 1u; nx = cnt > 0u ? cnt : 1u;
}
__device__ __forceinline__ void xcd_barrier(const XcdBarrier& b) {
    asm volatile("s_waitcnt vmcnt(0)" ::: "memory");
    __syncthreads();
    if (threadIdx.x == 0) {
        unsigned* bar = b.bar;
        __builtin_amdgcn_s_waitcnt(0);
        unsigned nloc = b.st[0], nx = b.st[1];
        if (nloc == 0u) { xcd_barrier_complete(bar, b.x, nloc, nx); b.st[0] = nloc; b.st[1] = nx; }
        const unsigned old = xb_add(&bar[XB_XSUB(b.x)], 1u);
        const unsigned gen = old / nloc;
        if (old + 1u == (gen + 1u) * nloc) {
            __builtin_amdgcn_fence(__ATOMIC_RELEASE, "agent");
            asm volatile("s_waitcnt vmcnt(0)" ::: "memory");
            const unsigned og = xb_add(&bar[XB_TOP], 1u);
            const unsigned tg = og / nx;
            if (og + 1u == (tg + 1u) * nx) xb_add(&bar[XB_TOPGEN], 1u);
            else XB_SPIN(xb_ld(&bar[XB_TOPGEN]) == tg, bar);
            __builtin_amdgcn_fence(__ATOMIC_ACQUIRE, "agent");
            xb_add(&bar[XB_XGEN(b.x)], 1u);
            asm volatile("s_waitcnt vmcnt(0)" ::: "memory");
        } else {
            XB_SPIN(xb_ld(&bar[XB_XGEN(b.x)]) == gen, bar);
            __builtin_amdgcn_fence(__ATOMIC_ACQUIRE, "agent");
            asm volatile("s_waitcnt vmcnt(0)" ::: "memory");
        }
    }
    __syncthreads();
}

namespace pg8 {
#define PG8_LAS __attribute__((address_space(3)))
typedef unsigned short bf16_t;
typedef _Float16 bf16x8 __attribute__((ext_vector_type(8)));
typedef float f32x4 __attribute__((ext_vector_type(4)));
typedef unsigned u32x4 __attribute__((ext_vector_type(4)));
constexpr int BM = 256, BK = 64, HALF = 128, HTB = HALF * BK * 2  , STAGE_BYTES = 8 * HTB, NXCD = 8, WGM = 8;

__host__ __device__ __forceinline__ int lds_byte(int r, int c) { const int st = (r >> 4) * 2 + (c >> 5), rr = r & 15, cc = c & 31, ob = rr * 64 + cc * 2; return st * 1024 + (ob ^ (((ob >> 9) & 1) << 5)); }
__host__ __device__ __forceinline__ void stage_rc(int b, int& R, int& C) { const int st = b / 1024, sb = b % 1024, swz = sb ^ (((sb >> 9) & 1) << 5); R = (st >> 1) * 16 + swz / 64; C = (st & 1) * 32 + (swz % 64) / 2; }
__host__ __device__ __forceinline__ int perm32(int rho) { const int n = rho >> 4, i = rho & 15; return 8 * (i >> 2) + 4 * n + (i & 3); }

struct Unit { int pm, pn; };
struct Gemm { const bf16_t* A; const bf16_t* Bt; int M, N, K; };

struct StaticOrder {
    int nM, nN, nwg, G, c;
    __host__ __device__ void init(int M, int N, int G_, int c_) { nM = M / BM; nN = N / BM; nwg = nM * nN; G = G_; c = c_; }
    __host__ __device__ bool next(int i, Unit& u) const {
        const long L = (long)i * G + c; if (L >= nwg) return false;
        int wgid = (int)L; { const int q = nwg / NXCD, r = nwg % NXCD, xcd = wgid % NXCD, off = wgid / NXCD; wgid = (xcd < r ? xcd * (q + 1) : r * (q + 1) + (xcd - r) * q) + off; }
        const int nig = WGM * nN, gid = wgid / nig, fm = gid * WGM, gsz = (nM - fm) < WGM ? (nM - fm) : WGM;
        u.pm = fm + ((wgid % nig) % gsz); u.pn = (wgid % nig) / gsz; return true;
    }
    __device__ __forceinline__ void a_ready(const Unit&) const {}
    __device__ __forceinline__ void done(const Unit&) const {}
};

template <class Epi, class Sched, bool ALIGN_EPI = false, bool SP2 = false>
__device__ __forceinline__ void gemm_phase(PG8_LAS unsigned char* lds, const Gemm g, const Sched& S, const Epi& E) {
    int tid_ = threadIdx.x; asm volatile("" : "+v"(tid_));
    const int tid = tid_, wid = __builtin_amdgcn_readfirstlane(tid >> 6), lane = tid & 63, wr = wid >> 2, wc = wid & 3, fr = lane & 15, fq = lane >> 4;
    const int K = g.K, nt = K / BK;
    unsigned voffA[2], voffB[2];
#pragma unroll
    for (int i = 0; i < 2; ++i) { int R, C; stage_rc(tid * 16 + i * 8192, R, C); const int Rb = Epi::PERM ? ((R & ~31) + perm32(R & 31)) : R;
        voffA[i] = (unsigned)(R * K + C) * 2u; voffB[i] = (unsigned)(Rb * K + C) * 2u; }
    const size_t kstep = (size_t)(BK * 2);
    const size_t hstep = (size_t)HALF * K * 2;
    const size_t tstep = 2 * hstep;
    const unsigned ldsw = (unsigned)wid * 1024u;
    const int aoff = lds_byte(wr * 64 + fr, fq * 8), boff = lds_byte(wc * 32 + fr, fq * 8);
#define PG8_SA(b, h) (((b) * 2 + (h)) * HTB)
#define PG8_SB(b, h) ((4 + (b) * 2 + (h)) * HTB)
#define PG8_STAGE(bufoff, gbase, voff) do { _Pragma("unroll") for (int _i = 0; _i < 2; ++_i) \
        __builtin_amdgcn_global_load_lds((const unsigned*)((const char*)(gbase) + (voff)[_i]), (PG8_LAS unsigned*)(lds + (bufoff) + ldsw + _i * 8192), 16, 0, 0); } while (0)
#define PG8_LDA(dst, b, h) do { _Pragma("unroll") for (int m = 0; m < 4; ++m) _Pragma("unroll") for (int k = 0; k < 2; ++k) dst[m][k] = *(const PG8_LAS bf16x8*)(lds + PG8_SA(b, h) + aoff + m * 2048 + k * 1024); } while (0)
#define PG8_LDB(dst, b, h) do { _Pragma("unroll") for (int n = 0; n < 2; ++n) _Pragma("unroll") for (int k = 0; k < 2; ++k) dst[n][k] = *(const PG8_LAS bf16x8*)(lds + PG8_SB(b, h) + boff + n * 2048 + k * 1024); } while (0)
#define PG8_MMA(ai, bj, At, Bt) do { __builtin_amdgcn_s_setprio(1); _Pragma("unroll") for (int m = 0; m < 4; ++m) _Pragma("unroll") for (int n = 0; n < 2; ++n) _Pragma("unroll") for (int k = 0; k < 2; ++k) \
        acc[ai][bj][m][n] = __builtin_amdgcn_mfma_f32_16x16x32_f16(Bt[n][k], At[m][k], acc[ai][bj][m][n], 0, 0, 0); __builtin_amdgcn_s_setprio(0); } while (0)
#define PG8_WAIT_V(n) asm volatile("s_waitcnt vmcnt(" #n ")" ::: "memory")
#define PG8_WAIT_L(n) asm volatile("s_waitcnt lgkmcnt(" #n ")" ::: "memory")
#define PG8_BAR __builtin_amdgcn_s_barrier()
#define PG8_SCHED __builtin_amdgcn_sched_barrier(0)
    Unit cur, nxt; int ui = 0;
    if (!S.next(0, cur)) return;
    f32x4 acc[2][2][4][2];
#pragma unroll
    for (int a = 0; a < 2; ++a)
#pragma unroll
        for (int b = 0; b < 2; ++b)
#pragma unroll
            for (int m = 0; m < 4; ++m)
#pragma unroll
                for (int n = 0; n < 2; ++n) acc[a][b][m][n] = (f32x4){0.f, 0.f, 0.f, 0.f};
    bf16x8 At[4][2], B0[2][2], B1[2][2];
    const char* cA = (const char*)g.A + (size_t)cur.pm * tstep; const char* cB = (const char*)g.Bt + (size_t)cur.pn * tstep;
    S.a_ready(cur);
    if constexpr (SP2) {
        PG8_STAGE(PG8_SB(0, 0), cB, voffB); PG8_STAGE(PG8_SB(0, 1), cB + hstep, voffB); PG8_STAGE(PG8_SA(0, 0), cA, voffA); PG8_STAGE(PG8_SA(0, 1), cA + hstep, voffA);
        if (wr == 1) PG8_BAR;
        PG8_WAIT_V(2); PG8_BAR;
        PG8_STAGE(PG8_SB(1, 0), cB + kstep, voffB); PG8_STAGE(PG8_SA(1, 0), cA + kstep, voffA); PG8_STAGE(PG8_SB(1, 1), cB + hstep + kstep, voffB);
        PG8_WAIT_V(6); PG8_BAR;
    } else {
        PG8_STAGE(PG8_SB(0, 0), cB, voffB); PG8_STAGE(PG8_SA(0, 0), cA, voffA); PG8_STAGE(PG8_SB(0, 1), cB + hstep, voffB); PG8_STAGE(PG8_SA(0, 1), cA + hstep, voffA);
        if (wr == 1) PG8_BAR;
        PG8_WAIT_V(4); PG8_BAR;
        PG8_STAGE(PG8_SB(1, 0), cB + kstep, voffB); PG8_STAGE(PG8_SA(1, 0), cA + kstep, voffA); PG8_STAGE(PG8_SB(1, 1), cB + hstep + kstep, voffB);
        PG8_WAIT_V(6); PG8_BAR;
    }
    for (;;) {
        const bool has_next = S.next(ui + 1, nxt);
        const char* nA = has_next ? (const char*)g.A + (size_t)nxt.pm * tstep : cA; const char* nB = has_next ? (const char*)g.Bt + (size_t)nxt.pn * tstep : cB;
#pragma nounroll
        for (int t = 0; t < nt; t += 2) {
            const bool last = (t == nt - 2);
            if constexpr (Epi::MID_T > 0) { if (t == Epi::MID_T) E.mid(acc, cur, wr, wc); }
            const char* a1 = cA + (size_t)(t + 1) * kstep;
            const char* a2 = last ? nA : cA + (size_t)(t + 2) * kstep; const char* b2 = last ? nB : cB + (size_t)(t + 2) * kstep;
            const char* a3 = a2 + kstep; const char* b3 = b2 + kstep;
            if (last && has_next) S.a_ready(nxt);
            if constexpr (SP2) {
            PG8_LDB(B0, 0, 0); PG8_LDB(B1, 0, 1); PG8_SCHED; PG8_LDA(At, 0, 0); PG8_STAGE(PG8_SA(1, 1), a1 + hstep, voffA);
            PG8_WAIT_V(8); PG8_WAIT_L(0); PG8_BAR; PG8_MMA(0, 0, At, B0); PG8_MMA(0, 1, At, B1); PG8_BAR; PG8_SCHED;
            PG8_LDA(At, 0, 1); PG8_STAGE(PG8_SB(0, 0), b2, voffB); PG8_STAGE(PG8_SB(0, 1), b2 + hstep, voffB); PG8_STAGE(PG8_SA(0, 0), a2, voffA);
            PG8_WAIT_V(8); PG8_WAIT_L(0); PG8_BAR; PG8_MMA(1, 0, At, B0); PG8_MMA(1, 1, At, B1); PG8_BAR; PG8_SCHED;
            PG8_LDB(B0, 1, 0); PG8_LDB(B1, 1, 1); PG8_SCHED; PG8_LDA(At, 1, 0); PG8_STAGE(PG8_SA(0, 1), a2 + hstep, voffA);
            PG8_WAIT_V(8); PG8_WAIT_L(0); PG8_BAR; PG8_MMA(0, 0, At, B0); PG8_MMA(0, 1, At, B1); PG8_BAR; PG8_SCHED;
            PG8_LDA(At, 1, 1); PG8_STAGE(PG8_SB(1, 0), b3, voffB); PG8_STAGE(PG8_SB(1, 1), b3 + hstep, voffB); PG8_STAGE(PG8_SA(1, 0), a3, voffA);
            PG8_WAIT_V(8); PG8_WAIT_L(0); PG8_BAR; PG8_MMA(1, 0, At, B0); PG8_MMA(1, 1, At, B1); PG8_BAR; PG8_SCHED;
            } else {
            PG8_LDB(B0, 0, 0); PG8_SCHED; PG8_LDA(At, 0, 0); PG8_STAGE(PG8_SA(1, 1), a1 + hstep, voffA);
            PG8_WAIT_L(8); PG8_BAR; PG8_WAIT_L(0); PG8_MMA(0, 0, At, B0); PG8_BAR; PG8_SCHED;
            PG8_LDB(B1, 0, 1); PG8_STAGE(PG8_SB(0, 0), b2, voffB);
            PG8_BAR; PG8_WAIT_L(0); PG8_MMA(0, 1, At, B1); PG8_BAR;
            PG8_LDA(At, 0, 1); PG8_STAGE(PG8_SA(0, 0), a2, voffA);
            PG8_BAR; PG8_WAIT_L(0); PG8_MMA(1, 0, At, B0); PG8_BAR; PG8_SCHED;
            PG8_STAGE(PG8_SB(0, 1), b2 + hstep, voffB);
            PG8_WAIT_V(6); PG8_BAR; PG8_MMA(1, 1, At, B1); PG8_BAR;
            PG8_LDB(B0, 1, 0); PG8_SCHED; PG8_LDA(At, 1, 0); PG8_STAGE(PG8_SA(0, 1), a2 + hstep, voffA);
            PG8_WAIT_L(8); PG8_BAR; PG8_WAIT_L(0); PG8_MMA(0, 0, At, B0); PG8_BAR; PG8_SCHED;
            PG8_LDB(B1, 1, 1); PG8_STAGE(PG8_SB(1, 0), b3, voffB);
            PG8_BAR; PG8_WAIT_L(0); PG8_MMA(0, 1, At, B1); PG8_BAR;
            PG8_LDA(At, 1, 1); PG8_STAGE(PG8_SA(1, 0), a3, voffA);
            PG8_BAR; PG8_WAIT_L(0); PG8_MMA(1, 0, At, B0); PG8_BAR; PG8_SCHED;
            PG8_STAGE(PG8_SB(1, 1), b3 + hstep, voffB);
            PG8_WAIT_V(6); PG8_BAR; PG8_MMA(1, 1, At, B1); PG8_BAR;
            }
        }
        if constexpr (ALIGN_EPI) { if (wr == 0) PG8_BAR; }
        if constexpr (!Epi::AFTER_DRAIN) { E(acc, cur, wr, wc, fr, fq); S.done(cur); }
        if (!has_next) break;
#pragma unroll
        for (int a = 0; a < 2; ++a)
#pragma unroll
            for (int b = 0; b < 2; ++b)
#pragma unroll
                for (int m = 0; m < 4; ++m)
#pragma unroll
                    for (int n = 0; n < 2; ++n) acc[a][b][m][n] = (f32x4){0.f, 0.f, 0.f, 0.f};
        cur = nxt; cA = nA; cB = nB; ++ui;
        if constexpr (ALIGN_EPI) { if (wr == 1) PG8_BAR; }
    }
    PG8_WAIT_V(0);
    if constexpr (!ALIGN_EPI) { if (wr == 0) PG8_BAR; }
    PG8_BAR;
    if constexpr (Epi::AFTER_DRAIN) { E.fused(acc, cur, wr, wc, fr, fq, lds, wid, lane); S.done(cur); }
#undef PG8_SA
#undef PG8_SB
#undef PG8_STAGE
#undef PG8_LDA
#undef PG8_LDB
#undef PG8_MMA
#undef PG8_WAIT_V
#undef PG8_WAIT_L
#undef PG8_BAR
#undef PG8_SCHED
}
typedef _Float16 h8v __attribute__((ext_vector_type(8)));
typedef unsigned u32x2 __attribute__((ext_vector_type(2)));
typedef _Float16 h2v __attribute__((ext_vector_type(2)));
__device__ __forceinline__ unsigned pk_h2(float lo, float hi) { h2v v; v[0] = (_Float16)lo; v[1] = (_Float16)hi; return __builtin_bit_cast(unsigned, v); }
__device__ __forceinline__ u32x4 pack8(const f32x4& a, const f32x4& b) { u32x4 w; w.x = pk_h2(a[0], a[1]); w.y = pk_h2(a[2], a[3]); w.z = pk_h2(b[0], b[1]); w.w = pk_h2(b[2], b[3]); return w; }
__device__ __forceinline__ float sigm1(float v) { return __builtin_amdgcn_rcpf(1.f + __builtin_amdgcn_exp2f(v * -1.4426950408889634f)); }
__device__ __forceinline__ float silu1(float v) { return v * sigm1(v); }
__device__ __forceinline__ f32x4 silu4(const f32x4& v) { return (f32x4){silu1(v[0]), silu1(v[1]), silu1(v[2]), silu1(v[3])}; }
__device__ __forceinline__ f32x4 sigm4(const f32x4& v) { return (f32x4){sigm1(v[0]), sigm1(v[1]), sigm1(v[2]), sigm1(v[3])}; }

#define PG8_OPAQUE(fr_, fq_) int lane_x; asm volatile("v_mbcnt_lo_u32_b32 %0, -1, 0\n\tv_mbcnt_hi_u32_b32 %0, -1, %0" : "=v"(lane_x)); const int frx = lane_x & 15, fqx = lane_x >> 4
__device__ __forceinline__ void st16(unsigned char* base, unsigned off, const u32x4& v) { *(u32x4*)(base + off) = v; }
__device__ __forceinline__ f32x4 ld16f(const unsigned char* base, unsigned off) { return *(const f32x4*)(base + off); }
__device__ __forceinline__ float ld4f(const unsigned char* base, unsigned off) { return *(const float*)(base + off); }
__device__ __forceinline__ h8v ld16h(const unsigned char* base, unsigned off) { return *(const h8v*)(base + off); }
__device__ __forceinline__ float sumsq8(const f32x4& a, const f32x4& b) { return (a[0] * a[0] + a[1] * a[1]) + (a[2] * a[2] + a[3] * a[3]) + (b[0] * b[0] + b[1] * b[1]) + (b[2] * b[2] + b[3] * b[3]); }
__device__ __forceinline__ void rope4(const f32x4& t1, const f32x4& t2, const u32x4& cs, f32x4& o1, f32x4& o2) {
#pragma unroll
    for (int j = 0; j < 4; ++j) { const unsigned wj = cs[j]; h2v w; __builtin_memcpy(&w, &wj, 4);
        const float c = (float)w[0], s = (float)w[1]; o1[j] = t1[j] * c - t2[j] * s; o2[j] = t2[j] * c + t1[j] * s; }
}
__device__ __forceinline__ u32x4 ld16u(const unsigned char* base, unsigned off) { return *(const u32x4*)(base + off); }

struct EpiInF {
    static constexpr bool PERM = true, AFTER_DRAIN = false; static constexpr int MID_T = 0;
    unsigned char* ws; const float* b_merge; int noatomic;
    template <bool ISQ> __device__ __forceinline__ void rope_tile(const f32x4 (&acc)[2][2][4][2], const Unit& u, int wr, int wc, int frx, int fqx) const {
        const int pn = u.pn; const unsigned row0 = (unsigned)(u.pm * 256 + wr * 64) + (unsigned)frx; const float sc = ISQ ? SC_MB : 1.f;
        unsigned char* dst = ws + (ISQ ? WS_QMB : WS_KMB); const unsigned char* tab = ws + WS_TAB;
        const unsigned o0 = row0 * 1024u + (((pn & 1) ? 256u : 0u) + 64u * wc + 8u * fqx) * 2u, t0 = row0 * 128u + 32u * fqx;
        f32x4 c1[2] = {{0.f, 0.f, 0.f, 0.f}, {0.f, 0.f, 0.f, 0.f}}, c2[2] = {{0.f, 0.f, 0.f, 0.f}, {0.f, 0.f, 0.f, 0.f}};
        u32x4 cs[2][4][2];
#pragma unroll
        for (int ai = 0; ai < 2; ++ai)
#pragma unroll
            for (int m = 0; m < 4; ++m) { const unsigned to = t0 + (unsigned)(ai * 128 + m * 16) * 128u; cs[ai][m][0] = ld16u(tab, to); cs[ai][m][1] = ld16u(tab, to + 16u); }
#pragma unroll
        for (int ai = 0; ai < 2; ++ai)
#pragma unroll
            for (int m = 0; m < 4; ++m) { const unsigned ro = o0 + (unsigned)(ai * 128 + m * 16) * 1024u;
                f32x4 o1[2], o2[2];
#pragma unroll
                for (int n = 0; n < 2; ++n) { rope4(acc[ai][0][m][n], acc[ai][1][m][n], cs[ai][m][n], o1[n], o2[n]);
                    if (!ISQ) { c1[n] += o1[n]; c2[n] += o2[n]; } }
                st16(dst, ro, pack8(o1[0] * sc, o1[1] * sc)); st16(dst, ro + 64u, pack8(o2[0] * sc, o2[1] * sc));
                if (!ISQ) asm volatile("" : "+v"(c1[0]), "+v"(c1[1]), "+v"(c2[0]), "+v"(c2[1])); }
        if (!ISQ) {
            float* km = (float*)(ws + WS_KMEAN) + (size_t)u.pm * 512 + ((pn & 1) ? 256 : 0) + 64 * wc + 8 * fqx;
#pragma unroll
            for (int n = 0; n < 2; ++n)
#pragma unroll
                for (int j = 0; j < 4; ++j) { float a = c1[n][j], b = c2[n][j];
#pragma unroll
                    for (int o = 1; o < 16; o <<= 1) { a += __shfl_xor(a, o); b += __shfl_xor(b, o); }
                    if (frx == 0 && !noatomic) { atomicAdd(km + 4 * n + j, a * (1.f / 256.f)); atomicAdd(km + 32 + 4 * n + j, b * (1.f / 256.f)); } }
        }
    }
    __device__ __forceinline__ void operator()(const f32x4 (&acc)[2][2][4][2], const Unit& u, int wr, int wc, int fr, int fq) const {
        PG8_OPAQUE(fr, fq);
        const int pn = u.pn; const unsigned row0 = (unsigned)(u.pm * 256 + wr * 64) + (unsigned)frx, cl = 32u * wc + 8u * fqx;
        if (pn == 0) {
            unsigned char* dst = ws + WS_QLAT; float* ssq = (float*)(ws + WS_SSQ); const unsigned o0 = row0 * 512u + cl * 2u;
#pragma unroll
            for (int ai = 0; ai < 2; ++ai)
#pragma unroll
                for (int m = 0; m < 4; ++m) { const unsigned ro = o0 + (unsigned)(ai * 128 + m * 16) * 512u; float s = 0.f;
#pragma unroll
                    for (int bj = 0; bj < 2; ++bj) { s += sumsq8(acc[ai][bj][m][0], acc[ai][bj][m][1]); st16(dst, ro + bj * 256u, pack8(acc[ai][bj][m][0], acc[ai][bj][m][1])); }
                    s += __shfl_xor(s, 16); s += __shfl_xor(s, 32);
                    if (fqx == 0 && !noatomic) atomicAdd(ssq + (row0 + ai * 128 + m * 16), s); }
        } else if (pn == 1) {
            unsigned char* kvl = ws + WS_KVL; unsigned char* kpe = ws + WS_KPE; float* ssq = (float*)(ws + WS_SSQ) + M_; const unsigned char* tab = ws + WS_TAB;
#pragma unroll
            for (int ai = 0; ai < 2; ++ai)
#pragma unroll
                for (int m = 0; m < 4; ++m) { const unsigned row = row0 + ai * 128 + m * 16;
                    if (wc < 2) { float s = 0.f;
#pragma unroll
                        for (int bj = 0; bj < 2; ++bj) { s += sumsq8(acc[ai][bj][m][0], acc[ai][bj][m][1]); st16(kvl, row * 256u + (bj * 64u + cl) * 2u, pack8(acc[ai][bj][m][0], acc[ai][bj][m][1])); }
                        s += __shfl_xor(s, 16); s += __shfl_xor(s, 32);
                        if (fqx == 0 && !noatomic) atomicAdd(ssq + row, s);
                    } else {
                        if (wc == 2 && fqx < 2) {
                            f32x4 o1[2], o2[2];
#pragma unroll
                            for (int n = 0; n < 2; ++n) { const unsigned to = row * 128u + (unsigned)(16 * fqx + 8 * n) * 4u; const u32x4 wa = ld16u(tab, to), wb = ld16u(tab, to + 16u);
                                rope4(acc[ai][0][m][n], acc[ai][1][m][n], (u32x4){wa[0], wa[2], wb[0], wb[2]}, o1[n], o2[n]); }
                            st16(kpe, row * 64u + 16u * fqx, pack8(o1[0], o1[1])); st16(kpe, row * 64u + 32u + 16u * fqx, pack8(o2[0], o2[1]));
                        }
                    }
                    asm volatile("" ::: "memory"); }
        } else if (pn < 4 || (pn >= 8 && pn < 12)) {
            const bool act = (pn < 4) || (pn >= 10); const unsigned pitch = act ? 2048u : 1024u;
            unsigned char* dst = ws + (act ? WS_ZCAT : WS_VMB); const unsigned o0 = row0 * pitch + ((pn >= 10 ? 512u : 0u) + ((pn & 1) ? 256u : 0u) + cl) * 2u;
#pragma unroll
            for (int ai = 0; ai < 2; ++ai)
#pragma unroll
                for (int m = 0; m < 4; ++m) { const unsigned ro = o0 + (unsigned)(ai * 128 + m * 16) * pitch;
#pragma unroll
                    for (int bj = 0; bj < 2; ++bj) { f32x4 a = acc[ai][bj][m][0], b = acc[ai][bj][m][1]; if (act) { a = silu4(a); b = silu4(b); }
                        st16(dst, ro + bj * 256u, pack8(a, b)); } }
        } else if (pn < 6) { rope_tile<true>(acc, u, wr, wc, frx, fqx);
        } else if (pn < 8) { rope_tile<false>(acc, u, wr, wc, frx, fqx);
        } else {
            const bool isa = pn < 16; unsigned char* dst = ws + (isa ? WS_GA : WS_GB); const unsigned cg = 256u * ((pn - 12) & 3) + cl;
            const unsigned char* bm = (const unsigned char*)(b_merge + (isa ? 0 : 1024)); const unsigned o0 = row0 * 1024u + cg;
            f32x4 bv[2][2];
#pragma unroll
            for (int bj = 0; bj < 2; ++bj)
#pragma unroll
                for (int n = 0; n < 2; ++n) bv[bj][n] = ld16f(bm, (cg + bj * 128u + 4u * n) * 4u);
#pragma unroll
            for (int ai = 0; ai < 2; ++ai)
#pragma unroll
                for (int m = 0; m < 4; ++m) { const unsigned ro = o0 + (unsigned)(ai * 128 + m * 16) * 1024u;
#pragma unroll
                    for (int bj = 0; bj < 2; ++bj) { const f32x4 a = sigm4(acc[ai][bj][m][0] + bv[bj][0]) * 255.f + 0.5f, b = sigm4(acc[ai][bj][m][1] + bv[bj][1]) * 255.f + 0.5f;
                        u32x2 w; w.x = (unsigned)a[0] | ((unsigned)a[1] << 8) | ((unsigned)a[2] << 16) | ((unsigned)a[3] << 24); w.y = (unsigned)b[0] | ((unsigned)b[1] << 8) | ((unsigned)b[2] << 16) | ((unsigned)b[3] << 24);
                        *(u32x2*)(dst + (ro + bj * 128u)) = w; } }
        }
    }
};
struct EpiNull {
    static constexpr bool PERM = true, AFTER_DRAIN = false; static constexpr int MID_T = 0;
    __device__ __forceinline__ void operator()(const f32x4 (&acc)[2][2][4][2], const Unit& u, int wr, int wc, int fr, int fq) const {
#pragma unroll
        for (int ai = 0; ai < 2; ++ai)
#pragma unroll
            for (int bj = 0; bj < 2; ++bj)
#pragma unroll
                for (int m = 0; m < 4; ++m) asm volatile("" :: "v"(acc[ai][bj][m][0]), "v"(acc[ai][bj][m][1]));
    }
};
struct EpiUqF {
    static constexpr bool PERM = true, AFTER_DRAIN = false; static constexpr int MID_T = 0;
    unsigned char* ws;
    __device__ __forceinline__ void operator()(const f32x4 (&acc)[2][2][4][2], const Unit& u, int wr, int wc, int fr, int fq) const {
        PG8_OPAQUE(fr, fq);
        const int pn = u.pn; const unsigned row0 = (unsigned)(u.pm * 256 + wr * 64) + (unsigned)frx; unsigned char* Q = ws + WS_QMLA; const unsigned char* ssq = ws + WS_SSQ; const unsigned char* tab = ws + WS_TAB;
        float rsv[2][4];
#pragma unroll
        for (int ai = 0; ai < 2; ++ai)
#pragma unroll
            for (int m = 0; m < 4; ++m) rsv[ai][m] = ld4f(ssq, (row0 + ai * 128 + m * 16) * 4u);
#pragma unroll
        for (int ai = 0; ai < 2; ++ai)
#pragma unroll
            for (int m = 0; m < 4; ++m) { const unsigned row = row0 + ai * 128 + m * 16; const float rs = SC_MLA * __builtin_amdgcn_rsqf(rsv[ai][m] * (1.f / 256.f) + EPS);
                if (pn < 2) {
#pragma unroll
                    for (int bj = 0; bj < 2; ++bj) { const unsigned head = 4u * pn + 2u * bj + (wc >> 1), d = 32u * (wc & 1) + 8u * fqx;
                        st16(Q, row * 1536u + (96u * head + d) * 2u, pack8(acc[ai][bj][m][0] * rs, acc[ai][bj][m][1] * rs)); }
                } else { const unsigned head = 2u * wc + ((unsigned)fqx >> 1), i0 = 8u * (fqx & 1); f32x4 o1[2], o2[2];
#pragma unroll
                    for (int n = 0; n < 2; ++n) { const unsigned to = row * 128u + (2u * (i0 + 4u * n)) * 4u; const u32x4 wa = ld16u(tab, to), wb = ld16u(tab, to + 16u);
                        rope4(acc[ai][0][m][n] * rs, acc[ai][1][m][n] * rs, (u32x4){wa[0], wa[2], wb[0], wb[2]}, o1[n], o2[n]); }
                    st16(Q, row * 1536u + (96u * head + 64u + i0) * 2u, pack8(o1[0], o1[1])); st16(Q, row * 1536u + (96u * head + 80u + i0) * 2u, pack8(o2[0], o2[1])); } }
    }
};
struct EpiUkvF {
    static constexpr bool PERM = true, AFTER_DRAIN = false; static constexpr int MID_T = 0;
    unsigned char* ws;
    __device__ __forceinline__ void operator()(const f32x4 (&acc)[2][2][4][2], const Unit& u, int wr, int wc, int fr, int fq) const {
        PG8_OPAQUE(fr, fq);
        const int pn = u.pn; const unsigned row0 = (unsigned)(u.pm * 256 + wr * 64) + (unsigned)frx; unsigned char* dst = ws + (pn < 2 ? WS_KN : WS_VM); const unsigned char* ssq = ws + WS_SSQ + (size_t)M_ * 4;
        float rsv[2][4];
#pragma unroll
        for (int ai = 0; ai < 2; ++ai)
#pragma unroll
            for (int m = 0; m < 4; ++m) rsv[ai][m] = ld4f(ssq, (row0 + ai * 128 + m * 16) * 4u);
#pragma unroll
        for (int ai = 0; ai < 2; ++ai)
#pragma unroll
            for (int m = 0; m < 4; ++m) { const unsigned row = row0 + ai * 128 + m * 16; const float rs = __builtin_amdgcn_rsqf(rsv[ai][m] * (1.f / 128.f) + EPS);
#pragma unroll
                for (int bj = 0; bj < 2; ++bj) { const unsigned head = 4u * (pn & 1) + 2u * bj + (wc >> 1), d = 32u * (wc & 1) + 8u * fqx;
                    st16(dst, row * 1024u + (64u * head + d) * 2u, pack8(acc[ai][bj][m][0] * rs, acc[ai][bj][m][1] * rs)); } }
    }
};
struct EpiYcatF {
    static constexpr bool PERM = true, AFTER_DRAIN = false; static constexpr int MID_T = 8;
    unsigned char* ws;
    template <bool MID> __device__ __forceinline__ void run(f32x4 (&acc)[2][2][4][2], const Unit& u, int wr, int wc) const {
        PG8_OPAQUE(0, 0);
        const unsigned row0 = (unsigned)(u.pm * 256 + wr * 64) + (unsigned)frx, c0 = u.pn * 256u + 32u * wc + 8u * fqx, o0 = row0 * 2048u + c0 * 2u, g0 = row0 * 1024u + c0;
        const unsigned char* GA = ws + WS_GA; const unsigned char* GB = ws + WS_GB; unsigned char* YM = ws + WS_YM;
#pragma unroll
        for (int ai = 0; ai < 2; ++ai) {
            u32x2 ga[4][2], gb[4][2];
#pragma unroll
            for (int m = 0; m < 4; ++m)
#pragma unroll
                for (int bj = 0; bj < 2; ++bj) { const unsigned go = g0 + (unsigned)(ai * 128 + m * 16) * 1024u + bj * 128u; gb[m][bj] = *(const u32x2*)(GB + go); if (MID) ga[m][bj] = *(const u32x2*)(GA + go); }
#pragma unroll
            for (int m = 0; m < 4; ++m)
#pragma unroll
                for (int bj = 0; bj < 2; ++bj) { const unsigned off = o0 + (unsigned)(ai * 128 + m * 16) * 2048u + bj * 256u; f32x4 s0, s1;
#pragma unroll
                    for (int j = 0; j < 4; ++j) { const float b0 = fmaxf((float)((gb[m][bj].x >> (8 * j)) & 0xffu), 0.5f), b1 = fmaxf((float)((gb[m][bj].y >> (8 * j)) & 0xffu), 0.5f);
                        s0[j] = MID ? (float)((ga[m][bj].x >> (8 * j)) & 0xffu) * __builtin_amdgcn_rcpf(b0) : b0 * (1.f / 255.f);
                        s1[j] = MID ? (float)((ga[m][bj].y >> (8 * j)) & 0xffu) * __builtin_amdgcn_rcpf(b1) : b1 * (1.f / 255.f); }
                    acc[ai][bj][m][0] *= s0; acc[ai][bj][m][1] *= s1;
                    if (!MID) st16(YM, off, pack8(acc[ai][bj][m][0], acc[ai][bj][m][1])); }
            asm volatile("" ::: "memory"); }
    }
    __device__ __forceinline__ void mid(f32x4 (&acc)[2][2][4][2], const Unit& u, int wr, int wc) const { run<true>(acc, u, wr, wc); }
    __device__ __forceinline__ void operator()(f32x4 (&acc)[2][2][4][2], const Unit& u, int wr, int wc, int fr, int fq) const { run<false>(acc, u, wr, wc); }
};
struct EpiYF {
    static constexpr bool PERM = true, AFTER_DRAIN = false; static constexpr int MID_T = 0;
    unsigned char* ws;
    __device__ __forceinline__ void operator()(const f32x4 (&acc)[2][2][4][2], const Unit& u, int wr, int wc, int fr, int fq) const {
        PG8_OPAQUE(fr, fq);
        const unsigned row0 = (unsigned)(u.pm * 256 + wr * 64) + (unsigned)frx, c0 = u.pn * 256u + 32u * wc + 8u * fqx, o0 = row0 * 2048u + c0 * 2u; unsigned char* Y = ws + WS_Y; float* ssq = (float*)(ws + WS_SSQY);
#pragma unroll
        for (int ai = 0; ai < 2; ++ai)
#pragma unroll
            for (int m = 0; m < 4; ++m) { float s = 0.f;
#pragma unroll
                for (int bj = 0; bj < 2; ++bj) { s += sumsq8(acc[ai][bj][m][0], acc[ai][bj][m][1]); st16(Y, o0 + (unsigned)(ai * 128 + m * 16) * 2048u + bj * 256u, pack8(acc[ai][bj][m][0], acc[ai][bj][m][1])); }
                s += __shfl_xor(s, 16); s += __shfl_xor(s, 32);
                if (fqx == 0) atomicAdd(ssq + (row0 + ai * 128 + m * 16), s); }
    }
};
}

struct MapIn { __device__ int operator()(int n) const { const int t = n >> 8, tc = n & 255, bj = tc >> 7, uu = tc & 127;
    if (t == 0) return n;
    if (t == 1) return uu < 64 ? C_KVLAT + 64 * bj + uu : (uu < 80 ? C_KROPE + 16 * bj + (uu - 64) : -1);
    if (t < 4) return C_ZMLA + (n - 512);
    if (t < 8) return (t < 6 ? C_QMB : C_KMB) + 256 * (t & 1) + 64 * (uu >> 5) + 32 * bj + (uu & 31);
    if (t < 10) return C_VMB + (n - 2048);
    if (t < 12) return C_ZMB + (n - 2560);
    if (t < 16) return C_GA + (n - 3072);
    return C_GB + (n - 4096); } };
struct MapUq { __device__ int operator()(int n) const { const int t = n >> 8, tc = n & 255, bj = tc >> 7, uu = tc & 127;
    if (t < 2) return 96 * (4 * t + (tc >> 6)) + (tc & 63);
    return 96 * (uu >> 4) + 64 + 16 * bj + (uu & 15); } };
struct MapUkv { __device__ int operator()(int n) const { const int t = n >> 8, tc = n & 255; return 128 * (4 * (t & 1) + (tc >> 6)) + (t < 2 ? 0 : 64) + (tc & 63); } };
struct MapId { __device__ int operator()(int n) const { return n; } };
template <class Map> __device__ __forceinline__ void wt_items(const float* W, int ldw, int Kreal, int K, int N, unsigned short* WT, const float* kscale, Map map, LAS float* scr, int gw, int ngw, int lane, int ldk = 0, int koff = 0) {
    if (ldk == 0) ldk = K;
    const int nblk = N / 64, nitems = (K / 32) * nblk; typedef float f4 __attribute__((ext_vector_type(4)));
    for (int it = gw; it < nitems; it += ngw) {
        const int kb = it / nblk, nb = it % nblk, k0 = 32 * kb, n0 = 64 * nb; const int src = map(n0 + 4 * (lane & 15));
        f4 wv[8];
#pragma unroll
        for (int i = 0; i < 8; ++i) { const int k = k0 + 4 * i + (lane >> 4); wv[i] = (src >= 0 && k < Kreal) ? *(const f4*)(W + (size_t)k * ldw + src) : (f4){0.f, 0.f, 0.f, 0.f}; }
#pragma unroll
        for (int i = 0; i < 8; ++i) { const int kk = 4 * i + (lane >> 4), k = k0 + kk; f4 v = wv[i]; if (kscale && k < Kreal) v = v * kscale[k]; *(LAS f4*)(scr + kk * 68 + 4 * (lane & 15)) = v; }
        asm volatile("s_waitcnt lgkmcnt(0)" ::: "memory");
#pragma unroll
        for (int j = 0; j < 4; ++j) { const int q = lane + 64 * j, n = q >> 2, c = q & 3; const LAS float* s = scr + (8 * c) * 68 + n;
            pg8::u32x4 o; o.x = pg8::pk_h2(s[0 * 68], s[1 * 68]); o.y = pg8::pk_h2(s[2 * 68], s[3 * 68]); o.z = pg8::pk_h2(s[4 * 68], s[5 * 68]); o.w = pg8::pk_h2(s[6 * 68], s[7 * 68]);
            *(pg8::u32x4*)(WT + (size_t)(n0 + n) * ldk + koff + k0 + 8 * c) = o; }
        asm volatile("s_waitcnt lgkmcnt(0)" ::: "memory");
    }
}
constexpr size_t WT_IN = WS_WT, WT_UQ = WS_WT + 10 * MiB, WT_UKV = WT_UQ + 512 * 1024, WT_OA = WS_WT + 11 * MiB, WT_OB = WS_WT + 12 * MiB, WT_OUT = WS_WT + 13 * MiB;
__device__ __forceinline__ void ph_weights(const Params& p, LAS unsigned char* lds, int gw, int ngw, int wave, int lane) {
    LAS float* scr = (LAS float*)(lds + wave * 16384);
    wt_items(p.w_in, D_IN, 1024, 1024, 5120, (unsigned short*)(p.ws + WT_IN), nullptr, MapIn(), scr, gw, ngw, lane);
    wt_items(p.w_uq, 768, 256, 256, 768, (unsigned short*)(p.ws + WT_UQ), p.g_q, MapUq(), scr, gw, ngw, lane);
    wt_items(p.w_ukv, 1024, 128, 128, 1024, (unsigned short*)(p.ws + WT_UKV), p.g_kv, MapUkv(), scr, gw, ngw, lane);
    wt_items(p.w_o_mla, 1024, 512, 512, 1024, (unsigned short*)(p.ws + WT_OA), nullptr, MapId(), scr, gw, ngw, lane, 1024, 0);
    wt_items(p.w_o_moba, 1024, 512, 512, 1024, (unsigned short*)(p.ws + WT_OA), nullptr, MapId(), scr, gw, ngw, lane, 1024, 512);
    wt_items(p.w_out, 1024, 1024, 1024, 1024, (unsigned short*)(p.ws + WT_OUT), nullptr, MapId(), scr, gw, ngw, lane);
}

namespace att {
struct T1 { static constexpr bool value = true; }; struct T0 { static constexpr bool value = false; };
typedef _Float16 h8 __attribute__((ext_vector_type(8)));
typedef short s4 __attribute__((ext_vector_type(4)));
typedef short s8 __attribute__((ext_vector_type(8)));
typedef float f16v __attribute__((ext_vector_type(16)));
typedef float f2v __attribute__((ext_vector_type(2)));
typedef unsigned u4 __attribute__((ext_vector_type(4)));
typedef short v4i16_t __attribute__((ext_vector_type(4)));
constexpr int KBUF = 16384, VBUF = 8192;
constexpr int NBUF = 4;
constexpr int L_K = 0, L_V = NBUF * KBUF, L_WS = L_V + NBUF * VBUF, L_TB = L_WS + 8 * 256, L_UN = L_TB + 256, L_END = L_UN + 64, L_OST = 0;
constexpr float THR = 8.f;
#ifndef PROBE_ABL
#define PROBE_ABL 0
#endif
#ifndef ATT_STAGGER
#define ATT_STAGGER 0
#endif
constexpr bool STAGGER = ATT_STAGGER;
__device__ __forceinline__ int crow(int r, int hi) { return (r & 3) + 8 * (r >> 2) + 4 * hi; }
template <int DK> __device__ __forceinline__ int kaddr(int row, int ch) { return DK == 64 ? row * 128 + ((ch ^ ((row >> 1) & 7)) << 4) : row * 256 + ((ch ^ (row & 15)) << 4); }
__device__ __forceinline__ s4 vtr(const LAS unsigned char* p) { return __builtin_bit_cast(s4, __builtin_amdgcn_ds_read_tr16_b64_v4i16((LAS v4i16_t*)p)); }
__device__ __forceinline__ float swapmax(float m) { auto rr = __builtin_amdgcn_permlane32_swap(__float_as_uint(m), __float_as_uint(m), false, false); return fmaxf(__uint_as_float(rr[0]), __uint_as_float(rr[1])); }
__device__ __forceinline__ float swapsum(float m) { auto rr = __builtin_amdgcn_permlane32_swap(__float_as_uint(m), __float_as_uint(m), false, false); return __uint_as_float(rr[0]) + __uint_as_float(rr[1]); }
__device__ __forceinline__ void glds16(const void* g, unsigned lds_base) { unsigned sv;
    asm volatile("s_mov_b32 %0, m0\n\ts_mov_b32 m0, %2\n\ts_nop 0\n\tglobal_load_lds_dwordx4 %1, off\n\ts_mov_b32 m0, %0" : "=&s"(sv) : "v"(g), "s"(lds_base) : "memory"); }
__device__ __forceinline__ float max3f(float a, float b, float c) { float r; asm("v_max3_f32 %0, %1, %2, %3" : "=v"(r) : "v"(a), "v"(b), "v"(c)); return r; }
__device__ __forceinline__ unsigned pkh(float lo, float hi) { typedef _Float16 h2 __attribute__((ext_vector_type(2))); h2 v; v[0] = (_Float16)lo; v[1] = (_Float16)hi; return __builtin_bit_cast(unsigned, v); }

template <int DK, bool MOBA, int ABL = 0, bool OWN = false>
__device__ __forceinline__ void attn_unit(unsigned char* ws, int b, int h, int qb, LAS unsigned char* lds, bool dry = false) {
    constexpr int ND = DK / 16, QP = MOBA ? 512 : 768, QH = MOBA ? 64 : 96;
    int tid_ = threadIdx.x; asm volatile("" : "+v"(tid_));
    const int tid = tid_, lane = tid & 63, r32 = lane & 31, hi = lane >> 5; const int wid = __builtin_amdgcn_readfirstlane(tid >> 6);
    const _Float16* Qg = (const _Float16*)(ws + (MOBA ? WS_QMB : WS_QMLA)); const _Float16* Kg = (const _Float16*)(ws + (MOBA ? WS_KMB : WS_KN));
    const _Float16* Vg = (const _Float16*)(ws + (MOBA ? WS_VMB : WS_VM)); const _Float16* Pg = (const _Float16*)(ws + WS_KPE); _Float16* Zg = (_Float16*)(ws + WS_ZCAT) + (MOBA ? 512 : 0);
    const size_t rowbase = (size_t)b * SEQ; const int q0 = qb * 256, qw0 = q0 + wid * 32, qrow = qw0 + r32;
    LAS float* wsf = (LAS float*)(lds + L_WS) + wid * 64; LAS int* tb = (LAS int*)(lds + L_TB); LAS unsigned* un = (LAS unsigned*)(lds + L_UN);
    h8 qr[ND];
#pragma unroll
    for (int d0 = 0; d0 < ND; ++d0) qr[d0] = *(const h8*)(Qg + (rowbase + qrow) * QP + h * QH + d0 * 16 + hi * 8);
#pragma unroll
    for (int d0 = 0; d0 < ND; ++d0) asm volatile("" : "+v"(qr[d0]));
    unsigned sel = 0u, blocks = OWN ? (1u << qb) : (2u << qb) - 1u;
    if (MOBA && !OWN) {
        const float* km = (const float*)(ws + WS_KMEAN) + (size_t)b * 16 * 512 + h * 64 + hi * 8;
        float g0 = -INFINITY, g1 = -INFINITY, g2 = -INFINITY; int i0 = -1, i1 = -1, i2 = -1;
        for (int m = 0; m < qb; ++m) {
            float part = 0.f;
#pragma unroll
            for (int d0 = 0; d0 < 4; ++d0) { const float4 a = *(const float4*)(km + m * 512 + d0 * 16), c = *(const float4*)(km + m * 512 + d0 * 16 + 4);
                part += (float)qr[d0][0] * a.x + (float)qr[d0][1] * a.y + (float)qr[d0][2] * a.z + (float)qr[d0][3] * a.w + (float)qr[d0][4] * c.x + (float)qr[d0][5] * c.y + (float)qr[d0][6] * c.z + (float)qr[d0][7] * c.w; }
            const float g = swapsum(part);
            if (g > g0) { g2 = g1; i2 = i1; g1 = g0; i1 = i0; g0 = g; i0 = m; }
            else if (g > g1) { g2 = g1; i2 = i1; g1 = g; i1 = m; }
            else if (g > g2) { g2 = g; i2 = m; }
        }
        if (i0 >= 0) sel |= 1u << i0; if (i1 >= 0) sel |= 1u << i1; if (i2 >= 0) sel |= 1u << i2;
        unsigned uw = sel;
#pragma unroll
        for (int o = 1; o < 64; o <<= 1) uw |= (unsigned)__shfl_xor((int)uw, o);
        if (lane == 0) un[wid] = uw;
        __syncthreads();
        unsigned ua = 0u;
#pragma unroll
        for (int w = 0; w < 8; ++w) ua |= un[w];
        blocks = (unsigned)__builtin_amdgcn_readfirstlane((int)(ua | (1u << qb)));
    }
    const int NT = OWN ? 4 : 4 * __builtin_popcount(blocks);
    if (tid < 64 && tid < NT) { unsigned bm = blocks; for (int k = 0; k < (tid >> 2); ++k) bm &= bm - 1u; tb[tid] = (__builtin_ctz(bm) << 8) + ((tid & 3) << 6); }
    __syncthreads();
    const unsigned char* kbu = (const unsigned char*)(Kg + rowbase * 512 + h * 64); const unsigned char* vbu = (const unsigned char*)(Vg + rowbase * 512 + h * 64); const unsigned char* pbu = (const unsigned char*)(Pg + rowbase * 32);
    const unsigned char* kb0; const unsigned char* kb1 = nullptr; unsigned ksrc0, ksrc1 = 0u, kst0 = 1024u, kst1 = 1024u;
    if (DK == 96) { const int r0 = 4 * wid + (lane >> 4), r1 = r0 + 32; int c0 = (lane & 15) ^ (r0 & 15), c1 = (lane & 15) ^ (r1 & 15); if (c0 >= 12) c0 -= 4; if (c1 >= 12) c1 -= 4;
        const bool kpe0 = c0 >= 8, kpe1 = c1 >= 8;
        kb0 = kpe0 ? pbu : kbu; kst0 = kpe0 ? 64u : 1024u; ksrc0 = kpe0 ? (unsigned)(r0 * 32 + (c0 - 8) * 8) * 2u : (unsigned)(r0 * 512 + c0 * 8) * 2u;
        kb1 = kpe1 ? pbu : kbu; kst1 = kpe1 ? 64u : 1024u; ksrc1 = kpe1 ? (unsigned)(r1 * 32 + (c1 - 8) * 8) * 2u : (unsigned)(r1 * 512 + c1 * 8) * 2u;
    } else { const int r0 = 8 * wid + (lane >> 3), c0 = (lane & 7) ^ ((r0 >> 1) & 7); kb0 = kbu; ksrc0 = (unsigned)(r0 * 512 + c0 * 8) * 2u; }
    const unsigned vsrc = (unsigned)((16 * (wid & 3) + (lane >> 2)) * 512 + (wid >> 2) * 32 + (lane & 3) * 8) * 2u;
    constexpr int NDMA = (DK == 96) ? 3 : 2;
#define ATT_GLDS(src, dst) glds16((const void*)(src), (unsigned)__builtin_amdgcn_readfirstlane((int)(unsigned)(size_t)(dst)))
#define ATT_DMA(kb, buf) do { const unsigned kb_ = (unsigned)(kb); LAS unsigned char* kd_ = lds + L_K + (buf) * KBUF; \
        ATT_GLDS(kb0 + (ksrc0 + kb_ * kst0), kd_ + wid * 1024); \
        if (DK == 96) ATT_GLDS(kb1 + (ksrc1 + kb_ * kst1), kd_ + 8192 + wid * 1024); \
        ATT_GLDS(vbu + (vsrc + kb_ * 1024u), lds + L_V + (buf) * VBUF + wid * 1024); } while (0)
#define ATT_WAITV(n) asm volatile("s_waitcnt vmcnt(" #n ")" ::: "memory")
#define ATT_BAR() do { asm volatile("s_waitcnt lgkmcnt(0)" ::: "memory"); __builtin_amdgcn_s_barrier(); asm volatile("" ::: "memory"); } while (0)
    const int vro = ((lane >> 4) & 1) * 32 + (lane & 3) * 8 + (4 * hi + ((lane & 15) >> 2)) * 64;
    LAS unsigned char* ldsv = lds + L_V + vro; asm volatile("" : "+v"(ldsv));
    float l_reg = 0.f; bool init = false; f16v o[2]; o[0] = f16v{}; o[1] = f16v{}; f16v negm = f16v{}; asm volatile("" : "+v"(negm));
    constexpr int G = 2 * ND;
#define ATT_SBAR() __builtin_amdgcn_sched_barrier(0)
#define ATT_PIN(x) asm volatile("" : "+v"(x))
#define ATT_KF(buf, g) (*(const LAS h8*)(lds + L_K + (buf) * KBUF + kaddr<DK>(32 * ((g) & 1) + r32, 2 * ((g) >> 1) + hi)))
#define ATT_MF(a, b, c) __builtin_amdgcn_mfma_f32_32x32x16_f16(a, b, c, 0, 0, 0)
#define ATT_QK(P0, P1, buf) do { h8 kf_[G]; _Pragma("unroll") for (int g_ = 0; g_ < G; ++g_) kf_[g_] = ATT_KF(buf, g_); ATT_SBAR(); \
        _Pragma("unroll") for (int d_ = 0; d_ < ND; ++d_) { P0 = ATT_MF(kf_[2 * d_], qr[d_], d_ == 0 ? negm : P0); P1 = ATT_MF(kf_[2 * d_ + 1], qr[d_], d_ == 0 ? negm : P1); } } while (0)
#define ATT_MAXCHAIN(P0, P1, PM) do { float pa_ = max3f(P0[0], P0[1], P1[0]), pb_ = max3f(P0[2], P0[3], P1[1]); pa_ = max3f(pa_, P1[2], P1[3]); \
        _Pragma("unroll") for (int r_ = 4; r_ < 16; r_ += 4) { pa_ = max3f(pa_, P0[r_], P0[r_ + 1]); pb_ = max3f(pb_, P0[r_ + 2], P0[r_ + 3]); pa_ = max3f(pa_, P1[r_], P1[r_ + 1]); pb_ = max3f(pb_, P1[r_ + 2], P1[r_ + 3]); } \
        PM = swapmax(fmaxf(pa_, pb_)); } while (0)
#define ATT_MOVE(P0, P1, PM) do { const bool move_ = init ? ((PM) > THR) : ((PM) > -INFINITY); \
        if (__any(move_)) { const float dl_ = move_ ? (init ? fmaxf((PM), 0.f) : (PM)) : 0.f; const float al_ = (move_ && init) ? __builtin_amdgcn_exp2f(-dl_) : 1.f; \
            init = init || move_; l_reg *= al_; \
            _Pragma("unroll") for (int r_ = 0; r_ < 16; ++r_) { P0[r_] -= dl_; P1[r_] -= dl_; negm[r_] -= dl_; } \
            if (hi == 0) wsf[r32] = al_; asm volatile("s_waitcnt lgkmcnt(0)" ::: "memory"); \
            _Pragma("unroll") for (int r_ = 0; r_ < 16; ++r_) { const float a_ = wsf[crow(r_, hi)]; o[0][r_] *= a_; o[1][r_] *= a_; } } } while (0)
#define ATT_PACK(P0, P1, PW, KEEP) do { _Pragma("unroll") for (int k_ = 0; k_ < 2; ++k_) { \
            PW[k_] = (u4){pkh(P0[8 * k_], P0[8 * k_ + 1]), pkh(P0[8 * k_ + 2], P0[8 * k_ + 3]), pkh(P0[8 * k_ + 4], P0[8 * k_ + 5]), pkh(P0[8 * k_ + 6], P0[8 * k_ + 7])}; \
            PW[2 + k_] = (u4){pkh(P1[8 * k_], P1[8 * k_ + 1]), pkh(P1[8 * k_ + 2], P1[8 * k_ + 3]), pkh(P1[8 * k_ + 4], P1[8 * k_ + 5]), pkh(P1[8 * k_ + 6], P1[8 * k_ + 7])}; } \
        if (MOBA) { _Pragma("unroll") for (int k_ = 0; k_ < 4; ++k_) PW[k_] &= (KEEP); } } while (0)
#define ATT_VF(buf, i) (ldsv + (buf) * VBUF + ((i) >> 2) * 4096 + ((i) & 3) * 1024)
#define ATT_WAIT_NEXT(t_) do { if ((t_) + 3 < NT) { if (NDMA == 3) ATT_WAITV(3); else ATT_WAITV(2); } else ATT_WAITV(0); } while (0)
#define ATT_TB(i) (MOBA ? tb[(i)] : 64 * (i))
    const int NF = OWN ? 0 : NT - 4;
    ATT_DMA(ATT_TB(0), 0); ATT_DMA(ATT_TB(1), 1); ATT_DMA(ATT_TB(2), 2);
    if (NDMA == 3) ATT_WAITV(3); else ATT_WAITV(2);
    ATT_BAR();
    f16v pC0, pC1;
    if (NF > 0) { ATT_QK(pC0, pC1, 0); asm volatile("s_nop 15\n\ts_nop 7" : "+v"(pC0), "+v"(pC1)); float pm; ATT_MAXCHAIN(pC0, pC1, pm);
        if (MOBA && !((sel >> (ATT_TB(0) >> 8)) & 1u)) pm = -INFINITY; ATT_MOVE(pC0, pC1, pm); }
    auto step = [&](f16v& pC0, f16v& pC1, f16v& pN0, f16v& pN1, const int t, auto hn) __attribute__((always_inline)) {
        const int cur = t & 3, nx = (t + 1) & 3; constexpr bool hasn = decltype(hn)::value;
        ATT_DMA(ATT_TB(t + 3), (t + 3) & 3);
        const unsigned keepC = (!MOBA || ((sel >> (ATT_TB(t) >> 8)) & 1u)) ? 0xffffffffu : 0u;
        float ps = 0.f; f2v ps2 = (f2v){0.f, 0.f};
        if (hasn) {
            h8 kf[G];
#pragma unroll
            for (int g = 0; g < 4; ++g) kf[g] = ATT_KF(nx, g);
            ATT_SBAR();
#pragma unroll
            for (int g = 0; g < G; ++g) {
                if (g + 4 < G) kf[g + 4] = ATT_KF(nx, g + 4);
                if (g & 1) pN1 = ATT_MF(kf[g], qr[g >> 1], g == 1 ? negm : pN1); else pN0 = ATT_MF(kf[g], qr[g >> 1], g == 0 ? negm : pN0);
                constexpr int dummy = 0; (void)dummy;
                const int e0 = (ND == 4) ? 4 * g : (g < 8 ? 3 * g : 24 + 2 * (g - 8)), e1 = (ND == 4) ? 4 * g + 4 : (g < 8 ? 3 * g + 3 : 26 + 2 * (g - 8));
#pragma unroll
                for (int e = e0; e < e1; ++e) { if (e < 16) pC0[e] = __builtin_amdgcn_exp2f(pC0[e]); else pC1[e - 16] = __builtin_amdgcn_exp2f(pC1[e - 16]);
                    if (e & 1) { if (e < 16) ps2 += (f2v){pC0[e - 1], pC0[e]}; else ps2 += (f2v){pC1[e - 17], pC1[e - 16]}; } }
                ATT_PIN(pC0); ATT_PIN(pC1); ATT_PIN(ps2); ATT_SBAR();
            }
        } else {
#pragma unroll
            for (int r = 0; r < 16; ++r) { pC0[r] = __builtin_amdgcn_exp2f(pC0[r]); pC1[r] = __builtin_amdgcn_exp2f(pC1[r]); ps += pC0[r] + pC1[r]; }
        }
        ps += ps2[0] + ps2[1];
        if (MOBA && !keepC) ps = 0.f;
        l_reg += swapsum(ps);
        u4 pw[4]; ATT_PACK(pC0, pC1, pw, keepC);
        {
            s4 vlo[8], vhi[8]; float pa = 0.f, pb = 0.f;
#pragma unroll
            for (int i = 0; i < 3; ++i) { vlo[i] = vtr(ATT_VF(cur, i)); vhi[i] = vtr(ATT_VF(cur, i) + 512); }
            if (hasn) asm volatile("s_nop 7" : "+v"(pN0), "+v"(pN1));
            ATT_SBAR();
#pragma unroll
            for (int i = 0; i < 8; ++i) {
                if (i + 3 < 8) { vlo[i + 3] = vtr(ATT_VF(cur, i + 3)); vhi[i + 3] = vtr(ATT_VF(cur, i + 3) + 512); }
                const s8 vv = (s8){vlo[i][0], vlo[i][1], vlo[i][2], vlo[i][3], vhi[i][0], vhi[i][1], vhi[i][2], vhi[i][3]};
                o[i >> 2] = ATT_MF(__builtin_bit_cast(h8, pw[i & 3]), __builtin_bit_cast(h8, vv), o[i >> 2]);
                if (hasn) {
                    if (i == 0) { pa = max3f(pN0[0], pN0[1], pN1[0]); pb = max3f(pN0[2], pN0[3], pN1[1]); }
                    else if (i == 1) { pa = max3f(pa, pN1[2], pN1[3]); pb = max3f(pb, pN0[6], pN0[7]); }
                    else if (i == 2) { pa = max3f(pa, pN0[4], pN0[5]); pb = max3f(pb, pN1[6], pN1[7]); }
                    else if (i == 3) { pa = max3f(pa, pN1[4], pN1[5]); pb = max3f(pb, pN0[10], pN0[11]); }
                    else if (i == 4) { pa = max3f(pa, pN0[8], pN0[9]); pb = max3f(pb, pN1[10], pN1[11]); }
                    else if (i == 5) { pa = max3f(pa, pN1[8], pN1[9]); pb = max3f(pb, pN0[14], pN0[15]); }
                    else if (i == 6) { pa = max3f(pa, pN0[12], pN0[13]); pb = max3f(pb, pN1[14], pN1[15]); }
                    else { pa = max3f(pa, pN1[12], pN1[13]); }
                    ATT_PIN(pa); ATT_PIN(pb);
                }
                ATT_SBAR();
            }
            if (hasn) { float pm = swapmax(fmaxf(pa, pb)); if (MOBA && !((sel >> (ATT_TB(t + 1) >> 8)) & 1u)) pm = -INFINITY; ATT_MOVE(pN0, pN1, pm); }
        }
        if (NDMA == 3) ATT_WAITV(3); else ATT_WAITV(2);
        ATT_BAR();
    };
    {
        f16v pD0, pD1; int t = 0;
        for (; t + 2 < NF; t += 2) { step(pC0, pC1, pD0, pD1, t, T1{}); step(pD0, pD1, pC0, pC1, t + 1, T1{}); }
        if (t + 1 < NF) { step(pC0, pC1, pD0, pD1, t, T1{}); step(pD0, pD1, pC0, pC1, t + 1, T0{}); }
        else if (t < NF) step(pC0, pC1, pD0, pD1, t, T0{});
    }
    for (int t = NF; t < NT; ++t) {
        const int cur = t & 3, kb = ATT_TB(t);
        if (t + 3 < NT) ATT_DMA(ATT_TB(t + 3), (t + 3) & 3);
        if (kb <= qw0 + 31) {
            f16v p0, p1; ATT_QK(p0, p1, cur);
            if (kb + 63 > qw0) {
#pragma unroll
                for (int r = 0; r < 16; ++r) { const int kv = kb + crow(r, hi); if (kv > qrow) p0[r] = -INFINITY; if (kv + 32 > qrow) p1[r] = -INFINITY; }
            }
            asm volatile("s_nop 15\n\ts_nop 7" : "+v"(p0), "+v"(p1));
            float pm; ATT_MAXCHAIN(p0, p1, pm); ATT_MOVE(p0, p1, pm);
            s4 vlo[8], vhi[8];
#pragma unroll
            for (int i = 0; i < 8; ++i) { vlo[i] = vtr(ATT_VF(cur, i)); vhi[i] = vtr(ATT_VF(cur, i) + 512); }
            ATT_SBAR();
            float ps = 0.f;
#pragma unroll
            for (int r = 0; r < 16; ++r) { p0[r] = __builtin_amdgcn_exp2f(p0[r]); p1[r] = __builtin_amdgcn_exp2f(p1[r]); ps += p0[r] + p1[r]; }
            l_reg += swapsum(ps);
            u4 pw[4]; ATT_PACK(p0, p1, pw, 0xffffffffu);
#pragma unroll
            for (int i = 0; i < 8; ++i) { const s8 vv = (s8){vlo[i][0], vlo[i][1], vlo[i][2], vlo[i][3], vhi[i][0], vhi[i][1], vhi[i][2], vhi[i][3]};
                o[i >> 2] = ATT_MF(__builtin_bit_cast(h8, pw[i & 3]), __builtin_bit_cast(h8, vv), o[i >> 2]); }
        }
        ATT_WAIT_NEXT(t);
        ATT_BAR();
    }
    if (hi == 0) { wsf[32 + r32] = l_reg; if (OWN) wsf[r32] = -negm[0]; } asm volatile("s_waitcnt lgkmcnt(0)" ::: "memory");
    LAS _Float16* stg = (LAS _Float16*)(lds + L_OST) + wid * 2048;
#pragma unroll
    for (int r = 0; r < 16; ++r) { const int orow = crow(r, hi); const float rl = 1.f / wsf[32 + orow];
        stg[orow * 64 + r32] = (_Float16)(o[0][r] * rl); stg[orow * 64 + 32 + r32] = (_Float16)(o[1][r] * rl); }
    asm volatile("s_waitcnt lgkmcnt(0)" ::: "memory");
    int lane_e = lane; asm volatile("" : "+v"(lane_e));
    unsigned char* zbu = (unsigned char*)(Zg + (rowbase + qw0) * 1024 + h * 64);
#pragma unroll
    for (int i = 0; i < 4; ++i) { const int row = i * 8 + (lane_e >> 3), ch = lane_e & 7; const h8 v = *(const LAS h8*)(stg + row * 64 + ch * 8);
        _Float16* zp = (_Float16*)(zbu + (unsigned)(row * 1024 + ch * 8) * 2u); const h8 z = *(const h8*)zp; h8 ov;
        if (OWN) {
            const int nsl = qb < 3 ? qb : 3; const unsigned gr = (unsigned)((b * 8 + h) * 4096 + qw0 + row);
            const float m_own = wsf[row], l_own = wsf[32 + row]; float M = m_own; float2 ml[3]; h8 po[3];
#pragma unroll
            for (int s = 0; s < 3; ++s) if (s < nsl) { ml[s] = ((const float2*)(ws + WS_ML))[(unsigned)s * 524288u + gr]; po[s] = *(const h8*)(ws + opart_off(s) + gr * 128u + (unsigned)ch * 16u); M = fmaxf(M, ml[s].x); }
            const float w0 = l_own * __builtin_amdgcn_exp2f(m_own - M); float W = w0; float acc[8];
#pragma unroll
            for (int j = 0; j < 8; ++j) acc[j] = w0 * (float)v[j];
#pragma unroll
            for (int s = 0; s < 3; ++s) if (s < nsl) { const float w = ml[s].y * __builtin_amdgcn_exp2f(ml[s].x - M); W += w;
#pragma unroll
                for (int j = 0; j < 8; ++j) acc[j] = fmaf(w, (float)po[s][j], acc[j]); }
            const float rW = 1.f / W;
#pragma unroll
            for (int j = 0; j < 8; ++j) ov[j] = (_Float16)(acc[j] * rW * (float)z[j]);
        } else {
#pragma unroll
            for (int j = 0; j < 8; ++j) ov[j] = (_Float16)((float)v[j] * (float)z[j]);
        }
        if (!dry) *(h8*)zp = ov; }
    __syncthreads();
#undef ATT_GLDS
#undef ATT_DMA
#undef ATT_WAITV
#undef ATT_BAR
#undef ATT_SBAR
#undef ATT_PIN
#undef ATT_KF
#undef ATT_MF
#undef ATT_QK
#undef ATT_MAXCHAIN
#undef ATT_MOVE
#undef ATT_PACK
#undef ATT_VF
#undef ATT_WAIT_NEXT
#undef ATT_TB
}


__device__ __forceinline__ void ph_gate(unsigned char* ws, int gw_, int ngw, int lane) {
    const int gw = __builtin_amdgcn_readfirstlane(gw_);
    unsigned* cnt = (unsigned*)(ws + WS_CNT); unsigned short* lists = (unsigned short*)(ws + WS_LIST);
    for (int it = gw; it < 128 * 60; it += ngw) {
        const int bh = it / 60, rr = it - bh * 60, qb = 1 + (rr >> 2), ch = rr & 3, b = bh >> 3, h = bh & 7;
        const int row = qb * 256 + ch * 64 + lane;
        const _Float16* q = (const _Float16*)(ws + WS_QMB) + ((size_t)b * SEQ + row) * 512 + h * 64;
        h8 qv[8];
#pragma unroll
        for (int i = 0; i < 8; ++i) qv[i] = *(const h8*)(q + 8 * i);
        const float* km = (const float*)(ws + WS_KMEAN) + (size_t)b * 16 * 512 + h * 64;
        float g0 = -INFINITY, g1 = -INFINITY, g2 = -INFINITY; int i0 = -1, i1 = -1, i2 = -1;
        for (int m = 0; m < qb; ++m) {
            float s0 = 0.f, s1 = 0.f;
#pragma unroll
            for (int d = 0; d < 64; d += 2) { s0 = fmaf((float)qv[d >> 3][d & 7], km[m * 512 + d], s0); s1 = fmaf((float)qv[d >> 3][(d & 7) + 1], km[m * 512 + d + 1], s1); }
            const float g = s0 + s1;
            if (g > g0) { g2 = g1; i2 = i1; g1 = g0; i1 = i0; g0 = g; i0 = m; }
            else if (g > g1) { g2 = g1; i2 = i1; g1 = g; i1 = m; }
            else if (g > g2) { g2 = g; i2 = m; }
        }
        unsigned mycnt = 0u;
#pragma unroll
        for (int j = 0; j < 15; ++j) { const bool s = (i0 == j) | (i1 == j) | (i2 == j); const unsigned long long mk = __ballot(s); if (lane == j) mycnt = (unsigned)__popcll(mk); }
        unsigned basev = 0u; if (lane < 15 && mycnt) basev = atomicAdd(&cnt[bh * 16 + lane], mycnt);
#pragma unroll
        for (int j = 0; j < 15; ++j) { const bool s = (i0 == j) | (i1 == j) | (i2 == j); const unsigned long long mk = __ballot(s); const unsigned base = (unsigned)__builtin_amdgcn_readlane((int)basev, j);
            if (s) { const unsigned rank = (unsigned)__popcll(mk & ((1ull << lane) - 1ull)); const int slot = (i0 == j) ? 0 : ((i1 == j) ? 1 : 2);
                lists[(size_t)(bh * 16 + j) * 4096 + base + rank] = (unsigned short)(row | (slot << 12)); } }
    }
}

constexpr int GBUF = 65536, G_V = 32768, G_WS = 131072 + 1024, G_CTL = G_WS + 4096, G_ST = G_CTL + 768;
constexpr unsigned G_SINK = 256 * 1024;
__device__ __forceinline__ void gather_dma(unsigned char* ws, int b, int h, int j, LAS unsigned char* lds, int X) {
    int tid_ = threadIdx.x; asm volatile("" : "+v"(tid_)); const int lane = tid_ & 63; const int wid = __builtin_amdgcn_readfirstlane(tid_ >> 6);
    const size_t rowbase = (size_t)b * SEQ + j * 256;
    const unsigned char* kbu = (const unsigned char*)((const _Float16*)(ws + WS_KMB) + rowbase * 512 + h * 64); const unsigned char* vbu = (const unsigned char*)((const _Float16*)(ws + WS_VMB) + rowbase * 512 + h * 64);
    const int r0 = 8 * wid + (lane >> 3), c0 = (lane & 7) ^ ((r0 >> 1) & 7);
    const unsigned ksrc = (unsigned)(r0 * 512 + c0 * 8) * 2u, vsrc = (unsigned)((16 * (wid & 3) + (lane >> 2)) * 512 + (wid >> 2) * 32 + (lane & 3) * 8) * 2u;
    LAS unsigned char* lb = lds + X * GBUF + wid * 1024;
#pragma unroll
    for (int t = 0; t < 4; ++t) {
        glds16((const void*)(kbu + (ksrc + (unsigned)t * 65536u)), (unsigned)__builtin_amdgcn_readfirstlane((int)(unsigned)(size_t)(lb + t * 8192)));
        glds16((const void*)(vbu + (vsrc + (unsigned)t * 65536u)), (unsigned)__builtin_amdgcn_readfirstlane((int)(unsigned)(size_t)(lb + G_V + t * 8192))); }
}
__device__ __forceinline__ void gather_dma_all(unsigned char* ws, int b, int h, int j, LAS unsigned char* lds, int X) {
    int tid_ = threadIdx.x; asm volatile("" : "+v"(tid_)); const int lane = tid_ & 63;
    const size_t rowbase = (size_t)b * SEQ + j * 256;
    const unsigned char* kbu = (const unsigned char*)((const _Float16*)(ws + WS_KMB) + rowbase * 512 + h * 64); const unsigned char* vbu = (const unsigned char*)((const _Float16*)(ws + WS_VMB) + rowbase * 512 + h * 64);
    for (int w = 0; w < 8; ++w) {
        const int r0 = 8 * w + (lane >> 3), c0 = (lane & 7) ^ ((r0 >> 1) & 7);
        const unsigned ksrc = (unsigned)(r0 * 512 + c0 * 8) * 2u, vsrc = (unsigned)((16 * (w & 3) + (lane >> 2)) * 512 + (w >> 2) * 32 + (lane & 3) * 8) * 2u;
        LAS unsigned char* lb = lds + X * GBUF + w * 1024;
#pragma unroll
        for (int t = 0; t < 4; ++t) {
            glds16((const void*)(kbu + (ksrc + (unsigned)t * 65536u)), (unsigned)__builtin_amdgcn_readfirstlane((int)(unsigned)(size_t)(lb + t * 8192)));
            glds16((const void*)(vbu + (vsrc + (unsigned)t * 65536u)), (unsigned)__builtin_amdgcn_readfirstlane((int)(unsigned)(size_t)(lb + G_V + t * 8192))); }
    }
}
__device__ __forceinline__ void gather_unit(unsigned char* ws, int b, int h, int j, LAS unsigned char* lds, int X, LAS unsigned* ctr) {
    constexpr int ND = 4, G = 8;
    int tid_ = threadIdx.x; asm volatile("" : "+v"(tid_));
    const int tid = tid_, lane = tid & 63, r32 = lane & 31, hi = lane >> 5; const int wid = __builtin_amdgcn_readfirstlane(tid >> 6);
    const int bh = b * 8 + h;
    const _Float16* Qg = (const _Float16*)(ws + WS_QMB) + (size_t)b * SEQ * 512 + h * 64;
    const unsigned short* lst = (const unsigned short*)(ws + WS_LIST) + (size_t)(bh * 16 + j) * 4096;
    const int cnt = __builtin_amdgcn_readfirstlane((int)((const unsigned*)(ws + WS_CNT))[bh * 16 + j]);
    const int ngr = (cnt + 31) >> 5;
    LAS unsigned char* kfb = lds + X * GBUF; LAS unsigned char* vfb = kfb + G_V;
    LAS float* wsf = (LAS float*)(lds + G_WS) + wid * 128; LAS unsigned* wsu = (LAS unsigned*)wsf;
    const int vro = ((lane >> 4) & 1) * 32 + (lane & 3) * 8 + (4 * hi + ((lane & 15) >> 2)) * 64;
#define GT_SBAR() __builtin_amdgcn_sched_barrier(0)
#define GT_PIN(x) asm volatile("" : "+v"(x))
#define GT_KF(buf, g) (*(const LAS h8*)(kfb + (buf) * 8192 + kaddr<64>(32 * ((g) & 1) + r32, 2 * ((g) >> 1) + hi)))
#define GT_VF(buf, i) (vfb + (buf) * 8192 + vro + ((i) >> 2) * 4096 + ((i) & 3) * 1024)
#define GT_MF(a, b, c) __builtin_amdgcn_mfma_f32_32x32x16_f16(a, b, c, 0, 0, 0)
#define GT_MOVE(P0, P1, PM) do { const bool move_ = init ? ((PM) > THR) : ((PM) > -INFINITY); \
        if (__any(move_)) { const float dl_ = move_ ? (init ? fmaxf((PM), 0.f) : (PM)) : 0.f; const float al_ = (move_ && init) ? __builtin_amdgcn_exp2f(-dl_) : 1.f; \
            init = init || move_; l_reg *= al_; \
            _Pragma("unroll") for (int r_ = 0; r_ < 16; ++r_) { P0[r_] -= dl_; P1[r_] -= dl_; negm[r_] -= dl_; } \
            if (hi == 0) wsf[r32] = al_; asm volatile("s_waitcnt lgkmcnt(0)" ::: "memory"); \
            _Pragma("unroll") for (int r_ = 0; r_ < 16; ++r_) { const float a_ = wsf[crow(r_, hi)]; o[0][r_] *= a_; o[1][r_] *= a_; } } } while (0)
#define GT_TAKE() ({ unsigned v_ = 0u; if (lane == 0) v_ = __hip_atomic_fetch_add(ctr, 1u, __ATOMIC_RELAXED, __HIP_MEMORY_SCOPE_WORKGROUP); (int)__builtin_amdgcn_readfirstlane((int)v_); })
    h8 qr[ND]; bool validn = false; unsigned entn = 0u;
    int g = GT_TAKE(), gn = ngr;
    if (g < ngr) { const int idx = g * 32 + r32; validn = idx < cnt; entn = validn ? (unsigned)lst[idx] : 0u;
#pragma unroll
        for (int d0 = 0; d0 < ND; ++d0) qr[d0] = *(const h8*)(Qg + (size_t)(entn & 4095u) * 512 + d0 * 16 + hi * 8); }
    for (; g < ngr; g = gn) {
        const bool valid = validn; const unsigned ent = entn; const int row = (int)(ent & 4095u), slot = (int)(ent >> 12) & 3;
        gn = GT_TAKE(); { const int idx = gn * 32 + r32; validn = idx < cnt; entn = validn ? (unsigned)lst[idx] : 0u; }
#pragma unroll
        for (int d0 = 0; d0 < ND; ++d0) asm volatile("" : "+v"(qr[d0]));
        float l_reg = 0.f; bool init = false; f16v o[2]; o[0] = f16v{}; o[1] = f16v{}; f16v negm = f16v{}; asm volatile("" : "+v"(negm));
        f16v pC0, pC1, pD0, pD1;
        {
            h8 kf_[G];
#pragma unroll
            for (int g_ = 0; g_ < G; ++g_) kf_[g_] = GT_KF(0, g_);
            GT_SBAR();
#pragma unroll
            for (int d_ = 0; d_ < ND; ++d_) { pC0 = GT_MF(kf_[2 * d_], qr[d_], d_ == 0 ? negm : pC0); pC1 = GT_MF(kf_[2 * d_ + 1], qr[d_], d_ == 0 ? negm : pC1); }
            asm volatile("s_nop 15\n\ts_nop 7" : "+v"(pC0), "+v"(pC1));
            float pa_ = max3f(pC0[0], pC0[1], pC1[0]), pb_ = max3f(pC0[2], pC0[3], pC1[1]); pa_ = max3f(pa_, pC1[2], pC1[3]);
#pragma unroll
            for (int r_ = 4; r_ < 16; r_ += 4) { pa_ = max3f(pa_, pC0[r_], pC0[r_ + 1]); pb_ = max3f(pb_, pC0[r_ + 2], pC0[r_ + 3]); pa_ = max3f(pa_, pC1[r_], pC1[r_ + 1]); pb_ = max3f(pb_, pC1[r_ + 2], pC1[r_ + 3]); }
            const float pm = swapmax(fmaxf(pa_, pb_)); GT_MOVE(pC0, pC1, pm);
        }
        auto gstep = [&](f16v& pC0, f16v& pC1, f16v& pN0, f16v& pN1, const int t, auto hn) __attribute__((always_inline)) {
            constexpr bool hasn = decltype(hn)::value;
            float ps = 0.f;
            if (hasn) {
                h8 kf[G];
#pragma unroll
                for (int g_ = 0; g_ < 4; ++g_) kf[g_] = GT_KF(t + 1, g_);
                GT_SBAR();
#pragma unroll
                for (int g_ = 0; g_ < G; ++g_) {
                    if (g_ + 4 < G) kf[g_ + 4] = GT_KF(t + 1, g_ + 4);
                    if (g_ & 1) pN1 = GT_MF(kf[g_], qr[g_ >> 1], g_ == 1 ? negm : pN1); else pN0 = GT_MF(kf[g_], qr[g_ >> 1], g_ == 0 ? negm : pN0);
#pragma unroll
                    for (int e = 4 * g_; e < 4 * g_ + 4; ++e) { if (e < 16) { pC0[e] = __builtin_amdgcn_exp2f(pC0[e]); ps += pC0[e]; } else { pC1[e - 16] = __builtin_amdgcn_exp2f(pC1[e - 16]); ps += pC1[e - 16]; } }
                    GT_PIN(pC0); GT_PIN(pC1); GT_PIN(ps); GT_SBAR();
                }
            } else {
#pragma unroll
                for (int r = 0; r < 16; ++r) { pC0[r] = __builtin_amdgcn_exp2f(pC0[r]); pC1[r] = __builtin_amdgcn_exp2f(pC1[r]); ps += pC0[r] + pC1[r]; }
            }
            l_reg += swapsum(ps);
            u4 pw[4];
#pragma unroll
            for (int k_ = 0; k_ < 2; ++k_) {
                pw[k_] = (u4){pkh(pC0[8 * k_], pC0[8 * k_ + 1]), pkh(pC0[8 * k_ + 2], pC0[8 * k_ + 3]), pkh(pC0[8 * k_ + 4], pC0[8 * k_ + 5]), pkh(pC0[8 * k_ + 6], pC0[8 * k_ + 7])};
                pw[2 + k_] = (u4){pkh(pC1[8 * k_], pC1[8 * k_ + 1]), pkh(pC1[8 * k_ + 2], pC1[8 * k_ + 3]), pkh(pC1[8 * k_ + 4], pC1[8 * k_ + 5]), pkh(pC1[8 * k_ + 6], pC1[8 * k_ + 7])}; }
            s4 vlo[8], vhi[8]; float pa = 0.f, pb = 0.f;
#pragma unroll
            for (int i = 0; i < 3; ++i) { vlo[i] = vtr(GT_VF(t, i)); vhi[i] = vtr(GT_VF(t, i) + 512); }
            if (hasn) asm volatile("s_nop 7" : "+v"(pN0), "+v"(pN1));
            GT_SBAR();
#pragma unroll
            for (int i = 0; i < 8; ++i) {
                if (i + 3 < 8) { vlo[i + 3] = vtr(GT_VF(t, i + 3)); vhi[i + 3] = vtr(GT_VF(t, i + 3) + 512); }
                const s8 vv = (s8){vlo[i][0], vlo[i][1], vlo[i][2], vlo[i][3], vhi[i][0], vhi[i][1], vhi[i][2], vhi[i][3]};
                o[i >> 2] = GT_MF(__builtin_bit_cast(h8, pw[i & 3]), __builtin_bit_cast(h8, vv), o[i >> 2]);
                if (hasn) {
                    if (i == 0) { pa = max3f(pN0[0], pN0[1], pN1[0]); pb = max3f(pN0[2], pN0[3], pN1[1]); }
                    else if (i == 1) { pa = max3f(pa, pN1[2], pN1[3]); pb = max3f(pb, pN0[6], pN0[7]); }
                    else if (i == 2) { pa = max3f(pa, pN0[4], pN0[5]); pb = max3f(pb, pN1[6], pN1[7]); }
                    else if (i == 3) { pa = max3f(pa, pN1[4], pN1[5]); pb = max3f(pb, pN0[10], pN0[11]); }
                    else if (i == 4) { pa = max3f(pa, pN0[8], pN0[9]); pb = max3f(pb, pN1[10], pN1[11]); }
                    else if (i == 5) { pa = max3f(pa, pN1[8], pN1[9]); pb = max3f(pb, pN0[14], pN0[15]); }
                    else if (i == 6) { pa = max3f(pa, pN0[12], pN0[13]); pb = max3f(pb, pN1[14], pN1[15]); }
                    else { pa = max3f(pa, pN1[12], pN1[13]); }
                    GT_PIN(pa); GT_PIN(pb);
                }
                GT_SBAR();
            }
            if (hasn) { const float pm = swapmax(fmaxf(pa, pb)); GT_MOVE(pN0, pN1, pm); }
        };
        gstep(pC0, pC1, pD0, pD1, 0, T1{}); gstep(pD0, pD1, pC0, pC1, 1, T1{}); gstep(pC0, pC1, pD0, pD1, 2, T1{}); gstep(pD0, pD1, pC0, pC1, 3, T0{});
        if (gn < ngr) {
#pragma unroll
            for (int d0 = 0; d0 < ND; ++d0) qr[d0] = *(const h8*)(Qg + (size_t)(entn & 4095u) * 512 + d0 * 16 + hi * 8); }
        const unsigned gr = (unsigned)(bh * 4096 + row);
        if (hi == 0) { wsf[32 + r32] = 1.f / l_reg; wsu[64 + r32] = valid ? opart_off(slot) + gr * 128u : G_SINK;
            if (valid) ((float2*)(ws + WS_ML))[(unsigned)slot * 524288u + gr] = make_float2(-negm[0], l_reg); }
        asm volatile("s_waitcnt lgkmcnt(0)" ::: "memory");
#pragma unroll
        for (int k = 0; k < 4; ++k) {
            typedef float f4e __attribute__((ext_vector_type(4)));
            const f4e rl4 = *(const LAS f4e*)(wsf + 32 + 8 * k + 4 * hi); const u4 of4 = *(const LAS u4*)(wsu + 64 + 8 * k + 4 * hi);
#pragma unroll
            for (int i = 0; i < 4; ++i) { const int r = 4 * k + i; const unsigned off = of4[i] + (unsigned)r32 * 2u;
                *(_Float16*)(ws + off) = (_Float16)(o[0][r] * rl4[i]); *(_Float16*)(ws + off + 64u) = (_Float16)(o[1][r] * rl4[i]); } }
    }
#undef GT_TAKE
#undef GT_SBAR
#undef GT_PIN
#undef GT_KF
#undef GT_VF
#undef GT_MF
#undef GT_MOVE
}


__device__ __forceinline__ void own_unit(unsigned char* ws, int b, int h, int qb, LAS unsigned char* lds, int X, bool dry, int rg) {
    constexpr int ND = 4, G = 8;
    int tid_ = threadIdx.x; asm volatile("" : "+v"(tid_));
    const int tid = tid_, lane = tid & 63, r32 = lane & 31, hi = lane >> 5; const int wid = __builtin_amdgcn_readfirstlane(tid >> 6);
    const int bh = b * 8 + h, nt = (rg >> 1) + 1; const bool odd = rg & 1; const int qw0 = qb * 256 + rg * 32;
    const _Float16* Qg = (const _Float16*)(ws + WS_QMB) + ((size_t)b * SEQ + qw0) * 512 + h * 64;
    LAS unsigned char* kfb = lds + X * GBUF; LAS unsigned char* vfb = kfb + G_V;
    LAS float* wsf = (LAS float*)(lds + G_WS) + wid * 128;
    const int vro = ((lane >> 4) & 1) * 32 + (lane & 3) * 8 + (4 * hi + ((lane & 15) >> 2)) * 64;
    const int dl = r32 - 4 * hi;
#define GT_SBAR() __builtin_amdgcn_sched_barrier(0)
#define GT_PIN(x) asm volatile("" : "+v"(x))
#define GT_KF(buf, g) (*(const LAS h8*)(kfb + (buf) * 8192 + kaddr<64>(32 * ((g) & 1) + r32, 2 * ((g) >> 1) + hi)))
#define GT_VF(buf, i) (vfb + (buf) * 8192 + vro + ((i) >> 2) * 4096 + ((i) & 3) * 1024)
#define GT_MF(a, b, c) __builtin_amdgcn_mfma_f32_32x32x16_f16(a, b, c, 0, 0, 0)
#define GT_MOVE(P0, P1, PM) do { const bool move_ = init ? ((PM) > THR) : ((PM) > -INFINITY); \
        if (__any(move_)) { const float dl_ = move_ ? (init ? fmaxf((PM), 0.f) : (PM)) : 0.f; const float al_ = (move_ && init) ? __builtin_amdgcn_exp2f(-dl_) : 1.f; \
            init = init || move_; l_reg *= al_; \
            _Pragma("unroll") for (int r_ = 0; r_ < 16; ++r_) { P0[r_] -= dl_; P1[r_] -= dl_; negm[r_] -= dl_; } \
            if (hi == 0) wsf[r32] = al_; asm volatile("s_waitcnt lgkmcnt(0)" ::: "memory"); \
            _Pragma("unroll") for (int r_ = 0; r_ < 16; ++r_) { const float a_ = wsf[crow(r_, hi)]; o[0][r_] *= a_; o[1][r_] *= a_; } } } while (0)
#define GT_MASK(P0, P1) do { _Pragma("unroll") for (int r_ = 0; r_ < 16; ++r_) { const bool dg_ = ((r_ & 3) + 8 * (r_ >> 2)) > dl; \
            if (!odd) { if (dg_) P0[r_] = -INFINITY; P1[r_] = -INFINITY; } else { if (dg_) P1[r_] = -INFINITY; } } } while (0)
    h8 qr[ND];
#pragma unroll
    for (int d0 = 0; d0 < ND; ++d0) qr[d0] = *(const h8*)(Qg + (size_t)r32 * 512 + d0 * 16 + hi * 8);
#pragma unroll
    for (int d0 = 0; d0 < ND; ++d0) asm volatile("" : "+v"(qr[d0]));
    float l_reg = 0.f; bool init = false; f16v o[2]; o[0] = f16v{}; o[1] = f16v{}; f16v negm = f16v{}; asm volatile("" : "+v"(negm));
    f16v pC0, pC1, pD0, pD1;
    {
        h8 kf_[G];
#pragma unroll
        for (int g_ = 0; g_ < G; ++g_) kf_[g_] = GT_KF(0, g_);
        GT_SBAR();
#pragma unroll
        for (int d_ = 0; d_ < ND; ++d_) { pC0 = GT_MF(kf_[2 * d_], qr[d_], d_ == 0 ? negm : pC0); pC1 = GT_MF(kf_[2 * d_ + 1], qr[d_], d_ == 0 ? negm : pC1); }
        asm volatile("s_nop 15\n\ts_nop 7" : "+v"(pC0), "+v"(pC1));
        if (nt == 1) GT_MASK(pC0, pC1);
        float pa_ = max3f(pC0[0], pC0[1], pC1[0]), pb_ = max3f(pC0[2], pC0[3], pC1[1]); pa_ = max3f(pa_, pC1[2], pC1[3]);
#pragma unroll
        for (int r_ = 4; r_ < 16; r_ += 4) { pa_ = max3f(pa_, pC0[r_], pC0[r_ + 1]); pb_ = max3f(pb_, pC0[r_ + 2], pC0[r_ + 3]); pa_ = max3f(pa_, pC1[r_], pC1[r_ + 1]); pb_ = max3f(pb_, pC1[r_ + 2], pC1[r_ + 3]); }
        const float pm = swapmax(fmaxf(pa_, pb_)); GT_MOVE(pC0, pC1, pm);
    }
    auto gstep = [&](f16v& pC0, f16v& pC1, f16v& pN0, f16v& pN1, const int t, auto hn, const bool mk) __attribute__((always_inline)) {
        constexpr bool hasn = decltype(hn)::value;
        float ps = 0.f; f2v ps2 = (f2v){0.f, 0.f};
        if (hasn) {
            h8 kf[G];
#pragma unroll
            for (int g_ = 0; g_ < 4; ++g_) kf[g_] = GT_KF(t + 1, g_);
            GT_SBAR();
#pragma unroll
            for (int g_ = 0; g_ < G; ++g_) {
                if (g_ + 4 < G) kf[g_ + 4] = GT_KF(t + 1, g_ + 4);
                if (g_ & 1) pN1 = GT_MF(kf[g_], qr[g_ >> 1], g_ == 1 ? negm : pN1); else pN0 = GT_MF(kf[g_], qr[g_ >> 1], g_ == 0 ? negm : pN0);
#pragma unroll
                for (int e = 4 * g_; e < 4 * g_ + 4; ++e) { if (e < 16) { pC0[e] = __builtin_amdgcn_exp2f(pC0[e]); ps += pC0[e]; } else { pC1[e - 16] = __builtin_amdgcn_exp2f(pC1[e - 16]); ps += pC1[e - 16]; } }
                GT_PIN(pC0); GT_PIN(pC1); GT_PIN(ps); GT_SBAR();
            }
        } else {
#pragma unroll
            for (int r = 0; r < 16; ++r) { pC0[r] = __builtin_amdgcn_exp2f(pC0[r]); pC1[r] = __builtin_amdgcn_exp2f(pC1[r]); ps += pC0[r] + pC1[r]; }
        }
        l_reg += swapsum(ps);
        u4 pw[4];
#pragma unroll
        for (int k_ = 0; k_ < 2; ++k_) {
            pw[k_] = (u4){pkh(pC0[8 * k_], pC0[8 * k_ + 1]), pkh(pC0[8 * k_ + 2], pC0[8 * k_ + 3]), pkh(pC0[8 * k_ + 4], pC0[8 * k_ + 5]), pkh(pC0[8 * k_ + 6], pC0[8 * k_ + 7])};
            pw[2 + k_] = (u4){pkh(pC1[8 * k_], pC1[8 * k_ + 1]), pkh(pC1[8 * k_ + 2], pC1[8 * k_ + 3]), pkh(pC1[8 * k_ + 4], pC1[8 * k_ + 5]), pkh(pC1[8 * k_ + 6], pC1[8 * k_ + 7])}; }
        s4 vlo[8], vhi[8]; float pa = 0.f, pb = 0.f;
#pragma unroll
        for (int i = 0; i < 3; ++i) { vlo[i] = vtr(GT_VF(t, i)); vhi[i] = vtr(GT_VF(t, i) + 512); }
        if (hasn) { asm volatile("s_nop 7" : "+v"(pN0), "+v"(pN1)); if (mk) GT_MASK(pN0, pN1); }
        GT_SBAR();
#pragma unroll
        for (int i = 0; i < 8; ++i) {
            if (i + 3 < 8) { vlo[i + 3] = vtr(GT_VF(t, i + 3)); vhi[i + 3] = vtr(GT_VF(t, i + 3) + 512); }
            const s8 vv = (s8){vlo[i][0], vlo[i][1], vlo[i][2], vlo[i][3], vhi[i][0], vhi[i][1], vhi[i][2], vhi[i][3]};
            o[i >> 2] = GT_MF(__builtin_bit_cast(h8, pw[i & 3]), __builtin_bit_cast(h8, vv), o[i >> 2]);
            if (hasn) {
                if (i == 0) { pa = max3f(pN0[0], pN0[1], pN1[0]); pb = max3f(pN0[2], pN0[3], pN1[1]); }
                else if (i == 1) { pa = max3f(pa, pN1[2], pN1[3]); pb = max3f(pb, pN0[6], pN0[7]); }
                else if (i == 2) { pa = max3f(pa, pN0[4], pN0[5]); pb = max3f(pb, pN1[6], pN1[7]); }
                else if (i == 3) { pa = max3f(pa, pN1[4], pN1[5]); pb = max3f(pb, pN0[10], pN0[11]); }
                else if (i == 4) { pa = max3f(pa, pN0[8], pN0[9]); pb = max3f(pb, pN1[10], pN1[11]); }
                else if (i == 5) { pa = max3f(pa, pN1[8], pN1[9]); pb = max3f(pb, pN0[14], pN0[15]); }
                else if (i == 6) { pa = max3f(pa, pN0[12], pN0[13]); pb = max3f(pb, pN1[14], pN1[15]); }
                else { pa = max3f(pa, pN1[12], pN1[13]); }
                GT_PIN(pa); GT_PIN(pb);
            }
            GT_SBAR();
        }
        if (hasn) { const float pm = swapmax(fmaxf(pa, pb)); GT_MOVE(pN0, pN1, pm); }
    };
    for (int t = 0; t < nt - 1; ++t) { gstep(pC0, pC1, pD0, pD1, t, T1{}, t + 2 == nt); pC0 = pD0; pC1 = pD1; }
    gstep(pC0, pC1, pD0, pD1, nt - 1, T0{}, false);
    if (hi == 0) { wsf[32 + r32] = 1.f / l_reg; wsf[64 + r32] = l_reg; wsf[r32] = -negm[0]; }
    int lane_e = lane; asm volatile("" : "+v"(lane_e));
    const int row8 = lane_e >> 3, ch = lane_e & 7, nsl = qb < 3 ? qb : 3;
    unsigned char* zbu = (unsigned char*)((_Float16*)(ws + WS_ZCAT) + 512 + ((size_t)b * SEQ + qw0) * 1024 + h * 64);
    h8 zz[4], po[4][3]; float2 ml[4][3];
#pragma unroll
    for (int k = 0; k < 4; ++k) { const int row = 8 * k + row8; const unsigned gr = (unsigned)(bh * 4096 + qw0 + row);
        zz[k] = *(const h8*)(zbu + (unsigned)(row * 1024 + ch * 8) * 2u);
#pragma unroll
        for (int s = 0; s < 3; ++s) if (s < nsl) { ml[k][s] = ((const float2*)(ws + WS_ML))[(unsigned)s * 524288u + gr]; po[k][s] = *(const h8*)(ws + opart_off(s) + gr * 128u + (unsigned)ch * 16u); } }
    asm volatile("s_waitcnt lgkmcnt(0)" ::: "memory");
    LAS _Float16* stg = (LAS _Float16*)(lds + G_ST) + wid * 512;
#pragma unroll
    for (int k = 0; k < 4; ++k) {
        typedef float f4e __attribute__((ext_vector_type(4)));
        const f4e rl4 = *(const LAS f4e*)(wsf + 32 + 8 * k + 4 * hi);
#pragma unroll
        for (int i = 0; i < 4; ++i) { stg[(4 * hi + i) * 64 + r32] = (_Float16)(o[0][4 * k + i] * rl4[i]); stg[(4 * hi + i) * 64 + 32 + r32] = (_Float16)(o[1][4 * k + i] * rl4[i]); }
        asm volatile("s_waitcnt lgkmcnt(0)" ::: "memory");
        const int row = 8 * k + row8; const h8 v = *(const LAS h8*)(stg + row8 * 64 + ch * 8);
        const float m_own = wsf[row], l_own = wsf[64 + row]; float M = m_own;
#pragma unroll
        for (int s = 0; s < 3; ++s) if (s < nsl) M = fmaxf(M, ml[k][s].x);
        const float w0 = l_own * __builtin_amdgcn_exp2f(m_own - M); float W = w0; float acc[8];
#pragma unroll
        for (int j = 0; j < 8; ++j) acc[j] = w0 * (float)v[j];
#pragma unroll
        for (int s = 0; s < 3; ++s) if (s < nsl) { const float w = ml[k][s].y * __builtin_amdgcn_exp2f(ml[k][s].x - M); W += w;
#pragma unroll
            for (int j = 0; j < 8; ++j) acc[j] = fmaf(w, (float)po[k][s][j], acc[j]); }
        const float rW = 1.f / W; h8 ov;
#pragma unroll
        for (int j = 0; j < 8; ++j) ov[j] = (_Float16)(acc[j] * rW * (float)zz[k][j]);
        if (!dry) *(h8*)(zbu + (unsigned)(row * 1024 + ch * 8) * 2u) = ov;
    }
#undef GT_SBAR
#undef GT_PIN
#undef GT_KF
#undef GT_VF
#undef GT_MF
#undef GT_MOVE
#undef GT_MASK
}

__device__ __forceinline__ void attn_phase(unsigned char* ws, LAS unsigned char* lds, int vb, int nvb) {
    const int vcu = (nvb % 8 == 0) ? (vb % 8) * (nvb / 8) + vb / 8 : vb; const int per = (1024 + nvb - 1) / nvb;
    for (int k = 0; k < per; ++k) {
        int it;
        if (nvb == 256) { const int xg = vcu >> 5, lw = vcu & 31; it = ((16 * xg + 4 * k + (lw >> 3)) << 3) | (lw & 7); }
        else { it = vcu * per + k; if (it >= 1024) break; }
        const int bh = it >> 3, pr = it & 7, b = bh >> 3, h = bh & 7;
        if (PROBE == 2) for (int uu = 0; uu < 2; ++uu) attn_unit<96, false, PROBE_ABL>(ws, b, h, uu ? 15 - pr : pr, lds, true);
        for (int uu = 0; uu < 2; ++uu) attn_unit<96, false>(ws, b, h, uu ? 15 - pr : pr, lds);
    }
    int nu = 0;
    for (int k = 0; k < per; ++k) { int it; if (nvb == 256) { const int xg = vcu >> 5, lw = vcu & 31; it = ((16 * xg + 4 * k + (lw >> 3)) << 3) | (lw & 7); } else { it = vcu * per + k; if (it >= 1024) break; } nu += 2; }
    auto unit_of = [&](int u, int& b, int& h, int& j) {
        const int k = u >> 1; int it; if (nvb == 256) { const int xg = vcu >> 5, lw = vcu & 31; it = ((16 * xg + 4 * k + (lw >> 3)) << 3) | (lw & 7); } else it = vcu * per + k;
        const int bh = it >> 3, pr = it & 7, rot = (bh >> 2) & 3; b = bh >> 3; h = bh & 7;
        const int sl = ((pr & 3) + rot) & 3; const int x = pr < 4 ? ((0x6170 >> (4 * sl)) & 15) : ((0x4352 >> (4 * sl)) & 15);
        j = (u & 1) ? 14 - x : x; return !((u & 1) && x == 7); };
    LAS unsigned* gc = (LAS unsigned*)(lds + G_CTL);
    int tid_g = threadIdx.x; asm volatile("" : "+v"(tid_g)); const int lane_g = tid_g & 63;
    for (int rep = 0; rep < (PROBE == 12 ? 2 : 1); ++rep)
    for (int u0 = 0; u0 < nu; u0 += 64) {
        const int nc = nu - u0 < 64 ? nu - u0 : 64;
        if (tid_g < 192) gc[tid_g] = 0u;
        { int b, h, j; if (unit_of(u0, b, h, j)) gather_dma(ws, b, h, j, lds, 0); if (nc > 1 && unit_of(u0 + 1, b, h, j)) gather_dma(ws, b, h, j, lds, 1); }
        asm volatile("s_waitcnt vmcnt(0)" ::: "memory"); __syncthreads();
        for (int uc = 0; uc < nc; ++uc) {
            int b, h, j; const bool ok = unit_of(u0 + uc, b, h, j);
            if (uc >= 2) while (((volatile LAS unsigned*)gc)[128 + uc] == 0u) __builtin_amdgcn_s_sleep(4);
            if (ok) gather_unit(ws, b, h, j, lds, uc & 1, gc + uc);
            unsigned n = 0u; if (lane_g == 0) n = __hip_atomic_fetch_add(gc + 64 + uc, 1u, __ATOMIC_RELAXED, __HIP_MEMORY_SCOPE_WORKGROUP);
            n = (unsigned)__builtin_amdgcn_readfirstlane((int)n) + 1u;
            if (n == 8u && uc + 2 < nc) { int b2, h2, j2;
                if (unit_of(u0 + uc + 2, b2, h2, j2)) { gather_dma_all(ws, b2, h2, j2, lds, uc & 1); asm volatile("s_waitcnt vmcnt(0)" ::: "memory"); }
                if (lane_g == 0) ((volatile LAS unsigned*)gc)[128 + uc + 2] = 1u; }
        }
        __syncthreads();
    }
}
template <bool DRY> __device__ __forceinline__ void attn_phase2_pass(unsigned char* ws, LAS unsigned char* lds, int vb, int nvb) {
    LAS unsigned* gc = (LAS unsigned*)(lds + G_CTL);
    int tid_g = threadIdx.x; asm volatile("" : "+v"(tid_g)); const int lane_g = tid_g & 63;
    const int nu = vb < 2048 ? (2048 - vb + nvb - 1) / nvb : 0;
    for (int u0 = 0; u0 < nu; u0 += 64) {
        const int nc = nu - u0 < 64 ? nu - u0 : 64;
        if (tid_g < 192) gc[tid_g] = 0u;
        { const int i0 = vb + u0 * nvb; gather_dma(ws, i0 >> 7, (i0 >> 4) & 7, i0 & 15, lds, 0); if (nc > 1) { const int i1 = i0 + nvb; gather_dma(ws, i1 >> 7, (i1 >> 4) & 7, i1 & 15, lds, 1); } }
        asm volatile("s_waitcnt vmcnt(0)" ::: "memory"); __syncthreads();
        for (int uc = 0; uc < nc; ++uc) {
            const int it = vb + (u0 + uc) * nvb;
            if (uc >= 2) while (((volatile LAS unsigned*)gc)[128 + uc] == 0u) __builtin_amdgcn_s_sleep(4);
            for (;;) { unsigned c = 0u; if (lane_g == 0) c = __hip_atomic_fetch_add(gc + uc, 1u, __ATOMIC_RELAXED, __HIP_MEMORY_SCOPE_WORKGROUP);
                c = (unsigned)__builtin_amdgcn_readfirstlane((int)c); if (c >= 8u) break;
                own_unit(ws, it >> 7, (it >> 4) & 7, it & 15, lds, uc & 1, DRY, 7 - (int)c); }
            unsigned n = 0u; if (lane_g == 0) n = __hip_atomic_fetch_add(gc + 64 + uc, 1u, __ATOMIC_RELAXED, __HIP_MEMORY_SCOPE_WORKGROUP);
            n = (unsigned)__builtin_amdgcn_readfirstlane((int)n) + 1u;
            if (n == 8u && uc + 2 < nc) { const int i2 = it + 2 * nvb; gather_dma_all(ws, i2 >> 7, (i2 >> 4) & 7, i2 & 15, lds, uc & 1); asm volatile("s_waitcnt vmcnt(0)" ::: "memory");
                if (lane_g == 0) ((volatile LAS unsigned*)gc)[128 + uc + 2] = 1u; }
        }
        __syncthreads();
    }
}
__device__ __forceinline__ void attn_phase2(unsigned char* ws, LAS unsigned char* lds, int vb, int nvb) {
    if (PROBE == 13) attn_phase2_pass<true>(ws, lds, vb, nvb);
    attn_phase2_pass<false>(ws, lds, vb, nvb);
}
}

constexpr int RING_BYTES = 131072, MISC_OFF = RING_BYTES + 320, LDS_BYTES = 147456;
constexpr int CW_BAR = 4096;

__global__ void __launch_bounds__(512, 2) mega(Params p) {
    extern __shared__ __attribute__((aligned(16))) unsigned char lds[];
    const int vb = blockIdx.x, nvb = gridDim.x, tid = threadIdx.x, lane = tid & 63, wave = tid >> 6;
    const int gtid = vb * 512 + tid, gsize = nvb * 512, gwave = vb * 8 + wave, nwaves = nvb * 8;
    volatile LAS unsigned* misc = (volatile LAS unsigned*)((LAS unsigned char*)lds + MISC_OFF);
    if (tid < 32) misc[tid] = 0u;
    __syncthreads();
    XcdBarrier bar = xcd_barrier_post((unsigned*)(p.ws + WS_CTL) + CW_BAR, misc + 8);
    LAS unsigned char* ldsl = (LAS unsigned char*)lds;
    { int t_ = threadIdx.x; asm volatile("" : "+v"(t_)); ph_prep(p, vb * 512 + t_, gsize, vb, nvb, ldsl); ph_weights(p, ldsl, vb * 8 + (t_ >> 6), nwaves, t_ >> 6, t_ & 63);
      if (PROBE == 10) ph_weights(p, ldsl, vb * 8 + (t_ >> 6), nwaves, t_ >> 6, t_ & 63);
      if (PROBE == 11) ph_tab(p, vb * 512 + t_, gsize); }
    xcd_barrier(bar);
    for (int rep4 = 0; rep4 < ((PROBE == 4 || PROBE == 6) ? 2 : 1); ++rep4) { int t_ = threadIdx.x; asm volatile("" : "+v"(t_)); ph_hnorm(p, vb * 8 + (t_ >> 6), nwaves, t_ & 63); }
    xcd_barrier(bar);
    {
        pg8::Gemm g{(const pg8::bf16_t*)(p.ws + WS_H), (const pg8::bf16_t*)(p.ws + WT_IN), M_, 5120, 1024}; pg8::StaticOrder S; S.init(M_, 5120, nvb, vb);
        for (int rep = (PROBE == 1 ? 1 : 0); rep >= 0; --rep) { pg8::EpiInF E{p.ws, p.b_merge, rep}; pg8::gemm_phase<pg8::EpiInF, pg8::StaticOrder, true, true>(ldsl, g, S, E); }
        if (PROBE == 5) { pg8::EpiNull E; pg8::gemm_phase<pg8::EpiNull, pg8::StaticOrder, true, true>(ldsl, g, S, E); }
    }
    xcd_barrier(bar);
    { int t_ = threadIdx.x; asm volatile("" : "+v"(t_)); att::ph_gate(p.ws, vb * 8 + (t_ >> 6), nwaves, t_ & 63); }
    for (int rep4 = 0; rep4 < ((PROBE == 4 || PROBE == 7) ? 2 : 1); ++rep4) {
        pg8::Gemm g{(const pg8::bf16_t*)(p.ws + WS_QLAT), (const pg8::bf16_t*)(p.ws + WT_UQ), M_, 768, 256}; pg8::StaticOrder S; S.init(M_, 768, nvb, vb);
        pg8::EpiUqF E{p.ws}; pg8::gemm_phase<pg8::EpiUqF, pg8::StaticOrder, true, true>(ldsl, g, S, E);
    }
    for (int rep4 = 0; rep4 < ((PROBE == 4 || PROBE == 7) ? 2 : 1); ++rep4) {
        pg8::Gemm g{(const pg8::bf16_t*)(p.ws + WS_KVL), (const pg8::bf16_t*)(p.ws + WT_UKV), M_, 1024, 128};     pg8::StaticOrder S; S.init(M_, 1024, nvb, vb);
        pg8::EpiUkvF E{p.ws}; pg8::gemm_phase<pg8::EpiUkvF, pg8::StaticOrder, true, true>(ldsl, g, S, E);
    }
    xcd_barrier(bar);
    att::attn_phase(p.ws, ldsl, vb, nvb);
    xcd_barrier(bar);
    att::attn_phase2(p.ws, ldsl, vb, nvb);
    xcd_barrier(bar);
    {
        pg8::Gemm g{(const pg8::bf16_t*)(p.ws + WS_ZCAT), (const pg8::bf16_t*)(p.ws + WT_OA), M_, 1024, 1024}; pg8::StaticOrder S; S.init(M_, 1024, nvb, vb);
        pg8::EpiYcatF E{p.ws}; pg8::gemm_phase<pg8::EpiYcatF, pg8::StaticOrder, true, true>(ldsl, g, S, E);
    }
    xcd_barrier(bar);
    for (int rep4 = 0; rep4 < ((PROBE == 4 || PROBE == 9) ? 2 : 1); ++rep4) {
        pg8::Gemm g{(const pg8::bf16_t*)(p.ws + WS_YM), (const pg8::bf16_t*)(p.ws + WT_OUT), M_, 1024, 1024}; pg8::StaticOrder S; S.init(M_, 1024, nvb, vb);
        pg8::EpiYF E{p.ws}; pg8::gemm_phase<pg8::EpiYF, pg8::StaticOrder, true, true>(ldsl, g, S, E);
    }
    xcd_barrier(bar);
    for (int rep4 = 0; rep4 < ((PROBE == 4 || PROBE == 9) ? 2 : 1); ++rep4) { int t_ = threadIdx.x; asm volatile("" : "+v"(t_)); ph_final(p, vb * 8 + (t_ >> 6), nwaves, t_ & 63); }
}

extern "C" void kernel_launch(void* const* d_in, const int* in_sizes, int n_in, void* d_out, int out_size, void* d_ws, size_t ws_size, hipStream_t stream) {
    if (n_in != 16 || out_size != M_ * DM || ws_size < WS_END) { fprintf(stderr, "kernel_launch: unexpected shapes (n_in %d, out %d, ws %zu)\n", n_in, out_size, ws_size); return; }
    Params p{};
    p.x = (const float*)d_in[0]; p.c = (const float*)d_in[1]; p.pos = (const int*)d_in[2]; p.w_ada = (const float*)d_in[3]; p.b_ada = (const float*)d_in[4];
    p.g_pre = (const float*)d_in[5]; p.g_post = (const float*)d_in[6]; p.w_in = (const float*)d_in[7]; p.g_q = (const float*)d_in[8]; p.w_uq = (const float*)d_in[9];
    p.g_kv = (const float*)d_in[10]; p.w_ukv = (const float*)d_in[11]; p.w_o_mla = (const float*)d_in[12]; p.w_o_moba = (const float*)d_in[13]; p.b_merge = (const float*)d_in[14]; p.w_out = (const float*)d_in[15];
    p.out = (float*)d_out; p.ws = (unsigned char*)d_ws;
    static int grid = 0;
    if (grid == 0) {
        int dev = 0, cus = 0, per_cu = 0;
        if (hipGetDevice(&dev) != hipSuccess || hipDeviceGetAttribute(&cus, hipDeviceAttributeMultiprocessorCount, dev) != hipSuccess) { fprintf(stderr, "kernel_launch: device query failed\n"); grid = -1; return; }
        if (hipFuncSetAttribute((const void*)mega, hipFuncAttributeMaxDynamicSharedMemorySize, LDS_BYTES) != hipSuccess) { fprintf(stderr, "kernel_launch: hipFuncSetAttribute failed\n"); grid = -1; return; }
        if (hipOccupancyMaxActiveBlocksPerMultiprocessor(&per_cu, (const void*)mega, 512, LDS_BYTES) != hipSuccess || per_cu < 1) { fprintf(stderr, "kernel_launch: occupancy query says %d\n", per_cu); }
        (void)hipGetLastError();
        grid = cus;
    }
    if (grid < 0) return;
    (void)hipMemsetAsync(d_ws, 0, ZERO_BYTES, stream);
    hipLaunchKernelGGL(mega, dim3(grid), dim3(512), LDS_BYTES, stream, p);
}
```

```cpp
#include <hip/hip_runtime.h>
#include <cstdio>
#ifndef PROBE
#define PROBE 0
#endif
#include <cstdint>

typedef _Float16 h16;
typedef _Float16 h16x4 __attribute__((ext_vector_type(4)));
typedef _Float16 h2n __attribute__((ext_vector_type(2)));

constexpr int NB = 16, SEQ = 4096, DM = 1024, M_ = NB * SEQ, NH = 8;
constexpr int D_IN = 5024;
constexpr int C_QLAT = 0, C_KVLAT = 256, C_KROPE = 384, C_ZMLA = 416, C_QMB = 928, C_KMB = 1440, C_VMB = 1952, C_ZMB = 2464, C_GA = 2976, C_GB = 4000;
constexpr float EPS = 1e-6f;
constexpr float LOG2E = 1.4426950408889634f;
constexpr float SC_MLA = 0.10206207261596577f * LOG2E;
constexpr float SC_MB = 0.125f * LOG2E;

constexpr size_t MiB = 1u << 20;
constexpr size_t WS_CTL = 0, WS_KMEAN = 512 * 1024, WS_SSQ = 1 * MiB, WS_SSQY = WS_SSQ + 2 * (size_t)M_ * 4, ZERO_BYTES = 2 * MiB;
constexpr size_t WS_MOD = WS_SSQ + 3 * (size_t)M_ * 4, WS_TAB = 4 * MiB, WS_WT = 20 * MiB;
constexpr size_t WS_H = 36 * MiB, WS_KN = 36 * MiB, WS_VM = 100 * MiB;
constexpr size_t WS_QLAT = 164 * MiB, WS_KVL = 196 * MiB, WS_KPE = 228 * MiB, WS_VMB = 232 * MiB;
constexpr size_t WS_QMB = 296 * MiB, WS_KMB = 360 * MiB, WS_ZCAT = 424 * MiB, WS_YM = 296 * MiB;
constexpr size_t WS_GA = 552 * MiB, WS_GB = 616 * MiB, WS_Y = 680 * MiB,     WS_QMLA = 808 * MiB, WS_LIST = 904 * MiB, WS_ML = 920 * MiB, WS_END = 936 * MiB;
constexpr size_t WS_CNT = 64 * 1024;
__device__ __forceinline__ unsigned opart_off(int slot) { return slot < 2 ? (unsigned)(WS_Y + (size_t)slot * 64 * MiB) : (unsigned)WS_QLAT; }

static_assert(WS_MOD + (size_t)NB * 3072 * 4 <= ZERO_BYTES, "MOD inside the zeroed region");
struct Params {
    const float *x, *c; const int* pos; const float *w_ada, *b_ada, *g_pre, *g_post, *w_in, *g_q, *w_uq, *g_kv, *w_ukv, *w_o_mla, *w_o_moba, *b_merge, *w_out;
    float* out; unsigned char* ws;
};

__device__ __forceinline__ float wave_sum(float v) {
#pragma unroll
    for (int o = 1; o < 64; o <<= 1) v += __shfl_xor(v, o);
    return v;
}
__device__ __forceinline__ float silu_f(float v) { return v / (1.f + __expf(-v)); }
__device__ __forceinline__ float sigmoid_f(float v) { return 1.f / (1.f + __expf(-v)); }

#define LAS __attribute__((address_space(3)))
__device__ void ph_tab(const Params& p, int gtid, int gsize);
__device__ void ph_prep(const Params& p, int gtid, int gsize, int vb, int nvb, LAS unsigned char* lds) {
    float* mod = (float*)(p.ws + WS_MOD);
    { const int tid = gtid - vb * 512; LAS float* sc = (LAS float*)lds; LAS float* part = (LAS float*)(lds + 65536);
      for (int i = tid; i < NB * DM; i += 512) { const float cv = p.c[i]; sc[i] = cv / (1.f + __expf(-cv)); }
      __syncthreads();
      for (int cg = vb; cg < 3072 / 12; cg += nvb) {
          if (tid < 384) { const int col = tid % 12, kc = tid / 12, j = cg * 12 + col, k0 = kc * 32;
              float w[32], acc[NB];
#pragma unroll
              for (int kk = 0; kk < 32; ++kk) w[kk] = p.w_ada[(size_t)(k0 + kk) * 3072 + j];
#pragma unroll
              for (int b = 0; b < NB; ++b) acc[b] = 0.f;
#pragma unroll
              for (int kk = 0; kk < 32; kk += 4) {
#pragma unroll
                  for (int b = 0; b < NB; ++b) { typedef float f4m __attribute__((ext_vector_type(4))); const f4m s4 = *(const LAS f4m*)(sc + b * DM + k0 + kk);
                      acc[b] = fmaf(s4.x, w[kk], acc[b]); acc[b] = fmaf(s4.y, w[kk + 1], acc[b]); acc[b] = fmaf(s4.z, w[kk + 2], acc[b]); acc[b] = fmaf(s4.w, w[kk + 3], acc[b]); } }
#pragma unroll
              for (int b = 0; b < NB; ++b) part[(kc * NB + b) * 12 + col] = acc[b]; }
          __syncthreads();
          if (tid < NB * 12) { const int b = tid / 12, c = tid % 12, j = cg * 12 + c; float s = p.b_ada[j];
#pragma unroll
              for (int kc = 0; kc < 32; ++kc) s += part[(kc * NB + b) * 12 + c];
              mod[b * 3072 + j] = s; }
          __syncthreads();
      } }
    ph_tab(p, gtid, gsize);
}
__device__ void ph_tab(const Params& p, int gtid, int gsize) {
    unsigned* tab = (unsigned*)(p.ws + WS_TAB);
    const int f = gtid & 31;
    const double c = exp2(-(double)f * (13.287712379549449 / 32.0)) * 0.15915494309189535;
    int ex; const double mant = frexp(c, &ex); const double c_hi_d = ldexp(rint(ldexp(mant, 11)), ex - 11);
    const float c_hi = (float)c_hi_d, c_lo = (float)(c - c_hi_d);
    for (int i = gtid; i < M_ * 32; i += gsize) {
        const float pos = (float)p.pos[i >> 5];
        float x = pos * c_hi; x = x - floorf(x); x = fmaf(pos, c_lo, x);
        typedef _Float16 h2t __attribute__((ext_vector_type(2))); h2t cs; cs[0] = (_Float16)__builtin_amdgcn_cosf(x); cs[1] = (_Float16)__builtin_amdgcn_sinf(x);
        tab[i] = __builtin_bit_cast(unsigned, cs);
    }
}

__device__ void ph_hnorm(const Params& p, int gwave, int nwaves, int lane) {
    constexpr int R = 4;
    typedef float f4 __attribute__((ext_vector_type(4)));
    const float* mod = (const float*)(p.ws + WS_MOD); h16* H = (h16*)(p.ws + WS_H);
    for (int m0 = R * gwave; m0 < M_; m0 += R * nwaves) {
        f4 v[R][4]; float ss[R];
#pragma unroll
        for (int r = 0; r < R; ++r) { const f4* xr = (const f4*)(p.x + (size_t)(m0 + r) * DM);
#pragma unroll
            for (int j = 0; j < 4; ++j) v[r][j] = __builtin_nontemporal_load(xr + lane + 64 * j); }
#pragma unroll
        for (int r = 0; r < R; ++r) { float s = 0.f;
#pragma unroll
            for (int j = 0; j < 4; ++j) s += (v[r][j][0] * v[r][j][0] + v[r][j][1] * v[r][j][1]) + (v[r][j][2] * v[r][j][2] + v[r][j][3] * v[r][j][3]);
            ss[r] = 1.f / sqrtf(wave_sum(s) * (1.f / DM) + EPS); }
        const int b = m0 >> 12;
#pragma unroll
        for (int j = 0; j < 4; ++j) {
            const int col = 4 * (lane + 64 * j);
            const float4 g = *(const float4*)(p.g_pre + col), sc = *(const float4*)(mod + b * 3072 + 1024 + col), sh = *(const float4*)(mod + b * 3072 + col);
            const float g0 = g.x * (1.f + sc.x), g1 = g.y * (1.f + sc.y), g2 = g.z * (1.f + sc.z), g3 = g.w * (1.f + sc.w);
#pragma unroll
            for (int r = 0; r < R; ++r) { const float rstd = ss[r]; const f4 x = v[r][j];
                h16x4 o; o[0] = (h16)(x[0] * rstd * g0 + sh.x); o[1] = (h16)(x[1] * rstd * g1 + sh.y); o[2] = (h16)(x[2] * rstd * g2 + sh.z); o[3] = (h16)(x[3] * rstd * g3 + sh.w);
                *(h16x4*)(H + (size_t)(m0 + r) * DM + col) = o; }
        }
    }
}

__device__ void ph_final(const Params& p, int gwave, int nwaves, int lane) {
    constexpr int R = 4; typedef float f4 __attribute__((ext_vector_type(4)));
    const float* mod = (const float*)(p.ws + WS_MOD); const h16* Y = (const h16*)(p.ws + WS_Y); const float* ssq = (const float*)(p.ws + WS_SSQY);
    for (int m0 = R * gwave; m0 < M_; m0 += R * nwaves) {
        const int b = m0 >> 12; h16x4 yv[R][4]; f4 xv[R][4]; float rs[R];
#pragma unroll
        for (int r = 0; r < R; ++r) { const h16x4* yr = (const h16x4*)(Y + (size_t)(m0 + r) * DM); const f4* xr = (const f4*)(p.x + (size_t)(m0 + r) * DM); rs[r] = ssq[m0 + r];
#pragma unroll
            for (int j = 0; j < 4; ++j) { yv[r][j] = yr[lane + 64 * j]; xv[r][j] = __builtin_nontemporal_load(xr + lane + 64 * j); } }
#pragma unroll
        for (int r = 0; r < R; ++r) rs[r] = 1.f / sqrtf(rs[r] * (1.f / DM) + EPS);
#pragma unroll
        for (int j = 0; j < 4; ++j) {
            const int col = 4 * (lane + 64 * j); const float4 g = *(const float4*)(p.g_post + col), gt = *(const float4*)(mod + b * 3072 + 2048 + col);
            const float g0 = g.x * gt.x, g1 = g.y * gt.y, g2 = g.z * gt.z, g3 = g.w * gt.w;
#pragma unroll
            for (int r = 0; r < R; ++r) { const h16x4 y = yv[r][j]; const f4 x = xv[r][j]; const float s = rs[r];
                f4 o; o[0] = x[0] + g0 * (float)y[0] * s; o[1] = x[1] + g1 * (float)y[1] * s; o[2] = x[2] + g2 * (float)y[2] * s; o[3] = x[3] + g3 * (float)y[3] * s;
                __builtin_nontemporal_store(o, (f4*)(p.out + (size_t)(m0 + r) * DM) + lane + 64 * j); }
        }
    }
}


#define XB_TMO      128
#define XB_XCNT(j)  (256  + 64 * (j))
#define XB_XSUB(j)  (1280 + 64 * (j))
#define XB_XGEN(j)  (2304 + 64 * (j))
#define XB_TOP      3328
#define XB_TOPGEN   3392
#define XCD_BAR_WORDS 3456
#define XB_SPIN_CAP (1u << 27)
__device__ __forceinline__ unsigned xb_ld(unsigned* p)              { return __hip_atomic_load(p, __ATOMIC_RELAXED, __HIP_MEMORY_SCOPE_AGENT); }
__device__ __forceinline__ unsigned xb_add(unsigned* p, unsigned v) { return __hip_atomic_fetch_add(p, v, __ATOMIC_RELAXED, __HIP_MEMORY_SCOPE_AGENT); }
__device__ __forceinline__ unsigned xb_xcc_id() { return (unsigned)__builtin_amdgcn_s_getreg((3 << 11) | 20) & 0xFu; }
#define XB_SPIN(cond, bar) do { unsigned _sp = 0; while (cond) { __builtin_amdgcn_s_sleep(1); \
    if ((++_sp & 255u) == 0u) { if (xb_ld(&(bar)[XB_TMO])) break; if (_sp > XB_SPIN_CAP) { atomicAdd(&(bar)[XB_TMO], 1u); break; } } } } while (0)
struct XcdBarrier { unsigned* bar; unsigned x; volatile LAS unsigned* st; };
__device__ __forceinline__ XcdBarrier xcd_barrier_post(unsigned* bar, volatile LAS unsigned* st) {
    XcdBarrier b; b.bar = bar; b.x = xb_xcc_id(); b.st = st;
    if (threadIdx.x == 0) (void)xb_add(&bar[XB_XCNT(b.x)], 1u);
    return b;
}
__device__ __forceinline__ void xcd_barrier_complete(unsigned* bar, unsigned x, unsigned& nloc, unsigned& nx) {
    const unsigned G = gridDim.x * gridDim.y * gridDim.z;
    unsigned sum, cnt, mine, sp = 0u;
    for (;;) {
        sum = 0u; cnt = 0u; mine = 0u;
#pragma unroll
        for (unsigned j = 0; j < 16; ++j) { const unsigned c = xb_ld(&bar[XB_XCNT(j)]); sum += c; cnt += (c > 0u) ? 1u : 0u; mine = (j == x) ? c : mine; }
        if (sum == G) break;
        __builtin_amdgcn_s_sleep(1);
        if ((++sp & 255u) == 0u) { if (xb_ld(&bar[XB_TMO])) break; if (sp > XB_SPIN_CAP) { atomicAdd(&bar[XB_TMO], 1u); break; } }
    }
    nloc = mine > 0u ? mine : 1u; nx = cnt > 0u ? cnt : 1u;
}
__device__ __forceinline__ void xcd_barrier(const XcdBarrier& b) {
    asm volatile("s_waitcnt vmcnt(0)" ::: "memory");
    __syncthreads();
    if (threadIdx.x == 0) {
        unsigned* bar = b.bar;
        __builtin_amdgcn_s_waitcnt(0);
        unsigned nloc = b.st[0], nx = b.st[1];
        if (nloc == 0u) { xcd_barrier_complete(bar, b.x, nloc, nx); b.st[0] = nloc; b.st[1] = nx; }
        const unsigned old = xb_add(&bar[XB_XSUB(b.x)], 1u);
        const unsigned gen = old / nloc;
        if (old + 1u == (gen + 1u) * nloc) {
            __builtin_amdgcn_fence(__ATOMIC_RELEASE, "agent");
            asm volatile("s_waitcnt vmcnt(0)" ::: "memory");
            const unsigned og = xb_add(&bar[XB_TOP], 1u);
            const unsigned tg = og / nx;
            if (og + 1u == (tg + 1u) * nx) xb_add(&bar[XB_TOPGEN], 1u);
            else XB_SPIN(xb_ld(&bar[XB_TOPGEN]) == tg, bar);
            __builtin_amdgcn_fence(__ATOMIC_ACQUIRE, "agent");
            xb_add(&bar[XB_XGEN(b.x)], 1u);
            asm volatile("s_waitcnt vmcnt(0)" ::: "memory");
        } else {
            XB_SPIN(xb_ld(&bar[XB_XGEN(b.x)]) == gen, bar);
            __builtin_amdgcn_fence(__ATOMIC_ACQUIRE, "agent");
            asm volatile("s_waitcnt vmcnt(0)" ::: "memory");
        }
    }
    __syncthreads();
}

namespace pg8 {
#define PG8_LAS __attribute__((address_space(3)))
typedef unsigned short bf16_t;
typedef _Float16 bf16x8 __attribute__((ext_vector_type(8)));
typedef float f32x4 __attribute__((ext_vector_type(4)));
typedef unsigned u32x4 __attribute__((ext_vector_type(4)));
constexpr int BM = 256, BK = 64, HALF = 128, HTB = HALF * BK * 2  , STAGE_BYTES = 8 * HTB, NXCD = 8, WGM = 8;

__host__ __device__ __forceinline__ int lds_byte(int r, int c) { const int st = (r >> 4) * 2 + (c >> 5), rr = r & 15, cc = c & 31, ob = rr * 64 + cc * 2; return st * 1024 + (ob ^ (((ob >> 9) & 1) << 5)); }
__host__ __device__ __forceinline__ void stage_rc(int b, int& R, int& C) { const int st = b / 1024, sb = b % 1024, swz = sb ^ (((sb >> 9) & 1) << 5); R = (st >> 1) * 16 + swz / 64; C = (st & 1) * 32 + (swz % 64) / 2; }
__host__ __device__ __forceinline__ int perm32(int rho) { const int n = rho >> 4, i = rho & 15; return 8 * (i >> 2) + 4 * n + (i & 3); }

struct Unit { int pm, pn; };
struct Gemm { const bf16_t* A; const bf16_t* Bt; int M, N, K; };

struct StaticOrder {
    int nM, nN, nwg, G, c;
    __host__ __device__ void init(int M, int N, int G_, int c_) { nM = M / BM; nN = N / BM; nwg = nM * nN; G = G_; c = c_; }
    __host__ __device__ bool next(int i, Unit& u) const {
        const long L = (long)i * G + c; if (L >= nwg) return false;
        int wgid = (int)L; { const int q = nwg / NXCD, r = nwg % NXCD, xcd = wgid % NXCD, off = wgid / NXCD; wgid = (xcd < r ? xcd * (q + 1) : r * (q + 1) + (xcd - r) * q) + off; }
        const int nig = WGM * nN, gid = wgid / nig, fm = gid * WGM, gsz = (nM - fm) < WGM ? (nM - fm) : WGM;
        u.pm = fm + ((wgid % nig) % gsz); u.pn = (wgid % nig) / gsz; return true;
    }
    __device__ __forceinline__ void a_ready(const Unit&) const {}
    __device__ __forceinline__ void done(const Unit&) const {}
};

template <class Epi, class Sched, bool ALIGN_EPI = false, bool SP2 = false>
__device__ __forceinline__ void gemm_phase(PG8_LAS unsigned char* lds, const Gemm g, const Sched& S, const Epi& E) {
    int tid_ = threadIdx.x; asm volatile("" : "+v"(tid_));
    const int tid = tid_, wid = __builtin_amdgcn_readfirstlane(tid >> 6), lane = tid & 63, wr = wid >> 2, wc = wid & 3, fr = lane & 15, fq = lane >> 4;
    const int K = g.K, nt = K / BK;
    unsigned voffA[2], voffB[2];
#pragma unroll
    for (int i = 0; i < 2; ++i) { int R, C; stage_rc(tid * 16 + i * 8192, R, C); const int Rb = Epi::PERM ? ((R & ~31) + perm32(R & 31)) : R;
        voffA[i] = (unsigned)(R * K + C) * 2u; voffB[i] = (unsigned)(Rb * K + C) * 2u; }
    const size_t kstep = (size_t)(BK * 2);
    const size_t hstep = (size_t)HALF * K * 2;
    const size_t tstep = 2 * hstep;
    const unsigned ldsw = (unsigned)wid * 1024u;
    const int aoff = lds_byte(wr * 64 + fr, fq * 8), boff = lds_byte(wc * 32 + fr, fq * 8);
#define PG8_SA(b, h) (((b) * 2 + (h)) * HTB)
#define PG8_SB(b, h) ((4 + (b) * 2 + (h)) * HTB)
#define PG8_STAGE(bufoff, gbase, voff) do { _Pragma("unroll") for (int _i = 0; _i < 2; ++_i) \
        __builtin_amdgcn_global_load_lds((const unsigned*)((const char*)(gbase) + (voff)[_i]), (PG8_LAS unsigned*)(lds + (bufoff) + ldsw + _i * 8192), 16, 0, 0); } while (0)
#define PG8_LDA(dst, b, h) do { _Pragma("unroll") for (int m = 0; m < 4; ++m) _Pragma("unroll") for (int k = 0; k < 2; ++k) dst[m][k] = *(const PG8_LAS bf16x8*)(lds + PG8_SA(b, h) + aoff + m * 2048 + k * 1024); } while (0)
#define PG8_LDB(dst, b, h) do { _Pragma("unroll") for (int n = 0; n < 2; ++n) _Pragma("unroll") for (int k = 0; k < 2; ++k) dst[n][k] = *(const PG8_LAS bf16x8*)(lds + PG8_SB(b, h) + boff + n * 2048 + k * 1024); } while (0)
#define PG8_MMA(ai, bj, At, Bt) do { __builtin_amdgcn_s_setprio(1); _Pragma("unroll") for (int m = 0; m < 4; ++m) _Pragma("unroll") for (int n = 0; n < 2; ++n) _Pragma("unroll") for (int k = 0; k < 2; ++k) \
        acc[ai][bj][m][n] = __builtin_amdgcn_mfma_f32_16x16x32_f16(Bt[n][k], At[m][k], acc[ai][bj][m][n], 0, 0, 0); __builtin_amdgcn_s_setprio(0); } while (0)
#define PG8_WAIT_V(n) asm volatile("s_waitcnt vmcnt(" #n ")" ::: "memory")
#define PG8_WAIT_L(n) asm volatile("s_waitcnt lgkmcnt(" #n ")" ::: "memory")
#define PG8_BAR __builtin_amdgcn_s_barrier()
#define PG8_SCHED __builtin_amdgcn_sched_barrier(0)
    Unit cur, nxt; int ui = 0;
    if (!S.next(0, cur)) return;
    f32x4 acc[2][2][4][2];
#pragma unroll
    for (int a = 0; a < 2; ++a)
#pragma unroll
        for (int b = 0; b < 2; ++b)
#pragma unroll
            for (int m = 0; m < 4; ++m)
#pragma unroll
                for (int n = 0; n < 2; ++n) acc[a][b][m][n] = (f32x4){0.f, 0.f, 0.f, 0.f};
    bf16x8 At[4][2], B0[2][2], B1[2][2];
    const char* cA = (const char*)g.A + (size_t)cur.pm * tstep; const char* cB = (const char*)g.Bt + (size_t)cur.pn * tstep;
    S.a_ready(cur);
    if constexpr (SP2) {
        PG8_STAGE(PG8_SB(0, 0), cB, voffB); PG8_STAGE(PG8_SB(0, 1), cB + hstep, voffB); PG8_STAGE(PG8_SA(0, 0), cA, voffA); PG8_STAGE(PG8_SA(0, 1), cA + hstep, voffA);
        if (wr == 1) PG8_BAR;
        PG8_WAIT_V(2); PG8_BAR;
        PG8_STAGE(PG8_SB(1, 0), cB + kstep, voffB); PG8_STAGE(PG8_SA(1, 0), cA + kstep, voffA); PG8_STAGE(PG8_SB(1, 1), cB + hstep + kstep, voffB);
        PG8_WAIT_V(6); PG8_BAR;
    } else {
        PG8_STAGE(PG8_SB(0, 0), cB, voffB); PG8_STAGE(PG8_SA(0, 0), cA, voffA); PG8_STAGE(PG8_SB(0, 1), cB + hstep, voffB); PG8_STAGE(PG8_SA(0, 1), cA + hstep, voffA);
        if (wr == 1) PG8_BAR;
        PG8_WAIT_V(4); PG8_BAR;
        PG8_STAGE(PG8_SB(1, 0), cB + kstep, voffB); PG8_STAGE(PG8_SA(1, 0), cA + kstep, voffA); PG8_STAGE(PG8_SB(1, 1), cB + hstep + kstep, voffB);
        PG8_WAIT_V(6); PG8_BAR;
    }
    for (;;) {
        const bool has_next = S.next(ui + 1, nxt);
        const char* nA = has_next ? (const char*)g.A + (size_t)nxt.pm * tstep : cA; const char* nB = has_next ? (const char*)g.Bt + (size_t)nxt.pn * tstep : cB;
#pragma nounroll
        for (int t = 0; t < nt; t += 2) {
            const bool last = (t == nt - 2);
            if constexpr (Epi::MID_T > 0) { if (t == Epi::MID_T) E.mid(acc, cur, wr, wc); }
            const char* a1 = cA + (size_t)(t + 1) * kstep;
            const char* a2 = last ? nA : cA + (size_t)(t + 2) * kstep; const char* b2 = last ? nB : cB + (size_t)(t + 2) * kstep;
            const char* a3 = a2 + kstep; const char* b3 = b2 + kstep;
            if (last && has_next) S.a_ready(nxt);
            if constexpr (SP2) {
            PG8_LDB(B0, 0, 0); PG8_LDB(B1, 0, 1); PG8_SCHED; PG8_LDA(At, 0, 0); PG8_STAGE(PG8_SA(1, 1), a1 + hstep, voffA);
            PG8_WAIT_V(8); PG8_WAIT_L(0); PG8_BAR; PG8_MMA(0, 0, At, B0); PG8_MMA(0, 1, At, B1); PG8_BAR; PG8_SCHED;
            PG8_LDA(At, 0, 1); PG8_STAGE(PG8_SB(0, 0), b2, voffB); PG8_STAGE(PG8_SB(0, 1), b2 + hstep, voffB); PG8_STAGE(PG8_SA(0, 0), a2, voffA);
            PG8_WAIT_V(8); PG8_WAIT_L(0); PG8_BAR; PG8_MMA(1, 0, At, B0); PG8_MMA(1, 1, At, B1); PG8_BAR; PG8_SCHED;
            PG8_LDB(B0, 1, 0); PG8_LDB(B1, 1, 1); PG8_SCHED; PG8_LDA(At, 1, 0); PG8_STAGE(PG8_SA(0, 1), a2 + hstep, voffA);
            PG8_WAIT_V(8); PG8_WAIT_L(0); PG8_BAR; PG8_MMA(0, 0, At, B0); PG8_MMA(0, 1, At, B1); PG8_BAR; PG8_SCHED;
            PG8_LDA(At, 1, 1); PG8_STAGE(PG8_SB(1, 0), b3, voffB); PG8_STAGE(PG8_SB(1, 1), b3 + hstep, voffB); PG8_STAGE(PG8_SA(1, 0), a3, voffA);
            PG8_WAIT_V(8); PG8_WAIT_L(0); PG8_BAR; PG8_MMA(1, 0, At, B0); PG8_MMA(1, 1, At, B1); PG8_BAR; PG8_SCHED;
            } else {
            PG8_LDB(B0, 0, 0); PG8_SCHED; PG8_LDA(At, 0, 0); PG8_STAGE(PG8_SA(1, 1), a1 + hstep, voffA);
            PG8_WAIT_L(8); PG8_BAR; PG8_WAIT_L(0); PG8_MMA(0, 0, At, B0); PG8_BAR; PG8_SCHED;
            PG8_LDB(B1, 0, 1); PG8_STAGE(PG8_SB(0, 0), b2, voffB);
            PG8_BAR; PG8_WAIT_L(0); PG8_MMA(0, 1, At, B1); PG8_BAR;
            PG8_LDA(At, 0, 1); PG8_STAGE(PG8_SA(0, 0), a2, voffA);
            PG8_BAR; PG8_WAIT_L(0); PG8_MMA(1, 0, At, B0); PG8_BAR; PG8_SCHED;
            PG8_STAGE(PG8_SB(0, 1), b2 + hstep, voffB);
            PG8_WAIT_V(6); PG8_BAR; PG8_MMA(1, 1, At, B1); PG8_BAR;
            PG8_LDB(B0, 1, 0); PG8_SCHED; PG8_LDA(At, 1, 0); PG8_STAGE(PG8_SA(0, 1), a2 + hstep, voffA);
            PG8_WAIT_L(8); PG8_BAR; PG8_WAIT_L(0); PG8_MMA(0, 0, At, B0); PG8_BAR; PG8_SCHED;
            PG8_LDB(B1, 1, 1); PG8_STAGE(PG8_SB(1, 0), b3, voffB);
            PG8_BAR; PG8_WAIT_L(0); PG8_MMA(0, 1, At, B1); PG8_BAR;
            PG8_LDA(At, 1, 1); PG8_STAGE(PG8_SA(1, 0), a3, voffA);
            PG8_BAR; PG8_WAIT_L(0); PG8_MMA(1, 0, At, B0); PG8_BAR; PG8_SCHED;
            PG8_STAGE(PG8_SB(1, 1), b3 + hstep, voffB);
            PG8_WAIT_V(6); PG8_BAR; PG8_MMA(1, 1, At, B1); PG8_BAR;
            }
        }
        if constexpr (ALIGN_EPI) { if (wr == 0) PG8_BAR; }
        if constexpr (!Epi::AFTER_DRAIN) { E(acc, cur, wr, wc, fr, fq); S.done(cur); }
        if (!has_next) break;
#pragma unroll
        for (int a = 0; a < 2; ++a)
#pragma unroll
            for (int b = 0; b < 2; ++b)
#pragma unroll
                for (int m = 0; m < 4; ++m)
#pragma unroll
                    for (int n = 0; n < 2; ++n) acc[a][b][m][n] = (f32x4){0.f, 0.f, 0.f, 0.f};
        cur = nxt; cA = nA; cB = nB; ++ui;
        if constexpr (ALIGN_EPI) { if (wr == 1) PG8_BAR; }
    }
    PG8_WAIT_V(0);
    if constexpr (!ALIGN_EPI) { if (wr == 0) PG8_BAR; }
    PG8_BAR;
    if constexpr (Epi::AFTER_DRAIN) { E.fused(acc, cur, wr, wc, fr, fq, lds, wid, lane); S.done(cur); }
#undef PG8_SA
#undef PG8_SB
#undef PG8_STAGE
#undef PG8_LDA
#undef PG8_LDB
#undef PG8_MMA
#undef PG8_WAIT_V
#undef PG8_WAIT_L
#undef PG8_BAR
#undef PG8_SCHED
}
typedef _Float16 h8v __attribute__((ext_vector_type(8)));
typedef unsigned u32x2 __attribute__((ext_vector_type(2)));
typedef _Float16 h2v __attribute__((ext_vector_type(2)));
__device__ __forceinline__ unsigned pk_h2(float lo, float hi) { h2v v; v[0] = (_Float16)lo; v[1] = (_Float16)hi; return __builtin_bit_cast(unsigned, v); }
__device__ __forceinline__ u32x4 pack8(const f32x4& a, const f32x4& b) { u32x4 w; w.x = pk_h2(a[0], a[1]); w.y = pk_h2(a[2], a[3]); w.z = pk_h2(b[0], b[1]); w.w = pk_h2(b[2], b[3]); return w; }
__device__ __forceinline__ float sigm1(float v) { return __builtin_amdgcn_rcpf(1.f + __builtin_amdgcn_exp2f(v * -1.4426950408889634f)); }
__device__ __forceinline__ float silu1(float v) { return v * sigm1(v); }
__device__ __forceinline__ f32x4 silu4(const f32x4& v) { return (f32x4){silu1(v[0]), silu1(v[1]), silu1(v[2]), silu1(v[3])}; }
__device__ __forceinline__ f32x4 sigm4(const f32x4& v) { return (f32x4){sigm1(v[0]), sigm1(v[1]), sigm1(v[2]), sigm1(v[3])}; }

#define PG8_OPAQUE(fr_, fq_) int lane_x; asm volatile("v_mbcnt_lo_u32_b32 %0, -1, 0\n\tv_mbcnt_hi_u32_b32 %0, -1, %0" : "=v"(lane_x)); const int frx = lane_x & 15, fqx = lane_x >> 4
__device__ __forceinline__ void st16(unsigned char* base, unsigned off, const u32x4& v) { *(u32x4*)(base + off) = v; }
__device__ __forceinline__ f32x4 ld16f(const unsigned char* base, unsigned off) { return *(const f32x4*)(base + off); }
__device__ __forceinline__ float ld4f(const unsigned char* base, unsigned off) { return *(const float*)(base + off); }
__device__ __forceinline__ h8v ld16h(const unsigned char* base, unsigned off) { return *(const h8v*)(base + off); }
__device__ __forceinline__ float sumsq8(const f32x4& a, const f32x4& b) { return (a[0] * a[0] + a[1] * a[1]) + (a[2] * a[2] + a[3] * a[3]) + (b[0] * b[0] + b[1] * b[1]) + (b[2] * b[2] + b[3] * b[3]); }
__device__ __forceinline__ void rope4(const f32x4& t1, const f32x4& t2, const u32x4& cs, f32x4& o1, f32x4& o2) {
#pragma unroll
    for (int j = 0; j < 4; ++j) { const unsigned wj = cs[j]; h2v w; __builtin_memcpy(&w, &wj, 4);
        const float c = (float)w[0], s = (float)w[1]; o1[j] = t1[j] * c - t2[j] * s; o2[j] = t2[j] * c + t1[j] * s; }
}
__device__ __forceinline__ u32x4 ld16u(const unsigned char* base, unsigned off) { return *(const u32x4*)(base + off); }

struct EpiInF {
    static constexpr bool PERM = true, AFTER_DRAIN = false; static constexpr int MID_T = 0;
    unsigned char* ws; const float* b_merge; int noatomic;
    template <bool ISQ> __device__ __forceinline__ void rope_tile(const f32x4 (&acc)[2][2][4][2], const Unit& u, int wr, int wc, int frx, int fqx) const {
        const int pn = u.pn; const unsigned row0 = (unsigned)(u.pm * 256 + wr * 64) + (unsigned)frx; const float sc = ISQ ? SC_MB : 1.f;
        unsigned char* dst = ws + (ISQ ? WS_QMB : WS_KMB); const unsigned char* tab = ws + WS_TAB;
        const unsigned o0 = row0 * 1024u + (((pn & 1) ? 256u : 0u) + 64u * wc + 8u * fqx) * 2u, t0 = row0 * 128u + 32u * fqx;
        f32x4 c1[2] = {{0.f, 0.f, 0.f, 0.f}, {0.f, 0.f, 0.f, 0.f}}, c2[2] = {{0.f, 0.f, 0.f, 0.f}, {0.f, 0.f, 0.f, 0.f}};
        u32x4 cs[2][4][2];
#pragma unroll
        for (int ai = 0; ai < 2; ++ai)
#pragma unroll
            for (int m = 0; m < 4; ++m) { const unsigned to = t0 + (unsigned)(ai * 128 + m * 16) * 128u; cs[ai][m][0] = ld16u(tab, to); cs[ai][m][1] = ld16u(tab, to + 16u); }
#pragma unroll
        for (int ai = 0; ai < 2; ++ai)
#pragma unroll
            for (int m = 0; m < 4; ++m) { const unsigned ro = o0 + (unsigned)(ai * 128 + m * 16) * 1024u;
                f32x4 o1[2], o2[2];
#pragma unroll
                for (int n = 0; n < 2; ++n) { rope4(acc[ai][0][m][n], acc[ai][1][m][n], cs[ai][m][n], o1[n], o2[n]);
                    if (!ISQ) { c1[n] += o1[n]; c2[n] += o2[n]; } }
                st16(dst, ro, pack8(o1[0] * sc, o1[1] * sc)); st16(dst, ro + 64u, pack8(o2[0] * sc, o2[1] * sc));
                if (!ISQ) asm volatile("" : "+v"(c1[0]), "+v"(c1[1]), "+v"(c2[0]), "+v"(c2[1])); }
        if (!ISQ) {
            float* km = (float*)(ws + WS_KMEAN) + (size_t)u.pm * 512 + ((pn & 1) ? 256 : 0) + 64 * wc + 8 * fqx;
#pragma unroll
            for (int n = 0; n < 2; ++n)
#pragma unroll
                for (int j = 0; j < 4; ++j) { float a = c1[n][j], b = c2[n][j];
#pragma unroll
                    for (int o = 1; o < 16; o <<= 1) { a += __shfl_xor(a, o); b += __shfl_xor(b, o); }
                    if (frx == 0 && !noatomic) { atomicAdd(km + 4 * n + j, a * (1.f / 256.f)); atomicAdd(km + 32 + 4 * n + j, b * (1.f / 256.f)); } }
        }
    }
    __device__ __forceinline__ void operator()(const f32x4 (&acc)[2][2][4][2], const Unit& u, int wr, int wc, int fr, int fq) const {
        PG8_OPAQUE(fr, fq);
        const int pn = u.pn; const unsigned row0 = (unsigned)(u.pm * 256 + wr * 64) + (unsigned)frx, cl = 32u * wc + 8u * fqx;
        if (pn == 0) {
            unsigned char* dst = ws + WS_QLAT; float* ssq = (float*)(ws + WS_SSQ); const unsigned o0 = row0 * 512u + cl * 2u;
#pragma unroll
            for (int ai = 0; ai < 2; ++ai)
#pragma unroll
                for (int m = 0; m < 4; ++m) { const unsigned ro = o0 + (unsigned)(ai * 128 + m * 16) * 512u; float s = 0.f;
#pragma unroll
                    for (int bj = 0; bj < 2; ++bj) { s += sumsq8(acc[ai][bj][m][0], acc[ai][bj][m][1]); st16(dst, ro + bj * 256u, pack8(acc[ai][bj][m][0], acc[ai][bj][m][1])); }
                    s += __shfl_xor(s, 16); s += __shfl_xor(s, 32);
                    if (fqx == 0 && !noatomic) atomicAdd(ssq + (row0 + ai * 128 + m * 16), s); }
        } else if (pn == 1) {
            unsigned char* kvl = ws + WS_KVL; unsigned char* kpe = ws + WS_KPE; float* ssq = (float*)(ws + WS_SSQ) + M_; const unsigned char* tab = ws + WS_TAB;
#pragma unroll
            for (int ai = 0; ai < 2; ++ai)
#pragma unroll
                for (int m = 0; m < 4; ++m) { const unsigned row = row0 + ai * 128 + m * 16;
                    if (wc < 2) { float s = 0.f;
#pragma unroll
                        for (int bj = 0; bj < 2; ++bj) { s += sumsq8(acc[ai][bj][m][0], acc[ai][bj][m][1]); st16(kvl, row * 256u + (bj * 64u + cl) * 2u, pack8(acc[ai][bj][m][0], acc[ai][bj][m][1])); }
                        s += __shfl_xor(s, 16); s += __shfl_xor(s, 32);
                        if (fqx == 0 && !noatomic) atomicAdd(ssq + row, s);
                    } else {
                        if (wc == 2 && fqx < 2) {
                            f32x4 o1[2], o2[2];
#pragma unroll
                            for (int n = 0; n < 2; ++n) { const unsigned to = row * 128u + (unsigned)(16 * fqx + 8 * n) * 4u; const u32x4 wa = ld16u(tab, to), wb = ld16u(tab, to + 16u);
                                rope4(acc[ai][0][m][n], acc[ai][1][m][n], (u32x4){wa[0], wa[2], wb[0], wb[2]}, o1[n], o2[n]); }
                            st16(kpe, row * 64u + 16u * fqx, pack8(o1[0], o1[1])); st16(kpe, row * 64u + 32u + 16u * fqx, pack8(o2[0], o2[1]));
                        }
                    }
                    asm volatile("" ::: "memory"); }
        } else if (pn < 4 || (pn >= 8 && pn < 12)) {
            const bool act = (pn < 4) || (pn >= 10); const unsigned pitch = act ? 2048u : 1024u;
            unsigned char* dst = ws + (act ? WS_ZCAT : WS_VMB); const unsigned o0 = row0 * pitch + ((pn >= 10 ? 512u : 0u) + ((pn & 1) ? 256u : 0u) + cl) * 2u;
#pragma unroll
            for (int ai = 0; ai < 2; ++ai)
#pragma unroll
                for (int m = 0; m < 4; ++m) { const unsigned ro = o0 + (unsigned)(ai * 128 + m * 16) * pitch;
#pragma unroll
                    for (int bj = 0; bj < 2; ++bj) { f32x4 a = acc[ai][bj][m][0], b = acc[ai][bj][m][1]; if (act) { a = silu4(a); b = silu4(b); }
                        st16(dst, ro + bj * 256u, pack8(a, b)); } }
        } else if (pn < 6) { rope_tile<true>(acc, u, wr, wc, frx, fqx);
        } else if (pn < 8) { rope_tile<false>(acc, u, wr, wc, frx, fqx);
        } else {
            const bool isa = pn < 16; unsigned char* dst = ws + (isa ? WS_GA : WS_GB); const unsigned cg = 256u * ((pn - 12) & 3) + cl;
            const unsigned char* bm = (const unsigned char*)(b_merge + (isa ? 0 : 1024)); const unsigned o0 = row0 * 1024u + cg;
            f32x4 bv[2][2];
#pragma unroll
            for (int bj = 0; bj < 2; ++bj)
#pragma unroll
                for (int n = 0; n < 2; ++n) bv[bj][n] = ld16f(bm, (cg + bj * 128u + 4u * n) * 4u);
#pragma unroll
            for (int ai = 0; ai < 2; ++ai)
#pragma unroll
                for (int m = 0; m < 4; ++m) { const unsigned ro = o0 + (unsigned)(ai * 128 + m * 16) * 1024u;
#pragma unroll
                    for (int bj = 0; bj < 2; ++bj) { const f32x4 a = sigm4(acc[ai][bj][m][0] + bv[bj][0]) * 255.f + 0.5f, b = sigm4(acc[ai][bj][m][1] + bv[bj][1]) * 255.f + 0.5f;
                        u32x2 w; w.x = (unsigned)a[0] | ((unsigned)a[1] << 8) | ((unsigned)a[2] << 16) | ((unsigned)a[3] << 24); w.y = (unsigned)b[0] | ((unsigned)b[1] << 8) | ((unsigned)b[2] << 16) | ((unsigned)b[3] << 24);
                        *(u32x2*)(dst + (ro + bj * 128u)) = w; } }
        }
    }
};
struct EpiNull {
    static constexpr bool PERM = true, AFTER_DRAIN = false; static constexpr int MID_T = 0;
    __device__ __forceinline__ void operator()(const f32x4 (&acc)[2][2][4][2], const Unit& u, int wr, int wc, int fr, int fq) const {
#pragma unroll
        for (int ai = 0; ai < 2; ++ai)
#pragma unroll
            for (int bj = 0; bj < 2; ++bj)
#pragma unroll
                for (int m = 0; m < 4; ++m) asm volatile("" :: "v"(acc[ai][bj][m][0]), "v"(acc[ai][bj][m][1]));
    }
};
struct EpiUqF {
    static constexpr bool PERM = true, AFTER_DRAIN = false; static constexpr int MID_T = 0;
    unsigned char* ws;
    __device__ __forceinline__ void operator()(const f32x4 (&acc)[2][2][4][2], const Unit& u, int wr, int wc, int fr, int fq) const {
        PG8_OPAQUE(fr, fq);
        const int pn = u.pn; const unsigned row0 = (unsigned)(u.pm * 256 + wr * 64) + (unsigned)frx; unsigned char* Q = ws + WS_QMLA; const unsigned char* ssq = ws + WS_SSQ; const unsigned char* tab = ws + WS_TAB;
        float rsv[2][4];
#pragma unroll
        for (int ai = 0; ai < 2; ++ai)
#pragma unroll
            for (int m = 0; m < 4; ++m) rsv[ai][m] = ld4f(ssq, (row0 + ai * 128 + m * 16) * 4u);
#pragma unroll
        for (int ai = 0; ai < 2; ++ai)
#pragma unroll
            for (int m = 0; m < 4; ++m) { const unsigned row = row0 + ai * 128 + m * 16; const float rs = SC_MLA * __builtin_amdgcn_rsqf(rsv[ai][m] * (1.f / 256.f) + EPS);
                if (pn < 2) {
#pragma unroll
                    for (int bj = 0; bj < 2; ++bj) { const unsigned head = 4u * pn + 2u * bj + (wc >> 1), d = 32u * (wc & 1) + 8u * fqx;
                        st16(Q, row * 1536u + (96u * head + d) * 2u, pack8(acc[ai][bj][m][0] * rs, acc[ai][bj][m][1] * rs)); }
                } else { const unsigned head = 2u * wc + ((unsigned)fqx >> 1), i0 = 8u * (fqx & 1); f32x4 o1[2], o2[2];
#pragma unroll
                    for (int n = 0; n < 2; ++n) { const unsigned to = row * 128u + (2u * (i0 + 4u * n)) * 4u; const u32x4 wa = ld16u(tab, to), wb = ld16u(tab, to + 16u);
                        rope4(acc[ai][0][m][n] * rs, acc[ai][1][m][n] * rs, (u32x4){wa[0], wa[2], wb[0], wb[2]}, o1[n], o2[n]); }
                    st16(Q, row * 1536u + (96u * head + 64u + i0) * 2u, pack8(o1[0], o1[1])); st16(Q, row * 1536u + (96u * head + 80u + i0) * 2u, pack8(o2[0], o2[1])); } }
    }
};
struct EpiUkvF {
    static constexpr bool PERM = true, AFTER_DRAIN = false; static constexpr int MID_T = 0;
    unsigned char* ws;
    __device__ __forceinline__ void operator()(const f32x4 (&acc)[2][2][4][2], const Unit& u, int wr, int wc, int fr, int fq) const {
        PG8_OPAQUE(fr, fq);
        const int pn = u.pn; const unsigned row0 = (unsigned)(u.pm * 256 + wr * 64) + (unsigned)frx; unsigned char* dst = ws + (pn < 2 ? WS_KN : WS_VM); const unsigned char* ssq = ws + WS_SSQ + (size_t)M_ * 4;
        float rsv[2][4];
#pragma unroll
        for (int ai = 0; ai < 2; ++ai)
#pragma unroll
            for (int m = 0; m < 4; ++m) rsv[ai][m] = ld4f(ssq, (row0 + ai * 128 + m * 16) * 4u);
#pragma unroll
        for (int ai = 0; ai < 2; ++ai)
#pragma unroll
            for (int m = 0; m < 4; ++m) { const unsigned row = row0 + ai * 128 + m * 16; const float rs = __builtin_amdgcn_rsqf(rsv[ai][m] * (1.f / 128.f) + EPS);
#pragma unroll
                for (int bj = 0; bj < 2; ++bj) { const unsigned head = 4u * (pn & 1) + 2u * bj + (wc >> 1), d = 32u * (wc & 1) + 8u * fqx;
                    st16(dst, row * 1024u + (64u * head + d) * 2u, pack8(acc[ai][bj][m][0] * rs, acc[ai][bj][m][1] * rs)); } }
    }
};
struct EpiYcatF {
    static constexpr bool PERM = true, AFTER_DRAIN = false; static constexpr int MID_T = 8;
    unsigned char* ws;
    template <bool MID> __device__ __forceinline__ void run(f32x4 (&acc)[2][2][4][2], const Unit& u, int wr, int wc) const {
        PG8_OPAQUE(0, 0);
        const unsigned row0 = (unsigned)(u.pm * 256 + wr * 64) + (unsigned)frx, c0 = u.pn * 256u + 32u * wc + 8u * fqx, o0 = row0 * 2048u + c0 * 2u, g0 = row0 * 1024u + c0;
        const unsigned char* GA = ws + WS_GA; const unsigned char* GB = ws + WS_GB; unsigned char* YM = ws + WS_YM;
#pragma unroll
        for (int ai = 0; ai < 2; ++ai) {
            u32x2 ga[4][2], gb[4][2];
#pragma unroll
            for (int m = 0; m < 4; ++m)
#pragma unroll
                for (int bj = 0; bj < 2; ++bj) { const unsigned go = g0 + (unsigned)(ai * 128 + m * 16) * 1024u + bj * 128u; gb[m][bj] = *(const u32x2*)(GB + go); if (MID) ga[m][bj] = *(const u32x2*)(GA + go); }
#pragma unroll
            for (int m = 0; m < 4; ++m)
#pragma unroll
                for (int bj = 0; bj < 2; ++bj) { const unsigned off = o0 + (unsigned)(ai * 128 + m * 16) * 2048u + bj * 256u; f32x4 s0, s1;
#pragma unroll
                    for (int j = 0; j < 4; ++j) { const float b0 = fmaxf((float)((gb[m][bj].x >> (8 * j)) & 0xffu), 0.5f), b1 = fmaxf((float)((gb[m][bj].y >> (8 * j)) & 0xffu), 0.5f);
                        s0[j] = MID ? (float)((ga[m][bj].x >> (8 * j)) & 0xffu) * __builtin_amdgcn_rcpf(b0) : b0 * (1.f / 255.f);
                        s1[j] = MID ? (float)((ga[m][bj].y >> (8 * j)) & 0xffu) * __builtin_amdgcn_rcpf(b1) : b1 * (1.f / 255.f); }
                    acc[ai][bj][m][0] *= s0; acc[ai][bj][m][1] *= s1;
                    if (!MID) st16(YM, off, pack8(acc[ai][bj][m][0], acc[ai][bj][m][1])); }
            asm volatile("" ::: "memory"); }
    }
    __device__ __forceinline__ void mid(f32x4 (&acc)[2][2][4][2], const Unit& u, int wr, int wc) const { run<true>(acc, u, wr, wc); }
    __device__ __forceinline__ void operator()(f32x4 (&acc)[2][2][4][2], const Unit& u, int wr, int wc, int fr, int fq) const { run<false>(acc, u, wr, wc); }
};
struct EpiYF {
    static constexpr bool PERM = true, AFTER_DRAIN = false; static constexpr int MID_T = 0;
    unsigned char* ws;
    __device__ __forceinline__ void operator()(const f32x4 (&acc)[2][2][4][2], const Unit& u, int wr, int wc, int fr, int fq) const {
        PG8_OPAQUE(fr, fq);
        const unsigned row0 = (unsigned)(u.pm * 256 + wr * 64) + (unsigned)frx, c0 = u.pn * 256u + 32u * wc + 8u * fqx, o0 = row0 * 2048u + c0 * 2u; unsigned char* Y = ws + WS_Y; float* ssq = (float*)(ws + WS_SSQY);
#pragma unroll
        for (int ai = 0; ai < 2; ++ai)
#pragma unroll
            for (int m = 0; m < 4; ++m) { float s = 0.f;
#pragma unroll
                for (int bj = 0; bj < 2; ++bj) { s += sumsq8(acc[ai][bj][m][0], acc[ai][bj][m][1]); st16(Y, o0 + (unsigned)(ai * 128 + m * 16) * 2048u + bj * 256u, pack8(acc[ai][bj][m][0], acc[ai][bj][m][1])); }
                s += __shfl_xor(s, 16); s += __shfl_xor(s, 32);
                if (fqx == 0) atomicAdd(ssq + (row0 + ai * 128 + m * 16), s); }
    }
};
}

struct MapIn { __device__ int operator()(int n) const { const int t = n >> 8, tc = n & 255, bj = tc >> 7, uu = tc & 127;
    if (t == 0) return n;
    if (t == 1) return uu < 64 ? C_KVLAT + 64 * bj + uu : (uu < 80 ? C_KROPE + 16 * bj + (uu - 64) : -1);
    if (t < 4) return C_ZMLA + (n - 512);
    if (t < 8) return (t < 6 ? C_QMB : C_KMB) + 256 * (t & 1) + 64 * (uu >> 5) + 32 * bj + (uu & 31);
    if (t < 10) return C_VMB + (n - 2048);
    if (t < 12) return C_ZMB + (n - 2560);
    if (t < 16) return C_GA + (n - 3072);
    return C_GB + (n - 4096); } };
struct MapUq { __device__ int operator()(int n) const { const int t = n >> 8, tc = n & 255, bj = tc >> 7, uu = tc & 127;
    if (t < 2) return 96 * (4 * t + (tc >> 6)) + (tc & 63);
    return 96 * (uu >> 4) + 64 + 16 * bj + (uu & 15); } };
struct MapUkv { __device__ int operator()(int n) const { const int t = n >> 8, tc = n & 255; return 128 * (4 * (t & 1) + (tc >> 6)) + (t < 2 ? 0 : 64) + (tc & 63); } };
struct MapId { __device__ int operator()(int n) const { return n; } };
template <class Map> __device__ __forceinline__ void wt_items(const float* W, int ldw, int Kreal, int K, int N, unsigned short* WT, const float* kscale, Map map, LAS float* scr, int gw, int ngw, int lane, int ldk = 0, int koff = 0) {
    if (ldk == 0) ldk = K;
    const int nblk = N / 64, nitems = (K / 32) * nblk; typedef float f4 __attribute__((ext_vector_type(4)));
    for (int it = gw; it < nitems; it += ngw) {
        const int kb = it / nblk, nb = it % nblk, k0 = 32 * kb, n0 = 64 * nb; const int src = map(n0 + 4 * (lane & 15));
        f4 wv[8];
#pragma unroll
        for (int i = 0; i < 8; ++i) { const int k = k0 + 4 * i + (lane >> 4); wv[i] = (src >= 0 && k < Kreal) ? *(const f4*)(W + (size_t)k * ldw + src) : (f4){0.f, 0.f, 0.f, 0.f}; }
#pragma unroll
        for (int i = 0; i < 8; ++i) { const int kk = 4 * i + (lane >> 4), k = k0 + kk; f4 v = wv[i]; if (kscale && k < Kreal) v = v * kscale[k]; *(LAS f4*)(scr + kk * 68 + 4 * (lane & 15)) = v; }
        asm volatile("s_waitcnt lgkmcnt(0)" ::: "memory");
#pragma unroll
        for (int j = 0; j < 4; ++j) { const int q = lane + 64 * j, n = q >> 2, c = q & 3; const LAS float* s = scr + (8 * c) * 68 + n;
            pg8::u32x4 o; o.x = pg8::pk_h2(s[0 * 68], s[1 * 68]); o.y = pg8::pk_h2(s[2 * 68], s[3 * 68]); o.z = pg8::pk_h2(s[4 * 68], s[5 * 68]); o.w = pg8::pk_h2(s[6 * 68], s[7 * 68]);
            *(pg8::u32x4*)(WT + (size_t)(n0 + n) * ldk + koff + k0 + 8 * c) = o; }
        asm volatile("s_waitcnt lgkmcnt(0)" ::: "memory");
    }
}
constexpr size_t WT_IN = WS_WT, WT_UQ = WS_WT + 10 * MiB, WT_UKV = WT_UQ + 512 * 1024, WT_OA = WS_WT + 11 * MiB, WT_OB = WS_WT + 12 * MiB, WT_OUT = WS_WT + 13 * MiB;
__device__ __forceinline__ void ph_weights(const Params& p, LAS unsigned char* lds, int gw, int ngw, int wave, int lane) {
    LAS float* scr = (LAS float*)(lds + wave * 16384);
#define WT_ROT(off) ((gw + ngw - ((off) % ngw)) % ngw)
    wt_items(p.w_in, D_IN, 1024, 1024, 5120, (unsigned short*)(p.ws + WT_IN), nullptr, MapIn(), scr, gw, ngw, lane);
    wt_items(p.w_uq, 768, 256, 256, 768, (unsigned short*)(p.ws + WT_UQ), p.g_q, MapUq(), scr, WT_ROT(2560), ngw, lane);
    wt_items(p.w_ukv, 1024, 128, 128, 1024, (unsigned short*)(p.ws + WT_UKV), p.g_kv, MapUkv(), scr, WT_ROT(2656), ngw, lane);
    wt_items(p.w_o_mla, 1024, 512, 512, 1024, (unsigned short*)(p.ws + WT_OA), nullptr, MapId(), scr, WT_ROT(2720), ngw, lane, 1024, 0);
    wt_items(p.w_o_moba, 1024, 512, 512, 1024, (unsigned short*)(p.ws + WT_OA), nullptr, MapId(), scr, WT_ROT(2976), ngw, lane, 1024, 512);
    wt_items(p.w_out, 1024, 1024, 1024, 1024, (unsigned short*)(p.ws + WT_OUT), nullptr, MapId(), scr, WT_ROT(3232), ngw, lane);
#undef WT_ROT
}

namespace att {
struct T1 { static constexpr bool value = true; }; struct T0 { static constexpr bool value = false; };
typedef _Float16 h8 __attribute__((ext_vector_type(8)));
typedef short s4 __attribute__((ext_vector_type(4)));
typedef short s8 __attribute__((ext_vector_type(8)));
typedef float f16v __attribute__((ext_vector_type(16)));
typedef float f2v __attribute__((ext_vector_type(2)));
typedef unsigned u4 __attribute__((ext_vector_type(4)));
typedef short v4i16_t __attribute__((ext_vector_type(4)));
constexpr int KBUF = 16384, VBUF = 8192;
constexpr int NBUF = 4;
constexpr int L_K = 0, L_V = NBUF * KBUF, L_WS = L_V + NBUF * VBUF, L_TB = L_WS + 8 * 256, L_UN = L_TB + 256, L_END = L_UN + 64, L_OST = 0;
constexpr float THR = 8.f;
#ifndef PROBE_ABL
#define PROBE_ABL 0
#endif
#ifndef ATT_STAGGER
#define ATT_STAGGER 0
#endif
constexpr bool STAGGER = ATT_STAGGER;
__device__ __forceinline__ int crow(int r, int hi) { return (r & 3) + 8 * (r >> 2) + 4 * hi; }
template <int DK> __device__ __forceinline__ int kaddr(int row, int ch) { return DK == 64 ? row * 128 + ((ch ^ ((row >> 1) & 7)) << 4) : row * 256 + ((ch ^ (row & 15)) << 4); }
__device__ __forceinline__ s4 vtr(const LAS unsigned char* p) { return __builtin_bit_cast(s4, __builtin_amdgcn_ds_read_tr16_b64_v4i16((LAS v4i16_t*)p)); }
__device__ __forceinline__ float swapmax(float m) { auto rr = __builtin_amdgcn_permlane32_swap(__float_as_uint(m), __float_as_uint(m), false, false); return fmaxf(__uint_as_float(rr[0]), __uint_as_float(rr[1])); }
__device__ __forceinline__ float swapsum(float m) { auto rr = __builtin_amdgcn_permlane32_swap(__float_as_uint(m), __float_as_uint(m), false, false); return __uint_as_float(rr[0]) + __uint_as_float(rr[1]); }
__device__ __forceinline__ void glds16(const void* g, unsigned lds_base) { unsigned sv;
    asm volatile("s_mov_b32 %0, m0\n\ts_mov_b32 m0, %2\n\ts_nop 0\n\tglobal_load_lds_dwordx4 %1, off\n\ts_mov_b32 m0, %0" : "=&s"(sv) : "v"(g), "s"(lds_base) : "memory"); }
__device__ __forceinline__ float max3f(float a, float b, float c) { float r; asm("v_max3_f32 %0, %1, %2, %3" : "=v"(r) : "v"(a), "v"(b), "v"(c)); return r; }
__device__ __forceinline__ unsigned pkh(float lo, float hi) { typedef _Float16 h2 __attribute__((ext_vector_type(2))); h2 v; v[0] = (_Float16)lo; v[1] = (_Float16)hi; return __builtin_bit_cast(unsigned, v); }

template <int DK, bool MOBA, int ABL = 0, bool OWN = false>
__device__ __forceinline__ void attn_unit(unsigned char* ws, int b, int h, int qb, LAS unsigned char* lds, bool dry = false) {
    constexpr int ND = DK / 16, QP = MOBA ? 512 : 768, QH = MOBA ? 64 : 96;
    int tid_ = threadIdx.x; asm volatile("" : "+v"(tid_));
    const int tid = tid_, lane = tid & 63, r32 = lane & 31, hi = lane >> 5; const int wid = __builtin_amdgcn_readfirstlane(tid >> 6);
    const _Float16* Qg = (const _Float16*)(ws + (MOBA ? WS_QMB : WS_QMLA)); const _Float16* Kg = (const _Float16*)(ws + (MOBA ? WS_KMB : WS_KN));
    const _Float16* Vg = (const _Float16*)(ws + (MOBA ? WS_VMB : WS_VM)); const _Float16* Pg = (const _Float16*)(ws + WS_KPE); _Float16* Zg = (_Float16*)(ws + WS_ZCAT) + (MOBA ? 512 : 0);
    const size_t rowbase = (size_t)b * SEQ; const int q0 = qb * 256, qw0 = q0 + wid * 32, qrow = qw0 + r32;
    LAS float* wsf = (LAS float*)(lds + L_WS) + wid * 64; LAS int* tb = (LAS int*)(lds + L_TB); LAS unsigned* un = (LAS unsigned*)(lds + L_UN);
    h8 qr[ND];
#pragma unroll
    for (int d0 = 0; d0 < ND; ++d0) qr[d0] = *(const h8*)(Qg + (rowbase + qrow) * QP + h * QH + d0 * 16 + hi * 8);
#pragma unroll
    for (int d0 = 0; d0 < ND; ++d0) asm volatile("" : "+v"(qr[d0]));
    unsigned sel = 0u, blocks = OWN ? (1u << qb) : (2u << qb) - 1u;
    if (MOBA && !OWN) {
        const float* km = (const float*)(ws + WS_KMEAN) + (size_t)b * 16 * 512 + h * 64 + hi * 8;
        float g0 = -INFINITY, g1 = -INFINITY, g2 = -INFINITY; int i0 = -1, i1 = -1, i2 = -1;
        for (int m = 0; m < qb; ++m) {
            float part = 0.f;
#pragma unroll
            for (int d0 = 0; d0 < 4; ++d0) { const float4 a = *(const float4*)(km + m * 512 + d0 * 16), c = *(const float4*)(km + m * 512 + d0 * 16 + 4);
                part += (float)qr[d0][0] * a.x + (float)qr[d0][1] * a.y + (float)qr[d0][2] * a.z + (float)qr[d0][3] * a.w + (float)qr[d0][4] * c.x + (float)qr[d0][5] * c.y + (float)qr[d0][6] * c.z + (float)qr[d0][7] * c.w; }
            const float g = swapsum(part);
            if (g > g0) { g2 = g1; i2 = i1; g1 = g0; i1 = i0; g0 = g; i0 = m; }
            else if (g > g1) { g2 = g1; i2 = i1; g1 = g; i1 = m; }
            else if (g > g2) { g2 = g; i2 = m; }
        }
        if (i0 >= 0) sel |= 1u << i0; if (i1 >= 0) sel |= 1u << i1; if (i2 >= 0) sel |= 1u << i2;
        unsigned uw = sel;
#pragma unroll
        for (int o = 1; o < 64; o <<= 1) uw |= (unsigned)__shfl_xor((int)uw, o);
        if (lane == 0) un[wid] = uw;
        __syncthreads();
        unsigned ua = 0u;
#pragma unroll
        for (int w = 0; w < 8; ++w) ua |= un[w];
        blocks = (unsigned)__builtin_amdgcn_readfirstlane((int)(ua | (1u << qb)));
    }
    const int NT = OWN ? 4 : 4 * __builtin_popcount(blocks);
    if (tid < 64 && tid < NT) { unsigned bm = blocks; for (int k = 0; k < (tid >> 2); ++k) bm &= bm - 1u; tb[tid] = (__builtin_ctz(bm) << 8) + ((tid & 3) << 6); }
    __syncthreads();
    const unsigned char* kbu = (const unsigned char*)(Kg + rowbase * 512 + h * 64); const unsigned char* vbu = (const unsigned char*)(Vg + rowbase * 512 + h * 64); const unsigned char* pbu = (const unsigned char*)(Pg + rowbase * 32);
    const unsigned char* kb0; const unsigned char* kb1 = nullptr; unsigned ksrc0, ksrc1 = 0u, kst0 = 1024u, kst1 = 1024u;
    if (DK == 96) { const int r0 = 4 * wid + (lane >> 4), r1 = r0 + 32; int c0 = (lane & 15) ^ (r0 & 15), c1 = (lane & 15) ^ (r1 & 15); if (c0 >= 12) c0 -= 4; if (c1 >= 12) c1 -= 4;
        const bool kpe0 = c0 >= 8, kpe1 = c1 >= 8;
        kb0 = kpe0 ? pbu : kbu; kst0 = kpe0 ? 64u : 1024u; ksrc0 = kpe0 ? (unsigned)(r0 * 32 + (c0 - 8) * 8) * 2u : (unsigned)(r0 * 512 + c0 * 8) * 2u;
        kb1 = kpe1 ? pbu : kbu; kst1 = kpe1 ? 64u : 1024u; ksrc1 = kpe1 ? (unsigned)(r1 * 32 + (c1 - 8) * 8) * 2u : (unsigned)(r1 * 512 + c1 * 8) * 2u;
    } else { const int r0 = 8 * wid + (lane >> 3), c0 = (lane & 7) ^ ((r0 >> 1) & 7); kb0 = kbu; ksrc0 = (unsigned)(r0 * 512 + c0 * 8) * 2u; }
    const unsigned vsrc = (unsigned)((16 * (wid & 3) + (lane >> 2)) * 512 + (wid >> 2) * 32 + (lane & 3) * 8) * 2u;
    constexpr int NDMA = (DK == 96) ? 3 : 2;
#define ATT_GLDS(src, dst) glds16((const void*)(src), (unsigned)__builtin_amdgcn_readfirstlane((int)(unsigned)(size_t)(dst)))
#define ATT_DMA(kb, buf) do { const unsigned kb_ = (unsigned)(kb); LAS unsigned char* kd_ = lds + L_K + (buf) * KBUF; \
        ATT_GLDS(kb0 + (ksrc0 + kb_ * kst0), kd_ + wid * 1024); \
        if (DK == 96) ATT_GLDS(kb1 + (ksrc1 + kb_ * kst1), kd_ + 8192 + wid * 1024); \
        ATT_GLDS(vbu + (vsrc + kb_ * 1024u), lds + L_V + (buf) * VBUF + wid * 1024); } while (0)
#define ATT_WAITV(n) asm volatile("s_waitcnt vmcnt(" #n ")" ::: "memory")
#define ATT_BAR() do { asm volatile("s_waitcnt lgkmcnt(0)" ::: "memory"); __builtin_amdgcn_s_barrier(); asm volatile("" ::: "memory"); } while (0)
    const int vro = ((lane >> 4) & 1) * 32 + (lane & 3) * 8 + (4 * hi + ((lane & 15) >> 2)) * 64;
    LAS unsigned char* ldsv = lds + L_V + vro; asm volatile("" : "+v"(ldsv));
    float l_reg = 0.f; bool init = false; f16v o[2]; o[0] = f16v{}; o[1] = f16v{}; f16v negm = f16v{}; asm volatile("" : "+v"(negm));
    constexpr int G = 2 * ND;
#define ATT_SBAR() __builtin_amdgcn_sched_barrier(0)
#define ATT_PIN(x) asm volatile("" : "+v"(x))
#define ATT_KF(buf, g) (*(const LAS h8*)(lds + L_K + (buf) * KBUF + kaddr<DK>(32 * ((g) & 1) + r32, 2 * ((g) >> 1) + hi)))
#define ATT_MF(a, b, c) __builtin_amdgcn_mfma_f32_32x32x16_f16(a, b, c, 0, 0, 0)
#define ATT_QK(P0, P1, buf) do { h8 kf_[G]; _Pragma("unroll") for (int g_ = 0; g_ < G; ++g_) kf_[g_] = ATT_KF(buf, g_); ATT_SBAR(); \
        _Pragma("unroll") for (int d_ = 0; d_ < ND; ++d_) { P0 = ATT_MF(kf_[2 * d_], qr[d_], d_ == 0 ? negm : P0); P1 = ATT_MF(kf_[2 * d_ + 1], qr[d_], d_ == 0 ? negm : P1); } } while (0)
#define ATT_MAXCHAIN(P0, P1, PM) do { float pa_ = max3f(P0[0], P0[1], P1[0]), pb_ = max3f(P0[2], P0[3], P1[1]); pa_ = max3f(pa_, P1[2], P1[3]); \
        _Pragma("unroll") for (int r_ = 4; r_ < 16; r_ += 4) { pa_ = max3f(pa_, P0[r_], P0[r_ + 1]); pb_ = max3f(pb_, P0[r_ + 2], P0[r_ + 3]); pa_ = max3f(pa_, P1[r_], P1[r_ + 1]); pb_ = max3f(pb_, P1[r_ + 2], P1[r_ + 3]); } \
        PM = swapmax(fmaxf(pa_, pb_)); } while (0)
#define ATT_MOVE(P0, P1, PM) do { const bool move_ = init ? ((PM) > THR) : ((PM) > -INFINITY); \
        if (__any(move_)) { const float dl_ = move_ ? (init ? fmaxf((PM), 0.f) : (PM)) : 0.f; const float al_ = (move_ && init) ? __builtin_amdgcn_exp2f(-dl_) : 1.f; \
            init = init || move_; l_reg *= al_; \
            _Pragma("unroll") for (int r_ = 0; r_ < 16; ++r_) { P0[r_] -= dl_; P1[r_] -= dl_; negm[r_] -= dl_; } \
            if (hi == 0) wsf[r32] = al_; asm volatile("s_waitcnt lgkmcnt(0)" ::: "memory"); \
            _Pragma("unroll") for (int r_ = 0; r_ < 16; ++r_) { const float a_ = wsf[crow(r_, hi)]; o[0][r_] *= a_; o[1][r_] *= a_; } } } while (0)
#define ATT_PACK(P0, P1, PW, KEEP) do { _Pragma("unroll") for (int k_ = 0; k_ < 2; ++k_) { \
            PW[k_] = (u4){pkh(P0[8 * k_], P0[8 * k_ + 1]), pkh(P0[8 * k_ + 2], P0[8 * k_ + 3]), pkh(P0[8 * k_ + 4], P0[8 * k_ + 5]), pkh(P0[8 * k_ + 6], P0[8 * k_ + 7])}; \
            PW[2 + k_] = (u4){pkh(P1[8 * k_], P1[8 * k_ + 1]), pkh(P1[8 * k_ + 2], P1[8 * k_ + 3]), pkh(P1[8 * k_ + 4], P1[8 * k_ + 5]), pkh(P1[8 * k_ + 6], P1[8 * k_ + 7])}; } \
        if (MOBA) { _Pragma("unroll") for (int k_ = 0; k_ < 4; ++k_) PW[k_] &= (KEEP); } } while (0)
#define ATT_VF(buf, i) (ldsv + (buf) * VBUF + ((i) >> 2) * 4096 + ((i) & 3) * 1024)
#define ATT_WAIT_NEXT(t_) do { if ((t_) + 3 < NT) { if (NDMA == 3) ATT_WAITV(3); else ATT_WAITV(2); } else ATT_WAITV(0); } while (0)
#define ATT_TB(i) (MOBA ? tb[(i)] : 64 * (i))
    const int NF = OWN ? 0 : NT - 4;
    ATT_DMA(ATT_TB(0), 0); ATT_DMA(ATT_TB(1), 1); ATT_DMA(ATT_TB(2), 2);
    if (NDMA == 3) ATT_WAITV(3); else ATT_WAITV(2);
    ATT_BAR();
    f16v pC0, pC1;
    if (NF > 0) { ATT_QK(pC0, pC1, 0); asm volatile("s_nop 15\n\ts_nop 7" : "+v"(pC0), "+v"(pC1)); float pm; ATT_MAXCHAIN(pC0, pC1, pm);
        if (MOBA && !((sel >> (ATT_TB(0) >> 8)) & 1u)) pm = -INFINITY; ATT_MOVE(pC0, pC1, pm); }
    auto step = [&](f16v& pC0, f16v& pC1, f16v& pN0, f16v& pN1, const int t, auto hn) __attribute__((always_inline)) {
        const int cur = t & 3, nx = (t + 1) & 3; constexpr bool hasn = decltype(hn)::value;
        ATT_DMA(ATT_TB(t + 3), (t + 3) & 3);
        const unsigned keepC = (!MOBA || ((sel >> (ATT_TB(t) >> 8)) & 1u)) ? 0xffffffffu : 0u;
        float ps = 0.f; f2v ps2 = (f2v){0.f, 0.f};
        if (hasn) {
            h8 kf[G];
#pragma unroll
            for (int g = 0; g < 4; ++g) kf[g] = ATT_KF(nx, g);
            ATT_SBAR();
#pragma unroll
            for (int g = 0; g < G; ++g) {
                if (g + 4 < G) kf[g + 4] = ATT_KF(nx, g + 4);
                if (g & 1) pN1 = ATT_MF(kf[g], qr[g >> 1], g == 1 ? negm : pN1); else pN0 = ATT_MF(kf[g], qr[g >> 1], g == 0 ? negm : pN0);
                constexpr int dummy = 0; (void)dummy;
                const int e0 = (ND == 4) ? 4 * g : (g < 8 ? 3 * g : 24 + 2 * (g - 8)), e1 = (ND == 4) ? 4 * g + 4 : (g < 8 ? 3 * g + 3 : 26 + 2 * (g - 8));
#pragma unroll
                for (int e = e0; e < e1; ++e) { if (e < 16) pC0[e] = __builtin_amdgcn_exp2f(pC0[e]); else pC1[e - 16] = __builtin_amdgcn_exp2f(pC1[e - 16]);
                    if (e & 1) { if (e < 16) ps2 += (f2v){pC0[e - 1], pC0[e]}; else ps2 += (f2v){pC1[e - 17], pC1[e - 16]}; } }
                ATT_PIN(pC0); ATT_PIN(pC1); ATT_PIN(ps2); ATT_SBAR();
            }
        } else {
#pragma unroll
            for (int r = 0; r < 16; ++r) { pC0[r] = __builtin_amdgcn_exp2f(pC0[r]); pC1[r] = __builtin_amdgcn_exp2f(pC1[r]); ps += pC0[r] + pC1[r]; }
        }
        ps += ps2[0] + ps2[1];
        if (MOBA && !keepC) ps = 0.f;
        l_reg += swapsum(ps);
        u4 pw[4]; ATT_PACK(pC0, pC1, pw, keepC);
        {
            s4 vlo[8], vhi[8]; float pa = 0.f, pb = 0.f;
#pragma unroll
            for (int i = 0; i < 3; ++i) { vlo[i] = vtr(ATT_VF(cur, i)); vhi[i] = vtr(ATT_VF(cur, i) + 512); }
            if (hasn) asm volatile("s_nop 7" : "+v"(pN0), "+v"(pN1));
            ATT_SBAR();
#pragma unroll
            for (int i = 0; i < 8; ++i) {
                if (i + 3 < 8) { vlo[i + 3] = vtr(ATT_VF(cur, i + 3)); vhi[i + 3] = vtr(ATT_VF(cur, i + 3) + 512); }
                const s8 vv = (s8){vlo[i][0], vlo[i][1], vlo[i][2], vlo[i][3], vhi[i][0], vhi[i][1], vhi[i][2], vhi[i][3]};
                o[i >> 2] = ATT_MF(__builtin_bit_cast(h8, pw[i & 3]), __builtin_bit_cast(h8, vv), o[i >> 2]);
                if (hasn) {
                    if (i == 0) { pa = max3f(pN0[0], pN0[1], pN1[0]); pb = max3f(pN0[2], pN0[3], pN1[1]); }
                    else if (i == 1) { pa = max3f(pa, pN1[2], pN1[3]); pb = max3f(pb, pN0[6], pN0[7]); }
                    else if (i == 2) { pa = max3f(pa, pN0[4], pN0[5]); pb = max3f(pb, pN1[6], pN1[7]); }
                    else if (i == 3) { pa = max3f(pa, pN1[4], pN1[5]); pb = max3f(pb, pN0[10], pN0[11]); }
                    else if (i == 4) { pa = max3f(pa, pN0[8], pN0[9]); pb = max3f(pb, pN1[10], pN1[11]); }
                    else if (i == 5) { pa = max3f(pa, pN1[8], pN1[9]); pb = max3f(pb, pN0[14], pN0[15]); }
                    else if (i == 6) { pa = max3f(pa, pN0[12], pN0[13]); pb = max3f(pb, pN1[14], pN1[15]); }
                    else { pa = max3f(pa, pN1[12], pN1[13]); }
                    ATT_PIN(pa); ATT_PIN(pb);
                }
                ATT_SBAR();
            }
            if (hasn) { float pm = swapmax(fmaxf(pa, pb)); if (MOBA && !((sel >> (ATT_TB(t + 1) >> 8)) & 1u)) pm = -INFINITY; ATT_MOVE(pN0, pN1, pm); }
        }
        if (NDMA == 3) ATT_WAITV(3); else ATT_WAITV(2);
        ATT_BAR();
    };
    {
        f16v pD0, pD1; int t = 0;
        for (; t + 2 < NF; t += 2) { step(pC0, pC1, pD0, pD1, t, T1{}); step(pD0, pD1, pC0, pC1, t + 1, T1{}); }
        if (t + 1 < NF) { step(pC0, pC1, pD0, pD1, t, T1{}); step(pD0, pD1, pC0, pC1, t + 1, T0{}); }
        else if (t < NF) step(pC0, pC1, pD0, pD1, t, T0{});
    }
    for (int t = NF; t < NT; ++t) {
        const int cur = t & 3, kb = ATT_TB(t);
        if (t + 3 < NT) ATT_DMA(ATT_TB(t + 3), (t + 3) & 3);
        if (kb <= qw0 + 31) {
            f16v p0, p1; ATT_QK(p0, p1, cur);
            if (kb + 63 > qw0) {
#pragma unroll
                for (int r = 0; r < 16; ++r) { const int kv = kb + crow(r, hi); if (kv > qrow) p0[r] = -INFINITY; if (kv + 32 > qrow) p1[r] = -INFINITY; }
            }
            asm volatile("s_nop 15\n\ts_nop 7" : "+v"(p0), "+v"(p1));
            float pm; ATT_MAXCHAIN(p0, p1, pm); ATT_MOVE(p0, p1, pm);
            s4 vlo[8], vhi[8];
#pragma unroll
            for (int i = 0; i < 8; ++i) { vlo[i] = vtr(ATT_VF(cur, i)); vhi[i] = vtr(ATT_VF(cur, i) + 512); }
            ATT_SBAR();
            float ps = 0.f;
#pragma unroll
            for (int r = 0; r < 16; ++r) { p0[r] = __builtin_amdgcn_exp2f(p0[r]); p1[r] = __builtin_amdgcn_exp2f(p1[r]); ps += p0[r] + p1[r]; }
            l_reg += swapsum(ps);
            u4 pw[4]; ATT_PACK(p0, p1, pw, 0xffffffffu);
#pragma unroll
            for (int i = 0; i < 8; ++i) { const s8 vv = (s8){vlo[i][0], vlo[i][1], vlo[i][2], vlo[i][3], vhi[i][0], vhi[i][1], vhi[i][2], vhi[i][3]};
                o[i >> 2] = ATT_MF(__builtin_bit_cast(h8, pw[i & 3]), __builtin_bit_cast(h8, vv), o[i >> 2]); }
        }
        ATT_WAIT_NEXT(t);
        ATT_BAR();
    }
    if (hi == 0) { wsf[32 + r32] = l_reg; if (OWN) wsf[r32] = -negm[0]; } asm volatile("s_waitcnt lgkmcnt(0)" ::: "memory");
    LAS _Float16* stg = (LAS _Float16*)(lds + L_OST) + wid * 2048;
#pragma unroll
    for (int r = 0; r < 16; ++r) { const int orow = crow(r, hi); const float rl = 1.f / wsf[32 + orow];
        stg[orow * 64 + r32] = (_Float16)(o[0][r] * rl); stg[orow * 64 + 32 + r32] = (_Float16)(o[1][r] * rl); }
    asm volatile("s_waitcnt lgkmcnt(0)" ::: "memory");
    int lane_e = lane; asm volatile("" : "+v"(lane_e));
    unsigned char* zbu = (unsigned char*)(Zg + (rowbase + qw0) * 1024 + h * 64);
#pragma unroll
    for (int i = 0; i < 4; ++i) { const int row = i * 8 + (lane_e >> 3), ch = lane_e & 7; const h8 v = *(const LAS h8*)(stg + row * 64 + ch * 8);
        _Float16* zp = (_Float16*)(zbu + (unsigned)(row * 1024 + ch * 8) * 2u); const h8 z = *(const h8*)zp; h8 ov;
        if (OWN) {
            const int nsl = qb < 3 ? qb : 3; const unsigned gr = (unsigned)((b * 8 + h) * 4096 + qw0 + row);
            const float m_own = wsf[row], l_own = wsf[32 + row]; float M = m_own; float2 ml[3]; h8 po[3];
#pragma unroll
            for (int s = 0; s < 3; ++s) if (s < nsl) { ml[s] = ((const float2*)(ws + WS_ML))[(unsigned)s * 524288u + gr]; po[s] = *(const h8*)(ws + opart_off(s) + gr * 128u + (unsigned)ch * 16u); M = fmaxf(M, ml[s].x); }
            const float w0 = l_own * __builtin_amdgcn_exp2f(m_own - M); float W = w0; float acc[8];
#pragma unroll
            for (int j = 0; j < 8; ++j) acc[j] = w0 * (float)v[j];
#pragma unroll
            for (int s = 0; s < 3; ++s) if (s < nsl) { const float w = ml[s].y * __builtin_amdgcn_exp2f(ml[s].x - M); W += w;
#pragma unroll
                for (int j = 0; j < 8; ++j) acc[j] = fmaf(w, (float)po[s][j], acc[j]); }
            const float rW = 1.f / W;
#pragma unroll
            for (int j = 0; j < 8; ++j) ov[j] = (_Float16)(acc[j] * rW * (float)z[j]);
        } else {
#pragma unroll
            for (int j = 0; j < 8; ++j) ov[j] = (_Float16)((float)v[j] * (float)z[j]);
        }
        if (!dry) *(h8*)zp = ov; }
    __syncthreads();
#undef ATT_GLDS
#undef ATT_DMA
#undef ATT_WAITV
#undef ATT_BAR
#undef ATT_SBAR
#undef ATT_PIN
#undef ATT_KF
#undef ATT_MF
#undef ATT_QK
#undef ATT_MAXCHAIN
#undef ATT_MOVE
#undef ATT_PACK
#undef ATT_VF
#undef ATT_WAIT_NEXT
#undef ATT_TB
}


__device__ __forceinline__ void ph_gate(unsigned char* ws, int gw_, int ngw, int lane) {
    const int gw = __builtin_amdgcn_readfirstlane(gw_);
    unsigned* cnt = (unsigned*)(ws + WS_CNT); unsigned short* lists = (unsigned short*)(ws + WS_LIST);
    for (int it = gw; it < 128 * 60; it += ngw) {
        const int bh = it / 60, rr = it - bh * 60, qb = 1 + (rr >> 2), ch = rr & 3, b = bh >> 3, h = bh & 7;
        const int row = qb * 256 + ch * 64 + lane;
        const _Float16* q = (const _Float16*)(ws + WS_QMB) + ((size_t)b * SEQ + row) * 512 + h * 64;
        h8 qv[8];
#pragma unroll
        for (int i = 0; i < 8; ++i) qv[i] = *(const h8*)(q + 8 * i);
        const float* km = (const float*)(ws + WS_KMEAN) + (size_t)b * 16 * 512 + h * 64;
        float g0 = -INFINITY, g1 = -INFINITY, g2 = -INFINITY; int i0 = -1, i1 = -1, i2 = -1;
        for (int m = 0; m < qb; ++m) {
            float s0 = 0.f, s1 = 0.f;
#pragma unroll
            for (int d = 0; d < 64; d += 2) { s0 = fmaf((float)qv[d >> 3][d & 7], km[m * 512 + d], s0); s1 = fmaf((float)qv[d >> 3][(d & 7) + 1], km[m * 512 + d + 1], s1); }
            const float g = s0 + s1;
            if (g > g0) { g2 = g1; i2 = i1; g1 = g0; i1 = i0; g0 = g; i0 = m; }
            else if (g > g1) { g2 = g1; i2 = i1; g1 = g; i1 = m; }
            else if (g > g2) { g2 = g; i2 = m; }
        }
        unsigned mycnt = 0u;
#pragma unroll
        for (int j = 0; j < 15; ++j) { const bool s = (i0 == j) | (i1 == j) | (i2 == j); const unsigned long long mk = __ballot(s); if (lane == j) mycnt = (unsigned)__popcll(mk); }
        unsigned basev = 0u; if (lane < 15 && mycnt) basev = atomicAdd(&cnt[bh * 16 + lane], mycnt);
#pragma unroll
        for (int j = 0; j < 15; ++j) { const bool s = (i0 == j) | (i1 == j) | (i2 == j); const unsigned long long mk = __ballot(s); const unsigned base = (unsigned)__builtin_amdgcn_readlane((int)basev, j);
            if (s) { const unsigned rank = (unsigned)__popcll(mk & ((1ull << lane) - 1ull)); const int slot = (i0 == j) ? 0 : ((i1 == j) ? 1 : 2);
                lists[(size_t)(bh * 16 + j) * 4096 + base + rank] = (unsigned short)(row | (slot << 12)); } }
    }
}

constexpr int GBUF = 65536, G_V = 32768, G_WS = 131072 + 1024, G_CTL = G_WS + 4096, G_ST = G_CTL + 768;
constexpr unsigned G_SINK = 256 * 1024;
__device__ __forceinline__ void gather_dma(unsigned char* ws, int b, int h, int j, LAS unsigned char* lds, int X) {
    int tid_ = threadIdx.x; asm volatile("" : "+v"(tid_)); const int lane = tid_ & 63; const int wid = __builtin_amdgcn_readfirstlane(tid_ >> 6);
    const size_t rowbase = (size_t)b * SEQ + j * 256;
    const unsigned char* kbu = (const unsigned char*)((const _Float16*)(ws + WS_KMB) + rowbase * 512 + h * 64); const unsigned char* vbu = (const unsigned char*)((const _Float16*)(ws + WS_VMB) + rowbase * 512 + h * 64);
    const int r0 = 8 * wid + (lane >> 3), c0 = (lane & 7) ^ ((r0 >> 1) & 7);
    const unsigned ksrc = (unsigned)(r0 * 512 + c0 * 8) * 2u, vsrc = (unsigned)((16 * (wid & 3) + (lane >> 2)) * 512 + (wid >> 2) * 32 + (lane & 3) * 8) * 2u;
    LAS unsigned char* lb = lds + X * GBUF + wid * 1024;
#pragma unroll
    for (int t = 0; t < 4; ++t) {
        glds16((const void*)(kbu + (ksrc + (unsigned)t * 65536u)), (unsigned)__builtin_amdgcn_readfirstlane((int)(unsigned)(size_t)(lb + t * 8192)));
        glds16((const void*)(vbu + (vsrc + (unsigned)t * 65536u)), (unsigned)__builtin_amdgcn_readfirstlane((int)(unsigned)(size_t)(lb + G_V + t * 8192))); }
}
__device__ __forceinline__ void gather_dma_all(unsigned char* ws, int b, int h, int j, LAS unsigned char* lds, int X) {
    int tid_ = threadIdx.x; asm volatile("" : "+v"(tid_)); const int lane = tid_ & 63;
    const size_t rowbase = (size_t)b * SEQ + j * 256;
    const unsigned char* kbu = (const unsigned char*)((const _Float16*)(ws + WS_KMB) + rowbase * 512 + h * 64); const unsigned char* vbu = (const unsigned char*)((const _Float16*)(ws + WS_VMB) + rowbase * 512 + h * 64);
    for (int w = 0; w < 8; ++w) {
        const int r0 = 8 * w + (lane >> 3), c0 = (lane & 7) ^ ((r0 >> 1) & 7);
        const unsigned ksrc = (unsigned)(r0 * 512 + c0 * 8) * 2u, vsrc = (unsigned)((16 * (w & 3) + (lane >> 2)) * 512 + (w >> 2) * 32 + (lane & 3) * 8) * 2u;
        LAS unsigned char* lb = lds + X * GBUF + w * 1024;
#pragma unroll
        for (int t = 0; t < 4; ++t) {
            glds16((const void*)(kbu + (ksrc + (unsigned)t * 65536u)), (unsigned)__builtin_amdgcn_readfirstlane((int)(unsigned)(size_t)(lb + t * 8192)));
            glds16((const void*)(vbu + (vsrc + (unsigned)t * 65536u)), (unsigned)__builtin_amdgcn_readfirstlane((int)(unsigned)(size_t)(lb + G_V + t * 8192))); }
    }
}
__device__ __forceinline__ void gather_unit(unsigned char* ws, int b, int h, int j, LAS unsigned char* lds, int X, LAS unsigned* ctr) {
    constexpr int ND = 4, G = 8;
    int tid_ = threadIdx.x; asm volatile("" : "+v"(tid_));
    const int tid = tid_, lane = tid & 63, r32 = lane & 31, hi = lane >> 5; const int wid = __builtin_amdgcn_readfirstlane(tid >> 6);
    const int bh = b * 8 + h;
    const _Float16* Qg = (const _Float16*)(ws + WS_QMB) + (size_t)b * SEQ * 512 + h * 64;
    const unsigned short* lst = (const unsigned short*)(ws + WS_LIST) + (size_t)(bh * 16 + j) * 4096;
    const int cnt = __builtin_amdgcn_readfirstlane((int)((const unsigned*)(ws + WS_CNT))[bh * 16 + j]);
    const int ngr = (cnt + 31) >> 5;
    LAS unsigned char* kfb = lds + X * GBUF; LAS unsigned char* vfb = kfb + G_V;
    LAS float* wsf = (LAS float*)(lds + G_WS) + wid * 128; LAS unsigned* wsu = (LAS unsigned*)wsf;
    const int vro = ((lane >> 4) & 1) * 32 + (lane & 3) * 8 + (4 * hi + ((lane & 15) >> 2)) * 64;
#define GT_SBAR() __builtin_amdgcn_sched_barrier(0)
#define GT_PIN(x) asm volatile("" : "+v"(x))
#define GT_KF(buf, g) (*(const LAS h8*)(kfb + (buf) * 8192 + kaddr<64>(32 * ((g) & 1) + r32, 2 * ((g) >> 1) + hi)))
#define GT_VF(buf, i) (vfb + (buf) * 8192 + vro + ((i) >> 2) * 4096 + ((i) & 3) * 1024)
#define GT_MF(a, b, c) __builtin_amdgcn_mfma_f32_32x32x16_f16(a, b, c, 0, 0, 0)
#define GT_MOVE(P0, P1, PM) do { const bool move_ = init ? ((PM) > THR) : ((PM) > -INFINITY); \
        if (__any(move_)) { const float dl_ = move_ ? (init ? fmaxf((PM), 0.f) : (PM)) : 0.f; const float al_ = (move_ && init) ? __builtin_amdgcn_exp2f(-dl_) : 1.f; \
            init = init || move_; l_reg *= al_; \
            _Pragma("unroll") for (int r_ = 0; r_ < 16; ++r_) { P0[r_] -= dl_; P1[r_] -= dl_; negm[r_] -= dl_; } \
            if (hi == 0) wsf[r32] = al_; asm volatile("s_waitcnt lgkmcnt(0)" ::: "memory"); \
            _Pragma("unroll") for (int r_ = 0; r_ < 16; ++r_) { const float a_ = wsf[crow(r_, hi)]; o[0][r_] *= a_; o[1][r_] *= a_; } } } while (0)
#define GT_TAKE() ({ unsigned v_ = 0u; if (lane == 0) v_ = __hip_atomic_fetch_add(ctr, 1u, __ATOMIC_RELAXED, __HIP_MEMORY_SCOPE_WORKGROUP); (int)__builtin_amdgcn_readfirstlane((int)v_); })
    h8 qr[ND]; bool validn = false; unsigned entn = 0u;
    int g = GT_TAKE(), gn = ngr;
    if (g < ngr) { const int idx = g * 32 + r32; validn = idx < cnt; entn = validn ? (unsigned)lst[idx] : 0u;
#pragma unroll
        for (int d0 = 0; d0 < ND; ++d0) qr[d0] = *(const h8*)(Qg + (size_t)(entn & 4095u) * 512 + d0 * 16 + hi * 8); }
    for (; g < ngr; g = gn) {
        const bool valid = validn; const unsigned ent = entn; const int row = (int)(ent & 4095u), slot = (int)(ent >> 12) & 3;
        gn = GT_TAKE(); { const int idx = gn * 32 + r32; validn = idx < cnt; entn = validn ? (unsigned)lst[idx] : 0u; }
#pragma unroll
        for (int d0 = 0; d0 < ND; ++d0) asm volatile("" : "+v"(qr[d0]));
        float l_reg = 0.f; bool init = false; f16v o[2]; o[0] = f16v{}; o[1] = f16v{}; f16v negm = f16v{}; asm volatile("" : "+v"(negm));
        f16v pC0, pC1, pD0, pD1;
        {
            h8 kf_[G];
#pragma unroll
            for (int g_ = 0; g_ < G; ++g_) kf_[g_] = GT_KF(0, g_);
            GT_SBAR();
#pragma unroll
            for (int d_ = 0; d_ < ND; ++d_) { pC0 = GT_MF(kf_[2 * d_], qr[d_], d_ == 0 ? negm : pC0); pC1 = GT_MF(kf_[2 * d_ + 1], qr[d_], d_ == 0 ? negm : pC1); }
            asm volatile("s_nop 15\n\ts_nop 7" : "+v"(pC0), "+v"(pC1));
            float pa_ = max3f(pC0[0], pC0[1], pC1[0]), pb_ = max3f(pC0[2], pC0[3], pC1[1]); pa_ = max3f(pa_, pC1[2], pC1[3]);
#pragma unroll
            for (int r_ = 4; r_ < 16; r_ += 4) { pa_ = max3f(pa_, pC0[r_], pC0[r_ + 1]); pb_ = max3f(pb_, pC0[r_ + 2], pC0[r_ + 3]); pa_ = max3f(pa_, pC1[r_], pC1[r_ + 1]); pb_ = max3f(pb_, pC1[r_ + 2], pC1[r_ + 3]); }
            const float pm = swapmax(fmaxf(pa_, pb_)); GT_MOVE(pC0, pC1, pm);
        }
        auto gstep = [&](f16v& pC0, f16v& pC1, f16v& pN0, f16v& pN1, const int t, auto hn) __attribute__((always_inline)) {
            constexpr bool hasn = decltype(hn)::value;
            float ps = 0.f;
            if (hasn) {
                h8 kf[G];
#pragma unroll
                for (int g_ = 0; g_ < 4; ++g_) kf[g_] = GT_KF(t + 1, g_);
                GT_SBAR();
#pragma unroll
                for (int g_ = 0; g_ < G; ++g_) {
                    if (g_ + 4 < G) kf[g_ + 4] = GT_KF(t + 1, g_ + 4);
                    if (g_ & 1) pN1 = GT_MF(kf[g_], qr[g_ >> 1], g_ == 1 ? negm : pN1); else pN0 = GT_MF(kf[g_], qr[g_ >> 1], g_ == 0 ? negm : pN0);
#pragma unroll
                    for (int e = 4 * g_; e < 4 * g_ + 4; ++e) { if (e < 16) { pC0[e] = __builtin_amdgcn_exp2f(pC0[e]); ps += pC0[e]; } else { pC1[e - 16] = __builtin_amdgcn_exp2f(pC1[e - 16]); ps += pC1[e - 16]; } }
                    GT_PIN(pC0); GT_PIN(pC1); GT_PIN(ps); GT_SBAR();
                }
            } else {
#pragma unroll
                for (int r = 0; r < 16; ++r) { pC0[r] = __builtin_amdgcn_exp2f(pC0[r]); pC1[r] = __builtin_amdgcn_exp2f(pC1[r]); ps += pC0[r] + pC1[r]; }
            }
            l_reg += swapsum(ps);
            u4 pw[4];
#pragma unroll
            for (int k_ = 0; k_ < 2; ++k_) {
                pw[k_] = (u4){pkh(pC0[8 * k_], pC0[8 * k_ + 1]), pkh(pC0[8 * k_ + 2], pC0[8 * k_ + 3]), pkh(pC0[8 * k_ + 4], pC0[8 * k_ + 5]), pkh(pC0[8 * k_ + 6], pC0[8 * k_ + 7])};
                pw[2 + k_] = (u4){pkh(pC1[8 * k_], pC1[8 * k_ + 1]), pkh(pC1[8 * k_ + 2], pC1[8 * k_ + 3]), pkh(pC1[8 * k_ + 4], pC1[8 * k_ + 5]), pkh(pC1[8 * k_ + 6], pC1[8 * k_ + 7])}; }
            s4 vlo[8], vhi[8]; float pa = 0.f, pb = 0.f;
#pragma unroll
            for (int i = 0; i < 3; ++i) { vlo[i] = vtr(GT_VF(t, i)); vhi[i] = vtr(GT_VF(t, i) + 512); }
            if (hasn) asm volatile("s_nop 7" : "+v"(pN0), "+v"(pN1));
            GT_SBAR();
#pragma unroll
            for (int i = 0; i < 8; ++i) {
                if (i + 3 < 8) { vlo[i + 3] = vtr(GT_VF(t, i + 3)); vhi[i + 3] = vtr(GT_VF(t, i + 3) + 512); }
                const s8 vv = (s8){vlo[i][0], vlo[i][1], vlo[i][2], vlo[i][3], vhi[i][0], vhi[i][1], vhi[i][2], vhi[i][3]};
                o[i >> 2] = GT_MF(__builtin_bit_cast(h8, pw[i & 3]), __builtin_bit_cast(h8, vv), o[i >> 2]);
                if (hasn) {
                    if (i == 0) { pa = max3f(pN0[0], pN0[1], pN1[0]); pb = max3f(pN0[2], pN0[3], pN1[1]); }
                    else if (i == 1) { pa = max3f(pa, pN1[2], pN1[3]); pb = max3f(pb, pN0[6], pN0[7]); }
                    else if (i == 2) { pa = max3f(pa, pN0[4], pN0[5]); pb = max3f(pb, pN1[6], pN1[7]); }
                    else if (i == 3) { pa = max3f(pa, pN1[4], pN1[5]); pb = max3f(pb, pN0[10], pN0[11]); }
                    else if (i == 4) { pa = max3f(pa, pN0[8], pN0[9]); pb = max3f(pb, pN1[10], pN1[11]); }
                    else if (i == 5) { pa = max3f(pa, pN1[8], pN1[9]); pb = max3f(pb, pN0[14], pN0[15]); }
                    else if (i == 6) { pa = max3f(pa, pN0[12], pN0[13]); pb = max3f(pb, pN1[14], pN1[15]); }
                    else { pa = max3f(pa, pN1[12], pN1[13]); }
                    GT_PIN(pa); GT_PIN(pb);
                }
                GT_SBAR();
            }
            if (hasn) { const float pm = swapmax(fmaxf(pa, pb)); GT_MOVE(pN0, pN1, pm); }
        };
        gstep(pC0, pC1, pD0, pD1, 0, T1{}); gstep(pD0, pD1, pC0, pC1, 1, T1{}); gstep(pC0, pC1, pD0, pD1, 2, T1{}); gstep(pD0, pD1, pC0, pC1, 3, T0{});
        if (gn < ngr) {
#pragma unroll
            for (int d0 = 0; d0 < ND; ++d0) qr[d0] = *(const h8*)(Qg + (size_t)(entn & 4095u) * 512 + d0 * 16 + hi * 8); }
        const unsigned gr = (unsigned)(bh * 4096 + row);
        if (hi == 0) { wsf[32 + r32] = 1.f / l_reg; wsu[64 + r32] = valid ? opart_off(slot) + gr * 128u : G_SINK;
            if (valid) ((float2*)(ws + WS_ML))[(unsigned)slot * 524288u + gr] = make_float2(-negm[0], l_reg); }
        asm volatile("s_waitcnt lgkmcnt(0)" ::: "memory");
#pragma unroll
        for (int k = 0; k < 4; ++k) {
            typedef float f4e __attribute__((ext_vector_type(4)));
            const f4e rl4 = *(const LAS f4e*)(wsf + 32 + 8 * k + 4 * hi); const u4 of4 = *(const LAS u4*)(wsu + 64 + 8 * k + 4 * hi);
#pragma unroll
            for (int i = 0; i < 4; ++i) { const int r = 4 * k + i; const unsigned off = of4[i] + (unsigned)r32 * 2u;
                *(_Float16*)(ws + off) = (_Float16)(o[0][r] * rl4[i]); *(_Float16*)(ws + off + 64u) = (_Float16)(o[1][r] * rl4[i]); } }
    }
#undef GT_TAKE
#undef GT_SBAR
#undef GT_PIN
#undef GT_KF
#undef GT_VF
#undef GT_MF
#undef GT_MOVE
}


__device__ __forceinline__ void own_unit(unsigned char* ws, int b, int h, int qb, LAS unsigned char* lds, int X, bool dry, int rg) {
    constexpr int ND = 4, G = 8;
    int tid_ = threadIdx.x; asm volatile("" : "+v"(tid_));
    const int tid = tid_, lane = tid & 63, r32 = lane & 31, hi = lane >> 5; const int wid = __builtin_amdgcn_readfirstlane(tid >> 6);
    const int bh = b * 8 + h, nt = (rg >> 1) + 1; const bool odd = rg & 1; const int qw0 = qb * 256 + rg * 32;
    const _Float16* Qg = (const _Float16*)(ws + WS_QMB) + ((size_t)b * SEQ + qw0) * 512 + h * 64;
    LAS unsigned char* kfb = lds + X * GBUF; LAS unsigned char* vfb = kfb + G_V;
    LAS float* wsf = (LAS float*)(lds + G_WS) + wid * 128;
    const int vro = ((lane >> 4) & 1) * 32 + (lane & 3) * 8 + (4 * hi + ((lane & 15) >> 2)) * 64;
    const int dl = r32 - 4 * hi;
#define GT_SBAR() __builtin_amdgcn_sched_barrier(0)
#define GT_PIN(x) asm volatile("" : "+v"(x))
#define GT_KF(buf, g) (*(const LAS h8*)(kfb + (buf) * 8192 + kaddr<64>(32 * ((g) & 1) + r32, 2 * ((g) >> 1) + hi)))
#define GT_VF(buf, i) (vfb + (buf) * 8192 + vro + ((i) >> 2) * 4096 + ((i) & 3) * 1024)
#define GT_MF(a, b, c) __builtin_amdgcn_mfma_f32_32x32x16_f16(a, b, c, 0, 0, 0)
#define GT_MOVE(P0, P1, PM) do { const bool move_ = init ? ((PM) > THR) : ((PM) > -INFINITY); \
        if (__any(move_)) { const float dl_ = move_ ? (init ? fmaxf((PM), 0.f) : (PM)) : 0.f; const float al_ = (move_ && init) ? __builtin_amdgcn_exp2f(-dl_) : 1.f; \
            init = init || move_; l_reg *= al_; \
            _Pragma("unroll") for (int r_ = 0; r_ < 16; ++r_) { P0[r_] -= dl_; P1[r_] -= dl_; negm[r_] -= dl_; } \
            if (hi == 0) wsf[r32] = al_; asm volatile("s_waitcnt lgkmcnt(0)" ::: "memory"); \
            _Pragma("unroll") for (int r_ = 0; r_ < 16; ++r_) { const float a_ = wsf[crow(r_, hi)]; o[0][r_] *= a_; o[1][r_] *= a_; } } } while (0)
#define GT_MASK(P0, P1) do { _Pragma("unroll") for (int r_ = 0; r_ < 16; ++r_) { const bool dg_ = ((r_ & 3) + 8 * (r_ >> 2)) > dl; \
            if (!odd) { if (dg_) P0[r_] = -INFINITY; P1[r_] = -INFINITY; } else { if (dg_) P1[r_] = -INFINITY; } } } while (0)
    h8 qr[ND];
#pragma unroll
    for (int d0 = 0; d0 < ND; ++d0) qr[d0] = *(const h8*)(Qg + (size_t)r32 * 512 + d0 * 16 + hi * 8);
#pragma unroll
    for (int d0 = 0; d0 < ND; ++d0) asm volatile("" : "+v"(qr[d0]));
    float l_reg = 0.f; bool init = false; f16v o[2]; o[0] = f16v{}; o[1] = f16v{}; f16v negm = f16v{}; asm volatile("" : "+v"(negm));
    f16v pC0, pC1, pD0, pD1;
    {
        h8 kf_[G];
#pragma unroll
        for (int g_ = 0; g_ < G; ++g_) kf_[g_] = GT_KF(0, g_);
        GT_SBAR();
#pragma unroll
        for (int d_ = 0; d_ < ND; ++d_) { pC0 = GT_MF(kf_[2 * d_], qr[d_], d_ == 0 ? negm : pC0); pC1 = GT_MF(kf_[2 * d_ + 1], qr[d_], d_ == 0 ? negm : pC1); }
        asm volatile("s_nop 15\n\ts_nop 7" : "+v"(pC0), "+v"(pC1));
        if (nt == 1) GT_MASK(pC0, pC1);
        float pa_ = max3f(pC0[0], pC0[1], pC1[0]), pb_ = max3f(pC0[2], pC0[3], pC1[1]); pa_ = max3f(pa_, pC1[2], pC1[3]);
#pragma unroll
        for (int r_ = 4; r_ < 16; r_ += 4) { pa_ = max3f(pa_, pC0[r_], pC0[r_ + 1]); pb_ = max3f(pb_, pC0[r_ + 2], pC0[r_ + 3]); pa_ = max3f(pa_, pC1[r_], pC1[r_ + 1]); pb_ = max3f(pb_, pC1[r_ + 2], pC1[r_ + 3]); }
        const float pm = swapmax(fmaxf(pa_, pb_)); GT_MOVE(pC0, pC1, pm);
    }
    auto gstep = [&](f16v& pC0, f16v& pC1, f16v& pN0, f16v& pN1, const int t, auto hn, const bool mk) __attribute__((always_inline)) {
        constexpr bool hasn = decltype(hn)::value;
        float ps = 0.f; f2v ps2 = (f2v){0.f, 0.f};
        if (hasn) {
            h8 kf[G];
#pragma unroll
            for (int g_ = 0; g_ < 4; ++g_) kf[g_] = GT_KF(t + 1, g_);
            GT_SBAR();
#pragma unroll
            for (int g_ = 0; g_ < G; ++g_) {
                if (g_ + 4 < G) kf[g_ + 4] = GT_KF(t + 1, g_ + 4);
                if (g_ & 1) pN1 = GT_MF(kf[g_], qr[g_ >> 1], g_ == 1 ? negm : pN1); else pN0 = GT_MF(kf[g_], qr[g_ >> 1], g_ == 0 ? negm : pN0);
#pragma unroll
                for (int e = 4 * g_; e < 4 * g_ + 4; ++e) { if (e < 16) { pC0[e] = __builtin_amdgcn_exp2f(pC0[e]); ps += pC0[e]; } else { pC1[e - 16] = __builtin_amdgcn_exp2f(pC1[e - 16]); ps += pC1[e - 16]; } }
                GT_PIN(pC0); GT_PIN(pC1); GT_PIN(ps); GT_SBAR();
            }
        } else {
#pragma unroll
            for (int r = 0; r < 16; ++r) { pC0[r] = __builtin_amdgcn_exp2f(pC0[r]); pC1[r] = __builtin_amdgcn_exp2f(pC1[r]); ps += pC0[r] + pC1[r]; }
        }
        l_reg += swapsum(ps);
        u4 pw[4];
#pragma unroll
        for (int k_ = 0; k_ < 2; ++k_) {
            pw[k_] = (u4){pkh(pC0[8 * k_], pC0[8 * k_ + 1]), pkh(pC0[8 * k_ + 2], pC0[8 * k_ + 3]), pkh(pC0[8 * k_ + 4], pC0[8 * k_ + 5]), pkh(pC0[8 * k_ + 6], pC0[8 * k_ + 7])};
            pw[2 + k_] = (u4){pkh(pC1[8 * k_], pC1[8 * k_ + 1]), pkh(pC1[8 * k_ + 2], pC1[8 * k_ + 3]), pkh(pC1[8 * k_ + 4], pC1[8 * k_ + 5]), pkh(pC1[8 * k_ + 6], pC1[8 * k_ + 7])}; }
        s4 vlo[8], vhi[8]; float pa = 0.f, pb = 0.f;
#pragma unroll
        for (int i = 0; i < 3; ++i) { vlo[i] = vtr(GT_VF(t, i)); vhi[i] = vtr(GT_VF(t, i) + 512); }
        if (hasn) { asm volatile("s_nop 7" : "+v"(pN0), "+v"(pN1)); if (mk) GT_MASK(pN0, pN1); }
        GT_SBAR();
#pragma unroll
        for (int i = 0; i < 8; ++i) {
            if (i + 3 < 8) { vlo[i + 3] = vtr(GT_VF(t, i + 3)); vhi[i + 3] = vtr(GT_VF(t, i + 3) + 512); }
            const s8 vv = (s8){vlo[i][0], vlo[i][1], vlo[i][2], vlo[i][3], vhi[i][0], vhi[i][1], vhi[i][2], vhi[i][3]};
            o[i >> 2] = GT_MF(__builtin_bit_cast(h8, pw[i & 3]), __builtin_bit_cast(h8, vv), o[i >> 2]);
            if (hasn) {
                if (i == 0) { pa = max3f(pN0[0], pN0[1], pN1[0]); pb = max3f(pN0[2], pN0[3], pN1[1]); }
                else if (i == 1) { pa = max3f(pa, pN1[2], pN1[3]); pb = max3f(pb, pN0[6], pN0[7]); }
                else if (i == 2) { pa = max3f(pa, pN0[4], pN0[5]); pb = max3f(pb, pN1[6], pN1[7]); }
                else if (i == 3) { pa = max3f(pa, pN1[4], pN1[5]); pb = max3f(pb, pN0[10], pN0[11]); }
                else if (i == 4) { pa = max3f(pa, pN0[8], pN0[9]); pb = max3f(pb, pN1[10], pN1[11]); }
                else if (i == 5) { pa = max3f(pa, pN1[8], pN1[9]); pb = max3f(pb, pN0[14], pN0[15]); }
                else if (i == 6) { pa = max3f(pa, pN0[12], pN0[13]); pb = max3f(pb, pN1[14], pN1[15]); }
                else { pa = max3f(pa, pN1[12], pN1[13]); }
                GT_PIN(pa); GT_PIN(pb);
            }
            GT_SBAR();
        }
        if (hasn) { const float pm = swapmax(fmaxf(pa, pb)); GT_MOVE(pN0, pN1, pm); }
    };
    for (int t = 0; t < nt - 1; ++t) { gstep(pC0, pC1, pD0, pD1, t, T1{}, t + 2 == nt); pC0 = pD0; pC1 = pD1; }
    gstep(pC0, pC1, pD0, pD1, nt - 1, T0{}, false);
    if (hi == 0) { wsf[32 + r32] = 1.f / l_reg; wsf[64 + r32] = l_reg; wsf[r32] = -negm[0]; }
    int lane_e = lane; asm volatile("" : "+v"(lane_e));
    const int row8 = lane_e >> 3, ch = lane_e & 7, nsl = qb < 3 ? qb : 3;
    unsigned char* zbu = (unsigned char*)((_Float16*)(ws + WS_ZCAT) + 512 + ((size_t)b * SEQ + qw0) * 1024 + h * 64);
    h8 zz[4], po[4][3]; float2 ml[4][3];
#pragma unroll
    for (int k = 0; k < 4; ++k) { const int row = 8 * k + row8; const unsigned gr = (unsigned)(bh * 4096 + qw0 + row);
        zz[k] = *(const h8*)(zbu + (unsigned)(row * 1024 + ch * 8) * 2u);
#pragma unroll
        for (int s = 0; s < 3; ++s) if (s < nsl) { ml[k][s] = ((const float2*)(ws + WS_ML))[(unsigned)s * 524288u + gr]; po[k][s] = *(const h8*)(ws + opart_off(s) + gr * 128u + (unsigned)ch * 16u); } }
    asm volatile("s_waitcnt lgkmcnt(0)" ::: "memory");
    LAS _Float16* stg = (LAS _Float16*)(lds + G_ST) + wid * 512;
#pragma unroll
    for (int k = 0; k < 4; ++k) {
        typedef float f4e __attribute__((ext_vector_type(4)));
        const f4e rl4 = *(const LAS f4e*)(wsf + 32 + 8 * k + 4 * hi);
#pragma unroll
        for (int i = 0; i < 4; ++i) { stg[(4 * hi + i) * 64 + r32] = (_Float16)(o[0][4 * k + i] * rl4[i]); stg[(4 * hi + i) * 64 + 32 + r32] = (_Float16)(o[1][4 * k + i] * rl4[i]); }
        asm volatile("s_waitcnt lgkmcnt(0)" ::: "memory");
        const int row = 8 * k + row8; const h8 v = *(const LAS h8*)(stg + row8 * 64 + ch * 8);
        const float m_own = wsf[row], l_own = wsf[64 + row]; float M = m_own;
#pragma unroll
        for (int s = 0; s < 3; ++s) if (s < nsl) M = fmaxf(M, ml[k][s].x);
        const float w0 = l_own * __builtin_amdgcn_exp2f(m_own - M); float W = w0; float acc[8];
#pragma unroll
        for (int j = 0; j < 8; ++j) acc[j] = w0 * (float)v[j];
#pragma unroll
        for (int s = 0; s < 3; ++s) if (s < nsl) { const float w = ml[k][s].y * __builtin_amdgcn_exp2f(ml[k][s].x - M); W += w;
#pragma unroll
            for (int j = 0; j < 8; ++j) acc[j] = fmaf(w, (float)po[k][s][j], acc[j]); }
        const float rW = 1.f / W; h8 ov;
#pragma unroll
        for (int j = 0; j < 8; ++j) ov[j] = (_Float16)(acc[j] * rW * (float)zz[k][j]);
        if (!dry) *(h8*)(zbu + (unsigned)(row * 1024 + ch * 8) * 2u) = ov;
    }
#undef GT_SBAR
#undef GT_PIN
#undef GT_KF
#undef GT_VF
#undef GT_MF
#undef GT_MOVE
#undef GT_MASK
}

__device__ __forceinline__ void attn_phase(unsigned char* ws, LAS unsigned char* lds, int vb, int nvb) {
    const int vcu = (nvb % 8 == 0) ? (vb % 8) * (nvb / 8) + vb / 8 : vb; const int per = (1024 + nvb - 1) / nvb;
    for (int k = 0; k < per; ++k) {
        int it;
        if (nvb == 256) { const int xg = vcu >> 5, lw = vcu & 31; it = ((16 * xg + 4 * k + (lw >> 3)) << 3) | (lw & 7); }
        else { it = vcu * per + k; if (it >= 1024) break; }
        const int bh = it >> 3, pr = it & 7, b = bh >> 3, h = bh & 7;
        if (PROBE == 2) for (int uu = 0; uu < 2; ++uu) attn_unit<96, false, PROBE_ABL>(ws, b, h, uu ? 15 - pr : pr, lds, true);
        for (int uu = 0; uu < 2; ++uu) attn_unit<96, false>(ws, b, h, uu ? 15 - pr : pr, lds);
    }
    int nu = 0;
    for (int k = 0; k < per; ++k) { int it; if (nvb == 256) { const int xg = vcu >> 5, lw = vcu & 31; it = ((16 * xg + 4 * k + (lw >> 3)) << 3) | (lw & 7); } else { it = vcu * per + k; if (it >= 1024) break; } nu += 2; }
    auto unit_of = [&](int u, int& b, int& h, int& j) {
        const int k = u >> 1; int it; if (nvb == 256) { const int xg = vcu >> 5, lw = vcu & 31; it = ((16 * xg + 4 * k + (lw >> 3)) << 3) | (lw & 7); } else it = vcu * per + k;
        const int bh = it >> 3, pr = it & 7, rot = (bh >> 2) & 3; b = bh >> 3; h = bh & 7;
        const int sl = ((pr & 3) + rot) & 3; const int x = pr < 4 ? ((0x6170 >> (4 * sl)) & 15) : ((0x4352 >> (4 * sl)) & 15);
        j = (u & 1) ? 14 - x : x; return !((u & 1) && x == 7); };
    LAS unsigned* gc = (LAS unsigned*)(lds + G_CTL);
    int tid_g = threadIdx.x; asm volatile("" : "+v"(tid_g)); const int lane_g = tid_g & 63;
    for (int rep = 0; rep < (PROBE == 12 ? 2 : 1); ++rep)
    for (int u0 = 0; u0 < nu; u0 += 64) {
        const int nc = nu - u0 < 64 ? nu - u0 : 64;
        if (tid_g < 192) gc[tid_g] = 0u;
        { int b, h, j; if (unit_of(u0, b, h, j)) gather_dma(ws, b, h, j, lds, 0); if (nc > 1 && unit_of(u0 + 1, b, h, j)) gather_dma(ws, b, h, j, lds, 1); }
        asm volatile("s_waitcnt vmcnt(0)" ::: "memory"); __syncthreads();
        for (int uc = 0; uc < nc; ++uc) {
            int b, h, j; const bool ok = unit_of(u0 + uc, b, h, j);
            if (uc >= 2) while (((volatile LAS unsigned*)gc)[128 + uc] == 0u) __builtin_amdgcn_s_sleep(4);
            if (ok) gather_unit(ws, b, h, j, lds, uc & 1, gc + uc);
            unsigned n = 0u; if (lane_g == 0) n = __hip_atomic_fetch_add(gc + 64 + uc, 1u, __ATOMIC_RELAXED, __HIP_MEMORY_SCOPE_WORKGROUP);
            n = (unsigned)__builtin_amdgcn_readfirstlane((int)n) + 1u;
            if (n == 8u && uc + 2 < nc) { int b2, h2, j2;
                if (unit_of(u0 + uc + 2, b2, h2, j2)) { gather_dma_all(ws, b2, h2, j2, lds, uc & 1); asm volatile("s_waitcnt vmcnt(0)" ::: "memory"); }
                if (lane_g == 0) ((volatile LAS unsigned*)gc)[128 + uc + 2] = 1u; }
        }
        __syncthreads();
    }
}
template <bool DRY> __device__ __forceinline__ void attn_phase2_pass(unsigned char* ws, LAS unsigned char* lds, int vb, int nvb) {
    LAS unsigned* gc = (LAS unsigned*)(lds + G_CTL);
    int tid_g = threadIdx.x; asm volatile("" : "+v"(tid_g)); const int lane_g = tid_g & 63;
    const int nu = vb < 2048 ? (2048 - vb + nvb - 1) / nvb : 0;
    for (int u0 = 0; u0 < nu; u0 += 64) {
        const int nc = nu - u0 < 64 ? nu - u0 : 64;
        if (tid_g < 192) gc[tid_g] = 0u;
        { const int i0 = vb + u0 * nvb; gather_dma(ws, i0 >> 7, (i0 >> 4) & 7, i0 & 15, lds, 0); if (nc > 1) { const int i1 = i0 + nvb; gather_dma(ws, i1 >> 7, (i1 >> 4) & 7, i1 & 15, lds, 1); } }
        asm volatile("s_waitcnt vmcnt(0)" ::: "memory"); __syncthreads();
        for (int uc = 0; uc < nc; ++uc) {
            const int it = vb + (u0 + uc) * nvb;
            if (uc >= 2) while (((volatile LAS unsigned*)gc)[128 + uc] == 0u) __builtin_amdgcn_s_sleep(4);
            for (;;) { unsigned c = 0u; if (lane_g == 0) c = __hip_atomic_fetch_add(gc + uc, 1u, __ATOMIC_RELAXED, __HIP_MEMORY_SCOPE_WORKGROUP);
                c = (unsigned)__builtin_amdgcn_readfirstlane((int)c); if (c >= 8u) break;
                own_unit(ws, it >> 7, (it >> 4) & 7, it & 15, lds, uc & 1, DRY, 7 - (int)c); }
            unsigned n = 0u; if (lane_g == 0) n = __hip_atomic_fetch_add(gc + 64 + uc, 1u, __ATOMIC_RELAXED, __HIP_MEMORY_SCOPE_WORKGROUP);
            n = (unsigned)__builtin_amdgcn_readfirstlane((int)n) + 1u;
            if (n == 8u && uc + 2 < nc) { const int i2 = it + 2 * nvb; gather_dma_all(ws, i2 >> 7, (i2 >> 4) & 7, i2 & 15, lds, uc & 1); asm volatile("s_waitcnt vmcnt(0)" ::: "memory");
                if (lane_g == 0) ((volatile LAS unsigned*)gc)[128 + uc + 2] = 1u; }
        }
        __syncthreads();
    }
}
__device__ __forceinline__ void attn_phase2(unsigned char* ws, LAS unsigned char* lds, int vb, int nvb) {
    if (PROBE == 13) attn_phase2_pass<true>(ws, lds, vb, nvb);
    attn_phase2_pass<false>(ws, lds, vb, nvb);
}
}

constexpr int RING_BYTES = 131072, MISC_OFF = RING_BYTES + 320, LDS_BYTES = 147456;
constexpr int CW_BAR = 4096;

__global__ void __launch_bounds__(512, 2) mega(Params p) {
    extern __shared__ __attribute__((aligned(16))) unsigned char lds[];
    const int vb = blockIdx.x, nvb = gridDim.x, tid = threadIdx.x, lane = tid & 63, wave = tid >> 6;
    const int gtid = vb * 512 + tid, gsize = nvb * 512, gwave = vb * 8 + wave, nwaves = nvb * 8;
    volatile LAS unsigned* misc = (volatile LAS unsigned*)((LAS unsigned char*)lds + MISC_OFF);
    if (tid < 32) misc[tid] = 0u;
    __syncthreads();
    XcdBarrier bar = xcd_barrier_post((unsigned*)(p.ws + WS_CTL) + CW_BAR, misc + 8);
    LAS unsigned char* ldsl = (LAS unsigned char*)lds;
    { int t_ = threadIdx.x; asm volatile("" : "+v"(t_)); ph_prep(p, vb * 512 + t_, gsize, vb, nvb, ldsl); ph_weights(p, ldsl, vb * 8 + (t_ >> 6), nwaves, t_ >> 6, t_ & 63);
      if (PROBE == 10) ph_weights(p, ldsl, vb * 8 + (t_ >> 6), nwaves, t_ >> 6, t_ & 63);
      if (PROBE == 11) ph_tab(p, vb * 512 + t_, gsize); }
    xcd_barrier(bar);
    for (int rep4 = 0; rep4 < ((PROBE == 4 || PROBE == 6) ? 2 : 1); ++rep4) { int t_ = threadIdx.x; asm volatile("" : "+v"(t_)); ph_hnorm(p, vb * 8 + (t_ >> 6), nwaves, t_ & 63); }
    xcd_barrier(bar);
    {
        pg8::Gemm g{(const pg8::bf16_t*)(p.ws + WS_H), (const pg8::bf16_t*)(p.ws + WT_IN), M_, 5120, 1024}; pg8::StaticOrder S; S.init(M_, 5120, nvb, vb);
        for (int rep = (PROBE == 1 ? 1 : 0); rep >= 0; --rep) { pg8::EpiInF E{p.ws, p.b_merge, rep}; pg8::gemm_phase<pg8::EpiInF, pg8::StaticOrder, true, true>(ldsl, g, S, E); }
        if (PROBE == 5) { pg8::EpiNull E; pg8::gemm_phase<pg8::EpiNull, pg8::StaticOrder, true, true>(ldsl, g, S, E); }
    }
    xcd_barrier(bar);
    { int t_ = threadIdx.x; asm volatile("" : "+v"(t_)); att::ph_gate(p.ws, vb * 8 + (t_ >> 6), nwaves, t_ & 63); }
    for (int rep4 = 0; rep4 < ((PROBE == 4 || PROBE == 7) ? 2 : 1); ++rep4) {
        pg8::Gemm g{(const pg8::bf16_t*)(p.ws + WS_QLAT), (const pg8::bf16_t*)(p.ws + WT_UQ), M_, 768, 256}; pg8::StaticOrder S; S.init(M_, 768, nvb, vb);
        pg8::EpiUqF E{p.ws}; pg8::gemm_phase<pg8::EpiUqF, pg8::StaticOrder, true, true>(ldsl, g, S, E);
    }
    for (int rep4 = 0; rep4 < ((PROBE == 4 || PROBE == 7) ? 2 : 1); ++rep4) {
        pg8::Gemm g{(const pg8::bf16_t*)(p.ws + WS_KVL), (const pg8::bf16_t*)(p.ws + WT_UKV), M_, 1024, 128};     pg8::StaticOrder S; S.init(M_, 1024, nvb, vb);
        pg8::EpiUkvF E{p.ws}; pg8::gemm_phase<pg8::EpiUkvF, pg8::StaticOrder, true, true>(ldsl, g, S, E);
    }
    xcd_barrier(bar);
    att::attn_phase(p.ws, ldsl, vb, nvb);
    xcd_barrier(bar);
    att::attn_phase2(p.ws, ldsl, vb, nvb);
    xcd_barrier(bar);
    {
        pg8::Gemm g{(const pg8::bf16_t*)(p.ws + WS_ZCAT), (const pg8::bf16_t*)(p.ws + WT_OA), M_, 1024, 1024}; pg8::StaticOrder S; S.init(M_, 1024, nvb, vb);
        pg8::EpiYcatF E{p.ws}; pg8::gemm_phase<pg8::EpiYcatF, pg8::StaticOrder, true, true>(ldsl, g, S, E);
    }
    xcd_barrier(bar);
    for (int rep4 = 0; rep4 < ((PROBE == 4 || PROBE == 9) ? 2 : 1); ++rep4) {
        pg8::Gemm g{(const pg8::bf16_t*)(p.ws + WS_YM), (const pg8::bf16_t*)(p.ws + WT_OUT), M_, 1024, 1024}; pg8::StaticOrder S; S.init(M_, 1024, nvb, vb);
        pg8::EpiYF E{p.ws}; pg8::gemm_phase<pg8::EpiYF, pg8::StaticOrder, true, true>(ldsl, g, S, E);
    }
    xcd_barrier(bar);
    for (int rep4 = 0; rep4 < ((PROBE == 4 || PROBE == 9) ? 2 : 1); ++rep4) { int t_ = threadIdx.x; asm volatile("" : "+v"(t_)); ph_final(p, vb * 8 + (t_ >> 6), nwaves, t_ & 63); }
}

extern "C" void kernel_launch(void* const* d_in, const int* in_sizes, int n_in, void* d_out, int out_size, void* d_ws, size_t ws_size, hipStream_t stream) {
    if (n_in != 16 || out_size != M_ * DM || ws_size < WS_END) { fprintf(stderr, "kernel_launch: unexpected shapes (n_in %d, out %d, ws %zu)\n", n_in, out_size, ws_size); return; }
    Params p{};
    p.x = (const float*)d_in[0]; p.c = (const float*)d_in[1]; p.pos = (const int*)d_in[2]; p.w_ada = (const float*)d_in[3]; p.b_ada = (const float*)d_in[4];
    p.g_pre = (const float*)d_in[5]; p.g_post = (const float*)d_in[6]; p.w_in = (const float*)d_in[7]; p.g_q = (const float*)d_in[8]; p.w_uq = (const float*)d_in[9];
    p.g_kv = (const float*)d_in[10]; p.w_ukv = (const float*)d_in[11]; p.w_o_mla = (const float*)d_in[12]; p.w_o_moba = (const float*)d_in[13]; p.b_merge = (const float*)d_in[14]; p.w_out = (const float*)d_in[15];
    p.out = (float*)d_out; p.ws = (unsigned char*)d_ws;
    static int grid = 0;
    if (grid == 0) {
        int dev = 0, cus = 0, per_cu = 0;
        if (hipGetDevice(&dev) != hipSuccess || hipDeviceGetAttribute(&cus, hipDeviceAttributeMultiprocessorCount, dev) != hipSuccess) { fprintf(stderr, "kernel_launch: device query failed\n"); grid = -1; return; }
        if (hipFuncSetAttribute((const void*)mega, hipFuncAttributeMaxDynamicSharedMemorySize, LDS_BYTES) != hipSuccess) { fprintf(stderr, "kernel_launch: hipFuncSetAttribute failed\n"); grid = -1; return; }
        if (hipOccupancyMaxActiveBlocksPerMultiprocessor(&per_cu, (const void*)mega, 512, LDS_BYTES) != hipSuccess || per_cu < 1) { fprintf(stderr, "kernel_launch: occupancy query says %d\n", per_cu); }
        (void)hipGetLastError();
        grid = cus;
    }
    if (grid < 0) return;
    (void)hipMemsetAsync(d_ws, 0, ZERO_BYTES, stream);
    hipLaunchKernelGGL(mega, dim3(grid), dim3(512), LDS_BYTES, stream, p);
}
```

```cpp
#include <hip/hip_runtime.h>
#include <cstdio>
#ifndef PROBE
#define PROBE 0
#endif
#include <cstdint>

typedef _Float16 h16;
typedef _Float16 h16x4 __attribute__((ext_vector_type(4)));
typedef _Float16 h2n __attribute__((ext_vector_type(2)));

constexpr int NB = 16, SEQ = 4096, DM = 1024, M_ = NB * SEQ, NH = 8;
constexpr int D_IN = 5024;
constexpr int C_QLAT = 0, C_KVLAT = 256, C_KROPE = 384, C_ZMLA = 416, C_QMB = 928, C_KMB = 1440, C_VMB = 1952, C_ZMB = 2464, C_GA = 2976, C_GB = 4000;
constexpr float EPS = 1e-6f;
constexpr float LOG2E = 1.4426950408889634f;
constexpr float SC_MLA = 0.10206207261596577f * LOG2E;
constexpr float SC_MB = 0.125f * LOG2E;
__host__ __device__ constexpr int tile_perm(int pn) { return pn >= 12 ? pn : (int)((0x8128290e65a862ull >> (5 * pn)) & 31ull); }

constexpr size_t MiB = 1u << 20;
constexpr size_t WS_CTL = 0, WS_KMEAN = 512 * 1024, WS_SSQ = 1 * MiB, WS_SSQY = WS_SSQ + 2 * (size_t)M_ * 4, ZERO_BYTES = 2 * MiB;
constexpr size_t WS_MOD = WS_SSQ + 3 * (size_t)M_ * 4, WS_TAB = 4 * MiB, WS_WT = 20 * MiB;
constexpr size_t WS_H = 36 * MiB, WS_KN = 36 * MiB, WS_VM = 100 * MiB;
constexpr size_t WS_QLAT = 164 * MiB, WS_KVL = 196 * MiB, WS_KPE = 228 * MiB, WS_VMB = 232 * MiB;
constexpr size_t WS_QMB = 296 * MiB, WS_KMB = 360 * MiB, WS_ZCAT = 424 * MiB, WS_YM = 296 * MiB;
constexpr size_t WS_GA = 552 * MiB, WS_GB = 616 * MiB, WS_Y = 680 * MiB,     WS_QMLA = 808 * MiB, WS_LIST = 904 * MiB, WS_ML = 920 * MiB, WS_END = 936 * MiB;
constexpr size_t WS_CNT = 64 * 1024;
__device__ __forceinline__ unsigned opart_off(int slot) { return slot < 2 ? (unsigned)(WS_Y + (size_t)slot * 64 * MiB) : (unsigned)WS_QLAT; }

static_assert(WS_MOD + (size_t)NB * 3072 * 4 <= ZERO_BYTES, "MOD inside the zeroed region");
struct Params {
    const float *x, *c; const int* pos; const float *w_ada, *b_ada, *g_pre, *g_post, *w_in, *g_q, *w_uq, *g_kv, *w_ukv, *w_o_mla, *w_o_moba, *b_merge, *w_out;
    float* out; unsigned char* ws;
};

__device__ __forceinline__ float wave_sum(float v) {
#pragma unroll
    for (int o = 1; o < 64; o <<= 1) v += __shfl_xor(v, o);
    return v;
}
__device__ __forceinline__ float silu_f(float v) { return v / (1.f + __expf(-v)); }
__device__ __forceinline__ float sigmoid_f(float v) { return 1.f / (1.f + __expf(-v)); }

#define LAS __attribute__((address_space(3)))
__device__ void ph_tab(const Params& p, int gtid, int gsize);
__device__ void ph_prep(const Params& p, int gtid, int gsize, int vb, int nvb, LAS unsigned char* lds) {
    float* mod = (float*)(p.ws + WS_MOD);
    { const int tid = gtid - vb * 512; LAS float* sc = (LAS float*)lds; LAS float* part = (LAS float*)(lds + 65536);
      for (int i = tid; i < NB * DM; i += 512) { const float cv = p.c[i]; sc[i] = cv / (1.f + __expf(-cv)); }
      __syncthreads();
      for (int cg = vb; cg < 3072 / 12; cg += nvb) {
          if (tid < 384) { const int col = tid % 12, kc = tid / 12, j = cg * 12 + col, k0 = kc * 32;
              float w[32], acc[NB];
#pragma unroll
              for (int kk = 0; kk < 32; ++kk) w[kk] = p.w_ada[(size_t)(k0 + kk) * 3072 + j];
#pragma unroll
              for (int b = 0; b < NB; ++b) acc[b] = 0.f;
#pragma unroll
              for (int kk = 0; kk < 32; kk += 4) {
#pragma unroll
                  for (int b = 0; b < NB; ++b) { typedef float f4m __attribute__((ext_vector_type(4))); const f4m s4 = *(const LAS f4m*)(sc + b * DM + k0 + kk);
                      acc[b] = fmaf(s4.x, w[kk], acc[b]); acc[b] = fmaf(s4.y, w[kk + 1], acc[b]); acc[b] = fmaf(s4.z, w[kk + 2], acc[b]); acc[b] = fmaf(s4.w, w[kk + 3], acc[b]); } }
#pragma unroll
              for (int b = 0; b < NB; ++b) part[(kc * NB + b) * 12 + col] = acc[b]; }
          __syncthreads();
          if (tid < NB * 12) { const int b = tid / 12, c = tid % 12, j = cg * 12 + c; float s = p.b_ada[j];
#pragma unroll
              for (int kc = 0; kc < 32; ++kc) s += part[(kc * NB + b) * 12 + c];
              mod[b * 3072 + j] = s; }
          __syncthreads();
      } }
    ph_tab(p, gtid, gsize);
}
__device__ void ph_tab(const Params& p, int gtid, int gsize) {
    unsigned* tab = (unsigned*)(p.ws + WS_TAB);
    const int f = gtid & 31;
    const double c = exp2(-(double)f * (13.287712379549449 / 32.0)) * 0.15915494309189535;
    int ex; const double mant = frexp(c, &ex); const double c_hi_d = ldexp(rint(ldexp(mant, 11)), ex - 11);
    const float c_hi = (float)c_hi_d, c_lo = (float)(c - c_hi_d);
    for (int i = gtid; i < M_ * 32; i += gsize) {
        const float pos = (float)p.pos[i >> 5];
        float x = pos * c_hi; x = x - floorf(x); x = fmaf(pos, c_lo, x);
        typedef _Float16 h2t __attribute__((ext_vector_type(2))); h2t cs; cs[0] = (_Float16)__builtin_amdgcn_cosf(x); cs[1] = (_Float16)__builtin_amdgcn_sinf(x);
        tab[i] = __builtin_bit_cast(unsigned, cs);
    }
}

__device__ void ph_hnorm(const Params& p, int gwave, int nwaves, int lane) {
    constexpr int R = 4;
    typedef float f4 __attribute__((ext_vector_type(4)));
    const float* mod = (const float*)(p.ws + WS_MOD); h16* H = (h16*)(p.ws + WS_H);
    for (int m0 = R * gwave; m0 < M_; m0 += R * nwaves) {
        f4 v[R][4]; float ss[R];
#pragma unroll
        for (int r = 0; r < R; ++r) { const f4* xr = (const f4*)(p.x + (size_t)(m0 + r) * DM);
#pragma unroll
            for (int j = 0; j < 4; ++j) v[r][j] = __builtin_nontemporal_load(xr + lane + 64 * j); }
#pragma unroll
        for (int r = 0; r < R; ++r) { float s = 0.f;
#pragma unroll
            for (int j = 0; j < 4; ++j) s += (v[r][j][0] * v[r][j][0] + v[r][j][1] * v[r][j][1]) + (v[r][j][2] * v[r][j][2] + v[r][j][3] * v[r][j][3]);
            ss[r] = 1.f / sqrtf(wave_sum(s) * (1.f / DM) + EPS); }
        const int b = m0 >> 12;
#pragma unroll
        for (int j = 0; j < 4; ++j) {
            const int col = 4 * (lane + 64 * j);
            const float4 g = *(const float4*)(p.g_pre + col), sc = *(const float4*)(mod + b * 3072 + 1024 + col), sh = *(const float4*)(mod + b * 3072 + col);
            const float g0 = g.x * (1.f + sc.x), g1 = g.y * (1.f + sc.y), g2 = g.z * (1.f + sc.z), g3 = g.w * (1.f + sc.w);
#pragma unroll
            for (int r = 0; r < R; ++r) { const float rstd = ss[r]; const f4 x = v[r][j];
                h16x4 o; o[0] = (h16)(x[0] * rstd * g0 + sh.x); o[1] = (h16)(x[1] * rstd * g1 + sh.y); o[2] = (h16)(x[2] * rstd * g2 + sh.z); o[3] = (h16)(x[3] * rstd * g3 + sh.w);
                *(h16x4*)(H + (size_t)(m0 + r) * DM + col) = o; }
        }
    }
}

__device__ void ph_final(const Params& p, int gwave, int nwaves, int lane) {
    constexpr int R = 4; typedef float f4 __attribute__((ext_vector_type(4)));
    const float* mod = (const float*)(p.ws + WS_MOD); const h16* Y = (const h16*)(p.ws + WS_Y); const float* ssq = (const float*)(p.ws + WS_SSQY);
    for (int m0 = R * gwave; m0 < M_; m0 += R * nwaves) {
        const int b = m0 >> 12; h16x4 yv[R][4]; f4 xv[R][4]; float rs[R];
#pragma unroll
        for (int r = 0; r < R; ++r) { const h16x4* yr = (const h16x4*)(Y + (size_t)(m0 + r) * DM); const f4* xr = (const f4*)(p.x + (size_t)(m0 + r) * DM); rs[r] = ssq[m0 + r];
#pragma unroll
            for (int j = 0; j < 4; ++j) { yv[r][j] = yr[lane + 64 * j]; xv[r][j] = __builtin_nontemporal_load(xr + lane + 64 * j); } }
#pragma unroll
        for (int r = 0; r < R; ++r) rs[r] = 1.f / sqrtf(rs[r] * (1.f / DM) + EPS);
#pragma unroll
        for (int j = 0; j < 4; ++j) {
            const int col = 4 * (lane + 64 * j); const float4 g = *(const float4*)(p.g_post + col), gt = *(const float4*)(mod + b * 3072 + 2048 + col);
            const float g0 = g.x * gt.x, g1 = g.y * gt.y, g2 = g.z * gt.z, g3 = g.w * gt.w;
#pragma unroll
            for (int r = 0; r < R; ++r) { const h16x4 y = yv[r][j]; const f4 x = xv[r][j]; const float s = rs[r];
                f4 o; o[0] = x[0] + g0 * (float)y[0] * s; o[1] = x[1] + g1 * (float)y[1] * s; o[2] = x[2] + g2 * (float)y[2] * s; o[3] = x[3] + g3 * (float)y[3] * s;
                __builtin_nontemporal_store(o, (f4*)(p.out + (size_t)(m0 + r) * DM) + lane + 64 * j); }
        }
    }
}


#define XB_TMO      128
#define XB_XCNT(j)  (256  + 64 * (j))
#define XB_XSUB(j)  (1280 + 64 * (j))
#define XB_XGEN(j)  (2304 + 64 * (j))
#define XB_TOP      3328
#define XB_TOPGEN   3392
#define XCD_BAR_WORDS 3456
#define XB_SPIN_CAP (1u << 27)
__device__ __forceinline__ unsigned xb_ld(unsigned* p)              { return __hip_atomic_load(p, __ATOMIC_RELAXED, __HIP_MEMORY_SCOPE_AGENT); }
__device__ __forceinline__ unsigned xb_add(unsigned* p, unsigned v) { return __hip_atomic_fetch_add(p, v, __ATOMIC_RELAXED, __HIP_MEMORY_SCOPE_AGENT); }
__device__ __forceinline__ unsigned xb_xcc_id() { return (unsigned)__builtin_amdgcn_s_getreg((3 << 11) | 20) & 0xFu; }
#define XB_SPIN(cond, bar) do { unsigned _sp = 0; while (cond) { __builtin_amdgcn_s_sleep(1); \
    if ((++_sp & 255u) == 0u) { if (xb_ld(&(bar)[XB_TMO])) break; if (_sp > XB_SPIN_CAP) { atomicAdd(&(bar)[XB_TMO], 1u); break; } } } } while (0)
struct XcdBarrier { unsigned* bar; unsigned x; volatile LAS unsigned* st; };
__device__ __forceinline__ XcdBarrier xcd_barrier_post(unsigned* bar, volatile LAS unsigned* st) {
    XcdBarrier b; b.bar = bar; b.x = xb_xcc_id(); b.st = st;
    if (threadIdx.x == 0) (void)xb_add(&bar[XB_XCNT(b.x)], 1u);
    return b;
}
__device__ __forceinline__ void xcd_barrier_complete(unsigned* bar, unsigned x, unsigned& nloc, unsigned& nx) {
    const unsigned G = gridDim.x * gridDim.y * gridDim.z;
    unsigned sum, cnt, mine, sp = 0u;
    for (;;) {
        sum = 0u; cnt = 0u; mine = 0u;
#pragma unroll
        for (unsigned j = 0; j < 16; ++j) { const unsigned c = xb_ld(&bar[XB_XCNT(j)]); sum += c; cnt += (c > 0u) ? 1u : 0u; mine = (j == x) ? c : mine; }
        if (sum == G) break;
        __builtin_amdgcn_s_sleep(1);
        if ((++sp & 255u) == 0u) { if (xb_ld(&bar[XB_TMO])) break; if (sp > XB_SPIN_CAP) { atomicAdd(&bar[XB_TMO], 1u); break; } }
    }
    nloc = mine > 0u ? mine : 1u; nx = cnt > 0u ? cnt : 1u;
}
__device__ __forceinline__ void xcd_barrier(const XcdBarrier& b) {
    asm volatile("s_waitcnt vmcnt(0)" ::: "memory");
    __syncthreads();
    if (threadIdx.x == 0) {
        unsigned* bar = b.bar;
        __builtin_amdgcn_s_waitcnt(0);
        unsigned nloc = b.st[0], nx = b.st[1];
        if (nloc == 0u) { xcd_barrier_complete(bar, b.x, nloc, nx); b.st[0] = nloc; b.st[1] = nx; }
        const unsigned old = xb_add(&bar[XB_XSUB(b.x)], 1u);
        const unsigned gen = old / nloc;
        if (old + 1u == (gen + 1u) * nloc) {
            __builtin_amdgcn_fence(__ATOMIC_RELEASE, "agent");
            asm volatile("s_waitcnt vmcnt(0)" ::: "memory");
            const unsigned og = xb_add(&bar[XB_TOP], 1u);
            const unsigned tg = og / nx;
            if (og + 1u == (tg + 1u) * nx) xb_add(&bar[XB_TOPGEN], 1u);
            else XB_SPIN(xb_ld(&bar[XB_TOPGEN]) == tg, bar);
            __builtin_amdgcn_fence(__ATOMIC_ACQUIRE, "agent");
            xb_add(&bar[XB_XGEN(b.x)], 1u);
            asm volatile("s_waitcnt vmcnt(0)" ::: "memory");
        } else {
            XB_SPIN(xb_ld(&bar[XB_XGEN(b.x)]) == gen, bar);
            __builtin_amdgcn_fence(__ATOMIC_ACQUIRE, "agent");
            asm volatile("s_waitcnt vmcnt(0)" ::: "memory");
        }
    }
    __syncthreads();
}

namespace pg8 {
#define PG8_LAS __attribute__((address_space(3)))
typedef unsigned short bf16_t;
typedef _Float16 bf16x8 __attribute__((ext_vector_type(8)));
typedef float f32x4 __attribute__((ext_vector_type(4)));
typedef unsigned u32x4 __attribute__((ext_vector_type(4)));
constexpr int BM = 256, BK = 64, HALF = 128, HTB = HALF * BK * 2  , STAGE_BYTES = 8 * HTB, NXCD = 8, WGM = 8;

__host__ __device__ __forceinline__ int lds_byte(int r, int c) { const int st = (r >> 4) * 2 + (c >> 5), rr = r & 15, cc = c & 31, ob = rr * 64 + cc * 2; return st * 1024 + (ob ^ (((ob >> 9) & 1) << 5)); }
__host__ __device__ __forceinline__ void stage_rc(int b, int& R, int& C) { const int st = b / 1024, sb = b % 1024, swz = sb ^ (((sb >> 9) & 1) << 5); R = (st >> 1) * 16 + swz / 64; C = (st & 1) * 32 + (swz % 64) / 2; }
__host__ __device__ __forceinline__ int perm32(int rho) { const int n = rho >> 4, i = rho & 15; return 8 * (i >> 2) + 4 * n + (i & 3); }

struct Unit { int pm, pn; };
struct Gemm { const bf16_t* A; const bf16_t* Bt; int M, N, K; };

struct StaticOrder {
    int nM, nN, nwg, G, c;
    __host__ __device__ void init(int M, int N, int G_, int c_) { nM = M / BM; nN = N / BM; nwg = nM * nN; G = G_; c = c_; }
    __host__ __device__ bool next(int i, Unit& u) const {
        const long L = (long)i * G + c; if (L >= nwg) return false;
        int wgid = (int)L; { const int q = nwg / NXCD, r = nwg % NXCD, xcd = wgid % NXCD, off = wgid / NXCD; wgid = (xcd < r ? xcd * (q + 1) : r * (q + 1) + (xcd - r) * q) + off; }
        const int nig = WGM * nN, gid = wgid / nig, fm = gid * WGM, gsz = (nM - fm) < WGM ? (nM - fm) : WGM;
        u.pm = fm + ((wgid % nig) % gsz); u.pn = (wgid % nig) / gsz; return true;
    }
    __device__ __forceinline__ void a_ready(const Unit&) const {}
    __device__ __forceinline__ void done(const Unit&) const {}
};

template <class Epi, class Sched, bool ALIGN_EPI = false, bool SP2 = false>
__device__ __forceinline__ void gemm_phase(PG8_LAS unsigned char* lds, const Gemm g, const Sched& S, const Epi& E) {
    int tid_ = threadIdx.x; asm volatile("" : "+v"(tid_));
    const int tid = tid_, wid = __builtin_amdgcn_readfirstlane(tid >> 6), lane = tid & 63, wr = wid >> 2, wc = wid & 3, fr = lane & 15, fq = lane >> 4;
    const int K = g.K, nt = K / BK;
    unsigned voffA[2], voffB[2];
#pragma unroll
    for (int i = 0; i < 2; ++i) { int R, C; stage_rc(tid * 16 + i * 8192, R, C); const int Rb = Epi::PERM ? ((R & ~31) + perm32(R & 31)) : R;
        voffA[i] = (unsigned)(R * K + C) * 2u; voffB[i] = (unsigned)(Rb * K + C) * 2u; }
    const size_t kstep = (size_t)(BK * 2);
    const size_t hstep = (size_t)HALF * K * 2;
    const size_t tstep = 2 * hstep;
    const unsigned ldsw = (unsigned)wid * 1024u;
    const int aoff = lds_byte(wr * 64 + fr, fq * 8), boff = lds_byte(wc * 32 + fr, fq * 8);
#define PG8_SA(b, h) (((b) * 2 + (h)) * HTB)
#define PG8_SB(b, h) ((4 + (b) * 2 + (h)) * HTB)
#define PG8_STAGE(bufoff, gbase, voff) do { _Pragma("unroll") for (int _i = 0; _i < 2; ++_i) \
        __builtin_amdgcn_global_load_lds((const unsigned*)((const char*)(gbase) + (voff)[_i]), (PG8_LAS unsigned*)(lds + (bufoff) + ldsw + _i * 8192), 16, 0, 0); } while (0)
#define PG8_LDA(dst, b, h) do { _Pragma("unroll") for (int m = 0; m < 4; ++m) _Pragma("unroll") for (int k = 0; k < 2; ++k) dst[m][k] = *(const PG8_LAS bf16x8*)(lds + PG8_SA(b, h) + aoff + m * 2048 + k * 1024); } while (0)
#define PG8_LDB(dst, b, h) do { _Pragma("unroll") for (int n = 0; n < 2; ++n) _Pragma("unroll") for (int k = 0; k < 2; ++k) dst[n][k] = *(const PG8_LAS bf16x8*)(lds + PG8_SB(b, h) + boff + n * 2048 + k * 1024); } while (0)
#define PG8_MMA(ai, bj, At, Bt) do { __builtin_amdgcn_s_setprio(1); _Pragma("unroll") for (int m = 0; m < 4; ++m) _Pragma("unroll") for (int n = 0; n < 2; ++n) _Pragma("unroll") for (int k = 0; k < 2; ++k) \
        acc[ai][bj][m][n] = __builtin_amdgcn_mfma_f32_16x16x32_f16(Bt[n][k], At[m][k], acc[ai][bj][m][n], 0, 0, 0); __builtin_amdgcn_s_setprio(0); } while (0)
#define PG8_WAIT_V(n) asm volatile("s_waitcnt vmcnt(" #n ")" ::: "memory")
#define PG8_WAIT_L(n) asm volatile("s_waitcnt lgkmcnt(" #n ")" ::: "memory")
#define PG8_BAR __builtin_amdgcn_s_barrier()
#define PG8_SCHED __builtin_amdgcn_sched_barrier(0)
    Unit cur, nxt; int ui = 0;
    if (!S.next(0, cur)) return;
    f32x4 acc[2][2][4][2];
#pragma unroll
    for (int a = 0; a < 2; ++a)
#pragma unroll
        for (int b = 0; b < 2; ++b)
#pragma unroll
            for (int m = 0; m < 4; ++m)
#pragma unroll
                for (int n = 0; n < 2; ++n) acc[a][b][m][n] = (f32x4){0.f, 0.f, 0.f, 0.f};
    bf16x8 At[4][2], B0[2][2], B1[2][2];
    const char* cA = (const char*)g.A + (size_t)cur.pm * tstep; const char* cB = (const char*)g.Bt + (size_t)cur.pn * tstep;
    S.a_ready(cur);
    if constexpr (SP2) {
        PG8_STAGE(PG8_SB(0, 0), cB, voffB); PG8_STAGE(PG8_SB(0, 1), cB + hstep, voffB); PG8_STAGE(PG8_SA(0, 0), cA, voffA); PG8_STAGE(PG8_SA(0, 1), cA + hstep, voffA);
        if (wr == 1) PG8_BAR;
        PG8_WAIT_V(2); PG8_BAR;
        PG8_STAGE(PG8_SB(1, 0), cB + kstep, voffB); PG8_STAGE(PG8_SA(1, 0), cA + kstep, voffA); PG8_STAGE(PG8_SB(1, 1), cB + hstep + kstep, voffB);
        PG8_WAIT_V(6); PG8_BAR;
    } else {
        PG8_STAGE(PG8_SB(0, 0), cB, voffB); PG8_STAGE(PG8_SA(0, 0), cA, voffA); PG8_STAGE(PG8_SB(0, 1), cB + hstep, voffB); PG8_STAGE(PG8_SA(0, 1), cA + hstep, voffA);
        if (wr == 1) PG8_BAR;
        PG8_WAIT_V(4); PG8_BAR;
        PG8_STAGE(PG8_SB(1, 0), cB + kstep, voffB); PG8_STAGE(PG8_SA(1, 0), cA + kstep, voffA); PG8_STAGE(PG8_SB(1, 1), cB + hstep + kstep, voffB);
        PG8_WAIT_V(6); PG8_BAR;
    }
    for (;;) {
        const bool has_next = S.next(ui + 1, nxt);
        const char* nA = has_next ? (const char*)g.A + (size_t)nxt.pm * tstep : cA; const char* nB = has_next ? (const char*)g.Bt + (size_t)nxt.pn * tstep : cB;
#pragma nounroll
        for (int t = 0; t < nt; t += 2) {
            const bool last = (t == nt - 2);
            if constexpr (Epi::MID_T > 0) { if (t == Epi::MID_T) E.mid(acc, cur, wr, wc); }
            const char* a1 = cA + (size_t)(t + 1) * kstep;
            const char* a2 = last ? nA : cA + (size_t)(t + 2) * kstep; const char* b2 = last ? nB : cB + (size_t)(t + 2) * kstep;
            const char* a3 = a2 + kstep; const char* b3 = b2 + kstep;
            if (last && has_next) S.a_ready(nxt);
            if constexpr (SP2) {
            PG8_LDB(B0, 0, 0); PG8_LDB(B1, 0, 1); PG8_SCHED; PG8_LDA(At, 0, 0); PG8_STAGE(PG8_SA(1, 1), a1 + hstep, voffA);
            PG8_WAIT_V(8); PG8_WAIT_L(0); PG8_BAR; PG8_MMA(0, 0, At, B0); PG8_MMA(0, 1, At, B1); PG8_BAR; PG8_SCHED;
            PG8_LDA(At, 0, 1); PG8_STAGE(PG8_SB(0, 0), b2, voffB); PG8_STAGE(PG8_SB(0, 1), b2 + hstep, voffB); PG8_STAGE(PG8_SA(0, 0), a2, voffA);
            PG8_WAIT_V(8); PG8_WAIT_L(0); PG8_BAR; PG8_MMA(1, 0, At, B0); PG8_MMA(1, 1, At, B1); PG8_BAR; PG8_SCHED;
            PG8_LDB(B0, 1, 0); PG8_LDB(B1, 1, 1); PG8_SCHED; PG8_LDA(At, 1, 0); PG8_STAGE(PG8_SA(0, 1), a2 + hstep, voffA);
            PG8_WAIT_V(8); PG8_WAIT_L(0); PG8_BAR; PG8_MMA(0, 0, At, B0); PG8_MMA(0, 1, At, B1); PG8_BAR; PG8_SCHED;
            PG8_LDA(At, 1, 1); PG8_STAGE(PG8_SB(1, 0), b3, voffB); PG8_STAGE(PG8_SB(1, 1), b3 + hstep, voffB); PG8_STAGE(PG8_SA(1, 0), a3, voffA);
            PG8_WAIT_V(8); PG8_WAIT_L(0); PG8_BAR; PG8_MMA(1, 0, At, B0); PG8_MMA(1, 1, At, B1); PG8_BAR; PG8_SCHED;
            } else {
            PG8_LDB(B0, 0, 0); PG8_SCHED; PG8_LDA(At, 0, 0); PG8_STAGE(PG8_SA(1, 1), a1 + hstep, voffA);
            PG8_WAIT_L(8); PG8_BAR; PG8_WAIT_L(0); PG8_MMA(0, 0, At, B0); PG8_BAR; PG8_SCHED;
            PG8_LDB(B1, 0, 1); PG8_STAGE(PG8_SB(0, 0), b2, voffB);
            PG8_BAR; PG8_WAIT_L(0); PG8_MMA(0, 1, At, B1); PG8_BAR;
            PG8_LDA(At, 0, 1); PG8_STAGE(PG8_SA(0, 0), a2, voffA);
            PG8_BAR; PG8_WAIT_L(0); PG8_MMA(1, 0, At, B0); PG8_BAR; PG8_SCHED;
            PG8_STAGE(PG8_SB(0, 1), b2 + hstep, voffB);
            PG8_WAIT_V(6); PG8_BAR; PG8_MMA(1, 1, At, B1); PG8_BAR;
            PG8_LDB(B0, 1, 0); PG8_SCHED; PG8_LDA(At, 1, 0); PG8_STAGE(PG8_SA(0, 1), a2 + hstep, voffA);
            PG8_WAIT_L(8); PG8_BAR; PG8_WAIT_L(0); PG8_MMA(0, 0, At, B0); PG8_BAR; PG8_SCHED;
            PG8_LDB(B1, 1, 1); PG8_STAGE(PG8_SB(1, 0), b3, voffB);
            PG8_BAR; PG8_WAIT_L(0); PG8_MMA(0, 1, At, B1); PG8_BAR;
            PG8_LDA(At, 1, 1); PG8_STAGE(PG8_SA(1, 0), a3, voffA);
            PG8_BAR; PG8_WAIT_L(0); PG8_MMA(1, 0, At, B0); PG8_BAR; PG8_SCHED;
            PG8_STAGE(PG8_SB(1, 1), b3 + hstep, voffB);
            PG8_WAIT_V(6); PG8_BAR; PG8_MMA(1, 1, At, B1); PG8_BAR;
            }
        }
        if constexpr (ALIGN_EPI) { if (wr == 0) PG8_BAR; }
        if constexpr (!Epi::AFTER_DRAIN) { E(acc, cur, wr, wc, fr, fq); S.done(cur); }
        if (!has_next) break;
#pragma unroll
        for (int a = 0; a < 2; ++a)
#pragma unroll
            for (int b = 0; b < 2; ++b)
#pragma unroll
                for (int m = 0; m < 4; ++m)
#pragma unroll
                    for (int n = 0; n < 2; ++n) acc[a][b][m][n] = (f32x4){0.f, 0.f, 0.f, 0.f};
        cur = nxt; cA = nA; cB = nB; ++ui;
        if constexpr (ALIGN_EPI) { if (wr == 1) PG8_BAR; }
    }
    PG8_WAIT_V(0);
    if constexpr (!ALIGN_EPI) { if (wr == 0) PG8_BAR; }
    PG8_BAR;
    if constexpr (Epi::AFTER_DRAIN) { E.fused(acc, cur, wr, wc, fr, fq, lds, wid, lane); S.done(cur); }
#undef PG8_SA
#undef PG8_SB
#undef PG8_STAGE
#undef PG8_LDA
#undef PG8_LDB
#undef PG8_MMA
#undef PG8_WAIT_V
#undef PG8_WAIT_L
#undef PG8_BAR
#undef PG8_SCHED
}
typedef _Float16 h8v __attribute__((ext_vector_type(8)));
typedef unsigned u32x2 __attribute__((ext_vector_type(2)));
typedef _Float16 h2v __attribute__((ext_vector_type(2)));
__device__ __forceinline__ unsigned pk_h2(float lo, float hi) { h2v v; v[0] = (_Float16)lo; v[1] = (_Float16)hi; return __builtin_bit_cast(unsigned, v); }
__device__ __forceinline__ u32x4 pack8(const f32x4& a, const f32x4& b) { u32x4 w; w.x = pk_h2(a[0], a[1]); w.y = pk_h2(a[2], a[3]); w.z = pk_h2(b[0], b[1]); w.w = pk_h2(b[2], b[3]); return w; }
__device__ __forceinline__ float sigm1(float v) { return __builtin_amdgcn_rcpf(1.f + __builtin_amdgcn_exp2f(v * -1.4426950408889634f)); }
__device__ __forceinline__ float silu1(float v) { return v * sigm1(v); }
__device__ __forceinline__ f32x4 silu4(const f32x4& v) { return (f32x4){silu1(v[0]), silu1(v[1]), silu1(v[2]), silu1(v[3])}; }
__device__ __forceinline__ f32x4 sigm4(const f32x4& v) { return (f32x4){sigm1(v[0]), sigm1(v[1]), sigm1(v[2]), sigm1(v[3])}; }

#define PG8_OPAQUE(fr_, fq_) int lane_x; asm volatile("v_mbcnt_lo_u32_b32 %0, -1, 0\n\tv_mbcnt_hi_u32_b32 %0, -1, %0" : "=v"(lane_x)); const int frx = lane_x & 15, fqx = lane_x >> 4
__device__ __forceinline__ void st16(unsigned char* base, unsigned off, const u32x4& v) { *(u32x4*)(base + off) = v; }
__device__ __forceinline__ f32x4 ld16f(const unsigned char* base, unsigned off) { return *(const f32x4*)(base + off); }
__device__ __forceinline__ float ld4f(const unsigned char* base, unsigned off) { return *(const float*)(base + off); }
__device__ __forceinline__ h8v ld16h(const unsigned char* base, unsigned off) { return *(const h8v*)(base + off); }
__device__ __forceinline__ float sumsq8(const f32x4& a, const f32x4& b) { return (a[0] * a[0] + a[1] * a[1]) + (a[2] * a[2] + a[3] * a[3]) + (b[0] * b[0] + b[1] * b[1]) + (b[2] * b[2] + b[3] * b[3]); }
__device__ __forceinline__ void rope4(const f32x4& t1, const f32x4& t2, const u32x4& cs, f32x4& o1, f32x4& o2) {
#pragma unroll
    for (int j = 0; j < 4; ++j) { const unsigned wj = cs[j]; h2v w; __builtin_memcpy(&w, &wj, 4);
        const float c = (float)w[0], s = (float)w[1]; o1[j] = t1[j] * c - t2[j] * s; o2[j] = t2[j] * c + t1[j] * s; }
}
__device__ __forceinline__ u32x4 ld16u(const unsigned char* base, unsigned off) { return *(const u32x4*)(base + off); }

struct EpiInF {
    static constexpr bool PERM = true, AFTER_DRAIN = false; static constexpr int MID_T = 0;
    unsigned char* ws; const float* b_merge; int noatomic;
    template <bool ISQ> __device__ __forceinline__ void rope_tile(const f32x4 (&acc)[2][2][4][2], const Unit& u, int wr, int wc, int frx, int fqx) const {
        const int pn = tile_perm(u.pn); const unsigned row0 = (unsigned)(u.pm * 256 + wr * 64) + (unsigned)frx; const float sc = ISQ ? SC_MB : 1.f;
        unsigned char* dst = ws + (ISQ ? WS_QMB : WS_KMB); const unsigned char* tab = ws + WS_TAB;
        const unsigned o0 = row0 * 1024u + (((pn & 1) ? 256u : 0u) + 64u * wc + 8u * fqx) * 2u, t0 = row0 * 128u + 32u * fqx;
        f32x4 c1[2] = {{0.f, 0.f, 0.f, 0.f}, {0.f, 0.f, 0.f, 0.f}}, c2[2] = {{0.f, 0.f, 0.f, 0.f}, {0.f, 0.f, 0.f, 0.f}};
        u32x4 cs[2][4][2];
#pragma unroll
        for (int ai = 0; ai < 2; ++ai)
#pragma unroll
            for (int m = 0; m < 4; ++m) { const unsigned to = t0 + (unsigned)(ai * 128 + m * 16) * 128u; cs[ai][m][0] = ld16u(tab, to); cs[ai][m][1] = ld16u(tab, to + 16u); }
#pragma unroll
        for (int ai = 0; ai < 2; ++ai)
#pragma unroll
            for (int m = 0; m < 4; ++m) { const unsigned ro = o0 + (unsigned)(ai * 128 + m * 16) * 1024u;
                f32x4 o1[2], o2[2];
#pragma unroll
                for (int n = 0; n < 2; ++n) { rope4(acc[ai][0][m][n], acc[ai][1][m][n], cs[ai][m][n], o1[n], o2[n]);
                    if (!ISQ) { c1[n] += o1[n]; c2[n] += o2[n]; } }
                st16(dst, ro, pack8(o1[0] * sc, o1[1] * sc)); st16(dst, ro + 64u, pack8(o2[0] * sc, o2[1] * sc));
                if (!ISQ) asm volatile("" : "+v"(c1[0]), "+v"(c1[1]), "+v"(c2[0]), "+v"(c2[1])); }
        if (!ISQ) {
            float* km = (float*)(ws + WS_KMEAN) + (size_t)u.pm * 512 + ((pn & 1) ? 256 : 0) + 64 * wc + 8 * fqx;
#pragma unroll
            for (int n = 0; n < 2; ++n)
#pragma unroll
                for (int j = 0; j < 4; ++j) { float a = c1[n][j], b = c2[n][j];
#pragma unroll
                    for (int o = 1; o < 16; o <<= 1) { a += __shfl_xor(a, o); b += __shfl_xor(b, o); }
                    if (frx == 0 && !noatomic) { atomicAdd(km + 4 * n + j, a * (1.f / 256.f)); atomicAdd(km + 32 + 4 * n + j, b * (1.f / 256.f)); } }
        }
    }
    __device__ __forceinline__ void operator()(const f32x4 (&acc)[2][2][4][2], const Unit& u, int wr, int wc, int fr, int fq) const {
        PG8_OPAQUE(fr, fq);
        const int pn = tile_perm(u.pn); const unsigned row0 = (unsigned)(u.pm * 256 + wr * 64) + (unsigned)frx, cl = 32u * wc + 8u * fqx;
        if (pn == 0) {
            unsigned char* dst = ws + WS_QLAT; float* ssq = (float*)(ws + WS_SSQ); const unsigned o0 = row0 * 512u + cl * 2u;
#pragma unroll
            for (int ai = 0; ai < 2; ++ai)
#pragma unroll
                for (int m = 0; m < 4; ++m) { const unsigned ro = o0 + (unsigned)(ai * 128 + m * 16) * 512u; float s = 0.f;
#pragma unroll
                    for (int bj = 0; bj < 2; ++bj) { s += sumsq8(acc[ai][bj][m][0], acc[ai][bj][m][1]); st16(dst, ro + bj * 256u, pack8(acc[ai][bj][m][0], acc[ai][bj][m][1])); }
                    s += __shfl_xor(s, 16); s += __shfl_xor(s, 32);
                    if (fqx == 0 && !noatomic) atomicAdd(ssq + (row0 + ai * 128 + m * 16), s); }
        } else if (pn == 1) {
            unsigned char* kvl = ws + WS_KVL; unsigned char* kpe = ws + WS_KPE; float* ssq = (float*)(ws + WS_SSQ) + M_; const unsigned char* tab = ws + WS_TAB;
#pragma unroll
            for (int ai = 0; ai < 2; ++ai)
#pragma unroll
                for (int m = 0; m < 4; ++m) { const unsigned row = row0 + ai * 128 + m * 16;
                    if (wc < 2) { float s = 0.f;
#pragma unroll
                        for (int bj = 0; bj < 2; ++bj) { s += sumsq8(acc[ai][bj][m][0], acc[ai][bj][m][1]); st16(kvl, row * 256u + (bj * 64u + cl) * 2u, pack8(acc[ai][bj][m][0], acc[ai][bj][m][1])); }
                        s += __shfl_xor(s, 16); s += __shfl_xor(s, 32);
                        if (fqx == 0 && !noatomic) atomicAdd(ssq + row, s);
                    } else {
                        if (wc == 2 && fqx < 2) {
                            f32x4 o1[2], o2[2];
#pragma unroll
                            for (int n = 0; n < 2; ++n) { const unsigned to = row * 128u + (unsigned)(16 * fqx + 8 * n) * 4u; const u32x4 wa = ld16u(tab, to), wb = ld16u(tab, to + 16u);
                                rope4(acc[ai][0][m][n], acc[ai][1][m][n], (u32x4){wa[0], wa[2], wb[0], wb[2]}, o1[n], o2[n]); }
                            st16(kpe, row * 64u + 16u * fqx, pack8(o1[0], o1[1])); st16(kpe, row * 64u + 32u + 16u * fqx, pack8(o2[0], o2[1]));
                        }
                    }
                    asm volatile("" ::: "memory"); }
        } else if (pn < 4 || (pn >= 8 && pn < 12)) {
            const bool act = (pn < 4) || (pn >= 10); const unsigned pitch = act ? 2048u : 1024u;
            unsigned char* dst = ws + (act ? WS_ZCAT : WS_VMB); const unsigned o0 = row0 * pitch + ((pn >= 10 ? 512u : 0u) + ((pn & 1) ? 256u : 0u) + cl) * 2u;
#pragma unroll
            for (int ai = 0; ai < 2; ++ai)
#pragma unroll
                for (int m = 0; m < 4; ++m) { const unsigned ro = o0 + (unsigned)(ai * 128 + m * 16) * pitch;
#pragma unroll
                    for (int bj = 0; bj < 2; ++bj) { f32x4 a = acc[ai][bj][m][0], b = acc[ai][bj][m][1]; if (act) { a = silu4(a); b = silu4(b); }
                        st16(dst, ro + bj * 256u, pack8(a, b)); } }
        } else if (pn < 6) { rope_tile<true>(acc, u, wr, wc, frx, fqx);
        } else if (pn < 8) { rope_tile<false>(acc, u, wr, wc, frx, fqx);
        } else {
            const bool isa = pn < 16; unsigned char* dst = ws + (isa ? WS_GA : WS_GB); const unsigned cg = 256u * ((pn - 12) & 3) + cl;
            const unsigned char* bm = (const unsigned char*)(b_merge + (isa ? 0 : 1024)); const unsigned o0 = row0 * 1024u + cg;
            f32x4 bv[2][2];
#pragma unroll
            for (int bj = 0; bj < 2; ++bj)
#pragma unroll
                for (int n = 0; n < 2; ++n) bv[bj][n] = ld16f(bm, (cg + bj * 128u + 4u * n) * 4u);
#pragma unroll
            for (int ai = 0; ai < 2; ++ai)
#pragma unroll
                for (int m = 0; m < 4; ++m) { const unsigned ro = o0 + (unsigned)(ai * 128 + m * 16) * 1024u;
#pragma unroll
                    for (int bj = 0; bj < 2; ++bj) { const f32x4 a = sigm4(acc[ai][bj][m][0] + bv[bj][0]) * 255.f + 0.5f, b = sigm4(acc[ai][bj][m][1] + bv[bj][1]) * 255.f + 0.5f;
                        u32x2 w; w.x = (unsigned)a[0] | ((unsigned)a[1] << 8) | ((unsigned)a[2] << 16) | ((unsigned)a[3] << 24); w.y = (unsigned)b[0] | ((unsigned)b[1] << 8) | ((unsigned)b[2] << 16) | ((unsigned)b[3] << 24);
                        *(u32x2*)(dst + (ro + bj * 128u)) = w; } }
        }
    }
};
struct EpiNull {
    static constexpr bool PERM = true, AFTER_DRAIN = false; static constexpr int MID_T = 0;
    __device__ __forceinline__ void operator()(const f32x4 (&acc)[2][2][4][2], const Unit& u, int wr, int wc, int fr, int fq) const {
#pragma unroll
        for (int ai = 0; ai < 2; ++ai)
#pragma unroll
            for (int bj = 0; bj < 2; ++bj)
#pragma unroll
                for (int m = 0; m < 4; ++m) asm volatile("" :: "v"(acc[ai][bj][m][0]), "v"(acc[ai][bj][m][1]));
    }
};
struct EpiUqF {
    static constexpr bool PERM = true, AFTER_DRAIN = false; static constexpr int MID_T = 0;
    unsigned char* ws;
    __device__ __forceinline__ void operator()(const f32x4 (&acc)[2][2][4][2], const Unit& u, int wr, int wc, int fr, int fq) const {
        PG8_OPAQUE(fr, fq);
        const int pn = u.pn; const unsigned row0 = (unsigned)(u.pm * 256 + wr * 64) + (unsigned)frx; unsigned char* Q = ws + WS_QMLA; const unsigned char* ssq = ws + WS_SSQ; const unsigned char* tab = ws + WS_TAB;
        float rsv[2][4];
#pragma unroll
        for (int ai = 0; ai < 2; ++ai)
#pragma unroll
            for (int m = 0; m < 4; ++m) rsv[ai][m] = ld4f(ssq, (row0 + ai * 128 + m * 16) * 4u);
#pragma unroll
        for (int ai = 0; ai < 2; ++ai)
#pragma unroll
            for (int m = 0; m < 4; ++m) { const unsigned row = row0 + ai * 128 + m * 16; const float rs = SC_MLA * __builtin_amdgcn_rsqf(rsv[ai][m] * (1.f / 256.f) + EPS);
                if (pn < 2) {
#pragma unroll
                    for (int bj = 0; bj < 2; ++bj) { const unsigned head = 4u * pn + 2u * bj + (wc >> 1), d = 32u * (wc & 1) + 8u * fqx;
                        st16(Q, row * 1536u + (96u * head + d) * 2u, pack8(acc[ai][bj][m][0] * rs, acc[ai][bj][m][1] * rs)); }
                } else { const unsigned head = 2u * wc + ((unsigned)fqx >> 1), i0 = 8u * (fqx & 1); f32x4 o1[2], o2[2];
#pragma unroll
                    for (int n = 0; n < 2; ++n) { const unsigned to = row * 128u + (2u * (i0 + 4u * n)) * 4u; const u32x4 wa = ld16u(tab, to), wb = ld16u(tab, to + 16u);
                        rope4(acc[ai][0][m][n] * rs, acc[ai][1][m][n] * rs, (u32x4){wa[0], wa[2], wb[0], wb[2]}, o1[n], o2[n]); }
                    st16(Q, row * 1536u + (96u * head + 64u + i0) * 2u, pack8(o1[0], o1[1])); st16(Q, row * 1536u + (96u * head + 80u + i0) * 2u, pack8(o2[0], o2[1])); } }
    }
};
struct EpiUkvF {
    static constexpr bool PERM = true, AFTER_DRAIN = false; static constexpr int MID_T = 0;
    unsigned char* ws;
    __device__ __forceinline__ void operator()(const f32x4 (&acc)[2][2][4][2], const Unit& u, int wr, int wc, int fr, int fq) const {
        PG8_OPAQUE(fr, fq);
        const int pn = u.pn; const unsigned row0 = (unsigned)(u.pm * 256 + wr * 64) + (unsigned)frx; unsigned char* dst = ws + (pn < 2 ? WS_KN : WS_VM); const unsigned char* ssq = ws + WS_SSQ + (size_t)M_ * 4;
        float rsv[2][4];
#pragma unroll
        for (int ai = 0; ai < 2; ++ai)
#pragma unroll
            for (int m = 0; m < 4; ++m) rsv[ai][m] = ld4f(ssq, (row0 + ai * 128 + m * 16) * 4u);
#pragma unroll
        for (int ai = 0; ai < 2; ++ai)
#pragma unroll
            for (int m = 0; m < 4; ++m) { const unsigned row = row0 + ai * 128 + m * 16; const float rs = __builtin_amdgcn_rsqf(rsv[ai][m] * (1.f / 128.f) + EPS);
#pragma unroll
                for (int bj = 0; bj < 2; ++bj) { const unsigned head = 4u * (pn & 1) + 2u * bj + (wc >> 1), d = 32u * (wc & 1) + 8u * fqx;
                    st16(dst, row * 1024u + (64u * head + d) * 2u, pack8(acc[ai][bj][m][0] * rs, acc[ai][bj][m][1] * rs)); } }
    }
};
struct EpiYcatF {
    static constexpr bool PERM = true, AFTER_DRAIN = false; static constexpr int MID_T = 8;
    unsigned char* ws;
    template <bool MID> __device__ __forceinline__ void run(f32x4 (&acc)[2][2][4][2], const Unit& u, int wr, int wc) const {
        PG8_OPAQUE(0, 0);
        const unsigned row0 = (unsigned)(u.pm * 256 + wr * 64) + (unsigned)frx, c0 = u.pn * 256u + 32u * wc + 8u * fqx, o0 = row0 * 2048u + c0 * 2u, g0 = row0 * 1024u + c0;
        const unsigned char* GA = ws + WS_GA; const unsigned char* GB = ws + WS_GB; unsigned char* YM = ws + WS_YM;
#pragma unroll
        for (int ai = 0; ai < 2; ++ai) {
            u32x2 ga[4][2], gb[4][2];
#pragma unroll
            for (int m = 0; m < 4; ++m)
#pragma unroll
                for (int bj = 0; bj < 2; ++bj) { const unsigned go = g0 + (unsigned)(ai * 128 + m * 16) * 1024u + bj * 128u; gb[m][bj] = *(const u32x2*)(GB + go); if (MID) ga[m][bj] = *(const u32x2*)(GA + go); }
#pragma unroll
            for (int m = 0; m < 4; ++m)
#pragma unroll
                for (int bj = 0; bj < 2; ++bj) { const unsigned off = o0 + (unsigned)(ai * 128 + m * 16) * 2048u + bj * 256u; f32x4 s0, s1;
#pragma unroll
                    for (int j = 0; j < 4; ++j) { const float b0 = fmaxf((float)((gb[m][bj].x >> (8 * j)) & 0xffu), 0.5f), b1 = fmaxf((float)((gb[m][bj].y >> (8 * j)) & 0xffu), 0.5f);
                        s0[j] = MID ? (float)((ga[m][bj].x >> (8 * j)) & 0xffu) * __builtin_amdgcn_rcpf(b0) : b0 * (1.f / 255.f);
                        s1[j] = MID ? (float)((ga[m][bj].y >> (8 * j)) & 0xffu) * __builtin_amdgcn_rcpf(b1) : b1 * (1.f / 255.f); }
                    acc[ai][bj][m][0] *= s0; acc[ai][bj][m][1] *= s1;
                    if (!MID) st16(YM, off, pack8(acc[ai][bj][m][0], acc[ai][bj][m][1])); }
            asm volatile("" ::: "memory"); }
    }
    __device__ __forceinline__ void mid(f32x4 (&acc)[2][2][4][2], const Unit& u, int wr, int wc) const { run<true>(acc, u, wr, wc); }
    __device__ __forceinline__ void operator()(f32x4 (&acc)[2][2][4][2], const Unit& u, int wr, int wc, int fr, int fq) const { run<false>(acc, u, wr, wc); }
};
struct EpiYF {
    static constexpr bool PERM = true, AFTER_DRAIN = false; static constexpr int MID_T = 0;
    unsigned char* ws;
    __device__ __forceinline__ void operator()(const f32x4 (&acc)[2][2][4][2], const Unit& u, int wr, int wc, int fr, int fq) const {
        PG8_OPAQUE(fr, fq);
        const unsigned row0 = (unsigned)(u.pm * 256 + wr * 64) + (unsigned)frx, c0 = u.pn * 256u + 32u * wc + 8u * fqx, o0 = row0 * 2048u + c0 * 2u; unsigned char* Y = ws + WS_Y; float* ssq = (float*)(ws + WS_SSQY);
#pragma unroll
        for (int ai = 0; ai < 2; ++ai)
#pragma unroll
            for (int m = 0; m < 4; ++m) { float s = 0.f;
#pragma unroll
                for (int bj = 0; bj < 2; ++bj) { s += sumsq8(acc[ai][bj][m][0], acc[ai][bj][m][1]); st16(Y, o0 + (unsigned)(ai * 128 + m * 16) * 2048u + bj * 256u, pack8(acc[ai][bj][m][0], acc[ai][bj][m][1])); }
                s += __shfl_xor(s, 16); s += __shfl_xor(s, 32);
                if (fqx == 0) atomicAdd(ssq + (row0 + ai * 128 + m * 16), s); }
    }
};
}

struct MapIn { __device__ int operator()(int n0) const { const int n = tile_perm(n0 >> 8) * 256 + (n0 & 255); const int t = n >> 8, tc = n & 255, bj = tc >> 7, uu = tc & 127;
    if (t == 0) return n;
    if (t == 1) return uu < 64 ? C_KVLAT + 64 * bj + uu : (uu < 80 ? C_KROPE + 16 * bj + (uu - 64) : -1);
    if (t < 4) return C_ZMLA + (n - 512);
    if (t < 8) return (t < 6 ? C_QMB : C_KMB) + 256 * (t & 1) + 64 * (uu >> 5) + 32 * bj + (uu & 31);
    if (t < 10) return C_VMB + (n - 2048);
    if (t < 12) return C_ZMB + (n - 2560);
    if (t < 16) return C_GA + (n - 3072);
    return C_GB + (n - 4096); } };
struct MapUq { __device__ int operator()(int n) const { const int t = n >> 8, tc = n & 255, bj = tc >> 7, uu = tc & 127;
    if (t < 2) return 96 * (4 * t + (tc >> 6)) + (tc & 63);
    return 96 * (uu >> 4) + 64 + 16 * bj + (uu & 15); } };
struct MapUkv { __device__ int operator()(int n) const { const int t = n >> 8, tc = n & 255; return 128 * (4 * (t & 1) + (tc >> 6)) + (t < 2 ? 0 : 64) + (tc & 63); } };
struct MapId { __device__ int operator()(int n) const { return n; } };
template <class Map> __device__ __forceinline__ void wt_items(const float* W, int ldw, int Kreal, int K, int N, unsigned short* WT, const float* kscale, Map map, LAS float* scr, int gw, int ngw, int lane, int ldk = 0, int koff = 0) {
    if (ldk == 0) ldk = K;
    const int nblk = N / 64, nitems = (K / 32) * nblk; typedef float f4 __attribute__((ext_vector_type(4)));
    for (int it = gw; it < nitems; it += ngw) {
        const int kb = it / nblk, nb = it % nblk, k0 = 32 * kb, n0 = 64 * nb; const int src = map(n0 + 4 * (lane & 15));
        f4 wv[8];
#pragma unroll
        for (int i = 0; i < 8; ++i) { const int k = k0 + 4 * i + (lane >> 4); wv[i] = (src >= 0 && k < Kreal) ? *(const f4*)(W + (size_t)k * ldw + src) : (f4){0.f, 0.f, 0.f, 0.f}; }
#pragma unroll
        for (int i = 0; i < 8; ++i) { const int kk = 4 * i + (lane >> 4), k = k0 + kk; f4 v = wv[i]; if (kscale && k < Kreal) v = v * kscale[k]; *(LAS f4*)(scr + kk * 68 + 4 * (lane & 15)) = v; }
        asm volatile("s_waitcnt lgkmcnt(0)" ::: "memory");
#pragma unroll
        for (int j = 0; j < 4; ++j) { const int q = lane + 64 * j, n = q >> 2, c = q & 3; const LAS float* s = scr + (8 * c) * 68 + n;
            pg8::u32x4 o; o.x = pg8::pk_h2(s[0 * 68], s[1 * 68]); o.y = pg8::pk_h2(s[2 * 68], s[3 * 68]); o.z = pg8::pk_h2(s[4 * 68], s[5 * 68]); o.w = pg8::pk_h2(s[6 * 68], s[7 * 68]);
            *(pg8::u32x4*)(WT + (size_t)(n0 + n) * ldk + koff + k0 + 8 * c) = o; }
        asm volatile("s_waitcnt lgkmcnt(0)" ::: "memory");
    }
}
constexpr size_t WT_IN = WS_WT, WT_UQ = WS_WT + 10 * MiB, WT_UKV = WT_UQ + 512 * 1024, WT_OA = WS_WT + 11 * MiB, WT_OB = WS_WT + 12 * MiB, WT_OUT = WS_WT + 13 * MiB;
__device__ __forceinline__ void ph_weights(const Params& p, LAS unsigned char* lds, int gw, int ngw, int wave, int lane) {
    LAS float* scr = (LAS float*)(lds + wave * 16384);
#define WT_ROT(off) ((gw + ngw - ((off) % ngw)) % ngw)
    wt_items(p.w_in, D_IN, 1024, 1024, 5120, (unsigned short*)(p.ws + WT_IN), nullptr, MapIn(), scr, gw, ngw, lane);
    wt_items(p.w_uq, 768, 256, 256, 768, (unsigned short*)(p.ws + WT_UQ), p.g_q, MapUq(), scr, WT_ROT(2560), ngw, lane);
    wt_items(p.w_ukv, 1024, 128, 128, 1024, (unsigned short*)(p.ws + WT_UKV), p.g_kv, MapUkv(), scr, WT_ROT(2656), ngw, lane);
    wt_items(p.w_o_mla, 1024, 512, 512, 1024, (unsigned short*)(p.ws + WT_OA), nullptr, MapId(), scr, WT_ROT(2720), ngw, lane, 1024, 0);
    wt_items(p.w_o_moba, 1024, 512, 512, 1024, (unsigned short*)(p.ws + WT_OA), nullptr, MapId(), scr, WT_ROT(2976), ngw, lane, 1024, 512);
    wt_items(p.w_out, 1024, 1024, 1024, 1024, (unsigned short*)(p.ws + WT_OUT), nullptr, MapId(), scr, WT_ROT(3232), ngw, lane);
#undef WT_ROT
}

namespace att {
struct T1 { static constexpr bool value = true; }; struct T0 { static constexpr bool value = false; };
typedef _Float16 h8 __attribute__((ext_vector_type(8)));
typedef short s4 __attribute__((ext_vector_type(4)));
typedef short s8 __attribute__((ext_vector_type(8)));
typedef float f16v __attribute__((ext_vector_type(16)));
typedef float f2v __attribute__((ext_vector_type(2)));
typedef unsigned u4 __attribute__((ext_vector_type(4)));
typedef short v4i16_t __attribute__((ext_vector_type(4)));
constexpr int KBUF = 16384, VBUF = 8192;
constexpr int NBUF = 4;
constexpr int L_K = 0, L_V = NBUF * KBUF, L_WS = L_V + NBUF * VBUF, L_TB = L_WS + 8 * 256, L_UN = L_TB + 256, L_END = L_UN + 64, L_OST = 0;
constexpr float THR = 8.f;
#ifndef PROBE_ABL
#define PROBE_ABL 0
#endif
#ifndef ATT_STAGGER
#define ATT_STAGGER 0
#endif
constexpr bool STAGGER = ATT_STAGGER;
__device__ __forceinline__ int crow(int r, int hi) { return (r & 3) + 8 * (r >> 2) + 4 * hi; }
template <int DK> __device__ __forceinline__ int kaddr(int row, int ch) { return DK == 64 ? row * 128 + ((ch ^ ((row >> 1) & 7)) << 4) : row * 256 + ((ch ^ (row & 15)) << 4); }
__device__ __forceinline__ s4 vtr(const LAS unsigned char* p) { return __builtin_bit_cast(s4, __builtin_amdgcn_ds_read_tr16_b64_v4i16((LAS v4i16_t*)p)); }
__device__ __forceinline__ float swapmax(float m) { auto rr = __builtin_amdgcn_permlane32_swap(__float_as_uint(m), __float_as_uint(m), false, false); return fmaxf(__uint_as_float(rr[0]), __uint_as_float(rr[1])); }
__device__ __forceinline__ float swapsum(float m) { auto rr = __builtin_amdgcn_permlane32_swap(__float_as_uint(m), __float_as_uint(m), false, false); return __uint_as_float(rr[0]) + __uint_as_float(rr[1]); }
__device__ __forceinline__ void glds16(const void* g, unsigned lds_base) { unsigned sv;
    asm volatile("s_mov_b32 %0, m0\n\ts_mov_b32 m0, %2\n\ts_nop 0\n\tglobal_load_lds_dwordx4 %1, off\n\ts_mov_b32 m0, %0" : "=&s"(sv) : "v"(g), "s"(lds_base) : "memory"); }
__device__ __forceinline__ float max3f(float a, float b, float c) { float r; asm("v_max3_f32 %0, %1, %2, %3" : "=v"(r) : "v"(a), "v"(b), "v"(c)); return r; }
__device__ __forceinline__ unsigned pkh(float lo, float hi) { typedef _Float16 h2 __attribute__((ext_vector_type(2))); h2 v; v[0] = (_Float16)lo; v[1] = (_Float16)hi; return __builtin_bit_cast(unsigned, v); }

template <int DK, bool MOBA, int ABL = 0, bool OWN = false>
__device__ __forceinline__ void attn_unit(unsigned char* ws, int b, int h, int qb, LAS unsigned char* lds, bool dry = false) {
    constexpr int ND = DK / 16, QP = MOBA ? 512 : 768, QH = MOBA ? 64 : 96;
    int tid_ = threadIdx.x; asm volatile("" : "+v"(tid_));
    const int tid = tid_, lane = tid & 63, r32 = lane & 31, hi = lane >> 5; const int wid = __builtin_amdgcn_readfirstlane(tid >> 6);
    const _Float16* Qg = (const _Float16*)(ws + (MOBA ? WS_QMB : WS_QMLA)); const _Float16* Kg = (const _Float16*)(ws + (MOBA ? WS_KMB : WS_KN));
    const _Float16* Vg = (const _Float16*)(ws + (MOBA ? WS_VMB : WS_VM)); const _Float16* Pg = (const _Float16*)(ws + WS_KPE); _Float16* Zg = (_Float16*)(ws + WS_ZCAT) + (MOBA ? 512 : 0);
    const size_t rowbase = (size_t)b * SEQ; const int q0 = qb * 256, qw0 = q0 + wid * 32, qrow = qw0 + r32;
    LAS float* wsf = (LAS float*)(lds + L_WS) + wid * 64; LAS int* tb = (LAS int*)(lds + L_TB); LAS unsigned* un = (LAS unsigned*)(lds + L_UN);
    h8 qr[ND];
#pragma unroll
    for (int d0 = 0; d0 < ND; ++d0) qr[d0] = *(const h8*)(Qg + (rowbase + qrow) * QP + h * QH + d0 * 16 + hi * 8);
#pragma unroll
    for (int d0 = 0; d0 < ND; ++d0) asm volatile("" : "+v"(qr[d0]));
    unsigned sel = 0u, blocks = OWN ? (1u << qb) : (2u << qb) - 1u;
    if (MOBA && !OWN) {
        const float* km = (const float*)(ws + WS_KMEAN) + (size_t)b * 16 * 512 + h * 64 + hi * 8;
        float g0 = -INFINITY, g1 = -INFINITY, g2 = -INFINITY; int i0 = -1, i1 = -1, i2 = -1;
        for (int m = 0; m < qb; ++m) {
            float part = 0.f;
#pragma unroll
            for (int d0 = 0; d0 < 4; ++d0) { const float4 a = *(const float4*)(km + m * 512 + d0 * 16), c = *(const float4*)(km + m * 512 + d0 * 16 + 4);
                part += (float)qr[d0][0] * a.x + (float)qr[d0][1] * a.y + (float)qr[d0][2] * a.z + (float)qr[d0][3] * a.w + (float)qr[d0][4] * c.x + (float)qr[d0][5] * c.y + (float)qr[d0][6] * c.z + (float)qr[d0][7] * c.w; }
            const float g = swapsum(part);
            if (g > g0) { g2 = g1; i2 = i1; g1 = g0; i1 = i0; g0 = g; i0 = m; }
            else if (g > g1) { g2 = g1; i2 = i1; g1 = g; i1 = m; }
            else if (g > g2) { g2 = g; i2 = m; }
        }
        if (i0 >= 0) sel |= 1u << i0; if (i1 >= 0) sel |= 1u << i1; if (i2 >= 0) sel |= 1u << i2;
        unsigned uw = sel;
#pragma unroll
        for (int o = 1; o < 64; o <<= 1) uw |= (unsigned)__shfl_xor((int)uw, o);
        if (lane == 0) un[wid] = uw;
        __syncthreads();
        unsigned ua = 0u;
#pragma unroll
        for (int w = 0; w < 8; ++w) ua |= un[w];
        blocks = (unsigned)__builtin_amdgcn_readfirstlane((int)(ua | (1u << qb)));
    }
    const int NT = OWN ? 4 : 4 * __builtin_popcount(blocks);
    if (tid < 64 && tid < NT) { unsigned bm = blocks; for (int k = 0; k < (tid >> 2); ++k) bm &= bm - 1u; tb[tid] = (__builtin_ctz(bm) << 8) + ((tid & 3) << 6); }
    __syncthreads();
    const unsigned char* kbu = (const unsigned char*)(Kg + rowbase * 512 + h * 64); const unsigned char* vbu = (const unsigned char*)(Vg + rowbase * 512 + h * 64); const unsigned char* pbu = (const unsigned char*)(Pg + rowbase * 32);
    const unsigned char* kb0; const unsigned char* kb1 = nullptr; unsigned ksrc0, ksrc1 = 0u, kst0 = 1024u, kst1 = 1024u;
    if (DK == 96) { const int r0 = 4 * wid + (lane >> 4), r1 = r0 + 32; int c0 = (lane & 15) ^ (r0 & 15), c1 = (lane & 15) ^ (r1 & 15); if (c0 >= 12) c0 -= 4; if (c1 >= 12) c1 -= 4;
        const bool kpe0 = c0 >= 8, kpe1 = c1 >= 8;
        kb0 = kpe0 ? pbu : kbu; kst0 = kpe0 ? 64u : 1024u; ksrc0 = kpe0 ? (unsigned)(r0 * 32 + (c0 - 8) * 8) * 2u : (unsigned)(r0 * 512 + c0 * 8) * 2u;
        kb1 = kpe1 ? pbu : kbu; kst1 = kpe1 ? 64u : 1024u; ksrc1 = kpe1 ? (unsigned)(r1 * 32 + (c1 - 8) * 8) * 2u : (unsigned)(r1 * 512 + c1 * 8) * 2u;
    } else { const int r0 = 8 * wid + (lane >> 3), c0 = (lane & 7) ^ ((r0 >> 1) & 7); kb0 = kbu; ksrc0 = (unsigned)(r0 * 512 + c0 * 8) * 2u; }
    const unsigned vsrc = (unsigned)((16 * (wid & 3) + (lane >> 2)) * 512 + (wid >> 2) * 32 + (lane & 3) * 8) * 2u;
    constexpr int NDMA = (DK == 96) ? 3 : 2;
#define ATT_GLDS(src, dst) glds16((const void*)(src), (unsigned)__builtin_amdgcn_readfirstlane((int)(unsigned)(size_t)(dst)))
#define ATT_DMA(kb, buf) do { const unsigned kb_ = (unsigned)(kb); LAS unsigned char* kd_ = lds + L_K + (buf) * KBUF; \
        ATT_GLDS(kb0 + (ksrc0 + kb_ * kst0), kd_ + wid * 1024); \
        if (DK == 96) ATT_GLDS(kb1 + (ksrc1 + kb_ * kst1), kd_ + 8192 + wid * 1024); \
        ATT_GLDS(vbu + (vsrc + kb_ * 1024u), lds + L_V + (buf) * VBUF + wid * 1024); } while (0)
#define ATT_WAITV(n) asm volatile("s_waitcnt vmcnt(" #n ")" ::: "memory")
#define ATT_BAR() do { asm volatile("s_waitcnt lgkmcnt(0)" ::: "memory"); __builtin_amdgcn_s_barrier(); asm volatile("" ::: "memory"); } while (0)
    const int vro = ((lane >> 4) & 1) * 32 + (lane & 3) * 8 + (4 * hi + ((lane & 15) >> 2)) * 64;
    LAS unsigned char* ldsv = lds + L_V + vro; asm volatile("" : "+v"(ldsv));
    float l_reg = 0.f; bool init = false; f16v o[2]; o[0] = f16v{}; o[1] = f16v{}; f16v negm = f16v{}; asm volatile("" : "+v"(negm));
    constexpr int G = 2 * ND;
#define ATT_SBAR() __builtin_amdgcn_sched_barrier(0)
#define ATT_PIN(x) asm volatile("" : "+v"(x))
#define ATT_KF(buf, g) (*(const LAS h8*)(lds + L_K + (buf) * KBUF + kaddr<DK>(32 * ((g) & 1) + r32, 2 * ((g) >> 1) + hi)))
#define ATT_MF(a, b, c) __builtin_amdgcn_mfma_f32_32x32x16_f16(a, b, c, 0, 0, 0)
#define ATT_QK(P0, P1, buf) do { h8 kf_[G]; _Pragma("unroll") for (int g_ = 0; g_ < G; ++g_) kf_[g_] = ATT_KF(buf, g_); ATT_SBAR(); \
        _Pragma("unroll") for (int d_ = 0; d_ < ND; ++d_) { P0 = ATT_MF(kf_[2 * d_], qr[d_], d_ == 0 ? negm : P0); P1 = ATT_MF(kf_[2 * d_ + 1], qr[d_], d_ == 0 ? negm : P1); } } while (0)
#define ATT_MAXCHAIN(P0, P1, PM) do { float pa_ = max3f(P0[0], P0[1], P1[0]), pb_ = max3f(P0[2], P0[3], P1[1]); pa_ = max3f(pa_, P1[2], P1[3]); \
        _Pragma("unroll") for (int r_ = 4; r_ < 16; r_ += 4) { pa_ = max3f(pa_, P0[r_], P0[r_ + 1]); pb_ = max3f(pb_, P0[r_ + 2], P0[r_ + 3]); pa_ = max3f(pa_, P1[r_], P1[r_ + 1]); pb_ = max3f(pb_, P1[r_ + 2], P1[r_ + 3]); } \
        PM = swapmax(fmaxf(pa_, pb_)); } while (0)
#define ATT_MOVE(P0, P1, PM) do { const bool move_ = init ? ((PM) > THR) : ((PM) > -INFINITY); \
        if (__any(move_)) { const float dl_ = move_ ? (init ? fmaxf((PM), 0.f) : (PM)) : 0.f; const float al_ = (move_ && init) ? __builtin_amdgcn_exp2f(-dl_) : 1.f; \
            init = init || move_; l_reg *= al_; \
            _Pragma("unroll") for (int r_ = 0; r_ < 16; ++r_) { P0[r_] -= dl_; P1[r_] -= dl_; negm[r_] -= dl_; } \
            if (hi == 0) wsf[r32] = al_; asm volatile("s_waitcnt lgkmcnt(0)" ::: "memory"); \
            _Pragma("unroll") for (int r_ = 0; r_ < 16; ++r_) { const float a_ = wsf[crow(r_, hi)]; o[0][r_] *= a_; o[1][r_] *= a_; } } } while (0)
#define ATT_PACK(P0, P1, PW, KEEP) do { _Pragma("unroll") for (int k_ = 0; k_ < 2; ++k_) { \
            PW[k_] = (u4){pkh(P0[8 * k_], P0[8 * k_ + 1]), pkh(P0[8 * k_ + 2], P0[8 * k_ + 3]), pkh(P0[8 * k_ + 4], P0[8 * k_ + 5]), pkh(P0[8 * k_ + 6], P0[8 * k_ + 7])}; \
            PW[2 + k_] = (u4){pkh(P1[8 * k_], P1[8 * k_ + 1]), pkh(P1[8 * k_ + 2], P1[8 * k_ + 3]), pkh(P1[8 * k_ + 4], P1[8 * k_ + 5]), pkh(P1[8 * k_ + 6], P1[8 * k_ + 7])}; } \
        if (MOBA) { _Pragma("unroll") for (int k_ = 0; k_ < 4; ++k_) PW[k_] &= (KEEP); } } while (0)
#define ATT_VF(buf, i) (ldsv + (buf) * VBUF + ((i) >> 2) * 4096 + ((i) & 3) * 1024)
#define ATT_WAIT_NEXT(t_) do { if ((t_) + 3 < NT) { if (NDMA == 3) ATT_WAITV(3); else ATT_WAITV(2); } else ATT_WAITV(0); } while (0)
#define ATT_TB(i) (MOBA ? tb[(i)] : 64 * (i))
    const int NF = OWN ? 0 : NT - 4;
    ATT_DMA(ATT_TB(0), 0); ATT_DMA(ATT_TB(1), 1); ATT_DMA(ATT_TB(2), 2);
    if (NDMA == 3) ATT_WAITV(3); else ATT_WAITV(2);
    ATT_BAR();
    f16v pC0, pC1;
    if (NF > 0) { ATT_QK(pC0, pC1, 0); asm volatile("s_nop 15\n\ts_nop 7" : "+v"(pC0), "+v"(pC1)); float pm; ATT_MAXCHAIN(pC0, pC1, pm);
        if (MOBA && !((sel >> (ATT_TB(0) >> 8)) & 1u)) pm = -INFINITY; ATT_MOVE(pC0, pC1, pm); }
    auto step = [&](f16v& pC0, f16v& pC1, f16v& pN0, f16v& pN1, const int t, auto hn) __attribute__((always_inline)) {
        const int cur = t & 3, nx = (t + 1) & 3; constexpr bool hasn = decltype(hn)::value;
        ATT_DMA(ATT_TB(t + 3), (t + 3) & 3);
        const unsigned keepC = (!MOBA || ((sel >> (ATT_TB(t) >> 8)) & 1u)) ? 0xffffffffu : 0u;
        float ps = 0.f; f2v ps2 = (f2v){0.f, 0.f};
        if (hasn) {
            h8 kf[G];
#pragma unroll
            for (int g = 0; g < 4; ++g) kf[g] = ATT_KF(nx, g);
            ATT_SBAR();
#pragma unroll
            for (int g = 0; g < G; ++g) {
                if (g + 4 < G) kf[g + 4] = ATT_KF(nx, g + 4);
                if (g & 1) pN1 = ATT_MF(kf[g], qr[g >> 1], g == 1 ? negm : pN1); else pN0 = ATT_MF(kf[g], qr[g >> 1], g == 0 ? negm : pN0);
                constexpr int dummy = 0; (void)dummy;
                const int e0 = (ND == 4) ? 4 * g : (g < 8 ? 3 * g : 24 + 2 * (g - 8)), e1 = (ND == 4) ? 4 * g + 4 : (g < 8 ? 3 * g + 3 : 26 + 2 * (g - 8));
#pragma unroll
                for (int e = e0; e < e1; ++e) { if (e < 16) pC0[e] = __builtin_amdgcn_exp2f(pC0[e]); else pC1[e - 16] = __builtin_amdgcn_exp2f(pC1[e - 16]);
                    if (e & 1) { if (e < 16) ps2 += (f2v){pC0[e - 1], pC0[e]}; else ps2 += (f2v){pC1[e - 17], pC1[e - 16]}; } }
                ATT_PIN(pC0); ATT_PIN(pC1); ATT_PIN(ps2); ATT_SBAR();
            }
        } else {
#pragma unroll
            for (int r = 0; r < 16; ++r) { pC0[r] = __builtin_amdgcn_exp2f(pC0[r]); pC1[r] = __builtin_amdgcn_exp2f(pC1[r]); ps += pC0[r] + pC1[r]; }
        }
        ps += ps2[0] + ps2[1];
        if (MOBA && !keepC) ps = 0.f;
        l_reg += swapsum(ps);
        u4 pw[4]; ATT_PACK(pC0, pC1, pw, keepC);
        {
            s4 vlo[8], vhi[8]; float pa = 0.f, pb = 0.f;
#pragma unroll
            for (int i = 0; i < 3; ++i) { vlo[i] = vtr(ATT_VF(cur, i)); vhi[i] = vtr(ATT_VF(cur, i) + 512); }
            if (hasn) asm volatile("s_nop 7" : "+v"(pN0), "+v"(pN1));
            ATT_SBAR();
#pragma unroll
            for (int i = 0; i < 8; ++i) {
                if (i + 3 < 8) { vlo[i + 3] = vtr(ATT_VF(cur, i + 3)); vhi[i + 3] = vtr(ATT_VF(cur, i + 3) + 512); }
                const s8 vv = (s8){vlo[i][0], vlo[i][1], vlo[i][2], vlo[i][3], vhi[i][0], vhi[i][1], vhi[i][2], vhi[i][3]};
                o[i >> 2] = ATT_MF(__builtin_bit_cast(h8, pw[i & 3]), __builtin_bit_cast(h8, vv), o[i >> 2]);
                if (hasn) {
                    if (i == 0) { pa = max3f(pN0[0], pN0[1], pN1[0]); pb = max3f(pN0[2], pN0[3], pN1[1]); }
                    else if (i == 1) { pa = max3f(pa, pN1[2], pN1[3]); pb = max3f(pb, pN0[6], pN0[7]); }
                    else if (i == 2) { pa = max3f(pa, pN0[4], pN0[5]); pb = max3f(pb, pN1[6], pN1[7]); }
                    else if (i == 3) { pa = max3f(pa, pN1[4], pN1[5]); pb = max3f(pb, pN0[10], pN0[11]); }
                    else if (i == 4) { pa = max3f(pa, pN0[8], pN0[9]); pb = max3f(pb, pN1[10], pN1[11]); }
                    else if (i == 5) { pa = max3f(pa, pN1[8], pN1[9]); pb = max3f(pb, pN0[14], pN0[15]); }
                    else if (i == 6) { pa = max3f(pa, pN0[12], pN0[13]); pb = max3f(pb, pN1[14], pN1[15]); }
                    else { pa = max3f(pa, pN1[12], pN1[13]); }
                    ATT_PIN(pa); ATT_PIN(pb);
                }
                ATT_SBAR();
            }
            if (hasn) { float pm = swapmax(fmaxf(pa, pb)); if (MOBA && !((sel >> (ATT_TB(t + 1) >> 8)) & 1u)) pm = -INFINITY; ATT_MOVE(pN0, pN1, pm); }
        }
        if (NDMA == 3) ATT_WAITV(3); else ATT_WAITV(2);
        ATT_BAR();
    };
    {
        f16v pD0, pD1; int t = 0;
        for (; t + 2 < NF; t += 2) { step(pC0, pC1, pD0, pD1, t, T1{}); step(pD0, pD1, pC0, pC1, t + 1, T1{}); }
        if (t + 1 < NF) { step(pC0, pC1, pD0, pD1, t, T1{}); step(pD0, pD1, pC0, pC1, t + 1, T0{}); }
        else if (t < NF) step(pC0, pC1, pD0, pD1, t, T0{});
    }
    for (int t = NF; t < NT; ++t) {
        const int cur = t & 3, kb = ATT_TB(t);
        if (t + 3 < NT) ATT_DMA(ATT_TB(t + 3), (t + 3) & 3);
        if (kb <= qw0 + 31) {
            f16v p0, p1; ATT_QK(p0, p1, cur);
            if (kb + 63 > qw0) {
#pragma unroll
                for (int r = 0; r < 16; ++r) { const int kv = kb + crow(r, hi); if (kv > qrow) p0[r] = -INFINITY; if (kv + 32 > qrow) p1[r] = -INFINITY; }
            }
            asm volatile("s_nop 15\n\ts_nop 7" : "+v"(p0), "+v"(p1));
            float pm; ATT_MAXCHAIN(p0, p1, pm); ATT_MOVE(p0, p1, pm);
            s4 vlo[8], vhi[8];
#pragma unroll
            for (int i = 0; i < 8; ++i) { vlo[i] = vtr(ATT_VF(cur, i)); vhi[i] = vtr(ATT_VF(cur, i) + 512); }
            ATT_SBAR();
            float ps = 0.f;
#pragma unroll
            for (int r = 0; r < 16; ++r) { p0[r] = __builtin_amdgcn_exp2f(p0[r]); p1[r] = __builtin_amdgcn_exp2f(p1[r]); ps += p0[r] + p1[r]; }
            l_reg += swapsum(ps);
            u4 pw[4]; ATT_PACK(p0, p1, pw, 0xffffffffu);
#pragma unroll
            for (int i = 0; i < 8; ++i) { const s8 vv = (s8){vlo[i][0], vlo[i][1], vlo[i][2], vlo[i][3], vhi[i][0], vhi[i][1], vhi[i][2], vhi[i][3]};
                o[i >> 2] = ATT_MF(__builtin_bit_cast(h8, pw[i & 3]), __builtin_bit_cast(h8, vv), o[i >> 2]); }
        }
        ATT_WAIT_NEXT(t);
        ATT_BAR();
    }
    if (hi == 0) { wsf[32 + r32] = l_reg; if (OWN) wsf[r32] = -negm[0]; } asm volatile("s_waitcnt lgkmcnt(0)" ::: "memory");
    LAS _Float16* stg = (LAS _Float16*)(lds + L_OST) + wid * 2048;
#pragma unroll
    for (int r = 0; r < 16; ++r) { const int orow = crow(r, hi); const float rl = 1.f / wsf[32 + orow];
        stg[orow * 64 + r32] = (_Float16)(o[0][r] * rl); stg[orow * 64 + 32 + r32] = (_Float16)(o[1][r] * rl); }
    asm volatile("s_waitcnt lgkmcnt(0)" ::: "memory");
    int lane_e = lane; asm volatile("" : "+v"(lane_e));
    unsigned char* zbu = (unsigned char*)(Zg + (rowbase + qw0) * 1024 + h * 64);
#pragma unroll
    for (int i = 0; i < 4; ++i) { const int row = i * 8 + (lane_e >> 3), ch = lane_e & 7; const h8 v = *(const LAS h8*)(stg + row * 64 + ch * 8);
        _Float16* zp = (_Float16*)(zbu + (unsigned)(row * 1024 + ch * 8) * 2u); const h8 z = *(const h8*)zp; h8 ov;
        if (OWN) {
            const int nsl = qb < 3 ? qb : 3; const unsigned gr = (unsigned)((b * 8 + h) * 4096 + qw0 + row);
            const float m_own = wsf[row], l_own = wsf[32 + row]; float M = m_own; float2 ml[3]; h8 po[3];
#pragma unroll
            for (int s = 0; s < 3; ++s) if (s < nsl) { ml[s] = ((const float2*)(ws + WS_ML))[(unsigned)s * 524288u + gr]; po[s] = *(const h8*)(ws + opart_off(s) + gr * 128u + (unsigned)ch * 16u); M = fmaxf(M, ml[s].x); }
            const float w0 = l_own * __builtin_amdgcn_exp2f(m_own - M); float W = w0; float acc[8];
#pragma unroll
            for (int j = 0; j < 8; ++j) acc[j] = w0 * (float)v[j];
#pragma unroll
            for (int s = 0; s < 3; ++s) if (s < nsl) { const float w = ml[s].y * __builtin_amdgcn_exp2f(ml[s].x - M); W += w;
#pragma unroll
                for (int j = 0; j < 8; ++j) acc[j] = fmaf(w, (float)po[s][j], acc[j]); }
            const float rW = 1.f / W;
#pragma unroll
            for (int j = 0; j < 8; ++j) ov[j] = (_Float16)(acc[j] * rW * (float)z[j]);
        } else {
#pragma unroll
            for (int j = 0; j < 8; ++j) ov[j] = (_Float16)((float)v[j] * (float)z[j]);
        }
        if (!dry) *(h8*)zp = ov; }
    __syncthreads();
#undef ATT_GLDS
#undef ATT_DMA
#undef ATT_WAITV
#undef ATT_BAR
#undef ATT_SBAR
#undef ATT_PIN
#undef ATT_KF
#undef ATT_MF
#undef ATT_QK
#undef ATT_MAXCHAIN
#undef ATT_MOVE
#undef ATT_PACK
#undef ATT_VF
#undef ATT_WAIT_NEXT
#undef ATT_TB
}


__device__ __forceinline__ void ph_gate(unsigned char* ws, int gw_, int ngw, int lane) {
    const int gw = __builtin_amdgcn_readfirstlane(gw_);
    unsigned* cnt = (unsigned*)(ws + WS_CNT); unsigned short* lists = (unsigned short*)(ws + WS_LIST);
    for (int it = gw; it < 128 * 60; it += ngw) {
        const int bh = it / 60, rr = it - bh * 60, qb = 1 + (rr >> 2), ch = rr & 3, b = bh >> 3, h = bh & 7;
        const int row = qb * 256 + ch * 64 + lane;
        const _Float16* q = (const _Float16*)(ws + WS_QMB) + ((size_t)b * SEQ + row) * 512 + h * 64;
        h8 qv[8];
#pragma unroll
        for (int i = 0; i < 8; ++i) qv[i] = *(const h8*)(q + 8 * i);
        const float* km = (const float*)(ws + WS_KMEAN) + (size_t)b * 16 * 512 + h * 64;
        float g0 = -INFINITY, g1 = -INFINITY, g2 = -INFINITY; int i0 = -1, i1 = -1, i2 = -1;
        for (int m = 0; m < qb; ++m) {
            float s0 = 0.f, s1 = 0.f;
#pragma unroll
            for (int d = 0; d < 64; d += 2) { s0 = fmaf((float)qv[d >> 3][d & 7], km[m * 512 + d], s0); s1 = fmaf((float)qv[d >> 3][(d & 7) + 1], km[m * 512 + d + 1], s1); }
            const float g = s0 + s1;
            if (g > g0) { g2 = g1; i2 = i1; g1 = g0; i1 = i0; g0 = g; i0 = m; }
            else if (g > g1) { g2 = g1; i2 = i1; g1 = g; i1 = m; }
            else if (g > g2) { g2 = g; i2 = m; }
        }
        unsigned mycnt = 0u;
#pragma unroll
        for (int j = 0; j < 15; ++j) { const bool s = (i0 == j) | (i1 == j) | (i2 == j); const unsigned long long mk = __ballot(s); if (lane == j) mycnt = (unsigned)__popcll(mk); }
        unsigned basev = 0u; if (lane < 15 && mycnt) basev = atomicAdd(&cnt[bh * 16 + lane], mycnt);
#pragma unroll
        for (int j = 0; j < 15; ++j) { const bool s = (i0 == j) | (i1 == j) | (i2 == j); const unsigned long long mk = __ballot(s); const unsigned base = (unsigned)__builtin_amdgcn_readlane((int)basev, j);
            if (s) { const unsigned rank = (unsigned)__popcll(mk & ((1ull << lane) - 1ull)); const int slot = (i0 == j) ? 0 : ((i1 == j) ? 1 : 2);
                lists[(size_t)(bh * 16 + j) * 4096 + base + rank] = (unsigned short)(row | (slot << 12)); } }
    }
}

constexpr int GBUF = 65536, G_V = 32768, G_WS = 131072 + 1024, G_CTL = G_WS + 4096, G_ST = G_CTL + 768;
constexpr unsigned G_SINK = 256 * 1024;
__device__ __forceinline__ void gather_dma(unsigned char* ws, int b, int h, int j, LAS unsigned char* lds, int X) {
    int tid_ = threadIdx.x; asm volatile("" : "+v"(tid_)); const int lane = tid_ & 63; const int wid = __builtin_amdgcn_readfirstlane(tid_ >> 6);
    const size_t rowbase = (size_t)b * SEQ + j * 256;
    const unsigned char* kbu = (const unsigned char*)((const _Float16*)(ws + WS_KMB) + rowbase * 512 + h * 64); const unsigned char* vbu = (const unsigned char*)((const _Float16*)(ws + WS_VMB) + rowbase * 512 + h * 64);
    const int r0 = 8 * wid + (lane >> 3), c0 = (lane & 7) ^ ((r0 >> 1) & 7);
    const unsigned ksrc = (unsigned)(r0 * 512 + c0 * 8) * 2u, vsrc = (unsigned)((16 * (wid & 3) + (lane >> 2)) * 512 + (wid >> 2) * 32 + (lane & 3) * 8) * 2u;
    LAS unsigned char* lb = lds + X * GBUF + wid * 1024;
#pragma unroll
    for (int t = 0; t < 4; ++t) {
        glds16((const void*)(kbu + (ksrc + (unsigned)t * 65536u)), (unsigned)__builtin_amdgcn_readfirstlane((int)(unsigned)(size_t)(lb + t * 8192)));
        glds16((const void*)(vbu + (vsrc + (unsigned)t * 65536u)), (unsigned)__builtin_amdgcn_readfirstlane((int)(unsigned)(size_t)(lb + G_V + t * 8192))); }
}
__device__ __forceinline__ void gather_dma_all(unsigned char* ws, int b, int h, int j, LAS unsigned char* lds, int X) {
    int tid_ = threadIdx.x; asm volatile("" : "+v"(tid_)); const int lane = tid_ & 63;
    const size_t rowbase = (size_t)b * SEQ + j * 256;
    const unsigned char* kbu = (const unsigned char*)((const _Float16*)(ws + WS_KMB) + rowbase * 512 + h * 64); const unsigned char* vbu = (const unsigned char*)((const _Float16*)(ws + WS_VMB) + rowbase * 512 + h * 64);
    for (int w = 0; w < 8; ++w) {
        const int r0 = 8 * w + (lane >> 3), c0 = (lane & 7) ^ ((r0 >> 1) & 7);
        const unsigned ksrc = (unsigned)(r0 * 512 + c0 * 8) * 2u, vsrc = (unsigned)((16 * (w & 3) + (lane >> 2)) * 512 + (w >> 2) * 32 + (lane & 3) * 8) * 2u;
        LAS unsigned char* lb = lds + X * GBUF + w * 1024;
#pragma unroll
        for (int t = 0; t < 4; ++t) {
            glds16((const void*)(kbu + (ksrc + (unsigned)t * 65536u)), (unsigned)__builtin_amdgcn_readfirstlane((int)(unsigned)(size_t)(lb + t * 8192)));
            glds16((const void*)(vbu + (vsrc + (unsigned)t * 65536u)), (unsigned)__builtin_amdgcn_readfirstlane((int)(unsigned)(size_t)(lb + G_V + t * 8192))); }
    }
}
__device__ __forceinline__ void gather_unit(unsigned char* ws, int b, int h, int j, LAS unsigned char* lds, int X, LAS unsigned* ctr) {
    constexpr int ND = 4, G = 8;
    int tid_ = threadIdx.x; asm volatile("" : "+v"(tid_));
    const int tid = tid_, lane = tid & 63, r32 = lane & 31, hi = lane >> 5; const int wid = __builtin_amdgcn_readfirstlane(tid >> 6);
    const int bh = b * 8 + h;
    const _Float16* Qg = (const _Float16*)(ws + WS_QMB) + (size_t)b * SEQ * 512 + h * 64;
    const unsigned short* lst = (const unsigned short*)(ws + WS_LIST) + (size_t)(bh * 16 + j) * 4096;
    const int cnt = __builtin_amdgcn_readfirstlane((int)((const unsigned*)(ws + WS_CNT))[bh * 16 + j]);
    const int ngr = (cnt + 31) >> 5;
    LAS unsigned char* kfb = lds + X * GBUF; LAS unsigned char* vfb = kfb + G_V;
    LAS float* wsf = (LAS float*)(lds + G_WS) + wid * 128; LAS unsigned* wsu = (LAS unsigned*)wsf;
    const int vro = ((lane >> 4) & 1) * 32 + (lane & 3) * 8 + (4 * hi + ((lane & 15) >> 2)) * 64;
#define GT_SBAR() __builtin_amdgcn_sched_barrier(0)
#define GT_PIN(x) asm volatile("" : "+v"(x))
#define GT_KF(buf, g) (*(const LAS h8*)(kfb + (buf) * 8192 + kaddr<64>(32 * ((g) & 1) + r32, 2 * ((g) >> 1) + hi)))
#define GT_VF(buf, i) (vfb + (buf) * 8192 + vro + ((i) >> 2) * 4096 + ((i) & 3) * 1024)
#define GT_MF(a, b, c) __builtin_amdgcn_mfma_f32_32x32x16_f16(a, b, c, 0, 0, 0)
#define GT_MOVE(P0, P1, PM) do { const bool move_ = init ? ((PM) > THR) : ((PM) > -INFINITY); \
        if (__any(move_)) { const float dl_ = move_ ? (init ? fmaxf((PM), 0.f) : (PM)) : 0.f; const float al_ = (move_ && init) ? __builtin_amdgcn_exp2f(-dl_) : 1.f; \
            init = init || move_; l_reg *= al_; \
            _Pragma("unroll") for (int r_ = 0; r_ < 16; ++r_) { P0[r_] -= dl_; P1[r_] -= dl_; negm[r_] -= dl_; } \
            if (hi == 0) wsf[r32] = al_; asm volatile("s_waitcnt lgkmcnt(0)" ::: "memory"); \
            _Pragma("unroll") for (int r_ = 0; r_ < 16; ++r_) { const float a_ = wsf[crow(r_, hi)]; o[0][r_] *= a_; o[1][r_] *= a_; } } } while (0)
#define GT_TAKE() ({ unsigned v_ = 0u; if (lane == 0) v_ = __hip_atomic_fetch_add(ctr, 1u, __ATOMIC_RELAXED, __HIP_MEMORY_SCOPE_WORKGROUP); (int)__builtin_amdgcn_readfirstlane((int)v_); })
    h8 qr[ND]; bool validn = false; unsigned entn = 0u;
    int g = GT_TAKE(), gn = ngr;
    if (g < ngr) { const int idx = g * 32 + r32; validn = idx < cnt; entn = validn ? (unsigned)lst[idx] : 0u;
#pragma unroll
        for (int d0 = 0; d0 < ND; ++d0) qr[d0] = *(const h8*)(Qg + (size_t)(entn & 4095u) * 512 + d0 * 16 + hi * 8); }
    for (; g < ngr; g = gn) {
        const bool valid = validn; const unsigned ent = entn; const int row = (int)(ent & 4095u), slot = (int)(ent >> 12) & 3;
        gn = GT_TAKE(); { const int idx = gn * 32 + r32; validn = idx < cnt; entn = validn ? (unsigned)lst[idx] : 0u; }
#pragma unroll
        for (int d0 = 0; d0 < ND; ++d0) asm volatile("" : "+v"(qr[d0]));
        float l_reg = 0.f; bool init = false; f16v o[2]; o[0] = f16v{}; o[1] = f16v{}; f16v negm = f16v{}; asm volatile("" : "+v"(negm));
        f16v pC0, pC1, pD0, pD1;
        {
            h8 kf_[G];
#pragma unroll
            for (int g_ = 0; g_ < G; ++g_) kf_[g_] = GT_KF(0, g_);
            GT_SBAR();
#pragma unroll
            for (int d_ = 0; d_ < ND; ++d_) { pC0 = GT_MF(kf_[2 * d_], qr[d_], d_ == 0 ? negm : pC0); pC1 = GT_MF(kf_[2 * d_ + 1], qr[d_], d_ == 0 ? negm : pC1); }
            asm volatile("s_nop 15\n\ts_nop 7" : "+v"(pC0), "+v"(pC1));
            float pa_ = max3f(pC0[0], pC0[1], pC1[0]), pb_ = max3f(pC0[2], pC0[3], pC1[1]); pa_ = max3f(pa_, pC1[2], pC1[3]);
#pragma unroll
            for (int r_ = 4; r_ < 16; r_ += 4) { pa_ = max3f(pa_, pC0[r_], pC0[r_ + 1]); pb_ = max3f(pb_, pC0[r_ + 2], pC0[r_ + 3]); pa_ = max3f(pa_, pC1[r_], pC1[r_ + 1]); pb_ = max3f(pb_, pC1[r_ + 2], pC1[r_ + 3]); }
            const float pm = swapmax(fmaxf(pa_, pb_)); GT_MOVE(pC0, pC1, pm);
        }
        auto gstep = [&](f16v& pC0, f16v& pC1, f16v& pN0, f16v& pN1, const int t, auto hn) __attribute__((always_inline)) {
            constexpr bool hasn = decltype(hn)::value;
            float ps = 0.f;
            if (hasn) {
                h8 kf[G];
#pragma unroll
                for (int g_ = 0; g_ < 4; ++g_) kf[g_] = GT_KF(t + 1, g_);
                GT_SBAR();
#pragma unroll
                for (int g_ = 0; g_ < G; ++g_) {
                    if (g_ + 4 < G) kf[g_ + 4] = GT_KF(t + 1, g_ + 4);
                    if (g_ & 1) pN1 = GT_MF(kf[g_], qr[g_ >> 1], g_ == 1 ? negm : pN1); else pN0 = GT_MF(kf[g_], qr[g_ >> 1], g_ == 0 ? negm : pN0);
#pragma unroll
                    for (int e = 4 * g_; e < 4 * g_ + 4; ++e) { if (e < 16) { pC0[e] = __builtin_amdgcn_exp2f(pC0[e]); ps += pC0[e]; } else { pC1[e - 16] = __builtin_amdgcn_exp2f(pC1[e - 16]); ps += pC1[e - 16]; } }
                    GT_PIN(pC0); GT_PIN(pC1); GT_PIN(ps); GT_SBAR();
                }
            } else {
#pragma unroll
                for (int r = 0; r < 16; ++r) { pC0[r] = __builtin_amdgcn_exp2f(pC0[r]); pC1[r] = __builtin_amdgcn_exp2f(pC1[r]); ps += pC0[r] + pC1[r]; }
            }
            l_reg += swapsum(ps);
            u4 pw[4];
#pragma unroll
            for (int k_ = 0; k_ < 2; ++k_) {
                pw[k_] = (u4){pkh(pC0[8 * k_], pC0[8 * k_ + 1]), pkh(pC0[8 * k_ + 2], pC0[8 * k_ + 3]), pkh(pC0[8 * k_ + 4], pC0[8 * k_ + 5]), pkh(pC0[8 * k_ + 6], pC0[8 * k_ + 7])};
                pw[2 + k_] = (u4){pkh(pC1[8 * k_], pC1[8 * k_ + 1]), pkh(pC1[8 * k_ + 2], pC1[8 * k_ + 3]), pkh(pC1[8 * k_ + 4], pC1[8 * k_ + 5]), pkh(pC1[8 * k_ + 6], pC1[8 * k_ + 7])}; }
            s4 vlo[8], vhi[8]; float pa = 0.f, pb = 0.f;
#pragma unroll
            for (int i = 0; i < 3; ++i) { vlo[i] = vtr(GT_VF(t, i)); vhi[i] = vtr(GT_VF(t, i) + 512); }
            if (hasn) asm volatile("s_nop 7" : "+v"(pN0), "+v"(pN1));
            GT_SBAR();
#pragma unroll
            for (int i = 0; i < 8; ++i) {
                if (i + 3 < 8) { vlo[i + 3] = vtr(GT_VF(t, i + 3)); vhi[i + 3] = vtr(GT_VF(t, i + 3) + 512); }
                const s8 vv = (s8){vlo[i][0], vlo[i][1], vlo[i][2], vlo[i][3], vhi[i][0], vhi[i][1], vhi[i][2], vhi[i][3]};
                o[i >> 2] = GT_MF(__builtin_bit_cast(h8, pw[i & 3]), __builtin_bit_cast(h8, vv), o[i >> 2]);
                if (hasn) {
                    if (i == 0) { pa = max3f(pN0[0], pN0[1], pN1[0]); pb = max3f(pN0[2], pN0[3], pN1[1]); }
                    else if (i == 1) { pa = max3f(pa, pN1[2], pN1[3]); pb = max3f(pb, pN0[6], pN0[7]); }
                    else if (i == 2) { pa = max3f(pa, pN0[4], pN0[5]); pb = max3f(pb, pN1[6], pN1[7]); }
                    else if (i == 3) { pa = max3f(pa, pN1[4], pN1[5]); pb = max3f(pb, pN0[10], pN0[11]); }
                    else if (i == 4) { pa = max3f(pa, pN0[8], pN0[9]); pb = max3f(pb, pN1[10], pN1[11]); }
                    else if (i == 5) { pa = max3f(pa, pN1[8], pN1[9]); pb = max3f(pb, pN0[14], pN0[15]); }
                    else if (i == 6) { pa = max3f(pa, pN0[12], pN0[13]); pb = max3f(pb, pN1[14], pN1[15]); }
                    else { pa = max3f(pa, pN1[12], pN1[13]); }
                    GT_PIN(pa); GT_PIN(pb);
                }
                GT_SBAR();
            }
            if (hasn) { const float pm = swapmax(fmaxf(pa, pb)); GT_MOVE(pN0, pN1, pm); }
        };
        gstep(pC0, pC1, pD0, pD1, 0, T1{}); gstep(pD0, pD1, pC0, pC1, 1, T1{}); gstep(pC0, pC1, pD0, pD1, 2, T1{}); gstep(pD0, pD1, pC0, pC1, 3, T0{});
        if (gn < ngr) {
#pragma unroll
            for (int d0 = 0; d0 < ND; ++d0) qr[d0] = *(const h8*)(Qg + (size_t)(entn & 4095u) * 512 + d0 * 16 + hi * 8); }
        const unsigned gr = (unsigned)(bh * 4096 + row);
        if (hi == 0) { wsf[32 + r32] = 1.f / l_reg; wsu[64 + r32] = valid ? opart_off(slot) + gr * 128u : G_SINK;
            if (valid) ((float2*)(ws + WS_ML))[(unsigned)slot * 524288u + gr] = make_float2(-negm[0], l_reg); }
        asm volatile("s_waitcnt lgkmcnt(0)" ::: "memory");
#pragma unroll
        for (int k = 0; k < 4; ++k) {
            typedef float f4e __attribute__((ext_vector_type(4)));
            const f4e rl4 = *(const LAS f4e*)(wsf + 32 + 8 * k + 4 * hi); const u4 of4 = *(const LAS u4*)(wsu + 64 + 8 * k + 4 * hi);
#pragma unroll
            for (int i = 0; i < 4; ++i) { const int r = 4 * k + i; const unsigned off = of4[i] + (unsigned)r32 * 2u;
                *(_Float16*)(ws + off) = (_Float16)(o[0][r] * rl4[i]); *(_Float16*)(ws + off + 64u) = (_Float16)(o[1][r] * rl4[i]); } }
    }
#undef GT_TAKE
#undef GT_SBAR
#undef GT_PIN
#undef GT_KF
#undef GT_VF
#undef GT_MF
#undef GT_MOVE
}


__device__ __forceinline__ void own_unit(unsigned char* ws, int b, int h, int qb, LAS unsigned char* lds, int X, bool dry, int rg) {
    constexpr int ND = 4, G = 8;
    int tid_ = threadIdx.x; asm volatile("" : "+v"(tid_));
    const int tid = tid_, lane = tid & 63, r32 = lane & 31, hi = lane >> 5; const int wid = __builtin_amdgcn_readfirstlane(tid >> 6);
    const int bh = b * 8 + h, nt = (rg >> 1) + 1; const bool odd = rg & 1; const int qw0 = qb * 256 + rg * 32;
    const _Float16* Qg = (const _Float16*)(ws + WS_QMB) + ((size_t)b * SEQ + qw0) * 512 + h * 64;
    LAS unsigned char* kfb = lds + X * GBUF; LAS unsigned char* vfb = kfb + G_V;
    LAS float* wsf = (LAS float*)(lds + G_WS) + wid * 128;
    const int vro = ((lane >> 4) & 1) * 32 + (lane & 3) * 8 + (4 * hi + ((lane & 15) >> 2)) * 64;
    const int dl = r32 - 4 * hi;
#define GT_SBAR() __builtin_amdgcn_sched_barrier(0)
#define GT_PIN(x) asm volatile("" : "+v"(x))
#define GT_KF(buf, g) (*(const LAS h8*)(kfb + (buf) * 8192 + kaddr<64>(32 * ((g) & 1) + r32, 2 * ((g) >> 1) + hi)))
#define GT_VF(buf, i) (vfb + (buf) * 8192 + vro + ((i) >> 2) * 4096 + ((i) & 3) * 1024)
#define GT_MF(a, b, c) __builtin_amdgcn_mfma_f32_32x32x16_f16(a, b, c, 0, 0, 0)
#define GT_MOVE(P0, P1, PM) do { const bool move_ = init ? ((PM) > THR) : ((PM) > -INFINITY); \
        if (__any(move_)) { const float dl_ = move_ ? (init ? fmaxf((PM), 0.f) : (PM)) : 0.f; const float al_ = (move_ && init) ? __builtin_amdgcn_exp2f(-dl_) : 1.f; \
            init = init || move_; l_reg *= al_; \
            _Pragma("unroll") for (int r_ = 0; r_ < 16; ++r_) { P0[r_] -= dl_; P1[r_] -= dl_; negm[r_] -= dl_; } \
            if (hi == 0) wsf[r32] = al_; asm volatile("s_waitcnt lgkmcnt(0)" ::: "memory"); \
            _Pragma("unroll") for (int r_ = 0; r_ < 16; ++r_) { const float a_ = wsf[crow(r_, hi)]; o[0][r_] *= a_; o[1][r_] *= a_; } } } while (0)
#define GT_MASK(P0, P1) do { _Pragma("unroll") for (int r_ = 0; r_ < 16; ++r_) { const bool dg_ = ((r_ & 3) + 8 * (r_ >> 2)) > dl; \
            if (!odd) { if (dg_) P0[r_] = -INFINITY; P1[r_] = -INFINITY; } else { if (dg_) P1[r_] = -INFINITY; } } } while (0)
    h8 qr[ND];
#pragma unroll
    for (int d0 = 0; d0 < ND; ++d0) qr[d0] = *(const h8*)(Qg + (size_t)r32 * 512 + d0 * 16 + hi * 8);
#pragma unroll
    for (int d0 = 0; d0 < ND; ++d0) asm volatile("" : "+v"(qr[d0]));
    float l_reg = 0.f; bool init = false; f16v o[2]; o[0] = f16v{}; o[1] = f16v{}; f16v negm = f16v{}; asm volatile("" : "+v"(negm));
    f16v pC0, pC1, pD0, pD1;
    {
        h8 kf_[G];
#pragma unroll
        for (int g_ = 0; g_ < G; ++g_) kf_[g_] = GT_KF(0, g_);
        GT_SBAR();
#pragma unroll
        for (int d_ = 0; d_ < ND; ++d_) { pC0 = GT_MF(kf_[2 * d_], qr[d_], d_ == 0 ? negm : pC0); pC1 = GT_MF(kf_[2 * d_ + 1], qr[d_], d_ == 0 ? negm : pC1); }
        asm volatile("s_nop 15\n\ts_nop 7" : "+v"(pC0), "+v"(pC1));
        if (nt == 1) GT_MASK(pC0, pC1);
        float pa_ = max3f(pC0[0], pC0[1], pC1[0]), pb_ = max3f(pC0[2], pC0[3], pC1[1]); pa_ = max3f(pa_, pC1[2], pC1[3]);
#pragma unroll
        for (int r_ = 4; r_ < 16; r_ += 4) { pa_ = max3f(pa_, pC0[r_], pC0[r_ + 1]); pb_ = max3f(pb_, pC0[r_ + 2], pC0[r_ + 3]); pa_ = max3f(pa_, pC1[r_], pC1[r_ + 1]); pb_ = max3f(pb_, pC1[r_ + 2], pC1[r_ + 3]); }
        const float pm = swapmax(fmaxf(pa_, pb_)); GT_MOVE(pC0, pC1, pm);
    }
    auto gstep = [&](f16v& pC0, f16v& pC1, f16v& pN0, f16v& pN1, const int t, auto hn, const bool mk) __attribute__((always_inline)) {
        constexpr bool hasn = decltype(hn)::value;
        float ps = 0.f; f2v ps2 = (f2v){0.f, 0.f};
        if (hasn) {
            h8 kf[G];
#pragma unroll
            for (int g_ = 0; g_ < 4; ++g_) kf[g_] = GT_KF(t + 1, g_);
            GT_SBAR();
#pragma unroll
            for (int g_ = 0; g_ < G; ++g_) {
                if (g_ + 4 < G) kf[g_ + 4] = GT_KF(t + 1, g_ + 4);
                if (g_ & 1) pN1 = GT_MF(kf[g_], qr[g_ >> 1], g_ == 1 ? negm : pN1); else pN0 = GT_MF(kf[g_], qr[g_ >> 1], g_ == 0 ? negm : pN0);
#pragma unroll
                for (int e = 4 * g_; e < 4 * g_ + 4; ++e) { if (e < 16) { pC0[e] = __builtin_amdgcn_exp2f(pC0[e]); ps += pC0[e]; } else { pC1[e - 16] = __builtin_amdgcn_exp2f(pC1[e - 16]); ps += pC1[e - 16]; } }
                GT_PIN(pC0); GT_PIN(pC1); GT_PIN(ps); GT_SBAR();
            }
        } else {
#pragma unroll
            for (int r = 0; r < 16; ++r) { pC0[r] = __builtin_amdgcn_exp2f(pC0[r]); pC1[r] = __builtin_amdgcn_exp2f(pC1[r]); ps += pC0[r] + pC1[r]; }
        }
        l_reg += swapsum(ps);
        u4 pw[4];
#pragma unroll
        for (int k_ = 0; k_ < 2; ++k_) {
            pw[k_] = (u4){pkh(pC0[8 * k_], pC0[8 * k_ + 1]), pkh(pC0[8 * k_ + 2], pC0[8 * k_ + 3]), pkh(pC0[8 * k_ + 4], pC0[8 * k_ + 5]), pkh(pC0[8 * k_ + 6], pC0[8 * k_ + 7])};
            pw[2 + k_] = (u4){pkh(pC1[8 * k_], pC1[8 * k_ + 1]), pkh(pC1[8 * k_ + 2], pC1[8 * k_ + 3]), pkh(pC1[8 * k_ + 4], pC1[8 * k_ + 5]), pkh(pC1[8 * k_ + 6], pC1[8 * k_ + 7])}; }
        s4 vlo[8], vhi[8]; float pa = 0.f, pb = 0.f;
#pragma unroll
        for (int i = 0; i < 3; ++i) { vlo[i] = vtr(GT_VF(t, i)); vhi[i] = vtr(GT_VF(t, i) + 512); }
        if (hasn) { asm volatile("s_nop 7" : "+v"(pN0), "+v"(pN1)); if (mk) GT_MASK(pN0, pN1); }
        GT_SBAR();
#pragma unroll
        for (int i = 0; i < 8; ++i) {
            if (i + 3 < 8) { vlo[i + 3] = vtr(GT_VF(t, i + 3)); vhi[i + 3] = vtr(GT_VF(t, i + 3) + 512); }
            const s8 vv = (s8){vlo[i][0], vlo[i][1], vlo[i][2], vlo[i][3], vhi[i][0], vhi[i][1], vhi[i][2], vhi[i][3]};
            o[i >> 2] = GT_MF(__builtin_bit_cast(h8, pw[i & 3]), __builtin_bit_cast(h8, vv), o[i >> 2]);
            if (hasn) {
                if (i == 0) { pa = max3f(pN0[0], pN0[1], pN1[0]); pb = max3f(pN0[2], pN0[3], pN1[1]); }
                else if (i == 1) { pa = max3f(pa, pN1[2], pN1[3]); pb = max3f(pb, pN0[6], pN0[7]); }
                else if (i == 2) { pa = max3f(pa, pN0[4], pN0[5]); pb = max3f(pb, pN1[6], pN1[7]); }
                else if (i == 3) { pa = max3f(pa, pN1[4], pN1[5]); pb = max3f(pb, pN0[10], pN0[11]); }
                else if (i == 4) { pa = max3f(pa, pN0[8], pN0[9]); pb = max3f(pb, pN1[10], pN1[11]); }
                else if (i == 5) { pa = max3f(pa, pN1[8], pN1[9]); pb = max3f(pb, pN0[14], pN0[15]); }
                else if (i == 6) { pa = max3f(pa, pN0[12], pN0[13]); pb = max3f(pb, pN1[14], pN1[15]); }
                else { pa = max3f(pa, pN1[12], pN1[13]); }
                GT_PIN(pa); GT_PIN(pb);
            }
            GT_SBAR();
        }
        if (hasn) { const float pm = swapmax(fmaxf(pa, pb)); GT_MOVE(pN0, pN1, pm); }
    };
    for (int t = 0; t < nt - 1; ++t) { gstep(pC0, pC1, pD0, pD1, t, T1{}, t + 2 == nt); pC0 = pD0; pC1 = pD1; }
    gstep(pC0, pC1, pD0, pD1, nt - 1, T0{}, false);
    if (hi == 0) { wsf[32 + r32] = 1.f / l_reg; wsf[64 + r32] = l_reg; wsf[r32] = -negm[0]; }
    int lane_e = lane; asm volatile("" : "+v"(lane_e));
    const int row8 = lane_e >> 3, ch = lane_e & 7, nsl = qb < 3 ? qb : 3;
    unsigned char* zbu = (unsigned char*)((_Float16*)(ws + WS_ZCAT) + 512 + ((size_t)b * SEQ + qw0) * 1024 + h * 64);
    h8 zz[4], po[4][3]; float2 ml[4][3];
#pragma unroll
    for (int k = 0; k < 4; ++k) { const int row = 8 * k + row8; const unsigned gr = (unsigned)(bh * 4096 + qw0 + row);
        zz[k] = *(const h8*)(zbu + (unsigned)(row * 1024 + ch * 8) * 2u);
#pragma unroll
        for (int s = 0; s < 3; ++s) if (s < nsl) { ml[k][s] = ((const float2*)(ws + WS_ML))[(unsigned)s * 524288u + gr]; po[k][s] = *(const h8*)(ws + opart_off(s) + gr * 128u + (unsigned)ch * 16u); } }
    asm volatile("s_waitcnt lgkmcnt(0)" ::: "memory");
    LAS _Float16* stg = (LAS _Float16*)(lds + G_ST) + wid * 512;
#pragma unroll
    for (int k = 0; k < 4; ++k) {
        typedef float f4e __attribute__((ext_vector_type(4)));
        const f4e rl4 = *(const LAS f4e*)(wsf + 32 + 8 * k + 4 * hi);
#pragma unroll
        for (int i = 0; i < 4; ++i) { stg[(4 * hi + i) * 64 + r32] = (_Float16)(o[0][4 * k + i] * rl4[i]); stg[(4 * hi + i) * 64 + 32 + r32] = (_Float16)(o[1][4 * k + i] * rl4[i]); }
        asm volatile("s_waitcnt lgkmcnt(0)" ::: "memory");
        const int row = 8 * k + row8; const h8 v = *(const LAS h8*)(stg + row8 * 64 + ch * 8);
        const float m_own = wsf[row], l_own = wsf[64 + row]; float M = m_own;
#pragma unroll
        for (int s = 0; s < 3; ++s) if (s < nsl) M = fmaxf(M, ml[k][s].x);
        const float w0 = l_own * __builtin_amdgcn_exp2f(m_own - M); float W = w0; float acc[8];
#pragma unroll
        for (int j = 0; j < 8; ++j) acc[j] = w0 * (float)v[j];
#pragma unroll
        for (int s = 0; s < 3; ++s) if (s < nsl) { const float w = ml[k][s].y * __builtin_amdgcn_exp2f(ml[k][s].x - M); W += w;
#pragma unroll
            for (int j = 0; j < 8; ++j) acc[j] = fmaf(w, (float)po[k][s][j], acc[j]); }
        const float rW = 1.f / W; h8 ov;
#pragma unroll
        for (int j = 0; j < 8; ++j) ov[j] = (_Float16)(acc[j] * rW * (float)zz[k][j]);
        if (!dry) *(h8*)(zbu + (unsigned)(row * 1024 + ch * 8) * 2u) = ov;
    }
#undef GT_SBAR
#undef GT_PIN
#undef GT_KF
#undef GT_VF
#undef GT_MF
#undef GT_MOVE
#undef GT_MASK
}

__device__ __forceinline__ void attn_phase(unsigned char* ws, LAS unsigned char* lds, int vb, int nvb) {
    const int vcu = (nvb % 8 == 0) ? (vb % 8) * (nvb / 8) + vb / 8 : vb; const int per = (1024 + nvb - 1) / nvb;
    for (int k = 0; k < per; ++k) {
        int it;
        if (nvb == 256) { const int xg = vcu >> 5, lw = vcu & 31; it = ((16 * xg + 4 * k + (lw >> 3)) << 3) | (lw & 7); }
        else { it = vcu * per + k; if (it >= 1024) break; }
        const int bh = it >> 3, pr = it & 7, b = bh >> 3, h = bh & 7;
        if (PROBE == 2) for (int uu = 0; uu < 2; ++uu) attn_unit<96, false, PROBE_ABL>(ws, b, h, uu ? 15 - pr : pr, lds, true);
        for (int uu = 0; uu < 2; ++uu) attn_unit<96, false>(ws, b, h, uu ? 15 - pr : pr, lds);
    }
    int nu = 0;
    for (int k = 0; k < per; ++k) { int it; if (nvb == 256) { const int xg = vcu >> 5, lw = vcu & 31; it = ((16 * xg + 4 * k + (lw >> 3)) << 3) | (lw & 7); } else { it = vcu * per + k; if (it >= 1024) break; } nu += 2; }
    auto unit_of = [&](int u, int& b, int& h, int& j) {
        const int k = u >> 1; int it; if (nvb == 256) { const int xg = vcu >> 5, lw = vcu & 31; it = ((16 * xg + 4 * k + (lw >> 3)) << 3) | (lw & 7); } else it = vcu * per + k;
        const int bh = it >> 3, pr = it & 7, rot = (bh >> 2) & 3; b = bh >> 3; h = bh & 7;
        const int sl = ((pr & 3) + rot) & 3; const int x = pr < 4 ? ((0x6170 >> (4 * sl)) & 15) : ((0x4352 >> (4 * sl)) & 15);
        j = (u & 1) ? 14 - x : x; return !((u & 1) && x == 7); };
    LAS unsigned* gc = (LAS unsigned*)(lds + G_CTL);
    int tid_g = threadIdx.x; asm volatile("" : "+v"(tid_g)); const int lane_g = tid_g & 63;
    for (int rep = 0; rep < (PROBE == 12 ? 2 : 1); ++rep)
    for (int u0 = 0; u0 < nu; u0 += 64) {
        const int nc = nu - u0 < 64 ? nu - u0 : 64;
        if (tid_g < 192) gc[tid_g] = 0u;
        { int b, h, j; if (unit_of(u0, b, h, j)) gather_dma(ws, b, h, j, lds, 0); if (nc > 1 && unit_of(u0 + 1, b, h, j)) gather_dma(ws, b, h, j, lds, 1); }
        asm volatile("s_waitcnt vmcnt(0)" ::: "memory"); __syncthreads();
        for (int uc = 0; uc < nc; ++uc) {
            int b, h, j; const bool ok = unit_of(u0 + uc, b, h, j);
            if (uc >= 2) while (((volatile LAS unsigned*)gc)[128 + uc] == 0u) __builtin_amdgcn_s_sleep(4);
            if (ok) gather_unit(ws, b, h, j, lds, uc & 1, gc + uc);
            unsigned n = 0u; if (lane_g == 0) n = __hip_atomic_fetch_add(gc + 64 + uc, 1u, __ATOMIC_RELAXED, __HIP_MEMORY_SCOPE_WORKGROUP);
            n = (unsigned)__builtin_amdgcn_readfirstlane((int)n) + 1u;
            if (n == 8u && uc + 2 < nc) { int b2, h2, j2;
                if (unit_of(u0 + uc + 2, b2, h2, j2)) { gather_dma_all(ws, b2, h2, j2, lds, uc & 1); asm volatile("s_waitcnt vmcnt(0)" ::: "memory"); }
                if (lane_g == 0) ((volatile LAS unsigned*)gc)[128 + uc + 2] = 1u; }
        }
        __syncthreads();
    }
}
template <bool DRY> __device__ __forceinline__ void attn_phase2_pass(unsigned char* ws, LAS unsigned char* lds, int vb, int nvb) {
    LAS unsigned* gc = (LAS unsigned*)(lds + G_CTL);
    int tid_g = threadIdx.x; asm volatile("" : "+v"(tid_g)); const int lane_g = tid_g & 63;
    const int nu = vb < 2048 ? (2048 - vb + nvb - 1) / nvb : 0;
    for (int u0 = 0; u0 < nu; u0 += 64) {
        const int nc = nu - u0 < 64 ? nu - u0 : 64;
        if (tid_g < 192) gc[tid_g] = 0u;
        { const int i0 = vb + u0 * nvb; gather_dma(ws, i0 >> 7, (i0 >> 4) & 7, i0 & 15, lds, 0); if (nc > 1) { const int i1 = i0 + nvb; gather_dma(ws, i1 >> 7, (i1 >> 4) & 7, i1 & 15, lds, 1); } }
        asm volatile("s_waitcnt vmcnt(0)" ::: "memory"); __syncthreads();
        for (int uc = 0; uc < nc; ++uc) {
            const int it = vb + (u0 + uc) * nvb;
            if (uc >= 2) while (((volatile LAS unsigned*)gc)[128 + uc] == 0u) __builtin_amdgcn_s_sleep(4);
            for (;;) { unsigned c = 0u; if (lane_g == 0) c = __hip_atomic_fetch_add(gc + uc, 1u, __ATOMIC_RELAXED, __HIP_MEMORY_SCOPE_WORKGROUP);
                c = (unsigned)__builtin_amdgcn_readfirstlane((int)c); if (c >= 8u) break;
                own_unit(ws, it >> 7, (it >> 4) & 7, it & 15, lds, uc & 1, DRY, 7 - (int)c); }
            unsigned n = 0u; if (lane_g == 0) n = __hip_atomic_fetch_add(gc + 64 + uc, 1u, __ATOMIC_RELAXED, __HIP_MEMORY_SCOPE_WORKGROUP);
            n = (unsigned)__builtin_amdgcn_readfirstlane((int)n) + 1u;
            if (n == 8u && uc + 2 < nc) { const int i2 = it + 2 * nvb; gather_dma_all(ws, i2 >> 7, (i2 >> 4) & 7, i2 & 15, lds, uc & 1); asm volatile("s_waitcnt vmcnt(0)" ::: "memory");
                if (lane_g == 0) ((volatile LAS unsigned*)gc)[128 + uc + 2] = 1u; }
        }
        __syncthreads();
    }
}
__device__ __forceinline__ void attn_phase2(unsigned char* ws, LAS unsigned char* lds, int vb, int nvb) {
    if (PROBE == 13) attn_phase2_pass<true>(ws, lds, vb, nvb);
    attn_phase2_pass<false>(ws, lds, vb, nvb);
}
}

constexpr int RING_BYTES = 131072, MISC_OFF = RING_BYTES + 320, LDS_BYTES = 147456;
constexpr int CW_BAR = 4096;

__global__ void __launch_bounds__(512, 2) mega(Params p) {
    extern __shared__ __attribute__((aligned(16))) unsigned char lds[];
    const int vb = blockIdx.x, nvb = gridDim.x, tid = threadIdx.x, lane = tid & 63, wave = tid >> 6;
    const int gtid = vb * 512 + tid, gsize = nvb * 512, gwave = vb * 8 + wave, nwaves = nvb * 8;
    volatile LAS unsigned* misc = (volatile LAS unsigned*)((LAS unsigned char*)lds + MISC_OFF);
    if (tid < 32) misc[tid] = 0u;
    __syncthreads();
    XcdBarrier bar = xcd_barrier_post((unsigned*)(p.ws + WS_CTL) + CW_BAR, misc + 8);
    LAS unsigned char* ldsl = (LAS unsigned char*)lds;
    { int t_ = threadIdx.x; asm volatile("" : "+v"(t_)); ph_prep(p, vb * 512 + t_, gsize, vb, nvb, ldsl); ph_weights(p, ldsl, vb * 8 + (t_ >> 6), nwaves, t_ >> 6, t_ & 63);
      if (PROBE == 10) ph_weights(p, ldsl, vb * 8 + (t_ >> 6), nwaves, t_ >> 6, t_ & 63);
      if (PROBE == 11) ph_tab(p, vb * 512 + t_, gsize); }
    xcd_barrier(bar);
    for (int rep4 = 0; rep4 < ((PROBE == 4 || PROBE == 6) ? 2 : 1); ++rep4) { int t_ = threadIdx.x; asm volatile("" : "+v"(t_)); ph_hnorm(p, vb * 8 + (t_ >> 6), nwaves, t_ & 63); }
    xcd_barrier(bar);
    {
        pg8::Gemm g{(const pg8::bf16_t*)(p.ws + WS_H), (const pg8::bf16_t*)(p.ws + WT_IN), M_, 5120, 1024}; pg8::StaticOrder S; S.init(M_, 5120, nvb, vb);
        for (int rep = (PROBE == 1 ? 1 : 0); rep >= 0; --rep) { pg8::EpiInF E{p.ws, p.b_merge, rep}; pg8::gemm_phase<pg8::EpiInF, pg8::StaticOrder, true, true>(ldsl, g, S, E); }
        if (PROBE == 5) { pg8::EpiNull E; pg8::gemm_phase<pg8::EpiNull, pg8::StaticOrder, true, true>(ldsl, g, S, E); }
    }
    xcd_barrier(bar);
    { int t_ = threadIdx.x; asm volatile("" : "+v"(t_)); att::ph_gate(p.ws, vb * 8 + (t_ >> 6), nwaves, t_ & 63); }
    for (int rep4 = 0; rep4 < ((PROBE == 4 || PROBE == 7) ? 2 : 1); ++rep4) {
        pg8::Gemm g{(const pg8::bf16_t*)(p.ws + WS_QLAT), (const pg8::bf16_t*)(p.ws + WT_UQ), M_, 768, 256}; pg8::StaticOrder S; S.init(M_, 768, nvb, vb);
        pg8::EpiUqF E{p.ws}; pg8::gemm_phase<pg8::EpiUqF, pg8::StaticOrder, true, true>(ldsl, g, S, E);
    }
    for (int rep4 = 0; rep4 < ((PROBE == 4 || PROBE == 7) ? 2 : 1); ++rep4) {
        pg8::Gemm g{(const pg8::bf16_t*)(p.ws + WS_KVL), (const pg8::bf16_t*)(p.ws + WT_UKV), M_, 1024, 128};     pg8::StaticOrder S; S.init(M_, 1024, nvb, vb);
        pg8::EpiUkvF E{p.ws}; pg8::gemm_phase<pg8::EpiUkvF, pg8::StaticOrder, true, true>(ldsl, g, S, E);
    }
    xcd_barrier(bar);
    att::attn_phase(p.ws, ldsl, vb, nvb);
    xcd_barrier(bar);
    att::attn_phase2(p.ws, ldsl, vb, nvb);
    xcd_barrier(bar);
    {
        pg8::Gemm g{(const pg8::bf16_t*)(p.ws + WS_ZCAT), (const pg8::bf16_t*)(p.ws + WT_OA), M_, 1024, 1024}; pg8::StaticOrder S; S.init(M_, 1024, nvb, vb);
        pg8::EpiYcatF E{p.ws}; pg8::gemm_phase<pg8::EpiYcatF, pg8::StaticOrder, true, true>(ldsl, g, S, E);
    }
    xcd_barrier(bar);
    for (int rep4 = 0; rep4 < ((PROBE == 4 || PROBE == 9) ? 2 : 1); ++rep4) {
        pg8::Gemm g{(const pg8::bf16_t*)(p.ws + WS_YM), (const pg8::bf16_t*)(p.ws + WT_OUT), M_, 1024, 1024}; pg8::StaticOrder S; S.init(M_, 1024, nvb, vb);
        pg8::EpiYF E{p.ws}; pg8::gemm_phase<pg8::EpiYF, pg8::StaticOrder, true, true>(ldsl, g, S, E);
    }
    xcd_barrier(bar);
    for (int rep4 = 0; rep4 < ((PROBE == 4 || PROBE == 9) ? 2 : 1); ++rep4) { int t_ = threadIdx.x; asm volatile("" : "+v"(t_)); ph_final(p, vb * 8 + (t_ >> 6), nwaves, t_ & 63); }
}

extern "C" void kernel_launch(void* const* d_in, const int* in_sizes, int n_in, void* d_out, int out_size, void* d_ws, size_t ws_size, hipStream_t stream) {
    if (n_in != 16 || out_size != M_ * DM || ws_size < WS_END) { fprintf(stderr, "kernel_launch: unexpected shapes (n_in %d, out %d, ws %zu)\n", n_in, out_size, ws_size); return; }
    Params p{};
    p.x = (const float*)d_in[0]; p.c = (const float*)d_in[1]; p.pos = (const int*)d_in[2]; p.w_ada = (const float*)d_in[3]; p.b_ada = (const float*)d_in[4];
    p.g_pre = (const float*)d_in[5]; p.g_post = (const float*)d_in[6]; p.w_in = (const float*)d_in[7]; p.g_q = (const float*)d_in[8]; p.w_uq = (const float*)d_in[9];
    p.g_kv = (const float*)d_in[10]; p.w_ukv = (const float*)d_in[11]; p.w_o_mla = (const float*)d_in[12]; p.w_o_moba = (const float*)d_in[13]; p.b_merge = (const float*)d_in[14]; p.w_out = (const float*)d_in[15];
    p.out = (float*)d_out; p.ws = (unsigned char*)d_ws;
    static int grid = 0;
    if (grid == 0) {
        int dev = 0, cus = 0, per_cu = 0;
        if (hipGetDevice(&dev) != hipSuccess || hipDeviceGetAttribute(&cus, hipDeviceAttributeMultiprocessorCount, dev) != hipSuccess) { fprintf(stderr, "kernel_launch: device query failed\n"); grid = -1; return; }
        if (hipFuncSetAttribute((const void*)mega, hipFuncAttributeMaxDynamicSharedMemorySize, LDS_BYTES) != hipSuccess) { fprintf(stderr, "kernel_launch: hipFuncSetAttribute failed\n"); grid = -1; return; }
        if (hipOccupancyMaxActiveBlocksPerMultiprocessor(&per_cu, (const void*)mega, 512, LDS_BYTES) != hipSuccess || per_cu < 1) { fprintf(stderr, "kernel_launch: occupancy query says %d\n", per_cu); }
        (void)hipGetLastError();
        grid = cus;
    }
    if (grid < 0) return;
    (void)hipMemsetAsync(d_ws, 0, ZERO_BYTES, stream);
    hipLaunchKernelGGL(mega, dim3(grid), dim3(512), LDS_BYTES, stream, p);
}
```

```cpp
#include <hip/hip_runtime.h>
#include <cstdio>
#ifndef PROBE
#define PROBE 0
#endif
#include <cstdint>

typedef _Float16 h16;
typedef _Float16 h16x4 __attribute__((ext_vector_type(4)));
typedef _Float16 h2n __attribute__((ext_vector_type(2)));

constexpr int NB = 16, SEQ = 4096, DM = 1024, M_ = NB * SEQ, NH = 8;
constexpr int D_IN = 5024;
constexpr int C_QLAT = 0, C_KVLAT = 256, C_KROPE = 384, C_ZMLA = 416, C_QMB = 928, C_KMB = 1440, C_VMB = 1952, C_ZMB = 2464, C_GA = 2976, C_GB = 4000;
constexpr float EPS = 1e-6f;
constexpr float LOG2E = 1.4426950408889634f;
constexpr float SC_MLA = 0.10206207261596577f * LOG2E;
constexpr float SC_MB = 0.125f * LOG2E;

constexpr size_t MiB = 1u << 20;
constexpr size_t WS_CTL = 0, WS_KMEAN = 512 * 1024, WS_SSQ = 1 * MiB, WS_SSQY = WS_SSQ + 2 * (size_t)M_ * 4, ZERO_BYTES = 2 * MiB;
constexpr size_t WS_MOD = WS_SSQ + 3 * (size_t)M_ * 4, WS_TAB = 4 * MiB, WS_WT = 20 * MiB;
constexpr size_t WS_H = 36 * MiB, WS_KN = 36 * MiB, WS_VM = 100 * MiB;
constexpr size_t WS_QLAT = 164 * MiB, WS_KVL = 196 * MiB, WS_KPE = 228 * MiB, WS_VMB = 232 * MiB;
constexpr size_t WS_QMB = 296 * MiB, WS_KMB = 360 * MiB, WS_ZCAT = 424 * MiB, WS_YM = 296 * MiB;
constexpr size_t WS_GA = 552 * MiB, WS_GB = 616 * MiB, WS_Y = 680 * MiB,     WS_QMLA = 808 * MiB, WS_LIST = 904 * MiB, WS_ML = 920 * MiB, WS_END = 936 * MiB;
constexpr size_t WS_CNT = 64 * 1024;
__device__ __forceinline__ unsigned opart_off(int slot) { return slot < 2 ? (unsigned)(WS_Y + (size_t)slot * 64 * MiB) : (unsigned)WS_QLAT; }

static_assert(WS_MOD + (size_t)NB * 3072 * 4 <= ZERO_BYTES, "MOD inside the zeroed region");
struct Params {
    const float *x, *c; const int* pos; const float *w_ada, *b_ada, *g_pre, *g_post, *w_in, *g_q, *w_uq, *g_kv, *w_ukv, *w_o_mla, *w_o_moba, *b_merge, *w_out;
    float* out; unsigned char* ws;
};

__device__ __forceinline__ float wave_sum(float v) {
#pragma unroll
    for (int o = 1; o < 64; o <<= 1) v += __shfl_xor(v, o);
    return v;
}
__device__ __forceinline__ float silu_f(float v) { return v / (1.f + __expf(-v)); }
__device__ __forceinline__ float sigmoid_f(float v) { return 1.f / (1.f + __expf(-v)); }

#define LAS __attribute__((address_space(3)))
__device__ void ph_tab(const Params& p, int gtid, int gsize);
__device__ void ph_prep(const Params& p, int gtid, int gsize, int vb, int nvb, LAS unsigned char* lds) {
    float* mod = (float*)(p.ws + WS_MOD);
    { const int tid = gtid - vb * 512; LAS float* sc = (LAS float*)lds; LAS float* part = (LAS float*)(lds + 65536);
      for (int i = tid; i < NB * DM; i += 512) { const float cv = p.c[i]; sc[i] = cv / (1.f + __expf(-cv)); }
      __syncthreads();
      for (int cg = vb; cg < 3072 / 12; cg += nvb) {
          if (tid < 384) { const int col = tid % 12, kc = tid / 12, j = cg * 12 + col, k0 = kc * 32;
              float w[32], acc[NB];
#pragma unroll
              for (int kk = 0; kk < 32; ++kk) w[kk] = p.w_ada[(size_t)(k0 + kk) * 3072 + j];
#pragma unroll
              for (int b = 0; b < NB; ++b) acc[b] = 0.f;
#pragma unroll
              for (int kk = 0; kk < 32; kk += 4) {
#pragma unroll
                  for (int b = 0; b < NB; ++b) { typedef float f4m __attribute__((ext_vector_type(4))); const f4m s4 = *(const LAS f4m*)(sc + b * DM + k0 + kk);
                      acc[b] = fmaf(s4.x, w[kk], acc[b]); acc[b] = fmaf(s4.y, w[kk + 1], acc[b]); acc[b] = fmaf(s4.z, w[kk + 2], acc[b]); acc[b] = fmaf(s4.w, w[kk + 3], acc[b]); } }
#pragma unroll
              for (int b = 0; b < NB; ++b) part[(kc * NB + b) * 12 + col] = acc[b]; }
          __syncthreads();
          if (tid < NB * 12) { const int b = tid / 12, c = tid % 12, j = cg * 12 + c; float s = p.b_ada[j];
#pragma unroll
              for (int kc = 0; kc < 32; ++kc) s += part[(kc * NB + b) * 12 + c];
              mod[b * 3072 + j] = s; }
          __syncthreads();
      } }
    ph_tab(p, gtid, gsize);
}
__device__ void ph_tab(const Params& p, int gtid, int gsize) {
    unsigned* tab = (unsigned*)(p.ws + WS_TAB);
    const int f = gtid & 31;
    const double c = exp2(-(double)f * (13.287712379549449 / 32.0)) * 0.15915494309189535;
    int ex; const double mant = frexp(c, &ex); const double c_hi_d = ldexp(rint(ldexp(mant, 11)), ex - 11);
    const float c_hi = (float)c_hi_d, c_lo = (float)(c - c_hi_d);
    for (int i = gtid; i < M_ * 32; i += gsize) {
        const float pos = (float)p.pos[i >> 5];
        float x = pos * c_hi; x = x - floorf(x); x = fmaf(pos, c_lo, x);
        typedef _Float16 h2t __attribute__((ext_vector_type(2))); h2t cs; cs[0] = (_Float16)__builtin_amdgcn_cosf(x); cs[1] = (_Float16)__builtin_amdgcn_sinf(x);
        tab[i] = __builtin_bit_cast(unsigned, cs);
    }
}

__device__ void ph_hnorm(const Params& p, int gwave, int nwaves, int lane) {
    constexpr int R = 4;
    typedef float f4 __attribute__((ext_vector_type(4)));
    const float* mod = (const float*)(p.ws + WS_MOD); h16* H = (h16*)(p.ws + WS_H);
    for (int m0 = R * gwave; m0 < M_; m0 += R * nwaves) {
        f4 v[R][4]; float ss[R];
#pragma unroll
        for (int r = 0; r < R; ++r) { const f4* xr = (const f4*)(p.x + (size_t)(m0 + r) * DM);
#pragma unroll
            for (int j = 0; j < 4; ++j) v[r][j] = __builtin_nontemporal_load(xr + lane + 64 * j); }
#pragma unroll
        for (int r = 0; r < R; ++r) { float s = 0.f;
#pragma unroll
            for (int j = 0; j < 4; ++j) s += (v[r][j][0] * v[r][j][0] + v[r][j][1] * v[r][j][1]) + (v[r][j][2] * v[r][j][2] + v[r][j][3] * v[r][j][3]);
            ss[r] = 1.f / sqrtf(wave_sum(s) * (1.f / DM) + EPS); }
        const int b = m0 >> 12;
#pragma unroll
        for (int j = 0; j < 4; ++j) {
            const int col = 4 * (lane + 64 * j);
            const float4 g = *(const float4*)(p.g_pre + col), sc = *(const float4*)(mod + b * 3072 + 1024 + col), sh = *(const float4*)(mod + b * 3072 + col);
            const float g0 = g.x * (1.f + sc.x), g1 = g.y * (1.f + sc.y), g2 = g.z * (1.f + sc.z), g3 = g.w * (1.f + sc.w);
#pragma unroll
            for (int r = 0; r < R; ++r) { const float rstd = ss[r]; const f4 x = v[r][j];
                h16x4 o; o[0] = (h16)(x[0] * rstd * g0 + sh.x); o[1] = (h16)(x[1] * rstd * g1 + sh.y); o[2] = (h16)(x[2] * rstd * g2 + sh.z); o[3] = (h16)(x[3] * rstd * g3 + sh.w);
                *(h16x4*)(H + (size_t)(m0 + r) * DM + col) = o; }
        }
    }
}

__device__ void ph_final(const Params& p, int gwave, int nwaves, int lane) {
    constexpr int R = 4; typedef float f4 __attribute__((ext_vector_type(4)));
    const float* mod = (const float*)(p.ws + WS_MOD); const h16* Y = (const h16*)(p.ws + WS_Y); const float* ssq = (const float*)(p.ws + WS_SSQY);
    for (int m0 = R * gwave; m0 < M_; m0 += R * nwaves) {
        const int b = m0 >> 12; h16x4 yv[R][4]; f4 xv[R][4]; float rs[R];
#pragma unroll
        for (int r = 0; r < R; ++r) { const h16x4* yr = (const h16x4*)(Y + (size_t)(m0 + r) * DM); const f4* xr = (const f4*)(p.x + (size_t)(m0 + r) * DM); rs[r] = ssq[m0 + r];
#pragma unroll
            for (int j = 0; j < 4; ++j) { yv[r][j] = yr[lane + 64 * j]; xv[r][j] = __builtin_nontemporal_load(xr + lane + 64 * j); } }
#pragma unroll
        for (int r = 0; r < R; ++r) rs[r] = 1.f / sqrtf(rs[r] * (1.f / DM) + EPS);
#pragma unroll
        for (int j = 0; j < 4; ++j) {
            const int col = 4 * (lane + 64 * j); const float4 g = *(const float4*)(p.g_post + col), gt = *(const float4*)(mod + b * 3072 + 2048 + col);
            const float g0 = g.x * gt.x, g1 = g.y * gt.y, g2 = g.z * gt.z, g3 = g.w * gt.w;
#pragma unroll
            for (int r = 0; r < R; ++r) { const h16x4 y = yv[r][j]; const f4 x = xv[r][j]; const float s = rs[r];
                f4 o; o[0] = x[0] + g0 * (float)y[0] * s; o[1] = x[1] + g1 * (float)y[1] * s; o[2] = x[2] + g2 * (float)y[2] * s; o[3] = x[3] + g3 * (float)y[3] * s;
                __builtin_nontemporal_store(o, (f4*)(p.out + (size_t)(m0 + r) * DM) + lane + 64 * j); }
        }
    }
}


#define XB_TMO      128
#define XB_XCNT(j)  (256  + 64 * (j))
#define XB_XSUB(j)  (1280 + 64 * (j))
#define XB_XGEN(j)  (2304 + 64 * (j))
#define XB_TOP      3328
#define XB_TOPGEN   3392
#define XCD_BAR_WORDS 3456
#define XB_SPIN_CAP (1u << 27)
__device__ __forceinline__ unsigned xb_ld(unsigned* p)              { return __hip_atomic_load(p, __ATOMIC_RELAXED, __HIP_MEMORY_SCOPE_AGENT); }
__device__ __forceinline__ unsigned xb_add(unsigned* p, unsigned v) { return __hip_atomic_fetch_add(p, v, __ATOMIC_RELAXED, __HIP_MEMORY_SCOPE_AGENT); }
__device__ __forceinline__ unsigned xb_xcc_id() { return (unsigned)__builtin_amdgcn_s_getreg((3 << 11) | 20) & 0xFu; }
#define XB_SPIN(cond, bar) do { unsigned _sp = 0; while (cond) { __builtin_amdgcn_s_sleep(1); \
    if ((++_sp & 255u) == 0u) { if (xb_ld(&(bar)[XB_TMO])) break; if (_sp > XB_SPIN_CAP) { atomicAdd(&(bar)[XB_TMO], 1u); break; } } } } while (0)
struct XcdBarrier { unsigned* bar; unsigned x; volatile LAS unsigned* st; };
__device__ __forceinline__ XcdBarrier xcd_barrier_post(unsigned* bar, volatile LAS unsigned* st) {
    XcdBarrier b; b.bar = bar; b.x = xb_xcc_id(); b.st = st;
    if (threadIdx.x == 0) (void)xb_add(&bar[XB_XCNT(b.x)], 1u);
    return b;
}
__device__ __forceinline__ void xcd_barrier_complete(unsigned* bar, unsigned x, unsigned& nloc, unsigned& nx) {
    const unsigned G = gridDim.x * gridDim.y * gridDim.z;
    unsigned sum, cnt, mine, sp = 0u;
    for (;;) {
        sum = 0u; cnt = 0u; mine = 0u;
#pragma unroll
        for (unsigned j = 0; j < 16; ++j) { const unsigned c = xb_ld(&bar[XB_XCNT(j)]); sum += c; cnt += (c > 0u) ? 1u : 0u; mine = (j == x) ? c : mine; }
        if (sum == G) break;
        __builtin_amdgcn_s_sleep(1);
        if ((++sp & 255u) == 0u) { if (xb_ld(&bar[XB_TMO])) break; if (sp > XB_SPIN_CAP) { atomicAdd(&bar[XB_TMO], 1u); break; } }
    }
    nloc = mine > 0u ? mine : 1u; nx = cnt > 0u ? cnt : 1u;
}
__device__ __forceinline__ void xcd_barrier(const XcdBarrier& b) {
    asm volatile("s_waitcnt vmcnt(0)" ::: "memory");
    __syncthreads();
    if (threadIdx.x == 0) {
        unsigned* bar = b.bar;
        __builtin_amdgcn_s_waitcnt(0);
        unsigned nloc = b.st[0], nx = b.st[1];
        if (nloc == 0u) { xcd_barrier_complete(bar, b.x, nloc, nx); b.st[0] = nloc; b.st[1] = nx; }
        const unsigned old = xb_add(&bar[XB_XSUB(b.x)], 1u);
        const unsigned gen = old / nloc;
        if (old + 1u == (gen + 1u) * nloc) {
            __builtin_amdgcn_fence(__ATOMIC_RELEASE, "agent");
            asm volatile("s_waitcnt vmcnt(0)" ::: "memory");
            const unsigned og = xb_add(&bar[XB_TOP], 1u);
            const unsigned tg = og / nx;
            if (og + 1u == (tg + 1u) * nx) xb_add(&bar[XB_TOPGEN], 1u);
            else XB_SPIN(xb_ld(&bar[XB_TOPGEN]) == tg, bar);
            __builtin_amdgcn_fence(__ATOMIC_ACQUIRE, "agent");
            xb_add(&bar[XB_XGEN(b.x)], 1u);
            asm volatile("s_waitcnt vmcnt(0)" ::: "memory");
        } else {
            XB_SPIN(xb_ld(&bar[XB_XGEN(b.x)]) == gen, bar);
            __builtin_amdgcn_fence(__ATOMIC_ACQUIRE, "agent");
            asm volatile("s_waitcnt vmcnt(0)" ::: "memory");
        }
    }
    __syncthreads();
}

namespace pg8 {
#define PG8_LAS __attribute__((address_space(3)))
typedef unsigned short bf16_t;
typedef _Float16 bf16x8 __attribute__((ext_vector_type(8)));
typedef float f32x4 __attribute__((ext_vector_type(4)));
typedef unsigned u32x4 __attribute__((ext_vector_type(4)));
constexpr int BM = 256, BK = 64, HALF = 128, HTB = HALF * BK * 2  , STAGE_BYTES = 8 * HTB, NXCD = 8, WGM = 8;

__host__ __device__ __forceinline__ int lds_byte(int r, int c) { const int st = (r >> 4) * 2 + (c >> 5), rr = r & 15, cc = c & 31, ob = rr * 64 + cc * 2; return st * 1024 + (ob ^ (((ob >> 9) & 1) << 5)); }
__host__ __device__ __forceinline__ void stage_rc(int b, int& R, int& C) { const int st = b / 1024, sb = b % 1024, swz = sb ^ (((sb >> 9) & 1) << 5); R = (st >> 1) * 16 + swz / 64; C = (st & 1) * 32 + (swz % 64) / 2; }
__host__ __device__ __forceinline__ int perm32(int rho) { const int n = rho >> 4, i = rho & 15; return 8 * (i >> 2) + 4 * n + (i & 3); }

struct Unit { int pm, pn; };
struct Gemm { const bf16_t* A; const bf16_t* Bt; int M, N, K; };

struct StaticOrder {
    int nM, nN, nwg, G, c;
    __host__ __device__ void init(int M, int N, int G_, int c_) { nM = M / BM; nN = N / BM; nwg = nM * nN; G = G_; c = c_; }
    __host__ __device__ bool next(int i, Unit& u) const {
        const long L = (long)i * G + c; if (L >= nwg) return false;
        int wgid = (int)L; { const int q = nwg / NXCD, r = nwg % NXCD, xcd = wgid % NXCD, off = wgid / NXCD; wgid = (xcd < r ? xcd * (q + 1) : r * (q + 1) + (xcd - r) * q) + off; }
        const int nig = WGM * nN, gid = wgid / nig, fm = gid * WGM, gsz = (nM - fm) < WGM ? (nM - fm) : WGM;
        u.pm = fm + ((wgid % nig) % gsz); u.pn = (wgid % nig) / gsz; return true;
    }
    __device__ __forceinline__ void a_ready(const Unit&) const {}
    __device__ __forceinline__ void done(const Unit&) const {}
};

template <class Epi, class Sched, bool ALIGN_EPI = false, bool SP2 = false>
__device__ __forceinline__ void gemm_phase(PG8_LAS unsigned char* lds, const Gemm g, const Sched& S, const Epi& E) {
    int tid_ = threadIdx.x; asm volatile("" : "+v"(tid_));
    const int tid = tid_, wid = __builtin_amdgcn_readfirstlane(tid >> 6), lane = tid & 63, wr = wid >> 2, wc = wid & 3, fr = lane & 15, fq = lane >> 4;
    const int K = g.K, nt = K / BK;
    unsigned voffA[2], voffB[2];
#pragma unroll
    for (int i = 0; i < 2; ++i) { int R, C; stage_rc(tid * 16 + i * 8192, R, C); const int Rb = Epi::PERM ? ((R & ~31) + perm32(R & 31)) : R;
        voffA[i] = (unsigned)(R * K + C) * 2u; voffB[i] = (unsigned)(Rb * K + C) * 2u; }
    const size_t kstep = (size_t)(BK * 2);
    const size_t hstep = (size_t)HALF * K * 2;
    const size_t tstep = 2 * hstep;
    const unsigned ldsw = (unsigned)wid * 1024u;
    const int aoff = lds_byte(wr * 64 + fr, fq * 8), boff = lds_byte(wc * 32 + fr, fq * 8);
#define PG8_SA(b, h) (((b) * 2 + (h)) * HTB)
#define PG8_SB(b, h) ((4 + (b) * 2 + (h)) * HTB)
#define PG8_STAGE(bufoff, gbase, voff) do { _Pragma("unroll") for (int _i = 0; _i < 2; ++_i) \
        __builtin_amdgcn_global_load_lds((const unsigned*)((const char*)(gbase) + (voff)[_i]), (PG8_LAS unsigned*)(lds + (bufoff) + ldsw + _i * 8192), 16, 0, 0); } while (0)
#define PG8_LDA(dst, b, h) do { _Pragma("unroll") for (int m = 0; m < 4; ++m) _Pragma("unroll") for (int k = 0; k < 2; ++k) dst[m][k] = *(const PG8_LAS bf16x8*)(lds + PG8_SA(b, h) + aoff + m * 2048 + k * 1024); } while (0)
#define PG8_LDB(dst, b, h) do { _Pragma("unroll") for (int n = 0; n < 2; ++n) _Pragma("unroll") for (int k = 0; k < 2; ++k) dst[n][k] = *(const PG8_LAS bf16x8*)(lds + PG8_SB(b, h) + boff + n * 2048 + k * 1024); } while (0)
#define PG8_MMA(ai, bj, At, Bt) do { __builtin_amdgcn_s_setprio(1); _Pragma("unroll") for (int m = 0; m < 4; ++m) _Pragma("unroll") for (int n = 0; n < 2; ++n) _Pragma("unroll") for (int k = 0; k < 2; ++k) \
        acc[ai][bj][m][n] = __builtin_amdgcn_mfma_f32_16x16x32_f16(Bt[n][k], At[m][k], acc[ai][bj][m][n], 0, 0, 0); __builtin_amdgcn_s_setprio(0); } while (0)
#define PG8_WAIT_V(n) asm volatile("s_waitcnt vmcnt(" #n ")" ::: "memory")
#define PG8_WAIT_L(n) asm volatile("s_waitcnt lgkmcnt(" #n ")" ::: "memory")
#define PG8_BAR __builtin_amdgcn_s_barrier()
#define PG8_SCHED __builtin_amdgcn_sched_barrier(0)
    Unit cur, nxt; int ui = 0;
    if (!S.next(0, cur)) return;
    f32x4 acc[2][2][4][2];
#pragma unroll
    for (int a = 0; a < 2; ++a)
#pragma unroll
        for (int b = 0; b < 2; ++b)
#pragma unroll
            for (int m = 0; m < 4; ++m)
#pragma unroll
                for (int n = 0; n < 2; ++n) acc[a][b][m][n] = (f32x4){0.f, 0.f, 0.f, 0.f};
    bf16x8 At[4][2], B0[2][2], B1[2][2];
    const char* cA = (const char*)g.A + (size_t)cur.pm * tstep; const char* cB = (const char*)g.Bt + (size_t)cur.pn * tstep;
    S.a_ready(cur);
    if constexpr (SP2) {
        PG8_STAGE(PG8_SB(0, 0), cB, voffB); PG8_STAGE(PG8_SB(0, 1), cB + hstep, voffB); PG8_STAGE(PG8_SA(0, 0), cA, voffA); PG8_STAGE(PG8_SA(0, 1), cA + hstep, voffA);
        if (wr == 1) PG8_BAR;
        PG8_WAIT_V(2); PG8_BAR;
        PG8_STAGE(PG8_SB(1, 0), cB + kstep, voffB); PG8_STAGE(PG8_SA(1, 0), cA + kstep, voffA); PG8_STAGE(PG8_SB(1, 1), cB + hstep + kstep, voffB);
        PG8_WAIT_V(6); PG8_BAR;
    } else {
        PG8_STAGE(PG8_SB(0, 0), cB, voffB); PG8_STAGE(PG8_SA(0, 0), cA, voffA); PG8_STAGE(PG8_SB(0, 1), cB + hstep, voffB); PG8_STAGE(PG8_SA(0, 1), cA + hstep, voffA);
        if (wr == 1) PG8_BAR;
        PG8_WAIT_V(4); PG8_BAR;
        PG8_STAGE(PG8_SB(1, 0), cB + kstep, voffB); PG8_STAGE(PG8_SA(1, 0), cA + kstep, voffA); PG8_STAGE(PG8_SB(1, 1), cB + hstep + kstep, voffB);
        PG8_WAIT_V(6); PG8_BAR;
    }
    for (;;) {
        const bool has_next = S.next(ui + 1, nxt);
        const char* nA = has_next ? (const char*)g.A + (size_t)nxt.pm * tstep : cA; const char* nB = has_next ? (const char*)g.Bt + (size_t)nxt.pn * tstep : cB;
#pragma nounroll
        for (int t = 0; t < nt; t += 2) {
            const bool last = (t == nt - 2);
            if constexpr (Epi::MID_T > 0) { if (t == Epi::MID_T) E.mid(acc, cur, wr, wc); }
            const char* a1 = cA + (size_t)(t + 1) * kstep;
            const char* a2 = last ? nA : cA + (size_t)(t + 2) * kstep; const char* b2 = last ? nB : cB + (size_t)(t + 2) * kstep;
            const char* a3 = a2 + kstep; const char* b3 = b2 + kstep;
            if (last && has_next) S.a_ready(nxt);
            if constexpr (SP2) {
            PG8_LDB(B0, 0, 0); PG8_LDB(B1, 0, 1); PG8_SCHED; PG8_LDA(At, 0, 0); PG8_STAGE(PG8_SA(1, 1), a1 + hstep, voffA);
            PG8_WAIT_V(8); PG8_WAIT_L(0); PG8_BAR; PG8_MMA(0, 0, At, B0); PG8_MMA(0, 1, At, B1); PG8_BAR; PG8_SCHED;
            PG8_LDA(At, 0, 1); PG8_STAGE(PG8_SB(0, 0), b2, voffB); PG8_STAGE(PG8_SB(0, 1), b2 + hstep, voffB); PG8_STAGE(PG8_SA(0, 0), a2, voffA);
            PG8_WAIT_V(8); PG8_WAIT_L(0); PG8_BAR; PG8_MMA(1, 0, At, B0); PG8_MMA(1, 1, At, B1); PG8_BAR; PG8_SCHED;
            PG8_LDB(B0, 1, 0); PG8_LDB(B1, 1, 1); PG8_SCHED; PG8_LDA(At, 1, 0); PG8_STAGE(PG8_SA(0, 1), a2 + hstep, voffA);
            PG8_WAIT_V(8); PG8_WAIT_L(0); PG8_BAR; PG8_MMA(0, 0, At, B0); PG8_MMA(0, 1, At, B1); PG8_BAR; PG8_SCHED;
            PG8_LDA(At, 1, 1); PG8_STAGE(PG8_SB(1, 0), b3, voffB); PG8_STAGE(PG8_SB(1, 1), b3 + hstep, voffB); PG8_STAGE(PG8_SA(1, 0), a3, voffA);
            PG8_WAIT_V(8); PG8_WAIT_L(0); PG8_BAR; PG8_MMA(1, 0, At, B0); PG8_MMA(1, 1, At, B1); PG8_BAR; PG8_SCHED;
            } else {
            PG8_LDB(B0, 0, 0); PG8_SCHED; PG8_LDA(At, 0, 0); PG8_STAGE(PG8_SA(1, 1), a1 + hstep, voffA);
            PG8_WAIT_L(8); PG8_BAR; PG8_WAIT_L(0); PG8_MMA(0, 0, At, B0); PG8_BAR; PG8_SCHED;
            PG8_LDB(B1, 0, 1); PG8_STAGE(PG8_SB(0, 0), b2, voffB);
            PG8_BAR; PG8_WAIT_L(0); PG8_MMA(0, 1, At, B1); PG8_BAR;
            PG8_LDA(At, 0, 1); PG8_STAGE(PG8_SA(0, 0), a2, voffA);
            PG8_BAR; PG8_WAIT_L(0); PG8_MMA(1, 0, At, B0); PG8_BAR; PG8_SCHED;
            PG8_STAGE(PG8_SB(0, 1), b2 + hstep, voffB);
            PG8_WAIT_V(6); PG8_BAR; PG8_MMA(1, 1, At, B1); PG8_BAR;
            PG8_LDB(B0, 1, 0); PG8_SCHED; PG8_LDA(At, 1, 0); PG8_STAGE(PG8_SA(0, 1), a2 + hstep, voffA);
            PG8_WAIT_L(8); PG8_BAR; PG8_WAIT_L(0); PG8_MMA(0, 0, At, B0); PG8_BAR; PG8_SCHED;
            PG8_LDB(B1, 1, 1); PG8_STAGE(PG8_SB(1, 0), b3, voffB);
            PG8_BAR; PG8_WAIT_L(0); PG8_MMA(0, 1, At, B1); PG8_BAR;
            PG8_LDA(At, 1, 1); PG8_STAGE(PG8_SA(1, 0), a3, voffA);
            PG8_BAR; PG8_WAIT_L(0); PG8_MMA(1, 0, At, B0); PG8_BAR; PG8_SCHED;
            PG8_STAGE(PG8_SB(1, 1), b3 + hstep, voffB);
            PG8_WAIT_V(6); PG8_BAR; PG8_MMA(1, 1, At, B1); PG8_BAR;
            }
        }
        if constexpr (ALIGN_EPI) { if (wr == 0) PG8_BAR; }
        if constexpr (!Epi::AFTER_DRAIN) { E(acc, cur, wr, wc, fr, fq); S.done(cur); }
        if (!has_next) break;
#pragma unroll
        for (int a = 0; a < 2; ++a)
#pragma unroll
            for (int b = 0; b < 2; ++b)
#pragma unroll
                for (int m = 0; m < 4; ++m)
#pragma unroll
                    for (int n = 0; n < 2; ++n) acc[a][b][m][n] = (f32x4){0.f, 0.f, 0.f, 0.f};
        cur = nxt; cA = nA; cB = nB; ++ui;
        if constexpr (ALIGN_EPI) { if (wr == 1) PG8_BAR; }
    }
    PG8_WAIT_V(0);
    if constexpr (!ALIGN_EPI) { if (wr == 0) PG8_BAR; }
    PG8_BAR;
    if constexpr (Epi::AFTER_DRAIN) { E.fused(acc, cur, wr, wc, fr, fq, lds, wid, lane); S.done(cur); }
#undef PG8_SA
#undef PG8_SB
#undef PG8_STAGE
#undef PG8_LDA
#undef PG8_LDB
#undef PG8_MMA
#undef PG8_WAIT_V
#undef PG8_WAIT_L
#undef PG8_BAR
#undef PG8_SCHED
}
typedef _Float16 h8v __attribute__((ext_vector_type(8)));
typedef unsigned u32x2 __attribute__((ext_vector_type(2)));
typedef _Float16 h2v __attribute__((ext_vector_type(2)));
__device__ __forceinline__ unsigned pk_h2(float lo, float hi) { h2v v; v[0] = (_Float16)lo; v[1] = (_Float16)hi; return __builtin_bit_cast(unsigned, v); }
__device__ __forceinline__ u32x4 pack8(const f32x4& a, const f32x4& b) { u32x4 w; w.x = pk_h2(a[0], a[1]); w.y = pk_h2(a[2], a[3]); w.z = pk_h2(b[0], b[1]); w.w = pk_h2(b[2], b[3]); return w; }
__device__ __forceinline__ float sigm1(float v) { return __builtin_amdgcn_rcpf(1.f + __builtin_amdgcn_exp2f(v * -1.4426950408889634f)); }
__device__ __forceinline__ float silu1(float v) { return v * sigm1(v); }
__device__ __forceinline__ f32x4 silu4(const f32x4& v) { return (f32x4){silu1(v[0]), silu1(v[1]), silu1(v[2]), silu1(v[3])}; }
__device__ __forceinline__ f32x4 sigm4(const f32x4& v) { return (f32x4){sigm1(v[0]), sigm1(v[1]), sigm1(v[2]), sigm1(v[3])}; }

#define PG8_OPAQUE(fr_, fq_) int lane_x; asm volatile("v_mbcnt_lo_u32_b32 %0, -1, 0\n\tv_mbcnt_hi_u32_b32 %0, -1, %0" : "=v"(lane_x)); const int frx = lane_x & 15, fqx = lane_x >> 4
__device__ __forceinline__ void st16(unsigned char* base, unsigned off, const u32x4& v) { *(u32x4*)(base + off) = v; }
__device__ __forceinline__ f32x4 ld16f(const unsigned char* base, unsigned off) { return *(const f32x4*)(base + off); }
__device__ __forceinline__ float ld4f(const unsigned char* base, unsigned off) { return *(const float*)(base + off); }
__device__ __forceinline__ h8v ld16h(const unsigned char* base, unsigned off) { return *(const h8v*)(base + off); }
__device__ __forceinline__ float sumsq8(const f32x4& a, const f32x4& b) { return (a[0] * a[0] + a[1] * a[1]) + (a[2] * a[2] + a[3] * a[3]) + (b[0] * b[0] + b[1] * b[1]) + (b[2] * b[2] + b[3] * b[3]); }
__device__ __forceinline__ void rope4(const f32x4& t1, const f32x4& t2, const u32x4& cs, f32x4& o1, f32x4& o2) {
#pragma unroll
    for (int j = 0; j < 4; ++j) { const unsigned wj = cs[j]; h2v w; __builtin_memcpy(&w, &wj, 4);
        const float c = (float)w[0], s = (float)w[1]; o1[j] = t1[j] * c - t2[j] * s; o2[j] = t2[j] * c + t1[j] * s; }
}
__device__ __forceinline__ u32x4 ld16u(const unsigned char* base, unsigned off) { return *(const u32x4*)(base + off); }

struct EpiInF {
    static constexpr bool PERM = true, AFTER_DRAIN = false; static constexpr int MID_T = 0;
    unsigned char* ws; const float* b_merge; int noatomic;
    template <bool ISQ> __device__ __forceinline__ void rope_tile(const f32x4 (&acc)[2][2][4][2], const Unit& u, int wr, int wc, int frx, int fqx) const {
        const int pn = u.pn; const unsigned row0 = (unsigned)(u.pm * 256 + wr * 64) + (unsigned)frx; const float sc = ISQ ? SC_MB : 1.f;
        unsigned char* dst = ws + (ISQ ? WS_QMB : WS_KMB); const unsigned char* tab = ws + WS_TAB;
        const unsigned o0 = row0 * 1024u + (((pn & 1) ? 256u : 0u) + 64u * wc + 8u * fqx) * 2u, t0 = row0 * 128u + 32u * fqx;
        f32x4 c1[2] = {{0.f, 0.f, 0.f, 0.f}, {0.f, 0.f, 0.f, 0.f}}, c2[2] = {{0.f, 0.f, 0.f, 0.f}, {0.f, 0.f, 0.f, 0.f}};
        u32x4 cs[2][4][2];
#pragma unroll
        for (int ai = 0; ai < 2; ++ai)
#pragma unroll
            for (int m = 0; m < 4; ++m) { const unsigned to = t0 + (unsigned)(ai * 128 + m * 16) * 128u; cs[ai][m][0] = ld16u(tab, to); cs[ai][m][1] = ld16u(tab, to + 16u); }
#pragma unroll
        for (int ai = 0; ai < 2; ++ai)
#pragma unroll
            for (int m = 0; m < 4; ++m) { const unsigned ro = o0 + (unsigned)(ai * 128 + m * 16) * 1024u;
                f32x4 o1[2], o2[2];
#pragma unroll
                for (int n = 0; n < 2; ++n) { rope4(acc[ai][0][m][n], acc[ai][1][m][n], cs[ai][m][n], o1[n], o2[n]);
                    if (!ISQ) { c1[n] += o1[n]; c2[n] += o2[n]; } }
                st16(dst, ro, pack8(o1[0] * sc, o1[1] * sc)); st16(dst, ro + 64u, pack8(o2[0] * sc, o2[1] * sc));
                if (!ISQ) asm volatile("" : "+v"(c1[0]), "+v"(c1[1]), "+v"(c2[0]), "+v"(c2[1])); }
        if (!ISQ) {
            float* km = (float*)(ws + WS_KMEAN) + (size_t)u.pm * 512 + ((pn & 1) ? 256 : 0) + 64 * wc + 8 * fqx;
#pragma unroll
            for (int n = 0; n < 2; ++n)
#pragma unroll
                for (int j = 0; j < 4; ++j) { float a = c1[n][j], b = c2[n][j];
#pragma unroll
                    for (int o = 1; o < 16; o <<= 1) { a += __shfl_xor(a, o); b += __shfl_xor(b, o); }
                    if (frx == 0 && !noatomic) { atomicAdd(km + 4 * n + j, a * (1.f / 256.f)); atomicAdd(km + 32 + 4 * n + j, b * (1.f / 256.f)); } }
        }
    }
    __device__ __forceinline__ void operator()(const f32x4 (&acc)[2][2][4][2], const Unit& u, int wr, int wc, int fr, int fq) const {
        PG8_OPAQUE(fr, fq);
        const int pn = u.pn; const unsigned row0 = (unsigned)(u.pm * 256 + wr * 64) + (unsigned)frx, cl = 32u * wc + 8u * fqx;
        if (pn == 0) {
            unsigned char* dst = ws + WS_QLAT; float* ssq = (float*)(ws + WS_SSQ); const unsigned o0 = row0 * 512u + cl * 2u;
#pragma unroll
            for (int ai = 0; ai < 2; ++ai)
#pragma unroll
                for (int m = 0; m < 4; ++m) { const unsigned ro = o0 + (unsigned)(ai * 128 + m * 16) * 512u; float s = 0.f;
#pragma unroll
                    for (int bj = 0; bj < 2; ++bj) { s += sumsq8(acc[ai][bj][m][0], acc[ai][bj][m][1]); st16(dst, ro + bj * 256u, pack8(acc[ai][bj][m][0], acc[ai][bj][m][1])); }
                    s += __shfl_xor(s, 16); s += __shfl_xor(s, 32);
                    if (fqx == 0 && !noatomic) atomicAdd(ssq + (row0 + ai * 128 + m * 16), s); }
        } else if (pn == 1) {
            unsigned char* kvl = ws + WS_KVL; unsigned char* kpe = ws + WS_KPE; float* ssq = (float*)(ws + WS_SSQ) + M_; const unsigned char* tab = ws + WS_TAB;
#pragma unroll
            for (int ai = 0; ai < 2; ++ai)
#pragma unroll
                for (int m = 0; m < 4; ++m) { const unsigned row = row0 + ai * 128 + m * 16;
                    if (wc < 2) { float s = 0.f;
#pragma unroll
                        for (int bj = 0; bj < 2; ++bj) { s += sumsq8(acc[ai][bj][m][0], acc[ai][bj][m][1]); st16(kvl, row * 256u + (bj * 64u + cl) * 2u, pack8(acc[ai][bj][m][0], acc[ai][bj][m][1])); }
                        s += __shfl_xor(s, 16); s += __shfl_xor(s, 32);
                        if (fqx == 0 && !noatomic) atomicAdd(ssq + row, s);
                    } else {
                        if (wc == 2 && fqx < 2) {
                            f32x4 o1[2], o2[2];
#pragma unroll
                            for (int n = 0; n < 2; ++n) { const unsigned to = row * 128u + (unsigned)(16 * fqx + 8 * n) * 4u; const u32x4 wa = ld16u(tab, to), wb = ld16u(tab, to + 16u);
                                rope4(acc[ai][0][m][n], acc[ai][1][m][n], (u32x4){wa[0], wa[2], wb[0], wb[2]}, o1[n], o2[n]); }
                            st16(kpe, row * 64u + 16u * fqx, pack8(o1[0], o1[1])); st16(kpe, row * 64u + 32u + 16u * fqx, pack8(o2[0], o2[1]));
                        }
                    }
                    asm volatile("" ::: "memory"); }
        } else if (pn < 4 || (pn >= 8 && pn < 12)) {
            const bool act = (pn < 4) || (pn >= 10); const unsigned pitch = act ? 2048u : 1024u;
            unsigned char* dst = ws + (act ? WS_ZCAT : WS_VMB); const unsigned o0 = row0 * pitch + ((pn >= 10 ? 512u : 0u) + ((pn & 1) ? 256u : 0u) + cl) * 2u;
#pragma unroll
            for (int ai = 0; ai < 2; ++ai)
#pragma unroll
                for (int m = 0; m < 4; ++m) { const unsigned ro = o0 + (unsigned)(ai * 128 + m * 16) * pitch;
#pragma unroll
                    for (int bj = 0; bj < 2; ++bj) { f32x4 a = acc[ai][bj][m][0], b = acc[ai][bj][m][1]; if (act) { a = silu4(a); b = silu4(b); }
                        st16(dst, ro + bj * 256u, pack8(a, b)); } }
        } else if (pn < 6) { rope_tile<true>(acc, u, wr, wc, frx, fqx);
        } else if (pn < 8) { rope_tile<false>(acc, u, wr, wc, frx, fqx);
        } else {
            const bool isa = pn < 16; unsigned char* dst = ws + (isa ? WS_GA : WS_GB); const unsigned cg = 256u * ((pn - 12) & 3) + cl;
            const unsigned char* bm = (const unsigned char*)(b_merge + (isa ? 0 : 1024)); const unsigned o0 = row0 * 1024u + cg;
            f32x4 bv[2][2];
#pragma unroll
            for (int bj = 0; bj < 2; ++bj)
#pragma unroll
                for (int n = 0; n < 2; ++n) bv[bj][n] = ld16f(bm, (cg + bj * 128u + 4u * n) * 4u);
#pragma unroll
            for (int ai = 0; ai < 2; ++ai)
#pragma unroll
                for (int m = 0; m < 4; ++m) { const unsigned ro = o0 + (unsigned)(ai * 128 + m * 16) * 1024u;
#pragma unroll
                    for (int bj = 0; bj < 2; ++bj) { const f32x4 a = sigm4(acc[ai][bj][m][0] + bv[bj][0]) * 255.f + 0.5f, b = sigm4(acc[ai][bj][m][1] + bv[bj][1]) * 255.f + 0.5f;
                        u32x2 w; w.x = (unsigned)a[0] | ((unsigned)a[1] << 8) | ((unsigned)a[2] << 16) | ((unsigned)a[3] << 24); w.y = (unsigned)b[0] | ((unsigned)b[1] << 8) | ((unsigned)b[2] << 16) | ((unsigned)b[3] << 24);
                        *(u32x2*)(dst + (ro + bj * 128u)) = w; } }
        }
    }
};
struct EpiNull {
    static constexpr bool PERM = true, AFTER_DRAIN = false; static constexpr int MID_T = 0;
    __device__ __forceinline__ void operator()(const f32x4 (&acc)[2][2][4][2], const Unit& u, int wr, int wc, int fr, int fq) const {
#pragma unroll
        for (int ai = 0; ai < 2; ++ai)
#pragma unroll
            for (int bj = 0; bj < 2; ++bj)
#pragma unroll
                for (int m = 0; m < 4; ++m) asm volatile("" :: "v"(acc[ai][bj][m][0]), "v"(acc[ai][bj][m][1]));
    }
};
struct EpiUqF {
    static constexpr bool PERM = true, AFTER_DRAIN = false; static constexpr int MID_T = 0;
    unsigned char* ws;
    __device__ __forceinline__ void operator()(const f32x4 (&acc)[2][2][4][2], const Unit& u, int wr, int wc, int fr, int fq) const {
        PG8_OPAQUE(fr, fq);
        const int pn = u.pn; const unsigned row0 = (unsigned)(u.pm * 256 + wr * 64) + (unsigned)frx; unsigned char* Q = ws + WS_QMLA; const unsigned char* ssq = ws + WS_SSQ; const unsigned char* tab = ws + WS_TAB;
        float rsv[2][4];
#pragma unroll
        for (int ai = 0; ai < 2; ++ai)
#pragma unroll
            for (int m = 0; m < 4; ++m) rsv[ai][m] = ld4f(ssq, (row0 + ai * 128 + m * 16) * 4u);
#pragma unroll
        for (int ai = 0; ai < 2; ++ai)
#pragma unroll
            for (int m = 0; m < 4; ++m) { const unsigned row = row0 + ai * 128 + m * 16; const float rs = SC_MLA * __builtin_amdgcn_rsqf(rsv[ai][m] * (1.f / 256.f) + EPS);
                if (pn < 2) {
#pragma unroll
                    for (int bj = 0; bj < 2; ++bj) { const unsigned head = 4u * pn + 2u * bj + (wc >> 1), d = 32u * (wc & 1) + 8u * fqx;
                        st16(Q, row * 1536u + (96u * head + d) * 2u, pack8(acc[ai][bj][m][0] * rs, acc[ai][bj][m][1] * rs)); }
                } else { const unsigned head = 2u * wc + ((unsigned)fqx >> 1), i0 = 8u * (fqx & 1); f32x4 o1[2], o2[2];
#pragma unroll
                    for (int n = 0; n < 2; ++n) { const unsigned to = row * 128u + (2u * (i0 + 4u * n)) * 4u; const u32x4 wa = ld16u(tab, to), wb = ld16u(tab, to + 16u);
                        rope4(acc[ai][0][m][n] * rs, acc[ai][1][m][n] * rs, (u32x4){wa[0], wa[2], wb[0], wb[2]}, o1[n], o2[n]); }
                    st16(Q, row * 1536u + (96u * head + 64u + i0) * 2u, pack8(o1[0], o1[1])); st16(Q, row * 1536u + (96u * head + 80u + i0) * 2u, pack8(o2[0], o2[1])); } }
    }
};
struct EpiUkvF {
    static constexpr bool PERM = true, AFTER_DRAIN = false; static constexpr int MID_T = 0;
    unsigned char* ws;
    __device__ __forceinline__ void operator()(const f32x4 (&acc)[2][2][4][2], const Unit& u, int wr, int wc, int fr, int fq) const {
        PG8_OPAQUE(fr, fq);
        const int pn = u.pn; const unsigned row0 = (unsigned)(u.pm * 256 + wr * 64) + (unsigned)frx; unsigned char* dst = ws + (pn < 2 ? WS_KN : WS_VM); const unsigned char* ssq = ws + WS_SSQ + (size_t)M_ * 4;
        float rsv[2][4];
#pragma unroll
        for (int ai = 0; ai < 2; ++ai)
#pragma unroll
            for (int m = 0; m < 4; ++m) rsv[ai][m] = ld4f(ssq, (row0 + ai * 128 + m * 16) * 4u);
#pragma unroll
        for (int ai = 0; ai < 2; ++ai)
#pragma unroll
            for (int m = 0; m < 4; ++m) { const unsigned row = row0 + ai * 128 + m * 16; const float rs = __builtin_amdgcn_rsqf(rsv[ai][m] * (1.f / 128.f) + EPS);
#pragma unroll
                for (int bj = 0; bj < 2; ++bj) { const unsigned head = 4u * (pn & 1) + 2u * bj + (wc >> 1), d = 32u * (wc & 1) + 8u * fqx;
                    st16(dst, row * 1024u + (64u * head + d) * 2u, pack8(acc[ai][bj][m][0] * rs, acc[ai][bj][m][1] * rs)); } }
    }
};
struct EpiYcatF {
    static constexpr bool PERM = true, AFTER_DRAIN = false; static constexpr int MID_T = 8;
    unsigned char* ws;
    template <bool MID> __device__ __forceinline__ void run(f32x4 (&acc)[2][2][4][2], const Unit& u, int wr, int wc) const {
        PG8_OPAQUE(0, 0);
        const unsigned row0 = (unsigned)(u.pm * 256 + wr * 64) + (unsigned)frx, c0 = u.pn * 256u + 32u * wc + 8u * fqx, o0 = row0 * 2048u + c0 * 2u, g0 = row0 * 1024u + c0;
        const unsigned char* GA = ws + WS_GA; const unsigned char* GB = ws + WS_GB; unsigned char* YM = ws + WS_YM;
#pragma unroll
        for (int ai = 0; ai < 2; ++ai) {
            u32x2 ga[4][2], gb[4][2];
#pragma unroll
            for (int m = 0; m < 4; ++m)
#pragma unroll
                for (int bj = 0; bj < 2; ++bj) { const unsigned go = g0 + (unsigned)(ai * 128 + m * 16) * 1024u + bj * 128u; gb[m][bj] = *(const u32x2*)(GB + go); if (MID) ga[m][bj] = *(const u32x2*)(GA + go); }
#pragma unroll
            for (int m = 0; m < 4; ++m)
#pragma unroll
                for (int bj = 0; bj < 2; ++bj) { const unsigned off = o0 + (unsigned)(ai * 128 + m * 16) * 2048u + bj * 256u; f32x4 s0, s1;
#pragma unroll
                    for (int j = 0; j < 4; ++j) { const float b0 = fmaxf((float)((gb[m][bj].x >> (8 * j)) & 0xffu), 0.5f), b1 = fmaxf((float)((gb[m][bj].y >> (8 * j)) & 0xffu), 0.5f);
                        s0[j] = MID ? (float)((ga[m][bj].x >> (8 * j)) & 0xffu) * __builtin_amdgcn_rcpf(b0) : b0 * (1.f / 255.f);
                        s1[j] = MID ? (float)((ga[m][bj].y >> (8 * j)) & 0xffu) * __builtin_amdgcn_rcpf(b1) : b1 * (1.f / 255.f); }
                    acc[ai][bj][m][0] *= s0; acc[ai][bj][m][1] *= s1;
                    if (!MID) st16(YM, off, pack8(acc[ai][bj][m][0], acc[ai][bj][m][1])); }
            asm volatile("" ::: "memory"); }
    }
    __device__ __forceinline__ void mid(f32x4 (&acc)[2][2][4][2], const Unit& u, int wr, int wc) const { run<true>(acc, u, wr, wc); }
    __device__ __forceinline__ void operator()(f32x4 (&acc)[2][2][4][2], const Unit& u, int wr, int wc, int fr, int fq) const { run<false>(acc, u, wr, wc); }
};
struct EpiYF {
    static constexpr bool PERM = true, AFTER_DRAIN = false; static constexpr int MID_T = 0;
    unsigned char* ws;
    __device__ __forceinline__ void operator()(const f32x4 (&acc)[2][2][4][2], const Unit& u, int wr, int wc, int fr, int fq) const {
        PG8_OPAQUE(fr, fq);
        const unsigned row0 = (unsigned)(u.pm * 256 + wr * 64) + (unsigned)frx, c0 = u.pn * 256u + 32u * wc + 8u * fqx, o0 = row0 * 2048u + c0 * 2u; unsigned char* Y = ws + WS_Y; float* ssq = (float*)(ws + WS_SSQY);
#pragma unroll
        for (int ai = 0; ai < 2; ++ai)
#pragma unroll
            for (int m = 0; m < 4; ++m) { float s = 0.f;
#pragma unroll
                for (int bj = 0; bj < 2; ++bj) { s += sumsq8(acc[ai][bj][m][0], acc[ai][bj][m][1]); st16(Y, o0 + (unsigned)(ai * 128 + m * 16) * 2048u + bj * 256u, pack8(acc[ai][bj][m][0], acc[ai][bj][m][1])); }
                s += __shfl_xor(s, 16); s += __shfl_xor(s, 32);
                if (fqx == 0) atomicAdd(ssq + (row0 + ai * 128 + m * 16), s); }
    }
};
}

struct MapIn { __device__ int operator()(int n) const { const int t = n >> 8, tc = n & 255, bj = tc >> 7, uu = tc & 127;
    if (t == 0) return n;
    if (t == 1) return uu < 64 ? C_KVLAT + 64 * bj + uu : (uu < 80 ? C_KROPE + 16 * bj + (uu - 64) : -1);
    if (t < 4) return C_ZMLA + (n - 512);
    if (t < 8) return (t < 6 ? C_QMB : C_KMB) + 256 * (t & 1) + 64 * (uu >> 5) + 32 * bj + (uu & 31);
    if (t < 10) return C_VMB + (n - 2048);
    if (t < 12) return C_ZMB + (n - 2560);
    if (t < 16) return C_GA + (n - 3072);
    return C_GB + (n - 4096); } };
struct MapUq { __device__ int operator()(int n) const { const int t = n >> 8, tc = n & 255, bj = tc >> 7, uu = tc & 127;
    if (t < 2) return 96 * (4 * t + (tc >> 6)) + (tc & 63);
    return 96 * (uu >> 4) + 64 + 16 * bj + (uu & 15); } };
struct MapUkv { __device__ int operator()(int n) const { const int t = n >> 8, tc = n & 255; return 128 * (4 * (t & 1) + (tc >> 6)) + (t < 2 ? 0 : 64) + (tc & 63); } };
struct MapId { __device__ int operator()(int n) const { return n; } };
template <class Map> __device__ __forceinline__ void wt_items(const float* W, int ldw, int Kreal, int K, int N, unsigned short* WT, const float* kscale, Map map, LAS float* scr, int gw, int ngw, int lane, int ldk = 0, int koff = 0) {
    if (ldk == 0) ldk = K;
    const int nblk = N / 64, nitems = (K / 32) * nblk; typedef float f4 __attribute__((ext_vector_type(4)));
    for (int it = gw; it < nitems; it += ngw) {
        const int kb = it / nblk, nb = it % nblk, k0 = 32 * kb, n0 = 64 * nb; const int src = map(n0 + 4 * (lane & 15));
        f4 wv[8];
#pragma unroll
        for (int i = 0; i < 8; ++i) { const int k = k0 + 4 * i + (lane >> 4); wv[i] = (src >= 0 && k < Kreal) ? *(const f4*)(W + (size_t)k * ldw + src) : (f4){0.f, 0.f, 0.f, 0.f}; }
#pragma unroll
        for (int i = 0; i < 8; ++i) { const int kk = 4 * i + (lane >> 4), k = k0 + kk; f4 v = wv[i]; if (kscale && k < Kreal) v = v * kscale[k]; *(LAS f4*)(scr + kk * 68 + 4 * (lane & 15)) = v; }
        asm volatile("s_waitcnt lgkmcnt(0)" ::: "memory");
#pragma unroll
        for (int j = 0; j < 4; ++j) { const int q = lane + 64 * j, n = q >> 2, c = q & 3; const LAS float* s = scr + (8 * c) * 68 + n;
            pg8::u32x4 o; o.x = pg8::pk_h2(s[0 * 68], s[1 * 68]); o.y = pg8::pk_h2(s[2 * 68], s[3 * 68]); o.z = pg8::pk_h2(s[4 * 68], s[5 * 68]); o.w = pg8::pk_h2(s[6 * 68], s[7 * 68]);
            *(pg8::u32x4*)(WT + (size_t)(n0 + n) * ldk + koff + k0 + 8 * c) = o; }
        asm volatile("s_waitcnt lgkmcnt(0)" ::: "memory");
    }
}
constexpr size_t WT_IN = WS_WT, WT_UQ = WS_WT + 10 * MiB, WT_UKV = WT_UQ + 512 * 1024, WT_OA = WS_WT + 11 * MiB, WT_OB = WS_WT + 12 * MiB, WT_OUT = WS_WT + 13 * MiB;
__device__ __forceinline__ void ph_weights(const Params& p, LAS unsigned char* lds, int gw, int ngw, int wave, int lane) {
    LAS float* scr = (LAS float*)(lds + wave * 16384);
#define WT_ROT(off) ((gw + ngw - ((off) % ngw)) % ngw)
    wt_items(p.w_in, D_IN, 1024, 1024, 5120, (unsigned short*)(p.ws + WT_IN), nullptr, MapIn(), scr, gw, ngw, lane);
    wt_items(p.w_uq, 768, 256, 256, 768, (unsigned short*)(p.ws + WT_UQ), p.g_q, MapUq(), scr, WT_ROT(2560), ngw, lane);
    wt_items(p.w_ukv, 1024, 128, 128, 1024, (unsigned short*)(p.ws + WT_UKV), p.g_kv, MapUkv(), scr, WT_ROT(2656), ngw, lane);
    wt_items(p.w_o_mla, 1024, 512, 512, 1024, (unsigned short*)(p.ws + WT_OA), nullptr, MapId(), scr, WT_ROT(2720), ngw, lane, 1024, 0);
    wt_items(p.w_o_moba, 1024, 512, 512, 1024, (unsigned short*)(p.ws + WT_OA), nullptr, MapId(), scr, WT_ROT(2976), ngw, lane, 1024, 512);
    wt_items(p.w_out, 1024, 1024, 1024, 1024, (unsigned short*)(p.ws + WT_OUT), nullptr, MapId(), scr, WT_ROT(3232), ngw, lane);
#undef WT_ROT
}

namespace att {
struct T1 { static constexpr bool value = true; }; struct T0 { static constexpr bool value = false; };
typedef _Float16 h8 __attribute__((ext_vector_type(8)));
typedef short s4 __attribute__((ext_vector_type(4)));
typedef short s8 __attribute__((ext_vector_type(8)));
typedef float f16v __attribute__((ext_vector_type(16)));
typedef float f2v __attribute__((ext_vector_type(2)));
typedef unsigned u4 __attribute__((ext_vector_type(4)));
typedef short v4i16_t __attribute__((ext_vector_type(4)));
constexpr int KBUF = 16384, VBUF = 8192;
constexpr int NBUF = 4;
constexpr int L_K = 0, L_V = NBUF * KBUF, L_WS = L_V + NBUF * VBUF, L_TB = L_WS + 8 * 256, L_UN = L_TB + 256, L_END = L_UN + 64, L_OST = 0;
constexpr float THR = 8.f;
#ifndef PROBE_ABL
#define PROBE_ABL 0
#endif
#ifndef ATT_STAGGER
#define ATT_STAGGER 0
#endif
constexpr bool STAGGER = ATT_STAGGER;
__device__ __forceinline__ int crow(int r, int hi) { return (r & 3) + 8 * (r >> 2) + 4 * hi; }
template <int DK> __device__ __forceinline__ int kaddr(int row, int ch) { return DK == 64 ? row * 128 + ((ch ^ ((row >> 1) & 7)) << 4) : row * 256 + ((ch ^ (row & 15)) << 4); }
__device__ __forceinline__ s4 vtr(const LAS unsigned char* p) { return __builtin_bit_cast(s4, __builtin_amdgcn_ds_read_tr16_b64_v4i16((LAS v4i16_t*)p)); }
__device__ __forceinline__ float swapmax(float m) { auto rr = __builtin_amdgcn_permlane32_swap(__float_as_uint(m), __float_as_uint(m), false, false); return fmaxf(__uint_as_float(rr[0]), __uint_as_float(rr[1])); }
__device__ __forceinline__ float swapsum(float m) { auto rr = __builtin_amdgcn_permlane32_swap(__float_as_uint(m), __float_as_uint(m), false, false); return __uint_as_float(rr[0]) + __uint_as_float(rr[1]); }
__device__ __forceinline__ void glds16(const void* g, unsigned lds_base) { unsigned sv;
    asm volatile("s_mov_b32 %0, m0\n\ts_mov_b32 m0, %2\n\ts_nop 0\n\tglobal_load_lds_dwordx4 %1, off\n\ts_mov_b32 m0, %0" : "=&s"(sv) : "v"(g), "s"(lds_base) : "memory"); }
__device__ __forceinline__ float max3f(float a, float b, float c) { float r; asm("v_max3_f32 %0, %1, %2, %3" : "=v"(r) : "v"(a), "v"(b), "v"(c)); return r; }
__device__ __forceinline__ unsigned pkh(float lo, float hi) { typedef _Float16 h2 __attribute__((ext_vector_type(2))); h2 v; v[0] = (_Float16)lo; v[1] = (_Float16)hi; return __builtin_bit_cast(unsigned, v); }

template <int DK, bool MOBA, int ABL = 0, bool OWN = false>
__device__ __forceinline__ void attn_unit(unsigned char* ws, int b, int h, int qb, LAS unsigned char* lds, bool dry = false) {
    constexpr int ND = DK / 16, QP = MOBA ? 512 : 768, QH = MOBA ? 64 : 96;
    int tid_ = threadIdx.x; asm volatile("" : "+v"(tid_));
    const int tid = tid_, lane = tid & 63, r32 = lane & 31, hi = lane >> 5; const int wid = __builtin_amdgcn_readfirstlane(tid >> 6);
    const _Float16* Qg = (const _Float16*)(ws + (MOBA ? WS_QMB : WS_QMLA)); const _Float16* Kg = (const _Float16*)(ws + (MOBA ? WS_KMB : WS_KN));
    const _Float16* Vg = (const _Float16*)(ws + (MOBA ? WS_VMB : WS_VM)); const _Float16* Pg = (const _Float16*)(ws + WS_KPE); _Float16* Zg = (_Float16*)(ws + WS_ZCAT) + (MOBA ? 512 : 0);
    const size_t rowbase = (size_t)b * SEQ; const int q0 = qb * 256, qw0 = q0 + wid * 32, qrow = qw0 + r32;
    LAS float* wsf = (LAS float*)(lds + L_WS) + wid * 64; LAS int* tb = (LAS int*)(lds + L_TB); LAS unsigned* un = (LAS unsigned*)(lds + L_UN);
    h8 qr[ND];
#pragma unroll
    for (int d0 = 0; d0 < ND; ++d0) qr[d0] = *(const h8*)(Qg + (rowbase + qrow) * QP + h * QH + d0 * 16 + hi * 8);
#pragma unroll
    for (int d0 = 0; d0 < ND; ++d0) asm volatile("" : "+v"(qr[d0]));
    unsigned sel = 0u, blocks = OWN ? (1u << qb) : (2u << qb) - 1u;
    if (MOBA && !OWN) {
        const float* km = (const float*)(ws + WS_KMEAN) + (size_t)b * 16 * 512 + h * 64 + hi * 8;
        float g0 = -INFINITY, g1 = -INFINITY, g2 = -INFINITY; int i0 = -1, i1 = -1, i2 = -1;
        for (int m = 0; m < qb; ++m) {
            float part = 0.f;
#pragma unroll
            for (int d0 = 0; d0 < 4; ++d0) { const float4 a = *(const float4*)(km + m * 512 + d0 * 16), c = *(const float4*)(km + m * 512 + d0 * 16 + 4);
                part += (float)qr[d0][0] * a.x + (float)qr[d0][1] * a.y + (float)qr[d0][2] * a.z + (float)qr[d0][3] * a.w + (float)qr[d0][4] * c.x + (float)qr[d0][5] * c.y + (float)qr[d0][6] * c.z + (float)qr[d0][7] * c.w; }
            const float g = swapsum(part);
            if (g > g0) { g2 = g1; i2 = i1; g1 = g0; i1 = i0; g0 = g; i0 = m; }
            else if (g > g1) { g2 = g1; i2 = i1; g1 = g; i1 = m; }
            else if (g > g2) { g2 = g; i2 = m; }
        }
        if (i0 >= 0) sel |= 1u << i0; if (i1 >= 0) sel |= 1u << i1; if (i2 >= 0) sel |= 1u << i2;
        unsigned uw = sel;
#pragma unroll
        for (int o = 1; o < 64; o <<= 1) uw |= (unsigned)__shfl_xor((int)uw, o);
        if (lane == 0) un[wid] = uw;
        __syncthreads();
        unsigned ua = 0u;
#pragma unroll
        for (int w = 0; w < 8; ++w) ua |= un[w];
        blocks = (unsigned)__builtin_amdgcn_readfirstlane((int)(ua | (1u << qb)));
    }
    const int NT = OWN ? 4 : 4 * __builtin_popcount(blocks);
    if (tid < 64 && tid < NT) { unsigned bm = blocks; for (int k = 0; k < (tid >> 2); ++k) bm &= bm - 1u; tb[tid] = (__builtin_ctz(bm) << 8) + ((tid & 3) << 6); }
    __syncthreads();
    const unsigned char* kbu = (const unsigned char*)(Kg + rowbase * 512 + h * 64); const unsigned char* vbu = (const unsigned char*)(Vg + rowbase * 512 + h * 64); const unsigned char* pbu = (const unsigned char*)(Pg + rowbase * 32);
    const unsigned char* kb0; const unsigned char* kb1 = nullptr; unsigned ksrc0, ksrc1 = 0u, kst0 = 1024u, kst1 = 1024u;
    if (DK == 96) { const int r0 = 4 * wid + (lane >> 4), r1 = r0 + 32; int c0 = (lane & 15) ^ (r0 & 15), c1 = (lane & 15) ^ (r1 & 15); if (c0 >= 12) c0 -= 4; if (c1 >= 12) c1 -= 4;
        const bool kpe0 = c0 >= 8, kpe1 = c1 >= 8;
        kb0 = kpe0 ? pbu : kbu; kst0 = kpe0 ? 64u : 1024u; ksrc0 = kpe0 ? (unsigned)(r0 * 32 + (c0 - 8) * 8) * 2u : (unsigned)(r0 * 512 + c0 * 8) * 2u;
        kb1 = kpe1 ? pbu : kbu; kst1 = kpe1 ? 64u : 1024u; ksrc1 = kpe1 ? (unsigned)(r1 * 32 + (c1 - 8) * 8) * 2u : (unsigned)(r1 * 512 + c1 * 8) * 2u;
    } else { const int r0 = 8 * wid + (lane >> 3), c0 = (lane & 7) ^ ((r0 >> 1) & 7); kb0 = kbu; ksrc0 = (unsigned)(r0 * 512 + c0 * 8) * 2u; }
    const unsigned vsrc = (unsigned)((16 * (wid & 3) + (lane >> 2)) * 512 + (wid >> 2) * 32 + (lane & 3) * 8) * 2u;
    constexpr int NDMA = (DK == 96) ? 3 : 2;
#define ATT_GLDS(src, dst) glds16((const void*)(src), (unsigned)__builtin_amdgcn_readfirstlane((int)(unsigned)(size_t)(dst)))
#define ATT_DMA(kb, buf) do { const unsigned kb_ = (unsigned)(kb); LAS unsigned char* kd_ = lds + L_K + (buf) * KBUF; \
        ATT_GLDS(kb0 + (ksrc0 + kb_ * kst0), kd_ + wid * 1024); \
        if (DK == 96) ATT_GLDS(kb1 + (ksrc1 + kb_ * kst1), kd_ + 8192 + wid * 1024); \
        ATT_GLDS(vbu + (vsrc + kb_ * 1024u), lds + L_V + (buf) * VBUF + wid * 1024); } while (0)
#define ATT_WAITV(n) asm volatile("s_waitcnt vmcnt(" #n ")" ::: "memory")
#define ATT_BAR() do { asm volatile("s_waitcnt lgkmcnt(0)" ::: "memory"); __builtin_amdgcn_s_barrier(); asm volatile("" ::: "memory"); } while (0)
    const int vro = ((lane >> 4) & 1) * 32 + (lane & 3) * 8 + (4 * hi + ((lane & 15) >> 2)) * 64;
    LAS unsigned char* ldsv = lds + L_V + vro; asm volatile("" : "+v"(ldsv));
    float l_reg = 0.f; bool init = false; f16v o[2]; o[0] = f16v{}; o[1] = f16v{}; f16v negm = f16v{}; asm volatile("" : "+v"(negm));
    constexpr int G = 2 * ND;
#define ATT_SBAR() __builtin_amdgcn_sched_barrier(0)
#define ATT_PIN(x) asm volatile("" : "+v"(x))
#define ATT_KF(buf, g) (*(const LAS h8*)(lds + L_K + (buf) * KBUF + kaddr<DK>(32 * ((g) & 1) + r32, 2 * ((g) >> 1) + hi)))
#define ATT_MF(a, b, c) __builtin_amdgcn_mfma_f32_32x32x16_f16(a, b, c, 0, 0, 0)
#define ATT_QK(P0, P1, buf) do { h8 kf_[G]; _Pragma("unroll") for (int g_ = 0; g_ < G; ++g_) kf_[g_] = ATT_KF(buf, g_); ATT_SBAR(); \
        _Pragma("unroll") for (int d_ = 0; d_ < ND; ++d_) { P0 = ATT_MF(kf_[2 * d_], qr[d_], d_ == 0 ? negm : P0); P1 = ATT_MF(kf_[2 * d_ + 1], qr[d_], d_ == 0 ? negm : P1); } } while (0)
#define ATT_MAXCHAIN(P0, P1, PM) do { float pa_ = max3f(P0[0], P0[1], P1[0]), pb_ = max3f(P0[2], P0[3], P1[1]); pa_ = max3f(pa_, P1[2], P1[3]); \
        _Pragma("unroll") for (int r_ = 4; r_ < 16; r_ += 4) { pa_ = max3f(pa_, P0[r_], P0[r_ + 1]); pb_ = max3f(pb_, P0[r_ + 2], P0[r_ + 3]); pa_ = max3f(pa_, P1[r_], P1[r_ + 1]); pb_ = max3f(pb_, P1[r_ + 2], P1[r_ + 3]); } \
        PM = swapmax(fmaxf(pa_, pb_)); } while (0)
#define ATT_MOVE(P0, P1, PM) do { const bool move_ = init ? ((PM) > THR) : ((PM) > -INFINITY); \
        if (__any(move_)) { const float dl_ = move_ ? (init ? fmaxf((PM), 0.f) : (PM)) : 0.f; const float al_ = (move_ && init) ? __builtin_amdgcn_exp2f(-dl_) : 1.f; \
            init = init || move_; l_reg *= al_; \
            _Pragma("unroll") for (int r_ = 0; r_ < 16; ++r_) { P0[r_] -= dl_; P1[r_] -= dl_; negm[r_] -= dl_; } \
            if (hi == 0) wsf[r32] = al_; asm volatile("s_waitcnt lgkmcnt(0)" ::: "memory"); \
            _Pragma("unroll") for (int r_ = 0; r_ < 16; ++r_) { const float a_ = wsf[crow(r_, hi)]; o[0][r_] *= a_; o[1][r_] *= a_; } } } while (0)
#define ATT_PACK(P0, P1, PW, KEEP) do { _Pragma("unroll") for (int k_ = 0; k_ < 2; ++k_) { \
            PW[k_] = (u4){pkh(P0[8 * k_], P0[8 * k_ + 1]), pkh(P0[8 * k_ + 2], P0[8 * k_ + 3]), pkh(P0[8 * k_ + 4], P0[8 * k_ + 5]), pkh(P0[8 * k_ + 6], P0[8 * k_ + 7])}; \
            PW[2 + k_] = (u4){pkh(P1[8 * k_], P1[8 * k_ + 1]), pkh(P1[8 * k_ + 2], P1[8 * k_ + 3]), pkh(P1[8 * k_ + 4], P1[8 * k_ + 5]), pkh(P1[8 * k_ + 6], P1[8 * k_ + 7])}; } \
        if (MOBA) { _Pragma("unroll") for (int k_ = 0; k_ < 4; ++k_) PW[k_] &= (KEEP); } } while (0)
#define ATT_VF(buf, i) (ldsv + (buf) * VBUF + ((i) >> 2) * 4096 + ((i) & 3) * 1024)
#define ATT_WAIT_NEXT(t_) do { if ((t_) + 3 < NT) { if (NDMA == 3) ATT_WAITV(3); else ATT_WAITV(2); } else ATT_WAITV(0); } while (0)
#define ATT_TB(i) (MOBA ? tb[(i)] : 64 * (i))
    const int NF = OWN ? 0 : NT - 4;
    ATT_DMA(ATT_TB(0), 0); ATT_DMA(ATT_TB(1), 1); ATT_DMA(ATT_TB(2), 2);
    if (NDMA == 3) ATT_WAITV(3); else ATT_WAITV(2);
    ATT_BAR();
    f16v pC0, pC1;
    if (NF > 0) { ATT_QK(pC0, pC1, 0); asm volatile("s_nop 15\n\ts_nop 7" : "+v"(pC0), "+v"(pC1)); float pm; ATT_MAXCHAIN(pC0, pC1, pm);
        if (MOBA && !((sel >> (ATT_TB(0) >> 8)) & 1u)) pm = -INFINITY; ATT_MOVE(pC0, pC1, pm); }
    auto step = [&](f16v& pC0, f16v& pC1, f16v& pN0, f16v& pN1, const int t, auto hn) __attribute__((always_inline)) {
        const int cur = t & 3, nx = (t + 1) & 3; constexpr bool hasn = decltype(hn)::value;
        ATT_DMA(ATT_TB(t + 3), (t + 3) & 3);
        const unsigned keepC = (!MOBA || ((sel >> (ATT_TB(t) >> 8)) & 1u)) ? 0xffffffffu : 0u;
        float ps = 0.f; f2v ps2 = (f2v){0.f, 0.f};
        if (hasn) {
            h8 kf[G];
#pragma unroll
            for (int g = 0; g < 4; ++g) kf[g] = ATT_KF(nx, g);
            ATT_SBAR();
#pragma unroll
            for (int g = 0; g < G; ++g) {
                if (g + 4 < G) kf[g + 4] = ATT_KF(nx, g + 4);
                if (g & 1) pN1 = ATT_MF(kf[g], qr[g >> 1], g == 1 ? negm : pN1); else pN0 = ATT_MF(kf[g], qr[g >> 1], g == 0 ? negm : pN0);
                constexpr int dummy = 0; (void)dummy;
                const int e0 = (ND == 4) ? 4 * g : (g < 8 ? 3 * g : 24 + 2 * (g - 8)), e1 = (ND == 4) ? 4 * g + 4 : (g < 8 ? 3 * g + 3 : 26 + 2 * (g - 8));
#pragma unroll
                for (int e = e0; e < e1; ++e) { if (e < 16) pC0[e] = __builtin_amdgcn_exp2f(pC0[e]); else pC1[e - 16] = __builtin_amdgcn_exp2f(pC1[e - 16]);
                    if (e & 1) { if (e < 16) ps2 += (f2v){pC0[e - 1], pC0[e]}; else ps2 += (f2v){pC1[e - 17], pC1[e - 16]}; } }
                ATT_PIN(pC0); ATT_PIN(pC1); ATT_PIN(ps2); ATT_SBAR();
            }
        } else {
#pragma unroll
            for (int r = 0; r < 16; ++r) { pC0[r] = __builtin_amdgcn_exp2f(pC0[r]); pC1[r] = __builtin_amdgcn_exp2f(pC1[r]); ps += pC0[r] + pC1[r]; }
        }
        ps += ps2[0] + ps2[1];
        if (MOBA && !keepC) ps = 0.f;
        l_reg += swapsum(ps);
        u4 pw[4]; ATT_PACK(pC0, pC1, pw, keepC);
        {
            s4 vlo[8], vhi[8]; float pa = 0.f, pb = 0.f;
#pragma unroll
            for (int i = 0; i < 3; ++i) { vlo[i] = vtr(ATT_VF(cur, i)); vhi[i] = vtr(ATT_VF(cur, i) + 512); }
            if (hasn) asm volatile("s_nop 7" : "+v"(pN0), "+v"(pN1));
            ATT_SBAR();
#pragma unroll
            for (int i = 0; i < 8; ++i) {
                if (i + 3 < 8) { vlo[i + 3] = vtr(ATT_VF(cur, i + 3)); vhi[i + 3] = vtr(ATT_VF(cur, i + 3) + 512); }
                const s8 vv = (s8){vlo[i][0], vlo[i][1], vlo[i][2], vlo[i][3], vhi[i][0], vhi[i][1], vhi[i][2], vhi[i][3]};
                o[i >> 2] = ATT_MF(__builtin_bit_cast(h8, pw[i & 3]), __builtin_bit_cast(h8, vv), o[i >> 2]);
                if (hasn) {
                    if (i == 0) { pa = max3f(pN0[0], pN0[1], pN1[0]); pb = max3f(pN0[2], pN0[3], pN1[1]); }
                    else if (i == 1) { pa = max3f(pa, pN1[2], pN1[3]); pb = max3f(pb, pN0[6], pN0[7]); }
                    else if (i == 2) { pa = max3f(pa, pN0[4], pN0[5]); pb = max3f(pb, pN1[6], pN1[7]); }
                    else if (i == 3) { pa = max3f(pa, pN1[4], pN1[5]); pb = max3f(pb, pN0[10], pN0[11]); }
                    else if (i == 4) { pa = max3f(pa, pN0[8], pN0[9]); pb = max3f(pb, pN1[10], pN1[11]); }
                    else if (i == 5) { pa = max3f(pa, pN1[8], pN1[9]); pb = max3f(pb, pN0[14], pN0[15]); }
                    else if (i == 6) { pa = max3f(pa, pN0[12], pN0[13]); pb = max3f(pb, pN1[14], pN1[15]); }
                    else { pa = max3f(pa, pN1[12], pN1[13]); }
                    ATT_PIN(pa); ATT_PIN(pb);
                }
                ATT_SBAR();
            }
            if (hasn) { float pm = swapmax(fmaxf(pa, pb)); if (MOBA && !((sel >> (ATT_TB(t + 1) >> 8)) & 1u)) pm = -INFINITY; ATT_MOVE(pN0, pN1, pm); }
        }
        if (NDMA == 3) ATT_WAITV(3); else ATT_WAITV(2);
        ATT_BAR();
    };
    {
        f16v pD0, pD1; int t = 0;
        for (; t + 2 < NF; t += 2) { step(pC0, pC1, pD0, pD1, t, T1{}); step(pD0, pD1, pC0, pC1, t + 1, T1{}); }
        if (t + 1 < NF) { step(pC0, pC1, pD0, pD1, t, T1{}); step(pD0, pD1, pC0, pC1, t + 1, T0{}); }
        else if (t < NF) step(pC0, pC1, pD0, pD1, t, T0{});
    }
    for (int t = NF; t < NT; ++t) {
        const int cur = t & 3, kb = ATT_TB(t);
        if (t + 3 < NT) ATT_DMA(ATT_TB(t + 3), (t + 3) & 3);
        if (kb <= qw0 + 31) {
            f16v p0, p1; ATT_QK(p0, p1, cur);
            if (kb + 63 > qw0) {
#pragma unroll
                for (int r = 0; r < 16; ++r) { const int kv = kb + crow(r, hi); if (kv > qrow) p0[r] = -INFINITY; if (kv + 32 > qrow) p1[r] = -INFINITY; }
            }
            asm volatile("s_nop 15\n\ts_nop 7" : "+v"(p0), "+v"(p1));
            float pm; ATT_MAXCHAIN(p0, p1, pm); ATT_MOVE(p0, p1, pm);
            s4 vlo[8], vhi[8];
#pragma unroll
            for (int i = 0; i < 8; ++i) { vlo[i] = vtr(ATT_VF(cur, i)); vhi[i] = vtr(ATT_VF(cur, i) + 512); }
            ATT_SBAR();
            float ps = 0.f;
#pragma unroll
            for (int r = 0; r < 16; ++r) { p0[r] = __builtin_amdgcn_exp2f(p0[r]); p1[r] = __builtin_amdgcn_exp2f(p1[r]); ps += p0[r] + p1[r]; }
            l_reg += swapsum(ps);
            u4 pw[4]; ATT_PACK(p0, p1, pw, 0xffffffffu);
#pragma unroll
            for (int i = 0; i < 8; ++i) { const s8 vv = (s8){vlo[i][0], vlo[i][1], vlo[i][2], vlo[i][3], vhi[i][0], vhi[i][1], vhi[i][2], vhi[i][3]};
                o[i >> 2] = ATT_MF(__builtin_bit_cast(h8, pw[i & 3]), __builtin_bit_cast(h8, vv), o[i >> 2]); }
        }
        ATT_WAIT_NEXT(t);
        ATT_BAR();
    }
    if (hi == 0) { wsf[32 + r32] = l_reg; if (OWN) wsf[r32] = -negm[0]; } asm volatile("s_waitcnt lgkmcnt(0)" ::: "memory");
    LAS _Float16* stg = (LAS _Float16*)(lds + L_OST) + wid * 2048;
#pragma unroll
    for (int r = 0; r < 16; ++r) { const int orow = crow(r, hi); const float rl = 1.f / wsf[32 + orow];
        stg[orow * 64 + r32] = (_Float16)(o[0][r] * rl); stg[orow * 64 + 32 + r32] = (_Float16)(o[1][r] * rl); }
    asm volatile("s_waitcnt lgkmcnt(0)" ::: "memory");
    int lane_e = lane; asm volatile("" : "+v"(lane_e));
    unsigned char* zbu = (unsigned char*)(Zg + (rowbase + qw0) * 1024 + h * 64);
#pragma unroll
    for (int i = 0; i < 4; ++i) { const int row = i * 8 + (lane_e >> 3), ch = lane_e & 7; const h8 v = *(const LAS h8*)(stg + row * 64 + ch * 8);
        _Float16* zp = (_Float16*)(zbu + (unsigned)(row * 1024 + ch * 8) * 2u); const h8 z = *(const h8*)zp; h8 ov;
        if (OWN) {
            const int nsl = qb < 3 ? qb : 3; const unsigned gr = (unsigned)((b * 8 + h) * 4096 + qw0 + row);
            const float m_own = wsf[row], l_own = wsf[32 + row]; float M = m_own; float2 ml[3]; h8 po[3];
#pragma unroll
            for (int s = 0; s < 3; ++s) if (s < nsl) { ml[s] = ((const float2*)(ws + WS_ML))[(unsigned)s * 524288u + gr]; po[s] = *(const h8*)(ws + opart_off(s) + gr * 128u + (unsigned)ch * 16u); M = fmaxf(M, ml[s].x); }
            const float w0 = l_own * __builtin_amdgcn_exp2f(m_own - M); float W = w0; float acc[8];
#pragma unroll
            for (int j = 0; j < 8; ++j) acc[j] = w0 * (float)v[j];
#pragma unroll
            for (int s = 0; s < 3; ++s) if (s < nsl) { const float w = ml[s].y * __builtin_amdgcn_exp2f(ml[s].x - M); W += w;
#pragma unroll
                for (int j = 0; j < 8; ++j) acc[j] = fmaf(w, (float)po[s][j], acc[j]); }
            const float rW = 1.f / W;
#pragma unroll
            for (int j = 0; j < 8; ++j) ov[j] = (_Float16)(acc[j] * rW * (float)z[j]);
        } else {
#pragma unroll
            for (int j = 0; j < 8; ++j) ov[j] = (_Float16)((float)v[j] * (float)z[j]);
        }
        if (!dry) *(h8*)zp = ov; }
    __syncthreads();
#undef ATT_GLDS
#undef ATT_DMA
#undef ATT_WAITV
#undef ATT_BAR
#undef ATT_SBAR
#undef ATT_PIN
#undef ATT_KF
#undef ATT_MF
#undef ATT_QK
#undef ATT_MAXCHAIN
#undef ATT_MOVE
#undef ATT_PACK
#undef ATT_VF
#undef ATT_WAIT_NEXT
#undef ATT_TB
}


__device__ __forceinline__ void ph_gate(unsigned char* ws, int gw_, int ngw, int lane) {
    const int gw = __builtin_amdgcn_readfirstlane(gw_);
    unsigned* cnt = (unsigned*)(ws + WS_CNT); unsigned short* lists = (unsigned short*)(ws + WS_LIST);
    for (int k = 0; ; ++k) {
        const int s = (k & 1) ? (k + 1) * ngw - 1 - gw : k * ngw + gw;
        if (k * ngw >= 128 * 60) break;
        if (s >= 128 * 60) continue;
        const int qb = 15 - s / 512, rr = s & 511, bh = rr >> 2, ch = rr & 3, b = bh >> 3, h = bh & 7;
        const int row = qb * 256 + ch * 64 + lane;
        const _Float16* q = (const _Float16*)(ws + WS_QMB) + ((size_t)b * SEQ + row) * 512 + h * 64;
        h8 qv[8];
#pragma unroll
        for (int i = 0; i < 8; ++i) qv[i] = *(const h8*)(q + 8 * i);
        const float* km = (const float*)(ws + WS_KMEAN) + (size_t)b * 16 * 512 + h * 64;
        float g0 = -INFINITY, g1 = -INFINITY, g2 = -INFINITY; int i0 = -1, i1 = -1, i2 = -1;
        for (int m = 0; m < qb; ++m) {
            float s0 = 0.f, s1 = 0.f;
#pragma unroll
            for (int d = 0; d < 64; d += 2) { s0 = fmaf((float)qv[d >> 3][d & 7], km[m * 512 + d], s0); s1 = fmaf((float)qv[d >> 3][(d & 7) + 1], km[m * 512 + d + 1], s1); }
            const float g = s0 + s1;
            if (g > g0) { g2 = g1; i2 = i1; g1 = g0; i1 = i0; g0 = g; i0 = m; }
            else if (g > g1) { g2 = g1; i2 = i1; g1 = g; i1 = m; }
            else if (g > g2) { g2 = g; i2 = m; }
        }
        unsigned mycnt = 0u;
#pragma unroll
        for (int j = 0; j < 15; ++j) { const bool s = (i0 == j) | (i1 == j) | (i2 == j); const unsigned long long mk = __ballot(s); if (lane == j) mycnt = (unsigned)__popcll(mk); }
        unsigned basev = 0u; if (lane < 15 && mycnt) basev = atomicAdd(&cnt[bh * 16 + lane], mycnt);
#pragma unroll
        for (int j = 0; j < 15; ++j) { const bool s = (i0 == j) | (i1 == j) | (i2 == j); const unsigned long long mk = __ballot(s); const unsigned base = (unsigned)__builtin_amdgcn_readlane((int)basev, j);
            if (s) { const unsigned rank = (unsigned)__popcll(mk & ((1ull << lane) - 1ull)); const int slot = (i0 == j) ? 0 : ((i1 == j) ? 1 : 2);
                lists[(size_t)(bh * 16 + j) * 4096 + base + rank] = (unsigned short)(row | (slot << 12)); } }
    }
}

constexpr int GBUF = 65536, G_V = 32768, G_WS = 131072 + 1024, G_CTL = G_WS + 4096, G_ST = G_CTL + 768;
constexpr unsigned G_SINK = 256 * 1024;
__device__ __forceinline__ void gather_dma(unsigned char* ws, int b, int h, int j, LAS unsigned char* lds, int X) {
    int tid_ = threadIdx.x; asm volatile("" : "+v"(tid_)); const int lane = tid_ & 63; const int wid = __builtin_amdgcn_readfirstlane(tid_ >> 6);
    const size_t rowbase = (size_t)b * SEQ + j * 256;
    const unsigned char* kbu = (const unsigned char*)((const _Float16*)(ws + WS_KMB) + rowbase * 512 + h * 64); const unsigned char* vbu = (const unsigned char*)((const _Float16*)(ws + WS_VMB) + rowbase * 512 + h * 64);
    const int r0 = 8 * wid + (lane >> 3), c0 = (lane & 7) ^ ((r0 >> 1) & 7);
    const unsigned ksrc = (unsigned)(r0 * 512 + c0 * 8) * 2u, vsrc = (unsigned)((16 * (wid & 3) + (lane >> 2)) * 512 + (wid >> 2) * 32 + (lane & 3) * 8) * 2u;
    LAS unsigned char* lb = lds + X * GBUF + wid * 1024;
#pragma unroll
    for (int t = 0; t < 4; ++t) {
        glds16((const void*)(kbu + (ksrc + (unsigned)t * 65536u)), (unsigned)__builtin_amdgcn_readfirstlane((int)(unsigned)(size_t)(lb + t * 8192)));
        glds16((const void*)(vbu + (vsrc + (unsigned)t * 65536u)), (unsigned)__builtin_amdgcn_readfirstlane((int)(unsigned)(size_t)(lb + G_V + t * 8192))); }
}
__device__ __forceinline__ void gather_dma_all(unsigned char* ws, int b, int h, int j, LAS unsigned char* lds, int X) {
    int tid_ = threadIdx.x; asm volatile("" : "+v"(tid_)); const int lane = tid_ & 63;
    const size_t rowbase = (size_t)b * SEQ + j * 256;
    const unsigned char* kbu = (const unsigned char*)((const _Float16*)(ws + WS_KMB) + rowbase * 512 + h * 64); const unsigned char* vbu = (const unsigned char*)((const _Float16*)(ws + WS_VMB) + rowbase * 512 + h * 64);
    for (int w = 0; w < 8; ++w) {
        const int r0 = 8 * w + (lane >> 3), c0 = (lane & 7) ^ ((r0 >> 1) & 7);
        const unsigned ksrc = (unsigned)(r0 * 512 + c0 * 8) * 2u, vsrc = (unsigned)((16 * (w & 3) + (lane >> 2)) * 512 + (w >> 2) * 32 + (lane & 3) * 8) * 2u;
        LAS unsigned char* lb = lds + X * GBUF + w * 1024;
#pragma unroll
        for (int t = 0; t < 4; ++t) {
            glds16((const void*)(kbu + (ksrc + (unsigned)t * 65536u)), (unsigned)__builtin_amdgcn_readfirstlane((int)(unsigned)(size_t)(lb + t * 8192)));
            glds16((const void*)(vbu + (vsrc + (unsigned)t * 65536u)), (unsigned)__builtin_amdgcn_readfirstlane((int)(unsigned)(size_t)(lb + G_V + t * 8192))); }
    }
}
__device__ __forceinline__ void gather_unit(unsigned char* ws, int b, int h, int j, LAS unsigned char* lds, int X, LAS unsigned* ctr) {
    constexpr int ND = 4, G = 8;
    int tid_ = threadIdx.x; asm volatile("" : "+v"(tid_));
    const int tid = tid_, lane = tid & 63, r32 = lane & 31, hi = lane >> 5; const int wid = __builtin_amdgcn_readfirstlane(tid >> 6);
    const int bh = b * 8 + h;
    const _Float16* Qg = (const _Float16*)(ws + WS_QMB) + (size_t)b * SEQ * 512 + h * 64;
    const unsigned short* lst = (const unsigned short*)(ws + WS_LIST) + (size_t)(bh * 16 + j) * 4096;
    const int cnt = __builtin_amdgcn_readfirstlane((int)((const unsigned*)(ws + WS_CNT))[bh * 16 + j]);
    const int ngr = (cnt + 31) >> 5;
    LAS unsigned char* kfb = lds + X * GBUF; LAS unsigned char* vfb = kfb + G_V;
    LAS float* wsf = (LAS float*)(lds + G_WS) + wid * 128; LAS unsigned* wsu = (LAS unsigned*)wsf;
    const int vro = ((lane >> 4) & 1) * 32 + (lane & 3) * 8 + (4 * hi + ((lane & 15) >> 2)) * 64;
#define GT_SBAR() __builtin_amdgcn_sched_barrier(0)
#define GT_PIN(x) asm volatile("" : "+v"(x))
#define GT_KF(buf, g) (*(const LAS h8*)(kfb + (buf) * 8192 + kaddr<64>(32 * ((g) & 1) + r32, 2 * ((g) >> 1) + hi)))
#define GT_VF(buf, i) (vfb + (buf) * 8192 + vro + ((i) >> 2) * 4096 + ((i) & 3) * 1024)
#define GT_MF(a, b, c) __builtin_amdgcn_mfma_f32_32x32x16_f16(a, b, c, 0, 0, 0)
#define GT_MOVE(P0, P1, PM) do { const bool move_ = init ? ((PM) > THR) : ((PM) > -INFINITY); \
        if (__any(move_)) { const float dl_ = move_ ? (init ? fmaxf((PM), 0.f) : (PM)) : 0.f; const float al_ = (move_ && init) ? __builtin_amdgcn_exp2f(-dl_) : 1.f; \
            init = init || move_; l_reg *= al_; \
            _Pragma("unroll") for (int r_ = 0; r_ < 16; ++r_) { P0[r_] -= dl_; P1[r_] -= dl_; negm[r_] -= dl_; } \
            if (hi == 0) wsf[r32] = al_; asm volatile("s_waitcnt lgkmcnt(0)" ::: "memory"); \
            _Pragma("unroll") for (int r_ = 0; r_ < 16; ++r_) { const float a_ = wsf[crow(r_, hi)]; o[0][r_] *= a_; o[1][r_] *= a_; } } } while (0)
#define GT_TAKE() ({ unsigned v_ = 0u; if (lane == 0) v_ = __hip_atomic_fetch_add(ctr, 1u, __ATOMIC_RELAXED, __HIP_MEMORY_SCOPE_WORKGROUP); (int)__builtin_amdgcn_readfirstlane((int)v_); })
    h8 qr[ND]; bool validn = false; unsigned entn = 0u;
    int g = GT_TAKE(), gn = ngr;
    if (g < ngr) { const int idx = g * 32 + r32; validn = idx < cnt; entn = validn ? (unsigned)lst[idx] : 0u;
#pragma unroll
        for (int d0 = 0; d0 < ND; ++d0) qr[d0] = *(const h8*)(Qg + (size_t)(entn & 4095u) * 512 + d0 * 16 + hi * 8); }
    for (; g < ngr; g = gn) {
        const bool valid = validn; const unsigned ent = entn; const int row = (int)(ent & 4095u), slot = (int)(ent >> 12) & 3;
        gn = GT_TAKE(); { const int idx = gn * 32 + r32; validn = idx < cnt; entn = validn ? (unsigned)lst[idx] : 0u; }
#pragma unroll
        for (int d0 = 0; d0 < ND; ++d0) asm volatile("" : "+v"(qr[d0]));
        float l_reg = 0.f; bool init = false; f16v o[2]; o[0] = f16v{}; o[1] = f16v{}; f16v negm = f16v{}; asm volatile("" : "+v"(negm));
        f16v pC0, pC1, pD0, pD1;
        {
            h8 kf_[G];
#pragma unroll
            for (int g_ = 0; g_ < G; ++g_) kf_[g_] = GT_KF(0, g_);
            GT_SBAR();
#pragma unroll
            for (int d_ = 0; d_ < ND; ++d_) { pC0 = GT_MF(kf_[2 * d_], qr[d_], d_ == 0 ? negm : pC0); pC1 = GT_MF(kf_[2 * d_ + 1], qr[d_], d_ == 0 ? negm : pC1); }
            asm volatile("s_nop 15\n\ts_nop 7" : "+v"(pC0), "+v"(pC1));
            float pa_ = max3f(pC0[0], pC0[1], pC1[0]), pb_ = max3f(pC0[2], pC0[3], pC1[1]); pa_ = max3f(pa_, pC1[2], pC1[3]);
#pragma unroll
            for (int r_ = 4; r_ < 16; r_ += 4) { pa_ = max3f(pa_, pC0[r_], pC0[r_ + 1]); pb_ = max3f(pb_, pC0[r_ + 2], pC0[r_ + 3]); pa_ = max3f(pa_, pC1[r_], pC1[r_ + 1]); pb_ = max3f(pb_, pC1[r_ + 2], pC1[r_ + 3]); }
            const float pm = swapmax(fmaxf(pa_, pb_)); GT_MOVE(pC0, pC1, pm);
        }
        auto gstep = [&](f16v& pC0, f16v& pC1, f16v& pN0, f16v& pN1, const int t, auto hn) __attribute__((always_inline)) {
            constexpr bool hasn = decltype(hn)::value;
            float ps = 0.f;
            if (hasn) {
                h8 kf[G];
#pragma unroll
                for (int g_ = 0; g_ < 4; ++g_) kf[g_] = GT_KF(t + 1, g_);
                GT_SBAR();
#pragma unroll
                for (int g_ = 0; g_ < G; ++g_) {
                    if (g_ + 4 < G) kf[g_ + 4] = GT_KF(t + 1, g_ + 4);
                    if (g_ & 1) pN1 = GT_MF(kf[g_], qr[g_ >> 1], g_ == 1 ? negm : pN1); else pN0 = GT_MF(kf[g_], qr[g_ >> 1], g_ == 0 ? negm : pN0);
#pragma unroll
                    for (int e = 4 * g_; e < 4 * g_ + 4; ++e) { if (e < 16) { pC0[e] = __builtin_amdgcn_exp2f(pC0[e]); ps += pC0[e]; } else { pC1[e - 16] = __builtin_amdgcn_exp2f(pC1[e - 16]); ps += pC1[e - 16]; } }
                    GT_PIN(pC0); GT_PIN(pC1); GT_PIN(ps); GT_SBAR();
                }
            } else {
#pragma unroll
                for (int r = 0; r < 16; ++r) { pC0[r] = __builtin_amdgcn_exp2f(pC0[r]); pC1[r] = __builtin_amdgcn_exp2f(pC1[r]); ps += pC0[r] + pC1[r]; }
            }
            l_reg += swapsum(ps);
            u4 pw[4];
#pragma unroll
            for (int k_ = 0; k_ < 2; ++k_) {
                pw[k_] = (u4){pkh(pC0[8 * k_], pC0[8 * k_ + 1]), pkh(pC0[8 * k_ + 2], pC0[8 * k_ + 3]), pkh(pC0[8 * k_ + 4], pC0[8 * k_ + 5]), pkh(pC0[8 * k_ + 6], pC0[8 * k_ + 7])};
                pw[2 + k_] = (u4){pkh(pC1[8 * k_], pC1[8 * k_ + 1]), pkh(pC1[8 * k_ + 2], pC1[8 * k_ + 3]), pkh(pC1[8 * k_ + 4], pC1[8 * k_ + 5]), pkh(pC1[8 * k_ + 6], pC1[8 * k_ + 7])}; }
            s4 vlo[8], vhi[8]; float pa = 0.f, pb = 0.f;
#pragma unroll
            for (int i = 0; i < 3; ++i) { vlo[i] = vtr(GT_VF(t, i)); vhi[i] = vtr(GT_VF(t, i) + 512); }
            if (hasn) asm volatile("s_nop 7" : "+v"(pN0), "+v"(pN1));
            GT_SBAR();
#pragma unroll
            for (int i = 0; i < 8; ++i) {
                if (i + 3 < 8) { vlo[i + 3] = vtr(GT_VF(t, i + 3)); vhi[i + 3] = vtr(GT_VF(t, i + 3) + 512); }
                const s8 vv = (s8){vlo[i][0], vlo[i][1], vlo[i][2], vlo[i][3], vhi[i][0], vhi[i][1], vhi[i][2], vhi[i][3]};
                o[i >> 2] = GT_MF(__builtin_bit_cast(h8, pw[i & 3]), __builtin_bit_cast(h8, vv), o[i >> 2]);
                if (hasn) {
                    if (i == 0) { pa = max3f(pN0[0], pN0[1], pN1[0]); pb = max3f(pN0[2], pN0[3], pN1[1]); }
                    else if (i == 1) { pa = max3f(pa, pN1[2], pN1[3]); pb = max3f(pb, pN0[6], pN0[7]); }
                    else if (i == 2) { pa = max3f(pa, pN0[4], pN0[5]); pb = max3f(pb, pN1[6], pN1[7]); }
                    else if (i == 3) { pa = max3f(pa, pN1[4], pN1[5]); pb = max3f(pb, pN0[10], pN0[11]); }
                    else if (i == 4) { pa = max3f(pa, pN0[8], pN0[9]); pb = max3f(pb, pN1[10], pN1[11]); }
                    else if (i == 5) { pa = max3f(pa, pN1[8], pN1[9]); pb = max3f(pb, pN0[14], pN0[15]); }
                    else if (i == 6) { pa = max3f(pa, pN0[12], pN0[13]); pb = max3f(pb, pN1[14], pN1[15]); }
                    else { pa = max3f(pa, pN1[12], pN1[13]); }
                    GT_PIN(pa); GT_PIN(pb);
                }
                GT_SBAR();
            }
            if (hasn) { const float pm = swapmax(fmaxf(pa, pb)); GT_MOVE(pN0, pN1, pm); }
        };
        gstep(pC0, pC1, pD0, pD1, 0, T1{}); gstep(pD0, pD1, pC0, pC1, 1, T1{}); gstep(pC0, pC1, pD0, pD1, 2, T1{}); gstep(pD0, pD1, pC0, pC1, 3, T0{});
        if (gn < ngr) {
#pragma unroll
            for (int d0 = 0; d0 < ND; ++d0) qr[d0] = *(const h8*)(Qg + (size_t)(entn & 4095u) * 512 + d0 * 16 + hi * 8); }
        const unsigned gr = (unsigned)(bh * 4096 + row);
        if (hi == 0) { wsf[32 + r32] = 1.f / l_reg; wsu[64 + r32] = valid ? opart_off(slot) + gr * 128u : G_SINK;
            if (valid) ((float2*)(ws + WS_ML))[(unsigned)slot * 524288u + gr] = make_float2(-negm[0], l_reg); }
        asm volatile("s_waitcnt lgkmcnt(0)" ::: "memory");
#pragma unroll
        for (int k = 0; k < 4; ++k) {
            typedef float f4e __attribute__((ext_vector_type(4)));
            const f4e rl4 = *(const LAS f4e*)(wsf + 32 + 8 * k + 4 * hi); const u4 of4 = *(const LAS u4*)(wsu + 64 + 8 * k + 4 * hi);
#pragma unroll
            for (int i = 0; i < 4; ++i) { const int r = 4 * k + i; const unsigned off = of4[i] + (unsigned)r32 * 2u;
                *(_Float16*)(ws + off) = (_Float16)(o[0][r] * rl4[i]); *(_Float16*)(ws + off + 64u) = (_Float16)(o[1][r] * rl4[i]); } }
    }
#undef GT_TAKE
#undef GT_SBAR
#undef GT_PIN
#undef GT_KF
#undef GT_VF
#undef GT_MF
#undef GT_MOVE
}


__device__ __forceinline__ void own_unit(unsigned char* ws, int b, int h, int qb, LAS unsigned char* lds, int X, bool dry, int rg) {
    constexpr int ND = 4, G = 8;
    int tid_ = threadIdx.x; asm volatile("" : "+v"(tid_));
    const int tid = tid_, lane = tid & 63, r32 = lane & 31, hi = lane >> 5; const int wid = __builtin_amdgcn_readfirstlane(tid >> 6);
    const int bh = b * 8 + h, nt = (rg >> 1) + 1; const bool odd = rg & 1; const int qw0 = qb * 256 + rg * 32;
    const _Float16* Qg = (const _Float16*)(ws + WS_QMB) + ((size_t)b * SEQ + qw0) * 512 + h * 64;
    LAS unsigned char* kfb = lds + X * GBUF; LAS unsigned char* vfb = kfb + G_V;
    LAS float* wsf = (LAS float*)(lds + G_WS) + wid * 128;
    const int vro = ((lane >> 4) & 1) * 32 + (lane & 3) * 8 + (4 * hi + ((lane & 15) >> 2)) * 64;
    const int dl = r32 - 4 * hi;
#define GT_SBAR() __builtin_amdgcn_sched_barrier(0)
#define GT_PIN(x) asm volatile("" : "+v"(x))
#define GT_KF(buf, g) (*(const LAS h8*)(kfb + (buf) * 8192 + kaddr<64>(32 * ((g) & 1) + r32, 2 * ((g) >> 1) + hi)))
#define GT_VF(buf, i) (vfb + (buf) * 8192 + vro + ((i) >> 2) * 4096 + ((i) & 3) * 1024)
#define GT_MF(a, b, c) __builtin_amdgcn_mfma_f32_32x32x16_f16(a, b, c, 0, 0, 0)
#define GT_MOVE(P0, P1, PM) do { const bool move_ = init ? ((PM) > THR) : ((PM) > -INFINITY); \
        if (__any(move_)) { const float dl_ = move_ ? (init ? fmaxf((PM), 0.f) : (PM)) : 0.f; const float al_ = (move_ && init) ? __builtin_amdgcn_exp2f(-dl_) : 1.f; \
            init = init || move_; l_reg *= al_; \
            _Pragma("unroll") for (int r_ = 0; r_ < 16; ++r_) { P0[r_] -= dl_; P1[r_] -= dl_; negm[r_] -= dl_; } \
            if (hi == 0) wsf[r32] = al_; asm volatile("s_waitcnt lgkmcnt(0)" ::: "memory"); \
            _Pragma("unroll") for (int r_ = 0; r_ < 16; ++r_) { const float a_ = wsf[crow(r_, hi)]; o[0][r_] *= a_; o[1][r_] *= a_; } } } while (0)
#define GT_MASK(P0, P1) do { _Pragma("unroll") for (int r_ = 0; r_ < 16; ++r_) { const bool dg_ = ((r_ & 3) + 8 * (r_ >> 2)) > dl; \
            if (!odd) { if (dg_) P0[r_] = -INFINITY; P1[r_] = -INFINITY; } else { if (dg_) P1[r_] = -INFINITY; } } } while (0)
    h8 qr[ND];
#pragma unroll
    for (int d0 = 0; d0 < ND; ++d0) qr[d0] = *(const h8*)(Qg + (size_t)r32 * 512 + d0 * 16 + hi * 8);
#pragma unroll
    for (int d0 = 0; d0 < ND; ++d0) asm volatile("" : "+v"(qr[d0]));
    float l_reg = 0.f; bool init = false; f16v o[2]; o[0] = f16v{}; o[1] = f16v{}; f16v negm = f16v{}; asm volatile("" : "+v"(negm));
    f16v pC0, pC1, pD0, pD1;
    {
        h8 kf_[G];
#pragma unroll
        for (int g_ = 0; g_ < G; ++g_) kf_[g_] = GT_KF(0, g_);
        GT_SBAR();
#pragma unroll
        for (int d_ = 0; d_ < ND; ++d_) { pC0 = GT_MF(kf_[2 * d_], qr[d_], d_ == 0 ? negm : pC0); pC1 = GT_MF(kf_[2 * d_ + 1], qr[d_], d_ == 0 ? negm : pC1); }
        asm volatile("s_nop 15\n\ts_nop 7" : "+v"(pC0), "+v"(pC1));
        if (nt == 1) GT_MASK(pC0, pC1);
        float pa_ = max3f(pC0[0], pC0[1], pC1[0]), pb_ = max3f(pC0[2], pC0[3], pC1[1]); pa_ = max3f(pa_, pC1[2], pC1[3]);
#pragma unroll
        for (int r_ = 4; r_ < 16; r_ += 4) { pa_ = max3f(pa_, pC0[r_], pC0[r_ + 1]); pb_ = max3f(pb_, pC0[r_ + 2], pC0[r_ + 3]); pa_ = max3f(pa_, pC1[r_], pC1[r_ + 1]); pb_ = max3f(pb_, pC1[r_ + 2], pC1[r_ + 3]); }
        const float pm = swapmax(fmaxf(pa_, pb_)); GT_MOVE(pC0, pC1, pm);
    }
    auto gstep = [&](f16v& pC0, f16v& pC1, f16v& pN0, f16v& pN1, const int t, auto hn, const bool mk) __attribute__((always_inline)) {
        constexpr bool hasn = decltype(hn)::value;
        float ps = 0.f; f2v ps2 = (f2v){0.f, 0.f};
        if (hasn) {
            h8 kf[G];
#pragma unroll
            for (int g_ = 0; g_ < 4; ++g_) kf[g_] = GT_KF(t + 1, g_);
            GT_SBAR();
#pragma unroll
            for (int g_ = 0; g_ < G; ++g_) {
                if (g_ + 4 < G) kf[g_ + 4] = GT_KF(t + 1, g_ + 4);
                if (g_ & 1) pN1 = GT_MF(kf[g_], qr[g_ >> 1], g_ == 1 ? negm : pN1); else pN0 = GT_MF(kf[g_], qr[g_ >> 1], g_ == 0 ? negm : pN0);
#pragma unroll
                for (int e = 4 * g_; e < 4 * g_ + 4; ++e) { if (e < 16) { pC0[e] = __builtin_amdgcn_exp2f(pC0[e]); ps += pC0[e]; } else { pC1[e - 16] = __builtin_amdgcn_exp2f(pC1[e - 16]); ps += pC1[e - 16]; } }
                GT_PIN(pC0); GT_PIN(pC1); GT_PIN(ps); GT_SBAR();
            }
        } else {
#pragma unroll
            for (int r = 0; r < 16; ++r) { pC0[r] = __builtin_amdgcn_exp2f(pC0[r]); pC1[r] = __builtin_amdgcn_exp2f(pC1[r]); ps += pC0[r] + pC1[r]; }
        }
        l_reg += swapsum(ps);
        u4 pw[4];
#pragma unroll
        for (int k_ = 0; k_ < 2; ++k_) {
            pw[k_] = (u4){pkh(pC0[8 * k_], pC0[8 * k_ + 1]), pkh(pC0[8 * k_ + 2], pC0[8 * k_ + 3]), pkh(pC0[8 * k_ + 4], pC0[8 * k_ + 5]), pkh(pC0[8 * k_ + 6], pC0[8 * k_ + 7])};
            pw[2 + k_] = (u4){pkh(pC1[8 * k_], pC1[8 * k_ + 1]), pkh(pC1[8 * k_ + 2], pC1[8 * k_ + 3]), pkh(pC1[8 * k_ + 4], pC1[8 * k_ + 5]), pkh(pC1[8 * k_ + 6], pC1[8 * k_ + 7])}; }
        s4 vlo[8], vhi[8]; float pa = 0.f, pb = 0.f;
#pragma unroll
        for (int i = 0; i < 3; ++i) { vlo[i] = vtr(GT_VF(t, i)); vhi[i] = vtr(GT_VF(t, i) + 512); }
        if (hasn) { asm volatile("s_nop 7" : "+v"(pN0), "+v"(pN1)); if (mk) GT_MASK(pN0, pN1); }
        GT_SBAR();
#pragma unroll
        for (int i = 0; i < 8; ++i) {
            if (i + 3 < 8) { vlo[i + 3] = vtr(GT_VF(t, i + 3)); vhi[i + 3] = vtr(GT_VF(t, i + 3) + 512); }
            const s8 vv = (s8){vlo[i][0], vlo[i][1], vlo[i][2], vlo[i][3], vhi[i][0], vhi[i][1], vhi[i][2], vhi[i][3]};
            o[i >> 2] = GT_MF(__builtin_bit_cast(h8, pw[i & 3]), __builtin_bit_cast(h8, vv), o[i >> 2]);
            if (hasn) {
                if (i == 0) { pa = max3f(pN0[0], pN0[1], pN1[0]); pb = max3f(pN0[2], pN0[3], pN1[1]); }
                else if (i == 1) { pa = max3f(pa, pN1[2], pN1[3]); pb = max3f(pb, pN0[6], pN0[7]); }
                else if (i == 2) { pa = max3f(pa, pN0[4], pN0[5]); pb = max3f(pb, pN1[6], pN1[7]); }
                else if (i == 3) { pa = max3f(pa, pN1[4], pN1[5]); pb = max3f(pb, pN0[10], pN0[11]); }
                else if (i == 4) { pa = max3f(pa, pN0[8], pN0[9]); pb = max3f(pb, pN1[10], pN1[11]); }
                else if (i == 5) { pa = max3f(pa, pN1[8], pN1[9]); pb = max3f(pb, pN0[14], pN0[15]); }
                else if (i == 6) { pa = max3f(pa, pN0[12], pN0[13]); pb = max3f(pb, pN1[14], pN1[15]); }
                else { pa = max3f(pa, pN1[12], pN1[13]); }
                GT_PIN(pa); GT_PIN(pb);
            }
            GT_SBAR();
        }
        if (hasn) { const float pm = swapmax(fmaxf(pa, pb)); GT_MOVE(pN0, pN1, pm); }
    };
    for (int t = 0; t < nt - 1; ++t) { gstep(pC0, pC1, pD0, pD1, t, T1{}, t + 2 == nt); pC0 = pD0; pC1 = pD1; }
    gstep(pC0, pC1, pD0, pD1, nt - 1, T0{}, false);
    if (hi == 0) { wsf[32 + r32] = 1.f / l_reg; wsf[64 + r32] = l_reg; wsf[r32] = -negm[0]; }
    int lane_e = lane; asm volatile("" : "+v"(lane_e));
    const int row8 = lane_e >> 3, ch = lane_e & 7, nsl = qb < 3 ? qb : 3;
    unsigned char* zbu = (unsigned char*)((_Float16*)(ws + WS_ZCAT) + 512 + ((size_t)b * SEQ + qw0) * 1024 + h * 64);
    h8 zz[4], po[4][3]; float2 ml[4][3];
#pragma unroll
    for (int k = 0; k < 4; ++k) { const int row = 8 * k + row8; const unsigned gr = (unsigned)(bh * 4096 + qw0 + row);
        zz[k] = *(const h8*)(zbu + (unsigned)(row * 1024 + ch * 8) * 2u);
#pragma unroll
        for (int s = 0; s < 3; ++s) if (s < nsl) { ml[k][s] = ((const float2*)(ws + WS_ML))[(unsigned)s * 524288u + gr]; po[k][s] = *(const h8*)(ws + opart_off(s) + gr * 128u + (unsigned)ch * 16u); } }
    asm volatile("s_waitcnt lgkmcnt(0)" ::: "memory");
    LAS _Float16* stg = (LAS _Float16*)(lds + G_ST) + wid * 512;
#pragma unroll
    for (int k = 0; k < 4; ++k) {
        typedef float f4e __attribute__((ext_vector_type(4)));
        const f4e rl4 = *(const LAS f4e*)(wsf + 32 + 8 * k + 4 * hi);
#pragma unroll
        for (int i = 0; i < 4; ++i) { stg[(4 * hi + i) * 64 + r32] = (_Float16)(o[0][4 * k + i] * rl4[i]); stg[(4 * hi + i) * 64 + 32 + r32] = (_Float16)(o[1][4 * k + i] * rl4[i]); }
        asm volatile("s_waitcnt lgkmcnt(0)" ::: "memory");
        const int row = 8 * k + row8; const h8 v = *(const LAS h8*)(stg + row8 * 64 + ch * 8);
        const float m_own = wsf[row], l_own = wsf[64 + row]; float M = m_own;
#pragma unroll
        for (int s = 0; s < 3; ++s) if (s < nsl) M = fmaxf(M, ml[k][s].x);
        const float w0 = l_own * __builtin_amdgcn_exp2f(m_own - M); float W = w0; float acc[8];
#pragma unroll
        for (int j = 0; j < 8; ++j) acc[j] = w0 * (float)v[j];
#pragma unroll
        for (int s = 0; s < 3; ++s) if (s < nsl) { const float w = ml[k][s].y * __builtin_amdgcn_exp2f(ml[k][s].x - M); W += w;
#pragma unroll
            for (int j = 0; j < 8; ++j) acc[j] = fmaf(w, (float)po[k][s][j], acc[j]); }
        const float rW = 1.f / W; h8 ov;
#pragma unroll
        for (int j = 0; j < 8; ++j) ov[j] = (_Float16)(acc[j] * rW * (float)zz[k][j]);
        if (!dry) *(h8*)(zbu + (unsigned)(row * 1024 + ch * 8) * 2u) = ov;
    }
#undef GT_SBAR
#undef GT_PIN
#undef GT_KF
#undef GT_VF
#undef GT_MF
#undef GT_MOVE
#undef GT_MASK
}

__device__ __forceinline__ void attn_phase(unsigned char* ws, LAS unsigned char* lds, int vb, int nvb) {
    const int vcu = (nvb % 8 == 0) ? (vb % 8) * (nvb / 8) + vb / 8 : vb; const int per = (1024 + nvb - 1) / nvb;
    for (int k = 0; k < per; ++k) {
        int it;
        if (nvb == 256) { const int xg = vcu >> 5, lw = vcu & 31; it = ((16 * xg + 4 * k + (lw >> 3)) << 3) | (lw & 7); }
        else { it = vcu * per + k; if (it >= 1024) break; }
        const int bh = it >> 3, pr = it & 7, b = bh >> 3, h = bh & 7;
        if (PROBE == 2) for (int uu = 0; uu < 2; ++uu) attn_unit<96, false, PROBE_ABL>(ws, b, h, uu ? 15 - pr : pr, lds, true);
        for (int uu = 0; uu < 2; ++uu) attn_unit<96, false>(ws, b, h, uu ? 15 - pr : pr, lds);
    }
    int nu = 0;
    for (int k = 0; k < per; ++k) { int it; if (nvb == 256) { const int xg = vcu >> 5, lw = vcu & 31; it = ((16 * xg + 4 * k + (lw >> 3)) << 3) | (lw & 7); } else { it = vcu * per + k; if (it >= 1024) break; } nu += 2; }
    auto unit_of = [&](int u, int& b, int& h, int& j) {
        const int k = u >> 1; int it; if (nvb == 256) { const int xg = vcu >> 5, lw = vcu & 31; it = ((16 * xg + 4 * k + (lw >> 3)) << 3) | (lw & 7); } else it = vcu * per + k;
        const int bh = it >> 3, pr = it & 7, rot = (bh >> 2) & 3; b = bh >> 3; h = bh & 7;
        const int sl = ((pr & 3) + rot) & 3; const int x = pr < 4 ? ((0x6170 >> (4 * sl)) & 15) : ((0x4352 >> (4 * sl)) & 15);
        j = (u & 1) ? 14 - x : x; return !((u & 1) && x == 7); };
    LAS unsigned* gc = (LAS unsigned*)(lds + G_CTL);
    int tid_g = threadIdx.x; asm volatile("" : "+v"(tid_g)); const int lane_g = tid_g & 63;
    for (int rep = 0; rep < (PROBE == 12 ? 2 : 1); ++rep)
    for (int u0 = 0; u0 < nu; u0 += 64) {
        const int nc = nu - u0 < 64 ? nu - u0 : 64;
        if (tid_g < 192) gc[tid_g] = 0u;
        { int b, h, j; if (unit_of(u0, b, h, j)) gather_dma(ws, b, h, j, lds, 0); if (nc > 1 && unit_of(u0 + 1, b, h, j)) gather_dma(ws, b, h, j, lds, 1); }
        asm volatile("s_waitcnt vmcnt(0)" ::: "memory"); __syncthreads();
        for (int uc = 0; uc < nc; ++uc) {
            int b, h, j; const bool ok = unit_of(u0 + uc, b, h, j);
            if (uc >= 2) while (((volatile LAS unsigned*)gc)[128 + uc] == 0u) __builtin_amdgcn_s_sleep(4);
            if (ok) gather_unit(ws, b, h, j, lds, uc & 1, gc + uc);
            unsigned n = 0u; if (lane_g == 0) n = __hip_atomic_fetch_add(gc + 64 + uc, 1u, __ATOMIC_RELAXED, __HIP_MEMORY_SCOPE_WORKGROUP);
            n = (unsigned)__builtin_amdgcn_readfirstlane((int)n) + 1u;
            if (n == 8u && uc + 2 < nc) { int b2, h2, j2;
                if (unit_of(u0 + uc + 2, b2, h2, j2)) { gather_dma_all(ws, b2, h2, j2, lds, uc & 1); asm volatile("s_waitcnt vmcnt(0)" ::: "memory"); }
                if (lane_g == 0) ((volatile LAS unsigned*)gc)[128 + uc + 2] = 1u; }
        }
        __syncthreads();
    }
}
template <bool DRY> __device__ __forceinline__ void attn_phase2_pass(unsigned char* ws, LAS unsigned char* lds, int vb, int nvb) {
    LAS unsigned* gc = (LAS unsigned*)(lds + G_CTL);
    int tid_g = threadIdx.x; asm volatile("" : "+v"(tid_g)); const int lane_g = tid_g & 63;
    const int nu = vb < 2048 ? (2048 - vb + nvb - 1) / nvb : 0;
    for (int u0 = 0; u0 < nu; u0 += 64) {
        const int nc = nu - u0 < 64 ? nu - u0 : 64;
        if (tid_g < 192) gc[tid_g] = 0u;
        { const int i0 = vb + u0 * nvb; gather_dma(ws, i0 >> 7, (i0 >> 4) & 7, i0 & 15, lds, 0); if (nc > 1) { const int i1 = i0 + nvb; gather_dma(ws, i1 >> 7, (i1 >> 4) & 7, i1 & 15, lds, 1); } }
        asm volatile("s_waitcnt vmcnt(0)" ::: "memory"); __syncthreads();
        for (int uc = 0; uc < nc; ++uc) {
            const int it = vb + (u0 + uc) * nvb;
            if (uc >= 2) while (((volatile LAS unsigned*)gc)[128 + uc] == 0u) __builtin_amdgcn_s_sleep(4);
            for (;;) { unsigned c = 0u; if (lane_g == 0) c = __hip_atomic_fetch_add(gc + uc, 1u, __ATOMIC_RELAXED, __HIP_MEMORY_SCOPE_WORKGROUP);
                c = (unsigned)__builtin_amdgcn_readfirstlane((int)c); if (c >= 8u) break;
                own_unit(ws, it >> 7, (it >> 4) & 7, it & 15, lds, uc & 1, DRY, 7 - (int)c); }
            unsigned n = 0u; if (lane_g == 0) n = __hip_atomic_fetch_add(gc + 64 + uc, 1u, __ATOMIC_RELAXED, __HIP_MEMORY_SCOPE_WORKGROUP);
            n = (unsigned)__builtin_amdgcn_readfirstlane((int)n) + 1u;
            if (n == 8u && uc + 2 < nc) { const int i2 = it + 2 * nvb; gather_dma_all(ws, i2 >> 7, (i2 >> 4) & 7, i2 & 15, lds, uc & 1); asm volatile("s_waitcnt vmcnt(0)" ::: "memory");
                if (lane_g == 0) ((volatile LAS unsigned*)gc)[128 + uc + 2] = 1u; }
        }
        __syncthreads();
    }
}
__device__ __forceinline__ void attn_phase2(unsigned char* ws, LAS unsigned char* lds, int vb, int nvb) {
    if (PROBE == 13) attn_phase2_pass<true>(ws, lds, vb, nvb);
    attn_phase2_pass<false>(ws, lds, vb, nvb);
}
}

constexpr int RING_BYTES = 131072, MISC_OFF = RING_BYTES + 320, LDS_BYTES = 147456;
constexpr int CW_BAR = 4096;

__global__ void __launch_bounds__(512, 2) mega(Params p) {
    extern __shared__ __attribute__((aligned(16))) unsigned char lds[];
    const int vb = blockIdx.x, nvb = gridDim.x, tid = threadIdx.x, lane = tid & 63, wave = tid >> 6;
    const int gtid = vb * 512 + tid, gsize = nvb * 512, gwave = vb * 8 + wave, nwaves = nvb * 8;
    volatile LAS unsigned* misc = (volatile LAS unsigned*)((LAS unsigned char*)lds + MISC_OFF);
    if (tid < 32) misc[tid] = 0u;
    __syncthreads();
    XcdBarrier bar = xcd_barrier_post((unsigned*)(p.ws + WS_CTL) + CW_BAR, misc + 8);
    LAS unsigned char* ldsl = (LAS unsigned char*)lds;
    { int t_ = threadIdx.x; asm volatile("" : "+v"(t_)); ph_prep(p, vb * 512 + t_, gsize, vb, nvb, ldsl); ph_weights(p, ldsl, vb * 8 + (t_ >> 6), nwaves, t_ >> 6, t_ & 63);
      if (PROBE == 10) ph_weights(p, ldsl, vb * 8 + (t_ >> 6), nwaves, t_ >> 6, t_ & 63);
      if (PROBE == 11) ph_tab(p, vb * 512 + t_, gsize); }
    xcd_barrier(bar);
    for (int rep4 = 0; rep4 < ((PROBE == 4 || PROBE == 6) ? 2 : 1); ++rep4) { int t_ = threadIdx.x; asm volatile("" : "+v"(t_)); ph_hnorm(p, vb * 8 + (t_ >> 6), nwaves, t_ & 63); }
    xcd_barrier(bar);
    {
        pg8::Gemm g{(const pg8::bf16_t*)(p.ws + WS_H), (const pg8::bf16_t*)(p.ws + WT_IN), M_, 5120, 1024}; pg8::StaticOrder S; S.init(M_, 5120, nvb, vb);
        for (int rep = (PROBE == 1 ? 1 : 0); rep >= 0; --rep) { pg8::EpiInF E{p.ws, p.b_merge, rep}; pg8::gemm_phase<pg8::EpiInF, pg8::StaticOrder, true, true>(ldsl, g, S, E); }
        if (PROBE == 5) { pg8::EpiNull E; pg8::gemm_phase<pg8::EpiNull, pg8::StaticOrder, true, true>(ldsl, g, S, E); }
    }
    xcd_barrier(bar);
    { int t_ = threadIdx.x; asm volatile("" : "+v"(t_)); att::ph_gate(p.ws, vb * 8 + (t_ >> 6), nwaves, t_ & 63); }
    for (int rep4 = 0; rep4 < ((PROBE == 4 || PROBE == 7) ? 2 : 1); ++rep4) {
        pg8::Gemm g{(const pg8::bf16_t*)(p.ws + WS_QLAT), (const pg8::bf16_t*)(p.ws + WT_UQ), M_, 768, 256}; pg8::StaticOrder S; S.init(M_, 768, nvb, vb);
        pg8::EpiUqF E{p.ws}; pg8::gemm_phase<pg8::EpiUqF, pg8::StaticOrder, true, true>(ldsl, g, S, E);
    }
    for (int rep4 = 0; rep4 < ((PROBE == 4 || PROBE == 7) ? 2 : 1); ++rep4) {
        pg8::Gemm g{(const pg8::bf16_t*)(p.ws + WS_KVL), (const pg8::bf16_t*)(p.ws + WT_UKV), M_, 1024, 128};     pg8::StaticOrder S; S.init(M_, 1024, nvb, vb);
        pg8::EpiUkvF E{p.ws}; pg8::gemm_phase<pg8::EpiUkvF, pg8::StaticOrder, true, true>(ldsl, g, S, E);
    }
    xcd_barrier(bar);
    att::attn_phase(p.ws, ldsl, vb, nvb);
    xcd_barrier(bar);
    att::attn_phase2(p.ws, ldsl, vb, nvb);
    xcd_barrier(bar);
    {
        pg8::Gemm g{(const pg8::bf16_t*)(p.ws + WS_ZCAT), (const pg8::bf16_t*)(p.ws + WT_OA), M_, 1024, 1024}; pg8::StaticOrder S; S.init(M_, 1024, nvb, vb);
        pg8::EpiYcatF E{p.ws}; pg8::gemm_phase<pg8::EpiYcatF, pg8::StaticOrder, true, true>(ldsl, g, S, E);
    }
    xcd_barrier(bar);
    for (int rep4 = 0; rep4 < ((PROBE == 4 || PROBE == 9) ? 2 : 1); ++rep4) {
        pg8::Gemm g{(const pg8::bf16_t*)(p.ws + WS_YM), (const pg8::bf16_t*)(p.ws + WT_OUT), M_, 1024, 1024}; pg8::StaticOrder S; S.init(M_, 1024, nvb, vb);
        pg8::EpiYF E{p.ws}; pg8::gemm_phase<pg8::EpiYF, pg8::StaticOrder, true, true>(ldsl, g, S, E);
    }
    xcd_barrier(bar);
    for (int rep4 = 0; rep4 < ((PROBE == 4 || PROBE == 9) ? 2 : 1); ++rep4) { int t_ = threadIdx.x; asm volatile("" : "+v"(t_)); ph_final(p, vb * 8 + (t_ >> 6), nwaves, t_ & 63); }
}

extern "C" void kernel_launch(void* const* d_in, const int* in_sizes, int n_in, void* d_out, int out_size, void* d_ws, size_t ws_size, hipStream_t stream) {
    if (n_in != 16 || out_size != M_ * DM || ws_size < WS_END) { fprintf(stderr, "kernel_launch: unexpected shapes (n_in %d, out %d, ws %zu)\n", n_in, out_size, ws_size); return; }
    Params p{};
    p.x = (const float*)d_in[0]; p.c = (const float*)d_in[1]; p.pos = (const int*)d_in[2]; p.w_ada = (const float*)d_in[3]; p.b_ada = (const float*)d_in[4];
    p.g_pre = (const float*)d_in[5]; p.g_post = (const float*)d_in[6]; p.w_in = (const float*)d_in[7]; p.g_q = (const float*)d_in[8]; p.w_uq = (const float*)d_in[9];
    p.g_kv = (const float*)d_in[10]; p.w_ukv = (const float*)d_in[11]; p.w_o_mla = (const float*)d_in[12]; p.w_o_moba = (const float*)d_in[13]; p.b_merge = (const float*)d_in[14]; p.w_out = (const float*)d_in[15];
    p.out = (float*)d_out; p.ws = (unsigned char*)d_ws;
    static int grid = 0;
    if (grid == 0) {
        int dev = 0, cus = 0, per_cu = 0;
        if (hipGetDevice(&dev) != hipSuccess || hipDeviceGetAttribute(&cus, hipDeviceAttributeMultiprocessorCount, dev) != hipSuccess) { fprintf(stderr, "kernel_launch: device query failed\n"); grid = -1; return; }
        if (hipFuncSetAttribute((const void*)mega, hipFuncAttributeMaxDynamicSharedMemorySize, LDS_BYTES) != hipSuccess) { fprintf(stderr, "kernel_launch: hipFuncSetAttribute failed\n"); grid = -1; return; }
        if (hipOccupancyMaxActiveBlocksPerMultiprocessor(&per_cu, (const void*)mega, 512, LDS_BYTES) != hipSuccess || per_cu < 1) { fprintf(stderr, "kernel_launch: occupancy query says %d\n", per_cu); }
        (void)hipGetLastError();
        grid = cus;
    }
    if (grid < 0) return;
    (void)hipMemsetAsync(d_ws, 0, ZERO_BYTES, stream);
    hipLaunchKernelGGL(mega, dim3(grid), dim3(512), LDS_BYTES, stream, p);
}
```
